# Optimizing an MI355X kernel written in HIP

```python
import math
import jax
import jax.numpy as jnp
from jax import lax
import numpy as np

D_MODEL = 2048
BATCH = 4
SEQ = 2048
DEPTH = 1

D_PLE = 256
MIX_WIDTH = D_MODEL
DIFF_WIDTH = MIX_WIDTH // 2
DIFF_HEAD_DIM = 64
DIFF_V_DIM = 2 * DIFF_HEAD_DIM
DIFF_HEADS = DIFF_WIDTH // DIFF_V_DIM
DIFF_QK_WIDTH = DIFF_HEADS * 2 * DIFF_HEAD_DIM
RWKV_WIDTH = MIX_WIDTH - DIFF_WIDTH
RWKV_HEAD_SIZE = 64
RWKV_HEADS = RWKV_WIDTH // RWKV_HEAD_SIZE
LORA_DECAY = 64
LORA_AAA = 64
LORA_GATE = 160
RWKV_PROJ = 3 * RWKV_WIDTH + LORA_DECAY + LORA_AAA + LORA_GATE
O_RWKV = 2 * DIFF_QK_WIDTH + DIFF_WIDTH
W_IN_COLS = O_RWKV + RWKV_PROJ
REL_BUCKETS = 32
REL_MAX_DIST = 128
Q_BLOCK = 128
N_GROUPS = 4
EXPERTS_PER_GROUP = 8
N_EXPERTS = N_GROUPS * EXPERTS_PER_GROUP
TOP_K_EXPERTS = 2
D_EXPERT = D_MODEL // 4
LN_EPS = 1e-5
RWKV_GN_EPS = 64e-5
NEG_INF = -1e30
DEEPNORM_ALPHA = (2 * DEPTH) ** 0.25
DEEPNORM_BETA = (8 * DEPTH) ** -0.25

kernel_name = 'hybrid_diffattn_rwkv7_hmoe'


def layer_norm(x, g, b):
    xf = x.astype(jnp.float32)
    mu = xf.mean(-1, keepdims=True)
    var = jnp.square(xf - mu).mean(-1, keepdims=True)
    return ((xf - mu) * lax.rsqrt(var + LN_EPS) * g + b).astype(x.dtype)


def rms_norm(x, g):
    xf = x.astype(jnp.float32)
    return xf * lax.rsqrt(jnp.square(xf).mean(-1, keepdims=True) + LN_EPS) * g


def t5_bucket(rel):
    n = jnp.maximum(rel, 0)
    max_exact = REL_BUCKETS // 2
    nf = jnp.maximum(n, 1).astype(jnp.float32)
    large = max_exact + (jnp.log(nf / max_exact) / math.log(REL_MAX_DIST / max_exact)
                         * (REL_BUCKETS - max_exact)).astype(jnp.int32)
    large = jnp.minimum(large, REL_BUCKETS - 1)
    return jnp.where(n < max_exact, n, large)


def diff_attention(q, k, v, rel_bias, lam, subln_g, lambda_init):
    B, S = q.shape[0], q.shape[1]
    nb = S // Q_BLOCK
    q_blocks = q.reshape(B, nb, Q_BLOCK, DIFF_HEADS, 2, DIFF_HEAD_DIM).swapaxes(0, 1)
    k_pos = jnp.arange(S, dtype=jnp.int32)
    vf = v.astype(jnp.float32)
    scale = DIFF_HEAD_DIM ** -0.5

    def one_block(args):
        qb, bi = args
        q_pos = bi * Q_BLOCK + jnp.arange(Q_BLOCK, dtype=jnp.int32)
        rel = q_pos[:, None] - k_pos[None, :]
        bias = jnp.moveaxis(rel_bias[t5_bucket(rel)], -1, 0).astype(jnp.float32)
        logits = jnp.einsum('bqhcd,bkhcd->bchqk', qb, k).astype(jnp.float32) * scale + bias[None, None]
        logits = jnp.where(rel[None, None, None] >= 0, logits, NEG_INF)
        probs = jax.nn.softmax(logits, axis=-1)
        attn = probs[:, 0] - lam * probs[:, 1]
        return jnp.einsum('bhqk,bkhd->bqhd', attn, vf)

    out = lax.map(one_block, (q_blocks, jnp.arange(nb, dtype=jnp.int32)))
    out = out.swapaxes(0, 1).reshape(B, S, DIFF_HEADS, DIFF_V_DIM)
    out = rms_norm(out, subln_g) * (1.0 - lambda_init)
    return out.reshape(B, S, DIFF_WIDTH).astype(q.dtype)


def _wkv7_step(state, inp):
    r, w, k, v, a, b = inp
    sa = jnp.einsum('bhij,bhj->bhi', state, a)
    state = state * w[:, :, None, :] + sa[..., None] * b[:, :, None, :] + v[..., None] * k[:, :, None, :]
    y = jnp.einsum('bhij,bhj->bhi', state, r)
    return state, y


def rwkv7_time_mix(proj, mu, w0, w2, a0, a2, g2, k_k, k_a, r_k, lnx_g, lnx_b):
    B, S = proj.shape[0], proj.shape[1]
    H, N = RWKV_HEADS, RWKV_HEAD_SIZE
    prev = jnp.pad(proj, ((0, 0), (1, 0), (0, 0)))[:, :-1]
    xs = proj + (prev - proj) * mu
    cuts = [RWKV_WIDTH, 2 * RWKV_WIDTH, 3 * RWKV_WIDTH,
            3 * RWKV_WIDTH + LORA_DECAY, 3 * RWKV_WIDTH + LORA_DECAY + LORA_AAA]
    r, k, v, xw, xa, xg = jnp.split(xs, cuts, axis=-1)
    w = -jax.nn.softplus(-(w0 + jnp.tanh(xw) @ w2)) - 0.5
    decay = jnp.exp(-jnp.exp(w.astype(jnp.float32)))
    a = jax.nn.sigmoid(a0 + xa @ a2)
    g = jax.nn.sigmoid(xg) @ g2
    kk = (k * k_k).reshape(B, S, H, N).astype(jnp.float32)
    kk = kk / jnp.maximum(jnp.linalg.norm(kk, axis=-1, keepdims=True), 1e-12)
    k = k * (1.0 + (a - 1.0) * k_a)
    rh = r.reshape(B, S, H, N).astype(jnp.float32)
    kh = k.reshape(B, S, H, N).astype(jnp.float32)
    vh = v.reshape(B, S, H, N).astype(jnp.float32)
    wh = decay.reshape(B, S, H, N)
    ah = a.reshape(B, S, H, N).astype(jnp.float32)
    xs_seq = tuple(jnp.moveaxis(t, 1, 0) for t in (rh, wh, kh, vh, -kk, kk * ah))
    state0 = jnp.zeros((B, H, N, N), jnp.float32)
    _, y = lax.scan(_wkv7_step, state0, xs_seq)
    y = jnp.moveaxis(y, 0, 1)
    y_mu = y.mean(-1, keepdims=True)
    y_var = jnp.square(y - y_mu).mean(-1, keepdims=True)
    y = (y - y_mu) * lax.rsqrt(y_var + RWKV_GN_EPS) * lnx_g.reshape(H, N) + lnx_b.reshape(H, N)
    bonus = jnp.sum(rh * kh * r_k, axis=-1, keepdims=True) * vh
    return ((y + bonus).reshape(B, S, RWKV_WIDTH) * g).astype(proj.dtype)


def hier_moe(h, gw, gb, ew, eb, w_gate, w_up, w_down):
    B, S, D = h.shape
    t = h.reshape(B * S, D)
    gprob = jax.nn.softmax((t @ gw + gb).astype(jnp.float32), axis=-1)
    gtop, gidx = lax.top_k(gprob, 1)
    elog = (t @ ew + eb).astype(jnp.float32).reshape(-1, N_GROUPS, EXPERTS_PER_GROUP)
    elog = jnp.take_along_axis(elog, gidx[:, :, None], axis=1)[:, 0]
    eprob = jax.nn.softmax(elog, axis=-1)
    etop, eidx = lax.top_k(eprob, TOP_K_EXPERTS)
    etop = etop / etop.sum(-1, keepdims=True)
    w_local = jnp.sum(jax.nn.one_hot(eidx, EXPERTS_PER_GROUP, dtype=jnp.float32) * etop[..., None], axis=1) * gtop
    gsel = jax.nn.one_hot(gidx[:, 0], N_GROUPS, dtype=jnp.float32)
    out = jnp.zeros_like(t)
    for gi in range(N_GROUPS):
        wg = (w_local * gsel[:, gi:gi + 1]).astype(t.dtype)
        hid = jax.nn.silu(jnp.einsum('td,edf->tef', t, w_gate[gi])) * jnp.einsum('td,edf->tef', t, w_up[gi])
        out = out + jnp.einsum('tef,efd->td', hid * wg[:, :, None], w_down[gi])
    return out.reshape(B, S, D)


def setup_inputs(seed: int = 0) -> dict:
    key = jax.random.key(seed)
    ks = iter(jax.random.split(key, 64))
    L, D = DEPTH, D_MODEL
    sd = D ** -0.5

    def nrm(shape, s):
        return s * jax.random.normal(next(ks), shape, jnp.float32)

    def unif(shape, lo, hi):
        return jax.random.uniform(next(ks), shape, jnp.float32, minval=lo, maxval=hi)

    x = nrm((BATCH, SEQ, D), 1.0)
    p = nrm((L, BATCH, SEQ, D_PLE), 1.0)
    ln_in_g = 1.0 + nrm((D,), 0.02)
    ln_in_b = nrm((D,), 0.02)
    rel_bias = nrm((REL_BUCKETS, DIFF_HEADS), 0.2)
    w_in = jnp.concatenate([
        nrm((L, D, 2 * DIFF_QK_WIDTH), sd),
        nrm((L, D, DIFF_WIDTH), sd * DEEPNORM_BETA),
        nrm((L, D, 2 * RWKV_WIDTH), sd),
        nrm((L, D, RWKV_WIDTH), sd * DEEPNORM_BETA),
        nrm((L, D, LORA_DECAY + LORA_AAA + LORA_GATE), sd),
    ], axis=-1)
    diff_lam_q1 = nrm((L, DIFF_HEAD_DIM), 0.1)
    diff_lam_k1 = nrm((L, DIFF_HEAD_DIM), 0.1)
    diff_lam_q2 = nrm((L, DIFF_HEAD_DIM), 0.1)
    diff_lam_k2 = nrm((L, DIFF_HEAD_DIM), 0.1)
    diff_subln_g = 1.0 + nrm((L, DIFF_V_DIM), 0.02)
    rwkv_mu = unif((L, RWKV_PROJ), 0.0, 1.0)
    rwkv_w0 = unif((L, RWKV_WIDTH), -6.0, 1.0)
    rwkv_w2 = nrm((L, LORA_DECAY, RWKV_WIDTH), 0.1)
    rwkv_a0 = nrm((L, RWKV_WIDTH), 0.1)
    rwkv_a2 = nrm((L, LORA_AAA, RWKV_WIDTH), 0.5 * LORA_AAA ** -0.5)
    rwkv_g2 = nrm((L, LORA_GATE, RWKV_WIDTH), LORA_GATE ** -0.5)
    rwkv_k_k = 0.85 + nrm((L, RWKV_WIDTH), 0.02)
    rwkv_k_a = 1.0 + nrm((L, RWKV_WIDTH), 0.02)
    rwkv_r_k = nrm((L, RWKV_HEADS, RWKV_HEAD_SIZE), 0.1)
    rwkv_lnx_g = 1.0 + nrm((L, RWKV_WIDTH), 0.02)
    rwkv_lnx_b = nrm((L, RWKV_WIDTH), 0.02)
    w_out = nrm((L, MIX_WIDTH, D), MIX_WIDTH ** -0.5 * DEEPNORM_BETA)
    ln1_g = 1.0 + nrm((L, D), 0.02)
    ln1_b = nrm((L, D), 0.02)
    router_group_w = nrm((L, D, N_GROUPS), sd)
    router_group_b = nrm((L, N_GROUPS), 0.01)
    router_expert_w = nrm((L, D, N_EXPERTS), sd)
    router_expert_b = nrm((L, N_EXPERTS), 0.01)
    moe_w_gate = nrm((L, N_GROUPS, EXPERTS_PER_GROUP, D, D_EXPERT), sd)
    moe_w_up = nrm((L, N_GROUPS, EXPERTS_PER_GROUP, D, D_EXPERT), sd)
    moe_w_down = nrm((L, N_GROUPS, EXPERTS_PER_GROUP, D_EXPERT, D), D_EXPERT ** -0.5 * DEEPNORM_BETA)
    ln2_g = 1.0 + nrm((L, D), 0.02)
    ln2_b = nrm((L, D), 0.02)
    ple_w = nrm((L, D_PLE, D), D_PLE ** -0.5)
    ple_norm_g = 1.0 + nrm((L, D), 0.02)
    ple_gate_w = nrm((L, D, D), sd)
    return {'x': x, 'p': p, 'ln_in_g': ln_in_g, 'ln_in_b': ln_in_b, 'rel_bias': rel_bias,
            'w_in': w_in, 'diff_lam_q1': diff_lam_q1, 'diff_lam_k1': diff_lam_k1,
            'diff_lam_q2': diff_lam_q2, 'diff_lam_k2': diff_lam_k2, 'diff_subln_g': diff_subln_g,
            'rwkv_mu': rwkv_mu, 'rwkv_w0': rwkv_w0, 'rwkv_w2': rwkv_w2, 'rwkv_a0': rwkv_a0,
            'rwkv_a2': rwkv_a2, 'rwkv_g2': rwkv_g2, 'rwkv_k_k': rwkv_k_k, 'rwkv_k_a': rwkv_k_a,
            'rwkv_r_k': rwkv_r_k, 'rwkv_lnx_g': rwkv_lnx_g, 'rwkv_lnx_b': rwkv_lnx_b,
            'w_out': w_out, 'ln1_g': ln1_g, 'ln1_b': ln1_b,
            'router_group_w': router_group_w, 'router_group_b': router_group_b,
            'router_expert_w': router_expert_w, 'router_expert_b': router_expert_b,
            'moe_w_gate': moe_w_gate, 'moe_w_up': moe_w_up, 'moe_w_down': moe_w_down,
            'ln2_g': ln2_g, 'ln2_b': ln2_b, 'ple_w': ple_w, 'ple_norm_g': ple_norm_g,
            'ple_gate_w': ple_gate_w}


def reference(x, p, ln_in_g, ln_in_b, rel_bias, w_in, diff_lam_q1, diff_lam_k1, diff_lam_q2,
              diff_lam_k2, diff_subln_g, rwkv_mu, rwkv_w0, rwkv_w2, rwkv_a0, rwkv_a2, rwkv_g2,
              rwkv_k_k, rwkv_k_a, rwkv_r_k, rwkv_lnx_g, rwkv_lnx_b, w_out, ln1_g, ln1_b,
              router_group_w, router_group_b, router_expert_w, router_expert_b,
              moe_w_gate, moe_w_up, moe_w_down, ln2_g, ln2_b, ple_w, ple_norm_g, ple_gate_w):
    B, S = x.shape[0], x.shape[1]
    h = layer_norm(x, ln_in_g, ln_in_b)
    for i in range(DEPTH):
        proj = h @ w_in[i]
        q = proj[..., :DIFF_QK_WIDTH].reshape(B, S, DIFF_HEADS, 2, DIFF_HEAD_DIM)
        k = proj[..., DIFF_QK_WIDTH:2 * DIFF_QK_WIDTH].reshape(B, S, DIFF_HEADS, 2, DIFF_HEAD_DIM)
        v = proj[..., 2 * DIFF_QK_WIDTH:O_RWKV].reshape(B, S, DIFF_HEADS, DIFF_V_DIM)
        lambda_init = 0.8 - 0.6 * math.exp(-0.3 * i)
        lam = (jnp.exp(jnp.sum(diff_lam_q1[i].astype(jnp.float32) * diff_lam_k1[i]))
               - jnp.exp(jnp.sum(diff_lam_q2[i].astype(jnp.float32) * diff_lam_k2[i]))
               + lambda_init)
        y_diff = diff_attention(q, k, v, rel_bias, lam, diff_subln_g[i], lambda_init)
        y_rwkv = rwkv7_time_mix(proj[..., O_RWKV:], rwkv_mu[i], rwkv_w0[i], rwkv_w2[i], rwkv_a0[i],
                                rwkv_a2[i], rwkv_g2[i], rwkv_k_k[i], rwkv_k_a[i], rwkv_r_k[i],
                                rwkv_lnx_g[i], rwkv_lnx_b[i])
        mix = jnp.concatenate([y_diff, y_rwkv], axis=-1) @ w_out[i]
        h = layer_norm(DEEPNORM_ALPHA * h + mix, ln1_g[i], ln1_b[i])
        ffn = hier_moe(h, router_group_w[i], router_group_b[i], router_expert_w[i], router_expert_b[i],
                       moe_w_gate[i], moe_w_up[i], moe_w_down[i])
        h = layer_norm(DEEPNORM_ALPHA * h + ffn, ln2_g[i], ln2_b[i])
        ple = rms_norm(p[i] @ ple_w[i], ple_norm_g[i]).astype(h.dtype)
        h = h + jax.nn.sigmoid(h @ ple_gate_w[i]) * ple
    return h
```

```cpp
#include <hip/hip_runtime.h>
#include <cstdio>
#include <cstdint>
#include <cmath>

constexpr int NB = 4, S = 2048, D = 2048, T = NB * S;
constexpr int NPROJ = 6432;
constexpr int RWK = 1024;
constexpr int COL_Q = 0, COL_K = 1024, COL_V = 2048, COL_RW = 3072;
constexpr int NH = 8, NRH = 16;
constexpr int NE = 32;
constexpr float LN_EPS = 1e-5f;
constexpr float ALPHA = 1.189207115002721f;
constexpr float LAMBDA_INIT = 0.2f;

constexpr size_t MiB = 1u << 20;
constexpr size_t WS_CNT = 0;
constexpr size_t WS_LAM = 256;
constexpr size_t WS_BIAS = 1024;
constexpr size_t WS_LTOK = 1 * MiB;
constexpr size_t WS_LPAIR = 2 * MiB;
constexpr size_t WS_PAIRW = 3 * MiB;
constexpr size_t WS_PROJ = 4 * MiB;
constexpr size_t WS_PREP = 206 * MiB;
constexpr size_t WS_Y = 366 * MiB;
constexpr size_t WS_END = 430 * MiB;

__device__ __forceinline__ float wave_sum(float v) {
#pragma unroll
    for (int o = 1; o < 64; o <<= 1) v += __shfl_xor(v, o);
    return v;
}
__device__ __forceinline__ float wave_max(float v) {
#pragma unroll
    for (int o = 1; o < 64; o <<= 1) v = fmaxf(v, __shfl_xor(v, o));
    return v;
}
__device__ __forceinline__ float sigmoidf_(float x) { return 1.f / (1.f + expf(-x)); }

__global__ void init_kernel(const float* rel_bias, const float* lq1, const float* lk1, const float* lq2, const float* lk2, float* lam, float* biasT) {
    int t = threadIdx.x;
    if (t < 64) {
        float a = wave_sum(lq1[t] * lk1[t]);
        float b = wave_sum(lq2[t] * lk2[t]);
        if (t == 0) *lam = expf(a) - expf(b) + LAMBDA_INIT;
    }
    for (int i = t; i < 8 * 129; i += blockDim.x) {
        int h = i / 129, n = i % 129;
        int bucket;
        if (n < 16) bucket = n;
        else { float nf = (float)n; int large = 16 + (int)(logf(nf / 16.f) / 2.0794415416798357f * 16.f); bucket = large < 31 ? large : 31; }
        biasT[i] = rel_bias[bucket * 8 + h];
    }
}

__global__ __launch_bounds__(256) void ln_kernel(const float* xin, const float* add, const float* ffn, const float* pairw, const float* g, const float* bb, float* out, int mode) {
    int row = blockIdx.x * 4 + (threadIdx.x >> 6), lane = threadIdx.x & 63;
    const float4* xr = (const float4*)(xin + (size_t)row * D);
    float4 v[8];
#pragma unroll
    for (int j = 0; j < 8; ++j) v[j] = xr[j * 64 + lane];
    if (mode == 1) {
        const float4* ar = (const float4*)(add + (size_t)row * D);
#pragma unroll
        for (int j = 0; j < 8; ++j) { float4 a = ar[j * 64 + lane]; v[j].x = ALPHA * v[j].x + a.x; v[j].y = ALPHA * v[j].y + a.y; v[j].z = ALPHA * v[j].z + a.z; v[j].w = ALPHA * v[j].w + a.w; }
    } else if (mode == 2) {
        const float4* f0 = (const float4*)(ffn + (size_t)(2 * row) * D);
        const float4* f1 = (const float4*)(ffn + (size_t)(2 * row + 1) * D);
        float w0 = pairw[2 * row], w1 = pairw[2 * row + 1];
#pragma unroll
        for (int j = 0; j < 8; ++j) { float4 a = f0[j * 64 + lane], c = f1[j * 64 + lane];
            v[j].x = ALPHA * v[j].x + w0 * a.x + w1 * c.x; v[j].y = ALPHA * v[j].y + w0 * a.y + w1 * c.y; v[j].z = ALPHA * v[j].z + w0 * a.z + w1 * c.z; v[j].w = ALPHA * v[j].w + w0 * a.w + w1 * c.w; }
    }
    float s = 0.f;
#pragma unroll
    for (int j = 0; j < 8; ++j) s += (v[j].x + v[j].y) + (v[j].z + v[j].w);
    float mean = wave_sum(s) * (1.f / D);
    float q = 0.f;
#pragma unroll
    for (int j = 0; j < 8; ++j) { v[j].x -= mean; v[j].y -= mean; v[j].z -= mean; v[j].w -= mean; q += (v[j].x * v[j].x + v[j].y * v[j].y) + (v[j].z * v[j].z + v[j].w * v[j].w); }
    float rstd = 1.0f / sqrtf(wave_sum(q) * (1.f / D) + LN_EPS);
    float4* orow = (float4*)(out + (size_t)row * D);
    const float4* g4 = (const float4*)g; const float4* b4 = (const float4*)bb;
#pragma unroll
    for (int j = 0; j < 8; ++j) { float4 gg = g4[j * 64 + lane], bv = b4[j * 64 + lane]; float4 o;
        o.x = v[j].x * rstd * gg.x + bv.x; o.y = v[j].y * rstd * gg.y + bv.y; o.z = v[j].z * rstd * gg.z + bv.z; o.w = v[j].w * rstd * gg.w + bv.w; orow[j * 64 + lane] = o; }
}

struct GemmP {
    const float* A; const float* B; float* C; const int* cnt; const int* listA; const int* listC;
    long strideB; int lda, ldb, ldc, M, N, K, listStride;
};
__global__ __launch_bounds__(256) void gemm_f32(GemmP p) {
    const int z = blockIdx.z;
    const int M = p.cnt ? p.cnt[z] : p.M;
    const int m0 = blockIdx.y * 128; if (m0 >= M) return;
    const int n0 = blockIdx.x * 128;
    const float* B = p.B + (long)z * p.strideB;
    const int* la = p.listA ? p.listA + (long)z * p.listStride : nullptr;
    const int* lc = p.listC ? p.listC + (long)z * p.listStride : nullptr;
    __shared__ float As[8][132];
    __shared__ float Bs[8][128];
    const int t = threadIdx.x;
    const int arow = m0 + (t >> 1); const bool aval = arow < M; const int asrc = aval ? (la ? la[arow] : arow) : 0;
    const float* Ap = p.A + (long)asrc * p.lda + (t & 1) * 4;
    const int bn = n0 + (t & 31) * 4; const bool bval = bn < p.N;
    const float* Bp = B + (long)(t >> 5) * p.ldb + bn;
    float acc[8][8];
#pragma unroll
    for (int i = 0; i < 8; ++i)
#pragma unroll
        for (int j = 0; j < 8; ++j) acc[i][j] = 0.f;
    const int ty = t >> 4, tx = t & 15;
    for (int k0 = 0; k0 < p.K; k0 += 8) {
        float4 av = aval ? *(const float4*)(Ap + k0) : make_float4(0.f, 0.f, 0.f, 0.f);
        float4 bv = bval ? *(const float4*)(Bp + (long)k0 * p.ldb) : make_float4(0.f, 0.f, 0.f, 0.f);
        __syncthreads();
        As[(t & 1) * 4 + 0][t >> 1] = av.x; As[(t & 1) * 4 + 1][t >> 1] = av.y; As[(t & 1) * 4 + 2][t >> 1] = av.z; As[(t & 1) * 4 + 3][t >> 1] = av.w;
        *(float4*)&Bs[t >> 5][(t & 31) * 4] = bv;
        __syncthreads();
#pragma unroll
        for (int kk = 0; kk < 8; ++kk) {
            float a[8], b[8];
            *(float4*)&a[0] = *(const float4*)&As[kk][ty * 8]; *(float4*)&a[4] = *(const float4*)&As[kk][ty * 8 + 4];
            *(float4*)&b[0] = *(const float4*)&Bs[kk][tx * 8]; *(float4*)&b[4] = *(const float4*)&Bs[kk][tx * 8 + 4];
#pragma unroll
            for (int i = 0; i < 8; ++i)
#pragma unroll
                for (int j = 0; j < 8; ++j) acc[i][j] = fmaf(a[i], b[j], acc[i][j]);
        }
    }
#pragma unroll
    for (int i = 0; i < 8; ++i) {
        const int row = m0 + ty * 8 + i; if (row >= M) continue;
        const int crow = lc ? lc[row] : row;
        float* cp = p.C + (long)crow * p.ldc + n0 + tx * 8;
        if (n0 + tx * 8 < p.N) { *(float4*)cp = make_float4(acc[i][0], acc[i][1], acc[i][2], acc[i][3]); }
        if (n0 + tx * 8 + 4 < p.N) { *(float4*)(cp + 4) = make_float4(acc[i][4], acc[i][5], acc[i][6], acc[i][7]); }
    }
}

__global__ __launch_bounds__(128) void attn_naive(const float* proj, const float* biasT, const float* lamp, const float* subln_g, float* y) {
    __shared__ float lg[2][2][2048];
    __shared__ float qs[2][128];
    const int w = threadIdx.x >> 6, lane = threadIdx.x & 63;
    const int item = blockIdx.x * 2 + w;
    const int h = item & 7, tok = item >> 3, q = tok & (S - 1), b = tok >> 11;
    const float lam = *lamp;
    const float* prow = proj + (size_t)tok * NPROJ;
    qs[w][lane] = prow[COL_Q + h * 128 + lane]; qs[w][64 + lane] = prow[COL_Q + h * 128 + 64 + lane];
    __syncthreads();
    const float* kbase = proj + (size_t)(b * S) * NPROJ + COL_K + h * 128;
    float m1 = -3.0e38f, m2 = -3.0e38f;
    for (int k = lane; k <= q; k += 64) {
        const float4* kr = (const float4*)(kbase + (size_t)k * NPROJ);
        float s1 = 0.f, s2 = 0.f;
#pragma unroll
        for (int d4 = 0; d4 < 16; ++d4) { float4 kv = kr[d4]; s1 += kv.x * qs[w][d4 * 4] + kv.y * qs[w][d4 * 4 + 1] + kv.z * qs[w][d4 * 4 + 2] + kv.w * qs[w][d4 * 4 + 3]; }
#pragma unroll
        for (int d4 = 0; d4 < 16; ++d4) { float4 kv = kr[16 + d4]; s2 += kv.x * qs[w][64 + d4 * 4] + kv.y * qs[w][64 + d4 * 4 + 1] + kv.z * qs[w][64 + d4 * 4 + 2] + kv.w * qs[w][64 + d4 * 4 + 3]; }
        int n = q - k; if (n > 128) n = 128;
        const float bias = biasT[h * 129 + n];
        s1 = s1 * 0.125f + bias; s2 = s2 * 0.125f + bias;
        lg[w][0][k] = s1; lg[w][1][k] = s2; m1 = fmaxf(m1, s1); m2 = fmaxf(m2, s2);
    }
    m1 = wave_max(m1); m2 = wave_max(m2);
    float l1 = 0.f, l2 = 0.f;
    for (int k = lane; k <= q; k += 64) { float p1 = expf(lg[w][0][k] - m1), p2 = expf(lg[w][1][k] - m2); lg[w][0][k] = p1; lg[w][1][k] = p2; l1 += p1; l2 += p2; }
    l1 = wave_sum(l1); l2 = wave_sum(l2);
    const float i1 = 1.f / l1, i2 = lam / l2;
    for (int k = lane; k <= q; k += 64) lg[w][0][k] = lg[w][0][k] * i1 - lg[w][1][k] * i2;
    __syncthreads();
    const float* vbase = proj + (size_t)(b * S) * NPROJ + COL_V + h * 128;
    float o0 = 0.f, o1 = 0.f;
    for (int k = 0; k <= q; ++k) { const float a = lg[w][0][k]; const float* vr = vbase + (size_t)k * NPROJ; o0 = fmaf(a, vr[lane], o0); o1 = fmaf(a, vr[64 + lane], o1); }
    const float ss = wave_sum(o0 * o0 + o1 * o1) * (1.f / 128.f);
    const float r = 1.0f / sqrtf(ss + LN_EPS) * (1.f - LAMBDA_INIT);
    float* yr = y + (size_t)tok * D + h * 128;
    yr[lane] = o0 * r * subln_g[lane]; yr[64 + lane] = o1 * r * subln_g[64 + lane];
}

__global__ __launch_bounds__(256) void rwkv_prep(const float* proj, const float* mu, const float* w0, const float* w2, const float* a0, const float* a2, const float* g2,
                                                  const float* k_k, const float* k_a, float* decay, float* kmod, float* Aout, float* Bout, float* gout) {
    __shared__ float sx[288];
    __shared__ float skk[1024];
    const int tok = blockIdx.x, pos = tok & (S - 1), t = threadIdx.x;
    const float* cur = proj + (size_t)tok * NPROJ + COL_RW;
    const float* prev = cur - NPROJ;
    for (int i = t; i < 288; i += 256) {
        const int c = 3072 + i; const float cv = cur[c], pv = pos > 0 ? prev[c] : 0.f; const float xs = cv + (pv - cv) * mu[c];
        float f; if (i < 64) f = tanhf(xs); else if (i < 128) f = xs; else f = sigmoidf_(xs);
        sx[i] = f;
    }
    float k0[4];
#pragma unroll
    for (int j = 0; j < 4; ++j) { const int c = t + 256 * j; const float cv = cur[1024 + c], pv = pos > 0 ? prev[1024 + c] : 0.f; k0[j] = cv + (pv - cv) * mu[1024 + c]; skk[c] = k0[j] * k_k[c]; }
    __syncthreads();
#pragma unroll
    for (int j = 0; j < 4; ++j) {
        const int c = t + 256 * j;
        float wp = w0[c], ap = a0[c], gp = 0.f;
        for (int i = 0; i < 64; ++i) { wp = fmaf(sx[i], w2[i * 1024 + c], wp); ap = fmaf(sx[64 + i], a2[i * 1024 + c], ap); }
        for (int i = 0; i < 160; ++i) gp = fmaf(sx[128 + i], g2[i * 1024 + c], gp);
        const float z = -wp; const float sp = z > 20.f ? z : log1pf(expf(z));
        const float w = -sp - 0.5f; const float dec = expf(-expf(w));
        const float asig = sigmoidf_(ap);
        const int hb = c & ~63; float nn = 0.f;
        for (int i = 0; i < 64; ++i) nn = fmaf(skk[hb + i], skk[hb + i], nn);
        const float kk = skk[c] / fmaxf(sqrtf(nn), 1e-12f);
        const size_t o = (size_t)tok * RWK + c;
        decay[o] = dec; kmod[o] = k0[j] * (1.f + (asig - 1.f) * k_a[c]); Aout[o] = -kk; Bout[o] = kk * asig; gout[o] = gp;
    }
}

__global__ __launch_bounds__(64) void rwkv_scan(const float* proj, const float* mu, const float* decay, const float* kmod, const float* Ain, const float* Bin, const float* gin,
                                                 const float* r_k, const float* lnx_g, const float* lnx_b, float* y) {
    constexpr int CH = 16;
    __shared__ float sv[CH][5][64];
    __shared__ float svv[CH][64];
    const int bh = blockIdx.x, b = bh >> 4, h = bh & 15, lane = threadIdx.x;
    float st[64];
#pragma unroll
    for (int j = 0; j < 64; ++j) st[j] = 0.f;
    const int c = h * 64 + lane;
    const float mur = mu[c], muv = mu[2048 + c], rk = r_k[c], lg = lnx_g[c], lb = lnx_b[c];
    for (int t0 = 0; t0 < S; t0 += CH) {
        __syncthreads();
#pragma unroll 4
        for (int s = 0; s < CH; ++s) {
            const int pos = t0 + s; const size_t tok = (size_t)b * S + pos;
            const float* cur = proj + tok * NPROJ + COL_RW; const float* prev = cur - NPROJ;
            const float rc = cur[c], rp = pos > 0 ? prev[c] : 0.f;
            const float vc = cur[2048 + c], vp = pos > 0 ? prev[2048 + c] : 0.f;
            sv[s][0][lane] = rc + (rp - rc) * mur;
            svv[s][lane] = vc + (vp - vc) * muv;
            const size_t o = tok * RWK + c;
            sv[s][1][lane] = decay[o]; sv[s][2][lane] = kmod[o]; sv[s][3][lane] = Ain[o]; sv[s][4][lane] = Bin[o];
        }
        __syncthreads();
        for (int s = 0; s < CH; ++s) {
            const float vi = svv[s][lane];
            float sa = 0.f;
#pragma unroll
            for (int j = 0; j < 64; ++j) sa = fmaf(st[j], sv[s][3][j], sa);
            float yv = 0.f;
#pragma unroll
            for (int j = 0; j < 64; ++j) { st[j] = st[j] * sv[s][1][j] + sa * sv[s][4][j] + vi * sv[s][2][j]; yv = fmaf(st[j], sv[s][0][j], yv); }
            const float mean = wave_sum(yv) * (1.f / 64.f);
            const float dv = yv - mean;
            const float var = wave_sum(dv * dv) * (1.f / 64.f);
            const float yn = dv * (1.0f / sqrtf(var + 64e-5f)) * lg + lb;
            const float bs = wave_sum(sv[s][0][lane] * sv[s][2][lane] * rk);
            const size_t tok = (size_t)b * S + t0 + s;
            y[tok * D + 1024 + c] = (yn + bs * vi) * gin[tok * RWK + c];
        }
    }
}

__global__ __launch_bounds__(256) void router_kernel(const float* h, const float* gw, const float* gb, const float* ew, const float* eb, int* cnt, int* ltok, int* lpair, float* pairw) {
    const int tok = blockIdx.x * 4 + (threadIdx.x >> 6), lane = threadIdx.x & 63;
    const float4* hr = (const float4*)(h + (size_t)tok * D);
    float acc[36];
#pragma unroll
    for (int e = 0; e < 36; ++e) acc[e] = 0.f;
    for (int j = 0; j < 8; ++j) {
        const float4 hv = hr[j * 64 + lane]; const float hx[4] = {hv.x, hv.y, hv.z, hv.w};
#pragma unroll
        for (int c = 0; c < 4; ++c) {
            const int d = j * 256 + lane * 4 + c;
            const float4 g4 = *(const float4*)(gw + (size_t)d * 4);
            acc[0] = fmaf(hx[c], g4.x, acc[0]); acc[1] = fmaf(hx[c], g4.y, acc[1]); acc[2] = fmaf(hx[c], g4.z, acc[2]); acc[3] = fmaf(hx[c], g4.w, acc[3]);
            const float4* e4 = (const float4*)(ew + (size_t)d * 32);
#pragma unroll
            for (int q = 0; q < 8; ++q) { const float4 w = e4[q]; acc[4 + q * 4] = fmaf(hx[c], w.x, acc[4 + q * 4]); acc[5 + q * 4] = fmaf(hx[c], w.y, acc[5 + q * 4]); acc[6 + q * 4] = fmaf(hx[c], w.z, acc[6 + q * 4]); acc[7 + q * 4] = fmaf(hx[c], w.w, acc[7 + q * 4]); }
        }
    }
#pragma unroll
    for (int e = 0; e < 36; ++e) acc[e] = wave_sum(acc[e]);
    if (lane == 0) {
        float gl[4]; float gm = -3.0e38f; int gi = 0;
#pragma unroll
        for (int i = 0; i < 4; ++i) { gl[i] = acc[i] + gb[i]; if (gl[i] > gm) { gm = gl[i]; gi = i; } }
        float gs = 0.f;
#pragma unroll
        for (int i = 0; i < 4; ++i) gs += expf(gl[i] - gm);
        const float gtop = 1.f / gs;
        float el[8]; float em = -3.0e38f; int e0 = 0;
#pragma unroll
        for (int i = 0; i < 8; ++i) { float v = 0.f;
#pragma unroll
            for (int g = 0; g < 4; ++g) if (g == gi) v = acc[4 + g * 8 + i] + eb[g * 8 + i];
            el[i] = v; if (v > em) { em = v; e0 = i; } }
        float em2 = -3.0e38f; int e1 = 0;
#pragma unroll
        for (int i = 0; i < 8; ++i) if (i != e0 && el[i] > em2) { em2 = el[i]; e1 = i; }
        const float x1 = expf(em2 - em);
        const float w0 = 1.f / (1.f + x1), w1 = x1 / (1.f + x1);
        const int ea = gi * 8 + e0, ebb = gi * 8 + e1;
        int p0 = atomicAdd(&cnt[ea], 1); ltok[ea * 8192 + p0] = tok; lpair[ea * 8192 + p0] = tok * 2;
        int p1 = atomicAdd(&cnt[ebb], 1); ltok[ebb * 8192 + p1] = tok; lpair[ebb * 8192 + p1] = tok * 2 + 1;
        pairw[tok * 2] = w0 * gtop; pairw[tok * 2 + 1] = w1 * gtop;
    }
}

__global__ void silu_mul(const float* G, const float* U, float* H, int n) {
    int i = blockIdx.x * blockDim.x + threadIdx.x; if (i >= n) return;
    float g = G[i]; H[i] = g / (1.f + expf(-g)) * U[i];
}

__global__ __launch_bounds__(256) void final_kernel(float* hio, const float* gate, const float* pw, const float* pg) {
    int row = blockIdx.x * 4 + (threadIdx.x >> 6), lane = threadIdx.x & 63;
    const float4* pr = (const float4*)(pw + (size_t)row * D);
    float4 v[8]; float q = 0.f;
#pragma unroll
    for (int j = 0; j < 8; ++j) { v[j] = pr[j * 64 + lane]; q += (v[j].x * v[j].x + v[j].y * v[j].y) + (v[j].z * v[j].z + v[j].w * v[j].w); }
    const float r = 1.0f / sqrtf(wave_sum(q) * (1.f / D) + LN_EPS);
    float4* hr = (float4*)(hio + (size_t)row * D); const float4* gr = (const float4*)(gate + (size_t)row * D); const float4* g4 = (const float4*)pg;
#pragma unroll
    for (int j = 0; j < 8; ++j) { float4 hv = hr[j * 64 + lane], gv = gr[j * 64 + lane], gg = g4[j * 64 + lane]; float4 o;
        o.x = hv.x + sigmoidf_(gv.x) * v[j].x * r * gg.x; o.y = hv.y + sigmoidf_(gv.y) * v[j].y * r * gg.y; o.z = hv.z + sigmoidf_(gv.z) * v[j].z * r * gg.z; o.w = hv.w + sigmoidf_(gv.w) * v[j].w * r * gg.w;
        hr[j * 64 + lane] = o; }
}

static void launch_gemm(hipStream_t st, const float* A, int lda, const float* B, int ldb, long strideB, float* C, int ldc, int M, int N, int K,
                        const int* cnt, const int* listA, const int* listC, int nz) {
    GemmP p{}; p.A = A; p.B = B; p.C = C; p.cnt = cnt; p.listA = listA; p.listC = listC; p.strideB = strideB; p.lda = lda; p.ldb = ldb; p.ldc = ldc; p.M = M; p.N = N; p.K = K; p.listStride = 8192;
    dim3 grid((N + 127) / 128, (M + 127) / 128, nz);
    hipLaunchKernelGGL(gemm_f32, grid, dim3(256), 0, st, p);
}

extern "C" void kernel_launch(void* const* d_in, const int* in_sizes, int n_in, void* d_out, int out_size, void* d_ws, size_t ws_size, hipStream_t stream) {
    if (ws_size < WS_END) { fprintf(stderr, "kernel_launch: ws too small: %zu < %zu\n", ws_size, (size_t)WS_END); return; }
    fprintf(stderr, "kernel_launch: ws_size = %zu MiB\n", ws_size >> 20);
    const float* const* in = (const float* const*)d_in;
    const float *x = in[0], *p = in[1], *ln_in_g = in[2], *ln_in_b = in[3], *rel_bias = in[4], *w_in = in[5];
    const float *lq1 = in[6], *lk1 = in[7], *lq2 = in[8], *lk2 = in[9], *subln_g = in[10];
    const float *mu = in[11], *w0 = in[12], *w2 = in[13], *a0 = in[14], *a2 = in[15], *g2 = in[16], *k_k = in[17], *k_a = in[18], *r_k = in[19], *lnx_g = in[20], *lnx_b = in[21];
    const float *w_out = in[22], *ln1_g = in[23], *ln1_b = in[24], *rgw = in[25], *rgb = in[26], *rew = in[27], *reb = in[28];
    const float *wg = in[29], *wu = in[30], *wd = in[31], *ln2_g = in[32], *ln2_b = in[33], *ple_w = in[34], *ple_g = in[35], *ple_gate = in[36];
    char* ws = (char*)d_ws;
    int* cnt = (int*)(ws + WS_CNT); float* lam = (float*)(ws + WS_LAM); float* biasT = (float*)(ws + WS_BIAS);
    int* ltok = (int*)(ws + WS_LTOK); int* lpair = (int*)(ws + WS_LPAIR); float* pairw = (float*)(ws + WS_PAIRW);
    float* proj = (float*)(ws + WS_PROJ); float* ffn = proj;
    float* prep = (float*)(ws + WS_PREP);
    float *decay = prep, *kmod = prep + (size_t)T * RWK, *Ab = prep + 2 * (size_t)T * RWK, *Bb = prep + 3 * (size_t)T * RWK, *gb = prep + 4 * (size_t)T * RWK;
    float* mix = prep; float* hidG = prep + (size_t)T * D; float* hidU = hidG + (size_t)16384 * 512; float* hid = hidU + (size_t)16384 * 512; float* pw = prep;
    float* y = (float*)(ws + WS_Y); float* gate = y;
    float* h = (float*)d_out;

    hipMemsetAsync(cnt, 0, 256, stream);
    hipLaunchKernelGGL(init_kernel, dim3(1), dim3(256), 0, stream, rel_bias, lq1, lk1, lq2, lk2, lam, biasT);
    hipLaunchKernelGGL(ln_kernel, dim3(T / 4), dim3(256), 0, stream, x, (const float*)nullptr, (const float*)nullptr, (const float*)nullptr, ln_in_g, ln_in_b, h, 0);
    launch_gemm(stream, h, D, w_in, NPROJ, 0, proj, NPROJ, T, NPROJ, D, nullptr, nullptr, nullptr, 1);
    hipLaunchKernelGGL(attn_naive, dim3(T * NH / 2), dim3(128), 0, stream, (const float*)proj, (const float*)biasT, (const float*)lam, subln_g, y);
    hipLaunchKernelGGL(rwkv_prep, dim3(T), dim3(256), 0, stream, (const float*)proj, mu, w0, w2, a0, a2, g2, k_k, k_a, decay, kmod, Ab, Bb, gb);
    hipLaunchKernelGGL(rwkv_scan, dim3(NB * NRH), dim3(64), 0, stream, (const float*)proj, mu, (const float*)decay, (const float*)kmod, (const float*)Ab, (const float*)Bb, (const float*)gb, r_k, lnx_g, lnx_b, y);
    launch_gemm(stream, y, D, w_out, D, 0, mix, D, T, D, D, nullptr, nullptr, nullptr, 1);
    hipLaunchKernelGGL(ln_kernel, dim3(T / 4), dim3(256), 0, stream, (const float*)h, (const float*)mix, (const float*)nullptr, (const float*)nullptr, ln1_g, ln1_b, h, 1);
    hipLaunchKernelGGL(router_kernel, dim3(T / 4), dim3(256), 0, stream, (const float*)h, rgw, rgb, rew, reb, cnt, ltok, lpair, pairw);
    launch_gemm(stream, h, D, wg, 512, (long)2048 * 512, hidG, 512, 8192, 512, D, cnt, ltok, lpair, NE);
    launch_gemm(stream, h, D, wu, 512, (long)2048 * 512, hidU, 512, 8192, 512, D, cnt, ltok, lpair, NE);
    hipLaunchKernelGGL(silu_mul, dim3(16384 * 512 / 256), dim3(256), 0, stream, (const float*)hidG, (const float*)hidU, hid, 16384 * 512);
    launch_gemm(stream, hid, 512, wd, D, (long)512 * 2048, ffn, D, 8192, D, 512, cnt, lpair, lpair, NE);
    hipLaunchKernelGGL(ln_kernel, dim3(T / 4), dim3(256), 0, stream, (const float*)h, (const float*)nullptr, (const float*)ffn, (const float*)pairw, ln2_g, ln2_b, h, 2);
    launch_gemm(stream, p, 256, ple_w, D, 0, pw, D, T, D, 256, nullptr, nullptr, nullptr, 1);
    launch_gemm(stream, h, D, ple_gate, D, 0, gate, D, T, D, D, nullptr, nullptr, nullptr, 1);
    hipLaunchKernelGGL(final_kernel, dim3(T / 4), dim3(256), 0, stream, h, (const float*)gate, (const float*)pw, ple_g);
}
```

```cpp
#include <hip/hip_runtime.h>
#include <cstdio>
#include <cstdint>
#include <cmath>

constexpr int NB = 4, S = 2048, D = 2048, T = NB * S;
constexpr int NPROJ = 6432;
constexpr int RWK = 1024;
constexpr int COL_Q = 0, COL_K = 1024, COL_V = 2048, COL_RW = 3072;
constexpr int NH = 8, NRH = 16;
constexpr int NE = 32;
constexpr float LN_EPS = 1e-5f;
constexpr float ALPHA = 1.189207115002721f;
constexpr float LAMBDA_INIT = 0.2f;

constexpr size_t MiB = 1u << 20;
constexpr size_t WS_CNT = 0;
constexpr size_t WS_LTOK = 1 * MiB;
constexpr size_t WS_LPAIR = 2 * MiB;
constexpr size_t WS_PAIRW = 3 * MiB;
constexpr size_t WS_RT = 3 * MiB + 128 * 1024;
constexpr size_t WS_LAM = 3 * MiB + 512 * 1024;
constexpr size_t WS_BIAS = 3 * MiB + 512 * 1024 + 1024;
constexpr size_t WS_ROWRS = 3 * MiB + 768 * 1024;
constexpr size_t WS_WINT = 4 * MiB;
constexpr size_t WS_WOUTT = 30 * MiB;
constexpr size_t WS_GATET = 38 * MiB;
constexpr size_t WS_PLET = 46 * MiB;
constexpr size_t WS_P16 = 47 * MiB;
constexpr size_t WS_GUT = 52 * MiB;
constexpr size_t WS_DNT = 180 * MiB;
constexpr size_t WS_PROJ16 = 244 * MiB;
constexpr size_t WS_FFN16 = 244 * MiB;
constexpr size_t WS_HID = 308 * MiB;
constexpr size_t WS_DECAY = 348 * MiB;
constexpr size_t WS_KMOD = 380 * MiB;
constexpr size_t WS_A16 = 396 * MiB;
constexpr size_t WS_B16 = 412 * MiB;
constexpr size_t WS_G16 = 428 * MiB;
constexpr size_t WS_H16 = 444 * MiB;
constexpr size_t WS_H1_16 = WS_H16;
constexpr size_t WS_Y16 = 476 * MiB;
constexpr size_t WS_PW16 = 508 * MiB;
constexpr size_t WS_END2 = 540 * MiB;

namespace pg8 {
#define PG8_LAS __attribute__((address_space(3)))
typedef unsigned short f16_t;
typedef _Float16 f16x8 __attribute__((ext_vector_type(8)));
typedef float f32x4 __attribute__((ext_vector_type(4)));
typedef unsigned u32x4 __attribute__((ext_vector_type(4)));
constexpr int BM = 256, BK = 64, HALF = 128, HTB = HALF * BK * 2  , STAGE_BYTES = 8 * HTB, NXCD = 8, WGM = 8;

__host__ __device__ __forceinline__ int lds_byte(int r, int c) { const int st = (r >> 4) * 2 + (c >> 5), rr = r & 15, cc = c & 31, ob = rr * 64 + cc * 2; return st * 1024 + (ob ^ (((ob >> 9) & 1) << 5)); }
__host__ __device__ __forceinline__ void stage_rc(int b, int& R, int& C) { const int st = b / 1024, sb = b % 1024, swz = sb ^ (((sb >> 9) & 1) << 5); R = (st >> 1) * 16 + swz / 64; C = (st & 1) * 32 + (swz % 64) / 2; }
__host__ __device__ __forceinline__ int perm32(int rho) { const int n = rho >> 4, i = rho & 15; return 8 * (i >> 2) + 4 * n + (i & 3); }

__device__ __forceinline__ int lane_id() { int l; asm volatile("v_mbcnt_lo_u32_b32 %0, -1, 0\n\tv_mbcnt_hi_u32_b32 %0, -1, %0" : "=v"(l)); return l; }
struct Unit { int pm, pn, e, rb, cnt; };
struct Gemm { const f16_t* A; const f16_t* Bt; int M, N, K; };

struct StaticOrder {
    int nM, nN, nwg, G, c;
    __host__ __device__ void init(int M, int N, int G_, int c_) { nM = M / BM; nN = N / BM; nwg = nM * nN; G = G_; c = c_; }
    __host__ __device__ bool next(int i, Unit& u) const {
        const long L = (long)i * G + c; if (L >= nwg) return false;
        int wgid = (int)L; { const int q = nwg / NXCD, r = nwg % NXCD, xcd = wgid % NXCD, off = wgid / NXCD; wgid = (xcd < r ? xcd * (q + 1) : r * (q + 1) + (xcd - r) * q) + off; }
        const int nig = WGM * nN, gid = wgid / nig, fm = gid * WGM, gsz = (nM - fm) < WGM ? (nM - fm) : WGM;
        u.pm = fm + ((wgid % nig) % gsz); u.pn = (wgid % nig) / gsz; return true;
    }
    __device__ __forceinline__ void a_ready(const Unit&) const {}
    __device__ __forceinline__ void done(const Unit&) const {}
    __device__ __forceinline__ const char* a_base(const Gemm& g, const Unit& u) const { return (const char*)g.A + (size_t)u.pm * ((size_t)BM * g.K * 2); }
    __device__ __forceinline__ const char* b_base(const Gemm& g, const Unit& u) const { return (const char*)g.Bt + (size_t)u.pn * ((size_t)BM * g.K * 2); }
    __device__ __forceinline__ void a_voff(const Gemm& g, const Unit&, int tid, unsigned (&va)[2][2]) const {
#pragma unroll
        for (int i = 0; i < 2; ++i) { int R, C; stage_rc(tid * 16 + i * 8192, R, C); va[0][i] = (unsigned)(R * g.K + C) * 2u; va[1][i] = va[0][i] + (unsigned)(HALF * g.K * 2); }
    }
};
template <bool GATHER> struct MoeOrder {
    const PG8_LAS int* tab; const int* list; int vcu, G, ntn; size_t estride;
    __device__ __forceinline__ bool next(int i, Unit& u) const {
        const int L = vcu + i * G; const int tot = tab[64] * ntn; if (L >= tot) return false;
        int e = 0; while (tab[33 + e] * ntn <= L) ++e;
        const int nb = tab[33 + e] - tab[32 + e], q = L - tab[32 + e] * ntn;
        u.e = __builtin_amdgcn_readfirstlane(e); u.pn = __builtin_amdgcn_readfirstlane(q / nb); u.rb = __builtin_amdgcn_readfirstlane(q % nb);
        u.pm = __builtin_amdgcn_readfirstlane(tab[32 + e] + q % nb); u.cnt = __builtin_amdgcn_readfirstlane(tab[e]); return true;
    }
    __device__ __forceinline__ void a_ready(const Unit&) const {}
    __device__ __forceinline__ void done(const Unit&) const {}
    __device__ __forceinline__ const char* a_base(const Gemm& g, const Unit& u) const { return GATHER ? (const char*)g.A : (const char*)g.A + (size_t)u.pm * ((size_t)BM * g.K * 2); }
    __device__ __forceinline__ const char* b_base(const Gemm& g, const Unit& u) const { return (const char*)g.Bt + (size_t)u.e * estride + (size_t)u.pn * ((size_t)BM * g.K * 2); }
    __device__ __forceinline__ void a_voff(const Gemm& g, const Unit& u, int tid, unsigned (&va)[2][2]) const {
#pragma unroll
        for (int i = 0; i < 2; ++i) { int R, C; stage_rc(tid * 16 + i * 8192, R, C);
            if (GATHER) {
#pragma unroll
                for (int h = 0; h < 2; ++h) { int idx = u.rb * BM + h * HALF + R; idx = idx < u.cnt ? idx : u.cnt - 1; const int tok = list[u.e * 8192 + idx]; va[h][i] = (unsigned)(tok * g.K + C) * 2u; }
            } else { va[0][i] = (unsigned)(R * g.K + C) * 2u; va[1][i] = va[0][i] + (unsigned)(HALF * g.K * 2); } }
    }
};


typedef _Float16 h2_t __attribute__((ext_vector_type(2)));
__device__ __forceinline__ unsigned cvt_pk_f16(float lo, float hi) { h2_t v = {(_Float16)lo, (_Float16)hi}; return __builtin_bit_cast(unsigned, v); }
struct EpiF16 {
    static constexpr bool PERM = true, AFTER_DRAIN = false;
    f16_t* O; int ldc; int ntile0; float scale0;
    __device__ __forceinline__ void operator()(const f32x4 (&acc)[2][2][4][2], const Unit& u, int wr, int wc, int fr, int fq) const {
        const int row0 = u.pm * BM + wr * 64 + fr; const int col0 = u.pn * BM + wc * 32 + 8 * fq;
        const float sc = (u.pn < ntile0) ? scale0 : 1.f;
#pragma unroll
        for (int ai = 0; ai < 2; ++ai)
#pragma unroll
            for (int m = 0; m < 4; ++m) { f16_t* rowp = O + (size_t)(row0 + ai * HALF + m * 16) * ldc + col0;
#pragma unroll
                for (int bj = 0; bj < 2; ++bj) { f32x4 v0 = acc[ai][bj][m][0] * sc, v1 = acc[ai][bj][m][1] * sc;
                    u32x4 w; w.x = cvt_pk_f16(v0[0], v0[1]); w.y = cvt_pk_f16(v0[2], v0[3]); w.z = cvt_pk_f16(v1[0], v1[1]); w.w = cvt_pk_f16(v1[2], v1[3]);
                    *(u32x4*)(rowp + bj * HALF) = w; } }
    }
};


struct EpiResF32 {
    static constexpr bool PERM = false, AFTER_DRAIN = false;
    float* io; int ldc; float alpha;
    __device__ __forceinline__ void operator()(const f32x4 (&acc)[2][2][4][2], const Unit& u, int wr, int wc, int fr, int fq) const {
        const int row0 = u.pm * BM + wr * 64 + fr; const int col0 = u.pn * BM + wc * 32 + 4 * fq;
#pragma unroll
        for (int ai = 0; ai < 2; ++ai)
#pragma unroll
            for (int m = 0; m < 4; ++m) { float* rowp = io + (size_t)(row0 + ai * HALF + m * 16) * ldc + col0;
#pragma unroll
                for (int bj = 0; bj < 2; ++bj)
#pragma unroll
                    for (int n = 0; n < 2; ++n) { f32x4* p = (f32x4*)(rowp + bj * HALF + n * 16); const f32x4 r = *p; *p = r * alpha + acc[ai][bj][m][n]; } }
    }
};
struct EpiFinal {
    static constexpr bool PERM = false, AFTER_DRAIN = false;
    float* io; int ldc; const f16_t* pw; const float* rowrs; const float* g;
    __device__ __forceinline__ void operator()(const f32x4 (&acc)[2][2][4][2], const Unit& u, int wr, int wc, int fr, int fq) const {
        typedef _Float16 h4_t __attribute__((ext_vector_type(4)));
        const int row0 = u.pm * BM + wr * 64 + fr; const int col0 = u.pn * BM + wc * 32 + 4 * fq;
#pragma unroll
        for (int ai = 0; ai < 2; ++ai)
#pragma unroll
            for (int m = 0; m < 4; ++m) { const int row = row0 + ai * HALF + m * 16; const size_t off = (size_t)row * ldc + col0;
                const float rs = rowrs[row];
#pragma unroll
                for (int bj = 0; bj < 2; ++bj)
#pragma unroll
                    for (int n = 0; n < 2; ++n) { f32x4* p = (f32x4*)(io + off + bj * HALF + n * 16); const f32x4 hv = *p; const h4_t pv = *(const h4_t*)(pw + off + bj * HALF + n * 16);
                        const f32x4 gv = *(const f32x4*)(g + col0 + bj * HALF + n * 16);
                        const f32x4 a = acc[ai][bj][m][n]; f32x4 o;
#pragma unroll
                        for (int c = 0; c < 4; ++c) o[c] = hv[c] + (1.f / (1.f + __expf(-a[c]))) * ((float)pv[c] * rs) * gv[c];
                        *p = o; }
                asm volatile("" ::: "memory"); }
    }
};

struct EpiGU {
    static constexpr bool PERM = true, AFTER_DRAIN = false;
    f16_t* O;
    __device__ __forceinline__ void operator()(const f32x4 (&acc)[2][2][4][2], const Unit& u, int wr, int wc, int fr, int fq) const {
        const int row0 = u.pm * BM + wr * 64 + fr; const int col0 = u.pn * HALF + wc * 32 + 8 * fq;
#pragma unroll
        for (int ai = 0; ai < 2; ++ai)
#pragma unroll
            for (int m = 0; m < 4; ++m) { f16_t* rowp = O + (size_t)(row0 + ai * HALF + m * 16) * 512 + col0; float o[8];
#pragma unroll
                for (int n = 0; n < 2; ++n)
#pragma unroll
                    for (int c = 0; c < 4; ++c) { const float gt = acc[ai][0][m][n][c], up = acc[ai][1][m][n][c]; o[n * 4 + c] = gt / (1.f + __expf(-gt)) * up; }
                u32x4 w; w.x = cvt_pk_f16(o[0], o[1]); w.y = cvt_pk_f16(o[2], o[3]); w.z = cvt_pk_f16(o[4], o[5]); w.w = cvt_pk_f16(o[6], o[7]);
                *(u32x4*)rowp = w; }
    }
};
struct EpiDown {
    static constexpr bool PERM = true, AFTER_DRAIN = false;
    f16_t* O; const int* lpair;
    __device__ __forceinline__ void operator()(const f32x4 (&acc)[2][2][4][2], const Unit& u, int wr, int wc, int fr, int fq) const {
        const int r0 = u.rb * BM + wr * 64 + fr; const int col0 = u.pn * BM + wc * 32 + 8 * fq;
#pragma unroll
        for (int ai = 0; ai < 2; ++ai)
#pragma unroll
            for (int m = 0; m < 4; ++m) { const int r = r0 + ai * HALF + m * 16;
                if (r < u.cnt) { const int pair = lpair[u.e * 8192 + r]; f16_t* rowp = O + (size_t)pair * 2048 + col0;
#pragma unroll
                    for (int bj = 0; bj < 2; ++bj) { const f32x4 v0 = acc[ai][bj][m][0], v1 = acc[ai][bj][m][1];
                        u32x4 w; w.x = cvt_pk_f16(v0[0], v0[1]); w.y = cvt_pk_f16(v0[2], v0[3]); w.z = cvt_pk_f16(v1[0], v1[1]); w.w = cvt_pk_f16(v1[2], v1[3]);
                        *(u32x4*)(rowp + bj * HALF) = w; } } }
    }
};
template <class Epi, class Sched, bool ALIGN_EPI = false, bool SP2 = true>
__device__ __forceinline__ void gemm_phase(PG8_LAS unsigned char* lds, const Gemm g, const Sched& S, const Epi& E, const int wid) {
    static_assert(SP2, "only the SP2 K-loop is kept in this file");
    const int lane = lane_id(), tid = wid * 64 + lane, wr = wid >> 2, wc = wid & 3, fr = lane & 15, fq = lane >> 4;
    const int K = g.K, nt = K / BK;
    unsigned voffB[2];
#pragma unroll
    for (int i = 0; i < 2; ++i) { int R, C; stage_rc(tid * 16 + i * 8192, R, C); const int Rb = Epi::PERM ? ((R & ~31) + perm32(R & 31)) : R;
        voffB[i] = (unsigned)(Rb * K + C) * 2u; }
    const size_t kstep = (size_t)(BK * 2);
    const size_t hstep = (size_t)HALF * K * 2;
    const unsigned ldsw = (unsigned)wid * 1024u;
    const int aoff = lds_byte(wr * 64 + fr, fq * 8), boff = lds_byte(wc * 32 + fr, fq * 8);
#define PG8_SA(b, h) (((b) * 2 + (h)) * HTB)
#define PG8_SB(b, h) ((4 + (b) * 2 + (h)) * HTB)
#define PG8_STAGE(bufoff, gbase, voff) do { _Pragma("unroll") for (int _i = 0; _i < 2; ++_i) \
        __builtin_amdgcn_global_load_lds((const unsigned*)((const char*)(gbase) + (voff)[_i]), (PG8_LAS unsigned*)(lds + (bufoff) + ldsw + _i * 8192), 16, 0, 0); } while (0)
#define PG8_LDA(dst, b, h) do { _Pragma("unroll") for (int m = 0; m < 4; ++m) _Pragma("unroll") for (int k = 0; k < 2; ++k) dst[m][k] = *(const PG8_LAS f16x8*)(lds + PG8_SA(b, h) + aoff + m * 2048 + k * 1024); } while (0)
#define PG8_LDB(dst, b, h) do { _Pragma("unroll") for (int n = 0; n < 2; ++n) _Pragma("unroll") for (int k = 0; k < 2; ++k) dst[n][k] = *(const PG8_LAS f16x8*)(lds + PG8_SB(b, h) + boff + n * 2048 + k * 1024); } while (0)
#define PG8_MMA(ai, bj, At, Bt) do { __builtin_amdgcn_s_setprio(1); _Pragma("unroll") for (int m = 0; m < 4; ++m) _Pragma("unroll") for (int n = 0; n < 2; ++n) _Pragma("unroll") for (int k = 0; k < 2; ++k) \
        acc[ai][bj][m][n] = __builtin_amdgcn_mfma_f32_16x16x32_f16(Bt[n][k], At[m][k], acc[ai][bj][m][n], 0, 0, 0); __builtin_amdgcn_s_setprio(0); } while (0)
#define PG8_WAIT_V(n) asm volatile("s_waitcnt vmcnt(" #n ")" ::: "memory")
#define PG8_WAIT_L(n) asm volatile("s_waitcnt lgkmcnt(" #n ")" ::: "memory")
#define PG8_BAR __builtin_amdgcn_s_barrier()
#define PG8_SCHED __builtin_amdgcn_sched_barrier(0)
    Unit cur, nxt; int ui = 0;
    if (!S.next(0, cur)) return;
    f32x4 acc[2][2][4][2];
#pragma unroll
    for (int a = 0; a < 2; ++a)
#pragma unroll
        for (int b = 0; b < 2; ++b)
#pragma unroll
            for (int m = 0; m < 4; ++m)
#pragma unroll
                for (int n = 0; n < 2; ++n) acc[a][b][m][n] = (f32x4){0.f, 0.f, 0.f, 0.f};
    f16x8 At[4][2], B0[2][2], B1[2][2];
    const char* cA = S.a_base(g, cur); const char* cB = S.b_base(g, cur);
    unsigned vaC[2][2];
    S.a_voff(g, cur, tid, vaC);
    S.a_ready(cur);
    PG8_STAGE(PG8_SB(0, 0), cB, voffB); PG8_STAGE(PG8_SB(0, 1), cB + hstep, voffB); PG8_STAGE(PG8_SA(0, 0), cA, vaC[0]); PG8_STAGE(PG8_SA(0, 1), cA, vaC[1]);
    if (wr == 1) PG8_BAR;
    PG8_WAIT_V(2); PG8_BAR;
    PG8_STAGE(PG8_SB(1, 0), cB + kstep, voffB); PG8_STAGE(PG8_SA(1, 0), cA + kstep, vaC[0]); PG8_STAGE(PG8_SB(1, 1), cB + hstep + kstep, voffB);
    PG8_WAIT_V(6); PG8_BAR;
    for (;;) {
        const bool has_next = S.next(ui + 1, nxt);
        const char* nA = has_next ? S.a_base(g, nxt) : cA; const char* nB = has_next ? S.b_base(g, nxt) : cB;
        for (int t = 0; t < nt; t += 2) {
            const bool last = (t == nt - 2);

            const char* a1 = cA + (size_t)(t + 1) * kstep;
            const char* a2 = last ? nA : cA + (size_t)(t + 2) * kstep; const char* b2 = last ? nB : cB + (size_t)(t + 2) * kstep;
            const char* a3 = a2 + kstep; const char* b3 = b2 + kstep;
            if (last && has_next) S.a_ready(nxt);
            PG8_LDB(B0, 0, 0); PG8_LDB(B1, 0, 1); PG8_SCHED; PG8_LDA(At, 0, 0); PG8_STAGE(PG8_SA(1, 1), a1, vaC[1]);
            if (last && has_next) S.a_voff(g, nxt, wid * 64 + lane_id(), vaC);
            PG8_WAIT_V(8); PG8_WAIT_L(0); PG8_BAR; PG8_MMA(0, 0, At, B0); PG8_MMA(0, 1, At, B1); PG8_BAR; PG8_SCHED;
            PG8_LDA(At, 0, 1); PG8_STAGE(PG8_SB(0, 0), b2, voffB); PG8_STAGE(PG8_SB(0, 1), b2 + hstep, voffB); PG8_STAGE(PG8_SA(0, 0), a2, vaC[0]);
            PG8_WAIT_V(8); PG8_WAIT_L(0); PG8_BAR; PG8_MMA(1, 0, At, B0); PG8_MMA(1, 1, At, B1); PG8_BAR; PG8_SCHED;
            PG8_LDB(B0, 1, 0); PG8_LDB(B1, 1, 1); PG8_SCHED; PG8_LDA(At, 1, 0); PG8_STAGE(PG8_SA(0, 1), a2, vaC[1]);
            PG8_WAIT_V(8); PG8_WAIT_L(0); PG8_BAR; PG8_MMA(0, 0, At, B0); PG8_MMA(0, 1, At, B1); PG8_BAR; PG8_SCHED;
            PG8_LDA(At, 1, 1); PG8_STAGE(PG8_SB(1, 0), b3, voffB); PG8_STAGE(PG8_SB(1, 1), b3 + hstep, voffB); PG8_STAGE(PG8_SA(1, 0), a3, vaC[0]);
            PG8_WAIT_V(8); PG8_WAIT_L(0); PG8_BAR; PG8_MMA(1, 0, At, B0); PG8_MMA(1, 1, At, B1); PG8_BAR; PG8_SCHED;
        }
        if constexpr (ALIGN_EPI) { if (wr == 0) PG8_BAR; }
        { const int l2 = lane_id(); E(acc, cur, wr, wc, l2 & 15, l2 >> 4); } S.done(cur);
        if (!has_next) break;
#pragma unroll
        for (int a = 0; a < 2; ++a)
#pragma unroll
            for (int b = 0; b < 2; ++b)
#pragma unroll
                for (int m = 0; m < 4; ++m)
#pragma unroll
                    for (int n = 0; n < 2; ++n) acc[a][b][m][n] = (f32x4){0.f, 0.f, 0.f, 0.f};
        cur = nxt; cA = nA; cB = nB; ++ui;
        if constexpr (ALIGN_EPI) { if (wr == 1) PG8_BAR; }
    }
    PG8_WAIT_V(0);
    if constexpr (!ALIGN_EPI) { if (wr == 0) PG8_BAR; }
    PG8_BAR;
#undef PG8_SA
#undef PG8_SB
#undef PG8_STAGE
#undef PG8_LDA
#undef PG8_LDB
#undef PG8_MMA
#undef PG8_WAIT_V
#undef PG8_WAIT_L
#undef PG8_BAR
#undef PG8_SCHED
}
}

constexpr int PN = 6656;
namespace att {
#define ALAS __attribute__((address_space(3)))
typedef _Float16 f16x8 __attribute__((ext_vector_type(8)));
typedef float f32x16 __attribute__((ext_vector_type(16)));
typedef short v4i16_t __attribute__((ext_vector_type(4)));
typedef unsigned u32x4 __attribute__((ext_vector_type(4)));
constexpr int SLOT = 16384, L_K = 0, L_V = 3 * SLOT, L_SCR = 6 * SLOT, L_TAB = L_SCR + 2048, L_END = L_TAB + 1024;
constexpr int L_XB = 0, L_STG = 65536;
constexpr float LOG2E = 1.4426950408889634f;
constexpr float C2 = 0.125f * LOG2E;
__device__ __forceinline__ int crow(int r, int hi) { return (r & 3) + 8 * (r >> 2) + 4 * hi; }
__device__ __forceinline__ void glds16(const void* g, ALAS unsigned char* l) { __builtin_amdgcn_global_load_lds((const unsigned*)g, (ALAS unsigned*)l, 16, 0, 0); }
__device__ __forceinline__ float xhalf(float v, int hi) { auto rr = __builtin_amdgcn_permlane32_swap(__float_as_uint(v), __float_as_uint(v), false, false); return hi ? __uint_as_float(rr[0]) : __uint_as_float(rr[1]); }
__device__ __forceinline__ unsigned pkh(float lo, float hi) { typedef _Float16 h2 __attribute__((ext_vector_type(2))); h2 v = {(_Float16)lo, (_Float16)hi}; return __builtin_bit_cast(unsigned, v); }
__device__ __forceinline__ v4i16_t vtr(const ALAS unsigned char* p) { return __builtin_amdgcn_ds_read_tr16_b64_v4i16((ALAS v4i16_t*)p); }

template <int THR>
__device__ __forceinline__ void attn_unit(ALAS unsigned char* lds, const int wave, const int b, const int h, const int qb, const unsigned short* PROJ, unsigned short* Y,
                                          const float* biasG, const float lam, const float* subln_g) {
    const int lane = pg8::lane_id(), r32 = lane & 31, hi = lane >> 5;
    const int c = wave >> 2, w4 = wave & 3;
    const int q0 = qb * 128, qw0 = q0 + 32 * w4, q = qw0 + r32;
    const size_t rowbase = (size_t)b * S;
    { ALAS float* tabL = (ALAS float*)(lds + L_TAB); const int tid = wave * 64 + lane; if (tid < 129) tabL[tid] = biasG[tid] * LOG2E; }
    f16x8 qf[4];
    { const unsigned short* Qp = PROJ + (rowbase + q) * PN + h * 128 + c * 64 + hi * 8;
#pragma unroll
      for (int d0 = 0; d0 < 4; ++d0) qf[d0] = *(const f16x8*)(Qp + d0 * 16); }
    const unsigned short* ksrc0 = PROJ + (rowbase + lane) * PN + 1024 + h * 128 + (2 * wave) * 8;
    const unsigned short* vsrc0 = PROJ + (rowbase + 16 * ((2 * wave) & 3) + (lane >> 2)) * PN + 2048 + h * 128 + 32 * ((2 * wave) >> 2) + (lane & 3) * 8;
    ALAS unsigned char* kdst = lds + L_K + (2 * wave) * 1024; ALAS unsigned char* vdst = lds + L_V + (2 * wave) * 1024;
#define ATT_ISSUE(t, slot) do { const size_t go_ = (size_t)(t) * 64 * PN; \
        glds16(ksrc0 + go_, kdst + (slot) * SLOT); glds16(ksrc0 + go_ + 8, kdst + (slot) * SLOT + 1024); \
        glds16(vsrc0 + go_, vdst + (slot) * SLOT); glds16(vsrc0 + go_ + (size_t)16 * PN, vdst + (slot) * SLOT + 1024); } while (0)
    const int NT = (q0 + 128) / 64;
    ATT_ISSUE(0, 0); ATT_ISSUE(1, 1);
    ALAS float* wsf = (ALAS float*)(lds + L_SCR) + wave * 64;
    const ALAS float* tabL = (const ALAS float*)(lds + L_TAB);
    const float bfar = biasG[128] * LOG2E;
    float mhat = 0.f, l = 0.f;
    f32x16 o[4];
#pragma unroll
    for (int d = 0; d < 4; ++d)
#pragma unroll
        for (int r = 0; r < 16; ++r) o[d][r] = 0.f;
    f32x16 negm;
#pragma unroll
    for (int r = 0; r < 16; ++r) negm[r] = bfar;
    int slot = 0;
    for (int t = 0; t < NT; ++t) {
        if (t + 1 < NT) asm volatile("s_waitcnt vmcnt(4)" ::: "memory"); else asm volatile("s_waitcnt vmcnt(0)" ::: "memory");
        __builtin_amdgcn_s_barrier();
        asm volatile("" ::: "memory");
        if (t + 2 < NT) { const int s2 = slot == 0 ? 2 : slot - 1; ATT_ISSUE(t + 2, s2); }
        const int k0 = t * 64;
        if (k0 <= qw0 + 31) {
            const ALAS unsigned char* Ks = lds + L_K + slot * SLOT + (8 * c + hi) * 1024 + r32 * 16;
            const ALAS unsigned char* Vs = lds + L_V + slot * SLOT + (4 * hi + ((lane & 15) >> 2)) * 64 + ((lane >> 4) & 1) * 32 + (lane & 3) * 8;
            f32x16 p0, p1;
            const bool nearb = (k0 + 63 + 128 > qw0);
            if (nearb) {
                f32x16 c0, c1;
#pragma unroll
                for (int r = 0; r < 16; ++r) { int rel = q - (k0 + crow(r, hi)); int i0 = rel < 0 ? 0 : (rel > 128 ? 128 : rel); int rel1 = rel - 32; int i1 = rel1 < 0 ? 0 : (rel1 > 128 ? 128 : rel1);
                    c0[r] = tabL[i0] - mhat; c1[r] = tabL[i1] - mhat; }
#pragma unroll
                for (int d0 = 0; d0 < 4; ++d0) { const f16x8 a0 = *(const ALAS f16x8*)(Ks + d0 * 2048), a1 = *(const ALAS f16x8*)(Ks + d0 * 2048 + 512);
                    p0 = __builtin_amdgcn_mfma_f32_32x32x16_f16(a0, qf[d0], d0 == 0 ? c0 : p0, 0, 0, 0); p1 = __builtin_amdgcn_mfma_f32_32x32x16_f16(a1, qf[d0], d0 == 0 ? c1 : p1, 0, 0, 0); }
                if (k0 + 63 > qw0) {
#pragma unroll
                    for (int r = 0; r < 16; ++r) { const int kv = k0 + crow(r, hi); if (kv > q) p0[r] = -INFINITY; if (kv + 32 > q) p1[r] = -INFINITY; }
                }
            } else {
#pragma unroll
                for (int d0 = 0; d0 < 4; ++d0) { const f16x8 a0 = *(const ALAS f16x8*)(Ks + d0 * 2048), a1 = *(const ALAS f16x8*)(Ks + d0 * 2048 + 512);
                    p0 = __builtin_amdgcn_mfma_f32_32x32x16_f16(a0, qf[d0], d0 == 0 ? negm : p0, 0, 0, 0); p1 = __builtin_amdgcn_mfma_f32_32x32x16_f16(a1, qf[d0], d0 == 0 ? negm : p1, 0, 0, 0); }
            }
            float rm = fmaxf(p0[0], p1[0]);
#pragma unroll
            for (int r = 1; r < 16; ++r) rm = fmaxf(rm, fmaxf(p0[r], p1[r]));
            rm = fmaxf(rm, xhalf(rm, hi));
            const bool first = (t == 0);
            if (first || __any(rm > (float)THR)) {
                const float dl = first ? rm : fmaxf(rm, 0.f);
                mhat += dl;
#pragma unroll
                for (int r = 0; r < 16; ++r) { p0[r] -= dl; p1[r] -= dl; }
#pragma unroll
                for (int r = 0; r < 16; ++r) negm[r] = bfar - mhat;
                if (!first) {
                    const float f = __builtin_amdgcn_exp2f(-dl); l *= f;
                    if (hi == 0) wsf[r32] = f;
                    asm volatile("s_waitcnt lgkmcnt(0)" ::: "memory");
#pragma unroll
                    for (int r = 0; r < 16; ++r) { const float fr_ = wsf[crow(r, hi)];
#pragma unroll
                        for (int d = 0; d < 4; ++d) o[d][r] *= fr_; }
                }
            }
            float sacc = 0.f;
#pragma unroll
            for (int r = 0; r < 16; ++r) { p0[r] = __builtin_amdgcn_exp2f(p0[r]); p1[r] = __builtin_amdgcn_exp2f(p1[r]); sacc += p0[r] + p1[r]; }
            l += sacc;
            u32x4 pw[4];
#pragma unroll
            for (int s = 0; s < 2; ++s) {
                pw[s] = (u32x4){pkh(p0[8 * s], p0[8 * s + 1]), pkh(p0[8 * s + 2], p0[8 * s + 3]), pkh(p0[8 * s + 4], p0[8 * s + 5]), pkh(p0[8 * s + 6], p0[8 * s + 7])};
                pw[2 + s] = (u32x4){pkh(p1[8 * s], p1[8 * s + 1]), pkh(p1[8 * s + 2], p1[8 * s + 3]), pkh(p1[8 * s + 4], p1[8 * s + 5]), pkh(p1[8 * s + 6], p1[8 * s + 7])};
            }
#pragma unroll
            for (int d = 0; d < 4; ++d) {
#pragma unroll
                for (int s = 0; s < 4; ++s) {
                    const v4i16_t lo = vtr(Vs + (d * 4 + s) * 1024), hi4 = vtr(Vs + (d * 4 + s) * 1024 + 512);
                    typedef short s16x8 __attribute__((ext_vector_type(8)));
                    const s16x8 bv = {lo[0], lo[1], lo[2], lo[3], hi4[0], hi4[1], hi4[2], hi4[3]};
                    o[d] = __builtin_amdgcn_mfma_f32_32x32x16_f16(__builtin_bit_cast(f16x8, pw[s]), __builtin_bit_cast(f16x8, bv), o[d], 0, 0, 0);
                }
            }
        }
        slot = slot == 2 ? 0 : slot + 1;
    }
#undef ATT_ISSUE
    l += xhalf(l, hi);
    if (hi == 0) wsf[r32] = 1.0f / l;
    asm volatile("s_waitcnt lgkmcnt(0)" ::: "memory");
#pragma unroll
    for (int r = 0; r < 16; ++r) { const float f = wsf[crow(r, hi)];
#pragma unroll
        for (int d = 0; d < 4; ++d) o[d][r] *= f; }
    asm volatile("s_waitcnt lgkmcnt(0)" ::: "memory"); __builtin_amdgcn_s_barrier(); asm volatile("" ::: "memory");
    ALAS float* xb = (ALAS float*)(lds + L_XB) + w4 * 4096 + lane;
    if (c == 1) {
#pragma unroll
        for (int d = 0; d < 4; ++d)
#pragma unroll
            for (int r = 0; r < 16; ++r) xb[(d * 16 + r) * 64] = o[d][r];
    }
    asm volatile("s_waitcnt lgkmcnt(0)" ::: "memory"); __builtin_amdgcn_s_barrier(); asm volatile("" ::: "memory");
    if (c == 0) {
        float sc[16];
#pragma unroll
        for (int r = 0; r < 16; ++r) { float ss = 0.f;
#pragma unroll
            for (int d = 0; d < 4; ++d) { o[d][r] -= lam * xb[(d * 16 + r) * 64]; ss += o[d][r] * o[d][r]; }
            ss += __shfl_xor(ss, 1); ss += __shfl_xor(ss, 2); ss += __shfl_xor(ss, 4); ss += __shfl_xor(ss, 8); ss += __shfl_xor(ss, 16);
            sc[r] = (1.0f / sqrtf(ss * (1.f / 128.f) + LN_EPS)) * (1.f - LAMBDA_INIT); }
        ALAS _Float16* stg = (ALAS _Float16*)(lds + L_STG + w4 * 8192);
#pragma unroll
        for (int d = 0; d < 4; ++d) { const float gg = subln_g[32 * d + r32];
#pragma unroll
            for (int r = 0; r < 16; ++r) stg[crow(r, hi) * 128 + 32 * d + r32] = (_Float16)(o[d][r] * sc[r] * gg); }
        asm volatile("s_waitcnt lgkmcnt(0)" ::: "memory");
        unsigned short* Yw = Y + (rowbase + qw0) * D + h * 128;
#pragma unroll
        for (int i = 0; i < 8; ++i) { const int row = i * 4 + (lane >> 4), ch = lane & 15; const u32x4 v = *(const ALAS u32x4*)((const ALAS unsigned char*)stg + row * 256 + ch * 16);
            *(u32x4*)(Yw + (size_t)row * D + ch * 8) = v; }
    }
    asm volatile("s_waitcnt lgkmcnt(0)" ::: "memory"); __builtin_amdgcn_s_barrier(); asm volatile("" ::: "memory");
}
#undef ALAS
}

constexpr int NWAVES = 8;
constexpr int RING_OFF = 0, RING_BYTES = 131072;
constexpr int LDSCTL_OFF = RING_BYTES, MISC_OFF = LDSCTL_OFF + 320;
constexpr int LDS_BYTES = 147456;
#define GAS __attribute__((address_space(1)))
#define LAS __attribute__((address_space(3)))
typedef unsigned v4u __attribute__((ext_vector_type(4)));
typedef float f32x4 __attribute__((ext_vector_type(4)));
typedef GAS unsigned gu32;
#define RLX_AGENT __ATOMIC_RELAXED, __HIP_MEMORY_SCOPE_AGENT
#define LDS_WAIT() asm volatile("s_waitcnt lgkmcnt(0)" ::: "memory")
#define VM_WAIT() asm volatile("s_waitcnt vmcnt(0)" ::: "memory")
constexpr int CW_BAR = 4096;
constexpr size_t CTL_ZERO_BYTES = 1 * MiB;

#define XB_TMO      128
#define XB_XCNT(j)  (256  + 64 * (j))
#define XB_XSUB(j)  (1280 + 64 * (j))
#define XB_XGEN(j)  (2304 + 64 * (j))
#define XB_TOP      3328
#define XB_TOPGEN   3392
#define XCD_BAR_WORDS 3456
#define XB_SPIN_CAP (1u << 18)

__device__ __forceinline__ unsigned xb_ld(unsigned* p)              { return __hip_atomic_load(p, __ATOMIC_RELAXED, __HIP_MEMORY_SCOPE_AGENT); }
__device__ __forceinline__ unsigned xb_add(unsigned* p, unsigned v) { return __hip_atomic_fetch_add(p, v, __ATOMIC_RELAXED, __HIP_MEMORY_SCOPE_AGENT); }
__device__ __forceinline__ unsigned xb_xcc_id() { return (unsigned)__builtin_amdgcn_s_getreg((3 << 11) | 20) & 0xFu; }
#define XB_SPIN(cond, bar) do { unsigned _sp = 0; while (cond) { __builtin_amdgcn_s_sleep(1); \
    if ((++_sp & 255u) == 0u) { if (xb_ld(&(bar)[XB_TMO])) break; if (_sp > XB_SPIN_CAP) { atomicAdd(&(bar)[XB_TMO], 1u); break; } } } } while (0)

struct XcdBarrier {
    unsigned* bar; unsigned x; bool w0;
    volatile LAS unsigned* st;
};

__device__ __forceinline__ XcdBarrier xcd_barrier_post(unsigned* bar, volatile LAS unsigned* st) {
    XcdBarrier b; b.bar = bar; b.x = xb_xcc_id(); b.st = st; b.w0 = (__builtin_amdgcn_readfirstlane(threadIdx.x >> 6) == 0);
    if (__builtin_amdgcn_readfirstlane(threadIdx.x >> 6) == 0 && pg8::lane_id() == 0) (void)xb_add(&bar[XB_XCNT(b.x)], 1u);
    return b;
}
__device__ __forceinline__ void xcd_barrier_complete(unsigned* bar, unsigned x, unsigned& nloc, unsigned& nx) {
    const unsigned G = gridDim.x * gridDim.y * gridDim.z;
    unsigned sum, cnt, mine, sp = 0u;
    for (;;) {
        sum = 0u; cnt = 0u; mine = 0u;
#pragma unroll
        for (unsigned j = 0; j < 16; ++j) { const unsigned c = xb_ld(&bar[XB_XCNT(j)]); sum += c; cnt += (c > 0u) ? 1u : 0u; mine = (j == x) ? c : mine; }
        if (sum == G) break;
        __builtin_amdgcn_s_sleep(1);
        if ((++sp & 255u) == 0u) { if (xb_ld(&bar[XB_TMO])) break; if (sp > XB_SPIN_CAP) { atomicAdd(&bar[XB_TMO], 1u); break; } }
    }
    nloc = mine > 0u ? mine : 1u; nx = cnt > 0u ? cnt : 1u;
}

__device__ __forceinline__ void xcd_barrier(const XcdBarrier& b) {
    asm volatile("s_waitcnt vmcnt(0)" ::: "memory");
    __syncthreads();
    if (b.w0 && pg8::lane_id() == 0) {
        unsigned* bar = b.bar;
        __builtin_amdgcn_s_waitcnt(0);
        unsigned nloc = b.st[0], nx = b.st[1];
        if (nloc == 0u) { xcd_barrier_complete(bar, b.x, nloc, nx); b.st[0] = nloc; b.st[1] = nx; }
        const unsigned old = xb_add(&bar[XB_XSUB(b.x)], 1u);
        const unsigned gen = old / nloc;
        if (old + 1u == (gen + 1u) * nloc) {
            __builtin_amdgcn_fence(__ATOMIC_RELEASE, "agent");
            asm volatile("s_waitcnt vmcnt(0)" ::: "memory");
            const unsigned og = xb_add(&bar[XB_TOP], 1u);
            const unsigned tg = og / nx;
            if (og + 1u == (tg + 1u) * nx) xb_add(&bar[XB_TOPGEN], 1u);
            else XB_SPIN(xb_ld(&bar[XB_TOPGEN]) == tg, bar);
            __builtin_amdgcn_fence(__ATOMIC_ACQUIRE, "agent");
            xb_add(&bar[XB_XGEN(b.x)], 1u);
            asm volatile("s_waitcnt vmcnt(0)" ::: "memory");
        } else {
            XB_SPIN(xb_ld(&bar[XB_XGEN(b.x)]) == gen, bar);
            __builtin_amdgcn_fence(__ATOMIC_ACQUIRE, "agent");
            asm volatile("s_waitcnt vmcnt(0)" ::: "memory");
        }
    }
    __syncthreads();
}


typedef unsigned short f16_t;
typedef _Float16 h2v __attribute__((ext_vector_type(2)));
__device__ __forceinline__ unsigned pk2h(float lo, float hi) { h2v v = {(_Float16)lo, (_Float16)hi}; return __builtin_bit_cast(unsigned, v); }

struct Frame {
    LAS unsigned char* lds; volatile LAS unsigned* MISC; gu32* ctl;
    int wave, vcu, G;
};
#define FTID (F.wave * 64 + pg8::lane_id())
#define FLANE (pg8::lane_id())
__device__ __forceinline__ void p0_transpose_item(const float* W, int K, int N, f16_t* WT, int row_off, LAS float* scr, int item, int lane) {
    const int nblk = N / 32, kb = item / nblk, nb = item % nblk, k0 = 64 * kb, n0 = 32 * nb;
#pragma unroll 8
    for (int i = 0; i < 32; ++i) { const int kk = 2 * i + (lane >> 5); scr[kk * 33 + (lane & 31)] = W[(size_t)(k0 + kk) * N + n0 + (lane & 31)]; }
    LDS_WAIT(); asm volatile("" ::: "memory");
    const int c = lane & 7;
#pragma unroll
    for (int j = 0; j < 4; ++j) { const int n = (lane >> 3) + 8 * j; const LAS float* s = scr + (8 * c) * 33 + n;
        v4u o; o.x = pk2h(s[0 * 33], s[1 * 33]); o.y = pk2h(s[2 * 33], s[3 * 33]); o.z = pk2h(s[4 * 33], s[5 * 33]); o.w = pk2h(s[6 * 33], s[7 * 33]);
        *(GAS v4u*)(WT + (size_t)(row_off + n0 + n) * K + k0 + 8 * c) = o; }
    LDS_WAIT(); asm volatile("" ::: "memory");
}
__device__ __forceinline__ float wave_sum_b(float v) {
#pragma unroll
    for (int o = 1; o < 64; o <<= 1) v += __shfl_xor(v, o);
    return v;
}
__device__ __forceinline__ void ln_row_dual(int lane, const float* xrow, const float* g, const float* b, float* o32, f16_t* o16) {
    const GAS f32x4* xr = (const GAS f32x4*)xrow + lane;
    f32x4 v[8]; float s = 0.f;
#pragma unroll
    for (int j = 0; j < 8; ++j) { v[j] = xr[64 * j]; s += (v[j].x + v[j].y) + (v[j].z + v[j].w); }
    const float mean = wave_sum_b(s) * (1.f / D); float s2 = 0.f;
#pragma unroll
    for (int j = 0; j < 8; ++j) { v[j] = v[j] - mean; s2 += (v[j].x * v[j].x + v[j].y * v[j].y) + (v[j].z * v[j].z + v[j].w * v[j].w); }
    const float rstd = 1.f / sqrtf(wave_sum_b(s2) * (1.f / D) + LN_EPS);
    const GAS f32x4* g4 = (const GAS f32x4*)g + lane; const GAS f32x4* b4 = (const GAS f32x4*)b + lane;
    GAS f32x4* o4 = (GAS f32x4*)o32 + lane; GAS unsigned long long* o8 = (GAS unsigned long long*)o16 + lane;
#pragma unroll
    for (int j = 0; j < 8; ++j) { const f32x4 o = v[j] * rstd * g4[64 * j] + b4[64 * j]; o4[64 * j] = o;
        o8[64 * j] = (unsigned long long)pk2h(o.x, o.y) | ((unsigned long long)pk2h(o.z, o.w) << 32); }
}


__device__ __forceinline__ void p0_transpose_item_gu(const float* W, int K, int N, f16_t* WT, int gu_s, LAS float* scr, int item, int lane) {
    const int nblk = N / 32, nb = item % nblk; const int row_off = gu_s < 0 ? 0 : 128 * (nb >> 2) + 128 * gu_s;
    p0_transpose_item(W, K, N, WT, row_off, scr, item, lane);
}
__device__ __forceinline__ void ln_regs(int lane, f32x4 (&v)[8], const float* g, const float* b, float* o32, f16_t* o16) {
    float s = 0.f;
#pragma unroll
    for (int j = 0; j < 8; ++j) s += (v[j].x + v[j].y) + (v[j].z + v[j].w);
    const float mean = wave_sum_b(s) * (1.f / D); float s2 = 0.f;
#pragma unroll
    for (int j = 0; j < 8; ++j) { v[j] = v[j] - mean; s2 += (v[j].x * v[j].x + v[j].y * v[j].y) + (v[j].z * v[j].z + v[j].w * v[j].w); }
    const float rstd = 1.f / sqrtf(wave_sum_b(s2) * (1.f / D) + LN_EPS);
    const GAS f32x4* g4 = (const GAS f32x4*)g + lane; const GAS f32x4* b4 = (const GAS f32x4*)b + lane;
    GAS f32x4* o4 = (GAS f32x4*)o32 + lane; GAS unsigned long long* o8 = (GAS unsigned long long*)o16 + lane;
#pragma unroll
    for (int j = 0; j < 8; ++j) { v[j] = v[j] * rstd * g4[64 * j] + b4[64 * j]; o4[64 * j] = v[j];
        o8[64 * j] = (unsigned long long)pk2h(v[j].x, v[j].y) | ((unsigned long long)pk2h(v[j].z, v[j].w) << 32); }
}
__device__ __forceinline__ void route_token(int tok, const float (&acc)[36], const float* gb, const float* eb, int* cnt, int* ltok, int* lpair, float* pairw) {
    float gl[4]; float gm = -3.0e38f; int gi = 0;
#pragma unroll
    for (int i = 0; i < 4; ++i) { gl[i] = acc[i] + gb[i]; if (gl[i] > gm) { gm = gl[i]; gi = i; } }
    float gs = 0.f;
#pragma unroll
    for (int i = 0; i < 4; ++i) gs += expf(gl[i] - gm);
    const float gtop = 1.f / gs;
    float el[8]; float em = -3.0e38f; int e0 = 0;
#pragma unroll
    for (int i = 0; i < 8; ++i) { float v = 0.f;
#pragma unroll
        for (int g = 0; g < 4; ++g) if (g == gi) v = acc[4 + g * 8 + i] + eb[g * 8 + i];
        el[i] = v; if (v > em) { em = v; e0 = i; } }
    float em2 = -3.0e38f; int e1 = 0;
#pragma unroll
    for (int i = 0; i < 8; ++i) if (i != e0 && el[i] > em2) { em2 = el[i]; e1 = i; }
    const float x1 = expf(em2 - em);
    const float w0 = 1.f / (1.f + x1), w1 = x1 / (1.f + x1);
    const int ea = gi * 8 + e0, ebb = gi * 8 + e1;
    const int p0 = atomicAdd(&cnt[ea], 1); ltok[ea * 8192 + p0] = tok; lpair[ea * 8192 + p0] = tok * 2;
    const int p1 = atomicAdd(&cnt[ebb], 1); ltok[ebb * 8192 + p1] = tok; lpair[ebb * 8192 + p1] = tok * 2 + 1;
    pairw[tok * 2] = w0 * gtop; pairw[tok * 2 + 1] = w1 * gtop;
}
constexpr int TAB_OFF = LDSCTL_OFF + 1024;
__device__ __forceinline__ void build_moe_table(Frame& F, const int* cnt) {
    LAS int* tab = (LAS int*)(F.lds + TAB_OFF);
    const int tid = FTID;
    if (tid < 32) tab[tid] = __hip_atomic_load(cnt + tid, __ATOMIC_RELAXED, __HIP_MEMORY_SCOPE_AGENT);
    __syncthreads();
    if (tid == 0) { int p = 0; for (int e = 0; e < 32; ++e) { tab[32 + e] = p; p += (tab[e] + 255) >> 8; } tab[64] = p; }
    __syncthreads();
}

__device__ __forceinline__ float sum8_dpp(float x) {
    x += __builtin_bit_cast(float, __builtin_amdgcn_update_dpp(0, __builtin_bit_cast(int, x), 0xB1, 0xF, 0xF, true));
    x += __builtin_bit_cast(float, __builtin_amdgcn_update_dpp(0, __builtin_bit_cast(int, x), 0x4E, 0xF, 0xF, true));
    x += __builtin_bit_cast(float, __builtin_amdgcn_update_dpp(0, __builtin_bit_cast(int, x), 0x141, 0xF, 0xF, true));
    return x;
}
__device__ __forceinline__ float h2f(unsigned short u) { return (float)__builtin_bit_cast(_Float16, u); }
__device__ __forceinline__ void rwkv_prep_tile(Frame& F, int tile, const f16_t* PROJ16, const float* mu, const float* w0, const float* w2, const float* a0, const float* a2, const float* g2,
                                               const float* k_k, const float* k_a, float* decay, f16_t* kmod, f16_t* Aout, f16_t* Bout, f16_t* gout) {
    typedef unsigned short us8 __attribute__((ext_vector_type(8)));
    LAS float* sxT = (LAS float*)(F.lds + RING_OFF);
    const int tid = FTID, t0 = tile * 32, tg = tid >> 7, cg = tid & 127;
    __syncthreads();
    for (int e = tid; e < 32 * 288; e += 512) {
        const int tok = e / 288, i = e % 288, pos = (t0 + tok) & (S - 1);
        const f16_t* cur = PROJ16 + (size_t)(t0 + tok) * PN + 6144 + i;
        const float cv = h2f(cur[0]), pv = pos > 0 ? h2f(cur[-PN]) : 0.f; const float xs = cv + (pv - cv) * mu[3072 + i];
        float f; if (i < 64) f = tanhf(xs); else if (i < 128) f = xs; else f = 1.f / (1.f + expf(-xs));
        sxT[i * 36 + tok] = f;
    }
    __syncthreads();
    const LAS float* sx = sxT + 8 * tg;
    float acc[8][8];
    float p0v[8], p1v[8];
#pragma unroll
    for (int t = 0; t < 8; ++t)
#pragma unroll
        for (int c = 0; c < 8; ++c) acc[t][c] = 0.f;
#pragma unroll 2
    for (int j = 0; j < 64; ++j) {
        const f32x4 wa = *(const GAS f32x4*)(w2 + (size_t)j * 1024 + 8 * cg), wb = *(const GAS f32x4*)(w2 + (size_t)j * 1024 + 8 * cg + 4);
        const f32x4 sa = *(const LAS f32x4*)(sx + j * 36), sb = *(const LAS f32x4*)(sx + j * 36 + 4);
        const float wv[8] = {wa.x, wa.y, wa.z, wa.w, wb.x, wb.y, wb.z, wb.w}, sv[8] = {sa.x, sa.y, sa.z, sa.w, sb.x, sb.y, sb.z, sb.w};
#pragma unroll
        for (int t = 0; t < 8; ++t)
#pragma unroll
            for (int c = 0; c < 8; ++c) acc[t][c] = fmaf(sv[t], wv[c], acc[t][c]);
    }
    { const f32x4 pa = *(const GAS f32x4*)(w0 + 8 * cg), pb = *(const GAS f32x4*)(w0 + 8 * cg + 4); const float pp[8] = {pa.x, pa.y, pa.z, pa.w, pb.x, pb.y, pb.z, pb.w};
#pragma unroll
      for (int t = 0; t < 8; ++t) { float o[8];
#pragma unroll
          for (int c = 0; c < 8; ++c) { const float z = -(pp[c] + acc[t][c]); const float sp = z > 20.f ? z : log1pf(expf(z)); o[c] = expf(-expf(-sp - 0.5f)); }
          GAS f32x4* d = (GAS f32x4*)(decay + (size_t)(t0 + 8 * tg + t) * RWK + 8 * cg); d[0] = (f32x4){o[0], o[1], o[2], o[3]}; d[1] = (f32x4){o[4], o[5], o[6], o[7]}; } }
#pragma unroll
    for (int t = 0; t < 8; ++t)
#pragma unroll
        for (int c = 0; c < 8; ++c) acc[t][c] = 0.f;
#pragma unroll 2
    for (int j = 0; j < 64; ++j) {
        const f32x4 wa = *(const GAS f32x4*)(a2 + (size_t)j * 1024 + 8 * cg), wb = *(const GAS f32x4*)(a2 + (size_t)j * 1024 + 8 * cg + 4);
        const f32x4 sa = *(const LAS f32x4*)(sx + (64 + j) * 36), sb = *(const LAS f32x4*)(sx + (64 + j) * 36 + 4);
        const float wv[8] = {wa.x, wa.y, wa.z, wa.w, wb.x, wb.y, wb.z, wb.w}, sv[8] = {sa.x, sa.y, sa.z, sa.w, sb.x, sb.y, sb.z, sb.w};
#pragma unroll
        for (int t = 0; t < 8; ++t)
#pragma unroll
            for (int c = 0; c < 8; ++c) acc[t][c] = fmaf(sv[t], wv[c], acc[t][c]);
    }
    { f32x4 pa = *(const GAS f32x4*)(a0 + 8 * cg), pb = *(const GAS f32x4*)(a0 + 8 * cg + 4); const float pa0[8] = {pa.x, pa.y, pa.z, pa.w, pb.x, pb.y, pb.z, pb.w};
      pa = *(const GAS f32x4*)(k_k + 8 * cg); pb = *(const GAS f32x4*)(k_k + 8 * cg + 4); const float pkk[8] = {pa.x, pa.y, pa.z, pa.w, pb.x, pb.y, pb.z, pb.w};
      pa = *(const GAS f32x4*)(k_a + 8 * cg); pb = *(const GAS f32x4*)(k_a + 8 * cg + 4); const float pka[8] = {pa.x, pa.y, pa.z, pa.w, pb.x, pb.y, pb.z, pb.w};
      pa = *(const GAS f32x4*)(mu + 1024 + 8 * cg); pb = *(const GAS f32x4*)(mu + 1024 + 8 * cg + 4); const float pmu[8] = {pa.x, pa.y, pa.z, pa.w, pb.x, pb.y, pb.z, pb.w};
#pragma unroll
      for (int t = 0; t < 8; ++t) { const int tok = t0 + 8 * tg + t, pos = tok & (S - 1);
          const us8 cu = *(const GAS us8*)(PROJ16 + (size_t)tok * PN + 4096 + 8 * cg); us8 pr = cu; if (pos > 0) pr = *(const GAS us8*)(PROJ16 + (size_t)(tok - 1) * PN + 4096 + 8 * cg);
          float k0[8], kkv[8], ss = 0.f;
#pragma unroll
          for (int c = 0; c < 8; ++c) { const float cv = h2f(cu[c]), pv = pos > 0 ? h2f(pr[c]) : 0.f; k0[c] = cv + (pv - cv) * pmu[c]; kkv[c] = k0[c] * pkk[c]; ss = fmaf(kkv[c], kkv[c], ss); }
          ss = sum8_dpp(ss); const float inv = 1.f / fmaxf(sqrtf(ss), 1e-12f);
          float ok[8], oa[8], ob[8];
#pragma unroll
          for (int c = 0; c < 8; ++c) { const float asig = 1.f / (1.f + expf(-(pa0[c] + acc[t][c]))); const float kk = kkv[c] * inv; ok[c] = k0[c] * (1.f + (asig - 1.f) * pka[c]); oa[c] = -kk; ob[c] = kk * asig; }
          const size_t off = (size_t)tok * RWK + 8 * cg;
          *(GAS v4u*)(kmod + off) = (v4u){pk2h(ok[0], ok[1]), pk2h(ok[2], ok[3]), pk2h(ok[4], ok[5]), pk2h(ok[6], ok[7])};
          *(GAS v4u*)(Aout + off) = (v4u){pk2h(oa[0], oa[1]), pk2h(oa[2], oa[3]), pk2h(oa[4], oa[5]), pk2h(oa[6], oa[7])};
          *(GAS v4u*)(Bout + off) = (v4u){pk2h(ob[0], ob[1]), pk2h(ob[2], ob[3]), pk2h(ob[4], ob[5]), pk2h(ob[6], ob[7])}; } }
#pragma unroll
    for (int t = 0; t < 8; ++t)
#pragma unroll
        for (int c = 0; c < 8; ++c) acc[t][c] = 0.f;
#pragma unroll 2
    for (int j = 0; j < 160; ++j) {
        const f32x4 wa = *(const GAS f32x4*)(g2 + (size_t)j * 1024 + 8 * cg), wb = *(const GAS f32x4*)(g2 + (size_t)j * 1024 + 8 * cg + 4);
        const f32x4 sa = *(const LAS f32x4*)(sx + (128 + j) * 36), sb = *(const LAS f32x4*)(sx + (128 + j) * 36 + 4);
        const float wv[8] = {wa.x, wa.y, wa.z, wa.w, wb.x, wb.y, wb.z, wb.w}, sv[8] = {sa.x, sa.y, sa.z, sa.w, sb.x, sb.y, sb.z, sb.w};
#pragma unroll
        for (int t = 0; t < 8; ++t)
#pragma unroll
            for (int c = 0; c < 8; ++c) acc[t][c] = fmaf(sv[t], wv[c], acc[t][c]);
    }
#pragma unroll
    for (int t = 0; t < 8; ++t) *(GAS v4u*)(gout + (size_t)(t0 + 8 * tg + t) * RWK + 8 * cg) = (v4u){pk2h(acc[t][0], acc[t][1]), pk2h(acc[t][2], acc[t][3]), pk2h(acc[t][4], acc[t][5]), pk2h(acc[t][6], acc[t][7])};
    (void)p0v; (void)p1v;
}

__device__ __forceinline__ float sum16_dpp(float x) {
    x += __builtin_bit_cast(float, __builtin_amdgcn_update_dpp(0, __builtin_bit_cast(int, x), 0xB1, 0xF, 0xF, true));
    x += __builtin_bit_cast(float, __builtin_amdgcn_update_dpp(0, __builtin_bit_cast(int, x), 0x4E, 0xF, 0xF, true));
    x += __builtin_bit_cast(float, __builtin_amdgcn_update_dpp(0, __builtin_bit_cast(int, x), 0x141, 0xF, 0xF, true));
    x += __builtin_bit_cast(float, __builtin_amdgcn_update_dpp(0, __builtin_bit_cast(int, x), 0x140, 0xF, 0xF, true));
    return x;
}
__device__ __forceinline__ f32x4 h4f(const f16_t* p) { typedef _Float16 h4_t __attribute__((ext_vector_type(4))); const h4_t v = *(const GAS h4_t*)p; return (f32x4){(float)v[0], (float)v[1], (float)v[2], (float)v[3]}; }
__device__ __forceinline__ void rwkv_scan_unit(Frame& F, int bh, const f16_t* PROJ16, const float* mu, const float* decay, const f16_t* kmod, const f16_t* A16, const f16_t* B16, const f16_t* G16,
                                               const float* r_k, const float* lnx_g, const float* lnx_b, f16_t* Y16) {
    constexpr int SCH = 32, STEPF = 6 * 64;
    LAS float* buf0 = (LAS float*)(F.lds + RING_OFF);
    LAS float* ybuf = buf0 + 2 * SCH * STEPF;
    const int b = bh >> 4, h = bh & 15;
    const int lane = FLANE, tid = F.wave * 64 + lane;
    const int ss = tid >> 4, scg = tid & 15, ch0 = h * 64 + 4 * scg;
    const f32x4 mur = *(const GAS f32x4*)(mu + ch0), muv = *(const GAS f32x4*)(mu + 2048 + ch0);
    const int rs = lane >> 4, cg = lane & 15, i0 = 8 * F.wave + rs, i1 = i0 + 4;
    const float rk = r_k[h * 64 + lane], lg = lnx_g[h * 64 + lane], lb = lnx_b[h * 64 + lane];
    f32x4 S0 = (f32x4){0.f, 0.f, 0.f, 0.f}, S1 = S0;
    f32x4 st_r, st_w, st_k, st_a, st_b, st_v;
#define SCAN_LOAD(chunk) do { const int pos_ = (chunk) * SCH + ss; const size_t tok_ = (size_t)b * S + pos_; const size_t o_ = tok_ * RWK + ch0; \
        st_w = *(const GAS f32x4*)(decay + o_); st_k = h4f(kmod + o_); st_a = h4f(A16 + o_); st_b = h4f(B16 + o_); \
        const f16_t* cur_ = PROJ16 + tok_ * PN + 3072 + ch0; const f32x4 rc_ = h4f(cur_), vc_ = h4f(cur_ + 2048); \
        f32x4 rp_ = (f32x4){0.f, 0.f, 0.f, 0.f}, vp_ = rp_; if (pos_ > 0) { rp_ = h4f(cur_ - PN); vp_ = h4f(cur_ - PN + 2048); } \
        st_r = rc_ + (rp_ - rc_) * mur; st_v = vc_ + (vp_ - vc_) * muv; } while (0)
#define SCAN_WRITE(bufp) do { LAS float* d_ = (bufp) + ss * STEPF + 4 * scg; *(LAS f32x4*)(d_) = st_r; *(LAS f32x4*)(d_ + 64) = st_w; *(LAS f32x4*)(d_ + 128) = st_k; \
        *(LAS f32x4*)(d_ + 192) = st_a; *(LAS f32x4*)(d_ + 256) = st_b; *(LAS f32x4*)(d_ + 320) = st_v; } while (0)
    __syncthreads();
    SCAN_LOAD(0); SCAN_WRITE(buf0);
    __syncthreads();
    for (int c = 0; c < S / SCH; ++c) {
        LAS float* bufc = buf0 + (c & 1) * SCH * STEPF;
        if (c + 1 < S / SCH) SCAN_LOAD(c + 1);
#pragma unroll 4
        for (int s = 0; s < SCH; ++s) {
            const LAS float* st = bufc + s * STEPF;
            const f32x4 r4 = *(const LAS f32x4*)(st + 4 * cg), w4 = *(const LAS f32x4*)(st + 64 + 4 * cg), k4 = *(const LAS f32x4*)(st + 128 + 4 * cg),
                        a4 = *(const LAS f32x4*)(st + 192 + 4 * cg), b4 = *(const LAS f32x4*)(st + 256 + 4 * cg);
            const float v0 = st[320 + i0], v1 = st[320 + i1];
            float sa0 = (S0.x * a4.x + S0.y * a4.y) + (S0.z * a4.z + S0.w * a4.w), sa1 = (S1.x * a4.x + S1.y * a4.y) + (S1.z * a4.z + S1.w * a4.w);
            const f32x4 t0 = S0 * w4 + k4 * v0, t1 = S1 * w4 + k4 * v1;
            sa0 = sum16_dpp(sa0); sa1 = sum16_dpp(sa1);
            S0 = t0 + b4 * sa0; S1 = t1 + b4 * sa1;
            float y0 = (S0.x * r4.x + S0.y * r4.y) + (S0.z * r4.z + S0.w * r4.w), y1 = (S1.x * r4.x + S1.y * r4.y) + (S1.z * r4.z + S1.w * r4.w);
            y0 = sum16_dpp(y0); y1 = sum16_dpp(y1);
            if (cg == 0) { ybuf[s * 64 + i0] = y0; ybuf[s * 64 + i1] = y1; }
        }
        __syncthreads();
#pragma unroll
        for (int q = 0; q < 4; ++q) {
            const int s = 4 * F.wave + q; const LAS float* st = bufc + s * STEPF;
            const float yv = ybuf[s * 64 + lane];
            const float mean = wave_sum_b(yv) * (1.f / 64.f); const float dv = yv - mean; const float var = wave_sum_b(dv * dv) * (1.f / 64.f);
            const float yn = dv * (1.0f / sqrtf(var + 64e-5f)) * lg + lb;
            const float bs = wave_sum_b(st[lane] * st[128 + lane] * rk);
            const size_t tok = (size_t)b * S + c * SCH + s;
            const float gg = h2f(G16[tok * RWK + h * 64 + lane]);
            Y16[tok * D + 1024 + h * 64 + lane] = __builtin_bit_cast(unsigned short, (_Float16)((yn + bs * st[320 + lane]) * gg));
        }
        if (c + 1 < S / SCH) SCAN_WRITE(buf0 + ((c + 1) & 1) * SCH * STEPF);
        __syncthreads();
    }
#undef SCAN_LOAD
#undef SCAN_WRITE
}

struct Args { const float* in[37]; float* out; unsigned char* ws; int ph_lo, ph_hi, li, pad; };
__global__ void __launch_bounds__(NWAVES * 64, 2) mega_fwd(Args args) {
    extern __shared__ __attribute__((aligned(16))) unsigned char lds[];
    Frame F;
    F.lds = (LAS unsigned char*)lds; F.MISC = (volatile LAS unsigned*)(F.lds + MISC_OFF);
    F.wave = __builtin_amdgcn_readfirstlane(threadIdx.x >> 6);
    F.G = gridDim.x; { const int bx = blockIdx.x; F.vcu = (F.G % 8 == 0) ? (bx % 8) * (F.G / 8) + bx / 8 : bx; }
    unsigned char* ws = args.ws;
    F.ctl = (gu32*)(ws);
    for (int u = FTID; u < (LDS_BYTES - LDSCTL_OFF) / 4; u += NWAVES * 64) ((LAS unsigned*)(F.lds + LDSCTL_OFF))[u] = 0u;
    __syncthreads();
    XcdBarrier bar = xcd_barrier_post((unsigned*)(F.ctl + CW_BAR) + args.li * XCD_BAR_WORDS, F.MISC + 8);
    const int lo = args.ph_lo, hi = args.ph_hi;
#define IN(k) (lo <= (k) && (k) < hi)
#define BOTH(k) (IN(k) && IN((k) + 1))
    f16_t* WinT = (f16_t*)(ws + WS_WINT); f16_t* H16 = (f16_t*)(ws + WS_H16); f16_t* PROJ16 = (f16_t*)(ws + WS_PROJ16); float* DECAY = (float*)(ws + WS_DECAY); f16_t* KMOD = (f16_t*)(ws + WS_KMOD); f16_t* A16 = (f16_t*)(ws + WS_A16); f16_t* B16 = (f16_t*)(ws + WS_B16); f16_t* G16 = (f16_t*)(ws + WS_G16);
    f16_t* WoutT = (f16_t*)(ws + WS_WOUTT); f16_t* GateT = (f16_t*)(ws + WS_GATET); f16_t* PleT = (f16_t*)(ws + WS_PLET); f16_t* P16 = (f16_t*)(ws + WS_P16);
    f16_t* PW16 = (f16_t*)(ws + WS_PW16); f16_t* Y16 = (f16_t*)(ws + WS_Y16); float* ROWRS = (float*)(ws + WS_ROWRS);
    float* RT = (float*)(ws + WS_RT); f16_t* GUT = (f16_t*)(ws + WS_GUT); f16_t* DNT = (f16_t*)(ws + WS_DNT); f16_t* HID = (f16_t*)(ws + WS_HID); f16_t* FFN16 = (f16_t*)(ws + WS_FFN16); f16_t* H1_16 = (f16_t*)(ws + WS_H1_16);
    int* cnt = (int*)(ws + WS_CNT); int* ltok = (int*)(ws + WS_LTOK); int* lpair = (int*)(ws + WS_LPAIR); float* pairw = (float*)(ws + WS_PAIRW);
    const int gw = F.vcu * NWAVES + F.wave, NGW = F.G * NWAVES;
    if (IN(0)) {
        LAS float* scr = (LAS float*)(F.lds + RING_OFF + F.wave * 16384);
        constexpr int I_IN = (D / 64) * (NPROJ / 32);
        for (int it = gw; it < I_IN; it += NGW) p0_transpose_item(args.in[5], D, NPROJ, WinT, 0, scr, it, FLANE);
        constexpr int I_SQ = (D / 64) * (D / 32), I_PLE = (256 / 64) * (D / 32);
        for (int it = gw; it < 2 * I_SQ + I_PLE; it += NGW) {
            if (it < I_SQ) p0_transpose_item(args.in[22], D, D, WoutT, 0, scr, it, FLANE);
            else if (it < 2 * I_SQ) p0_transpose_item(args.in[36], D, D, GateT, 0, scr, it - I_SQ, FLANE);
            else p0_transpose_item(args.in[34], 256, D, PleT, 0, scr, it - 2 * I_SQ, FLANE);
        }
        { const GAS f32x4* pi = (const GAS f32x4*)args.in[1]; GAS unsigned long long* po = (GAS unsigned long long*)P16;
          for (int i = blockIdx.x * 512 + FTID; i < T * 256 / 4; i += F.G * 512) { const f32x4 v = pi[i]; po[i] = (unsigned long long)pk2h(v.x, v.y) | ((unsigned long long)pk2h(v.z, v.w) << 32); } }
        { GAS v4u* z = (GAS v4u*)(WinT + (size_t)NPROJ * D); const int nz = (PN - NPROJ) * D * 2 / 16;
          for (int i = blockIdx.x * 512 + FTID; i < nz; i += F.G * 512) z[i] = (v4u){0u, 0u, 0u, 0u}; }
        if (blockIdx.x == 0) {
            const int tid = FTID; float* lamp = (float*)(ws + WS_LAM); float* biasT = (float*)(ws + WS_BIAS);
            if (tid < 64) { const float a = wave_sum_b(args.in[6][tid] * args.in[7][tid]), b2 = wave_sum_b(args.in[8][tid] * args.in[9][tid]); if (tid == 0) *lamp = expf(a) - expf(b2) + LAMBDA_INIT; }
            for (int i = tid; i < 8 * 129; i += 512) { const int hh = i / 129, n = i % 129; int bucket;
                if (n < 16) bucket = n; else { const int large = 16 + (int)(logf((float)n / 16.f) / 2.0794415416798357f * 16.f); bucket = large < 31 ? large : 31; }
                biasT[i] = args.in[4][bucket * 8 + hh]; }
        }
        for (int m = gw; m < T; m += NGW) ln_row_dual(FLANE, args.in[0] + (size_t)m * D, args.in[2], args.in[3], args.out + (size_t)m * D, H16 + (size_t)m * D);
        if (BOTH(0)) xcd_barrier(bar);
    }
    if (IN(1)) {
        pg8::Gemm g{H16, WinT, T, PN, D}; pg8::StaticOrder S; S.init(T, PN, F.G, (int)blockIdx.x);
        pg8::EpiF16 E{PROJ16, PN, 4, att::C2};
        pg8::gemm_phase<pg8::EpiF16, pg8::StaticOrder, true>(F.lds + RING_OFF, g, S, E, F.wave);
        { pg8::Gemm g2{P16, PleT, T, D, 256}; pg8::StaticOrder S2; S2.init(T, D, F.G, (int)blockIdx.x);
          pg8::EpiF16 E2{PW16, D, 0, 1.f};
          pg8::gemm_phase<pg8::EpiF16, pg8::StaticOrder, true>(F.lds + RING_OFF, g2, S2, E2, F.wave); }
        {
            __syncthreads();
        LAS float* scr = (LAS float*)(F.lds + RING_OFF + F.wave * 16384);
        for (int it = gw; it < NE * 1536; it += NGW) {
            const int e = it / 1536, r = it % 1536;
            if (r < 512) p0_transpose_item_gu(args.in[29] + (size_t)e * D * 512, D, 512, GUT + (size_t)e * 1024 * D, 0, scr, r, FLANE);
            else if (r < 1024) p0_transpose_item_gu(args.in[30] + (size_t)e * D * 512, D, 512, GUT + (size_t)e * 1024 * D, 1, scr, r - 512, FLANE);
            else p0_transpose_item_gu(args.in[31] + (size_t)e * 512 * D, 512, D, DNT + (size_t)e * D * 512, -1, scr, r - 1024, FLANE);
        }
        for (int i = blockIdx.x * 512 + FTID; i < 36 * D; i += F.G * 512) { const int e = i / D, d = i % D; RT[i] = e < 4 ? args.in[25][d * 4 + e] : args.in[27][d * 32 + (e - 4)]; }
            asm volatile("s_waitcnt vmcnt(0) lgkmcnt(0)" ::: "memory"); __syncthreads();
        }
        if (BOTH(1)) xcd_barrier(bar);
    }
    if (IN(2)) {
        for (int tile = F.vcu; tile < T / 32; tile += F.G)
            rwkv_prep_tile(F, tile, PROJ16, args.in[11], args.in[12], args.in[13], args.in[14], args.in[15], args.in[16], args.in[17], args.in[18], DECAY, KMOD, A16, B16, G16);
        if (BOTH(2)) xcd_barrier(bar);
    }
    if (IN(3)) {
        if (F.vcu < 64) rwkv_scan_unit(F, F.vcu, PROJ16, args.in[11], DECAY, KMOD, A16, B16, G16, args.in[19], args.in[20], args.in[21], Y16);
        else if (F.vcu < 256) {
            const int a = F.vcu - 64, bh = a / 6, L0 = a % 6;
            const float lam = *(const float*)(ws + WS_LAM); const float* biasG = (const float*)(ws + WS_BIAS) + (bh & 7) * 129;
            att::attn_unit<8>(F.lds + RING_OFF, F.wave, bh >> 3, bh & 7, 15 - L0, PROJ16, Y16, biasG, lam, args.in[10]);
            att::attn_unit<8>(F.lds + RING_OFF, F.wave, bh >> 3, bh & 7, 4 + L0, PROJ16, Y16, biasG, lam, args.in[10]);
            if (L0 < 4) att::attn_unit<8>(F.lds + RING_OFF, F.wave, bh >> 3, bh & 7, 3 - L0, PROJ16, Y16, biasG, lam, args.in[10]);
        }
        if (BOTH(3)) xcd_barrier(bar);
    }
    if (IN(4)) {
        pg8::Gemm g{Y16, WoutT, T, D, D}; pg8::StaticOrder S; S.init(T, D, F.G, (int)blockIdx.x);
        pg8::EpiResF32 E{args.out, D, ALPHA};
        pg8::gemm_phase<pg8::EpiResF32, pg8::StaticOrder, true>(F.lds + RING_OFF, g, S, E, F.wave);
        if (BOTH(4)) xcd_barrier(bar);
    }
    if (IN(5)) {
        const int lane = FLANE;
        for (int blk = F.vcu; blk < T / 32; blk += F.G)
            for (int pass = 0; pass < 2; ++pass) {
                const int r0 = blk * 32 + F.wave * 4 + pass * 2;
                f32x4 v0[8], v1[8];
                { const GAS f32x4* xr = (const GAS f32x4*)(args.out + (size_t)r0 * D) + lane;
#pragma unroll
                  for (int j = 0; j < 8; ++j) { v0[j] = xr[64 * j]; v1[j] = xr[64 * j + D / 4]; } }
                ln_regs(lane, v0, args.in[23], args.in[24], args.out + (size_t)r0 * D, H1_16 + (size_t)r0 * D);
                ln_regs(lane, v1, args.in[23], args.in[24], args.out + (size_t)(r0 + 1) * D, H1_16 + (size_t)(r0 + 1) * D);
                LAS float* lg = (LAS float*)(F.lds + RING_OFF) + F.wave * 128;
                const GAS f32x4* rt4 = (const GAS f32x4*)RT + lane;
#pragma unroll 1
                for (int ec = 0; ec < 6; ++ec) {
                    float a0[6], a1[6];
#pragma unroll
                    for (int e = 0; e < 6; ++e) { a0[e] = 0.f; a1[e] = 0.f; }
#pragma unroll
                    for (int j = 0; j < 8; ++j)
#pragma unroll
                        for (int e = 0; e < 6; ++e) { const f32x4 w = rt4[(ec * 6 + e) * (D / 4) + 64 * j];
                            a0[e] += (v0[j].x * w.x + v0[j].y * w.y) + (v0[j].z * w.z + v0[j].w * w.w);
                            a1[e] += (v1[j].x * w.x + v1[j].y * w.y) + (v1[j].z * w.z + v1[j].w * w.w); }
#pragma unroll
                    for (int e = 0; e < 6; ++e) { a0[e] = wave_sum_b(a0[e]); a1[e] = wave_sum_b(a1[e]); }
                    if (lane == 0) {
#pragma unroll
                        for (int e = 0; e < 6; ++e) { lg[ec * 6 + e] = a0[e]; lg[64 + ec * 6 + e] = a1[e]; } }
                }
                LDS_WAIT();
                if (lane == 0) { float a0[36], a1[36];
#pragma unroll
                    for (int e = 0; e < 36; ++e) { a0[e] = lg[e]; a1[e] = lg[64 + e]; }
                    route_token(r0, a0, args.in[26], args.in[28], cnt, ltok, lpair, pairw); route_token(r0 + 1, a1, args.in[26], args.in[28], cnt, ltok, lpair, pairw); }
                LDS_WAIT();
            }
        if (BOTH(5)) xcd_barrier(bar);
    }
    if (IN(6)) {
        build_moe_table(F, cnt);
        pg8::Gemm g{H1_16, GUT, 0, 0, D}; pg8::MoeOrder<true> S{(const LAS int*)(F.lds + TAB_OFF), ltok, F.vcu, F.G, 4, (size_t)1024 * D * 2};
        pg8::EpiGU E{HID};
        pg8::gemm_phase<pg8::EpiGU, pg8::MoeOrder<true>, true>(F.lds + RING_OFF, g, S, E, F.wave);
        if (BOTH(6)) xcd_barrier(bar);
    }
    if (IN(7)) {
        build_moe_table(F, cnt);
        pg8::Gemm g{HID, DNT, 0, 0, 512}; pg8::MoeOrder<false> S{(const LAS int*)(F.lds + TAB_OFF), nullptr, F.vcu, F.G, 8, (size_t)D * 512 * 2};
        pg8::EpiDown E{FFN16, lpair};
        pg8::gemm_phase<pg8::EpiDown, pg8::MoeOrder<false>, true>(F.lds + RING_OFF, g, S, E, F.wave);
        if (BOTH(7)) xcd_barrier(bar);
    }
    if (IN(8)) {
        typedef _Float16 h4_t __attribute__((ext_vector_type(4)));
        const int lane = FLANE;
        for (int m = gw; m < T; m += NGW) {
            f32x4 v[8]; const GAS f32x4* xr = (const GAS f32x4*)(args.out + (size_t)m * D) + lane;
            const GAS h4_t* f0 = (const GAS h4_t*)(FFN16 + (size_t)(2 * m) * D) + lane; const GAS h4_t* f1 = (const GAS h4_t*)(FFN16 + (size_t)(2 * m + 1) * D) + lane;
            const GAS h4_t* pr = (const GAS h4_t*)(PW16 + (size_t)m * D) + lane;
            const float w0 = pairw[2 * m], w1 = pairw[2 * m + 1]; float q = 0.f;
#pragma unroll
            for (int j = 0; j < 8; ++j) { const f32x4 x = xr[64 * j]; const h4_t a = f0[64 * j], c = f1[64 * j], pv = pr[64 * j];
                v[j].x = ALPHA * x.x + w0 * (float)a[0] + w1 * (float)c[0]; v[j].y = ALPHA * x.y + w0 * (float)a[1] + w1 * (float)c[1];
                v[j].z = ALPHA * x.z + w0 * (float)a[2] + w1 * (float)c[2]; v[j].w = ALPHA * x.w + w0 * (float)a[3] + w1 * (float)c[3];
                q += ((float)pv[0] * (float)pv[0] + (float)pv[1] * (float)pv[1]) + ((float)pv[2] * (float)pv[2] + (float)pv[3] * (float)pv[3]); }
            ln_regs(lane, v, args.in[32], args.in[33], args.out + (size_t)m * D, Y16 + (size_t)m * D);
            q = wave_sum_b(q);
            if (lane == 0) ROWRS[m] = 1.0f / sqrtf(q * (1.f / D) + LN_EPS);
        }
        if (BOTH(8)) xcd_barrier(bar);
    }
    if (IN(9)) {
        pg8::Gemm g{Y16, GateT, T, D, D}; pg8::StaticOrder S; S.init(T, D, F.G, (int)blockIdx.x);
        pg8::EpiFinal E{args.out, D, PW16, ROWRS, args.in[35]};
        pg8::gemm_phase<pg8::EpiFinal, pg8::StaticOrder, true>(F.lds + RING_OFF, g, S, E, F.wave);
    }
#undef IN
#undef BOTH
}

extern "C" void kernel_launch(void* const* d_in, const int* in_sizes, int n_in, void* d_out, int out_size, void* d_ws, size_t ws_size, hipStream_t stream) {
    static int grid = 0;
    if (grid == 0) {
        if (ws_size < WS_END2 || n_in != 37 || out_size != T * D) { fprintf(stderr, "kernel_launch: bad ws/n_in/out: %zu %d %d\n", ws_size, n_in, out_size); grid = -1; return; }
        int dev = 0, cus = 0;
        if (hipGetDevice(&dev) != hipSuccess || hipDeviceGetAttribute(&cus, hipDeviceAttributeMultiprocessorCount, dev) != hipSuccess) { grid = -1; return; }
        if (hipFuncSetAttribute((const void*)mega_fwd, hipFuncAttributeMaxDynamicSharedMemorySize, LDS_BYTES) != hipSuccess) { fprintf(stderr, "kernel_launch: hipFuncSetAttribute failed\n"); grid = -1; return; }
        if (cus != 256) { fprintf(stderr, "kernel_launch: built for a 256-CU device, found %d\n", cus); grid = -1; return; }
        grid = cus;
    }
    if (grid < 0) return;
    (void)hipMemsetAsync(d_ws, 0, CTL_ZERO_BYTES, stream);
    Args a{}; for (int i = 0; i < 37; ++i) a.in[i] = (const float*)d_in[i]; a.out = (float*)d_out; a.ws = (unsigned char*)d_ws; a.ph_lo = 0; a.ph_hi = 10; a.li = 0;
    hipLaunchKernelGGL(mega_fwd, dim3(grid), dim3(NWAVES * 64), LDS_BYTES, stream, a);
}
```

```cpp
#include <hip/hip_runtime.h>
#include <cstdio>
#include <cstdint>
#include <cmath>

constexpr int NB = 4, S = 2048, D = 2048, T = NB * S;
constexpr int NPROJ = 6432;
constexpr int RWK = 1024;
constexpr int COL_Q = 0, COL_K = 1024, COL_V = 2048, COL_RW = 3072;
constexpr int NH = 8, NRH = 16;
constexpr int NE = 32;
constexpr float LN_EPS = 1e-5f;
constexpr float ALPHA = 1.189207115002721f;
constexpr float LAMBDA_INIT = 0.2f;

constexpr size_t MiB = 1u << 20;
constexpr size_t WS_CNT = 0;
constexpr size_t WS_LTOK = 1 * MiB;
constexpr size_t WS_LPAIR = 2 * MiB;
constexpr size_t WS_PAIRW = 3 * MiB;
constexpr size_t WS_RT = 3 * MiB + 128 * 1024;
constexpr size_t WS_LAM = 3 * MiB + 512 * 1024;
constexpr size_t WS_BIAS = 3 * MiB + 512 * 1024 + 1024;
constexpr size_t WS_ROWRS = 3 * MiB + 768 * 1024;
constexpr size_t WS_WINT = 4 * MiB;
constexpr size_t WS_WOUTT = 30 * MiB;
constexpr size_t WS_GATET = 38 * MiB;
constexpr size_t WS_PLET = 46 * MiB;
constexpr size_t WS_P16 = 47 * MiB;
constexpr size_t WS_CHK = 52 * MiB;
constexpr size_t WS_BONUS = 148 * MiB;
constexpr size_t WS_GUT = 244 * MiB;
constexpr size_t WS_DNT = 372 * MiB;
constexpr size_t WS_PROJ16 = 244 * MiB;
constexpr size_t WS_FFN16 = 52 * MiB;
constexpr size_t WS_HID = 116 * MiB;
constexpr size_t WS_DECAY = 348 * MiB;
constexpr size_t WS_KMOD = 380 * MiB;
constexpr size_t WS_A16 = 396 * MiB;
constexpr size_t WS_B16 = 412 * MiB;
constexpr size_t WS_G16 = 428 * MiB;
constexpr size_t WS_H16 = 444 * MiB;
constexpr size_t WS_H1_16 = WS_H16;
constexpr size_t WS_Y16 = 476 * MiB;
constexpr size_t WS_PW16 = 508 * MiB;
constexpr size_t WS_END2 = 540 * MiB;

namespace pg8 {
#define PG8_LAS __attribute__((address_space(3)))
typedef unsigned short f16_t;
typedef _Float16 f16x8 __attribute__((ext_vector_type(8)));
typedef float f32x4 __attribute__((ext_vector_type(4)));
typedef unsigned u32x4 __attribute__((ext_vector_type(4)));
constexpr int BM = 256, BK = 64, HALF = 128, HTB = HALF * BK * 2  , STAGE_BYTES = 8 * HTB, NXCD = 8, WGM = 8;

__host__ __device__ __forceinline__ int lds_byte(int r, int c) { const int st = (r >> 4) * 2 + (c >> 5), rr = r & 15, cc = c & 31, ob = rr * 64 + cc * 2; return st * 1024 + (ob ^ (((ob >> 9) & 1) << 5)); }
__host__ __device__ __forceinline__ void stage_rc(int b, int& R, int& C) { const int st = b / 1024, sb = b % 1024, swz = sb ^ (((sb >> 9) & 1) << 5); R = (st >> 1) * 16 + swz / 64; C = (st & 1) * 32 + (swz % 64) / 2; }
__host__ __device__ __forceinline__ int perm32(int rho) { const int n = rho >> 4, i = rho & 15; return 8 * (i >> 2) + 4 * n + (i & 3); }

__device__ __forceinline__ int lane_id() { int l; asm volatile("v_mbcnt_lo_u32_b32 %0, -1, 0\n\tv_mbcnt_hi_u32_b32 %0, -1, %0" : "=v"(l)); return l; }
struct Unit { int pm, pn, e, rb, cnt; };
struct Gemm { const f16_t* A; const f16_t* Bt; int M, N, K; };

struct StaticOrder {
    int nM, nN, nwg, G, c;
    __host__ __device__ void init(int M, int N, int G_, int c_) { nM = M / BM; nN = N / BM; nwg = nM * nN; G = G_; c = c_; }
    __host__ __device__ bool next(int i, Unit& u) const {
        const long L = (long)i * G + c; if (L >= nwg) return false;
        int wgid = (int)L; { const int q = nwg / NXCD, r = nwg % NXCD, xcd = wgid % NXCD, off = wgid / NXCD; wgid = (xcd < r ? xcd * (q + 1) : r * (q + 1) + (xcd - r) * q) + off; }
        const int nig = WGM * nN, gid = wgid / nig, fm = gid * WGM, gsz = (nM - fm) < WGM ? (nM - fm) : WGM;
        u.pm = fm + ((wgid % nig) % gsz); u.pn = (wgid % nig) / gsz; return true;
    }
    __device__ __forceinline__ void a_ready(const Unit&) const {}
    __device__ __forceinline__ void done(const Unit&) const {}
    __device__ __forceinline__ const char* a_base(const Gemm& g, const Unit& u) const { return (const char*)g.A + (size_t)u.pm * ((size_t)BM * g.K * 2); }
    __device__ __forceinline__ const char* b_base(const Gemm& g, const Unit& u) const { return (const char*)g.Bt + (size_t)u.pn * ((size_t)BM * g.K * 2); }
    __device__ __forceinline__ void a_voff(const Gemm& g, const Unit&, int tid, unsigned (&va)[2][2]) const {
#pragma unroll
        for (int i = 0; i < 2; ++i) { int R, C; stage_rc(tid * 16 + i * 8192, R, C); va[0][i] = (unsigned)(R * g.K + C) * 2u; va[1][i] = va[0][i] + (unsigned)(HALF * g.K * 2); }
    }
};
template <bool GATHER> struct MoeOrder {
    const PG8_LAS int* tab; const int* list; int vcu, G, ntn; size_t estride;
    __device__ __forceinline__ bool next(int i, Unit& u) const {
        const int L = vcu + i * G; const int tot = tab[64] * ntn; if (L >= tot) return false;
        int e = 0; while (tab[33 + e] * ntn <= L) ++e;
        const int nb = tab[33 + e] - tab[32 + e], q = L - tab[32 + e] * ntn;
        u.e = __builtin_amdgcn_readfirstlane(e); u.pn = __builtin_amdgcn_readfirstlane(q / nb); u.rb = __builtin_amdgcn_readfirstlane(q % nb);
        u.pm = __builtin_amdgcn_readfirstlane(tab[32 + e] + q % nb); u.cnt = __builtin_amdgcn_readfirstlane(tab[e]); return true;
    }
    __device__ __forceinline__ void a_ready(const Unit&) const {}
    __device__ __forceinline__ void done(const Unit&) const {}
    __device__ __forceinline__ const char* a_base(const Gemm& g, const Unit& u) const { return GATHER ? (const char*)g.A : (const char*)g.A + (size_t)u.pm * ((size_t)BM * g.K * 2); }
    __device__ __forceinline__ const char* b_base(const Gemm& g, const Unit& u) const { return (const char*)g.Bt + (size_t)u.e * estride + (size_t)u.pn * ((size_t)BM * g.K * 2); }
    __device__ __forceinline__ void a_voff(const Gemm& g, const Unit& u, int tid, unsigned (&va)[2][2]) const {
#pragma unroll
        for (int i = 0; i < 2; ++i) { int R, C; stage_rc(tid * 16 + i * 8192, R, C);
            if (GATHER) {
#pragma unroll
                for (int h = 0; h < 2; ++h) { int idx = u.rb * BM + h * HALF + R; idx = idx < u.cnt ? idx : u.cnt - 1; const int tok = list[u.e * 8192 + idx]; va[h][i] = (unsigned)(tok * g.K + C) * 2u; }
            } else { va[0][i] = (unsigned)(R * g.K + C) * 2u; va[1][i] = va[0][i] + (unsigned)(HALF * g.K * 2); } }
    }
};


typedef _Float16 h2_t __attribute__((ext_vector_type(2)));
__device__ __forceinline__ unsigned cvt_pk_f16(float lo, float hi) { h2_t v = {(_Float16)lo, (_Float16)hi}; return __builtin_bit_cast(unsigned, v); }
struct EpiF16 {
    static constexpr bool PERM = true, AFTER_DRAIN = false;
    f16_t* O; int ldc; int ntile0; float scale0;
    __device__ __forceinline__ void operator()(const f32x4 (&acc)[2][2][4][2], const Unit& u, int wr, int wc, int fr, int fq) const {
        const int row0 = u.pm * BM + wr * 64 + fr; const int col0 = u.pn * BM + wc * 32 + 8 * fq;
        const float sc = (u.pn < ntile0) ? scale0 : 1.f;
#pragma unroll
        for (int ai = 0; ai < 2; ++ai)
#pragma unroll
            for (int m = 0; m < 4; ++m) { f16_t* rowp = O + (size_t)(row0 + ai * HALF + m * 16) * ldc + col0;
#pragma unroll
                for (int bj = 0; bj < 2; ++bj) { f32x4 v0 = acc[ai][bj][m][0] * sc, v1 = acc[ai][bj][m][1] * sc;
                    u32x4 w; w.x = cvt_pk_f16(v0[0], v0[1]); w.y = cvt_pk_f16(v0[2], v0[3]); w.z = cvt_pk_f16(v1[0], v1[1]); w.w = cvt_pk_f16(v1[2], v1[3]);
                    *(u32x4*)(rowp + bj * HALF) = w; } }
    }
};


struct EpiResF32 {
    static constexpr bool PERM = false, AFTER_DRAIN = false;
    float* io; int ldc; float alpha;
    __device__ __forceinline__ void operator()(const f32x4 (&acc)[2][2][4][2], const Unit& u, int wr, int wc, int fr, int fq) const {
        const int row0 = u.pm * BM + wr * 64 + fr; const int col0 = u.pn * BM + wc * 32 + 4 * fq;
#pragma unroll
        for (int ai = 0; ai < 2; ++ai)
#pragma unroll
            for (int m = 0; m < 4; ++m) { float* rowp = io + (size_t)(row0 + ai * HALF + m * 16) * ldc + col0;
#pragma unroll
                for (int bj = 0; bj < 2; ++bj)
#pragma unroll
                    for (int n = 0; n < 2; ++n) { f32x4* p = (f32x4*)(rowp + bj * HALF + n * 16); const f32x4 r = *p; *p = r * alpha + acc[ai][bj][m][n]; } }
    }
};
struct EpiFinal {
    static constexpr bool PERM = false, AFTER_DRAIN = false;
    float* io; int ldc; const f16_t* pw; const float* rowrs; const float* g;
    __device__ __forceinline__ void operator()(const f32x4 (&acc)[2][2][4][2], const Unit& u, int wr, int wc, int fr, int fq) const {
        typedef _Float16 h4_t __attribute__((ext_vector_type(4)));
        const int row0 = u.pm * BM + wr * 64 + fr; const int col0 = u.pn * BM + wc * 32 + 4 * fq;
#pragma unroll
        for (int ai = 0; ai < 2; ++ai)
#pragma unroll
            for (int m = 0; m < 4; ++m) { const int row = row0 + ai * HALF + m * 16; const size_t off = (size_t)row * ldc + col0;
                const float rs = rowrs[row];
#pragma unroll
                for (int bj = 0; bj < 2; ++bj)
#pragma unroll
                    for (int n = 0; n < 2; ++n) { f32x4* p = (f32x4*)(io + off + bj * HALF + n * 16); const f32x4 hv = *p; const h4_t pv = *(const h4_t*)(pw + off + bj * HALF + n * 16);
                        const f32x4 gv = *(const f32x4*)(g + col0 + bj * HALF + n * 16);
                        const f32x4 a = acc[ai][bj][m][n]; f32x4 o;
#pragma unroll
                        for (int c = 0; c < 4; ++c) o[c] = hv[c] + (1.f / (1.f + __expf(-a[c]))) * ((float)pv[c] * rs) * gv[c];
                        *p = o; }
                asm volatile("" ::: "memory"); }
    }
};

struct EpiGU {
    static constexpr bool PERM = true, AFTER_DRAIN = false;
    f16_t* O;
    __device__ __forceinline__ void operator()(const f32x4 (&acc)[2][2][4][2], const Unit& u, int wr, int wc, int fr, int fq) const {
        const int row0 = u.pm * BM + wr * 64 + fr; const int col0 = u.pn * HALF + wc * 32 + 8 * fq;
#pragma unroll
        for (int ai = 0; ai < 2; ++ai)
#pragma unroll
            for (int m = 0; m < 4; ++m) { f16_t* rowp = O + (size_t)(row0 + ai * HALF + m * 16) * 512 + col0; float o[8];
#pragma unroll
                for (int n = 0; n < 2; ++n)
#pragma unroll
                    for (int c = 0; c < 4; ++c) { const float gt = acc[ai][0][m][n][c], up = acc[ai][1][m][n][c]; o[n * 4 + c] = gt / (1.f + __expf(-gt)) * up; }
                u32x4 w; w.x = cvt_pk_f16(o[0], o[1]); w.y = cvt_pk_f16(o[2], o[3]); w.z = cvt_pk_f16(o[4], o[5]); w.w = cvt_pk_f16(o[6], o[7]);
                *(u32x4*)rowp = w; }
    }
};
struct EpiDown {
    static constexpr bool PERM = true, AFTER_DRAIN = false;
    f16_t* O; const int* lpair;
    __device__ __forceinline__ void operator()(const f32x4 (&acc)[2][2][4][2], const Unit& u, int wr, int wc, int fr, int fq) const {
        const int r0 = u.rb * BM + wr * 64 + fr; const int col0 = u.pn * BM + wc * 32 + 8 * fq;
#pragma unroll
        for (int ai = 0; ai < 2; ++ai)
#pragma unroll
            for (int m = 0; m < 4; ++m) { const int r = r0 + ai * HALF + m * 16;
                if (r < u.cnt) { const int pair = lpair[u.e * 8192 + r]; f16_t* rowp = O + (size_t)pair * 2048 + col0;
#pragma unroll
                    for (int bj = 0; bj < 2; ++bj) { const f32x4 v0 = acc[ai][bj][m][0], v1 = acc[ai][bj][m][1];
                        u32x4 w; w.x = cvt_pk_f16(v0[0], v0[1]); w.y = cvt_pk_f16(v0[2], v0[3]); w.z = cvt_pk_f16(v1[0], v1[1]); w.w = cvt_pk_f16(v1[2], v1[3]);
                        *(u32x4*)(rowp + bj * HALF) = w; } } }
    }
};
template <class Epi, class Sched, bool ALIGN_EPI = false, bool SP2 = true>
__device__ __forceinline__ void gemm_phase(PG8_LAS unsigned char* lds, const Gemm g, const Sched& S, const Epi& E, const int wid) {
    static_assert(SP2, "only the SP2 K-loop is kept in this file");
    const int lane = lane_id(), tid = wid * 64 + lane, wr = wid >> 2, wc = wid & 3, fr = lane & 15, fq = lane >> 4;
    const int K = g.K, nt = K / BK;
    unsigned voffB[2];
#pragma unroll
    for (int i = 0; i < 2; ++i) { int R, C; stage_rc(tid * 16 + i * 8192, R, C); const int Rb = Epi::PERM ? ((R & ~31) + perm32(R & 31)) : R;
        voffB[i] = (unsigned)(Rb * K + C) * 2u; }
    const size_t kstep = (size_t)(BK * 2);
    const size_t hstep = (size_t)HALF * K * 2;
    const unsigned ldsw = (unsigned)wid * 1024u;
    const int aoff = lds_byte(wr * 64 + fr, fq * 8), boff = lds_byte(wc * 32 + fr, fq * 8);
#define PG8_SA(b, h) (((b) * 2 + (h)) * HTB)
#define PG8_SB(b, h) ((4 + (b) * 2 + (h)) * HTB)
#define PG8_STAGE(bufoff, gbase, voff) do { _Pragma("unroll") for (int _i = 0; _i < 2; ++_i) \
        __builtin_amdgcn_global_load_lds((const unsigned*)((const char*)(gbase) + (voff)[_i]), (PG8_LAS unsigned*)(lds + (bufoff) + ldsw + _i * 8192), 16, 0, 0); } while (0)
#define PG8_LDA(dst, b, h) do { _Pragma("unroll") for (int m = 0; m < 4; ++m) _Pragma("unroll") for (int k = 0; k < 2; ++k) dst[m][k] = *(const PG8_LAS f16x8*)(lds + PG8_SA(b, h) + aoff + m * 2048 + k * 1024); } while (0)
#define PG8_LDB(dst, b, h) do { _Pragma("unroll") for (int n = 0; n < 2; ++n) _Pragma("unroll") for (int k = 0; k < 2; ++k) dst[n][k] = *(const PG8_LAS f16x8*)(lds + PG8_SB(b, h) + boff + n * 2048 + k * 1024); } while (0)
#define PG8_MMA(ai, bj, At, Bt) do { __builtin_amdgcn_s_setprio(1); _Pragma("unroll") for (int m = 0; m < 4; ++m) _Pragma("unroll") for (int n = 0; n < 2; ++n) _Pragma("unroll") for (int k = 0; k < 2; ++k) \
        acc[ai][bj][m][n] = __builtin_amdgcn_mfma_f32_16x16x32_f16(Bt[n][k], At[m][k], acc[ai][bj][m][n], 0, 0, 0); __builtin_amdgcn_s_setprio(0); } while (0)
#define PG8_WAIT_V(n) asm volatile("s_waitcnt vmcnt(" #n ")" ::: "memory")
#define PG8_WAIT_L(n) asm volatile("s_waitcnt lgkmcnt(" #n ")" ::: "memory")
#define PG8_BAR __builtin_amdgcn_s_barrier()
#define PG8_SCHED __builtin_amdgcn_sched_barrier(0)
    Unit cur, nxt; int ui = 0;
    if (!S.next(0, cur)) return;
    f32x4 acc[2][2][4][2];
#pragma unroll
    for (int a = 0; a < 2; ++a)
#pragma unroll
        for (int b = 0; b < 2; ++b)
#pragma unroll
            for (int m = 0; m < 4; ++m)
#pragma unroll
                for (int n = 0; n < 2; ++n) acc[a][b][m][n] = (f32x4){0.f, 0.f, 0.f, 0.f};
    f16x8 At[4][2], B0[2][2], B1[2][2];
    const char* cA = S.a_base(g, cur); const char* cB = S.b_base(g, cur);
    unsigned vaC[2][2];
    S.a_voff(g, cur, tid, vaC);
    S.a_ready(cur);
    PG8_STAGE(PG8_SB(0, 0), cB, voffB); PG8_STAGE(PG8_SB(0, 1), cB + hstep, voffB); PG8_STAGE(PG8_SA(0, 0), cA, vaC[0]); PG8_STAGE(PG8_SA(0, 1), cA, vaC[1]);
    if (wr == 1) PG8_BAR;
    PG8_WAIT_V(2); PG8_BAR;
    PG8_STAGE(PG8_SB(1, 0), cB + kstep, voffB); PG8_STAGE(PG8_SA(1, 0), cA + kstep, vaC[0]); PG8_STAGE(PG8_SB(1, 1), cB + hstep + kstep, voffB);
    PG8_WAIT_V(6); PG8_BAR;
    for (;;) {
        const bool has_next = S.next(ui + 1, nxt);
        const char* nA = has_next ? S.a_base(g, nxt) : cA; const char* nB = has_next ? S.b_base(g, nxt) : cB;
        for (int t = 0; t < nt; t += 2) {
            const bool last = (t == nt - 2);

            const char* a1 = cA + (size_t)(t + 1) * kstep;
            const char* a2 = last ? nA : cA + (size_t)(t + 2) * kstep; const char* b2 = last ? nB : cB + (size_t)(t + 2) * kstep;
            const char* a3 = a2 + kstep; const char* b3 = b2 + kstep;
            if (last && has_next) S.a_ready(nxt);
            PG8_LDB(B0, 0, 0); PG8_LDB(B1, 0, 1); PG8_SCHED; PG8_LDA(At, 0, 0); PG8_STAGE(PG8_SA(1, 1), a1, vaC[1]);
            if (last && has_next) S.a_voff(g, nxt, wid * 64 + lane_id(), vaC);
            PG8_WAIT_V(8); PG8_WAIT_L(0); PG8_BAR; PG8_MMA(0, 0, At, B0); PG8_MMA(0, 1, At, B1); PG8_BAR; PG8_SCHED;
            PG8_LDA(At, 0, 1); PG8_STAGE(PG8_SB(0, 0), b2, voffB); PG8_STAGE(PG8_SB(0, 1), b2 + hstep, voffB); PG8_STAGE(PG8_SA(0, 0), a2, vaC[0]);
            PG8_WAIT_V(8); PG8_WAIT_L(0); PG8_BAR; PG8_MMA(1, 0, At, B0); PG8_MMA(1, 1, At, B1); PG8_BAR; PG8_SCHED;
            PG8_LDB(B0, 1, 0); PG8_LDB(B1, 1, 1); PG8_SCHED; PG8_LDA(At, 1, 0); PG8_STAGE(PG8_SA(0, 1), a2, vaC[1]);
            PG8_WAIT_V(8); PG8_WAIT_L(0); PG8_BAR; PG8_MMA(0, 0, At, B0); PG8_MMA(0, 1, At, B1); PG8_BAR; PG8_SCHED;
            PG8_LDA(At, 1, 1); PG8_STAGE(PG8_SB(1, 0), b3, voffB); PG8_STAGE(PG8_SB(1, 1), b3 + hstep, voffB); PG8_STAGE(PG8_SA(1, 0), a3, vaC[0]);
            PG8_WAIT_V(8); PG8_WAIT_L(0); PG8_BAR; PG8_MMA(1, 0, At, B0); PG8_MMA(1, 1, At, B1); PG8_BAR; PG8_SCHED;
        }
        if constexpr (ALIGN_EPI) { if (wr == 0) PG8_BAR; }
        { const int l2 = lane_id(); E(acc, cur, wr, wc, l2 & 15, l2 >> 4); } S.done(cur);
        if (!has_next) break;
#pragma unroll
        for (int a = 0; a < 2; ++a)
#pragma unroll
            for (int b = 0; b < 2; ++b)
#pragma unroll
                for (int m = 0; m < 4; ++m)
#pragma unroll
                    for (int n = 0; n < 2; ++n) acc[a][b][m][n] = (f32x4){0.f, 0.f, 0.f, 0.f};
        cur = nxt; cA = nA; cB = nB; ++ui;
        if constexpr (ALIGN_EPI) { if (wr == 1) PG8_BAR; }
    }
    PG8_WAIT_V(0);
    if constexpr (!ALIGN_EPI) { if (wr == 0) PG8_BAR; }
    PG8_BAR;
#undef PG8_SA
#undef PG8_SB
#undef PG8_STAGE
#undef PG8_LDA
#undef PG8_LDB
#undef PG8_MMA
#undef PG8_WAIT_V
#undef PG8_WAIT_L
#undef PG8_BAR
#undef PG8_SCHED
}
}

constexpr int PN = 6656;
namespace att {
#define ALAS __attribute__((address_space(3)))
typedef _Float16 f16x8 __attribute__((ext_vector_type(8)));
typedef float f32x16 __attribute__((ext_vector_type(16)));
typedef short v4i16_t __attribute__((ext_vector_type(4)));
typedef unsigned u32x4 __attribute__((ext_vector_type(4)));
constexpr int SLOT = 16384, L_K = 0, L_V = 3 * SLOT, L_SCR = 6 * SLOT, L_TAB = L_SCR + 2048, L_END = L_TAB + 1024;
constexpr int L_XB = 0, L_STG = 65536;
constexpr float LOG2E = 1.4426950408889634f;
constexpr float C2 = 0.125f * LOG2E;
__device__ __forceinline__ int crow(int r, int hi) { return (r & 3) + 8 * (r >> 2) + 4 * hi; }
__device__ __forceinline__ void glds16(const void* g, ALAS unsigned char* l) { __builtin_amdgcn_global_load_lds((const unsigned*)g, (ALAS unsigned*)l, 16, 0, 0); }
__device__ __forceinline__ float xhalf(float v, int hi) { auto rr = __builtin_amdgcn_permlane32_swap(__float_as_uint(v), __float_as_uint(v), false, false); return hi ? __uint_as_float(rr[0]) : __uint_as_float(rr[1]); }
__device__ __forceinline__ unsigned pkh(float lo, float hi) { typedef _Float16 h2 __attribute__((ext_vector_type(2))); h2 v = {(_Float16)lo, (_Float16)hi}; return __builtin_bit_cast(unsigned, v); }
__device__ __forceinline__ v4i16_t vtr(const ALAS unsigned char* p) { return __builtin_amdgcn_ds_read_tr16_b64_v4i16((ALAS v4i16_t*)p); }

template <int THR>
__device__ __forceinline__ void attn_unit(ALAS unsigned char* lds, const int wave, const int b, const int h, const int qb, const unsigned short* PROJ, unsigned short* Y,
                                          const float* biasG, const float lam, const float* subln_g) {
    const int lane = pg8::lane_id(), r32 = lane & 31, hi = lane >> 5;
    const int c = wave >> 2, w4 = wave & 3;
    const int q0 = qb * 128, qw0 = q0 + 32 * w4, q = qw0 + r32;
    const size_t rowbase = (size_t)b * S;
    { ALAS float* tabL = (ALAS float*)(lds + L_TAB); const int tid = wave * 64 + lane; if (tid < 129) tabL[tid] = biasG[tid] * LOG2E; }
    f16x8 qf[4];
    { const unsigned short* Qp = PROJ + (rowbase + q) * PN + h * 128 + c * 64 + hi * 8;
#pragma unroll
      for (int d0 = 0; d0 < 4; ++d0) qf[d0] = *(const f16x8*)(Qp + d0 * 16); }
    const unsigned short* ksrc0 = PROJ + (rowbase + lane) * PN + 1024 + h * 128 + (2 * wave) * 8;
    const unsigned short* vsrc0 = PROJ + (rowbase + 16 * ((2 * wave) & 3) + (lane >> 2)) * PN + 2048 + h * 128 + 32 * ((2 * wave) >> 2) + (lane & 3) * 8;
    ALAS unsigned char* kdst = lds + L_K + (2 * wave) * 1024; ALAS unsigned char* vdst = lds + L_V + (2 * wave) * 1024;
#define ATT_ISSUE(t, slot) do { const size_t go_ = (size_t)(t) * 64 * PN; \
        glds16(ksrc0 + go_, kdst + (slot) * SLOT); glds16(ksrc0 + go_ + 8, kdst + (slot) * SLOT + 1024); \
        glds16(vsrc0 + go_, vdst + (slot) * SLOT); glds16(vsrc0 + go_ + (size_t)16 * PN, vdst + (slot) * SLOT + 1024); } while (0)
    const int NT = (q0 + 128) / 64;
    ATT_ISSUE(0, 0); ATT_ISSUE(1, 1);
    ALAS float* wsf = (ALAS float*)(lds + L_SCR) + wave * 64;
    const ALAS float* tabL = (const ALAS float*)(lds + L_TAB);
    const float bfar = biasG[128] * LOG2E;
    float mhat = 0.f, l = 0.f;
    f32x16 o[4];
#pragma unroll
    for (int d = 0; d < 4; ++d)
#pragma unroll
        for (int r = 0; r < 16; ++r) o[d][r] = 0.f;
    f32x16 negm;
#pragma unroll
    for (int r = 0; r < 16; ++r) negm[r] = bfar;
    int slot = 0;
    for (int t = 0; t < NT; ++t) {
        if (t + 1 < NT) asm volatile("s_waitcnt vmcnt(4)" ::: "memory"); else asm volatile("s_waitcnt vmcnt(0)" ::: "memory");
        __builtin_amdgcn_s_barrier();
        asm volatile("" ::: "memory");
        if (t + 2 < NT) { const int s2 = slot == 0 ? 2 : slot - 1; ATT_ISSUE(t + 2, s2); }
        const int k0 = t * 64;
        if (k0 <= qw0 + 31) {
            const ALAS unsigned char* Ks = lds + L_K + slot * SLOT + (8 * c + hi) * 1024 + r32 * 16;
            const ALAS unsigned char* Vs = lds + L_V + slot * SLOT + (4 * hi + ((lane & 15) >> 2)) * 64 + ((lane >> 4) & 1) * 32 + (lane & 3) * 8;
            f32x16 p0, p1;
            const bool nearb = (k0 + 63 + 128 > qw0);
            if (nearb) {
                f32x16 c0, c1;
#pragma unroll
                for (int r = 0; r < 16; ++r) { int rel = q - (k0 + crow(r, hi)); int i0 = rel < 0 ? 0 : (rel > 128 ? 128 : rel); int rel1 = rel - 32; int i1 = rel1 < 0 ? 0 : (rel1 > 128 ? 128 : rel1);
                    c0[r] = tabL[i0] - mhat; c1[r] = tabL[i1] - mhat; }
#pragma unroll
                for (int d0 = 0; d0 < 4; ++d0) { const f16x8 a0 = *(const ALAS f16x8*)(Ks + d0 * 2048), a1 = *(const ALAS f16x8*)(Ks + d0 * 2048 + 512);
                    p0 = __builtin_amdgcn_mfma_f32_32x32x16_f16(a0, qf[d0], d0 == 0 ? c0 : p0, 0, 0, 0); p1 = __builtin_amdgcn_mfma_f32_32x32x16_f16(a1, qf[d0], d0 == 0 ? c1 : p1, 0, 0, 0); }
                if (k0 + 63 > qw0) {
#pragma unroll
                    for (int r = 0; r < 16; ++r) { const int kv = k0 + crow(r, hi); if (kv > q) p0[r] = -INFINITY; if (kv + 32 > q) p1[r] = -INFINITY; }
                }
            } else {
#pragma unroll
                for (int d0 = 0; d0 < 4; ++d0) { const f16x8 a0 = *(const ALAS f16x8*)(Ks + d0 * 2048), a1 = *(const ALAS f16x8*)(Ks + d0 * 2048 + 512);
                    p0 = __builtin_amdgcn_mfma_f32_32x32x16_f16(a0, qf[d0], d0 == 0 ? negm : p0, 0, 0, 0); p1 = __builtin_amdgcn_mfma_f32_32x32x16_f16(a1, qf[d0], d0 == 0 ? negm : p1, 0, 0, 0); }
            }
            float rm = fmaxf(p0[0], p1[0]);
#pragma unroll
            for (int r = 1; r < 16; ++r) rm = fmaxf(rm, fmaxf(p0[r], p1[r]));
            rm = fmaxf(rm, xhalf(rm, hi));
            const bool first = (t == 0);
            if (first || __any(rm > (float)THR)) {
                const float dl = first ? rm : fmaxf(rm, 0.f);
                mhat += dl;
#pragma unroll
                for (int r = 0; r < 16; ++r) { p0[r] -= dl; p1[r] -= dl; }
#pragma unroll
                for (int r = 0; r < 16; ++r) negm[r] = bfar - mhat;
                if (!first) {
                    const float f = __builtin_amdgcn_exp2f(-dl); l *= f;
                    if (hi == 0) wsf[r32] = f;
                    asm volatile("s_waitcnt lgkmcnt(0)" ::: "memory");
#pragma unroll
                    for (int r = 0; r < 16; ++r) { const float fr_ = wsf[crow(r, hi)];
#pragma unroll
                        for (int d = 0; d < 4; ++d) o[d][r] *= fr_; }
                }
            }
            float sacc = 0.f;
#pragma unroll
            for (int r = 0; r < 16; ++r) { p0[r] = __builtin_amdgcn_exp2f(p0[r]); p1[r] = __builtin_amdgcn_exp2f(p1[r]); sacc += p0[r] + p1[r]; }
            l += sacc;
            u32x4 pw[4];
#pragma unroll
            for (int s = 0; s < 2; ++s) {
                pw[s] = (u32x4){pkh(p0[8 * s], p0[8 * s + 1]), pkh(p0[8 * s + 2], p0[8 * s + 3]), pkh(p0[8 * s + 4], p0[8 * s + 5]), pkh(p0[8 * s + 6], p0[8 * s + 7])};
                pw[2 + s] = (u32x4){pkh(p1[8 * s], p1[8 * s + 1]), pkh(p1[8 * s + 2], p1[8 * s + 3]), pkh(p1[8 * s + 4], p1[8 * s + 5]), pkh(p1[8 * s + 6], p1[8 * s + 7])};
            }
#pragma unroll
            for (int d = 0; d < 4; ++d) {
#pragma unroll
                for (int s = 0; s < 4; ++s) {
                    const v4i16_t lo = vtr(Vs + (d * 4 + s) * 1024), hi4 = vtr(Vs + (d * 4 + s) * 1024 + 512);
                    typedef short s16x8 __attribute__((ext_vector_type(8)));
                    const s16x8 bv = {lo[0], lo[1], lo[2], lo[3], hi4[0], hi4[1], hi4[2], hi4[3]};
                    o[d] = __builtin_amdgcn_mfma_f32_32x32x16_f16(__builtin_bit_cast(f16x8, pw[s]), __builtin_bit_cast(f16x8, bv), o[d], 0, 0, 0);
                }
            }
        }
        slot = slot == 2 ? 0 : slot + 1;
    }
#undef ATT_ISSUE
    l += xhalf(l, hi);
    if (hi == 0) wsf[r32] = 1.0f / l;
    asm volatile("s_waitcnt lgkmcnt(0)" ::: "memory");
#pragma unroll
    for (int r = 0; r < 16; ++r) { const float f = wsf[crow(r, hi)];
#pragma unroll
        for (int d = 0; d < 4; ++d) o[d][r] *= f; }
    asm volatile("s_waitcnt lgkmcnt(0)" ::: "memory"); __builtin_amdgcn_s_barrier(); asm volatile("" ::: "memory");
    ALAS float* xb = (ALAS float*)(lds + L_XB) + w4 * 4096 + lane;
    if (c == 1) {
#pragma unroll
        for (int d = 0; d < 4; ++d)
#pragma unroll
            for (int r = 0; r < 16; ++r) xb[(d * 16 + r) * 64] = o[d][r];
    }
    asm volatile("s_waitcnt lgkmcnt(0)" ::: "memory"); __builtin_amdgcn_s_barrier(); asm volatile("" ::: "memory");
    if (c == 0) {
        float sc[16];
#pragma unroll
        for (int r = 0; r < 16; ++r) { float ss = 0.f;
#pragma unroll
            for (int d = 0; d < 4; ++d) { o[d][r] -= lam * xb[(d * 16 + r) * 64]; ss += o[d][r] * o[d][r]; }
            ss += __shfl_xor(ss, 1); ss += __shfl_xor(ss, 2); ss += __shfl_xor(ss, 4); ss += __shfl_xor(ss, 8); ss += __shfl_xor(ss, 16);
            sc[r] = (1.0f / sqrtf(ss * (1.f / 128.f) + LN_EPS)) * (1.f - LAMBDA_INIT); }
        ALAS _Float16* stg = (ALAS _Float16*)(lds + L_STG + w4 * 8192);
#pragma unroll
        for (int d = 0; d < 4; ++d) { const float gg = subln_g[32 * d + r32];
#pragma unroll
            for (int r = 0; r < 16; ++r) stg[crow(r, hi) * 128 + 32 * d + r32] = (_Float16)(o[d][r] * sc[r] * gg); }
        asm volatile("s_waitcnt lgkmcnt(0)" ::: "memory");
        unsigned short* Yw = Y + (rowbase + qw0) * D + h * 128;
#pragma unroll
        for (int i = 0; i < 8; ++i) { const int row = i * 4 + (lane >> 4), ch = lane & 15; const u32x4 v = *(const ALAS u32x4*)((const ALAS unsigned char*)stg + row * 256 + ch * 16);
            *(u32x4*)(Yw + (size_t)row * D + ch * 8) = v; }
    }
    asm volatile("s_waitcnt lgkmcnt(0)" ::: "memory"); __builtin_amdgcn_s_barrier(); asm volatile("" ::: "memory");
}
#undef ALAS
}

namespace rk {
#define RLAS __attribute__((address_space(3)))
#define RGAS __attribute__((address_space(1)))
typedef __bf16 bf16x8 __attribute__((ext_vector_type(8)));
typedef _Float16 f16x8 __attribute__((ext_vector_type(8)));
typedef float f32x16 __attribute__((ext_vector_type(16)));
typedef float f32x4 __attribute__((ext_vector_type(4)));
typedef unsigned u32x4 __attribute__((ext_vector_type(4)));
typedef unsigned short us8 __attribute__((ext_vector_type(8)));
constexpr int C = 32;
constexpr int TS = 144, CS = 80;
constexpr int O_AT = 0, O_RT = 4608, O_BT = 9216, O_KT = 13824;
constexpr int O_AAB = 0, O_AAK = 4608, O_ARB = 7168, O_ARK = 9728;
constexpr int O_PIMG = 0, O_QIMG = 8192;
constexpr int O_VT = 18432, O_KH = 23552, O_BH = 28672;
constexpr int O_X0 = 33792;
constexpr int O_RH = 50688;
constexpr int O_GAM = 55296;
constexpr int HALF_BYTES = 57344;
constexpr int CHK_BYTES = 24576, CK_P = 0, CK_Q = 8192, CK_G = 12288, CK_Y = 20480;
__device__ __forceinline__ int crow(int r, int hi) { return (r & 3) + 8 * (r >> 2) + 4 * hi; }
__device__ __forceinline__ unsigned pkb(float lo, float hi) { typedef float f2 __attribute__((ext_vector_type(2))); typedef __bf16 b2 __attribute__((ext_vector_type(2))); f2 v = {lo, hi}; b2 w = __builtin_convertvector(v, b2); return __builtin_bit_cast(unsigned, w); }
__device__ __forceinline__ unsigned pkh(float lo, float hi) { typedef _Float16 h2 __attribute__((ext_vector_type(2))); h2 v = {(_Float16)lo, (_Float16)hi}; return __builtin_bit_cast(unsigned, v); }
__device__ __forceinline__ float h2f(unsigned short u) { return (float)__builtin_bit_cast(_Float16, u); }
__device__ __forceinline__ unsigned short f2h(float f) { return __builtin_bit_cast(unsigned short, (_Float16)f); }
__device__ __forceinline__ float sum8(float x) {
    x += __builtin_bit_cast(float, __builtin_amdgcn_update_dpp(0, __builtin_bit_cast(int, x), 0xB1, 0xF, 0xF, true));
    x += __builtin_bit_cast(float, __builtin_amdgcn_update_dpp(0, __builtin_bit_cast(int, x), 0x4E, 0xF, 0xF, true));
    x += __builtin_bit_cast(float, __builtin_amdgcn_update_dpp(0, __builtin_bit_cast(int, x), 0x141, 0xF, 0xF, true));
    return x;
}
__device__ __forceinline__ int frag_pos(int m, int c) { return (((c >> 4) * 64 + m + 32 * ((c >> 2) & 1)) * 8) + ((c >> 3) & 1) * 4 + (c & 3); }

__device__ __forceinline__ void chunk_pair(RLAS unsigned char* lds, const int wave, const int tile, const int hA, const unsigned short* PROJ16, const float* mu, const float* LW, const unsigned short* KMOD,
                                           const unsigned short* A16, const unsigned short* B16, const float* r_k, unsigned char* CHK, float* BONUS) {
    const int lane = pg8::lane_id(), hf = wave >> 2, q = wave & 3, r32 = lane & 31, hi = lane >> 5;
    const int h = hA + hf;
    RLAS unsigned char* L = lds + hf * HALF_BYTES;
    const int t = q * 64 + lane;
    const int tok = t >> 3, c8 = (t & 7) * 8;
    const int tglob = tile * C + tok, pos = tglob & (S - 1), bidx = tglob >> 11;
    const int chb = h * 64 + c8;
    float lw[8], av[8], bv[8], kv[8], rv[8], vv[8];
    { const f32x4 l0 = *(const RGAS f32x4*)(LW + (size_t)tglob * RWK + chb), l1 = *(const RGAS f32x4*)(LW + (size_t)tglob * RWK + chb + 4);
      lw[0] = l0.x; lw[1] = l0.y; lw[2] = l0.z; lw[3] = l0.w; lw[4] = l1.x; lw[5] = l1.y; lw[6] = l1.z; lw[7] = l1.w;
      const us8 a8 = *(const RGAS us8*)(A16 + (size_t)tglob * RWK + chb), b8 = *(const RGAS us8*)(B16 + (size_t)tglob * RWK + chb), k8 = *(const RGAS us8*)(KMOD + (size_t)tglob * RWK + chb);
      const unsigned short* cur = PROJ16 + (size_t)tglob * PN + 3072 + chb;
      const us8 rc = *(const RGAS us8*)cur, vc = *(const RGAS us8*)(cur + 2048); us8 rp = rc, vp = vc; if (pos > 0) { rp = *(const RGAS us8*)(cur - PN); vp = *(const RGAS us8*)(cur - PN + 2048); }
      const f32x4 m0 = *(const RGAS f32x4*)(mu + chb), m1 = *(const RGAS f32x4*)(mu + chb + 4), n0 = *(const RGAS f32x4*)(mu + 2048 + chb), n1 = *(const RGAS f32x4*)(mu + 2048 + chb + 4);
      const float mr[8] = {m0.x, m0.y, m0.z, m0.w, m1.x, m1.y, m1.z, m1.w}, mv[8] = {n0.x, n0.y, n0.z, n0.w, n1.x, n1.y, n1.z, n1.w};
#pragma unroll
      for (int i = 0; i < 8; ++i) { av[i] = h2f(a8[i]); bv[i] = h2f(b8[i]); kv[i] = h2f(k8[i]);
          const float rcf = h2f(rc[i]), rpf = pos > 0 ? h2f(rp[i]) : 0.f, vcf = h2f(vc[i]), vpf = pos > 0 ? h2f(vp[i]) : 0.f;
          rv[i] = rcf + (rpf - rcf) * mr[i]; vv[i] = vcf + (vpf - vcf) * mv[i]; } }
    { const f32x4 k0 = *(const RGAS f32x4*)(r_k + chb), k1 = *(const RGAS f32x4*)(r_k + chb + 4); const float rk8[8] = {k0.x, k0.y, k0.z, k0.w, k1.x, k1.y, k1.z, k1.w};
      float bs = 0.f;
#pragma unroll
      for (int i = 0; i < 8; ++i) bs += rv[i] * kv[i] * rk8[i];
      bs = sum8(bs); if ((t & 7) == 0) BONUS[(size_t)tglob * 16 + h] = bs; }
    RLAS float* lwL = (RLAS float*)(L + O_X0 + 64 * 132);
    __syncthreads();
#pragma unroll
    for (int i = 0; i < 8; ++i) lwL[tok * 65 + c8 + i] = lw[i];
    __syncthreads();
    if (t < 64) { float g = 0.f;
#pragma unroll 8
        for (int k = 0; k < C; ++k) { g += lwL[k * 65 + t]; lwL[k * 65 + t] = g; } }
    __syncthreads();
    {
        float G[8], GL[8];
#pragma unroll
        for (int i = 0; i < 8; ++i) { G[i] = lwL[tok * 65 + c8 + i]; GL[i] = lwL[31 * 65 + c8 + i]; }
        float at[8], rt[8], bt[8], kt[8], bh[8], kh[8];
#pragma unroll
        for (int i = 0; i < 8; ++i) { const float eg = __expf(G[i]), eng = __expf(-G[i]), egm = __expf(G[i] - lw[i]), egl = __expf(GL[i] - G[i]);
            at[i] = av[i] * egm; rt[i] = rv[i] * eg; bt[i] = bv[i] * eng; kt[i] = kv[i] * eng; bh[i] = bv[i] * egl; kh[i] = kv[i] * egl; }
        *(RLAS u32x4*)(L + O_AT + tok * TS + c8 * 2) = (u32x4){pkb(at[0], at[1]), pkb(at[2], at[3]), pkb(at[4], at[5]), pkb(at[6], at[7])};
        *(RLAS u32x4*)(L + O_RT + tok * TS + c8 * 2) = (u32x4){pkb(rt[0], rt[1]), pkb(rt[2], rt[3]), pkb(rt[4], rt[5]), pkb(rt[6], rt[7])};
        *(RLAS u32x4*)(L + O_BT + tok * TS + c8 * 2) = (u32x4){pkb(bt[0], bt[1]), pkb(bt[2], bt[3]), pkb(bt[4], bt[5]), pkb(bt[6], bt[7])};
        *(RLAS u32x4*)(L + O_KT + tok * TS + c8 * 2) = (u32x4){pkb(kt[0], kt[1]), pkb(kt[2], kt[3]), pkb(kt[4], kt[5]), pkb(kt[6], kt[7])};
        *(RLAS u32x4*)(L + O_RH + tok * TS + c8 * 2) = (u32x4){pkh(rt[0], rt[1]), pkh(rt[2], rt[3]), pkh(rt[4], rt[5]), pkh(rt[6], rt[7])};
#pragma unroll
        for (int i = 0; i < 8; ++i) { const int ch = c8 + i;
            *(RLAS unsigned short*)(L + O_VT + ch * CS + tok * 2) = f2h(vv[i]); *(RLAS unsigned short*)(L + O_KH + ch * CS + tok * 2) = f2h(kh[i]); *(RLAS unsigned short*)(L + O_BH + ch * CS + tok * 2) = f2h(bh[i]);
            ((RLAS float*)(L + O_X0))[ch * 33 + tok] = at[i];
            if (tok == C - 1) ((RLAS float*)(L + O_GAM))[ch] = __expf(GL[i]); }
    }
    __syncthreads();
    {
        const RLAS unsigned char* Lp = L + (q < 2 ? O_AT : O_RT) + r32 * TS + hi * 16; const RLAS unsigned char* Rp = L + ((q & 1) ? O_KT : O_BT) + r32 * TS + hi * 16;
        f32x16 acc;
#pragma unroll
        for (int r = 0; r < 16; ++r) acc[r] = 0.f;
#pragma unroll
        for (int ks = 0; ks < 4; ++ks) acc = __builtin_amdgcn_mfma_f32_32x32x16_bf16(*(const RLAS bf16x8*)(Lp + ks * 32), *(const RLAS bf16x8*)(Rp + ks * 32), acc, 0, 0, 0);
#pragma unroll
        for (int r = 0; r < 16; ++r) { const int tau = crow(r, hi); const bool keep = (q < 2) ? (r32 < tau) : (r32 <= tau); acc[r] = keep ? acc[r] : 0.f; }
        __syncthreads();
        if (q == 0) {
#pragma unroll
            for (int r = 0; r < 16; ++r) ((RLAS float*)(L + O_AAB))[r32 * 36 + crow(r, hi)] = acc[r];
        } else {
            RLAS unsigned char* o = L + (q == 1 ? O_AAK : (q == 2 ? O_ARB : O_ARK));
#pragma unroll
            for (int r = 0; r < 16; ++r) *(RLAS unsigned short*)(o + crow(r, hi) * CS + r32 * 2) = f2h(acc[r]);
        }
    }
    __syncthreads();
    const int J = q & 1, part = q >> 1;
    if (part == 1) {
        f32x16 accX;
#pragma unroll
        for (int r = 0; r < 16; ++r) accX[r] = 0.f;
        const RLAS unsigned char* Vp = L + O_VT + (32 * J + r32) * CS + hi * 16; const RLAS unsigned char* Ap = L + O_AAK + r32 * CS + hi * 16;
#pragma unroll
        for (int ks = 0; ks < 2; ++ks) accX = __builtin_amdgcn_mfma_f32_32x32x16_f16(*(const RLAS f16x8*)(Ap + ks * 32), *(const RLAS f16x8*)(Vp + ks * 32), accX, 0, 0, 0);
#pragma unroll
        for (int r = 0; r < 16; ++r) ((RLAS float*)(L + O_X0))[(64 + 32 * J + r32) * 33 + crow(r, hi)] = accX[r];
    }
    __syncthreads();
    float z[C];
    if (q < 2) {
        const RLAS float* xc = (const RLAS float*)(L + O_X0) + (64 * q + lane) * 33;
#pragma unroll
        for (int k = 0; k < C; ++k) z[k] = xc[k];
    }
    __syncthreads();
    if (q < 2) {
        const RLAS float* AabT = (const RLAS float*)(L + O_AAB);
#pragma unroll
        for (int sx = 0; sx < C - 1; ++sx) {
            const float zs = z[sx];
#pragma unroll
            for (int t4 = (sx + 1) / 4; t4 < C / 4; ++t4) { const f32x4 aa = *(const RLAS f32x4*)(AabT + sx * 36 + 4 * t4);
                if (4 * t4 + 0 > sx) z[4 * t4 + 0] = fmaf(aa.x, zs, z[4 * t4 + 0]); if (4 * t4 + 1 > sx) z[4 * t4 + 1] = fmaf(aa.y, zs, z[4 * t4 + 1]);
                if (4 * t4 + 2 > sx) z[4 * t4 + 2] = fmaf(aa.z, zs, z[4 * t4 + 2]); if (4 * t4 + 3 > sx) z[4 * t4 + 3] = fmaf(aa.w, zs, z[4 * t4 + 3]); }
        }
        RLAS unsigned char* zr = L + O_X0 + (64 * q + lane) * CS;
#pragma unroll
        for (int k8 = 0; k8 < 4; ++k8) *(RLAS u32x4*)(zr + k8 * 16) = (u32x4){pkh(z[8 * k8], z[8 * k8 + 1]), pkh(z[8 * k8 + 2], z[8 * k8 + 3]), pkh(z[8 * k8 + 4], z[8 * k8 + 5]), pkh(z[8 * k8 + 6], z[8 * k8 + 7])};
    }
    __syncthreads();
    f32x16 accQ, accP, accA, accB;
#pragma unroll
    for (int r = 0; r < 16; ++r) { accA[r] = 0.f; accB[r] = 0.f; }
    {
        const RLAS unsigned char* Vp = L + O_VT + (32 * J + r32) * CS + hi * 16;
        const RLAS unsigned char* Kp = L + O_KH + (32 * part + r32) * CS + hi * 16;
        const RLAS unsigned char* Ap = L + O_ARK + r32 * CS + hi * 16;
#pragma unroll
        for (int ks = 0; ks < 2; ++ks) { const f16x8 vf = *(const RLAS f16x8*)(Vp + ks * 32);
            if (part == 0) accA = __builtin_amdgcn_mfma_f32_32x32x16_f16(*(const RLAS f16x8*)(Ap + ks * 32), vf, accA, 0, 0, 0);
            accB = __builtin_amdgcn_mfma_f32_32x32x16_f16(*(const RLAS f16x8*)(Kp + ks * 32), vf, accB, 0, 0, 0); }
    }
    {
        const RLAS float* gam = (const RLAS float*)(L + O_GAM);
#pragma unroll
        for (int r = 0; r < 16; ++r) { const int m = crow(r, hi);
            accQ[r] = h2f(*(const RLAS unsigned short*)(L + O_RH + m * TS + (32 * J + r32) * 2));
            accP[r] = (J == part && m == r32) ? gam[32 * J + r32] : 0.f; }
        const RLAS unsigned char* Zw = L + O_X0 + (32 * J + r32) * CS + hi * 16; const RLAS unsigned char* Zu = Zw + 64 * CS;
        const RLAS unsigned char* Bp = L + O_BH + (32 * part + r32) * CS + hi * 16; const RLAS unsigned char* Rb = L + O_ARB + r32 * CS + hi * 16;
#pragma unroll
        for (int ks = 0; ks < 2; ++ks) { const f16x8 zw = *(const RLAS f16x8*)(Zw + ks * 32), zu = *(const RLAS f16x8*)(Zu + ks * 32), bf = *(const RLAS f16x8*)(Bp + ks * 32);
            accP = __builtin_amdgcn_mfma_f32_32x32x16_f16(bf, zw, accP, 0, 0, 0);
            accB = __builtin_amdgcn_mfma_f32_32x32x16_f16(bf, zu, accB, 0, 0, 0);
            if (part == 0) { const f16x8 rb = *(const RLAS f16x8*)(Rb + ks * 32);
                accQ = __builtin_amdgcn_mfma_f32_32x32x16_f16(rb, zw, accQ, 0, 0, 0);
                accA = __builtin_amdgcn_mfma_f32_32x32x16_f16(rb, zu, accA, 0, 0, 0); } }
    }
    __syncthreads();
    unsigned char* rec = CHK + ((size_t)((bidx * 16 + h) * (S / C)) + (size_t)(pos >> 5)) * CHK_BYTES;
    { u32x4 w0, w1; w0 = (u32x4){pkh(accB[0], accB[1]), pkh(accB[2], accB[3]), pkh(accB[4], accB[5]), pkh(accB[6], accB[7])}; w1 = (u32x4){pkh(accB[8], accB[9]), pkh(accB[10], accB[11]), pkh(accB[12], accB[13]), pkh(accB[14], accB[15])};
      RGAS u32x4* g = (RGAS u32x4*)(rec + CK_G + ((part * 2 + J) * 64 + lane) * 32); g[0] = w0; g[1] = w1;
      if (part == 0) { w0 = (u32x4){pkh(accA[0], accA[1]), pkh(accA[2], accA[3]), pkh(accA[4], accA[5]), pkh(accA[6], accA[7])}; w1 = (u32x4){pkh(accA[8], accA[9]), pkh(accA[10], accA[11]), pkh(accA[12], accA[13]), pkh(accA[14], accA[15])};
          RGAS u32x4* y = (RGAS u32x4*)(rec + CK_Y + (J * 64 + lane) * 32); y[0] = w0; y[1] = w1; } }
    {
        RLAS unsigned short* pimg = (RLAS unsigned short*)(L + O_PIMG) + ((part * 2 + J) * 2) * 512;
        RLAS unsigned short* qimg = (RLAS unsigned short*)(L + O_QIMG) + (J * 2) * 512;
#pragma unroll
        for (int r = 0; r < 16; ++r) { const int fp = frag_pos(crow(r, hi), r32); pimg[fp] = f2h(accP[r]); if (part == 0) qimg[fp] = f2h(accQ[r]); }
    }
    __syncthreads();
    { const RLAS u32x4* src = (const RLAS u32x4*)(L + O_PIMG); RGAS u32x4* dst = (RGAS u32x4*)(rec + CK_P);
#pragma unroll
      for (int i = 0; i < 3; ++i) dst[i * 256 + t] = src[i * 256 + t]; }
}

__device__ __forceinline__ void scan_unit(RLAS unsigned char* lds, const int wave, const int bh, const unsigned char* CHK, const float* BONUS, const unsigned short* PROJ16, const float* mu,
                                          const unsigned short* G16, const float* lnx_g, const float* lnx_b, unsigned short* Y16) {
    const int lane = pg8::lane_id(), r32 = lane & 31, hi = lane >> 5;
    const int b = bh >> 4, h = bh & 15;
    RLAS float* ytile = (RLAS float*)lds;
    const unsigned char* rec0 = CHK + (size_t)bh * (S / C) * CHK_BYTES;
    constexpr int NCH = S / C;
    if (wave < 2) {
        const int J = wave;
        f32x16 H0, H1;
#pragma unroll
        for (int r = 0; r < 16; ++r) { H0[r] = 0.f; H1[r] = 0.f; }
        u32x4 pf[8], qf[4], gm[4], yl[2];
#define RK_LOAD(c) do { const unsigned char* rec_ = rec0 + (size_t)(c) * CHK_BYTES; \
            _Pragma("unroll") for (int i_ = 0; i_ < 8; ++i_) pf[i_] = *(const RGAS u32x4*)(rec_ + CK_P + (i_ * 64 + lane) * 16); \
            _Pragma("unroll") for (int i_ = 0; i_ < 4; ++i_) qf[i_] = *(const RGAS u32x4*)(rec_ + CK_Q + (i_ * 64 + lane) * 16); \
            _Pragma("unroll") for (int i_ = 0; i_ < 2; ++i_) { gm[2 * i_] = *(const RGAS u32x4*)(rec_ + CK_G + ((i_ * 2 + J) * 64 + lane) * 32); gm[2 * i_ + 1] = *(const RGAS u32x4*)(rec_ + CK_G + ((i_ * 2 + J) * 64 + lane) * 32 + 16); } \
            yl[0] = *(const RGAS u32x4*)(rec_ + CK_Y + (J * 64 + lane) * 32); yl[1] = *(const RGAS u32x4*)(rec_ + CK_Y + (J * 64 + lane) * 32 + 16); } while (0)
        RK_LOAD(0);
        for (int c = 0; c < NCH; ++c) {
            u32x4 cp[8], cq[4], cg[4], cy[2];
#pragma unroll
            for (int i = 0; i < 8; ++i) cp[i] = pf[i];
#pragma unroll
            for (int i = 0; i < 4; ++i) { cq[i] = qf[i]; cg[i] = gm[i]; }
            cy[0] = yl[0]; cy[1] = yl[1];
            if (c + 1 < NCH) RK_LOAD(c + 1);
            u32x4 hb[4];
            hb[0] = (u32x4){pkh(H0[0], H0[1]), pkh(H0[2], H0[3]), pkh(H0[4], H0[5]), pkh(H0[6], H0[7])}; hb[1] = (u32x4){pkh(H0[8], H0[9]), pkh(H0[10], H0[11]), pkh(H0[12], H0[13]), pkh(H0[14], H0[15])};
            hb[2] = (u32x4){pkh(H1[0], H1[1]), pkh(H1[2], H1[3]), pkh(H1[4], H1[5]), pkh(H1[6], H1[7])}; hb[3] = (u32x4){pkh(H1[8], H1[9]), pkh(H1[10], H1[11]), pkh(H1[12], H1[13]), pkh(H1[14], H1[15])};
            f32x16 y, n0, n1;
#define RK_UNPK(dst, w0, w1) do { const f16x8 a_ = __builtin_bit_cast(f16x8, w0), b_ = __builtin_bit_cast(f16x8, w1); \
            _Pragma("unroll") for (int i_ = 0; i_ < 8; ++i_) { dst[i_] = (float)a_[i_]; dst[8 + i_] = (float)b_[i_]; } } while (0)
            RK_UNPK(y, cy[0], cy[1]); RK_UNPK(n0, cg[0], cg[1]); RK_UNPK(n1, cg[2], cg[3]);
#pragma unroll
            for (int ks = 0; ks < 4; ++ks) {
                const f16x8 hf = __builtin_bit_cast(f16x8, hb[ks]);
                y = __builtin_amdgcn_mfma_f32_32x32x16_f16(__builtin_bit_cast(f16x8, cq[ks]), hf, y, 0, 0, 0);
                n0 = __builtin_amdgcn_mfma_f32_32x32x16_f16(__builtin_bit_cast(f16x8, cp[ks]), hf, n0, 0, 0, 0);
                n1 = __builtin_amdgcn_mfma_f32_32x32x16_f16(__builtin_bit_cast(f16x8, cp[4 + ks]), hf, n1, 0, 0, 0);
            }
            H0 = n0; H1 = n1;
            RLAS float* yt = ytile + (c & 1) * (32 * 68);
#pragma unroll
            for (int r = 0; r < 16; ++r) yt[crow(r, hi) * 68 + 32 * J + r32] = y[r];
            asm volatile("s_waitcnt lgkmcnt(0)" ::: "memory"); __builtin_amdgcn_s_barrier(); asm volatile("" ::: "memory");
        }
        asm volatile("s_waitcnt lgkmcnt(0)" ::: "memory"); __builtin_amdgcn_s_barrier(); asm volatile("" ::: "memory");
#undef RK_LOAD
#undef RK_UNPK
    } else {
        const int p = wave - 2, v8 = (lane & 7) * 8, trow = 8 * p + (lane >> 3);
        float lg[8], lb[8], mv[8];
        if (p < 4) {
#pragma unroll
            for (int i = 0; i < 8; ++i) { lg[i] = lnx_g[h * 64 + v8 + i]; lb[i] = lnx_b[h * 64 + v8 + i]; mv[i] = mu[2048 + h * 64 + v8 + i]; } }
        for (int c = 0; c <= NCH; ++c) {
            asm volatile("s_waitcnt lgkmcnt(0)" ::: "memory"); __builtin_amdgcn_s_barrier(); asm volatile("" ::: "memory");
            if (c == NCH || p >= 4) continue;
            const int cc = c;
            const RLAS float* yt = ytile + (cc & 1) * (32 * 68) + trow * 68 + v8;
            const f32x4 ya = *(const RLAS f32x4*)yt, yb = *(const RLAS f32x4*)(yt + 4);
            float yv[8] = {ya.x, ya.y, ya.z, ya.w, yb.x, yb.y, yb.z, yb.w};
            float sm = 0.f;
#pragma unroll
            for (int i = 0; i < 8; ++i) sm += yv[i];
            const float mean = sum8(sm) * (1.f / 64.f); float sq = 0.f;
#pragma unroll
            for (int i = 0; i < 8; ++i) { yv[i] -= mean; sq += yv[i] * yv[i]; }
            const float rstd = 1.0f / sqrtf(sum8(sq) * (1.f / 64.f) + 64e-5f);
            const int pos = cc * C + trow; const size_t tok = (size_t)b * S + pos;
            const float bon = BONUS[tok * 16 + h];
            const unsigned short* cur = PROJ16 + tok * PN + 5120 + h * 64 + v8;
            const us8 vc = *(const RGAS us8*)cur; us8 vp = vc; if (pos > 0) vp = *(const RGAS us8*)(cur - PN);
            const us8 g8 = *(const RGAS us8*)(G16 + tok * RWK + h * 64 + v8);
            float o[8];
#pragma unroll
            for (int i = 0; i < 8; ++i) { const float vcf = h2f(vc[i]), vpf = pos > 0 ? h2f(vp[i]) : 0.f; const float vx = vcf + (vpf - vcf) * mv[i];
                o[i] = (yv[i] * rstd * lg[i] + lb[i] + bon * vx) * h2f(g8[i]); }
            *(RGAS u32x4*)(Y16 + tok * D + 1024 + h * 64 + v8) = (u32x4){pkh(o[0], o[1]), pkh(o[2], o[3]), pkh(o[4], o[5]), pkh(o[6], o[7])};
        }
    }
}
#undef RLAS
#undef RGAS
}

constexpr int NWAVES = 8;
constexpr int RING_OFF = 0, RING_BYTES = 131072;
constexpr int LDSCTL_OFF = RING_BYTES, MISC_OFF = LDSCTL_OFF + 320;
constexpr int LDS_BYTES = 147456;
#define GAS __attribute__((address_space(1)))
#define LAS __attribute__((address_space(3)))
typedef unsigned v4u __attribute__((ext_vector_type(4)));
typedef float f32x4 __attribute__((ext_vector_type(4)));
typedef GAS unsigned gu32;
#define RLX_AGENT __ATOMIC_RELAXED, __HIP_MEMORY_SCOPE_AGENT
#define LDS_WAIT() asm volatile("s_waitcnt lgkmcnt(0)" ::: "memory")
#define VM_WAIT() asm volatile("s_waitcnt vmcnt(0)" ::: "memory")
constexpr int CW_BAR = 4096;
constexpr size_t CTL_ZERO_BYTES = 1 * MiB;

#define XB_TMO      128
#define XB_XCNT(j)  (256  + 64 * (j))
#define XB_XSUB(j)  (1280 + 64 * (j))
#define XB_XGEN(j)  (2304 + 64 * (j))
#define XB_TOP      3328
#define XB_TOPGEN   3392
#define XCD_BAR_WORDS 3456
#define XB_SPIN_CAP (1u << 18)

__device__ __forceinline__ unsigned xb_ld(unsigned* p)              { return __hip_atomic_load(p, __ATOMIC_RELAXED, __HIP_MEMORY_SCOPE_AGENT); }
__device__ __forceinline__ unsigned xb_add(unsigned* p, unsigned v) { return __hip_atomic_fetch_add(p, v, __ATOMIC_RELAXED, __HIP_MEMORY_SCOPE_AGENT); }
__device__ __forceinline__ unsigned xb_xcc_id() { return (unsigned)__builtin_amdgcn_s_getreg((3 << 11) | 20) & 0xFu; }
#define XB_SPIN(cond, bar) do { unsigned _sp = 0; while (cond) { __builtin_amdgcn_s_sleep(1); \
    if ((++_sp & 255u) == 0u) { if (xb_ld(&(bar)[XB_TMO])) break; if (_sp > XB_SPIN_CAP) { atomicAdd(&(bar)[XB_TMO], 1u); break; } } } } while (0)

struct XcdBarrier {
    unsigned* bar; unsigned x; bool w0;
    volatile LAS unsigned* st;
};

__device__ __forceinline__ XcdBarrier xcd_barrier_post(unsigned* bar, volatile LAS unsigned* st) {
    XcdBarrier b; b.bar = bar; b.x = xb_xcc_id(); b.st = st; b.w0 = (__builtin_amdgcn_readfirstlane(threadIdx.x >> 6) == 0);
    if (__builtin_amdgcn_readfirstlane(threadIdx.x >> 6) == 0 && pg8::lane_id() == 0) (void)xb_add(&bar[XB_XCNT(b.x)], 1u);
    return b;
}
__device__ __forceinline__ void xcd_barrier_complete(unsigned* bar, unsigned x, unsigned& nloc, unsigned& nx) {
    const unsigned G = gridDim.x * gridDim.y * gridDim.z;
    unsigned sum, cnt, mine, sp = 0u;
    for (;;) {
        sum = 0u; cnt = 0u; mine = 0u;
#pragma unroll
        for (unsigned j = 0; j < 16; ++j) { const unsigned c = xb_ld(&bar[XB_XCNT(j)]); sum += c; cnt += (c > 0u) ? 1u : 0u; mine = (j == x) ? c : mine; }
        if (sum == G) break;
        __builtin_amdgcn_s_sleep(1);
        if ((++sp & 255u) == 0u) { if (xb_ld(&bar[XB_TMO])) break; if (sp > XB_SPIN_CAP) { atomicAdd(&bar[XB_TMO], 1u); break; } }
    }
    nloc = mine > 0u ? mine : 1u; nx = cnt > 0u ? cnt : 1u;
}

__device__ __forceinline__ void xcd_barrier(const XcdBarrier& b) {
    asm volatile("s_waitcnt vmcnt(0)" ::: "memory");
    __syncthreads();
    if (b.w0 && pg8::lane_id() == 0) {
        unsigned* bar = b.bar;
        __builtin_amdgcn_s_waitcnt(0);
        unsigned nloc = b.st[0], nx = b.st[1];
        if (nloc == 0u) { xcd_barrier_complete(bar, b.x, nloc, nx); b.st[0] = nloc; b.st[1] = nx; }
        const unsigned old = xb_add(&bar[XB_XSUB(b.x)], 1u);
        const unsigned gen = old / nloc;
        if (old + 1u == (gen + 1u) * nloc) {
            __builtin_amdgcn_fence(__ATOMIC_RELEASE, "agent");
            asm volatile("s_waitcnt vmcnt(0)" ::: "memory");
            const unsigned og = xb_add(&bar[XB_TOP], 1u);
            const unsigned tg = og / nx;
            if (og + 1u == (tg + 1u) * nx) xb_add(&bar[XB_TOPGEN], 1u);
            else XB_SPIN(xb_ld(&bar[XB_TOPGEN]) == tg, bar);
            __builtin_amdgcn_fence(__ATOMIC_ACQUIRE, "agent");
            xb_add(&bar[XB_XGEN(b.x)], 1u);
            asm volatile("s_waitcnt vmcnt(0)" ::: "memory");
        } else {
            XB_SPIN(xb_ld(&bar[XB_XGEN(b.x)]) == gen, bar);
            __builtin_amdgcn_fence(__ATOMIC_ACQUIRE, "agent");
            asm volatile("s_waitcnt vmcnt(0)" ::: "memory");
        }
    }
    __syncthreads();
}


typedef unsigned short f16_t;
typedef _Float16 h2v __attribute__((ext_vector_type(2)));
__device__ __forceinline__ unsigned pk2h(float lo, float hi) { h2v v = {(_Float16)lo, (_Float16)hi}; return __builtin_bit_cast(unsigned, v); }

struct Frame {
    LAS unsigned char* lds; volatile LAS unsigned* MISC; gu32* ctl;
    int wave, vcu, G;
};
#define FTID (F.wave * 64 + pg8::lane_id())
#define FLANE (pg8::lane_id())
__device__ __forceinline__ void p0_transpose_item(const float* W, int K, int N, f16_t* WT, int row_off, LAS float* scr, int item, int lane) {
    const int nblk = N / 32, kb = item / nblk, nb = item % nblk, k0 = 64 * kb, n0 = 32 * nb;
#pragma unroll 8
    for (int i = 0; i < 32; ++i) { const int kk = 2 * i + (lane >> 5); scr[kk * 33 + (lane & 31)] = W[(size_t)(k0 + kk) * N + n0 + (lane & 31)]; }
    LDS_WAIT(); asm volatile("" ::: "memory");
    const int c = lane & 7;
#pragma unroll
    for (int j = 0; j < 4; ++j) { const int n = (lane >> 3) + 8 * j; const LAS float* s = scr + (8 * c) * 33 + n;
        v4u o; o.x = pk2h(s[0 * 33], s[1 * 33]); o.y = pk2h(s[2 * 33], s[3 * 33]); o.z = pk2h(s[4 * 33], s[5 * 33]); o.w = pk2h(s[6 * 33], s[7 * 33]);
        *(GAS v4u*)(WT + (size_t)(row_off + n0 + n) * K + k0 + 8 * c) = o; }
    LDS_WAIT(); asm volatile("" ::: "memory");
}
__device__ __forceinline__ float wave_sum_b(float v) {
#pragma unroll
    for (int o = 1; o < 64; o <<= 1) v += __shfl_xor(v, o);
    return v;
}
__device__ __forceinline__ void ln_row_dual(int lane, const float* xrow, const float* g, const float* b, float* o32, f16_t* o16) {
    const GAS f32x4* xr = (const GAS f32x4*)xrow + lane;
    f32x4 v[8]; float s = 0.f;
#pragma unroll
    for (int j = 0; j < 8; ++j) { v[j] = xr[64 * j]; s += (v[j].x + v[j].y) + (v[j].z + v[j].w); }
    const float mean = wave_sum_b(s) * (1.f / D); float s2 = 0.f;
#pragma unroll
    for (int j = 0; j < 8; ++j) { v[j] = v[j] - mean; s2 += (v[j].x * v[j].x + v[j].y * v[j].y) + (v[j].z * v[j].z + v[j].w * v[j].w); }
    const float rstd = 1.f / sqrtf(wave_sum_b(s2) * (1.f / D) + LN_EPS);
    const GAS f32x4* g4 = (const GAS f32x4*)g + lane; const GAS f32x4* b4 = (const GAS f32x4*)b + lane;
    GAS f32x4* o4 = (GAS f32x4*)o32 + lane; GAS unsigned long long* o8 = (GAS unsigned long long*)o16 + lane;
#pragma unroll
    for (int j = 0; j < 8; ++j) { const f32x4 o = v[j] * rstd * g4[64 * j] + b4[64 * j]; o4[64 * j] = o;
        o8[64 * j] = (unsigned long long)pk2h(o.x, o.y) | ((unsigned long long)pk2h(o.z, o.w) << 32); }
}


__device__ __forceinline__ void p0_transpose_item_gu(const float* W, int K, int N, f16_t* WT, int gu_s, LAS float* scr, int item, int lane) {
    const int nblk = N / 32, nb = item % nblk; const int row_off = gu_s < 0 ? 0 : 128 * (nb >> 2) + 128 * gu_s;
    p0_transpose_item(W, K, N, WT, row_off, scr, item, lane);
}
__device__ __forceinline__ void ln_regs(int lane, f32x4 (&v)[8], const float* g, const float* b, float* o32, f16_t* o16) {
    float s = 0.f;
#pragma unroll
    for (int j = 0; j < 8; ++j) s += (v[j].x + v[j].y) + (v[j].z + v[j].w);
    const float mean = wave_sum_b(s) * (1.f / D); float s2 = 0.f;
#pragma unroll
    for (int j = 0; j < 8; ++j) { v[j] = v[j] - mean; s2 += (v[j].x * v[j].x + v[j].y * v[j].y) + (v[j].z * v[j].z + v[j].w * v[j].w); }
    const float rstd = 1.f / sqrtf(wave_sum_b(s2) * (1.f / D) + LN_EPS);
    const GAS f32x4* g4 = (const GAS f32x4*)g + lane; const GAS f32x4* b4 = (const GAS f32x4*)b + lane;
    GAS f32x4* o4 = (GAS f32x4*)o32 + lane; GAS unsigned long long* o8 = (GAS unsigned long long*)o16 + lane;
#pragma unroll
    for (int j = 0; j < 8; ++j) { v[j] = v[j] * rstd * g4[64 * j] + b4[64 * j]; o4[64 * j] = v[j];
        o8[64 * j] = (unsigned long long)pk2h(v[j].x, v[j].y) | ((unsigned long long)pk2h(v[j].z, v[j].w) << 32); }
}
__device__ __forceinline__ void route_token(int tok, const float (&acc)[36], const float* gb, const float* eb, int* cnt, int* ltok, int* lpair, float* pairw) {
    float gl[4]; float gm = -3.0e38f; int gi = 0;
#pragma unroll
    for (int i = 0; i < 4; ++i) { gl[i] = acc[i] + gb[i]; if (gl[i] > gm) { gm = gl[i]; gi = i; } }
    float gs = 0.f;
#pragma unroll
    for (int i = 0; i < 4; ++i) gs += expf(gl[i] - gm);
    const float gtop = 1.f / gs;
    float el[8]; float em = -3.0e38f; int e0 = 0;
#pragma unroll
    for (int i = 0; i < 8; ++i) { float v = 0.f;
#pragma unroll
        for (int g = 0; g < 4; ++g) if (g == gi) v = acc[4 + g * 8 + i] + eb[g * 8 + i];
        el[i] = v; if (v > em) { em = v; e0 = i; } }
    float em2 = -3.0e38f; int e1 = 0;
#pragma unroll
    for (int i = 0; i < 8; ++i) if (i != e0 && el[i] > em2) { em2 = el[i]; e1 = i; }
    const float x1 = expf(em2 - em);
    const float w0 = 1.f / (1.f + x1), w1 = x1 / (1.f + x1);
    const int ea = gi * 8 + e0, ebb = gi * 8 + e1;
    const int p0 = atomicAdd(&cnt[ea], 1); ltok[ea * 8192 + p0] = tok; lpair[ea * 8192 + p0] = tok * 2;
    const int p1 = atomicAdd(&cnt[ebb], 1); ltok[ebb * 8192 + p1] = tok; lpair[ebb * 8192 + p1] = tok * 2 + 1;
    pairw[tok * 2] = w0 * gtop; pairw[tok * 2 + 1] = w1 * gtop;
}
constexpr int TAB_OFF = LDSCTL_OFF + 1024;
__device__ __forceinline__ void build_moe_table(Frame& F, const int* cnt) {
    LAS int* tab = (LAS int*)(F.lds + TAB_OFF);
    const int tid = FTID;
    if (tid < 32) tab[tid] = __hip_atomic_load(cnt + tid, __ATOMIC_RELAXED, __HIP_MEMORY_SCOPE_AGENT);
    __syncthreads();
    if (tid == 0) { int p = 0; for (int e = 0; e < 32; ++e) { tab[32 + e] = p; p += (tab[e] + 255) >> 8; } tab[64] = p; }
    __syncthreads();
}

__device__ __forceinline__ float sum8_dpp(float x) {
    x += __builtin_bit_cast(float, __builtin_amdgcn_update_dpp(0, __builtin_bit_cast(int, x), 0xB1, 0xF, 0xF, true));
    x += __builtin_bit_cast(float, __builtin_amdgcn_update_dpp(0, __builtin_bit_cast(int, x), 0x4E, 0xF, 0xF, true));
    x += __builtin_bit_cast(float, __builtin_amdgcn_update_dpp(0, __builtin_bit_cast(int, x), 0x141, 0xF, 0xF, true));
    return x;
}
__device__ __forceinline__ float h2f(unsigned short u) { return (float)__builtin_bit_cast(_Float16, u); }
__device__ __forceinline__ void rwkv_prep_tile(Frame& F, int tile, const f16_t* PROJ16, const float* mu, const float* w0, const float* w2, const float* a0, const float* a2, const float* g2,
                                               const float* k_k, const float* k_a, float* decay, f16_t* kmod, f16_t* Aout, f16_t* Bout, f16_t* gout) {
    typedef unsigned short us8 __attribute__((ext_vector_type(8)));
    LAS float* sxT = (LAS float*)(F.lds + RING_OFF);
    const int tid = FTID, t0 = tile * 32, tg = tid >> 7, cg = tid & 127;
    __syncthreads();
    for (int e = tid; e < 32 * 288; e += 512) {
        const int tok = e / 288, i = e % 288, pos = (t0 + tok) & (S - 1);
        const f16_t* cur = PROJ16 + (size_t)(t0 + tok) * PN + 6144 + i;
        const float cv = h2f(cur[0]), pv = pos > 0 ? h2f(cur[-PN]) : 0.f; const float xs = cv + (pv - cv) * mu[3072 + i];
        float f; if (i < 64) f = tanhf(xs); else if (i < 128) f = xs; else f = 1.f / (1.f + expf(-xs));
        sxT[i * 36 + tok] = f;
    }
    __syncthreads();
    const LAS float* sx = sxT + 8 * tg;
    float acc[8][8];
    float p0v[8], p1v[8];
#pragma unroll
    for (int t = 0; t < 8; ++t)
#pragma unroll
        for (int c = 0; c < 8; ++c) acc[t][c] = 0.f;
#pragma unroll 2
    for (int j = 0; j < 64; ++j) {
        const f32x4 wa = *(const GAS f32x4*)(w2 + (size_t)j * 1024 + 8 * cg), wb = *(const GAS f32x4*)(w2 + (size_t)j * 1024 + 8 * cg + 4);
        const f32x4 sa = *(const LAS f32x4*)(sx + j * 36), sb = *(const LAS f32x4*)(sx + j * 36 + 4);
        const float wv[8] = {wa.x, wa.y, wa.z, wa.w, wb.x, wb.y, wb.z, wb.w}, sv[8] = {sa.x, sa.y, sa.z, sa.w, sb.x, sb.y, sb.z, sb.w};
#pragma unroll
        for (int t = 0; t < 8; ++t)
#pragma unroll
            for (int c = 0; c < 8; ++c) acc[t][c] = fmaf(sv[t], wv[c], acc[t][c]);
    }
    { const f32x4 pa = *(const GAS f32x4*)(w0 + 8 * cg), pb = *(const GAS f32x4*)(w0 + 8 * cg + 4); const float pp[8] = {pa.x, pa.y, pa.z, pa.w, pb.x, pb.y, pb.z, pb.w};
#pragma unroll
      for (int t = 0; t < 8; ++t) { float o[8];
#pragma unroll
          for (int c = 0; c < 8; ++c) { const float z = -(pp[c] + acc[t][c]); const float sp = z > 20.f ? z : log1pf(expf(z)); o[c] = -expf(-sp - 0.5f); }
          GAS f32x4* d = (GAS f32x4*)(decay + (size_t)(t0 + 8 * tg + t) * RWK + 8 * cg); d[0] = (f32x4){o[0], o[1], o[2], o[3]}; d[1] = (f32x4){o[4], o[5], o[6], o[7]}; } }
#pragma unroll
    for (int t = 0; t < 8; ++t)
#pragma unroll
        for (int c = 0; c < 8; ++c) acc[t][c] = 0.f;
#pragma unroll 2
    for (int j = 0; j < 64; ++j) {
        const f32x4 wa = *(const GAS f32x4*)(a2 + (size_t)j * 1024 + 8 * cg), wb = *(const GAS f32x4*)(a2 + (size_t)j * 1024 + 8 * cg + 4);
        const f32x4 sa = *(const LAS f32x4*)(sx + (64 + j) * 36), sb = *(const LAS f32x4*)(sx + (64 + j) * 36 + 4);
        const float wv[8] = {wa.x, wa.y, wa.z, wa.w, wb.x, wb.y, wb.z, wb.w}, sv[8] = {sa.x, sa.y, sa.z, sa.w, sb.x, sb.y, sb.z, sb.w};
#pragma unroll
        for (int t = 0; t < 8; ++t)
#pragma unroll
            for (int c = 0; c < 8; ++c) acc[t][c] = fmaf(sv[t], wv[c], acc[t][c]);
    }
    { f32x4 pa = *(const GAS f32x4*)(a0 + 8 * cg), pb = *(const GAS f32x4*)(a0 + 8 * cg + 4); const float pa0[8] = {pa.x, pa.y, pa.z, pa.w, pb.x, pb.y, pb.z, pb.w};
      pa = *(const GAS f32x4*)(k_k + 8 * cg); pb = *(const GAS f32x4*)(k_k + 8 * cg + 4); const float pkk[8] = {pa.x, pa.y, pa.z, pa.w, pb.x, pb.y, pb.z, pb.w};
      pa = *(const GAS f32x4*)(k_a + 8 * cg); pb = *(const GAS f32x4*)(k_a + 8 * cg + 4); const float pka[8] = {pa.x, pa.y, pa.z, pa.w, pb.x, pb.y, pb.z, pb.w};
      pa = *(const GAS f32x4*)(mu + 1024 + 8 * cg); pb = *(const GAS f32x4*)(mu + 1024 + 8 * cg + 4); const float pmu[8] = {pa.x, pa.y, pa.z, pa.w, pb.x, pb.y, pb.z, pb.w};
#pragma unroll
      for (int t = 0; t < 8; ++t) { const int tok = t0 + 8 * tg + t, pos = tok & (S - 1);
          const us8 cu = *(const GAS us8*)(PROJ16 + (size_t)tok * PN + 4096 + 8 * cg); us8 pr = cu; if (pos > 0) pr = *(const GAS us8*)(PROJ16 + (size_t)(tok - 1) * PN + 4096 + 8 * cg);
          float k0[8], kkv[8], ss = 0.f;
#pragma unroll
          for (int c = 0; c < 8; ++c) { const float cv = h2f(cu[c]), pv = pos > 0 ? h2f(pr[c]) : 0.f; k0[c] = cv + (pv - cv) * pmu[c]; kkv[c] = k0[c] * pkk[c]; ss = fmaf(kkv[c], kkv[c], ss); }
          ss = sum8_dpp(ss); const float inv = 1.f / fmaxf(sqrtf(ss), 1e-12f);
          float ok[8], oa[8], ob[8];
#pragma unroll
          for (int c = 0; c < 8; ++c) { const float asig = 1.f / (1.f + expf(-(pa0[c] + acc[t][c]))); const float kk = kkv[c] * inv; ok[c] = k0[c] * (1.f + (asig - 1.f) * pka[c]); oa[c] = -kk; ob[c] = kk * asig; }
          const size_t off = (size_t)tok * RWK + 8 * cg;
          *(GAS v4u*)(kmod + off) = (v4u){pk2h(ok[0], ok[1]), pk2h(ok[2], ok[3]), pk2h(ok[4], ok[5]), pk2h(ok[6], ok[7])};
          *(GAS v4u*)(Aout + off) = (v4u){pk2h(oa[0], oa[1]), pk2h(oa[2], oa[3]), pk2h(oa[4], oa[5]), pk2h(oa[6], oa[7])};
          *(GAS v4u*)(Bout + off) = (v4u){pk2h(ob[0], ob[1]), pk2h(ob[2], ob[3]), pk2h(ob[4], ob[5]), pk2h(ob[6], ob[7])}; } }
#pragma unroll
    for (int t = 0; t < 8; ++t)
#pragma unroll
        for (int c = 0; c < 8; ++c) acc[t][c] = 0.f;
#pragma unroll 2
    for (int j = 0; j < 160; ++j) {
        const f32x4 wa = *(const GAS f32x4*)(g2 + (size_t)j * 1024 + 8 * cg), wb = *(const GAS f32x4*)(g2 + (size_t)j * 1024 + 8 * cg + 4);
        const f32x4 sa = *(const LAS f32x4*)(sx + (128 + j) * 36), sb = *(const LAS f32x4*)(sx + (128 + j) * 36 + 4);
        const float wv[8] = {wa.x, wa.y, wa.z, wa.w, wb.x, wb.y, wb.z, wb.w}, sv[8] = {sa.x, sa.y, sa.z, sa.w, sb.x, sb.y, sb.z, sb.w};
#pragma unroll
        for (int t = 0; t < 8; ++t)
#pragma unroll
            for (int c = 0; c < 8; ++c) acc[t][c] = fmaf(sv[t], wv[c], acc[t][c]);
    }
#pragma unroll
    for (int t = 0; t < 8; ++t) *(GAS v4u*)(gout + (size_t)(t0 + 8 * tg + t) * RWK + 8 * cg) = (v4u){pk2h(acc[t][0], acc[t][1]), pk2h(acc[t][2], acc[t][3]), pk2h(acc[t][4], acc[t][5]), pk2h(acc[t][6], acc[t][7])};
    (void)p0v; (void)p1v;
}

__device__ __forceinline__ float sum16_dpp(float x) {
    x += __builtin_bit_cast(float, __builtin_amdgcn_update_dpp(0, __builtin_bit_cast(int, x), 0xB1, 0xF, 0xF, true));
    x += __builtin_bit_cast(float, __builtin_amdgcn_update_dpp(0, __builtin_bit_cast(int, x), 0x4E, 0xF, 0xF, true));
    x += __builtin_bit_cast(float, __builtin_amdgcn_update_dpp(0, __builtin_bit_cast(int, x), 0x141, 0xF, 0xF, true));
    x += __builtin_bit_cast(float, __builtin_amdgcn_update_dpp(0, __builtin_bit_cast(int, x), 0x140, 0xF, 0xF, true));
    return x;
}
__device__ __forceinline__ f32x4 h4f(const f16_t* p) { typedef _Float16 h4_t __attribute__((ext_vector_type(4))); const h4_t v = *(const GAS h4_t*)p; return (f32x4){(float)v[0], (float)v[1], (float)v[2], (float)v[3]}; }
__device__ __forceinline__ void rwkv_scan_unit(Frame& F, int bh, const f16_t* PROJ16, const float* mu, const float* decay, const f16_t* kmod, const f16_t* A16, const f16_t* B16, const f16_t* G16,
                                               const float* r_k, const float* lnx_g, const float* lnx_b, f16_t* Y16) {
    constexpr int SCH = 32, STEPF = 6 * 64;
    LAS float* buf0 = (LAS float*)(F.lds + RING_OFF);
    LAS float* ybuf = buf0 + 2 * SCH * STEPF;
    const int b = bh >> 4, h = bh & 15;
    const int lane = FLANE, tid = F.wave * 64 + lane;
    const int ss = tid >> 4, scg = tid & 15, ch0 = h * 64 + 4 * scg;
    const f32x4 mur = *(const GAS f32x4*)(mu + ch0), muv = *(const GAS f32x4*)(mu + 2048 + ch0);
    const int rs = lane >> 4, cg = lane & 15, i0 = 8 * F.wave + rs, i1 = i0 + 4;
    const float rk = r_k[h * 64 + lane], lg = lnx_g[h * 64 + lane], lb = lnx_b[h * 64 + lane];
    f32x4 S0 = (f32x4){0.f, 0.f, 0.f, 0.f}, S1 = S0;
    f32x4 st_r, st_w, st_k, st_a, st_b, st_v;
#define SCAN_LOAD(chunk) do { const int pos_ = (chunk) * SCH + ss; const size_t tok_ = (size_t)b * S + pos_; const size_t o_ = tok_ * RWK + ch0; \
        st_w = *(const GAS f32x4*)(decay + o_); st_k = h4f(kmod + o_); st_a = h4f(A16 + o_); st_b = h4f(B16 + o_); \
        const f16_t* cur_ = PROJ16 + tok_ * PN + 3072 + ch0; const f32x4 rc_ = h4f(cur_), vc_ = h4f(cur_ + 2048); \
        f32x4 rp_ = (f32x4){0.f, 0.f, 0.f, 0.f}, vp_ = rp_; if (pos_ > 0) { rp_ = h4f(cur_ - PN); vp_ = h4f(cur_ - PN + 2048); } \
        st_r = rc_ + (rp_ - rc_) * mur; st_v = vc_ + (vp_ - vc_) * muv; } while (0)
#define SCAN_WRITE(bufp) do { LAS float* d_ = (bufp) + ss * STEPF + 4 * scg; *(LAS f32x4*)(d_) = st_r; *(LAS f32x4*)(d_ + 64) = st_w; *(LAS f32x4*)(d_ + 128) = st_k; \
        *(LAS f32x4*)(d_ + 192) = st_a; *(LAS f32x4*)(d_ + 256) = st_b; *(LAS f32x4*)(d_ + 320) = st_v; } while (0)
    __syncthreads();
    SCAN_LOAD(0); SCAN_WRITE(buf0);
    __syncthreads();
    for (int c = 0; c < S / SCH; ++c) {
        LAS float* bufc = buf0 + (c & 1) * SCH * STEPF;
        if (c + 1 < S / SCH) SCAN_LOAD(c + 1);
        f32x4 r4 = *(const LAS f32x4*)(bufc + 4 * cg), w4 = *(const LAS f32x4*)(bufc + 64 + 4 * cg), k4 = *(const LAS f32x4*)(bufc + 128 + 4 * cg),
              a4 = *(const LAS f32x4*)(bufc + 192 + 4 * cg), b4 = *(const LAS f32x4*)(bufc + 256 + 4 * cg);
        float v0 = bufc[320 + i0], v1 = bufc[320 + i1];
#pragma unroll 2
        for (int s = 0; s < SCH; ++s) {
            const LAS float* stn = bufc + (s + 1 < SCH ? s + 1 : s) * STEPF;
            const f32x4 nr4 = *(const LAS f32x4*)(stn + 4 * cg), nw4 = *(const LAS f32x4*)(stn + 64 + 4 * cg), nk4 = *(const LAS f32x4*)(stn + 128 + 4 * cg),
                        na4 = *(const LAS f32x4*)(stn + 192 + 4 * cg), nb4 = *(const LAS f32x4*)(stn + 256 + 4 * cg);
            const float nv0 = stn[320 + i0], nv1 = stn[320 + i1];
            float sa0 = (S0.x * a4.x + S0.y * a4.y) + (S0.z * a4.z + S0.w * a4.w), sa1 = (S1.x * a4.x + S1.y * a4.y) + (S1.z * a4.z + S1.w * a4.w);
            const f32x4 t0 = S0 * w4 + k4 * v0, t1 = S1 * w4 + k4 * v1;
            sa0 = sum16_dpp(sa0); sa1 = sum16_dpp(sa1);
            S0 = t0 + b4 * sa0; S1 = t1 + b4 * sa1;
            float y0 = (S0.x * r4.x + S0.y * r4.y) + (S0.z * r4.z + S0.w * r4.w), y1 = (S1.x * r4.x + S1.y * r4.y) + (S1.z * r4.z + S1.w * r4.w);
            y0 = sum16_dpp(y0); y1 = sum16_dpp(y1);
            ybuf[s * 64 + i0] = y0; ybuf[s * 64 + i1] = y1;
            r4 = nr4; w4 = nw4; k4 = nk4; a4 = na4; b4 = nb4; v0 = nv0; v1 = nv1;
        }
        __syncthreads();
#pragma unroll
        for (int q = 0; q < 4; ++q) {
            const int s = 4 * F.wave + q; const LAS float* st = bufc + s * STEPF;
            const float yv = ybuf[s * 64 + lane];
            const float mean = wave_sum_b(yv) * (1.f / 64.f); const float dv = yv - mean; const float var = wave_sum_b(dv * dv) * (1.f / 64.f);
            const float yn = dv * (1.0f / sqrtf(var + 64e-5f)) * lg + lb;
            const float bs = wave_sum_b(st[lane] * st[128 + lane] * rk);
            const size_t tok = (size_t)b * S + c * SCH + s;
            const float gg = h2f(G16[tok * RWK + h * 64 + lane]);
            Y16[tok * D + 1024 + h * 64 + lane] = __builtin_bit_cast(unsigned short, (_Float16)((yn + bs * st[320 + lane]) * gg));
        }
        if (c + 1 < S / SCH) SCAN_WRITE(buf0 + ((c + 1) & 1) * SCH * STEPF);
        __syncthreads();
    }
#undef SCAN_LOAD
#undef SCAN_WRITE
}

#ifndef REP_P0
#define REP_P0 1
#endif
#ifndef REP_PROJ
#define REP_PROJ 1
#endif
#ifndef REP_PLE
#define REP_PLE 1
#endif
#ifndef REP_CONV
#define REP_CONV 1
#endif
#ifndef REP_P2
#define REP_P2 1
#endif
#ifndef REP_P3
#define REP_P3 1
#endif
#ifndef REP_P6
#define REP_P6 1
#endif
#ifndef REP_P7
#define REP_P7 1
#endif
struct Args { const float* in[37]; float* out; unsigned char* ws; int ph_lo, ph_hi, li, pad; };
__global__ void __launch_bounds__(NWAVES * 64, 2) mega_fwd(Args args) {
    extern __shared__ __attribute__((aligned(16))) unsigned char lds[];
    Frame F;
    F.lds = (LAS unsigned char*)lds; F.MISC = (volatile LAS unsigned*)(F.lds + MISC_OFF);
    F.wave = __builtin_amdgcn_readfirstlane(threadIdx.x >> 6);
    F.G = gridDim.x; { const int bx = blockIdx.x; F.vcu = (F.G % 8 == 0) ? (bx % 8) * (F.G / 8) + bx / 8 : bx; }
    unsigned char* ws = args.ws;
    F.ctl = (gu32*)(ws);
    for (int u = FTID; u < (LDS_BYTES - LDSCTL_OFF) / 4; u += NWAVES * 64) ((LAS unsigned*)(F.lds + LDSCTL_OFF))[u] = 0u;
    __syncthreads();
    XcdBarrier bar = xcd_barrier_post((unsigned*)(F.ctl + CW_BAR) + args.li * XCD_BAR_WORDS, F.MISC + 8);
    const int lo = args.ph_lo, hi = args.ph_hi;
#define IN(k) (lo <= (k) && (k) < hi)
#define BOTH(k) (IN(k) && IN((k) + 1))
    f16_t* WinT = (f16_t*)(ws + WS_WINT); f16_t* H16 = (f16_t*)(ws + WS_H16); f16_t* PROJ16 = (f16_t*)(ws + WS_PROJ16); float* DECAY = (float*)(ws + WS_DECAY); f16_t* KMOD = (f16_t*)(ws + WS_KMOD); f16_t* A16 = (f16_t*)(ws + WS_A16); f16_t* B16 = (f16_t*)(ws + WS_B16); f16_t* G16 = (f16_t*)(ws + WS_G16);
    f16_t* WoutT = (f16_t*)(ws + WS_WOUTT); f16_t* GateT = (f16_t*)(ws + WS_GATET); f16_t* PleT = (f16_t*)(ws + WS_PLET); f16_t* P16 = (f16_t*)(ws + WS_P16);
    f16_t* PW16 = (f16_t*)(ws + WS_PW16); f16_t* Y16 = (f16_t*)(ws + WS_Y16); float* ROWRS = (float*)(ws + WS_ROWRS);
    float* RT = (float*)(ws + WS_RT); f16_t* GUT = (f16_t*)(ws + WS_GUT); f16_t* DNT = (f16_t*)(ws + WS_DNT); f16_t* HID = (f16_t*)(ws + WS_HID); f16_t* FFN16 = (f16_t*)(ws + WS_FFN16); f16_t* H1_16 = (f16_t*)(ws + WS_H1_16);
    int* cnt = (int*)(ws + WS_CNT); int* ltok = (int*)(ws + WS_LTOK); int* lpair = (int*)(ws + WS_LPAIR); float* pairw = (float*)(ws + WS_PAIRW);
    const int gw = F.vcu * NWAVES + F.wave, NGW = F.G * NWAVES;
    if (IN(0)) for (int rep_ = 0; rep_ < REP_P0; ++rep_) {
        LAS float* scr = (LAS float*)(F.lds + RING_OFF + F.wave * 16384);
        constexpr int I_IN = (D / 64) * (NPROJ / 32);
        for (int it = gw; it < I_IN; it += NGW) p0_transpose_item(args.in[5], D, NPROJ, WinT, 0, scr, it, FLANE);
        constexpr int I_SQ = (D / 64) * (D / 32), I_PLE = (256 / 64) * (D / 32);
        for (int it = gw; it < 2 * I_SQ + I_PLE; it += NGW) {
            if (it < I_SQ) p0_transpose_item(args.in[22], D, D, WoutT, 0, scr, it, FLANE);
            else if (it < 2 * I_SQ) p0_transpose_item(args.in[36], D, D, GateT, 0, scr, it - I_SQ, FLANE);
            else p0_transpose_item(args.in[34], 256, D, PleT, 0, scr, it - 2 * I_SQ, FLANE);
        }
        { const GAS f32x4* pi = (const GAS f32x4*)args.in[1]; GAS unsigned long long* po = (GAS unsigned long long*)P16;
          for (int i = blockIdx.x * 512 + FTID; i < T * 256 / 4; i += F.G * 512) { const f32x4 v = pi[i]; po[i] = (unsigned long long)pk2h(v.x, v.y) | ((unsigned long long)pk2h(v.z, v.w) << 32); } }
        { GAS v4u* z = (GAS v4u*)(WinT + (size_t)NPROJ * D); const int nz = (PN - NPROJ) * D * 2 / 16;
          for (int i = blockIdx.x * 512 + FTID; i < nz; i += F.G * 512) z[i] = (v4u){0u, 0u, 0u, 0u}; }
        if (blockIdx.x == 0) {
            const int tid = FTID; float* lamp = (float*)(ws + WS_LAM); float* biasT = (float*)(ws + WS_BIAS);
            if (tid < 64) { const float a = wave_sum_b(args.in[6][tid] * args.in[7][tid]), b2 = wave_sum_b(args.in[8][tid] * args.in[9][tid]); if (tid == 0) *lamp = expf(a) - expf(b2) + LAMBDA_INIT; }
            for (int i = tid; i < 8 * 129; i += 512) { const int hh = i / 129, n = i % 129; int bucket;
                if (n < 16) bucket = n; else { const int large = 16 + (int)(logf((float)n / 16.f) / 2.0794415416798357f * 16.f); bucket = large < 31 ? large : 31; }
                biasT[i] = args.in[4][bucket * 8 + hh]; }
        }
        for (int m = gw; m < T; m += NGW) ln_row_dual(FLANE, args.in[0] + (size_t)m * D, args.in[2], args.in[3], args.out + (size_t)m * D, H16 + (size_t)m * D);
        if (BOTH(0) && rep_ == REP_P0 - 1) xcd_barrier(bar); else __syncthreads();
    }
    if (IN(1)) {
        pg8::Gemm g{H16, WinT, T, PN, D}; pg8::StaticOrder S; S.init(T, PN, F.G, (int)blockIdx.x);
        pg8::EpiF16 E{PROJ16, PN, 4, att::C2};
        for (int rep_ = 0; rep_ < REP_PROJ; ++rep_) pg8::gemm_phase<pg8::EpiF16, pg8::StaticOrder, true>(F.lds + RING_OFF, g, S, E, F.wave);
        for (int rep_ = 0; rep_ < REP_PLE; ++rep_) { pg8::Gemm g2{P16, PleT, T, D, 256}; pg8::StaticOrder S2; S2.init(T, D, F.G, (int)blockIdx.x);
          pg8::EpiF16 E2{PW16, D, 0, 1.f};
          pg8::gemm_phase<pg8::EpiF16, pg8::StaticOrder, true>(F.lds + RING_OFF, g2, S2, E2, F.wave); }
        if (BOTH(1)) xcd_barrier(bar);
    }
    if (IN(2)) {
        for (int rep_ = 0; rep_ < REP_P2; ++rep_)
        for (int tile = F.vcu; tile < T / 32; tile += F.G) {
            rwkv_prep_tile(F, tile, PROJ16, args.in[11], args.in[12], args.in[13], args.in[14], args.in[15], args.in[16], args.in[17], args.in[18], DECAY, KMOD, A16, B16, G16);
            asm volatile("s_waitcnt vmcnt(0)" ::: "memory"); __syncthreads();
            for (int hA = 0; hA < 16; hA += 2) rk::chunk_pair(F.lds + RING_OFF, F.wave, tile, hA, PROJ16, args.in[11], DECAY, KMOD, A16, B16, args.in[19], ws + WS_CHK, (float*)(ws + WS_BONUS));
            __syncthreads();
        }
        if (BOTH(2)) xcd_barrier(bar);
    }
    if (IN(3)) {
        for (int rep_ = 0; rep_ < REP_P3; ++rep_)
        if (F.vcu < 64) rk::scan_unit(F.lds + RING_OFF, F.wave, F.vcu, ws + WS_CHK, (const float*)(ws + WS_BONUS), PROJ16, args.in[11], G16, args.in[20], args.in[21], Y16);
        else if (F.vcu < 256) {
            const int a = F.vcu - 64, bh = a / 6, L0 = a % 6;
            const float lam = *(const float*)(ws + WS_LAM); const float* biasG = (const float*)(ws + WS_BIAS) + (bh & 7) * 129;
            att::attn_unit<8>(F.lds + RING_OFF, F.wave, bh >> 3, bh & 7, 15 - L0, PROJ16, Y16, biasG, lam, args.in[10]);
            att::attn_unit<8>(F.lds + RING_OFF, F.wave, bh >> 3, bh & 7, 4 + L0, PROJ16, Y16, biasG, lam, args.in[10]);
            if (L0 < 4) att::attn_unit<8>(F.lds + RING_OFF, F.wave, bh >> 3, bh & 7, 3 - L0, PROJ16, Y16, biasG, lam, args.in[10]);
        }
        if (BOTH(3)) xcd_barrier(bar);
    }
    if (IN(4)) {
        for (int rep_ = 0; rep_ < REP_CONV; ++rep_) {
            __syncthreads();
        LAS float* scr = (LAS float*)(F.lds + RING_OFF + F.wave * 16384);
        for (int it = gw; it < NE * 1536; it += NGW) {
            const int e = it / 1536, r = it % 1536;
            if (r < 512) p0_transpose_item_gu(args.in[29] + (size_t)e * D * 512, D, 512, GUT + (size_t)e * 1024 * D, 0, scr, r, FLANE);
            else if (r < 1024) p0_transpose_item_gu(args.in[30] + (size_t)e * D * 512, D, 512, GUT + (size_t)e * 1024 * D, 1, scr, r - 512, FLANE);
            else p0_transpose_item_gu(args.in[31] + (size_t)e * 512 * D, 512, D, DNT + (size_t)e * D * 512, -1, scr, r - 1024, FLANE);
        }
        for (int i = blockIdx.x * 512 + FTID; i < 36 * D; i += F.G * 512) { const int e = i / D, d = i % D; RT[i] = e < 4 ? args.in[25][d * 4 + e] : args.in[27][d * 32 + (e - 4)]; }
            asm volatile("s_waitcnt vmcnt(0) lgkmcnt(0)" ::: "memory"); __syncthreads();
        }
        pg8::Gemm g{Y16, WoutT, T, D, D}; pg8::StaticOrder S; S.init(T, D, F.G, (int)blockIdx.x);
        pg8::EpiResF32 E{args.out, D, ALPHA};
        pg8::gemm_phase<pg8::EpiResF32, pg8::StaticOrder, true>(F.lds + RING_OFF, g, S, E, F.wave);
        if (BOTH(4)) xcd_barrier(bar);
    }
    if (IN(5)) {
        const int lane = FLANE;
        for (int blk = F.vcu; blk < T / 32; blk += F.G)
            for (int pass = 0; pass < 2; ++pass) {
                const int r0 = blk * 32 + F.wave * 4 + pass * 2;
                f32x4 v0[8], v1[8];
                { const GAS f32x4* xr = (const GAS f32x4*)(args.out + (size_t)r0 * D) + lane;
#pragma unroll
                  for (int j = 0; j < 8; ++j) { v0[j] = xr[64 * j]; v1[j] = xr[64 * j + D / 4]; } }
                ln_regs(lane, v0, args.in[23], args.in[24], args.out + (size_t)r0 * D, H1_16 + (size_t)r0 * D);
                ln_regs(lane, v1, args.in[23], args.in[24], args.out + (size_t)(r0 + 1) * D, H1_16 + (size_t)(r0 + 1) * D);
                LAS float* lg = (LAS float*)(F.lds + RING_OFF) + F.wave * 128;
                const GAS f32x4* rt4 = (const GAS f32x4*)RT + lane;
#pragma unroll 1
                for (int ec = 0; ec < 6; ++ec) {
                    float a0[6], a1[6];
#pragma unroll
                    for (int e = 0; e < 6; ++e) { a0[e] = 0.f; a1[e] = 0.f; }
#pragma unroll
                    for (int j = 0; j < 8; ++j)
#pragma unroll
                        for (int e = 0; e < 6; ++e) { const f32x4 w = rt4[(ec * 6 + e) * (D / 4) + 64 * j];
                            a0[e] += (v0[j].x * w.x + v0[j].y * w.y) + (v0[j].z * w.z + v0[j].w * w.w);
                            a1[e] += (v1[j].x * w.x + v1[j].y * w.y) + (v1[j].z * w.z + v1[j].w * w.w); }
#pragma unroll
                    for (int e = 0; e < 6; ++e) { a0[e] = wave_sum_b(a0[e]); a1[e] = wave_sum_b(a1[e]); }
                    if (lane == 0) {
#pragma unroll
                        for (int e = 0; e < 6; ++e) { lg[ec * 6 + e] = a0[e]; lg[64 + ec * 6 + e] = a1[e]; } }
                }
                LDS_WAIT();
                if (lane == 0) { float a0[36], a1[36];
#pragma unroll
                    for (int e = 0; e < 36; ++e) { a0[e] = lg[e]; a1[e] = lg[64 + e]; }
                    route_token(r0, a0, args.in[26], args.in[28], cnt, ltok, lpair, pairw); route_token(r0 + 1, a1, args.in[26], args.in[28], cnt, ltok, lpair, pairw); }
                LDS_WAIT();
            }
        if (BOTH(5)) xcd_barrier(bar);
    }
    if (IN(6)) {
        build_moe_table(F, cnt);
        pg8::Gemm g{H1_16, GUT, 0, 0, D}; pg8::MoeOrder<true> S{(const LAS int*)(F.lds + TAB_OFF), ltok, F.vcu, F.G, 4, (size_t)1024 * D * 2};
        pg8::EpiGU E{HID};
        for (int rep_ = 0; rep_ < REP_P6; ++rep_) pg8::gemm_phase<pg8::EpiGU, pg8::MoeOrder<true>, true>(F.lds + RING_OFF, g, S, E, F.wave);
        if (BOTH(6)) xcd_barrier(bar);
    }
    if (IN(7)) {
        build_moe_table(F, cnt);
        pg8::Gemm g{HID, DNT, 0, 0, 512}; pg8::MoeOrder<false> S{(const LAS int*)(F.lds + TAB_OFF), nullptr, F.vcu, F.G, 8, (size_t)D * 512 * 2};
        pg8::EpiDown E{FFN16, lpair};
        for (int rep_ = 0; rep_ < REP_P7; ++rep_) pg8::gemm_phase<pg8::EpiDown, pg8::MoeOrder<false>, true>(F.lds + RING_OFF, g, S, E, F.wave);
        if (BOTH(7)) xcd_barrier(bar);
    }
    if (IN(8)) {
        typedef _Float16 h4_t __attribute__((ext_vector_type(4)));
        const int lane = FLANE;
        for (int m = gw; m < T; m += NGW) {
            f32x4 v[8]; const GAS f32x4* xr = (const GAS f32x4*)(args.out + (size_t)m * D) + lane;
            const GAS h4_t* f0 = (const GAS h4_t*)(FFN16 + (size_t)(2 * m) * D) + lane; const GAS h4_t* f1 = (const GAS h4_t*)(FFN16 + (size_t)(2 * m + 1) * D) + lane;
            const GAS h4_t* pr = (const GAS h4_t*)(PW16 + (size_t)m * D) + lane;
            const float w0 = pairw[2 * m], w1 = pairw[2 * m + 1]; float q = 0.f;
#pragma unroll
            for (int j = 0; j < 8; ++j) { const f32x4 x = xr[64 * j]; const h4_t a = f0[64 * j], c = f1[64 * j], pv = pr[64 * j];
                v[j].x = ALPHA * x.x + w0 * (float)a[0] + w1 * (float)c[0]; v[j].y = ALPHA * x.y + w0 * (float)a[1] + w1 * (float)c[1];
                v[j].z = ALPHA * x.z + w0 * (float)a[2] + w1 * (float)c[2]; v[j].w = ALPHA * x.w + w0 * (float)a[3] + w1 * (float)c[3];
                q += ((float)pv[0] * (float)pv[0] + (float)pv[1] * (float)pv[1]) + ((float)pv[2] * (float)pv[2] + (float)pv[3] * (float)pv[3]); }
            ln_regs(lane, v, args.in[32], args.in[33], args.out + (size_t)m * D, Y16 + (size_t)m * D);
            q = wave_sum_b(q);
            if (lane == 0) ROWRS[m] = 1.0f / sqrtf(q * (1.f / D) + LN_EPS);
        }
        if (BOTH(8)) xcd_barrier(bar);
    }
    if (IN(9)) {
        pg8::Gemm g{Y16, GateT, T, D, D}; pg8::StaticOrder S; S.init(T, D, F.G, (int)blockIdx.x);
        pg8::EpiFinal E{args.out, D, PW16, ROWRS, args.in[35]};
        pg8::gemm_phase<pg8::EpiFinal, pg8::StaticOrder, true>(F.lds + RING_OFF, g, S, E, F.wave);
    }
#undef IN
#undef BOTH
}

extern "C" void kernel_launch(void* const* d_in, const int* in_sizes, int n_in, void* d_out, int out_size, void* d_ws, size_t ws_size, hipStream_t stream) {
    static int grid = 0;
    if (grid == 0) {
        if (ws_size < WS_END2 || n_in != 37 || out_size != T * D) { fprintf(stderr, "kernel_launch: bad ws/n_in/out: %zu %d %d\n", ws_size, n_in, out_size); grid = -1; return; }
        int dev = 0, cus = 0;
        if (hipGetDevice(&dev) != hipSuccess || hipDeviceGetAttribute(&cus, hipDeviceAttributeMultiprocessorCount, dev) != hipSuccess) { grid = -1; return; }
        if (hipFuncSetAttribute((const void*)mega_fwd, hipFuncAttributeMaxDynamicSharedMemorySize, LDS_BYTES) != hipSuccess) { fprintf(stderr, "kernel_launch: hipFuncSetAttribute failed\n"); grid = -1; return; }
        if (cus != 256) { fprintf(stderr, "kernel_launch: built for a 256-CU device, found %d\n", cus); grid = -1; return; }
        grid = cus;
    }
    if (grid < 0) return;
    (void)hipMemsetAsync(d_ws, 0, CTL_ZERO_BYTES, stream);
    Args a{}; for (int i = 0; i < 37; ++i) a.in[i] = (const float*)d_in[i]; a.out = (float*)d_out; a.ws = (unsigned char*)d_ws; a.ph_lo = 0; a.ph_hi = 10; a.li = 0;
    hipLaunchKernelGGL(mega_fwd, dim3(grid), dim3(NWAVES * 64), LDS_BYTES, stream, a);
}
```

```cpp
#include <hip/hip_runtime.h>
#include <cstdio>
#include <cstdint>
#include <cmath>

constexpr int NB = 4, S = 2048, D = 2048, T = NB * S;
constexpr int NPROJ = 6432;
constexpr int RWK = 1024;
constexpr int COL_Q = 0, COL_K = 1024, COL_V = 2048, COL_RW = 3072;
constexpr int NH = 8, NRH = 16;
constexpr int NE = 32;
constexpr float LN_EPS = 1e-5f;
constexpr float ALPHA = 1.189207115002721f;
constexpr float LAMBDA_INIT = 0.2f;

constexpr size_t MiB = 1u << 20;
constexpr size_t WS_CNT = 0;
constexpr size_t WS_LTOK = 1 * MiB;
constexpr size_t WS_LPAIR = 2 * MiB;
constexpr size_t WS_PAIRW = 3 * MiB;
constexpr size_t WS_RT = 3 * MiB + 128 * 1024;
constexpr size_t WS_LAM = 3 * MiB + 512 * 1024;
constexpr size_t WS_BIAS = 3 * MiB + 512 * 1024 + 1024;
constexpr size_t WS_ROWRS = 3 * MiB + 768 * 1024;
constexpr size_t WS_WINT = 4 * MiB;
constexpr size_t WS_WOUTT = 30 * MiB;
constexpr size_t WS_GATET = 38 * MiB;
constexpr size_t WS_PLET = 46 * MiB;
constexpr size_t WS_P16 = 47 * MiB;
constexpr size_t WS_W2T = 51 * MiB;
constexpr size_t WS_A2T = 51 * MiB + 128 * 1024;
constexpr size_t WS_G2T = 51 * MiB + 256 * 1024;
constexpr size_t WS_CHK = 52 * MiB;
constexpr size_t WS_BONUS = 148 * MiB;
constexpr size_t WS_LSLAB = 150 * MiB;
constexpr size_t WS_GUT = 244 * MiB;
constexpr size_t WS_DNT = 372 * MiB;
constexpr size_t WS_PROJ16 = 244 * MiB;
constexpr size_t WS_FFN16 = 52 * MiB;
constexpr size_t WS_HID = 116 * MiB;
constexpr size_t WS_DECAY = 348 * MiB;
constexpr size_t WS_KMOD = 380 * MiB;
constexpr size_t WS_A16 = 396 * MiB;
constexpr size_t WS_B16 = 412 * MiB;
constexpr size_t WS_G16 = 428 * MiB;
constexpr size_t WS_H16 = 444 * MiB;
constexpr size_t WS_H1_16 = WS_H16;
constexpr size_t WS_Y16 = 476 * MiB;
constexpr size_t WS_PW16 = 508 * MiB;
constexpr size_t WS_END2 = 540 * MiB;

namespace pg8 {
#define PG8_LAS __attribute__((address_space(3)))
typedef unsigned short f16_t;
typedef _Float16 f16x8 __attribute__((ext_vector_type(8)));
typedef float f32x4 __attribute__((ext_vector_type(4)));
typedef unsigned u32x4 __attribute__((ext_vector_type(4)));
constexpr int BM = 256, BK = 64, HALF = 128, HTB = HALF * BK * 2  , STAGE_BYTES = 8 * HTB, NXCD = 8, WGM = 8;

__host__ __device__ __forceinline__ int lds_byte(int r, int c) { const int st = (r >> 4) * 2 + (c >> 5), rr = r & 15, cc = c & 31, ob = rr * 64 + cc * 2; return st * 1024 + (ob ^ (((ob >> 9) & 1) << 5)); }
__host__ __device__ __forceinline__ void stage_rc(int b, int& R, int& C) { const int st = b / 1024, sb = b % 1024, swz = sb ^ (((sb >> 9) & 1) << 5); R = (st >> 1) * 16 + swz / 64; C = (st & 1) * 32 + (swz % 64) / 2; }
__host__ __device__ __forceinline__ int perm32(int rho) { const int n = rho >> 4, i = rho & 15; return 8 * (i >> 2) + 4 * n + (i & 3); }

__device__ __forceinline__ int lane_id() { int l; asm volatile("v_mbcnt_lo_u32_b32 %0, -1, 0\n\tv_mbcnt_hi_u32_b32 %0, -1, %0" : "=v"(l)); return l; }
struct Unit { int pm, pn, e, rb, cnt; };
struct Gemm { const f16_t* A; const f16_t* Bt; int M, N, K, ld; };

struct StaticOrder {
    int nM, nN, nwg, G, c;
    __host__ __device__ void init(int M, int N, int G_, int c_) { nM = M / BM; nN = N / BM; nwg = nM * nN; G = G_; c = c_; }
    __host__ __device__ bool next(int i, Unit& u) const {
        const long L = (long)i * G + c; if (L >= nwg) return false;
        int wgid = (int)L; { const int q = nwg / NXCD, r = nwg % NXCD, xcd = wgid % NXCD, off = wgid / NXCD; wgid = (xcd < r ? xcd * (q + 1) : r * (q + 1) + (xcd - r) * q) + off; }
        const int nig = WGM * nN, gid = wgid / nig, fm = gid * WGM, gsz = (nM - fm) < WGM ? (nM - fm) : WGM;
        u.pm = fm + ((wgid % nig) % gsz); u.pn = (wgid % nig) / gsz; return true;
    }
    __device__ __forceinline__ void a_ready(const Unit&) const {}
    __device__ __forceinline__ void done(const Unit&) const {}
    __device__ __forceinline__ const char* a_base(const Gemm& g, const Unit& u) const { return (const char*)g.A + (size_t)u.pm * ((size_t)BM * g.ld * 2); }
    __device__ __forceinline__ const char* b_base(const Gemm& g, const Unit& u) const { return (const char*)g.Bt + (size_t)u.pn * ((size_t)BM * g.ld * 2); }
    __device__ __forceinline__ void a_voff(const Gemm& g, const Unit&, int tid, unsigned (&va)[2][2]) const {
#pragma unroll
        for (int i = 0; i < 2; ++i) { int R, C; stage_rc(tid * 16 + i * 8192, R, C); va[0][i] = (unsigned)(R * g.ld + C) * 2u; va[1][i] = va[0][i] + (unsigned)(HALF * g.ld * 2); }
    }
};
struct SplitKOrder {
    int nM, nN, nks, G, c;
    __device__ __forceinline__ bool next(int i, Unit& u) const { const int L = i * G + c; if (L >= nM * nN * nks) return false; u.e = L / (nM * nN); const int rem = L % (nM * nN); u.pn = rem / nM; u.pm = rem % nM; u.rb = 0; u.cnt = 0; return true; }
    __device__ __forceinline__ void a_ready(const Unit&) const {}
    __device__ __forceinline__ void done(const Unit&) const {}
    __device__ __forceinline__ const char* a_base(const Gemm& g, const Unit& u) const { return (const char*)g.A + (size_t)u.pm * ((size_t)BM * g.ld * 2) + (size_t)u.e * g.K * 2; }
    __device__ __forceinline__ const char* b_base(const Gemm& g, const Unit& u) const { return (const char*)g.Bt + (size_t)u.pn * ((size_t)BM * g.ld * 2) + (size_t)u.e * g.K * 2; }
    __device__ __forceinline__ void a_voff(const Gemm& g, const Unit&, int tid, unsigned (&va)[2][2]) const {
#pragma unroll
        for (int i = 0; i < 2; ++i) { int R, C; stage_rc(tid * 16 + i * 8192, R, C); va[0][i] = (unsigned)(R * g.ld + C) * 2u; va[1][i] = va[0][i] + (unsigned)(HALF * g.ld * 2); }
    }
};
template <bool GATHER> struct MoeOrder {
    const PG8_LAS int* tab; const int* list; int vcu, G, ntn; size_t estride;
    __device__ __forceinline__ bool next(int i, Unit& u) const {
        const int L = vcu + i * G; const int tot = tab[64] * ntn; if (L >= tot) return false;
        int e = 0; while (tab[33 + e] * ntn <= L) ++e;
        const int nb = tab[33 + e] - tab[32 + e], q = L - tab[32 + e] * ntn;
        u.e = __builtin_amdgcn_readfirstlane(e); u.pn = __builtin_amdgcn_readfirstlane(q / nb); u.rb = __builtin_amdgcn_readfirstlane(q % nb);
        u.pm = __builtin_amdgcn_readfirstlane(tab[32 + e] + q % nb); u.cnt = __builtin_amdgcn_readfirstlane(tab[e]); return true;
    }
    __device__ __forceinline__ void a_ready(const Unit&) const {}
    __device__ __forceinline__ void done(const Unit&) const {}
    __device__ __forceinline__ const char* a_base(const Gemm& g, const Unit& u) const { return GATHER ? (const char*)g.A : (const char*)g.A + (size_t)u.pm * ((size_t)BM * g.ld * 2); }
    __device__ __forceinline__ const char* b_base(const Gemm& g, const Unit& u) const { return (const char*)g.Bt + (size_t)u.e * estride + (size_t)u.pn * ((size_t)BM * g.ld * 2); }
    __device__ __forceinline__ void a_voff(const Gemm& g, const Unit& u, int tid, unsigned (&va)[2][2]) const {
#pragma unroll
        for (int i = 0; i < 2; ++i) { int R, C; stage_rc(tid * 16 + i * 8192, R, C);
            if (GATHER) {
#pragma unroll
                for (int h = 0; h < 2; ++h) { int idx = u.rb * BM + h * HALF + R; idx = idx < u.cnt ? idx : u.cnt - 1; const int tok = list[u.e * 8192 + idx]; va[h][i] = (unsigned)(tok * g.ld + C) * 2u; }
            } else { va[0][i] = (unsigned)(R * g.ld + C) * 2u; va[1][i] = va[0][i] + (unsigned)(HALF * g.ld * 2); } }
    }
};


typedef _Float16 h2_t __attribute__((ext_vector_type(2)));
__device__ __forceinline__ unsigned cvt_pk_f16(float lo, float hi) { h2_t v = {(_Float16)lo, (_Float16)hi}; return __builtin_bit_cast(unsigned, v); }
struct EpiF16 {
    static constexpr bool PERM = true, AFTER_DRAIN = false;
    f16_t* O; int ldc; int ntile0; float scale0;
    __device__ __forceinline__ void operator()(const f32x4 (&acc)[2][2][4][2], const Unit& u, int wr, int wc, int fr, int fq) const {
        const int row0 = u.pm * BM + wr * 64 + fr; const int col0 = u.pn * BM + wc * 32 + 8 * fq;
        const float sc = (u.pn < ntile0) ? scale0 : 1.f;
#pragma unroll
        for (int ai = 0; ai < 2; ++ai)
#pragma unroll
            for (int m = 0; m < 4; ++m) { f16_t* rowp = O + (size_t)(row0 + ai * HALF + m * 16) * ldc + col0;
#pragma unroll
                for (int bj = 0; bj < 2; ++bj) { f32x4 v0 = acc[ai][bj][m][0] * sc, v1 = acc[ai][bj][m][1] * sc;
                    u32x4 w; w.x = cvt_pk_f16(v0[0], v0[1]); w.y = cvt_pk_f16(v0[2], v0[3]); w.z = cvt_pk_f16(v1[0], v1[1]); w.w = cvt_pk_f16(v1[2], v1[3]);
                    *(u32x4*)(rowp + bj * HALF) = w; } }
    }
};


struct EpiSlab {
    static constexpr bool PERM = true, AFTER_DRAIN = false;
    f16_t* O; int ldc; size_t slab;
    __device__ __forceinline__ void operator()(const f32x4 (&acc)[2][2][4][2], const Unit& u, int wr, int wc, int fr, int fq) const {
        const int row0 = u.pm * BM + wr * 64 + fr; const int col0 = u.pn * BM + wc * 32 + 8 * fq; f16_t* Ob = O + (size_t)u.e * slab;
#pragma unroll
        for (int ai = 0; ai < 2; ++ai)
#pragma unroll
            for (int m = 0; m < 4; ++m) { f16_t* rowp = Ob + (size_t)(row0 + ai * HALF + m * 16) * ldc + col0;
#pragma unroll
                for (int bj = 0; bj < 2; ++bj) { const f32x4 v0 = acc[ai][bj][m][0], v1 = acc[ai][bj][m][1];
                    u32x4 w; w.x = cvt_pk_f16(v0[0], v0[1]); w.y = cvt_pk_f16(v0[2], v0[3]); w.z = cvt_pk_f16(v1[0], v1[1]); w.w = cvt_pk_f16(v1[2], v1[3]);
                    *(u32x4*)(rowp + bj * HALF) = w; } }
    }
};
struct EpiResF32 {
    static constexpr bool PERM = false, AFTER_DRAIN = false;
    float* io; int ldc; float alpha;
    __device__ __forceinline__ void operator()(const f32x4 (&acc)[2][2][4][2], const Unit& u, int wr, int wc, int fr, int fq) const {
        const int row0 = u.pm * BM + wr * 64 + fr; const int col0 = u.pn * BM + wc * 32 + 4 * fq;
#pragma unroll
        for (int ai = 0; ai < 2; ++ai)
#pragma unroll
            for (int m = 0; m < 4; ++m) { float* rowp = io + (size_t)(row0 + ai * HALF + m * 16) * ldc + col0;
#pragma unroll
                for (int bj = 0; bj < 2; ++bj)
#pragma unroll
                    for (int n = 0; n < 2; ++n) { f32x4* p = (f32x4*)(rowp + bj * HALF + n * 16); const f32x4 r = *p; *p = r * alpha + acc[ai][bj][m][n]; } }
    }
};
struct EpiFinal {
    static constexpr bool PERM = false, AFTER_DRAIN = false;
    float* io; int ldc; const f16_t* pw; const float* rowrs; const float* g;
    __device__ __forceinline__ void operator()(const f32x4 (&acc)[2][2][4][2], const Unit& u, int wr, int wc, int fr, int fq) const {
        typedef _Float16 h4_t __attribute__((ext_vector_type(4)));
        const int row0 = u.pm * BM + wr * 64 + fr; const int col0 = u.pn * BM + wc * 32 + 4 * fq;
#pragma unroll
        for (int ai = 0; ai < 2; ++ai)
#pragma unroll
            for (int m = 0; m < 4; ++m) { const int row = row0 + ai * HALF + m * 16; const size_t off = (size_t)row * ldc + col0;
                const float rs = rowrs[row];
#pragma unroll
                for (int bj = 0; bj < 2; ++bj)
#pragma unroll
                    for (int n = 0; n < 2; ++n) { f32x4* p = (f32x4*)(io + off + bj * HALF + n * 16); const f32x4 hv = *p; const h4_t pv = *(const h4_t*)(pw + off + bj * HALF + n * 16);
                        const f32x4 gv = *(const f32x4*)(g + col0 + bj * HALF + n * 16);
                        const f32x4 a = acc[ai][bj][m][n]; f32x4 o;
#pragma unroll
                        for (int c = 0; c < 4; ++c) o[c] = hv[c] + (1.f / (1.f + __expf(-a[c]))) * ((float)pv[c] * rs) * gv[c];
                        *p = o; }
                asm volatile("" ::: "memory"); }
    }
};

struct EpiGU {
    static constexpr bool PERM = true, AFTER_DRAIN = false;
    f16_t* O;
    __device__ __forceinline__ void operator()(const f32x4 (&acc)[2][2][4][2], const Unit& u, int wr, int wc, int fr, int fq) const {
        const int row0 = u.pm * BM + wr * 64 + fr; const int col0 = u.pn * HALF + wc * 32 + 8 * fq;
#pragma unroll
        for (int ai = 0; ai < 2; ++ai)
#pragma unroll
            for (int m = 0; m < 4; ++m) { f16_t* rowp = O + (size_t)(row0 + ai * HALF + m * 16) * 512 + col0; float o[8];
#pragma unroll
                for (int n = 0; n < 2; ++n)
#pragma unroll
                    for (int c = 0; c < 4; ++c) { const float gt = acc[ai][0][m][n][c], up = acc[ai][1][m][n][c]; o[n * 4 + c] = gt / (1.f + __expf(-gt)) * up; }
                u32x4 w; w.x = cvt_pk_f16(o[0], o[1]); w.y = cvt_pk_f16(o[2], o[3]); w.z = cvt_pk_f16(o[4], o[5]); w.w = cvt_pk_f16(o[6], o[7]);
                *(u32x4*)rowp = w; }
    }
};
struct EpiDown {
    static constexpr bool PERM = true, AFTER_DRAIN = false;
    f16_t* O; const int* lpair;
    __device__ __forceinline__ void operator()(const f32x4 (&acc)[2][2][4][2], const Unit& u, int wr, int wc, int fr, int fq) const {
        const int r0 = u.rb * BM + wr * 64 + fr; const int col0 = u.pn * BM + wc * 32 + 8 * fq;
#pragma unroll
        for (int ai = 0; ai < 2; ++ai)
#pragma unroll
            for (int m = 0; m < 4; ++m) { const int r = r0 + ai * HALF + m * 16;
                if (r < u.cnt) { const int pair = lpair[u.e * 8192 + r]; f16_t* rowp = O + (size_t)pair * 2048 + col0;
#pragma unroll
                    for (int bj = 0; bj < 2; ++bj) { const f32x4 v0 = acc[ai][bj][m][0], v1 = acc[ai][bj][m][1];
                        u32x4 w; w.x = cvt_pk_f16(v0[0], v0[1]); w.y = cvt_pk_f16(v0[2], v0[3]); w.z = cvt_pk_f16(v1[0], v1[1]); w.w = cvt_pk_f16(v1[2], v1[3]);
                        *(u32x4*)(rowp + bj * HALF) = w; } } }
    }
};
template <class Epi, class Sched, bool ALIGN_EPI = false, bool SP2 = true>
__device__ __forceinline__ void gemm_phase(PG8_LAS unsigned char* lds, const Gemm g, const Sched& S, const Epi& E, const int wid) {
    static_assert(SP2, "only the SP2 K-loop is kept in this file");
    const int lane = lane_id(), tid = wid * 64 + lane, wr = wid >> 2, wc = wid & 3, fr = lane & 15, fq = lane >> 4;
    const int K = g.ld, nt = g.K / BK;
    unsigned voffB[2];
#pragma unroll
    for (int i = 0; i < 2; ++i) { int R, C; stage_rc(tid * 16 + i * 8192, R, C); const int Rb = Epi::PERM ? ((R & ~31) + perm32(R & 31)) : R;
        voffB[i] = (unsigned)(Rb * K + C) * 2u; }
    const size_t kstep = (size_t)(BK * 2);
    const size_t hstep = (size_t)HALF * K * 2;
    const unsigned ldsw = (unsigned)wid * 1024u;
    const int aoff = lds_byte(wr * 64 + fr, fq * 8), boff = lds_byte(wc * 32 + fr, fq * 8);
#define PG8_SA(b, h) (((b) * 2 + (h)) * HTB)
#define PG8_SB(b, h) ((4 + (b) * 2 + (h)) * HTB)
#define PG8_STAGE(bufoff, gbase, voff) do { _Pragma("unroll") for (int _i = 0; _i < 2; ++_i) \
        __builtin_amdgcn_global_load_lds((const unsigned*)((const char*)(gbase) + (voff)[_i]), (PG8_LAS unsigned*)(lds + (bufoff) + ldsw + _i * 8192), 16, 0, 0); } while (0)
#define PG8_LDA(dst, b, h) do { _Pragma("unroll") for (int m = 0; m < 4; ++m) _Pragma("unroll") for (int k = 0; k < 2; ++k) dst[m][k] = *(const PG8_LAS f16x8*)(lds + PG8_SA(b, h) + aoff + m * 2048 + k * 1024); } while (0)
#define PG8_LDB(dst, b, h) do { _Pragma("unroll") for (int n = 0; n < 2; ++n) _Pragma("unroll") for (int k = 0; k < 2; ++k) dst[n][k] = *(const PG8_LAS f16x8*)(lds + PG8_SB(b, h) + boff + n * 2048 + k * 1024); } while (0)
#define PG8_MMA(ai, bj, At, Bt) do { __builtin_amdgcn_s_setprio(1); _Pragma("unroll") for (int m = 0; m < 4; ++m) _Pragma("unroll") for (int n = 0; n < 2; ++n) _Pragma("unroll") for (int k = 0; k < 2; ++k) \
        acc[ai][bj][m][n] = __builtin_amdgcn_mfma_f32_16x16x32_f16(Bt[n][k], At[m][k], acc[ai][bj][m][n], 0, 0, 0); __builtin_amdgcn_s_setprio(0); } while (0)
#define PG8_WAIT_V(n) asm volatile("s_waitcnt vmcnt(" #n ")" ::: "memory")
#define PG8_WAIT_L(n) asm volatile("s_waitcnt lgkmcnt(" #n ")" ::: "memory")
#define PG8_BAR __builtin_amdgcn_s_barrier()
#define PG8_SCHED __builtin_amdgcn_sched_barrier(0)
    Unit cur, nxt; int ui = 0;
    if (!S.next(0, cur)) return;
    f32x4 acc[2][2][4][2];
#pragma unroll
    for (int a = 0; a < 2; ++a)
#pragma unroll
        for (int b = 0; b < 2; ++b)
#pragma unroll
            for (int m = 0; m < 4; ++m)
#pragma unroll
                for (int n = 0; n < 2; ++n) acc[a][b][m][n] = (f32x4){0.f, 0.f, 0.f, 0.f};
    f16x8 At[4][2], B0[2][2], B1[2][2];
    const char* cA = S.a_base(g, cur); const char* cB = S.b_base(g, cur);
    unsigned vaC[2][2];
    S.a_voff(g, cur, tid, vaC);
    S.a_ready(cur);
    PG8_STAGE(PG8_SB(0, 0), cB, voffB); PG8_STAGE(PG8_SB(0, 1), cB + hstep, voffB); PG8_STAGE(PG8_SA(0, 0), cA, vaC[0]); PG8_STAGE(PG8_SA(0, 1), cA, vaC[1]);
    if (wr == 1) PG8_BAR;
    PG8_WAIT_V(2); PG8_BAR;
    PG8_STAGE(PG8_SB(1, 0), cB + kstep, voffB); PG8_STAGE(PG8_SA(1, 0), cA + kstep, vaC[0]); PG8_STAGE(PG8_SB(1, 1), cB + hstep + kstep, voffB);
    PG8_WAIT_V(6); PG8_BAR;
    for (;;) {
        const bool has_next = S.next(ui + 1, nxt);
        const char* nA = has_next ? S.a_base(g, nxt) : cA; const char* nB = has_next ? S.b_base(g, nxt) : cB;
        for (int t = 0; t < nt; t += 2) {
            const bool last = (t == nt - 2);

            const char* a1 = cA + (size_t)(t + 1) * kstep;
            const char* a2 = last ? nA : cA + (size_t)(t + 2) * kstep; const char* b2 = last ? nB : cB + (size_t)(t + 2) * kstep;
            const char* a3 = a2 + kstep; const char* b3 = b2 + kstep;
            if (last && has_next) S.a_ready(nxt);
            PG8_LDB(B0, 0, 0); PG8_LDB(B1, 0, 1); PG8_SCHED; PG8_LDA(At, 0, 0); PG8_STAGE(PG8_SA(1, 1), a1, vaC[1]);
            if (last && has_next) S.a_voff(g, nxt, wid * 64 + lane_id(), vaC);
            PG8_WAIT_V(8); PG8_WAIT_L(0); PG8_BAR; PG8_MMA(0, 0, At, B0); PG8_MMA(0, 1, At, B1); PG8_BAR; PG8_SCHED;
            PG8_LDA(At, 0, 1); PG8_STAGE(PG8_SB(0, 0), b2, voffB); PG8_STAGE(PG8_SB(0, 1), b2 + hstep, voffB); PG8_STAGE(PG8_SA(0, 0), a2, vaC[0]);
            PG8_WAIT_V(8); PG8_WAIT_L(0); PG8_BAR; PG8_MMA(1, 0, At, B0); PG8_MMA(1, 1, At, B1); PG8_BAR; PG8_SCHED;
            PG8_LDB(B0, 1, 0); PG8_LDB(B1, 1, 1); PG8_SCHED; PG8_LDA(At, 1, 0); PG8_STAGE(PG8_SA(0, 1), a2, vaC[1]);
            PG8_WAIT_V(8); PG8_WAIT_L(0); PG8_BAR; PG8_MMA(0, 0, At, B0); PG8_MMA(0, 1, At, B1); PG8_BAR; PG8_SCHED;
            PG8_LDA(At, 1, 1); PG8_STAGE(PG8_SB(1, 0), b3, voffB); PG8_STAGE(PG8_SB(1, 1), b3 + hstep, voffB); PG8_STAGE(PG8_SA(1, 0), a3, vaC[0]);
            PG8_WAIT_V(8); PG8_WAIT_L(0); PG8_BAR; PG8_MMA(1, 0, At, B0); PG8_MMA(1, 1, At, B1); PG8_BAR; PG8_SCHED;
        }
        if constexpr (ALIGN_EPI) { if (wr == 0) PG8_BAR; }
        { const int l2 = lane_id(); E(acc, cur, wr, wc, l2 & 15, l2 >> 4); } S.done(cur);
        if (!has_next) break;
#pragma unroll
        for (int a = 0; a < 2; ++a)
#pragma unroll
            for (int b = 0; b < 2; ++b)
#pragma unroll
                for (int m = 0; m < 4; ++m)
#pragma unroll
                    for (int n = 0; n < 2; ++n) acc[a][b][m][n] = (f32x4){0.f, 0.f, 0.f, 0.f};
        cur = nxt; cA = nA; cB = nB; ++ui;
        if constexpr (ALIGN_EPI) { if (wr == 1) PG8_BAR; }
    }
    PG8_WAIT_V(0);
    if constexpr (!ALIGN_EPI) { if (wr == 0) PG8_BAR; }
    PG8_BAR;
#undef PG8_SA
#undef PG8_SB
#undef PG8_STAGE
#undef PG8_LDA
#undef PG8_LDB
#undef PG8_MMA
#undef PG8_WAIT_V
#undef PG8_WAIT_L
#undef PG8_BAR
#undef PG8_SCHED
}
}

constexpr int PN = 6656;
namespace att {
#define ALAS __attribute__((address_space(3)))
typedef _Float16 f16x8 __attribute__((ext_vector_type(8)));
typedef float f32x16 __attribute__((ext_vector_type(16)));
typedef short v4i16_t __attribute__((ext_vector_type(4)));
typedef unsigned u32x4 __attribute__((ext_vector_type(4)));
constexpr int SLOT = 16384, L_K = 0, L_V = 3 * SLOT, L_SCR = 6 * SLOT, L_TAB = L_SCR + 2048, L_END = L_TAB + 1024;
constexpr int L_XB = 0, L_STG = 65536;
constexpr float LOG2E = 1.4426950408889634f;
constexpr float C2 = 0.125f * LOG2E;
__device__ __forceinline__ int crow(int r, int hi) { return (r & 3) + 8 * (r >> 2) + 4 * hi; }
__device__ __forceinline__ void glds16(const void* g, ALAS unsigned char* l) { __builtin_amdgcn_global_load_lds((const unsigned*)g, (ALAS unsigned*)l, 16, 0, 0); }
__device__ __forceinline__ float xhalf(float v, int hi) { auto rr = __builtin_amdgcn_permlane32_swap(__float_as_uint(v), __float_as_uint(v), false, false); return hi ? __uint_as_float(rr[0]) : __uint_as_float(rr[1]); }
__device__ __forceinline__ unsigned pkh(float lo, float hi) { typedef _Float16 h2 __attribute__((ext_vector_type(2))); h2 v = {(_Float16)lo, (_Float16)hi}; return __builtin_bit_cast(unsigned, v); }
__device__ __forceinline__ v4i16_t vtr(const ALAS unsigned char* p) { return __builtin_amdgcn_ds_read_tr16_b64_v4i16((ALAS v4i16_t*)p); }

template <int THR>
__device__ __forceinline__ void attn_unit(ALAS unsigned char* lds, const int wave, const int b, const int h, const int qb, const unsigned short* PROJ, unsigned short* Y,
                                          const float* biasG, const float lam, const float* subln_g) {
    const int lane = pg8::lane_id(), r32 = lane & 31, hi = lane >> 5;
    const int c = wave >> 2, w4 = wave & 3;
    const int q0 = qb * 128, qw0 = q0 + 32 * w4, q = qw0 + r32;
    const size_t rowbase = (size_t)b * S;
    { ALAS float* tabL = (ALAS float*)(lds + L_TAB); const int tid = wave * 64 + lane; if (tid < 129) tabL[tid] = biasG[tid] * LOG2E; }
    f16x8 qf[4];
    { const unsigned short* Qp = PROJ + (rowbase + q) * PN + h * 128 + c * 64 + hi * 8;
#pragma unroll
      for (int d0 = 0; d0 < 4; ++d0) qf[d0] = *(const f16x8*)(Qp + d0 * 16); }
    const int krow0 = 8 * wave + (lane >> 4), krow1 = krow0 + 4;
    const unsigned short* ksrc0 = PROJ + (rowbase + krow0) * PN + 1024 + h * 128 + (((lane & 15) ^ (krow0 & 15)) * 8);
    const unsigned short* ksrc1 = PROJ + (rowbase + krow1) * PN + 1024 + h * 128 + (((lane & 15) ^ (krow1 & 15)) * 8);
    const unsigned short* vsrc0 = PROJ + (rowbase + 16 * ((2 * wave) & 3) + (lane >> 2)) * PN + 2048 + h * 128 + 32 * ((2 * wave) >> 2) + (lane & 3) * 8;
    ALAS unsigned char* kdst = lds + L_K + (2 * wave) * 1024; ALAS unsigned char* vdst = lds + L_V + (2 * wave) * 1024;
#define ATT_ISSUE(t, slot) do { const size_t go_ = (size_t)(t) * 64 * PN; \
        glds16(ksrc0 + go_, kdst + (slot) * SLOT); glds16(ksrc1 + go_, kdst + (slot) * SLOT + 1024); \
        glds16(vsrc0 + go_, vdst + (slot) * SLOT); glds16(vsrc0 + go_ + (size_t)16 * PN, vdst + (slot) * SLOT + 1024); } while (0)
    const int NT = (q0 + 128) / 64;
    ATT_ISSUE(0, 0); ATT_ISSUE(1, 1);
    ALAS float* wsf = (ALAS float*)(lds + L_SCR) + wave * 64;
    const ALAS float* tabL = (const ALAS float*)(lds + L_TAB);
    const float bfar = biasG[128] * LOG2E;
    float mhat = 0.f, l = 0.f;
    f32x16 o[4];
#pragma unroll
    for (int d = 0; d < 4; ++d)
#pragma unroll
        for (int r = 0; r < 16; ++r) o[d][r] = 0.f;
    f32x16 negm;
#pragma unroll
    for (int r = 0; r < 16; ++r) negm[r] = bfar;
    int slot = 0;
    for (int t = 0; t < NT; ++t) {
        if (t + 1 < NT) asm volatile("s_waitcnt vmcnt(4)" ::: "memory"); else asm volatile("s_waitcnt vmcnt(0)" ::: "memory");
        __builtin_amdgcn_s_barrier();
        asm volatile("" ::: "memory");
        if (t + 2 < NT) { const int s2 = slot == 0 ? 2 : slot - 1; ATT_ISSUE(t + 2, s2); }
        const int k0 = t * 64;
        if (k0 <= qw0 + 31) {
            const ALAS unsigned char* Ks = lds + L_K + slot * SLOT + r32 * 256;
            const int kx = r32 & 15, kc0 = 8 * c + hi;
            const int ko[4] = {((kc0 + 0) ^ kx) << 4, ((kc0 + 2) ^ kx) << 4, ((kc0 + 4) ^ kx) << 4, ((kc0 + 6) ^ kx) << 4};
            const ALAS unsigned char* Vs = lds + L_V + slot * SLOT + (4 * hi + ((lane & 15) >> 2)) * 64 + ((lane >> 4) & 1) * 32 + (lane & 3) * 8;
            f32x16 p0, p1;
            const bool nearb = (k0 + 63 + 128 > qw0);
            if (nearb) {
                f32x16 c0, c1;
#pragma unroll
                for (int r = 0; r < 16; ++r) { int rel = q - (k0 + crow(r, hi)); int i0 = rel < 0 ? 0 : (rel > 128 ? 128 : rel); int rel1 = rel - 32; int i1 = rel1 < 0 ? 0 : (rel1 > 128 ? 128 : rel1);
                    c0[r] = tabL[i0] - mhat; c1[r] = tabL[i1] - mhat; }
#pragma unroll
                for (int d0 = 0; d0 < 4; ++d0) { const f16x8 a0 = *(const ALAS f16x8*)(Ks + ko[d0]), a1 = *(const ALAS f16x8*)(Ks + ko[d0] + 8192);
                    p0 = __builtin_amdgcn_mfma_f32_32x32x16_f16(a0, qf[d0], d0 == 0 ? c0 : p0, 0, 0, 0); p1 = __builtin_amdgcn_mfma_f32_32x32x16_f16(a1, qf[d0], d0 == 0 ? c1 : p1, 0, 0, 0); }
                if (k0 + 63 > qw0) {
#pragma unroll
                    for (int r = 0; r < 16; ++r) { const int kv = k0 + crow(r, hi); if (kv > q) p0[r] = -INFINITY; if (kv + 32 > q) p1[r] = -INFINITY; }
                }
            } else {
#pragma unroll
                for (int d0 = 0; d0 < 4; ++d0) { const f16x8 a0 = *(const ALAS f16x8*)(Ks + ko[d0]), a1 = *(const ALAS f16x8*)(Ks + ko[d0] + 8192);
                    p0 = __builtin_amdgcn_mfma_f32_32x32x16_f16(a0, qf[d0], d0 == 0 ? negm : p0, 0, 0, 0); p1 = __builtin_amdgcn_mfma_f32_32x32x16_f16(a1, qf[d0], d0 == 0 ? negm : p1, 0, 0, 0); }
            }
            float rm = fmaxf(p0[0], p1[0]);
#pragma unroll
            for (int r = 1; r < 16; ++r) rm = fmaxf(rm, fmaxf(p0[r], p1[r]));
            rm = fmaxf(rm, xhalf(rm, hi));
            const bool first = (t == 0);
            if (first || __any(rm > (float)THR)) {
                const float dl = first ? rm : fmaxf(rm, 0.f);
                mhat += dl;
#pragma unroll
                for (int r = 0; r < 16; ++r) { p0[r] -= dl; p1[r] -= dl; }
#pragma unroll
                for (int r = 0; r < 16; ++r) negm[r] = bfar - mhat;
                if (!first) {
                    const float f = __builtin_amdgcn_exp2f(-dl); l *= f;
                    if (hi == 0) wsf[r32] = f;
                    asm volatile("s_waitcnt lgkmcnt(0)" ::: "memory");
#pragma unroll
                    for (int r = 0; r < 16; ++r) { const float fr_ = wsf[crow(r, hi)];
#pragma unroll
                        for (int d = 0; d < 4; ++d) o[d][r] *= fr_; }
                }
            }
            float sacc = 0.f;
#pragma unroll
            for (int r = 0; r < 16; ++r) { p0[r] = __builtin_amdgcn_exp2f(p0[r]); p1[r] = __builtin_amdgcn_exp2f(p1[r]); sacc += p0[r] + p1[r]; }
            l += sacc;
            u32x4 pw[4];
#pragma unroll
            for (int s = 0; s < 2; ++s) {
                pw[s] = (u32x4){pkh(p0[8 * s], p0[8 * s + 1]), pkh(p0[8 * s + 2], p0[8 * s + 3]), pkh(p0[8 * s + 4], p0[8 * s + 5]), pkh(p0[8 * s + 6], p0[8 * s + 7])};
                pw[2 + s] = (u32x4){pkh(p1[8 * s], p1[8 * s + 1]), pkh(p1[8 * s + 2], p1[8 * s + 3]), pkh(p1[8 * s + 4], p1[8 * s + 5]), pkh(p1[8 * s + 6], p1[8 * s + 7])};
            }
#pragma unroll
            for (int d = 0; d < 4; ++d) {
#pragma unroll
                for (int s = 0; s < 4; ++s) {
                    const v4i16_t lo = vtr(Vs + (d * 4 + s) * 1024), hi4 = vtr(Vs + (d * 4 + s) * 1024 + 512);
                    typedef short s16x8 __attribute__((ext_vector_type(8)));
                    const s16x8 bv = {lo[0], lo[1], lo[2], lo[3], hi4[0], hi4[1], hi4[2], hi4[3]};
                    o[d] = __builtin_amdgcn_mfma_f32_32x32x16_f16(__builtin_bit_cast(f16x8, pw[s]), __builtin_bit_cast(f16x8, bv), o[d], 0, 0, 0);
                }
            }
        }
        slot = slot == 2 ? 0 : slot + 1;
    }
#undef ATT_ISSUE
    l += xhalf(l, hi);
    if (hi == 0) wsf[r32] = 1.0f / l;
    asm volatile("s_waitcnt lgkmcnt(0)" ::: "memory");
#pragma unroll
    for (int r = 0; r < 16; ++r) { const float f = wsf[crow(r, hi)];
#pragma unroll
        for (int d = 0; d < 4; ++d) o[d][r] *= f; }
    asm volatile("s_waitcnt lgkmcnt(0)" ::: "memory"); __builtin_amdgcn_s_barrier(); asm volatile("" ::: "memory");
    ALAS float* xb = (ALAS float*)(lds + L_XB) + w4 * 4096 + lane;
    if (c == 1) {
#pragma unroll
        for (int d = 0; d < 4; ++d)
#pragma unroll
            for (int r = 0; r < 16; ++r) xb[(d * 16 + r) * 64] = o[d][r];
    }
    asm volatile("s_waitcnt lgkmcnt(0)" ::: "memory"); __builtin_amdgcn_s_barrier(); asm volatile("" ::: "memory");
    if (c == 0) {
        float sc[16];
#pragma unroll
        for (int r = 0; r < 16; ++r) { float ss = 0.f;
#pragma unroll
            for (int d = 0; d < 4; ++d) { o[d][r] -= lam * xb[(d * 16 + r) * 64]; ss += o[d][r] * o[d][r]; }
            ss += __shfl_xor(ss, 1); ss += __shfl_xor(ss, 2); ss += __shfl_xor(ss, 4); ss += __shfl_xor(ss, 8); ss += __shfl_xor(ss, 16);
            sc[r] = __builtin_amdgcn_rsqf(ss * (1.f / 128.f) + LN_EPS) * (1.f - LAMBDA_INIT); }
        ALAS _Float16* stg = (ALAS _Float16*)(lds + L_STG + w4 * 8192);
#pragma unroll
        for (int d = 0; d < 4; ++d) { const float gg = subln_g[32 * d + r32];
#pragma unroll
            for (int r = 0; r < 16; ++r) stg[crow(r, hi) * 128 + 32 * d + r32] = (_Float16)(o[d][r] * sc[r] * gg); }
        asm volatile("s_waitcnt lgkmcnt(0)" ::: "memory");
        unsigned short* Yw = Y + (rowbase + qw0) * D + h * 128;
#pragma unroll
        for (int i = 0; i < 8; ++i) { const int row = i * 4 + (lane >> 4), ch = lane & 15; const u32x4 v = *(const ALAS u32x4*)((const ALAS unsigned char*)stg + row * 256 + ch * 16);
            *(u32x4*)(Yw + (size_t)row * D + ch * 8) = v; }
    }
    asm volatile("s_waitcnt lgkmcnt(0)" ::: "memory"); __builtin_amdgcn_s_barrier(); asm volatile("" ::: "memory");
}
#undef ALAS
}

namespace rk {
#define RLAS __attribute__((address_space(3)))
#define RGAS __attribute__((address_space(1)))
typedef __bf16 bf16x8 __attribute__((ext_vector_type(8)));
typedef _Float16 f16x8 __attribute__((ext_vector_type(8)));
typedef float f32x16 __attribute__((ext_vector_type(16)));
typedef float f32x4 __attribute__((ext_vector_type(4)));
typedef unsigned u32x4 __attribute__((ext_vector_type(4)));
typedef unsigned short us8 __attribute__((ext_vector_type(8)));
constexpr int C = 32;
constexpr int TS = 144, CS = 80;
constexpr int O_AT = 0, O_RT = 4608, O_BT = 9216, O_KT = 13824;
constexpr int O_AAB = 0, O_AAK = 4608, O_ARB = 7168, O_ARK = 9728;
constexpr int O_PIMG = 0, O_QIMG = 8192;
constexpr int O_VT = 18432, O_KH = 23552, O_BH = 28672;
constexpr int O_X0 = 33792;
constexpr int O_RH = 50688;
constexpr int O_GAM = 55296;
constexpr int HALF_BYTES = 57344;
constexpr int CHK_BYTES = 24576, CK_P = 0, CK_Q = 8192, CK_G = 12288, CK_Y = 20480;
__device__ __forceinline__ int crow(int r, int hi) { return (r & 3) + 8 * (r >> 2) + 4 * hi; }
__device__ __forceinline__ unsigned pkb(float lo, float hi) { typedef float f2 __attribute__((ext_vector_type(2))); typedef __bf16 b2 __attribute__((ext_vector_type(2))); f2 v = {lo, hi}; b2 w = __builtin_convertvector(v, b2); return __builtin_bit_cast(unsigned, w); }
__device__ __forceinline__ unsigned pkh(float lo, float hi) { typedef _Float16 h2 __attribute__((ext_vector_type(2))); h2 v = {(_Float16)lo, (_Float16)hi}; return __builtin_bit_cast(unsigned, v); }
__device__ __forceinline__ float h2f(unsigned short u) { return (float)__builtin_bit_cast(_Float16, u); }
__device__ __forceinline__ unsigned short f2h(float f) { return __builtin_bit_cast(unsigned short, (_Float16)f); }
__device__ __forceinline__ float sum8(float x) {
    x += __builtin_bit_cast(float, __builtin_amdgcn_update_dpp(0, __builtin_bit_cast(int, x), 0xB1, 0xF, 0xF, true));
    x += __builtin_bit_cast(float, __builtin_amdgcn_update_dpp(0, __builtin_bit_cast(int, x), 0x4E, 0xF, 0xF, true));
    x += __builtin_bit_cast(float, __builtin_amdgcn_update_dpp(0, __builtin_bit_cast(int, x), 0x141, 0xF, 0xF, true));
    return x;
}
__device__ __forceinline__ int frag_pos(int m, int c) { return (((c >> 4) * 64 + m + 32 * ((c >> 2) & 1)) * 8) + ((c >> 3) & 1) * 4 + (c & 3); }

struct ChunkIn { f32x4 l0, l1; us8 a8, b8, k8, rc, rp, vc, vp; };
__device__ __forceinline__ void chunk_load(ChunkIn& in, int tglob, int pos, int chb, const unsigned char* ws) {
    const unsigned short* PROJ16 = (const unsigned short*)(ws + WS_PROJ16); const float* LW = (const float*)(ws + WS_DECAY); const unsigned short* KMOD = (const unsigned short*)(ws + WS_KMOD);
    const unsigned short* A16 = (const unsigned short*)(ws + WS_A16); const unsigned short* B16 = (const unsigned short*)(ws + WS_B16);
    in.l0 = *(const RGAS f32x4*)(LW + (size_t)tglob * RWK + chb); in.l1 = *(const RGAS f32x4*)(LW + (size_t)tglob * RWK + chb + 4);
    in.a8 = *(const RGAS us8*)(A16 + (size_t)tglob * RWK + chb); in.b8 = *(const RGAS us8*)(B16 + (size_t)tglob * RWK + chb); in.k8 = *(const RGAS us8*)(KMOD + (size_t)tglob * RWK + chb);
    const unsigned short* cur = PROJ16 + (size_t)tglob * PN + 3072 + chb;
    in.rc = *(const RGAS us8*)cur; in.vc = *(const RGAS us8*)(cur + 2048); in.rp = in.rc; in.vp = in.vc; if (pos > 0) { in.rp = *(const RGAS us8*)(cur - PN); in.vp = *(const RGAS us8*)(cur - PN + 2048); }
}
__device__ __forceinline__ void chunk_pair(RLAS unsigned char* lds, const int wave, const int tile, const int hA, ChunkIn& in, const bool has_next, const float* mu, const float* r_k, unsigned char* ws) {
    unsigned char* CHK = ws + WS_CHK; float* BONUS = (float*)(ws + WS_BONUS);
    const int lane = pg8::lane_id(), hf = wave >> 2, q = wave & 3, r32 = lane & 31, hi = lane >> 5;
    const int h = hA + hf;
    RLAS unsigned char* L = lds + hf * HALF_BYTES;
    const int t = q * 64 + lane;
    const int tok = t >> 3, c8 = (t & 7) * 8;
    const int tglob = tile * C + tok, pos = tglob & (S - 1), bidx = tglob >> 11;
    const int chb = h * 64 + c8;
    float lw[8], av[8], bv[8], kv[8], rv[8], vv[8];
    { lw[0] = in.l0.x; lw[1] = in.l0.y; lw[2] = in.l0.z; lw[3] = in.l0.w; lw[4] = in.l1.x; lw[5] = in.l1.y; lw[6] = in.l1.z; lw[7] = in.l1.w;
      const f32x4 m0 = *(const RGAS f32x4*)(mu + chb), m1 = *(const RGAS f32x4*)(mu + chb + 4), n0 = *(const RGAS f32x4*)(mu + 2048 + chb), n1 = *(const RGAS f32x4*)(mu + 2048 + chb + 4);
      const float mr[8] = {m0.x, m0.y, m0.z, m0.w, m1.x, m1.y, m1.z, m1.w}, mv[8] = {n0.x, n0.y, n0.z, n0.w, n1.x, n1.y, n1.z, n1.w};
#pragma unroll
      for (int i = 0; i < 8; ++i) { av[i] = h2f(in.a8[i]); bv[i] = h2f(in.b8[i]); kv[i] = h2f(in.k8[i]);
          const float rcf = h2f(in.rc[i]), rpf = pos > 0 ? h2f(in.rp[i]) : 0.f, vcf = h2f(in.vc[i]), vpf = pos > 0 ? h2f(in.vp[i]) : 0.f;
          rv[i] = rcf + (rpf - rcf) * mr[i]; vv[i] = vcf + (vpf - vcf) * mv[i]; } }
    { const f32x4 k0 = *(const RGAS f32x4*)(r_k + chb), k1 = *(const RGAS f32x4*)(r_k + chb + 4); const float rk8[8] = {k0.x, k0.y, k0.z, k0.w, k1.x, k1.y, k1.z, k1.w};
      float bs = 0.f;
#pragma unroll
      for (int i = 0; i < 8; ++i) bs += rv[i] * kv[i] * rk8[i];
      bs = sum8(bs); if ((t & 7) == 0) BONUS[(size_t)tglob * 16 + h] = bs; }
    RLAS float* lwL = (RLAS float*)(L + O_X0 + 64 * 132);
    __syncthreads();
#pragma unroll
    for (int i = 0; i < 8; ++i) lwL[tok * 65 + c8 + i] = lw[i];
    __syncthreads();
    { RLAS float* part = (RLAS float*)(L + O_GAM) + 64;
      const int ch = t & 63, seg = t >> 6; float sg = 0.f;
#pragma unroll
      for (int k = 0; k < 8; ++k) sg += lwL[(8 * seg + k) * 65 + ch];
      part[seg * 64 + ch] = sg;
      __syncthreads();
      float g = 0.f;
#pragma unroll
      for (int s2 = 0; s2 < 3; ++s2) if (s2 < seg) g += part[s2 * 64 + ch];
#pragma unroll
      for (int k = 0; k < 8; ++k) { g += lwL[(8 * seg + k) * 65 + ch]; lwL[(8 * seg + k) * 65 + ch] = g; } }
    __syncthreads();
    {
        float G[8], GL[8];
#pragma unroll
        for (int i = 0; i < 8; ++i) { G[i] = lwL[tok * 65 + c8 + i]; GL[i] = lwL[31 * 65 + c8 + i]; }
        float at[8], rt[8], bt[8], kt[8], bh[8], kh[8];
#pragma unroll
        for (int i = 0; i < 8; ++i) { const float eg = __expf(G[i]), eng = __expf(-G[i]), egm = __expf(G[i] - lw[i]), egl = __expf(GL[i] - G[i]);
            at[i] = av[i] * egm; rt[i] = rv[i] * eg; bt[i] = bv[i] * eng; kt[i] = kv[i] * eng; bh[i] = bv[i] * egl; kh[i] = kv[i] * egl; }
        *(RLAS u32x4*)(L + O_AT + tok * TS + c8 * 2) = (u32x4){pkb(at[0], at[1]), pkb(at[2], at[3]), pkb(at[4], at[5]), pkb(at[6], at[7])};
        *(RLAS u32x4*)(L + O_RT + tok * TS + c8 * 2) = (u32x4){pkb(rt[0], rt[1]), pkb(rt[2], rt[3]), pkb(rt[4], rt[5]), pkb(rt[6], rt[7])};
        *(RLAS u32x4*)(L + O_BT + tok * TS + c8 * 2) = (u32x4){pkb(bt[0], bt[1]), pkb(bt[2], bt[3]), pkb(bt[4], bt[5]), pkb(bt[6], bt[7])};
        *(RLAS u32x4*)(L + O_KT + tok * TS + c8 * 2) = (u32x4){pkb(kt[0], kt[1]), pkb(kt[2], kt[3]), pkb(kt[4], kt[5]), pkb(kt[6], kt[7])};
        *(RLAS u32x4*)(L + O_RH + tok * TS + c8 * 2) = (u32x4){pkh(rt[0], rt[1]), pkh(rt[2], rt[3]), pkh(rt[4], rt[5]), pkh(rt[6], rt[7])};
#pragma unroll
        for (int i = 0; i < 8; ++i) { const int ch = c8 + i;
            *(RLAS unsigned short*)(L + O_VT + ch * CS + tok * 2) = f2h(vv[i]); *(RLAS unsigned short*)(L + O_KH + ch * CS + tok * 2) = f2h(kh[i]); *(RLAS unsigned short*)(L + O_BH + ch * CS + tok * 2) = f2h(bh[i]);
            ((RLAS float*)(L + O_X0))[ch * 33 + tok] = at[i];
            if (tok == C - 1) ((RLAS float*)(L + O_GAM))[ch] = __expf(GL[i]); }
    }
    __syncthreads();
    {
        const RLAS unsigned char* Lp = L + (q < 2 ? O_AT : O_RT) + r32 * TS + hi * 16; const RLAS unsigned char* Rp = L + ((q & 1) ? O_KT : O_BT) + r32 * TS + hi * 16;
        f32x16 acc;
#pragma unroll
        for (int r = 0; r < 16; ++r) acc[r] = 0.f;
#pragma unroll
        for (int ks = 0; ks < 4; ++ks) acc = __builtin_amdgcn_mfma_f32_32x32x16_bf16(*(const RLAS bf16x8*)(Lp + ks * 32), *(const RLAS bf16x8*)(Rp + ks * 32), acc, 0, 0, 0);
#pragma unroll
        for (int r = 0; r < 16; ++r) { const int tau = crow(r, hi); const bool keep = (q < 2) ? (r32 < tau) : (r32 <= tau); acc[r] = keep ? acc[r] : 0.f; }
        __syncthreads();
        if (q == 0) {
#pragma unroll
            for (int r = 0; r < 16; ++r) ((RLAS float*)(L + O_AAB))[r32 * 36 + crow(r, hi)] = acc[r];
        } else {
            RLAS unsigned char* o = L + (q == 1 ? O_AAK : (q == 2 ? O_ARB : O_ARK));
#pragma unroll
            for (int r = 0; r < 16; ++r) *(RLAS unsigned short*)(o + crow(r, hi) * CS + r32 * 2) = f2h(acc[r]);
        }
    }
    __syncthreads();
    const int J = q & 1, part = q >> 1;
    if (part == 1) {
        f32x16 accX;
#pragma unroll
        for (int r = 0; r < 16; ++r) accX[r] = 0.f;
        const RLAS unsigned char* Vp = L + O_VT + (32 * J + r32) * CS + hi * 16; const RLAS unsigned char* Ap = L + O_AAK + r32 * CS + hi * 16;
#pragma unroll
        for (int ks = 0; ks < 2; ++ks) accX = __builtin_amdgcn_mfma_f32_32x32x16_f16(*(const RLAS f16x8*)(Ap + ks * 32), *(const RLAS f16x8*)(Vp + ks * 32), accX, 0, 0, 0);
#pragma unroll
        for (int r = 0; r < 16; ++r) ((RLAS float*)(L + O_X0))[(64 + 32 * J + r32) * 33 + crow(r, hi)] = accX[r];
    }
    __syncthreads();
    float z[C];
    if (q < 2) {
        const RLAS float* xc = (const RLAS float*)(L + O_X0) + (64 * q + lane) * 33;
#pragma unroll
        for (int k = 0; k < C; ++k) z[k] = xc[k];
    }
    __syncthreads();
    if (q < 2) {
        const RLAS float* AabT = (const RLAS float*)(L + O_AAB);
#pragma unroll
        for (int sx = 0; sx < C - 1; ++sx) {
            const float zs = z[sx];
#pragma unroll
            for (int t4 = (sx + 1) / 4; t4 < C / 4; ++t4) { const f32x4 aa = *(const RLAS f32x4*)(AabT + sx * 36 + 4 * t4);
                if (4 * t4 + 0 > sx) z[4 * t4 + 0] = fmaf(aa.x, zs, z[4 * t4 + 0]); if (4 * t4 + 1 > sx) z[4 * t4 + 1] = fmaf(aa.y, zs, z[4 * t4 + 1]);
                if (4 * t4 + 2 > sx) z[4 * t4 + 2] = fmaf(aa.z, zs, z[4 * t4 + 2]); if (4 * t4 + 3 > sx) z[4 * t4 + 3] = fmaf(aa.w, zs, z[4 * t4 + 3]); }
        }
        RLAS unsigned char* zr = L + O_X0 + (64 * q + lane) * CS;
#pragma unroll
        for (int k8 = 0; k8 < 4; ++k8) *(RLAS u32x4*)(zr + k8 * 16) = (u32x4){pkh(z[8 * k8], z[8 * k8 + 1]), pkh(z[8 * k8 + 2], z[8 * k8 + 3]), pkh(z[8 * k8 + 4], z[8 * k8 + 5]), pkh(z[8 * k8 + 6], z[8 * k8 + 7])};
    }
    __syncthreads();
    f32x16 accQ, accP, accA, accB;
#pragma unroll
    for (int r = 0; r < 16; ++r) { accA[r] = 0.f; accB[r] = 0.f; }
    {
        const RLAS unsigned char* Vp = L + O_VT + (32 * J + r32) * CS + hi * 16;
        const RLAS unsigned char* Kp = L + O_KH + (32 * part + r32) * CS + hi * 16;
        const RLAS unsigned char* Ap = L + O_ARK + r32 * CS + hi * 16;
#pragma unroll
        for (int ks = 0; ks < 2; ++ks) { const f16x8 vf = *(const RLAS f16x8*)(Vp + ks * 32);
            if (part == 0) accA = __builtin_amdgcn_mfma_f32_32x32x16_f16(*(const RLAS f16x8*)(Ap + ks * 32), vf, accA, 0, 0, 0);
            accB = __builtin_amdgcn_mfma_f32_32x32x16_f16(*(const RLAS f16x8*)(Kp + ks * 32), vf, accB, 0, 0, 0); }
    }
    {
        const RLAS float* gam = (const RLAS float*)(L + O_GAM);
#pragma unroll
        for (int r = 0; r < 16; ++r) { const int m = crow(r, hi);
            accQ[r] = h2f(*(const RLAS unsigned short*)(L + O_RH + m * TS + (32 * J + r32) * 2));
            accP[r] = (J == part && m == r32) ? gam[32 * J + r32] : 0.f; }
        const RLAS unsigned char* Zw = L + O_X0 + (32 * J + r32) * CS + hi * 16; const RLAS unsigned char* Zu = Zw + 64 * CS;
        const RLAS unsigned char* Bp = L + O_BH + (32 * part + r32) * CS + hi * 16; const RLAS unsigned char* Rb = L + O_ARB + r32 * CS + hi * 16;
#pragma unroll
        for (int ks = 0; ks < 2; ++ks) { const f16x8 zw = *(const RLAS f16x8*)(Zw + ks * 32), zu = *(const RLAS f16x8*)(Zu + ks * 32), bf = *(const RLAS f16x8*)(Bp + ks * 32);
            accP = __builtin_amdgcn_mfma_f32_32x32x16_f16(bf, zw, accP, 0, 0, 0);
            accB = __builtin_amdgcn_mfma_f32_32x32x16_f16(bf, zu, accB, 0, 0, 0);
            if (part == 0) { const f16x8 rb = *(const RLAS f16x8*)(Rb + ks * 32);
                accQ = __builtin_amdgcn_mfma_f32_32x32x16_f16(rb, zw, accQ, 0, 0, 0);
                accA = __builtin_amdgcn_mfma_f32_32x32x16_f16(rb, zu, accA, 0, 0, 0); } }
    }
    __syncthreads();
    { int tg2 = tglob, cb2 = has_next ? chb + 128 : chb; asm volatile("" : "+v"(tg2), "+v"(cb2)); chunk_load(in, tg2, pos, cb2, ws); }
    unsigned char* rec = CHK + ((size_t)((bidx * 16 + h) * (S / C)) + (size_t)(pos >> 5)) * CHK_BYTES;
    { u32x4 w0, w1; w0 = (u32x4){pkh(accB[0], accB[1]), pkh(accB[2], accB[3]), pkh(accB[4], accB[5]), pkh(accB[6], accB[7])}; w1 = (u32x4){pkh(accB[8], accB[9]), pkh(accB[10], accB[11]), pkh(accB[12], accB[13]), pkh(accB[14], accB[15])};
      RGAS u32x4* g = (RGAS u32x4*)(rec + CK_G + ((part * 2 + J) * 64 + lane) * 32); g[0] = w0; g[1] = w1;
      if (part == 0) { w0 = (u32x4){pkh(accA[0], accA[1]), pkh(accA[2], accA[3]), pkh(accA[4], accA[5]), pkh(accA[6], accA[7])}; w1 = (u32x4){pkh(accA[8], accA[9]), pkh(accA[10], accA[11]), pkh(accA[12], accA[13]), pkh(accA[14], accA[15])};
          RGAS u32x4* y = (RGAS u32x4*)(rec + CK_Y + (J * 64 + lane) * 32); y[0] = w0; y[1] = w1; } }
    {
        RLAS unsigned short* pimg = (RLAS unsigned short*)(L + O_PIMG) + ((part * 2 + J) * 2) * 512;
        RLAS unsigned short* qimg = (RLAS unsigned short*)(L + O_QIMG) + (J * 2) * 512;
#pragma unroll
        for (int r = 0; r < 16; ++r) { const int fp = frag_pos(crow(r, hi), r32); pimg[fp] = f2h(accP[r]); if (part == 0) qimg[fp] = f2h(accQ[r]); }
    }
    __syncthreads();
    { const RLAS u32x4* src = (const RLAS u32x4*)(L + O_PIMG); RGAS u32x4* dst = (RGAS u32x4*)(rec + CK_P);
#pragma unroll
      for (int i = 0; i < 3; ++i) dst[i * 256 + t] = src[i * 256 + t]; }
}

__device__ __forceinline__ void scan_unit(RLAS unsigned char* lds, const int wave, const int bh, const unsigned char* CHK, const float* BONUS, const unsigned short* PROJ16, const float* mu,
                                          const unsigned short* G16, const float* lnx_g, const float* lnx_b, unsigned short* Y16) {
    const int lane = pg8::lane_id(), r32 = lane & 31, hi = lane >> 5;
    const int b = bh >> 4, h = bh & 15;
    RLAS float* ytile = (RLAS float*)lds;
    constexpr int RING0 = 18432, NSL = 4;
    const unsigned char* rec0 = CHK + (size_t)bh * (S / C) * CHK_BYTES;
    constexpr int NCH = S / C;
    __syncthreads();
    if (wave >= 6) {
        const int p0 = (wave - 6) * 12;
#define RK_DMA(c) do { const unsigned char* src_ = rec0 + (size_t)(c) * CHK_BYTES + p0 * 1024 + lane * 16; RLAS unsigned char* dst_ = lds + RING0 + ((c) & (NSL - 1)) * CHK_BYTES + p0 * 1024; \
            _Pragma("unroll") for (int j_ = 0; j_ < 12; ++j_) __builtin_amdgcn_global_load_lds((const unsigned*)(src_ + j_ * 1024), (RLAS unsigned*)(dst_ + j_ * 1024), 16, 0, 0); } while (0)
        RK_DMA(0); RK_DMA(1); RK_DMA(2);
        for (int c = 0; c <= NCH; ++c) {
            if (c + 2 < NCH) asm volatile("s_waitcnt vmcnt(24)" ::: "memory"); else if (c + 1 < NCH) asm volatile("s_waitcnt vmcnt(12)" ::: "memory"); else asm volatile("s_waitcnt vmcnt(0)" ::: "memory");
            __builtin_amdgcn_s_barrier(); asm volatile("" ::: "memory");
            if (c + 3 < NCH) RK_DMA(c + 3);
        }
#undef RK_DMA
    } else if (wave < 2) {
        const int J = wave;
        f32x16 H0, H1;
#pragma unroll
        for (int r = 0; r < 16; ++r) { H0[r] = 0.f; H1[r] = 0.f; }
        for (int c = 0; c <= NCH; ++c) {
            asm volatile("s_waitcnt lgkmcnt(0)" ::: "memory"); __builtin_amdgcn_s_barrier(); asm volatile("" ::: "memory");
            if (c == NCH) break;
            const RLAS unsigned char* rec = lds + RING0 + (c & (NSL - 1)) * CHK_BYTES;
            u32x4 hb[4];
            hb[0] = (u32x4){pkh(H0[0], H0[1]), pkh(H0[2], H0[3]), pkh(H0[4], H0[5]), pkh(H0[6], H0[7])}; hb[1] = (u32x4){pkh(H0[8], H0[9]), pkh(H0[10], H0[11]), pkh(H0[12], H0[13]), pkh(H0[14], H0[15])};
            hb[2] = (u32x4){pkh(H1[0], H1[1]), pkh(H1[2], H1[3]), pkh(H1[4], H1[5]), pkh(H1[6], H1[7])}; hb[3] = (u32x4){pkh(H1[8], H1[9]), pkh(H1[10], H1[11]), pkh(H1[12], H1[13]), pkh(H1[14], H1[15])};
            f32x16 y, n0, n1;
#define RK_UNPK(dst, w0, w1) do { const f16x8 a_ = __builtin_bit_cast(f16x8, w0), b_ = __builtin_bit_cast(f16x8, w1); \
            _Pragma("unroll") for (int i_ = 0; i_ < 8; ++i_) { dst[i_] = (float)a_[i_]; dst[8 + i_] = (float)b_[i_]; } } while (0)
            { const u32x4 y0 = *(const RLAS u32x4*)(rec + CK_Y + (J * 64 + lane) * 32), y1 = *(const RLAS u32x4*)(rec + CK_Y + (J * 64 + lane) * 32 + 16); RK_UNPK(y, y0, y1);
              const u32x4 g0 = *(const RLAS u32x4*)(rec + CK_G + (J * 64 + lane) * 32), g1 = *(const RLAS u32x4*)(rec + CK_G + (J * 64 + lane) * 32 + 16); RK_UNPK(n0, g0, g1);
              const u32x4 g2 = *(const RLAS u32x4*)(rec + CK_G + ((2 + J) * 64 + lane) * 32), g3 = *(const RLAS u32x4*)(rec + CK_G + ((2 + J) * 64 + lane) * 32 + 16); RK_UNPK(n1, g2, g3); }
#pragma unroll
            for (int ks = 0; ks < 4; ++ks) {
                const f16x8 hf = __builtin_bit_cast(f16x8, hb[ks]);
                y = __builtin_amdgcn_mfma_f32_32x32x16_f16(*(const RLAS f16x8*)(rec + CK_Q + (ks * 64 + lane) * 16), hf, y, 0, 0, 0);
                n0 = __builtin_amdgcn_mfma_f32_32x32x16_f16(*(const RLAS f16x8*)(rec + CK_P + (ks * 64 + lane) * 16), hf, n0, 0, 0, 0);
                n1 = __builtin_amdgcn_mfma_f32_32x32x16_f16(*(const RLAS f16x8*)(rec + CK_P + ((4 + ks) * 64 + lane) * 16), hf, n1, 0, 0, 0);
            }
#undef RK_UNPK
            H0 = n0; H1 = n1;
            RLAS float* yt = ytile + (c & 1) * (32 * 68);
#pragma unroll
            for (int r = 0; r < 16; ++r) yt[crow(r, hi) * 68 + 32 * J + r32] = y[r];
        }
    } else {
        const int p = wave - 2, v8 = (lane & 7) * 8, trow = 8 * p + (lane >> 3);
        float lg[8], lb[8], mv[8];
#pragma unroll
        for (int i = 0; i < 8; ++i) { lg[i] = lnx_g[h * 64 + v8 + i]; lb[i] = lnx_b[h * 64 + v8 + i]; mv[i] = mu[2048 + h * 64 + v8 + i]; }
        struct PSlot { float bon; us8 vc, vp, g8; };
        PSlot ps[4];
#define RK_PLOAD(SL, cc_) do { const int pos_ = (cc_) * C + trow; const size_t tok_ = (size_t)b * S + pos_; ps[SL].bon = BONUS[tok_ * 16 + h]; \
            const unsigned short* cur_ = PROJ16 + tok_ * PN + 5120 + h * 64 + v8; ps[SL].vc = *(const RGAS us8*)cur_; ps[SL].vp = ps[SL].vc; if (pos_ > 0) ps[SL].vp = *(const RGAS us8*)(cur_ - PN); \
            ps[SL].g8 = *(const RGAS us8*)(G16 + tok_ * RWK + h * 64 + v8); } while (0)
#define RK_PSTEP(SL, cc_) do { \
            asm volatile("s_waitcnt lgkmcnt(0)" ::: "memory"); __builtin_amdgcn_s_barrier(); asm volatile("" ::: "memory"); \
            if ((cc_) >= 0) { const int cc = (cc_); \
                const float bon = ps[SL].bon; const us8 vc = ps[SL].vc, vp = ps[SL].vp, g8 = ps[SL].g8; \
                if (cc + 4 < NCH) RK_PLOAD(SL, cc + 4); \
                const RLAS float* yt = ytile + (cc & 1) * (32 * 68) + trow * 68 + v8; \
                const f32x4 ya = *(const RLAS f32x4*)yt, yb = *(const RLAS f32x4*)(yt + 4); \
                float yv[8] = {ya.x, ya.y, ya.z, ya.w, yb.x, yb.y, yb.z, yb.w}; \
                float sm = 0.f; \
                _Pragma("unroll") for (int i = 0; i < 8; ++i) sm += yv[i]; \
                const float mean = sum8(sm) * (1.f / 64.f); float sq = 0.f; \
                _Pragma("unroll") for (int i = 0; i < 8; ++i) { yv[i] -= mean; sq += yv[i] * yv[i]; } \
                const float rstd = __builtin_amdgcn_rsqf(sum8(sq) * (1.f / 64.f) + 64e-5f); \
                const int pos = cc * C + trow; const size_t tok = (size_t)b * S + pos; \
                float o[8]; \
                _Pragma("unroll") for (int i = 0; i < 8; ++i) { const float vcf = h2f(vc[i]), vpf = pos > 0 ? h2f(vp[i]) : 0.f; const float vx = vcf + (vpf - vcf) * mv[i]; \
                    o[i] = (yv[i] * rstd * lg[i] + lb[i] + bon * vx) * h2f(g8[i]); } \
                *(RGAS u32x4*)(Y16 + tok * D + 1024 + h * 64 + v8) = (u32x4){pkh(o[0], o[1]), pkh(o[2], o[3]), pkh(o[4], o[5]), pkh(o[6], o[7])}; } } while (0)
        RK_PLOAD(0, 0); RK_PLOAD(1, 1); RK_PLOAD(2, 2); RK_PLOAD(3, 3);
        for (int cb = 0; cb < NCH; cb += 4) {
            RK_PSTEP(3, cb - 1); RK_PSTEP(0, cb); RK_PSTEP(1, cb + 1); RK_PSTEP(2, cb + 2);
        }
        RK_PSTEP(3, NCH - 1);
#undef RK_PSTEP
#undef RK_PLOAD
    }
    __syncthreads();
}
#undef RLAS
#undef RGAS
}

constexpr int NWAVES = 8;
constexpr int RING_OFF = 0, RING_BYTES = 131072;
constexpr int LDSCTL_OFF = RING_BYTES, MISC_OFF = LDSCTL_OFF + 320;
constexpr int LDS_BYTES = 147456;
#define GAS __attribute__((address_space(1)))
#define LAS __attribute__((address_space(3)))
typedef unsigned v4u __attribute__((ext_vector_type(4)));
typedef float f32x4 __attribute__((ext_vector_type(4)));
typedef GAS unsigned gu32;
#define RLX_AGENT __ATOMIC_RELAXED, __HIP_MEMORY_SCOPE_AGENT
#define LDS_WAIT() asm volatile("s_waitcnt lgkmcnt(0)" ::: "memory")
#define VM_WAIT() asm volatile("s_waitcnt vmcnt(0)" ::: "memory")
constexpr int CW_ATTQ = 64;
constexpr int CW_BAR = 4096;
constexpr size_t CTL_ZERO_BYTES = 1 * MiB;

#define XB_TMO      128
#define XB_XCNT(j)  (256  + 64 * (j))
#define XB_XSUB(j)  (1280 + 64 * (j))
#define XB_XGEN(j)  (2304 + 64 * (j))
#define XB_TOP      3328
#define XB_TOPGEN   3392
#define XCD_BAR_WORDS 3456
#define XB_SPIN_CAP (1u << 18)

__device__ __forceinline__ unsigned xb_ld(unsigned* p)              { return __hip_atomic_load(p, __ATOMIC_RELAXED, __HIP_MEMORY_SCOPE_AGENT); }
__device__ __forceinline__ unsigned xb_add(unsigned* p, unsigned v) { return __hip_atomic_fetch_add(p, v, __ATOMIC_RELAXED, __HIP_MEMORY_SCOPE_AGENT); }
__device__ __forceinline__ unsigned xb_xcc_id() { return (unsigned)__builtin_amdgcn_s_getreg((3 << 11) | 20) & 0xFu; }
#define XB_SPIN(cond, bar) do { unsigned _sp = 0; while (cond) { __builtin_amdgcn_s_sleep(1); \
    if ((++_sp & 255u) == 0u) { if (xb_ld(&(bar)[XB_TMO])) break; if (_sp > XB_SPIN_CAP) { atomicAdd(&(bar)[XB_TMO], 1u); break; } } } } while (0)

struct XcdBarrier {
    unsigned* bar; unsigned x; bool w0;
    volatile LAS unsigned* st;
};

__device__ __forceinline__ XcdBarrier xcd_barrier_post(unsigned* bar, volatile LAS unsigned* st) {
    XcdBarrier b; b.bar = bar; b.x = xb_xcc_id(); b.st = st; b.w0 = (__builtin_amdgcn_readfirstlane(threadIdx.x >> 6) == 0);
    if (__builtin_amdgcn_readfirstlane(threadIdx.x >> 6) == 0 && pg8::lane_id() == 0) (void)xb_add(&bar[XB_XCNT(b.x)], 1u);
    return b;
}
__device__ __forceinline__ void xcd_barrier_complete(unsigned* bar, unsigned x, unsigned& nloc, unsigned& nx) {
    const unsigned G = gridDim.x * gridDim.y * gridDim.z;
    unsigned sum, cnt, mine, sp = 0u;
    for (;;) {
        sum = 0u; cnt = 0u; mine = 0u;
#pragma unroll
        for (unsigned j = 0; j < 16; ++j) { const unsigned c = xb_ld(&bar[XB_XCNT(j)]); sum += c; cnt += (c > 0u) ? 1u : 0u; mine = (j == x) ? c : mine; }
        if (sum == G) break;
        __builtin_amdgcn_s_sleep(1);
        if ((++sp & 255u) == 0u) { if (xb_ld(&bar[XB_TMO])) break; if (sp > XB_SPIN_CAP) { atomicAdd(&bar[XB_TMO], 1u); break; } }
    }
    nloc = mine > 0u ? mine : 1u; nx = cnt > 0u ? cnt : 1u;
}

__device__ __forceinline__ void xcd_barrier(const XcdBarrier& b) {
    asm volatile("s_waitcnt vmcnt(0)" ::: "memory");
    __syncthreads();
    if (b.w0 && pg8::lane_id() == 0) {
        unsigned* bar = b.bar;
        __builtin_amdgcn_s_waitcnt(0);
        unsigned nloc = b.st[0], nx = b.st[1];
        if (nloc == 0u) { xcd_barrier_complete(bar, b.x, nloc, nx); b.st[0] = nloc; b.st[1] = nx; }
        const unsigned old = xb_add(&bar[XB_XSUB(b.x)], 1u);
        const unsigned gen = old / nloc;
        if (old + 1u == (gen + 1u) * nloc) {
            __builtin_amdgcn_fence(__ATOMIC_RELEASE, "agent");
            asm volatile("s_waitcnt vmcnt(0)" ::: "memory");
            const unsigned og = xb_add(&bar[XB_TOP], 1u);
            const unsigned tg = og / nx;
            if (og + 1u == (tg + 1u) * nx) xb_add(&bar[XB_TOPGEN], 1u);
            else XB_SPIN(xb_ld(&bar[XB_TOPGEN]) == tg, bar);
            __builtin_amdgcn_fence(__ATOMIC_ACQUIRE, "agent");
            xb_add(&bar[XB_XGEN(b.x)], 1u);
            asm volatile("s_waitcnt vmcnt(0)" ::: "memory");
        } else {
            XB_SPIN(xb_ld(&bar[XB_XGEN(b.x)]) == gen, bar);
            __builtin_amdgcn_fence(__ATOMIC_ACQUIRE, "agent");
            asm volatile("s_waitcnt vmcnt(0)" ::: "memory");
        }
    }
    __syncthreads();
}


typedef unsigned short f16_t;
typedef _Float16 h2v __attribute__((ext_vector_type(2)));
__device__ __forceinline__ unsigned pk2h(float lo, float hi) { h2v v = {(_Float16)lo, (_Float16)hi}; return __builtin_bit_cast(unsigned, v); }

struct Frame {
    LAS unsigned char* lds; volatile LAS unsigned* MISC; gu32* ctl;
    int wave, vcu, G;
};
#define FTID (F.wave * 64 + pg8::lane_id())
#define FLANE (pg8::lane_id())
__device__ __forceinline__ void p0_transpose_item(const float* W, int K, int N, f16_t* WT, int row_off, LAS float* scr, int item, int lane) {
    const int nblk = N / 32, kb = item / nblk, nb = item % nblk, k0 = 64 * kb, n0 = 32 * nb;
#pragma unroll 8
    for (int i = 0; i < 32; ++i) { const int kk = 2 * i + (lane >> 5); scr[kk * 33 + (lane & 31)] = W[(size_t)(k0 + kk) * N + n0 + (lane & 31)]; }
    LDS_WAIT(); asm volatile("" ::: "memory");
    const int c = lane & 7;
#pragma unroll
    for (int j = 0; j < 4; ++j) { const int n = (lane >> 3) + 8 * j; const LAS float* s = scr + (8 * c) * 33 + n;
        v4u o; o.x = pk2h(s[0 * 33], s[1 * 33]); o.y = pk2h(s[2 * 33], s[3 * 33]); o.z = pk2h(s[4 * 33], s[5 * 33]); o.w = pk2h(s[6 * 33], s[7 * 33]);
        *(GAS v4u*)(WT + (size_t)(row_off + n0 + n) * K + k0 + 8 * c) = o; }
    LDS_WAIT(); asm volatile("" ::: "memory");
}
__device__ __forceinline__ float wave_sum_b(float v) {
#pragma unroll
    for (int o = 1; o < 64; o <<= 1) v += __shfl_xor(v, o);
    return v;
}
__device__ __forceinline__ void ln_row_dual(int lane, const float* xrow, const float* g, const float* b, float* o32, f16_t* o16) {
    const GAS f32x4* xr = (const GAS f32x4*)xrow + lane;
    f32x4 v[8]; float s = 0.f;
#pragma unroll
    for (int j = 0; j < 8; ++j) { v[j] = xr[64 * j]; s += (v[j].x + v[j].y) + (v[j].z + v[j].w); }
    const float mean = wave_sum_b(s) * (1.f / D); float s2 = 0.f;
#pragma unroll
    for (int j = 0; j < 8; ++j) { v[j] = v[j] - mean; s2 += (v[j].x * v[j].x + v[j].y * v[j].y) + (v[j].z * v[j].z + v[j].w * v[j].w); }
    const float rstd = __builtin_amdgcn_rsqf(wave_sum_b(s2) * (1.f / D) + LN_EPS);
    const GAS f32x4* g4 = (const GAS f32x4*)g + lane; const GAS f32x4* b4 = (const GAS f32x4*)b + lane;
    GAS f32x4* o4 = (GAS f32x4*)o32 + lane; GAS unsigned long long* o8 = (GAS unsigned long long*)o16 + lane;
#pragma unroll
    for (int j = 0; j < 8; ++j) { const f32x4 o = v[j] * rstd * g4[64 * j] + b4[64 * j]; o4[64 * j] = o;
        o8[64 * j] = (unsigned long long)pk2h(o.x, o.y) | ((unsigned long long)pk2h(o.z, o.w) << 32); }
}


__device__ __forceinline__ void p0_transpose_item_gu(const float* W, int K, int N, f16_t* WT, int gu_s, LAS float* scr, int item, int lane) {
    const int nblk = N / 32, nb = item % nblk; const int row_off = gu_s < 0 ? 0 : 128 * (nb >> 2) + 128 * gu_s;
    p0_transpose_item(W, K, N, WT, row_off, scr, item, lane);
}
__device__ __forceinline__ void ln_norm(int lane, f32x4 (&v)[8], const float* g, const float* b) {
    float s = 0.f;
#pragma unroll
    for (int j = 0; j < 8; ++j) s += (v[j].x + v[j].y) + (v[j].z + v[j].w);
    const float mean = wave_sum_b(s) * (1.f / D); float s2 = 0.f;
#pragma unroll
    for (int j = 0; j < 8; ++j) { v[j] = v[j] - mean; s2 += (v[j].x * v[j].x + v[j].y * v[j].y) + (v[j].z * v[j].z + v[j].w * v[j].w); }
    const float rstd = __builtin_amdgcn_rsqf(wave_sum_b(s2) * (1.f / D) + LN_EPS);
    const GAS f32x4* g4 = (const GAS f32x4*)g + lane; const GAS f32x4* b4 = (const GAS f32x4*)b + lane;
#pragma unroll
    for (int j = 0; j < 8; ++j) v[j] = v[j] * rstd * g4[64 * j] + b4[64 * j];
}
__device__ __forceinline__ void ln_store(int lane, const f32x4 (&v)[8], float* o32, f16_t* o16) {
    GAS f32x4* o4 = (GAS f32x4*)o32 + lane; GAS unsigned long long* o8 = (GAS unsigned long long*)o16 + lane;
#pragma unroll
    for (int j = 0; j < 8; ++j) { o4[64 * j] = v[j]; o8[64 * j] = (unsigned long long)pk2h(v[j].x, v[j].y) | ((unsigned long long)pk2h(v[j].z, v[j].w) << 32); }
}
__device__ __forceinline__ void ln_regs(int lane, f32x4 (&v)[8], const float* g, const float* b, float* o32, f16_t* o16) { ln_norm(lane, v, g, b); ln_store(lane, v, o32, o16); }
__device__ __forceinline__ void route_token(int tok, const float (&acc)[36], const float* gb, const float* eb, int* cnt, int* ltok, int* lpair, float* pairw) {
    float gl[4]; float gm = -3.0e38f; int gi = 0;
#pragma unroll
    for (int i = 0; i < 4; ++i) { gl[i] = acc[i] + gb[i]; if (gl[i] > gm) { gm = gl[i]; gi = i; } }
    float gs = 0.f;
#pragma unroll
    for (int i = 0; i < 4; ++i) gs += __expf(gl[i] - gm);
    const float gtop = 1.f / gs;
    float el[8]; float em = -3.0e38f; int e0 = 0;
#pragma unroll
    for (int i = 0; i < 8; ++i) { float v = 0.f;
#pragma unroll
        for (int g = 0; g < 4; ++g) if (g == gi) v = acc[4 + g * 8 + i] + eb[g * 8 + i];
        el[i] = v; if (v > em) { em = v; e0 = i; } }
    float em2 = -3.0e38f; int e1 = 0;
#pragma unroll
    for (int i = 0; i < 8; ++i) if (i != e0 && el[i] > em2) { em2 = el[i]; e1 = i; }
    const float x1 = __expf(em2 - em);
    const float w0 = 1.f / (1.f + x1), w1 = x1 / (1.f + x1);
    const int ea = gi * 8 + e0, ebb = gi * 8 + e1;
    const int p0 = atomicAdd(&cnt[ea], 1); ltok[ea * 8192 + p0] = tok; lpair[ea * 8192 + p0] = tok * 2;
    const int p1 = atomicAdd(&cnt[ebb], 1); ltok[ebb * 8192 + p1] = tok; lpair[ebb * 8192 + p1] = tok * 2 + 1;
    pairw[tok * 2] = w0 * gtop; pairw[tok * 2 + 1] = w1 * gtop;
}
constexpr int TAB_OFF = LDSCTL_OFF + 1024;
__device__ __forceinline__ void build_moe_table(Frame& F, const int* cnt) {
    LAS int* tab = (LAS int*)(F.lds + TAB_OFF);
    const int tid = FTID;
    if (tid < 32) tab[tid] = __hip_atomic_load(cnt + tid, __ATOMIC_RELAXED, __HIP_MEMORY_SCOPE_AGENT);
    __syncthreads();
    if (tid == 0) { int p = 0; for (int e = 0; e < 32; ++e) { tab[32 + e] = p; p += (tab[e] + 255) >> 8; } tab[64] = p; }
    __syncthreads();
}

__device__ __forceinline__ float sum8_dpp(float x) {
    x += __builtin_bit_cast(float, __builtin_amdgcn_update_dpp(0, __builtin_bit_cast(int, x), 0xB1, 0xF, 0xF, true));
    x += __builtin_bit_cast(float, __builtin_amdgcn_update_dpp(0, __builtin_bit_cast(int, x), 0x4E, 0xF, 0xF, true));
    x += __builtin_bit_cast(float, __builtin_amdgcn_update_dpp(0, __builtin_bit_cast(int, x), 0x141, 0xF, 0xF, true));
    return x;
}
__device__ __forceinline__ float h2f(unsigned short u) { return (float)__builtin_bit_cast(_Float16, u); }
__device__ __forceinline__ float sum32_x(float x) {
    x += __builtin_bit_cast(float, __builtin_amdgcn_update_dpp(0, __builtin_bit_cast(int, x), 0xB1, 0xF, 0xF, true));
    x += __builtin_bit_cast(float, __builtin_amdgcn_update_dpp(0, __builtin_bit_cast(int, x), 0x4E, 0xF, 0xF, true));
    x += __builtin_bit_cast(float, __builtin_amdgcn_update_dpp(0, __builtin_bit_cast(int, x), 0x141, 0xF, 0xF, true));
    x += __builtin_bit_cast(float, __builtin_amdgcn_update_dpp(0, __builtin_bit_cast(int, x), 0x140, 0xF, 0xF, true));
    x += __builtin_bit_cast(float, __builtin_amdgcn_ds_bpermute((pg8::lane_id() ^ 16) << 2, __builtin_bit_cast(int, x)));
    return x;
}
__device__ __forceinline__ float wsum64(float x) {
    x = sum32_x(x); auto rr = __builtin_amdgcn_permlane32_swap(__float_as_uint(x), __float_as_uint(x), false, false); return __uint_as_float(rr[0]) + __uint_as_float(rr[1]);
}
__device__ __forceinline__ void rwkv_prep_tile(Frame& F, int tile, const f16_t* PROJ16, const f16_t* LSLAB, const float* mu, const float* w0, const f16_t* W2T, const float* a0, const f16_t* A2T, const f16_t* G2T,
                                               const float* k_k, const float* k_a, float* lwout, f16_t* kmod, f16_t* Aout, f16_t* Bout, f16_t* gout) {
    typedef _Float16 f16x8 __attribute__((ext_vector_type(8))); typedef float f32x16 __attribute__((ext_vector_type(16)));
    constexpr int SXS = 592;
    LAS unsigned char* sx = F.lds + RING_OFF;
    const int lane = FLANE, tid = F.wave * 64 + lane, t0 = tile * 32, r32 = lane & 31, hi = lane >> 5;
    __syncthreads();
    for (int e = tid; e < 32 * 36; e += 512) {
        typedef unsigned short us8v __attribute__((ext_vector_type(8)));
        const int tok = e / 36, i8 = (e % 36) * 8, pos = (t0 + tok) & (S - 1);
        float cv[8], pv[8];
#pragma unroll
        for (int i = 0; i < 8; ++i) { cv[i] = 0.f; pv[i] = 0.f; }
#pragma unroll
        for (int sl = 0; sl < 4; ++sl) { const f16_t* cur = LSLAB + ((size_t)sl * T + t0 + tok) * 512 + i8;
            const us8v c8 = *(const GAS us8v*)cur; us8v p8 = c8; if (pos > 0) p8 = *(const GAS us8v*)(cur - 512);
#pragma unroll
            for (int i = 0; i < 8; ++i) { cv[i] += h2f(c8[i]); pv[i] += h2f(p8[i]); } }
        float f[8];
#pragma unroll
        for (int i = 0; i < 8; ++i) { const float xs = cv[i] + ((pos > 0 ? pv[i] : 0.f) - cv[i]) * mu[3072 + i8 + i];
            f[i] = i8 < 64 ? 1.f - 2.f / (1.f + __expf(2.f * xs)) : (i8 < 128 ? xs : 1.f / (1.f + __expf(-xs))); }
        *(LAS v4u*)(sx + tok * SXS + i8 * 2) = (v4u){pk2h(f[0], f[1]), pk2h(f[2], f[3]), pk2h(f[4], f[5]), pk2h(f[6], f[7])};
    }
    __syncthreads();
    const LAS unsigned char* ap = sx + r32 * SXS + hi * 16;
#pragma unroll 1
    for (int hd = 0; hd < 2; ++hd) {
        const int ch0 = 128 * F.wave + 64 * hd;
        f32x16 aw[2], aa[2], ag[2];
#pragma unroll
        for (int tt = 0; tt < 2; ++tt)
#pragma unroll
            for (int r = 0; r < 16; ++r) { aw[tt][r] = 0.f; aa[tt][r] = 0.f; ag[tt][r] = 0.f; }
#pragma unroll
        for (int tt = 0; tt < 2; ++tt) {
            const int n = ch0 + 32 * tt + r32;
            const f16_t* bw = W2T + (size_t)n * 64 + hi * 8; const f16_t* ba = A2T + (size_t)n * 64 + hi * 8; const f16_t* bg = G2T + (size_t)n * 160 + hi * 8;
#pragma unroll
            for (int ks = 0; ks < 4; ++ks) {
                aw[tt] = __builtin_amdgcn_mfma_f32_32x32x16_f16(*(const LAS f16x8*)(ap + ks * 32), *(const GAS f16x8*)(bw + ks * 16), aw[tt], 0, 0, 0);
                aa[tt] = __builtin_amdgcn_mfma_f32_32x32x16_f16(*(const LAS f16x8*)(ap + 128 + ks * 32), *(const GAS f16x8*)(ba + ks * 16), aa[tt], 0, 0, 0); }
#pragma unroll
            for (int ks = 0; ks < 10; ++ks)
                ag[tt] = __builtin_amdgcn_mfma_f32_32x32x16_f16(*(const LAS f16x8*)(ap + 256 + ks * 32), *(const GAS f16x8*)(bg + ks * 16), ag[tt], 0, 0, 0);
        }
        float k0[2][16];
        float pkk[2], pka[2], pmu[2], pw0[2], pa0[2];
#pragma unroll
        for (int tt = 0; tt < 2; ++tt) { const int n = ch0 + 32 * tt + r32; pkk[tt] = k_k[n]; pka[tt] = k_a[n]; pmu[tt] = mu[1024 + n]; pw0[tt] = w0[n]; pa0[tt] = a0[n]; }
#pragma unroll
        for (int rh = 0; rh < 2; ++rh) {
        float inv[8];
#pragma unroll
        for (int r = 8 * rh; r < 8 * rh + 8; ++r) { const int tok = t0 + (r & 3) + 8 * (r >> 2) + 4 * hi, pos = tok & (S - 1); float ss = 0.f;
#pragma unroll
            for (int tt = 0; tt < 2; ++tt) { const f16_t* cur = PROJ16 + (size_t)tok * PN + 4096 + ch0 + 32 * tt + r32;
                const float cv = h2f(cur[0]), pv = pos > 0 ? h2f(cur[-PN]) : 0.f; k0[tt][r] = cv + (pv - cv) * pmu[tt]; const float kq = k0[tt][r] * pkk[tt]; ss = fmaf(kq, kq, ss); }
            ss = sum32_x(ss); inv[r - 8 * rh] = __builtin_amdgcn_rsqf(fmaxf(ss, 1e-24f)); }
#pragma unroll
        for (int r = 8 * rh; r < 8 * rh + 8; ++r) { const int tok = t0 + (r & 3) + 8 * (r >> 2) + 4 * hi;
#pragma unroll
            for (int tt = 0; tt < 2; ++tt) { const size_t o = (size_t)tok * RWK + ch0 + 32 * tt + r32;
                const float z = -(pw0[tt] + aw[tt][r]); const float sp = z > 20.f ? z : __logf(1.f + __expf(z));
                lwout[o] = -__expf(-sp - 0.5f);
                const float asig = 1.f / (1.f + __expf(-(pa0[tt] + aa[tt][r]))); const float kk = k0[tt][r] * pkk[tt] * inv[r - 8 * rh];
                kmod[o] = __builtin_bit_cast(unsigned short, (_Float16)(k0[tt][r] * (1.f + (asig - 1.f) * pka[tt])));
                Aout[o] = __builtin_bit_cast(unsigned short, (_Float16)(-kk)); Bout[o] = __builtin_bit_cast(unsigned short, (_Float16)(kk * asig));
                gout[o] = __builtin_bit_cast(unsigned short, (_Float16)ag[tt][r]); } }
        }
    }
}
__device__ __forceinline__ float sum16_dpp(float x) {
    x += __builtin_bit_cast(float, __builtin_amdgcn_update_dpp(0, __builtin_bit_cast(int, x), 0xB1, 0xF, 0xF, true));
    x += __builtin_bit_cast(float, __builtin_amdgcn_update_dpp(0, __builtin_bit_cast(int, x), 0x4E, 0xF, 0xF, true));
    x += __builtin_bit_cast(float, __builtin_amdgcn_update_dpp(0, __builtin_bit_cast(int, x), 0x141, 0xF, 0xF, true));
    x += __builtin_bit_cast(float, __builtin_amdgcn_update_dpp(0, __builtin_bit_cast(int, x), 0x140, 0xF, 0xF, true));
    return x;
}
__device__ __forceinline__ f32x4 h4f(const f16_t* p) { typedef _Float16 h4_t __attribute__((ext_vector_type(4))); const h4_t v = *(const GAS h4_t*)p; return (f32x4){(float)v[0], (float)v[1], (float)v[2], (float)v[3]}; }
#ifndef REP_P0
#define REP_P0 1
#endif
#ifndef REP_PROJ
#define REP_PROJ 1
#endif
#ifndef REP_PLE
#define REP_PLE 1
#endif
#ifndef REP_CONV
#define REP_CONV 1
#endif
#ifndef REP_P2
#define REP_P2 1
#endif
#ifndef REP_P3
#define REP_P3 1
#endif
#ifndef PROBE_K
#define PROBE_K -1
#endif
#ifndef REP_P5
#define REP_P5 1
#endif
#ifndef REP_P8
#define REP_P8 1
#endif
#ifndef REP_P6
#define REP_P6 1
#endif
#ifndef REP_P7
#define REP_P7 1
#endif
struct Args { const float* in[37]; float* out; unsigned char* ws; int ph_lo, ph_hi, li, pad; };
__global__ void __launch_bounds__(NWAVES * 64, 2) mega_fwd(Args args) {
    extern __shared__ __attribute__((aligned(16))) unsigned char lds[];
    Frame F;
    F.lds = (LAS unsigned char*)lds; F.MISC = (volatile LAS unsigned*)(F.lds + MISC_OFF);
    F.wave = __builtin_amdgcn_readfirstlane(threadIdx.x >> 6);
    F.G = gridDim.x; { const int bx = blockIdx.x; F.vcu = (F.G % 8 == 0) ? (bx % 8) * (F.G / 8) + bx / 8 : bx; }
    unsigned char* ws = args.ws;
    F.ctl = (gu32*)(ws);
    for (int u = FTID; u < (LDS_BYTES - LDSCTL_OFF) / 4; u += NWAVES * 64) ((LAS unsigned*)(F.lds + LDSCTL_OFF))[u] = 0u;
    __syncthreads();
    XcdBarrier bar = xcd_barrier_post((unsigned*)(F.ctl + CW_BAR) + args.li * XCD_BAR_WORDS, F.MISC + 8);
    unsigned long long t0_ = 0, tk_ = 0; if (PROBE_K != -1) t0_ = __builtin_amdgcn_s_memrealtime();
    const int lo = args.ph_lo, hi = args.ph_hi;
#define IN(k) (lo <= (k) && (k) < hi)
#define BOTH(k) (IN(k) && IN((k) + 1))
    f16_t* WinT = (f16_t*)(ws + WS_WINT); f16_t* H16 = (f16_t*)(ws + WS_H16); f16_t* PROJ16 = (f16_t*)(ws + WS_PROJ16); float* DECAY = (float*)(ws + WS_DECAY); f16_t* KMOD = (f16_t*)(ws + WS_KMOD); f16_t* A16 = (f16_t*)(ws + WS_A16); f16_t* B16 = (f16_t*)(ws + WS_B16); f16_t* G16 = (f16_t*)(ws + WS_G16);
    f16_t* WoutT = (f16_t*)(ws + WS_WOUTT); f16_t* GateT = (f16_t*)(ws + WS_GATET); f16_t* PleT = (f16_t*)(ws + WS_PLET); f16_t* P16 = (f16_t*)(ws + WS_P16);
    f16_t* PW16 = (f16_t*)(ws + WS_PW16); f16_t* Y16 = (f16_t*)(ws + WS_Y16); float* ROWRS = (float*)(ws + WS_ROWRS);
    float* RT = (float*)(ws + WS_RT); f16_t* GUT = (f16_t*)(ws + WS_GUT); f16_t* DNT = (f16_t*)(ws + WS_DNT); f16_t* HID = (f16_t*)(ws + WS_HID); f16_t* FFN16 = (f16_t*)(ws + WS_FFN16); f16_t* H1_16 = (f16_t*)(ws + WS_H1_16);
    int* cnt = (int*)(ws + WS_CNT); int* ltok = (int*)(ws + WS_LTOK); int* lpair = (int*)(ws + WS_LPAIR); float* pairw = (float*)(ws + WS_PAIRW);
    const int gw = F.vcu * NWAVES + F.wave, NGW = F.G * NWAVES;
    if (IN(0)) for (int rep_ = 0; rep_ < REP_P0; ++rep_) {
        LAS float* scr = (LAS float*)(F.lds + RING_OFF + F.wave * 16384);
        constexpr int I_IN = (D / 64) * (NPROJ / 32);
        for (int it = gw; it < I_IN; it += NGW) p0_transpose_item(args.in[5], D, NPROJ, WinT, 0, scr, it, FLANE);
        constexpr int I_SQ = (D / 64) * (D / 32), I_PLE = (256 / 64) * (D / 32);
        for (int it = gw; it < 2 * I_SQ + I_PLE; it += NGW) {
            if (it < I_SQ) p0_transpose_item(args.in[22], D, D, WoutT, 0, scr, it, FLANE);
            else if (it < 2 * I_SQ) p0_transpose_item(args.in[36], D, D, GateT, 0, scr, it - I_SQ, FLANE);
            else p0_transpose_item(args.in[34], 256, D, PleT, 0, scr, it - 2 * I_SQ, FLANE);
        }
        { const GAS f32x4* pi = (const GAS f32x4*)args.in[1]; GAS unsigned long long* po = (GAS unsigned long long*)P16;
          for (int i = blockIdx.x * 512 + FTID; i < T * 256 / 4; i += F.G * 512) { const f32x4 v = pi[i]; po[i] = (unsigned long long)pk2h(v.x, v.y) | ((unsigned long long)pk2h(v.z, v.w) << 32); } }
        { GAS v4u* z = (GAS v4u*)(WinT + (size_t)NPROJ * D); const int nz = (PN - NPROJ) * D * 2 / 16;
          for (int i = blockIdx.x * 512 + FTID; i < nz; i += F.G * 512) z[i] = (v4u){0u, 0u, 0u, 0u}; }
        {
            f16_t* W2T = (f16_t*)(ws + WS_W2T); f16_t* A2T = (f16_t*)(ws + WS_A2T); f16_t* G2T = (f16_t*)(ws + WS_G2T);
            for (int i = blockIdx.x * 512 + FTID; i < 1024 * 288; i += F.G * 512) { const int n = i / 288, k = i % 288;
                if (k < 64) W2T[n * 64 + k] = __builtin_bit_cast(unsigned short, (_Float16)args.in[13][k * 1024 + n]);
                else if (k < 128) A2T[n * 64 + (k - 64)] = __builtin_bit_cast(unsigned short, (_Float16)args.in[15][(k - 64) * 1024 + n]);
                else G2T[n * 160 + (k - 128)] = __builtin_bit_cast(unsigned short, (_Float16)args.in[16][(k - 128) * 1024 + n]); } }
        if (blockIdx.x == 0) {
            const int tid = FTID; float* lamp = (float*)(ws + WS_LAM); float* biasT = (float*)(ws + WS_BIAS);
            if (tid < 64) { const float a = wave_sum_b(args.in[6][tid] * args.in[7][tid]), b2 = wave_sum_b(args.in[8][tid] * args.in[9][tid]); if (tid == 0) *lamp = expf(a) - expf(b2) + LAMBDA_INIT; }
            for (int i = tid; i < 8 * 129; i += 512) { const int hh = i / 129, n = i % 129; int bucket;
                if (n < 16) bucket = n; else { const int large = 16 + (int)(logf((float)n / 16.f) / 2.0794415416798357f * 16.f); bucket = large < 31 ? large : 31; }
                biasT[i] = args.in[4][bucket * 8 + hh]; }
        }
        for (int m = gw; m < T; m += NGW) ln_row_dual(FLANE, args.in[0] + (size_t)m * D, args.in[2], args.in[3], args.out + (size_t)m * D, H16 + (size_t)m * D);
        if (BOTH(0) && rep_ == REP_P0 - 1) xcd_barrier(bar); else __syncthreads();
    }
    if (PROBE_K == 0) tk_ = __builtin_amdgcn_s_memrealtime();
    if (IN(1)) {
        pg8::Gemm g{H16, WinT, T, 6144, D, D}; pg8::StaticOrder S; S.init(T, 6144, F.G, (int)blockIdx.x);
        pg8::EpiF16 E{PROJ16, PN, 4, att::C2};
        for (int rep_ = 0; rep_ < REP_PROJ; ++rep_) pg8::gemm_phase<pg8::EpiF16, pg8::StaticOrder, true>(F.lds + RING_OFF, g, S, E, F.wave);
        { pg8::Gemm gl{H16, WinT + (size_t)6144 * D, T, 512, 512, D}; pg8::SplitKOrder Sl{T / 256, 2, 4, F.G, (int)blockIdx.x};
          pg8::EpiSlab El{(f16_t*)(ws + WS_LSLAB), 512, (size_t)T * 512};
          pg8::gemm_phase<pg8::EpiSlab, pg8::SplitKOrder, true>(F.lds + RING_OFF, gl, Sl, El, F.wave); }
        for (int rep_ = 0; rep_ < REP_PLE; ++rep_) { pg8::Gemm g2{P16, PleT, T, D, 256, 256}; pg8::StaticOrder S2; S2.init(T, D, F.G, (int)blockIdx.x);
          pg8::EpiF16 E2{PW16, D, 0, 1.f};
          pg8::gemm_phase<pg8::EpiF16, pg8::StaticOrder, true>(F.lds + RING_OFF, g2, S2, E2, F.wave); }
        if (BOTH(1)) xcd_barrier(bar);
    }
    if (PROBE_K == 1) tk_ = __builtin_amdgcn_s_memrealtime();
    if (IN(2)) {
        for (int rep_ = 0; rep_ < REP_P2; ++rep_)
        if (F.vcu < T / 32) { const int tile = F.vcu;
            rwkv_prep_tile(F, tile, PROJ16, (const f16_t*)(ws + WS_LSLAB), args.in[11], args.in[12], (const f16_t*)(ws + WS_W2T), args.in[14], (const f16_t*)(ws + WS_A2T), (const f16_t*)(ws + WS_G2T), args.in[17], args.in[18], DECAY, KMOD, A16, B16, G16);
            asm volatile("s_waitcnt vmcnt(0)" ::: "memory"); __syncthreads();
            { rk::ChunkIn nin; const int tl_ = (F.wave & 3) * 64 + FLANE, tg_ = tile * 32 + (tl_ >> 3), ps_ = tg_ & (S - 1), cb_ = (F.wave >> 2) * 64 + (tl_ & 7) * 8;
              rk::chunk_load(nin, tg_, ps_, cb_, ws);
              for (int hA = 0; hA < 16; hA += 2) {
                  rk::chunk_pair(F.lds + RING_OFF, F.wave, tile, hA, nin, hA + 2 < 16, args.in[11], args.in[19], ws); } }
            __syncthreads();
        }
        if (BOTH(2)) xcd_barrier(bar);
    }
    if (PROBE_K == 2) tk_ = __builtin_amdgcn_s_memrealtime();
    if (IN(3)) {
        if (F.vcu < 64) rk::scan_unit(F.lds + RING_OFF, F.wave, F.vcu, ws + WS_CHK, (const float*)(ws + WS_BONUS), PROJ16, args.in[11], G16, args.in[20], args.in[21], Y16);
        {
            const float lam = *(const float*)(ws + WS_LAM);
            volatile LAS unsigned* qslot = F.MISC + 12;
            for (;;) {
                __syncthreads();
                if (FTID == 0) *qslot = __hip_atomic_fetch_add(F.ctl + CW_ATTQ, 1u, __ATOMIC_RELAXED, __HIP_MEMORY_SCOPE_AGENT);
                __syncthreads();
                const int u = (int)__builtin_amdgcn_readfirstlane(*qslot);
                if (u >= 512) break;
                const int qb = 15 - (u >> 5), bh = u & 31;
                att::attn_unit<8>(F.lds + RING_OFF, F.wave, bh >> 3, bh & 7, qb, PROJ16, Y16, (const float*)(ws + WS_BIAS) + (bh & 7) * 129, lam, args.in[10]);
            }
        }
        if (BOTH(3)) xcd_barrier(bar);
    }
    if (PROBE_K == 3) tk_ = __builtin_amdgcn_s_memrealtime();
    if (IN(4)) {
        for (int rep_ = 0; rep_ < REP_CONV; ++rep_) {
            __syncthreads();
        LAS float* scr = (LAS float*)(F.lds + RING_OFF + F.wave * 16384);
        for (int it = gw; it < NE * 1536; it += NGW) {
            const int e = it / 1536, r = it % 1536;
            if (r < 512) p0_transpose_item_gu(args.in[29] + (size_t)e * D * 512, D, 512, GUT + (size_t)e * 1024 * D, 0, scr, r, FLANE);
            else if (r < 1024) p0_transpose_item_gu(args.in[30] + (size_t)e * D * 512, D, 512, GUT + (size_t)e * 1024 * D, 1, scr, r - 512, FLANE);
            else p0_transpose_item_gu(args.in[31] + (size_t)e * 512 * D, 512, D, DNT + (size_t)e * D * 512, -1, scr, r - 1024, FLANE);
        }
        for (int i = blockIdx.x * 512 + FTID; i < 36 * D; i += F.G * 512) { const int e = i / D, d = i % D; RT[i] = e < 4 ? args.in[25][d * 4 + e] : args.in[27][d * 32 + (e - 4)]; }
            asm volatile("s_waitcnt vmcnt(0) lgkmcnt(0)" ::: "memory"); __syncthreads();
        }
        pg8::Gemm g{Y16, WoutT, T, D, D, D}; pg8::StaticOrder S; S.init(T, D, F.G, (int)blockIdx.x);
        pg8::EpiResF32 E{args.out, D, ALPHA};
        pg8::gemm_phase<pg8::EpiResF32, pg8::StaticOrder, true>(F.lds + RING_OFF, g, S, E, F.wave);
        if (BOTH(4)) xcd_barrier(bar);
    }
    if (PROBE_K == 4) tk_ = __builtin_amdgcn_s_memrealtime();
    if (IN(5)) for (int rep_ = 0; rep_ < REP_P5; ++rep_) {
        const bool dry = rep_ < REP_P5 - 1;
        float* o32b = dry ? (float*)(ws + WS_CHK) : args.out; f16_t* o16b = dry ? (f16_t*)(ws + WS_CHK + 64 * MiB) : H1_16;
        const int lane = FLANE, tid = F.wave * 64 + lane;
        LAS float* rtb = (LAS float*)(F.lds + RING_OFF);
        LAS float* lg = (LAS float*)(F.lds + RING_OFF + 49152) + F.wave * 256;
        if (F.vcu < T / 32) {
            const int r0 = F.vcu * 32 + F.wave * 4;
            f32x4 v0[8], v1[8], v2[8], v3[8];
            { const GAS f32x4* xr = (const GAS f32x4*)(args.out + (size_t)r0 * D) + lane;
#pragma unroll
              for (int j = 0; j < 8; ++j) { v0[j] = xr[64 * j]; v1[j] = xr[64 * j + D / 4]; v2[j] = xr[64 * j + 2 * (D / 4)]; v3[j] = xr[64 * j + 3 * (D / 4)]; } }
            ln_norm(lane, v0, args.in[23], args.in[24]); ln_norm(lane, v1, args.in[23], args.in[24]); ln_norm(lane, v2, args.in[23], args.in[24]); ln_norm(lane, v3, args.in[23], args.in[24]);
            f32x4 stg[6];
#pragma unroll
            for (int i = 0; i < 6; ++i) stg[i] = *(const GAS f32x4*)(RT + 4 * (tid + 512 * i));
#pragma unroll 1
            for (int ec = 0; ec < 6; ++ec) {
                __syncthreads();
#pragma unroll
                for (int i = 0; i < 6; ++i) *(LAS f32x4*)(rtb + 4 * (tid + 512 * i)) = stg[i];
                { const int en = ec + 1 < 6 ? ec + 1 : ec;
#pragma unroll
                  for (int i = 0; i < 6; ++i) stg[i] = *(const GAS f32x4*)(RT + (size_t)en * 6 * D + 4 * (tid + 512 * i)); }
                __syncthreads();
                float a0[6], a1[6], a2[6], a3[6];
#pragma unroll
                for (int e = 0; e < 6; ++e) { a0[e] = 0.f; a1[e] = 0.f; a2[e] = 0.f; a3[e] = 0.f; }
#pragma unroll
                for (int j = 0; j < 8; ++j)
#pragma unroll
                    for (int e = 0; e < 6; ++e) { const f32x4 w = *(const LAS f32x4*)(rtb + e * D + 256 * j + 4 * lane);
                        a0[e] += (v0[j].x * w.x + v0[j].y * w.y) + (v0[j].z * w.z + v0[j].w * w.w);
                        a1[e] += (v1[j].x * w.x + v1[j].y * w.y) + (v1[j].z * w.z + v1[j].w * w.w);
                        a2[e] += (v2[j].x * w.x + v2[j].y * w.y) + (v2[j].z * w.z + v2[j].w * w.w);
                        a3[e] += (v3[j].x * w.x + v3[j].y * w.y) + (v3[j].z * w.z + v3[j].w * w.w); }
#pragma unroll
                for (int e = 0; e < 6; ++e) { a0[e] = wsum64(a0[e]); a1[e] = wsum64(a1[e]); a2[e] = wsum64(a2[e]); a3[e] = wsum64(a3[e]); }
                if (lane == 0) {
#pragma unroll
                    for (int e = 0; e < 6; ++e) { lg[ec * 6 + e] = a0[e]; lg[64 + ec * 6 + e] = a1[e]; lg[128 + ec * 6 + e] = a2[e]; lg[192 + ec * 6 + e] = a3[e]; } }
            }
            LDS_WAIT();
            if (lane < 4 && !dry) { float aa[36];
#pragma unroll
                for (int e = 0; e < 36; ++e) aa[e] = lg[lane * 64 + e];
                route_token(r0 + lane, aa, args.in[26], args.in[28], cnt, ltok, lpair, pairw); }
            LDS_WAIT();
            ln_store(lane, v0, o32b + (size_t)r0 * D, o16b + (size_t)r0 * D); ln_store(lane, v1, o32b + (size_t)(r0 + 1) * D, o16b + (size_t)(r0 + 1) * D);
            ln_store(lane, v2, o32b + (size_t)(r0 + 2) * D, o16b + (size_t)(r0 + 2) * D); ln_store(lane, v3, o32b + (size_t)(r0 + 3) * D, o16b + (size_t)(r0 + 3) * D);
        }
        if (BOTH(5) && !dry) xcd_barrier(bar); else __syncthreads();
    }
    if (PROBE_K == 5) tk_ = __builtin_amdgcn_s_memrealtime();
    if (IN(6)) {
        build_moe_table(F, cnt);
        pg8::Gemm g{H1_16, GUT, 0, 0, D, D}; pg8::MoeOrder<true> S{(const LAS int*)(F.lds + TAB_OFF), ltok, F.vcu, F.G, 4, (size_t)1024 * D * 2};
        pg8::EpiGU E{HID};
        for (int rep_ = 0; rep_ < REP_P6; ++rep_) pg8::gemm_phase<pg8::EpiGU, pg8::MoeOrder<true>, true>(F.lds + RING_OFF, g, S, E, F.wave);
        if (BOTH(6)) xcd_barrier(bar);
    }
    if (PROBE_K == 6) tk_ = __builtin_amdgcn_s_memrealtime();
    if (IN(7)) {
        build_moe_table(F, cnt);
        pg8::Gemm g{HID, DNT, 0, 0, 512, 512}; pg8::MoeOrder<false> S{(const LAS int*)(F.lds + TAB_OFF), nullptr, F.vcu, F.G, 8, (size_t)D * 512 * 2};
        pg8::EpiDown E{FFN16, lpair};
        for (int rep_ = 0; rep_ < REP_P7; ++rep_) pg8::gemm_phase<pg8::EpiDown, pg8::MoeOrder<false>, true>(F.lds + RING_OFF, g, S, E, F.wave);
        if (BOTH(7)) xcd_barrier(bar);
    }
    if (PROBE_K == 7) tk_ = __builtin_amdgcn_s_memrealtime();
    if (IN(8)) for (int rep_ = 0; rep_ < REP_P8; ++rep_) {
        const bool dry = rep_ < REP_P8 - 1;
        float* o32b = dry ? (float*)(ws + WS_GUT) : args.out; f16_t* o16b = dry ? (f16_t*)(ws + WS_GUT + 64 * MiB) : Y16; float* rrs = dry ? (float*)(ws + WS_GUT + 100 * MiB) : ROWRS;
        typedef _Float16 h4_t __attribute__((ext_vector_type(4)));
        const int lane = FLANE;
        for (int m = gw; m < T; m += NGW) {
            f32x4 v[8]; const GAS f32x4* xr = (const GAS f32x4*)(args.out + (size_t)m * D) + lane;
            const GAS h4_t* f0 = (const GAS h4_t*)(FFN16 + (size_t)(2 * m) * D) + lane; const GAS h4_t* f1 = (const GAS h4_t*)(FFN16 + (size_t)(2 * m + 1) * D) + lane;
            const GAS h4_t* pr = (const GAS h4_t*)(PW16 + (size_t)m * D) + lane;
            const float w0 = pairw[2 * m], w1 = pairw[2 * m + 1]; float q = 0.f;
#pragma unroll
            for (int j = 0; j < 8; ++j) { const f32x4 x = xr[64 * j]; const h4_t a = f0[64 * j], c = f1[64 * j], pv = pr[64 * j];
                v[j].x = ALPHA * x.x + w0 * (float)a[0] + w1 * (float)c[0]; v[j].y = ALPHA * x.y + w0 * (float)a[1] + w1 * (float)c[1];
                v[j].z = ALPHA * x.z + w0 * (float)a[2] + w1 * (float)c[2]; v[j].w = ALPHA * x.w + w0 * (float)a[3] + w1 * (float)c[3];
                q += ((float)pv[0] * (float)pv[0] + (float)pv[1] * (float)pv[1]) + ((float)pv[2] * (float)pv[2] + (float)pv[3] * (float)pv[3]); }
            ln_regs(lane, v, args.in[32], args.in[33], o32b + (size_t)m * D, o16b + (size_t)m * D);
            q = wave_sum_b(q);
            if (lane == 0) rrs[m] = __builtin_amdgcn_rsqf(q * (1.f / D) + LN_EPS);
        }
        if (BOTH(8) && !dry) xcd_barrier(bar); else __syncthreads();
    }
    if (PROBE_K == 8) tk_ = __builtin_amdgcn_s_memrealtime();
    if (IN(9)) {
        pg8::Gemm g{Y16, GateT, T, D, D, D}; pg8::StaticOrder S; S.init(T, D, F.G, (int)blockIdx.x);
        pg8::EpiFinal E{args.out, D, PW16, ROWRS, args.in[35]};
        pg8::gemm_phase<pg8::EpiFinal, pg8::StaticOrder, true>(F.lds + RING_OFF, g, S, E, F.wave);
    }
    if (PROBE_K != -1) {
        if (PROBE_K == 9) tk_ = __builtin_amdgcn_s_memrealtime();
        xcd_barrier(bar);
        if (blockIdx.x == 0 && FTID == 0) args.out[0] += (PROBE_K == -2) ? 100000.f : (float)(tk_ - t0_);
    }
#undef IN
#undef BOTH
}

extern "C" void kernel_launch(void* const* d_in, const int* in_sizes, int n_in, void* d_out, int out_size, void* d_ws, size_t ws_size, hipStream_t stream) {
    static int grid = 0;
    if (grid == 0) {
        if (ws_size < WS_END2 || n_in != 37 || out_size != T * D) { fprintf(stderr, "kernel_launch: bad ws/n_in/out: %zu %d %d\n", ws_size, n_in, out_size); grid = -1; return; }
        int dev = 0, cus = 0;
        if (hipGetDevice(&dev) != hipSuccess || hipDeviceGetAttribute(&cus, hipDeviceAttributeMultiprocessorCount, dev) != hipSuccess) { grid = -1; return; }
        if (hipFuncSetAttribute((const void*)mega_fwd, hipFuncAttributeMaxDynamicSharedMemorySize, LDS_BYTES) != hipSuccess) { fprintf(stderr, "kernel_launch: hipFuncSetAttribute failed\n"); grid = -1; return; }
        if (cus != 256) { fprintf(stderr, "kernel_launch: built for a 256-CU device, found %d\n", cus); grid = -1; return; }
        grid = cus;
    }
    if (grid < 0) return;
    (void)hipMemsetAsync(d_ws, 0, CTL_ZERO_BYTES, stream);
    Args a{}; for (int i = 0; i < 37; ++i) a.in[i] = (const float*)d_in[i]; a.out = (float*)d_out; a.ws = (unsigned char*)d_ws; a.ph_lo = 0; a.ph_hi = 10; a.li = 0;
    hipLaunchKernelGGL(mega_fwd, dim3(grid), dim3(NWAVES * 64), LDS_BYTES, stream, a);
}
```

```cpp
#include <hip/hip_runtime.h>
#include <cstdio>
#include <cstdint>
#include <cmath>

constexpr int NB = 4, S = 2048, D = 2048, T = NB * S;
constexpr int NPROJ = 6432;
constexpr int RWK = 1024;
constexpr int COL_Q = 0, COL_K = 1024, COL_V = 2048, COL_RW = 3072;
constexpr int NH = 8, NRH = 16;
constexpr int NE = 32;
constexpr float LN_EPS = 1e-5f;
constexpr float ALPHA = 1.189207115002721f;
constexpr float LAMBDA_INIT = 0.2f;

constexpr size_t MiB = 1u << 20;
constexpr size_t WS_CNT = 0;
constexpr size_t WS_LTOK = 1 * MiB;
constexpr size_t WS_LPAIR = 2 * MiB;
constexpr size_t WS_PAIRW = 3 * MiB;
constexpr size_t WS_RT = 3 * MiB + 128 * 1024;
constexpr size_t WS_LAM = 3 * MiB + 512 * 1024;
constexpr size_t WS_BIAS = 3 * MiB + 512 * 1024 + 1024;
constexpr size_t WS_ROWRS = 3 * MiB + 768 * 1024;
constexpr size_t WS_WINT = 4 * MiB;
constexpr size_t WS_WOUTT = 30 * MiB;
constexpr size_t WS_GATET = 38 * MiB;
constexpr size_t WS_PLET = 46 * MiB;
constexpr size_t WS_P16 = 47 * MiB;
constexpr size_t WS_W2T = 51 * MiB;
constexpr size_t WS_A2T = 51 * MiB + 128 * 1024;
constexpr size_t WS_G2T = 51 * MiB + 256 * 1024;
constexpr size_t WS_CHK = 52 * MiB;
constexpr size_t WS_BONUS = 148 * MiB;
constexpr size_t WS_LSLAB = 150 * MiB;
constexpr size_t WS_GUT = 244 * MiB;
constexpr size_t WS_DNT = 372 * MiB;
constexpr size_t WS_PROJ16 = 244 * MiB;
constexpr size_t WS_FFN16 = 52 * MiB;
constexpr size_t WS_HID = 116 * MiB;
constexpr size_t WS_DECAY = 348 * MiB;
constexpr size_t WS_KMOD = 380 * MiB;
constexpr size_t WS_A16 = 396 * MiB;
constexpr size_t WS_B16 = 412 * MiB;
constexpr size_t WS_G16 = 428 * MiB;
constexpr size_t WS_H16 = 444 * MiB;
constexpr size_t WS_H1_16 = WS_H16;
constexpr size_t WS_Y16 = 476 * MiB;
constexpr size_t WS_PW16 = 508 * MiB;
constexpr size_t WS_END2 = 540 * MiB;

namespace pg8 {
#define PG8_LAS __attribute__((address_space(3)))
typedef unsigned short f16_t;
typedef _Float16 f16x8 __attribute__((ext_vector_type(8)));
typedef float f32x4 __attribute__((ext_vector_type(4)));
typedef unsigned u32x4 __attribute__((ext_vector_type(4)));
constexpr int BM = 256, BK = 64, HALF = 128, HTB = HALF * BK * 2  , STAGE_BYTES = 8 * HTB, NXCD = 8, WGM = 8;

__host__ __device__ __forceinline__ int lds_byte(int r, int c) { const int st = (r >> 4) * 2 + (c >> 5), rr = r & 15, cc = c & 31, ob = rr * 64 + cc * 2; return st * 1024 + (ob ^ (((ob >> 9) & 1) << 5)); }
__host__ __device__ __forceinline__ void stage_rc(int b, int& R, int& C) { const int st = b / 1024, sb = b % 1024, swz = sb ^ (((sb >> 9) & 1) << 5); R = (st >> 1) * 16 + swz / 64; C = (st & 1) * 32 + (swz % 64) / 2; }
__host__ __device__ __forceinline__ int perm32(int rho) { const int n = rho >> 4, i = rho & 15; return 8 * (i >> 2) + 4 * n + (i & 3); }

__device__ __forceinline__ int lane_id() { int l; asm volatile("v_mbcnt_lo_u32_b32 %0, -1, 0\n\tv_mbcnt_hi_u32_b32 %0, -1, %0" : "=v"(l)); return l; }
struct Unit { int pm, pn, e, rb, cnt; };
struct Gemm { const f16_t* A; const f16_t* Bt; int M, N, K, ld; };

struct StaticOrder {
    int nM, nN, nwg, G, c;
    __host__ __device__ void init(int M, int N, int G_, int c_) { nM = M / BM; nN = N / BM; nwg = nM * nN; G = G_; c = c_; }
    __host__ __device__ bool next(int i, Unit& u) const {
        const long L = (long)i * G + c; if (L >= nwg) return false;
        int wgid = (int)L; { const int q = nwg / NXCD, r = nwg % NXCD, xcd = wgid % NXCD, off = wgid / NXCD; wgid = (xcd < r ? xcd * (q + 1) : r * (q + 1) + (xcd - r) * q) + off; }
        const int nig = WGM * nN, gid = wgid / nig, fm = gid * WGM, gsz = (nM - fm) < WGM ? (nM - fm) : WGM;
        u.pm = fm + ((wgid % nig) % gsz); u.pn = (wgid % nig) / gsz; return true;
    }
    __device__ __forceinline__ void a_ready(const Unit&) const {}
    __device__ __forceinline__ void done(const Unit&) const {}
    __device__ __forceinline__ const char* a_base(const Gemm& g, const Unit& u) const { return (const char*)g.A + (size_t)u.pm * ((size_t)BM * g.ld * 2); }
    __device__ __forceinline__ const char* b_base(const Gemm& g, const Unit& u) const { return (const char*)g.Bt + (size_t)u.pn * ((size_t)BM * g.ld * 2); }
    __device__ __forceinline__ void a_voff(const Gemm& g, const Unit&, int tid, unsigned (&va)[2][2]) const {
#pragma unroll
        for (int i = 0; i < 2; ++i) { int R, C; stage_rc(tid * 16 + i * 8192, R, C); va[0][i] = (unsigned)(R * g.ld + C) * 2u; va[1][i] = va[0][i] + (unsigned)(HALF * g.ld * 2); }
    }
};
struct SplitKOrder {
    int nM, nN, nks, G, c;
    __device__ __forceinline__ bool next(int i, Unit& u) const { const int L = i * G + c; if (L >= nM * nN * nks) return false; u.e = L / (nM * nN); const int rem = L % (nM * nN); u.pn = rem / nM; u.pm = rem % nM; u.rb = 0; u.cnt = 0; return true; }
    __device__ __forceinline__ void a_ready(const Unit&) const {}
    __device__ __forceinline__ void done(const Unit&) const {}
    __device__ __forceinline__ const char* a_base(const Gemm& g, const Unit& u) const { return (const char*)g.A + (size_t)u.pm * ((size_t)BM * g.ld * 2) + (size_t)u.e * g.K * 2; }
    __device__ __forceinline__ const char* b_base(const Gemm& g, const Unit& u) const { return (const char*)g.Bt + (size_t)u.pn * ((size_t)BM * g.ld * 2) + (size_t)u.e * g.K * 2; }
    __device__ __forceinline__ void a_voff(const Gemm& g, const Unit&, int tid, unsigned (&va)[2][2]) const {
#pragma unroll
        for (int i = 0; i < 2; ++i) { int R, C; stage_rc(tid * 16 + i * 8192, R, C); va[0][i] = (unsigned)(R * g.ld + C) * 2u; va[1][i] = va[0][i] + (unsigned)(HALF * g.ld * 2); }
    }
};
template <bool GATHER> struct MoeOrder {
    const PG8_LAS int* tab; const int* list; int vcu, G, ntn; size_t estride; int cls;
    __device__ __forceinline__ bool next(int i, Unit& u) const {
        const int L = vcu + i * G; const int base = cls ? 98 : 65; const int tot = tab[base + 32] * ntn; if (L >= tot) return false;
        int e = 0; while (tab[base + 1 + e] * ntn <= L) ++e;
        const int nbk = tab[base + 1 + e] - tab[base + e], q = L - tab[base + e] * ntn; const int rb = q % nbk + (cls ? 2 : 0);
        u.e = __builtin_amdgcn_readfirstlane(e); u.pn = __builtin_amdgcn_readfirstlane(q / nbk); u.rb = __builtin_amdgcn_readfirstlane(rb);
        u.pm = __builtin_amdgcn_readfirstlane(tab[32 + e] + rb); u.cnt = __builtin_amdgcn_readfirstlane(tab[e]); return true;
    }
    __device__ __forceinline__ void a_ready(const Unit&) const {}
    __device__ __forceinline__ void done(const Unit&) const {}
    __device__ __forceinline__ const char* a_base(const Gemm& g, const Unit& u) const { return GATHER ? (const char*)g.A : (const char*)g.A + (size_t)u.pm * ((size_t)BM * g.ld * 2); }
    __device__ __forceinline__ const char* b_base(const Gemm& g, const Unit& u) const { return (const char*)g.Bt + (size_t)u.e * estride + (size_t)u.pn * ((size_t)BM * g.ld * 2); }
    __device__ __forceinline__ void a_voff(const Gemm& g, const Unit& u, int tid, unsigned (&va)[2][2]) const {
#pragma unroll
        for (int i = 0; i < 2; ++i) { int R, C; stage_rc(tid * 16 + i * 8192, R, C);
            if (GATHER) {
#pragma unroll
                for (int h = 0; h < 2; ++h) { int idx = u.rb * BM + h * HALF + R; idx = idx < u.cnt ? idx : u.cnt - 1; const int tok = list[u.e * 8192 + idx]; va[h][i] = (unsigned)(tok * g.ld + C) * 2u; }
            } else { va[0][i] = (unsigned)(R * g.ld + C) * 2u; va[1][i] = va[0][i] + (unsigned)(HALF * g.ld * 2); } }
    }
};


typedef _Float16 h2_t __attribute__((ext_vector_type(2)));
__device__ __forceinline__ unsigned cvt_pk_f16(float lo, float hi) { h2_t v = {(_Float16)lo, (_Float16)hi}; return __builtin_bit_cast(unsigned, v); }
struct EpiF16 {
    static constexpr bool PERM = true, AFTER_DRAIN = false;
    f16_t* O; int ldc; int ntile0; float scale0;
    __device__ __forceinline__ void operator()(const f32x4 (&acc)[2][2][4][2], const Unit& u, int wr, int wc, int fr, int fq) const {
        const int row0 = u.pm * BM + wr * 64 + fr; const int col0 = u.pn * BM + wc * 32 + 8 * fq;
        const float sc = (u.pn < ntile0) ? scale0 : 1.f;
#pragma unroll
        for (int ai = 0; ai < 2; ++ai)
#pragma unroll
            for (int m = 0; m < 4; ++m) { f16_t* rowp = O + (size_t)(row0 + ai * HALF + m * 16) * ldc + col0;
#pragma unroll
                for (int bj = 0; bj < 2; ++bj) { f32x4 v0 = acc[ai][bj][m][0] * sc, v1 = acc[ai][bj][m][1] * sc;
                    u32x4 w; w.x = cvt_pk_f16(v0[0], v0[1]); w.y = cvt_pk_f16(v0[2], v0[3]); w.z = cvt_pk_f16(v1[0], v1[1]); w.w = cvt_pk_f16(v1[2], v1[3]);
                    *(u32x4*)(rowp + bj * HALF) = w; } }
    }
};


struct EpiSlab {
    static constexpr bool PERM = true, AFTER_DRAIN = false;
    f16_t* O; int ldc; size_t slab;
    __device__ __forceinline__ void operator()(const f32x4 (&acc)[2][2][4][2], const Unit& u, int wr, int wc, int fr, int fq) const {
        const int row0 = u.pm * BM + wr * 64 + fr; const int col0 = u.pn * BM + wc * 32 + 8 * fq; f16_t* Ob = O + (size_t)u.e * slab;
#pragma unroll
        for (int ai = 0; ai < 2; ++ai)
#pragma unroll
            for (int m = 0; m < 4; ++m) { f16_t* rowp = Ob + (size_t)(row0 + ai * HALF + m * 16) * ldc + col0;
#pragma unroll
                for (int bj = 0; bj < 2; ++bj) { const f32x4 v0 = acc[ai][bj][m][0], v1 = acc[ai][bj][m][1];
                    u32x4 w; w.x = cvt_pk_f16(v0[0], v0[1]); w.y = cvt_pk_f16(v0[2], v0[3]); w.z = cvt_pk_f16(v1[0], v1[1]); w.w = cvt_pk_f16(v1[2], v1[3]);
                    *(u32x4*)(rowp + bj * HALF) = w; } }
    }
};
struct EpiResF32 {
    static constexpr bool PERM = false, AFTER_DRAIN = false;
    float* io; int ldc; float alpha;
    __device__ __forceinline__ void operator()(const f32x4 (&acc)[2][2][4][2], const Unit& u, int wr, int wc, int fr, int fq) const {
        const int row0 = u.pm * BM + wr * 64 + fr; const int col0 = u.pn * BM + wc * 32 + 4 * fq;
#pragma unroll
        for (int ai = 0; ai < 2; ++ai)
#pragma unroll
            for (int m = 0; m < 4; ++m) { float* rowp = io + (size_t)(row0 + ai * HALF + m * 16) * ldc + col0;
#pragma unroll
                for (int bj = 0; bj < 2; ++bj)
#pragma unroll
                    for (int n = 0; n < 2; ++n) { f32x4* p = (f32x4*)(rowp + bj * HALF + n * 16); const f32x4 r = *p; *p = r * alpha + acc[ai][bj][m][n]; } }
    }
};
struct EpiFinal {
    static constexpr bool PERM = false, AFTER_DRAIN = false;
    float* io; int ldc; const f16_t* pw; const float* rowrs; const float* g;
    __device__ __forceinline__ void operator()(const f32x4 (&acc)[2][2][4][2], const Unit& u, int wr, int wc, int fr, int fq) const {
        typedef _Float16 h4_t __attribute__((ext_vector_type(4)));
        const int row0 = u.pm * BM + wr * 64 + fr; const int col0 = u.pn * BM + wc * 32 + 4 * fq;
#pragma unroll
        for (int ai = 0; ai < 2; ++ai)
#pragma unroll
            for (int m = 0; m < 4; ++m) { const int row = row0 + ai * HALF + m * 16; const size_t off = (size_t)row * ldc + col0;
                const float rs = rowrs[row];
#pragma unroll
                for (int bj = 0; bj < 2; ++bj)
#pragma unroll
                    for (int n = 0; n < 2; ++n) { f32x4* p = (f32x4*)(io + off + bj * HALF + n * 16); const f32x4 hv = *p; const h4_t pv = *(const h4_t*)(pw + off + bj * HALF + n * 16);
                        const f32x4 gv = *(const f32x4*)(g + col0 + bj * HALF + n * 16);
                        const f32x4 a = acc[ai][bj][m][n]; f32x4 o;
#pragma unroll
                        for (int c = 0; c < 4; ++c) o[c] = hv[c] + (1.f / (1.f + __expf(-a[c]))) * ((float)pv[c] * rs) * gv[c];
                        *p = o; }
                asm volatile("" ::: "memory"); }
    }
};

struct EpiGU {
    static constexpr bool PERM = true, AFTER_DRAIN = false;
    f16_t* O;
    __device__ __forceinline__ void operator()(const f32x4 (&acc)[2][2][4][2], const Unit& u, int wr, int wc, int fr, int fq) const {
        const int row0 = u.pm * BM + wr * 64 + fr; const int col0 = u.pn * HALF + wc * 32 + 8 * fq;
#pragma unroll
        for (int ai = 0; ai < 2; ++ai)
#pragma unroll
            for (int m = 0; m < 4; ++m) { f16_t* rowp = O + (size_t)(row0 + ai * HALF + m * 16) * 512 + col0; float o[8];
#pragma unroll
                for (int n = 0; n < 2; ++n)
#pragma unroll
                    for (int c = 0; c < 4; ++c) { const float gt = acc[ai][0][m][n][c], up = acc[ai][1][m][n][c]; o[n * 4 + c] = gt / (1.f + __expf(-gt)) * up; }
                u32x4 w; w.x = cvt_pk_f16(o[0], o[1]); w.y = cvt_pk_f16(o[2], o[3]); w.z = cvt_pk_f16(o[4], o[5]); w.w = cvt_pk_f16(o[6], o[7]);
                *(u32x4*)rowp = w; }
    }
};
struct EpiDown {
    static constexpr bool PERM = true, AFTER_DRAIN = false;
    f16_t* O; const int* lpair;
    __device__ __forceinline__ void operator()(const f32x4 (&acc)[2][2][4][2], const Unit& u, int wr, int wc, int fr, int fq) const {
        const int r0 = u.rb * BM + wr * 64 + fr; const int col0 = u.pn * BM + wc * 32 + 8 * fq;
#pragma unroll
        for (int ai = 0; ai < 2; ++ai)
#pragma unroll
            for (int m = 0; m < 4; ++m) { const int r = r0 + ai * HALF + m * 16;
                if (r < u.cnt) { const int pair = lpair[u.e * 8192 + r]; f16_t* rowp = O + (size_t)pair * 2048 + col0;
#pragma unroll
                    for (int bj = 0; bj < 2; ++bj) { const f32x4 v0 = acc[ai][bj][m][0], v1 = acc[ai][bj][m][1];
                        u32x4 w; w.x = cvt_pk_f16(v0[0], v0[1]); w.y = cvt_pk_f16(v0[2], v0[3]); w.z = cvt_pk_f16(v1[0], v1[1]); w.w = cvt_pk_f16(v1[2], v1[3]);
                        *(u32x4*)(rowp + bj * HALF) = w; } } }
    }
};
template <class Epi, class Sched, bool ALIGN_EPI = false, bool SP2 = true>
__device__ __forceinline__ void gemm_phase(PG8_LAS unsigned char* lds, const Gemm g, const Sched& S, const Epi& E, const int wid) {
    static_assert(SP2, "only the SP2 K-loop is kept in this file");
    const int lane = lane_id(), tid = wid * 64 + lane, wr = wid >> 2, wc = wid & 3, fr = lane & 15, fq = lane >> 4;
    const int K = g.ld, nt = g.K / BK;
    unsigned voffB[2];
#pragma unroll
    for (int i = 0; i < 2; ++i) { int R, C; stage_rc(tid * 16 + i * 8192, R, C); const int Rb = Epi::PERM ? ((R & ~31) + perm32(R & 31)) : R;
        voffB[i] = (unsigned)(Rb * K + C) * 2u; }
    const size_t kstep = (size_t)(BK * 2);
    const size_t hstep = (size_t)HALF * K * 2;
    const unsigned ldsw = (unsigned)wid * 1024u;
    const int aoff = lds_byte(wr * 64 + fr, fq * 8), boff = lds_byte(wc * 32 + fr, fq * 8);
#define PG8_SA(b, h) (((b) * 2 + (h)) * HTB)
#define PG8_SB(b, h) ((4 + (b) * 2 + (h)) * HTB)
#define PG8_STAGE(bufoff, gbase, voff) do { _Pragma("unroll") for (int _i = 0; _i < 2; ++_i) \
        __builtin_amdgcn_global_load_lds((const unsigned*)((const char*)(gbase) + (voff)[_i]), (PG8_LAS unsigned*)(lds + (bufoff) + ldsw + _i * 8192), 16, 0, 0); } while (0)
#define PG8_LDA(dst, b, h) do { _Pragma("unroll") for (int m = 0; m < 4; ++m) _Pragma("unroll") for (int k = 0; k < 2; ++k) dst[m][k] = *(const PG8_LAS f16x8*)(lds + PG8_SA(b, h) + aoff + m * 2048 + k * 1024); } while (0)
#define PG8_LDB(dst, b, h) do { _Pragma("unroll") for (int n = 0; n < 2; ++n) _Pragma("unroll") for (int k = 0; k < 2; ++k) dst[n][k] = *(const PG8_LAS f16x8*)(lds + PG8_SB(b, h) + boff + n * 2048 + k * 1024); } while (0)
#define PG8_MMA(ai, bj, At, Bt) do { __builtin_amdgcn_s_setprio(1); _Pragma("unroll") for (int m = 0; m < 4; ++m) _Pragma("unroll") for (int n = 0; n < 2; ++n) _Pragma("unroll") for (int k = 0; k < 2; ++k) \
        acc[ai][bj][m][n] = __builtin_amdgcn_mfma_f32_16x16x32_f16(Bt[n][k], At[m][k], acc[ai][bj][m][n], 0, 0, 0); __builtin_amdgcn_s_setprio(0); } while (0)
#define PG8_WAIT_V(n) asm volatile("s_waitcnt vmcnt(" #n ")" ::: "memory")
#define PG8_WAIT_L(n) asm volatile("s_waitcnt lgkmcnt(" #n ")" ::: "memory")
#define PG8_BAR __builtin_amdgcn_s_barrier()
#define PG8_SCHED __builtin_amdgcn_sched_barrier(0)
    Unit cur, nxt; int ui = 0;
    if (!S.next(0, cur)) return;
    f32x4 acc[2][2][4][2];
#pragma unroll
    for (int a = 0; a < 2; ++a)
#pragma unroll
        for (int b = 0; b < 2; ++b)
#pragma unroll
            for (int m = 0; m < 4; ++m)
#pragma unroll
                for (int n = 0; n < 2; ++n) acc[a][b][m][n] = (f32x4){0.f, 0.f, 0.f, 0.f};
    f16x8 At[4][2], B0[2][2], B1[2][2];
    const char* cA = S.a_base(g, cur); const char* cB = S.b_base(g, cur);
    unsigned vaC[2][2];
    S.a_voff(g, cur, tid, vaC);
    S.a_ready(cur);
    PG8_STAGE(PG8_SB(0, 0), cB, voffB); PG8_STAGE(PG8_SB(0, 1), cB + hstep, voffB); PG8_STAGE(PG8_SA(0, 0), cA, vaC[0]); PG8_STAGE(PG8_SA(0, 1), cA, vaC[1]);
    if (wr == 1) PG8_BAR;
    PG8_WAIT_V(2); PG8_BAR;
    PG8_STAGE(PG8_SB(1, 0), cB + kstep, voffB); PG8_STAGE(PG8_SA(1, 0), cA + kstep, vaC[0]); PG8_STAGE(PG8_SB(1, 1), cB + hstep + kstep, voffB);
    PG8_WAIT_V(6); PG8_BAR;
    for (;;) {
        const bool has_next = S.next(ui + 1, nxt);
        const char* nA = has_next ? S.a_base(g, nxt) : cA; const char* nB = has_next ? S.b_base(g, nxt) : cB;
        for (int t = 0; t < nt; t += 2) {
            const bool last = (t == nt - 2);

            const char* a1 = cA + (size_t)(t + 1) * kstep;
            const char* a2 = last ? nA : cA + (size_t)(t + 2) * kstep; const char* b2 = last ? nB : cB + (size_t)(t + 2) * kstep;
            const char* a3 = a2 + kstep; const char* b3 = b2 + kstep;
            if (last && has_next) S.a_ready(nxt);
            PG8_LDB(B0, 0, 0); PG8_LDB(B1, 0, 1); PG8_SCHED; PG8_LDA(At, 0, 0); PG8_STAGE(PG8_SA(1, 1), a1, vaC[1]);
            if (last && has_next) S.a_voff(g, nxt, wid * 64 + lane_id(), vaC);
            PG8_WAIT_V(8); PG8_WAIT_L(0); PG8_BAR; PG8_MMA(0, 0, At, B0); PG8_MMA(0, 1, At, B1); PG8_BAR; PG8_SCHED;
            PG8_LDA(At, 0, 1); PG8_STAGE(PG8_SB(0, 0), b2, voffB); PG8_STAGE(PG8_SB(0, 1), b2 + hstep, voffB); PG8_STAGE(PG8_SA(0, 0), a2, vaC[0]);
            PG8_WAIT_V(8); PG8_WAIT_L(0); PG8_BAR; PG8_MMA(1, 0, At, B0); PG8_MMA(1, 1, At, B1); PG8_BAR; PG8_SCHED;
            PG8_LDB(B0, 1, 0); PG8_LDB(B1, 1, 1); PG8_SCHED; PG8_LDA(At, 1, 0); PG8_STAGE(PG8_SA(0, 1), a2, vaC[1]);
            PG8_WAIT_V(8); PG8_WAIT_L(0); PG8_BAR; PG8_MMA(0, 0, At, B0); PG8_MMA(0, 1, At, B1); PG8_BAR; PG8_SCHED;
            PG8_LDA(At, 1, 1); PG8_STAGE(PG8_SB(1, 0), b3, voffB); PG8_STAGE(PG8_SB(1, 1), b3 + hstep, voffB); PG8_STAGE(PG8_SA(1, 0), a3, vaC[0]);
            PG8_WAIT_V(8); PG8_WAIT_L(0); PG8_BAR; PG8_MMA(1, 0, At, B0); PG8_MMA(1, 1, At, B1); PG8_BAR; PG8_SCHED;
        }
        if constexpr (ALIGN_EPI) { if (wr == 0) PG8_BAR; }
        { const int l2 = lane_id(); E(acc, cur, wr, wc, l2 & 15, l2 >> 4); } S.done(cur);
        if (!has_next) break;
#pragma unroll
        for (int a = 0; a < 2; ++a)
#pragma unroll
            for (int b = 0; b < 2; ++b)
#pragma unroll
                for (int m = 0; m < 4; ++m)
#pragma unroll
                    for (int n = 0; n < 2; ++n) acc[a][b][m][n] = (f32x4){0.f, 0.f, 0.f, 0.f};
        cur = nxt; cA = nA; cB = nB; ++ui;
        if constexpr (ALIGN_EPI) { if (wr == 1) PG8_BAR; }
    }
    PG8_WAIT_V(0);
    if constexpr (!ALIGN_EPI) { if (wr == 0) PG8_BAR; }
    PG8_BAR;
#undef PG8_SA
#undef PG8_SB
#undef PG8_STAGE
#undef PG8_LDA
#undef PG8_LDB
#undef PG8_MMA
#undef PG8_WAIT_V
#undef PG8_WAIT_L
#undef PG8_BAR
#undef PG8_SCHED
}
}

constexpr int PN = 6656;
namespace att {
#define ALAS __attribute__((address_space(3)))
typedef _Float16 f16x8 __attribute__((ext_vector_type(8)));
typedef float f32x16 __attribute__((ext_vector_type(16)));
typedef short v4i16_t __attribute__((ext_vector_type(4)));
typedef unsigned u32x4 __attribute__((ext_vector_type(4)));
constexpr int SLOT = 16384, L_K = 0, L_V = 3 * SLOT, L_SCR = 6 * SLOT, L_TAB = L_SCR + 2048, L_END = L_TAB + 1024;
constexpr int L_XB = 0, L_STG = 65536;
constexpr float LOG2E = 1.4426950408889634f;
constexpr float C2 = 0.125f * LOG2E;
__device__ __forceinline__ int crow(int r, int hi) { return (r & 3) + 8 * (r >> 2) + 4 * hi; }
__device__ __forceinline__ void glds16(const void* g, ALAS unsigned char* l) { __builtin_amdgcn_global_load_lds((const unsigned*)g, (ALAS unsigned*)l, 16, 0, 0); }
__device__ __forceinline__ float xhalf(float v, int hi) { auto rr = __builtin_amdgcn_permlane32_swap(__float_as_uint(v), __float_as_uint(v), false, false); return hi ? __uint_as_float(rr[0]) : __uint_as_float(rr[1]); }
__device__ __forceinline__ unsigned pkh(float lo, float hi) { typedef _Float16 h2 __attribute__((ext_vector_type(2))); h2 v = {(_Float16)lo, (_Float16)hi}; return __builtin_bit_cast(unsigned, v); }
__device__ __forceinline__ v4i16_t vtr(const ALAS unsigned char* p) { return __builtin_amdgcn_ds_read_tr16_b64_v4i16((ALAS v4i16_t*)p); }

template <int THR>
__device__ __forceinline__ void attn_unit(ALAS unsigned char* lds, const int wave, const int b, const int h, const int qb, const unsigned short* PROJ, unsigned short* Y,
                                          const float* biasG, const float lam, const float* subln_g) {
    const int lane = pg8::lane_id(), r32 = lane & 31, hi = lane >> 5;
    const int c = wave >> 2, w4 = wave & 3;
    const int q0 = qb * 128, qw0 = q0 + 32 * w4, q = qw0 + r32;
    const size_t rowbase = (size_t)b * S;
    { ALAS float* tabL = (ALAS float*)(lds + L_TAB); const int tid = wave * 64 + lane; if (tid < 129) tabL[tid] = biasG[tid] * LOG2E; }
    f16x8 qf[4];
    { const unsigned short* Qp = PROJ + (rowbase + q) * PN + h * 128 + c * 64 + hi * 8;
#pragma unroll
      for (int d0 = 0; d0 < 4; ++d0) qf[d0] = *(const f16x8*)(Qp + d0 * 16); }
    const int krow0 = 8 * wave + (lane >> 4), krow1 = krow0 + 4;
    const unsigned short* ksrc0 = PROJ + (rowbase + krow0) * PN + 1024 + h * 128 + (((lane & 15) ^ (krow0 & 15)) * 8);
    const unsigned short* ksrc1 = PROJ + (rowbase + krow1) * PN + 1024 + h * 128 + (((lane & 15) ^ (krow1 & 15)) * 8);
    const unsigned short* vsrc0 = PROJ + (rowbase + 16 * ((2 * wave) & 3) + (lane >> 2)) * PN + 2048 + h * 128 + 32 * ((2 * wave) >> 2) + (lane & 3) * 8;
    ALAS unsigned char* kdst = lds + L_K + (2 * wave) * 1024; ALAS unsigned char* vdst = lds + L_V + (2 * wave) * 1024;
#define ATT_ISSUE(t, slot) do { const size_t go_ = (size_t)(t) * 64 * PN; \
        glds16(ksrc0 + go_, kdst + (slot) * SLOT); glds16(ksrc1 + go_, kdst + (slot) * SLOT + 1024); \
        glds16(vsrc0 + go_, vdst + (slot) * SLOT); glds16(vsrc0 + go_ + (size_t)16 * PN, vdst + (slot) * SLOT + 1024); } while (0)
    const int NT = (q0 + 128) / 64;
    ATT_ISSUE(0, 0); ATT_ISSUE(1, 1);
    ALAS float* wsf = (ALAS float*)(lds + L_SCR) + wave * 64;
    const ALAS float* tabL = (const ALAS float*)(lds + L_TAB);
    const float bfar = biasG[128] * LOG2E;
    float mhat = 0.f, l = 0.f;
    f32x16 o[4];
#pragma unroll
    for (int d = 0; d < 4; ++d)
#pragma unroll
        for (int r = 0; r < 16; ++r) o[d][r] = 0.f;
    f32x16 negm;
#pragma unroll
    for (int r = 0; r < 16; ++r) negm[r] = bfar;
    int slot = 0;
    for (int t = 0; t < NT; ++t) {
        if (t + 1 < NT) asm volatile("s_waitcnt vmcnt(4)" ::: "memory"); else asm volatile("s_waitcnt vmcnt(0)" ::: "memory");
        __builtin_amdgcn_s_barrier();
        asm volatile("" ::: "memory");
        if (t + 2 < NT) { const int s2 = slot == 0 ? 2 : slot - 1; ATT_ISSUE(t + 2, s2); }
        const int k0 = t * 64;
        if (k0 <= qw0 + 31) {
            const ALAS unsigned char* Ks = lds + L_K + slot * SLOT + r32 * 256;
            const int kx = r32 & 15, kc0 = 8 * c + hi;
            const int ko[4] = {((kc0 + 0) ^ kx) << 4, ((kc0 + 2) ^ kx) << 4, ((kc0 + 4) ^ kx) << 4, ((kc0 + 6) ^ kx) << 4};
            const ALAS unsigned char* Vs = lds + L_V + slot * SLOT + (4 * hi + ((lane & 15) >> 2)) * 64 + ((lane >> 4) & 1) * 32 + (lane & 3) * 8;
            f32x16 p0, p1;
            const bool nearb = (k0 + 63 + 128 > qw0);
            if (nearb) {
                f32x16 c0, c1;
#pragma unroll
                for (int r = 0; r < 16; ++r) { int rel = q - (k0 + crow(r, hi)); int i0 = rel < 0 ? 0 : (rel > 128 ? 128 : rel); int rel1 = rel - 32; int i1 = rel1 < 0 ? 0 : (rel1 > 128 ? 128 : rel1);
                    c0[r] = tabL[i0] - mhat; c1[r] = tabL[i1] - mhat; }
#pragma unroll
                for (int d0 = 0; d0 < 4; ++d0) { const f16x8 a0 = *(const ALAS f16x8*)(Ks + ko[d0]), a1 = *(const ALAS f16x8*)(Ks + ko[d0] + 8192);
                    p0 = __builtin_amdgcn_mfma_f32_32x32x16_f16(a0, qf[d0], d0 == 0 ? c0 : p0, 0, 0, 0); p1 = __builtin_amdgcn_mfma_f32_32x32x16_f16(a1, qf[d0], d0 == 0 ? c1 : p1, 0, 0, 0); }
                if (k0 + 63 > qw0) {
#pragma unroll
                    for (int r = 0; r < 16; ++r) { const int kv = k0 + crow(r, hi); if (kv > q) p0[r] = -INFINITY; if (kv + 32 > q) p1[r] = -INFINITY; }
                }
            } else {
#pragma unroll
                for (int d0 = 0; d0 < 4; ++d0) { const f16x8 a0 = *(const ALAS f16x8*)(Ks + ko[d0]), a1 = *(const ALAS f16x8*)(Ks + ko[d0] + 8192);
                    p0 = __builtin_amdgcn_mfma_f32_32x32x16_f16(a0, qf[d0], d0 == 0 ? negm : p0, 0, 0, 0); p1 = __builtin_amdgcn_mfma_f32_32x32x16_f16(a1, qf[d0], d0 == 0 ? negm : p1, 0, 0, 0); }
            }
            float rm = fmaxf(p0[0], p1[0]);
#pragma unroll
            for (int r = 1; r < 16; ++r) rm = fmaxf(rm, fmaxf(p0[r], p1[r]));
            rm = fmaxf(rm, xhalf(rm, hi));
            const bool first = (t == 0);
            if (first || __any(rm > (float)THR)) {
                const float dl = first ? rm : fmaxf(rm, 0.f);
                mhat += dl;
#pragma unroll
                for (int r = 0; r < 16; ++r) { p0[r] -= dl; p1[r] -= dl; }
#pragma unroll
                for (int r = 0; r < 16; ++r) negm[r] = bfar - mhat;
                if (!first) {
                    const float f = __builtin_amdgcn_exp2f(-dl); l *= f;
                    if (hi == 0) wsf[r32] = f;
                    asm volatile("s_waitcnt lgkmcnt(0)" ::: "memory");
#pragma unroll
                    for (int r = 0; r < 16; ++r) { const float fr_ = wsf[crow(r, hi)];
#pragma unroll
                        for (int d = 0; d < 4; ++d) o[d][r] *= fr_; }
                }
            }
            float sacc = 0.f;
#pragma unroll
            for (int r = 0; r < 16; ++r) { p0[r] = __builtin_amdgcn_exp2f(p0[r]); p1[r] = __builtin_amdgcn_exp2f(p1[r]); sacc += p0[r] + p1[r]; }
            l += sacc;
            u32x4 pw[4];
#pragma unroll
            for (int s = 0; s < 2; ++s) {
                pw[s] = (u32x4){pkh(p0[8 * s], p0[8 * s + 1]), pkh(p0[8 * s + 2], p0[8 * s + 3]), pkh(p0[8 * s + 4], p0[8 * s + 5]), pkh(p0[8 * s + 6], p0[8 * s + 7])};
                pw[2 + s] = (u32x4){pkh(p1[8 * s], p1[8 * s + 1]), pkh(p1[8 * s + 2], p1[8 * s + 3]), pkh(p1[8 * s + 4], p1[8 * s + 5]), pkh(p1[8 * s + 6], p1[8 * s + 7])};
            }
#pragma unroll
            for (int d = 0; d < 4; ++d) {
#pragma unroll
                for (int s = 0; s < 4; ++s) {
                    const v4i16_t lo = vtr(Vs + (d * 4 + s) * 1024), hi4 = vtr(Vs + (d * 4 + s) * 1024 + 512);
                    typedef short s16x8 __attribute__((ext_vector_type(8)));
                    const s16x8 bv = {lo[0], lo[1], lo[2], lo[3], hi4[0], hi4[1], hi4[2], hi4[3]};
                    o[d] = __builtin_amdgcn_mfma_f32_32x32x16_f16(__builtin_bit_cast(f16x8, pw[s]), __builtin_bit_cast(f16x8, bv), o[d], 0, 0, 0);
                }
            }
        }
        slot = slot == 2 ? 0 : slot + 1;
    }
#undef ATT_ISSUE
    l += xhalf(l, hi);
    if (hi == 0) wsf[r32] = 1.0f / l;
    asm volatile("s_waitcnt lgkmcnt(0)" ::: "memory");
#pragma unroll
    for (int r = 0; r < 16; ++r) { const float f = wsf[crow(r, hi)];
#pragma unroll
        for (int d = 0; d < 4; ++d) o[d][r] *= f; }
    asm volatile("s_waitcnt lgkmcnt(0)" ::: "memory"); __builtin_amdgcn_s_barrier(); asm volatile("" ::: "memory");
    ALAS float* xb = (ALAS float*)(lds + L_XB) + w4 * 4096 + lane;
    if (c == 1) {
#pragma unroll
        for (int d = 0; d < 4; ++d)
#pragma unroll
            for (int r = 0; r < 16; ++r) xb[(d * 16 + r) * 64] = o[d][r];
    }
    asm volatile("s_waitcnt lgkmcnt(0)" ::: "memory"); __builtin_amdgcn_s_barrier(); asm volatile("" ::: "memory");
    if (c == 0) {
        float sc[16];
#pragma unroll
        for (int r = 0; r < 16; ++r) { float ss = 0.f;
#pragma unroll
            for (int d = 0; d < 4; ++d) { o[d][r] -= lam * xb[(d * 16 + r) * 64]; ss += o[d][r] * o[d][r]; }
            ss += __shfl_xor(ss, 1); ss += __shfl_xor(ss, 2); ss += __shfl_xor(ss, 4); ss += __shfl_xor(ss, 8); ss += __shfl_xor(ss, 16);
            sc[r] = __builtin_amdgcn_rsqf(ss * (1.f / 128.f) + LN_EPS) * (1.f - LAMBDA_INIT); }
        ALAS _Float16* stg = (ALAS _Float16*)(lds + L_STG + w4 * 8192);
#pragma unroll
        for (int d = 0; d < 4; ++d) { const float gg = subln_g[32 * d + r32];
#pragma unroll
            for (int r = 0; r < 16; ++r) stg[crow(r, hi) * 128 + 32 * d + r32] = (_Float16)(o[d][r] * sc[r] * gg); }
        asm volatile("s_waitcnt lgkmcnt(0)" ::: "memory");
        unsigned short* Yw = Y + (rowbase + qw0) * D + h * 128;
#pragma unroll
        for (int i = 0; i < 8; ++i) { const int row = i * 4 + (lane >> 4), ch = lane & 15; const u32x4 v = *(const ALAS u32x4*)((const ALAS unsigned char*)stg + row * 256 + ch * 16);
            *(u32x4*)(Yw + (size_t)row * D + ch * 8) = v; }
    }
    asm volatile("s_waitcnt lgkmcnt(0)" ::: "memory"); __builtin_amdgcn_s_barrier(); asm volatile("" ::: "memory");
}
#undef ALAS
}

namespace rk {
#define RLAS __attribute__((address_space(3)))
#define RGAS __attribute__((address_space(1)))
typedef __bf16 bf16x8 __attribute__((ext_vector_type(8)));
typedef _Float16 f16x8 __attribute__((ext_vector_type(8)));
typedef float f32x16 __attribute__((ext_vector_type(16)));
typedef float f32x4 __attribute__((ext_vector_type(4)));
typedef unsigned u32x4 __attribute__((ext_vector_type(4)));
typedef unsigned short us8 __attribute__((ext_vector_type(8)));
constexpr int C = 32;
constexpr int TS = 144, CS = 80;
constexpr int O_AT = 0, O_RT = 4608, O_BT = 9216, O_KT = 13824;
constexpr int O_AAB = 0, O_AAK = 4608, O_ARB = 7168, O_ARK = 9728;
constexpr int O_PIMG = 0, O_QIMG = 8192;
constexpr int O_VT = 18432, O_KH = 23552, O_BH = 28672;
constexpr int O_X0 = 33792;
constexpr int O_RH = 50688;
constexpr int O_GAM = 55296;
constexpr int HALF_BYTES = 57344;
constexpr int CHK_BYTES = 24576, CK_P = 0, CK_Q = 8192, CK_G = 12288, CK_Y = 20480;
__device__ __forceinline__ int crow(int r, int hi) { return (r & 3) + 8 * (r >> 2) + 4 * hi; }
__device__ __forceinline__ unsigned pkb(float lo, float hi) { typedef float f2 __attribute__((ext_vector_type(2))); typedef __bf16 b2 __attribute__((ext_vector_type(2))); f2 v = {lo, hi}; b2 w = __builtin_convertvector(v, b2); return __builtin_bit_cast(unsigned, w); }
__device__ __forceinline__ unsigned pkh(float lo, float hi) { typedef _Float16 h2 __attribute__((ext_vector_type(2))); h2 v = {(_Float16)lo, (_Float16)hi}; return __builtin_bit_cast(unsigned, v); }
__device__ __forceinline__ float h2f(unsigned short u) { return (float)__builtin_bit_cast(_Float16, u); }
__device__ __forceinline__ unsigned short f2h(float f) { return __builtin_bit_cast(unsigned short, (_Float16)f); }
__device__ __forceinline__ float sum8(float x) {
    x += __builtin_bit_cast(float, __builtin_amdgcn_update_dpp(0, __builtin_bit_cast(int, x), 0xB1, 0xF, 0xF, true));
    x += __builtin_bit_cast(float, __builtin_amdgcn_update_dpp(0, __builtin_bit_cast(int, x), 0x4E, 0xF, 0xF, true));
    x += __builtin_bit_cast(float, __builtin_amdgcn_update_dpp(0, __builtin_bit_cast(int, x), 0x141, 0xF, 0xF, true));
    return x;
}
__device__ __forceinline__ int frag_pos(int m, int c) { return (((c >> 4) * 64 + m + 32 * ((c >> 2) & 1)) * 8) + ((c >> 3) & 1) * 4 + (c & 3); }

struct ChunkIn { f32x4 l0, l1; us8 a8, b8, k8, rc, rp, vc, vp; };
__device__ __forceinline__ void chunk_load(ChunkIn& in, int tglob, int pos, int chb, const unsigned char* ws) {
    const unsigned short* PROJ16 = (const unsigned short*)(ws + WS_PROJ16); const float* LW = (const float*)(ws + WS_DECAY); const unsigned short* KMOD = (const unsigned short*)(ws + WS_KMOD);
    const unsigned short* A16 = (const unsigned short*)(ws + WS_A16); const unsigned short* B16 = (const unsigned short*)(ws + WS_B16);
    in.l0 = *(const RGAS f32x4*)(LW + (size_t)tglob * RWK + chb); in.l1 = *(const RGAS f32x4*)(LW + (size_t)tglob * RWK + chb + 4);
    in.a8 = *(const RGAS us8*)(A16 + (size_t)tglob * RWK + chb); in.b8 = *(const RGAS us8*)(B16 + (size_t)tglob * RWK + chb); in.k8 = *(const RGAS us8*)(KMOD + (size_t)tglob * RWK + chb);
    const unsigned short* cur = PROJ16 + (size_t)tglob * PN + 3072 + chb;
    in.rc = *(const RGAS us8*)cur; in.vc = *(const RGAS us8*)(cur + 2048); in.rp = in.rc; in.vp = in.vc; if (pos > 0) { in.rp = *(const RGAS us8*)(cur - PN); in.vp = *(const RGAS us8*)(cur - PN + 2048); }
}
__device__ __forceinline__ void chunk_pair(RLAS unsigned char* lds, const int wave, const int tile, const int hA, ChunkIn& in, const bool has_next, const float* mu, const float* r_k, unsigned char* ws) {
    unsigned char* CHK = ws + WS_CHK; float* BONUS = (float*)(ws + WS_BONUS);
    const int lane = pg8::lane_id(), hf = wave >> 2, q = wave & 3, r32 = lane & 31, hi = lane >> 5;
    const int h = hA + hf;
    RLAS unsigned char* L = lds + hf * HALF_BYTES;
    const int t = q * 64 + lane;
    const int tok = t >> 3, c8 = (t & 7) * 8;
    const int tglob = tile * C + tok, pos = tglob & (S - 1), bidx = tglob >> 11;
    const int chb = h * 64 + c8;
    float lw[8], av[8], bv[8], kv[8], rv[8], vv[8];
    { lw[0] = in.l0.x; lw[1] = in.l0.y; lw[2] = in.l0.z; lw[3] = in.l0.w; lw[4] = in.l1.x; lw[5] = in.l1.y; lw[6] = in.l1.z; lw[7] = in.l1.w;
      const f32x4 m0 = *(const RGAS f32x4*)(mu + chb), m1 = *(const RGAS f32x4*)(mu + chb + 4), n0 = *(const RGAS f32x4*)(mu + 2048 + chb), n1 = *(const RGAS f32x4*)(mu + 2048 + chb + 4);
      const float mr[8] = {m0.x, m0.y, m0.z, m0.w, m1.x, m1.y, m1.z, m1.w}, mv[8] = {n0.x, n0.y, n0.z, n0.w, n1.x, n1.y, n1.z, n1.w};
#pragma unroll
      for (int i = 0; i < 8; ++i) { av[i] = h2f(in.a8[i]); bv[i] = h2f(in.b8[i]); kv[i] = h2f(in.k8[i]);
          const float rcf = h2f(in.rc[i]), rpf = pos > 0 ? h2f(in.rp[i]) : 0.f, vcf = h2f(in.vc[i]), vpf = pos > 0 ? h2f(in.vp[i]) : 0.f;
          rv[i] = rcf + (rpf - rcf) * mr[i]; vv[i] = vcf + (vpf - vcf) * mv[i]; } }
    { const f32x4 k0 = *(const RGAS f32x4*)(r_k + chb), k1 = *(const RGAS f32x4*)(r_k + chb + 4); const float rk8[8] = {k0.x, k0.y, k0.z, k0.w, k1.x, k1.y, k1.z, k1.w};
      float bs = 0.f;
#pragma unroll
      for (int i = 0; i < 8; ++i) bs += rv[i] * kv[i] * rk8[i];
      bs = sum8(bs); if ((t & 7) == 0) BONUS[(size_t)tglob * 16 + h] = bs; }
    RLAS float* lwL = (RLAS float*)(L + O_X0 + 64 * 132);
    __syncthreads();
#pragma unroll
    for (int i = 0; i < 8; ++i) lwL[tok * 65 + c8 + i] = lw[i];
    __syncthreads();
    { RLAS float* part = (RLAS float*)(L + O_GAM) + 64;
      const int ch = t & 63, seg = t >> 6; float sg = 0.f;
#pragma unroll
      for (int k = 0; k < 8; ++k) sg += lwL[(8 * seg + k) * 65 + ch];
      part[seg * 64 + ch] = sg;
      __syncthreads();
      float g = 0.f;
#pragma unroll
      for (int s2 = 0; s2 < 3; ++s2) if (s2 < seg) g += part[s2 * 64 + ch];
#pragma unroll
      for (int k = 0; k < 8; ++k) { g += lwL[(8 * seg + k) * 65 + ch]; lwL[(8 * seg + k) * 65 + ch] = g; } }
    __syncthreads();
    {
        float G[8], GL[8];
#pragma unroll
        for (int i = 0; i < 8; ++i) { G[i] = lwL[tok * 65 + c8 + i]; GL[i] = lwL[31 * 65 + c8 + i]; }
        float at[8], rt[8], bt[8], kt[8], bh[8], kh[8];
#pragma unroll
        for (int i = 0; i < 8; ++i) { const float eg = __expf(G[i]), eng = __expf(-G[i]), egm = __expf(G[i] - lw[i]), egl = __expf(GL[i] - G[i]);
            at[i] = av[i] * egm; rt[i] = rv[i] * eg; bt[i] = bv[i] * eng; kt[i] = kv[i] * eng; bh[i] = bv[i] * egl; kh[i] = kv[i] * egl; }
        *(RLAS u32x4*)(L + O_AT + tok * TS + c8 * 2) = (u32x4){pkb(at[0], at[1]), pkb(at[2], at[3]), pkb(at[4], at[5]), pkb(at[6], at[7])};
        *(RLAS u32x4*)(L + O_RT + tok * TS + c8 * 2) = (u32x4){pkb(rt[0], rt[1]), pkb(rt[2], rt[3]), pkb(rt[4], rt[5]), pkb(rt[6], rt[7])};
        *(RLAS u32x4*)(L + O_BT + tok * TS + c8 * 2) = (u32x4){pkb(bt[0], bt[1]), pkb(bt[2], bt[3]), pkb(bt[4], bt[5]), pkb(bt[6], bt[7])};
        *(RLAS u32x4*)(L + O_KT + tok * TS + c8 * 2) = (u32x4){pkb(kt[0], kt[1]), pkb(kt[2], kt[3]), pkb(kt[4], kt[5]), pkb(kt[6], kt[7])};
        *(RLAS u32x4*)(L + O_RH + tok * TS + c8 * 2) = (u32x4){pkh(rt[0], rt[1]), pkh(rt[2], rt[3]), pkh(rt[4], rt[5]), pkh(rt[6], rt[7])};
#pragma unroll
        for (int i = 0; i < 8; ++i) { const int ch = c8 + i;
            *(RLAS unsigned short*)(L + O_VT + ch * CS + tok * 2) = f2h(vv[i]); *(RLAS unsigned short*)(L + O_KH + ch * CS + tok * 2) = f2h(kh[i]); *(RLAS unsigned short*)(L + O_BH + ch * CS + tok * 2) = f2h(bh[i]);
            ((RLAS float*)(L + O_X0))[ch * 33 + tok] = at[i];
            if (tok == C - 1) ((RLAS float*)(L + O_GAM))[ch] = __expf(GL[i]); }
    }
    __syncthreads();
    {
        const RLAS unsigned char* Lp = L + (q < 2 ? O_AT : O_RT) + r32 * TS + hi * 16; const RLAS unsigned char* Rp = L + ((q & 1) ? O_KT : O_BT) + r32 * TS + hi * 16;
        f32x16 acc;
#pragma unroll
        for (int r = 0; r < 16; ++r) acc[r] = 0.f;
#pragma unroll
        for (int ks = 0; ks < 4; ++ks) acc = __builtin_amdgcn_mfma_f32_32x32x16_bf16(*(const RLAS bf16x8*)(Lp + ks * 32), *(const RLAS bf16x8*)(Rp + ks * 32), acc, 0, 0, 0);
#pragma unroll
        for (int r = 0; r < 16; ++r) { const int tau = crow(r, hi); const bool keep = (q < 2) ? (r32 < tau) : (r32 <= tau); acc[r] = keep ? acc[r] : 0.f; }
        __syncthreads();
        if (q == 0) {
#pragma unroll
            for (int r = 0; r < 16; ++r) ((RLAS float*)(L + O_AAB))[r32 * 36 + crow(r, hi)] = acc[r];
        } else {
            RLAS unsigned char* o = L + (q == 1 ? O_AAK : (q == 2 ? O_ARB : O_ARK));
#pragma unroll
            for (int r = 0; r < 16; ++r) *(RLAS unsigned short*)(o + crow(r, hi) * CS + r32 * 2) = f2h(acc[r]);
        }
    }
    __syncthreads();
    const int J = q & 1, part = q >> 1;
    if (part == 1) {
        f32x16 accX;
#pragma unroll
        for (int r = 0; r < 16; ++r) accX[r] = 0.f;
        const RLAS unsigned char* Vp = L + O_VT + (32 * J + r32) * CS + hi * 16; const RLAS unsigned char* Ap = L + O_AAK + r32 * CS + hi * 16;
#pragma unroll
        for (int ks = 0; ks < 2; ++ks) accX = __builtin_amdgcn_mfma_f32_32x32x16_f16(*(const RLAS f16x8*)(Ap + ks * 32), *(const RLAS f16x8*)(Vp + ks * 32), accX, 0, 0, 0);
#pragma unroll
        for (int r = 0; r < 16; ++r) ((RLAS float*)(L + O_X0))[(64 + 32 * J + r32) * 33 + crow(r, hi)] = accX[r];
    }
    __syncthreads();
    float z[C];
    if (q < 2) {
        const RLAS float* xc = (const RLAS float*)(L + O_X0) + (64 * q + lane) * 33;
#pragma unroll
        for (int k = 0; k < C; ++k) z[k] = xc[k];
    }
    __syncthreads();
    if (q < 2) {
        const RLAS float* AabT = (const RLAS float*)(L + O_AAB);
#pragma unroll
        for (int sx = 0; sx < C - 1; ++sx) {
            const float zs = z[sx];
#pragma unroll
            for (int t4 = (sx + 1) / 4; t4 < C / 4; ++t4) { const f32x4 aa = *(const RLAS f32x4*)(AabT + sx * 36 + 4 * t4);
                if (4 * t4 + 0 > sx) z[4 * t4 + 0] = fmaf(aa.x, zs, z[4 * t4 + 0]); if (4 * t4 + 1 > sx) z[4 * t4 + 1] = fmaf(aa.y, zs, z[4 * t4 + 1]);
                if (4 * t4 + 2 > sx) z[4 * t4 + 2] = fmaf(aa.z, zs, z[4 * t4 + 2]); if (4 * t4 + 3 > sx) z[4 * t4 + 3] = fmaf(aa.w, zs, z[4 * t4 + 3]); }
        }
        RLAS unsigned char* zr = L + O_X0 + (64 * q + lane) * CS;
#pragma unroll
        for (int k8 = 0; k8 < 4; ++k8) *(RLAS u32x4*)(zr + k8 * 16) = (u32x4){pkh(z[8 * k8], z[8 * k8 + 1]), pkh(z[8 * k8 + 2], z[8 * k8 + 3]), pkh(z[8 * k8 + 4], z[8 * k8 + 5]), pkh(z[8 * k8 + 6], z[8 * k8 + 7])};
    }
    __syncthreads();
    f32x16 accQ, accP, accA, accB;
#pragma unroll
    for (int r = 0; r < 16; ++r) { accA[r] = 0.f; accB[r] = 0.f; }
    {
        const RLAS unsigned char* Vp = L + O_VT + (32 * J + r32) * CS + hi * 16;
        const RLAS unsigned char* Kp = L + O_KH + (32 * part + r32) * CS + hi * 16;
        const RLAS unsigned char* Ap = L + O_ARK + r32 * CS + hi * 16;
#pragma unroll
        for (int ks = 0; ks < 2; ++ks) { const f16x8 vf = *(const RLAS f16x8*)(Vp + ks * 32);
            if (part == 0) accA = __builtin_amdgcn_mfma_f32_32x32x16_f16(*(const RLAS f16x8*)(Ap + ks * 32), vf, accA, 0, 0, 0);
            accB = __builtin_amdgcn_mfma_f32_32x32x16_f16(*(const RLAS f16x8*)(Kp + ks * 32), vf, accB, 0, 0, 0); }
    }
    {
        const RLAS float* gam = (const RLAS float*)(L + O_GAM);
#pragma unroll
        for (int r = 0; r < 16; ++r) { const int m = crow(r, hi);
            accQ[r] = h2f(*(const RLAS unsigned short*)(L + O_RH + m * TS + (32 * J + r32) * 2));
            accP[r] = (J == part && m == r32) ? gam[32 * J + r32] : 0.f; }
        const RLAS unsigned char* Zw = L + O_X0 + (32 * J + r32) * CS + hi * 16; const RLAS unsigned char* Zu = Zw + 64 * CS;
        const RLAS unsigned char* Bp = L + O_BH + (32 * part + r32) * CS + hi * 16; const RLAS unsigned char* Rb = L + O_ARB + r32 * CS + hi * 16;
#pragma unroll
        for (int ks = 0; ks < 2; ++ks) { const f16x8 zw = *(const RLAS f16x8*)(Zw + ks * 32), zu = *(const RLAS f16x8*)(Zu + ks * 32), bf = *(const RLAS f16x8*)(Bp + ks * 32);
            accP = __builtin_amdgcn_mfma_f32_32x32x16_f16(bf, zw, accP, 0, 0, 0);
            accB = __builtin_amdgcn_mfma_f32_32x32x16_f16(bf, zu, accB, 0, 0, 0);
            if (part == 0) { const f16x8 rb = *(const RLAS f16x8*)(Rb + ks * 32);
                accQ = __builtin_amdgcn_mfma_f32_32x32x16_f16(rb, zw, accQ, 0, 0, 0);
                accA = __builtin_amdgcn_mfma_f32_32x32x16_f16(rb, zu, accA, 0, 0, 0); } }
    }
    __syncthreads();
    { int tg2 = tglob, cb2 = has_next ? chb + 128 : chb; asm volatile("" : "+v"(tg2), "+v"(cb2)); chunk_load(in, tg2, pos, cb2, ws); }
    unsigned char* rec = CHK + ((size_t)((bidx * 16 + h) * (S / C)) + (size_t)(pos >> 5)) * CHK_BYTES;
    { u32x4 w0, w1; w0 = (u32x4){pkh(accB[0], accB[1]), pkh(accB[2], accB[3]), pkh(accB[4], accB[5]), pkh(accB[6], accB[7])}; w1 = (u32x4){pkh(accB[8], accB[9]), pkh(accB[10], accB[11]), pkh(accB[12], accB[13]), pkh(accB[14], accB[15])};
      RGAS u32x4* g = (RGAS u32x4*)(rec + CK_G + ((part * 2 + J) * 64 + lane) * 32); g[0] = w0; g[1] = w1;
      if (part == 0) { w0 = (u32x4){pkh(accA[0], accA[1]), pkh(accA[2], accA[3]), pkh(accA[4], accA[5]), pkh(accA[6], accA[7])}; w1 = (u32x4){pkh(accA[8], accA[9]), pkh(accA[10], accA[11]), pkh(accA[12], accA[13]), pkh(accA[14], accA[15])};
          RGAS u32x4* y = (RGAS u32x4*)(rec + CK_Y + (J * 64 + lane) * 32); y[0] = w0; y[1] = w1; } }
    {
        RLAS unsigned short* pimg = (RLAS unsigned short*)(L + O_PIMG) + ((part * 2 + J) * 2) * 512;
        RLAS unsigned short* qimg = (RLAS unsigned short*)(L + O_QIMG) + (J * 2) * 512;
#pragma unroll
        for (int r = 0; r < 16; ++r) { const int fp = frag_pos(crow(r, hi), r32); pimg[fp] = f2h(accP[r]); if (part == 0) qimg[fp] = f2h(accQ[r]); }
    }
    __syncthreads();
    { const RLAS u32x4* src = (const RLAS u32x4*)(L + O_PIMG); RGAS u32x4* dst = (RGAS u32x4*)(rec + CK_P);
#pragma unroll
      for (int i = 0; i < 3; ++i) dst[i * 256 + t] = src[i * 256 + t]; }
}

__device__ __forceinline__ void scan_unit(RLAS unsigned char* lds, const int wave, const int bh, const unsigned char* CHK, const float* BONUS, const unsigned short* PROJ16, const float* mu,
                                          const unsigned short* G16, const float* lnx_g, const float* lnx_b, unsigned short* Y16) {
    const int lane = pg8::lane_id(), r32 = lane & 31, hi = lane >> 5;
    const int b = bh >> 4, h = bh & 15;
    RLAS float* ytile = (RLAS float*)lds;
    constexpr int RING0 = 18432, NSL = 4;
    const unsigned char* rec0 = CHK + (size_t)bh * (S / C) * CHK_BYTES;
    constexpr int NCH = S / C;
    __syncthreads();
    if (wave >= 6) {
        const int p0 = (wave - 6) * 12;
#define RK_DMA(c) do { const unsigned char* src_ = rec0 + (size_t)(c) * CHK_BYTES + p0 * 1024 + lane * 16; RLAS unsigned char* dst_ = lds + RING0 + ((c) & (NSL - 1)) * CHK_BYTES + p0 * 1024; \
            _Pragma("unroll") for (int j_ = 0; j_ < 12; ++j_) __builtin_amdgcn_global_load_lds((const unsigned*)(src_ + j_ * 1024), (RLAS unsigned*)(dst_ + j_ * 1024), 16, 0, 0); } while (0)
        RK_DMA(0); RK_DMA(1); RK_DMA(2);
        for (int c = 0; c <= NCH; ++c) {
            if (c + 2 < NCH) asm volatile("s_waitcnt vmcnt(24)" ::: "memory"); else if (c + 1 < NCH) asm volatile("s_waitcnt vmcnt(12)" ::: "memory"); else asm volatile("s_waitcnt vmcnt(0)" ::: "memory");
            __builtin_amdgcn_s_barrier(); asm volatile("" ::: "memory");
            if (c + 3 < NCH) RK_DMA(c + 3);
        }
#undef RK_DMA
    } else if (wave < 2) {
        const int J = wave;
        f32x16 H0, H1;
#pragma unroll
        for (int r = 0; r < 16; ++r) { H0[r] = 0.f; H1[r] = 0.f; }
        for (int c = 0; c <= NCH; ++c) {
            asm volatile("s_waitcnt lgkmcnt(0)" ::: "memory"); __builtin_amdgcn_s_barrier(); asm volatile("" ::: "memory");
            if (c == NCH) break;
            const RLAS unsigned char* rec = lds + RING0 + (c & (NSL - 1)) * CHK_BYTES;
            u32x4 hb[4];
            hb[0] = (u32x4){pkh(H0[0], H0[1]), pkh(H0[2], H0[3]), pkh(H0[4], H0[5]), pkh(H0[6], H0[7])}; hb[1] = (u32x4){pkh(H0[8], H0[9]), pkh(H0[10], H0[11]), pkh(H0[12], H0[13]), pkh(H0[14], H0[15])};
            hb[2] = (u32x4){pkh(H1[0], H1[1]), pkh(H1[2], H1[3]), pkh(H1[4], H1[5]), pkh(H1[6], H1[7])}; hb[3] = (u32x4){pkh(H1[8], H1[9]), pkh(H1[10], H1[11]), pkh(H1[12], H1[13]), pkh(H1[14], H1[15])};
            f32x16 y, n0, n1;
#define RK_UNPK(dst, w0, w1) do { const f16x8 a_ = __builtin_bit_cast(f16x8, w0), b_ = __builtin_bit_cast(f16x8, w1); \
            _Pragma("unroll") for (int i_ = 0; i_ < 8; ++i_) { dst[i_] = (float)a_[i_]; dst[8 + i_] = (float)b_[i_]; } } while (0)
            { const u32x4 y0 = *(const RLAS u32x4*)(rec + CK_Y + (J * 64 + lane) * 32), y1 = *(const RLAS u32x4*)(rec + CK_Y + (J * 64 + lane) * 32 + 16); RK_UNPK(y, y0, y1);
              const u32x4 g0 = *(const RLAS u32x4*)(rec + CK_G + (J * 64 + lane) * 32), g1 = *(const RLAS u32x4*)(rec + CK_G + (J * 64 + lane) * 32 + 16); RK_UNPK(n0, g0, g1);
              const u32x4 g2 = *(const RLAS u32x4*)(rec + CK_G + ((2 + J) * 64 + lane) * 32), g3 = *(const RLAS u32x4*)(rec + CK_G + ((2 + J) * 64 + lane) * 32 + 16); RK_UNPK(n1, g2, g3); }
#pragma unroll
            for (int ks = 0; ks < 4; ++ks) {
                const f16x8 hf = __builtin_bit_cast(f16x8, hb[ks]);
                y = __builtin_amdgcn_mfma_f32_32x32x16_f16(*(const RLAS f16x8*)(rec + CK_Q + (ks * 64 + lane) * 16), hf, y, 0, 0, 0);
                n0 = __builtin_amdgcn_mfma_f32_32x32x16_f16(*(const RLAS f16x8*)(rec + CK_P + (ks * 64 + lane) * 16), hf, n0, 0, 0, 0);
                n1 = __builtin_amdgcn_mfma_f32_32x32x16_f16(*(const RLAS f16x8*)(rec + CK_P + ((4 + ks) * 64 + lane) * 16), hf, n1, 0, 0, 0);
            }
#undef RK_UNPK
            H0 = n0; H1 = n1;
            RLAS float* yt = ytile + (c & 1) * (32 * 68);
#pragma unroll
            for (int r = 0; r < 16; ++r) yt[crow(r, hi) * 68 + 32 * J + r32] = y[r];
        }
    } else {
        const int p = wave - 2, v8 = (lane & 7) * 8, trow = 8 * p + (lane >> 3);
        float lg[8], lb[8], mv[8];
#pragma unroll
        for (int i = 0; i < 8; ++i) { lg[i] = lnx_g[h * 64 + v8 + i]; lb[i] = lnx_b[h * 64 + v8 + i]; mv[i] = mu[2048 + h * 64 + v8 + i]; }
        struct PSlot { float bon; us8 vc, vp, g8; };
        PSlot ps[4];
#define RK_PLOAD(SL, cc_) do { const int pos_ = (cc_) * C + trow; const size_t tok_ = (size_t)b * S + pos_; ps[SL].bon = BONUS[tok_ * 16 + h]; \
            const unsigned short* cur_ = PROJ16 + tok_ * PN + 5120 + h * 64 + v8; ps[SL].vc = *(const RGAS us8*)cur_; ps[SL].vp = ps[SL].vc; if (pos_ > 0) ps[SL].vp = *(const RGAS us8*)(cur_ - PN); \
            ps[SL].g8 = *(const RGAS us8*)(G16 + tok_ * RWK + h * 64 + v8); } while (0)
#define RK_PSTEP(SL, cc_) do { \
            asm volatile("s_waitcnt lgkmcnt(0)" ::: "memory"); __builtin_amdgcn_s_barrier(); asm volatile("" ::: "memory"); \
            if ((cc_) >= 0) { const int cc = (cc_); \
                const float bon = ps[SL].bon; const us8 vc = ps[SL].vc, vp = ps[SL].vp, g8 = ps[SL].g8; \
                if (cc + 4 < NCH) RK_PLOAD(SL, cc + 4); \
                const RLAS float* yt = ytile + (cc & 1) * (32 * 68) + trow * 68 + v8; \
                const f32x4 ya = *(const RLAS f32x4*)yt, yb = *(const RLAS f32x4*)(yt + 4); \
                float yv[8] = {ya.x, ya.y, ya.z, ya.w, yb.x, yb.y, yb.z, yb.w}; \
                float sm = 0.f; \
                _Pragma("unroll") for (int i = 0; i < 8; ++i) sm += yv[i]; \
                const float mean = sum8(sm) * (1.f / 64.f); float sq = 0.f; \
                _Pragma("unroll") for (int i = 0; i < 8; ++i) { yv[i] -= mean; sq += yv[i] * yv[i]; } \
                const float rstd = __builtin_amdgcn_rsqf(sum8(sq) * (1.f / 64.f) + 64e-5f); \
                const int pos = cc * C + trow; const size_t tok = (size_t)b * S + pos; \
                float o[8]; \
                _Pragma("unroll") for (int i = 0; i < 8; ++i) { const float vcf = h2f(vc[i]), vpf = pos > 0 ? h2f(vp[i]) : 0.f; const float vx = vcf + (vpf - vcf) * mv[i]; \
                    o[i] = (yv[i] * rstd * lg[i] + lb[i] + bon * vx) * h2f(g8[i]); } \
                *(RGAS u32x4*)(Y16 + tok * D + 1024 + h * 64 + v8) = (u32x4){pkh(o[0], o[1]), pkh(o[2], o[3]), pkh(o[4], o[5]), pkh(o[6], o[7])}; } } while (0)
        RK_PLOAD(0, 0); RK_PLOAD(1, 1); RK_PLOAD(2, 2); RK_PLOAD(3, 3);
        for (int cb = 0; cb < NCH; cb += 4) {
            RK_PSTEP(3, cb - 1); RK_PSTEP(0, cb); RK_PSTEP(1, cb + 1); RK_PSTEP(2, cb + 2);
        }
        RK_PSTEP(3, NCH - 1);
#undef RK_PSTEP
#undef RK_PLOAD
    }
    __syncthreads();
}
#undef RLAS
#undef RGAS
}

constexpr int NWAVES = 8;
constexpr int RING_OFF = 0, RING_BYTES = 131072;
constexpr int LDSCTL_OFF = RING_BYTES, MISC_OFF = LDSCTL_OFF + 320;
constexpr int LDS_BYTES = 147456;
#define GAS __attribute__((address_space(1)))
#define LAS __attribute__((address_space(3)))
typedef unsigned v4u __attribute__((ext_vector_type(4)));
typedef float f32x4 __attribute__((ext_vector_type(4)));
typedef GAS unsigned gu32;
#define RLX_AGENT __ATOMIC_RELAXED, __HIP_MEMORY_SCOPE_AGENT
#define LDS_WAIT() asm volatile("s_waitcnt lgkmcnt(0)" ::: "memory")
#define VM_WAIT() asm volatile("s_waitcnt vmcnt(0)" ::: "memory")
constexpr int CW_ATTQ = 64;
constexpr int CW_BAR = 4096;
constexpr size_t CTL_ZERO_BYTES = 64 * 1024;

#define XB_TMO      128
#define XB_XCNT(j)  (256  + 64 * (j))
#define XB_XSUB(j)  (1280 + 64 * (j))
#define XB_XGEN(j)  (2304 + 64 * (j))
#define XB_TOP      3328
#define XB_TOPGEN   3392
#define XCD_BAR_WORDS 3456
#define XB_SPIN_CAP (1u << 18)

__device__ __forceinline__ unsigned xb_ld(unsigned* p)              { return __hip_atomic_load(p, __ATOMIC_RELAXED, __HIP_MEMORY_SCOPE_AGENT); }
__device__ __forceinline__ unsigned xb_add(unsigned* p, unsigned v) { return __hip_atomic_fetch_add(p, v, __ATOMIC_RELAXED, __HIP_MEMORY_SCOPE_AGENT); }
__device__ __forceinline__ unsigned xb_xcc_id() { return (unsigned)__builtin_amdgcn_s_getreg((3 << 11) | 20) & 0xFu; }
#define XB_SPIN(cond, bar) do { unsigned _sp = 0; while (cond) { __builtin_amdgcn_s_sleep(1); \
    if ((++_sp & 255u) == 0u) { if (xb_ld(&(bar)[XB_TMO])) break; if (_sp > XB_SPIN_CAP) { atomicAdd(&(bar)[XB_TMO], 1u); break; } } } } while (0)

struct XcdBarrier {
    unsigned* bar; unsigned x; bool w0;
    volatile LAS unsigned* st;
};

__device__ __forceinline__ XcdBarrier xcd_barrier_post(unsigned* bar, volatile LAS unsigned* st) {
    XcdBarrier b; b.bar = bar; b.x = xb_xcc_id(); b.st = st; b.w0 = (__builtin_amdgcn_readfirstlane(threadIdx.x >> 6) == 0);
    if (__builtin_amdgcn_readfirstlane(threadIdx.x >> 6) == 0 && pg8::lane_id() == 0) (void)xb_add(&bar[XB_XCNT(b.x)], 1u);
    return b;
}
__device__ __forceinline__ void xcd_barrier_complete(unsigned* bar, unsigned x, unsigned& nloc, unsigned& nx) {
    const unsigned G = gridDim.x * gridDim.y * gridDim.z;
    unsigned sum, cnt, mine, sp = 0u;
    for (;;) {
        sum = 0u; cnt = 0u; mine = 0u;
#pragma unroll
        for (unsigned j = 0; j < 16; ++j) { const unsigned c = xb_ld(&bar[XB_XCNT(j)]); sum += c; cnt += (c > 0u) ? 1u : 0u; mine = (j == x) ? c : mine; }
        if (sum == G) break;
        __builtin_amdgcn_s_sleep(1);
        if ((++sp & 255u) == 0u) { if (xb_ld(&bar[XB_TMO])) break; if (sp > XB_SPIN_CAP) { atomicAdd(&bar[XB_TMO], 1u); break; } }
    }
    nloc = mine > 0u ? mine : 1u; nx = cnt > 0u ? cnt : 1u;
}

__device__ __forceinline__ void xcd_barrier(const XcdBarrier& b) {
    asm volatile("s_waitcnt vmcnt(0)" ::: "memory");
    __syncthreads();
    if (b.w0 && pg8::lane_id() == 0) {
        unsigned* bar = b.bar;
        __builtin_amdgcn_s_waitcnt(0);
        unsigned nloc = b.st[0], nx = b.st[1];
        if (nloc == 0u) { xcd_barrier_complete(bar, b.x, nloc, nx); b.st[0] = nloc; b.st[1] = nx; }
        const unsigned old = xb_add(&bar[XB_XSUB(b.x)], 1u);
        const unsigned gen = old / nloc;
        if (old + 1u == (gen + 1u) * nloc) {
            __builtin_amdgcn_fence(__ATOMIC_RELEASE, "agent");
            asm volatile("s_waitcnt vmcnt(0)" ::: "memory");
            const unsigned og = xb_add(&bar[XB_TOP], 1u);
            const unsigned tg = og / nx;
            if (og + 1u == (tg + 1u) * nx) xb_add(&bar[XB_TOPGEN], 1u);
            else XB_SPIN(xb_ld(&bar[XB_TOPGEN]) == tg, bar);
            __builtin_amdgcn_fence(__ATOMIC_ACQUIRE, "agent");
            xb_add(&bar[XB_XGEN(b.x)], 1u);
            asm volatile("s_waitcnt vmcnt(0)" ::: "memory");
        } else {
            XB_SPIN(xb_ld(&bar[XB_XGEN(b.x)]) == gen, bar);
            __builtin_amdgcn_fence(__ATOMIC_ACQUIRE, "agent");
            asm volatile("s_waitcnt vmcnt(0)" ::: "memory");
        }
    }
    __syncthreads();
}


typedef unsigned short f16_t;
typedef _Float16 h2v __attribute__((ext_vector_type(2)));
__device__ __forceinline__ unsigned pk2h(float lo, float hi) { h2v v = {(_Float16)lo, (_Float16)hi}; return __builtin_bit_cast(unsigned, v); }

struct Frame {
    LAS unsigned char* lds; volatile LAS unsigned* MISC; gu32* ctl;
    int wave, vcu, G;
};
#define FTID (F.wave * 64 + pg8::lane_id())
#define FLANE (pg8::lane_id())
__device__ __forceinline__ void p0_transpose_item(const float* W, int K, int N, f16_t* WT, int row_off, LAS float* scr, int item, int lane) {
    const int nblk = N / 32, kb = item / nblk, nb = item % nblk, k0 = 64 * kb, n0 = 32 * nb;
#pragma unroll 8
    for (int i = 0; i < 32; ++i) { const int kk = 2 * i + (lane >> 5); scr[kk * 33 + (lane & 31)] = W[(size_t)(k0 + kk) * N + n0 + (lane & 31)]; }
    LDS_WAIT(); asm volatile("" ::: "memory");
    const int c = lane & 7;
#pragma unroll
    for (int j = 0; j < 4; ++j) { const int n = (lane >> 3) + 8 * j; const LAS float* s = scr + (8 * c) * 33 + n;
        v4u o; o.x = pk2h(s[0 * 33], s[1 * 33]); o.y = pk2h(s[2 * 33], s[3 * 33]); o.z = pk2h(s[4 * 33], s[5 * 33]); o.w = pk2h(s[6 * 33], s[7 * 33]);
        *(GAS v4u*)(WT + (size_t)(row_off + n0 + n) * K + k0 + 8 * c) = o; }
    LDS_WAIT(); asm volatile("" ::: "memory");
}
__device__ __forceinline__ float wave_sum_b(float v) {
#pragma unroll
    for (int o = 1; o < 64; o <<= 1) v += __shfl_xor(v, o);
    return v;
}
__device__ __forceinline__ void ln_row_dual(int lane, const float* xrow, const float* g, const float* b, float* o32, f16_t* o16) {
    const GAS f32x4* xr = (const GAS f32x4*)xrow + lane;
    f32x4 v[8]; float s = 0.f;
#pragma unroll
    for (int j = 0; j < 8; ++j) { v[j] = xr[64 * j]; s += (v[j].x + v[j].y) + (v[j].z + v[j].w); }
    const float mean = wave_sum_b(s) * (1.f / D); float s2 = 0.f;
#pragma unroll
    for (int j = 0; j < 8; ++j) { v[j] = v[j] - mean; s2 += (v[j].x * v[j].x + v[j].y * v[j].y) + (v[j].z * v[j].z + v[j].w * v[j].w); }
    const float rstd = __builtin_amdgcn_rsqf(wave_sum_b(s2) * (1.f / D) + LN_EPS);
    const GAS f32x4* g4 = (const GAS f32x4*)g + lane; const GAS f32x4* b4 = (const GAS f32x4*)b + lane;
    GAS f32x4* o4 = (GAS f32x4*)o32 + lane; GAS unsigned long long* o8 = (GAS unsigned long long*)o16 + lane;
#pragma unroll
    for (int j = 0; j < 8; ++j) { const f32x4 o = v[j] * rstd * g4[64 * j] + b4[64 * j]; o4[64 * j] = o;
        o8[64 * j] = (unsigned long long)pk2h(o.x, o.y) | ((unsigned long long)pk2h(o.z, o.w) << 32); }
}


__device__ __forceinline__ void p0_transpose_item_gu(const float* W, int K, int N, f16_t* WT, int gu_s, LAS float* scr, int item, int lane) {
    const int nblk = N / 32, nb = item % nblk; const int row_off = gu_s < 0 ? 0 : 128 * (nb >> 2) + 128 * gu_s;
    p0_transpose_item(W, K, N, WT, row_off, scr, item, lane);
}
__device__ __forceinline__ void ln_norm(int lane, f32x4 (&v)[8], const float* g, const float* b) {
    float s = 0.f;
#pragma unroll
    for (int j = 0; j < 8; ++j) s += (v[j].x + v[j].y) + (v[j].z + v[j].w);
    const float mean = wave_sum_b(s) * (1.f / D); float s2 = 0.f;
#pragma unroll
    for (int j = 0; j < 8; ++j) { v[j] = v[j] - mean; s2 += (v[j].x * v[j].x + v[j].y * v[j].y) + (v[j].z * v[j].z + v[j].w * v[j].w); }
    const float rstd = __builtin_amdgcn_rsqf(wave_sum_b(s2) * (1.f / D) + LN_EPS);
    const GAS f32x4* g4 = (const GAS f32x4*)g + lane; const GAS f32x4* b4 = (const GAS f32x4*)b + lane;
#pragma unroll
    for (int j = 0; j < 8; ++j) v[j] = v[j] * rstd * g4[64 * j] + b4[64 * j];
}
__device__ __forceinline__ void ln_store(int lane, const f32x4 (&v)[8], float* o32, f16_t* o16) {
    GAS f32x4* o4 = (GAS f32x4*)o32 + lane; GAS unsigned long long* o8 = (GAS unsigned long long*)o16 + lane;
#pragma unroll
    for (int j = 0; j < 8; ++j) { o4[64 * j] = v[j]; o8[64 * j] = (unsigned long long)pk2h(v[j].x, v[j].y) | ((unsigned long long)pk2h(v[j].z, v[j].w) << 32); }
}
__device__ __forceinline__ void ln_regs(int lane, f32x4 (&v)[8], const float* g, const float* b, float* o32, f16_t* o16) { ln_norm(lane, v, g, b); ln_store(lane, v, o32, o16); }
__device__ __forceinline__ void route_token(int tok, const float (&acc)[36], const float* gb, const float* eb, int* cnt, int* ltok, int* lpair, float* pairw) {
    float gl[4]; float gm = -3.0e38f; int gi = 0;
#pragma unroll
    for (int i = 0; i < 4; ++i) { gl[i] = acc[i] + gb[i]; if (gl[i] > gm) { gm = gl[i]; gi = i; } }
    float gs = 0.f;
#pragma unroll
    for (int i = 0; i < 4; ++i) gs += __expf(gl[i] - gm);
    const float gtop = 1.f / gs;
    float el[8]; float em = -3.0e38f; int e0 = 0;
#pragma unroll
    for (int i = 0; i < 8; ++i) { float v = 0.f;
#pragma unroll
        for (int g = 0; g < 4; ++g) if (g == gi) v = acc[4 + g * 8 + i] + eb[g * 8 + i];
        el[i] = v; if (v > em) { em = v; e0 = i; } }
    float em2 = -3.0e38f; int e1 = 0;
#pragma unroll
    for (int i = 0; i < 8; ++i) if (i != e0 && el[i] > em2) { em2 = el[i]; e1 = i; }
    const float x1 = __expf(em2 - em);
    const float w0 = 1.f / (1.f + x1), w1 = x1 / (1.f + x1);
    const int ea = gi * 8 + e0, ebb = gi * 8 + e1;
    const int p0 = atomicAdd(&cnt[ea], 1); ltok[ea * 8192 + p0] = tok; lpair[ea * 8192 + p0] = tok * 2;
    const int p1 = atomicAdd(&cnt[ebb], 1); ltok[ebb * 8192 + p1] = tok; lpair[ebb * 8192 + p1] = tok * 2 + 1;
    pairw[tok * 2] = w0 * gtop; pairw[tok * 2 + 1] = w1 * gtop;
}
constexpr int TAB_OFF = LDSCTL_OFF + 1024;
__device__ __forceinline__ void build_moe_table(Frame& F, const int* cnt) {
    LAS int* tab = (LAS int*)(F.lds + TAB_OFF);
    const int tid = FTID;
    if (tid < 32) tab[tid] = __hip_atomic_load(cnt + tid, __ATOMIC_RELAXED, __HIP_MEMORY_SCOPE_AGENT);
    __syncthreads();
    if (tid == 0) { int p = 0, pa = 0, pb = 0; for (int e = 0; e < 32; ++e) { const int nb = (tab[e] + 255) >> 8, na = nb < 2 ? nb : 2;
            tab[32 + e] = p; tab[65 + e] = pa; tab[98 + e] = pb; p += nb; pa += na; pb += nb - na; } tab[64] = p; tab[97] = pa; tab[130] = pb; }
    __syncthreads();
}

__device__ __forceinline__ float sum8_dpp(float x) {
    x += __builtin_bit_cast(float, __builtin_amdgcn_update_dpp(0, __builtin_bit_cast(int, x), 0xB1, 0xF, 0xF, true));
    x += __builtin_bit_cast(float, __builtin_amdgcn_update_dpp(0, __builtin_bit_cast(int, x), 0x4E, 0xF, 0xF, true));
    x += __builtin_bit_cast(float, __builtin_amdgcn_update_dpp(0, __builtin_bit_cast(int, x), 0x141, 0xF, 0xF, true));
    return x;
}
__device__ __forceinline__ float h2f(unsigned short u) { return (float)__builtin_bit_cast(_Float16, u); }
__device__ __forceinline__ float sum32_x(float x) {
    x += __builtin_bit_cast(float, __builtin_amdgcn_update_dpp(0, __builtin_bit_cast(int, x), 0xB1, 0xF, 0xF, true));
    x += __builtin_bit_cast(float, __builtin_amdgcn_update_dpp(0, __builtin_bit_cast(int, x), 0x4E, 0xF, 0xF, true));
    x += __builtin_bit_cast(float, __builtin_amdgcn_update_dpp(0, __builtin_bit_cast(int, x), 0x141, 0xF, 0xF, true));
    x += __builtin_bit_cast(float, __builtin_amdgcn_update_dpp(0, __builtin_bit_cast(int, x), 0x140, 0xF, 0xF, true));
    x += __builtin_bit_cast(float, __builtin_amdgcn_ds_bpermute((pg8::lane_id() ^ 16) << 2, __builtin_bit_cast(int, x)));
    return x;
}
__device__ __forceinline__ float wsum64(float x) {
    x = sum32_x(x); auto rr = __builtin_amdgcn_permlane32_swap(__float_as_uint(x), __float_as_uint(x), false, false); return __uint_as_float(rr[0]) + __uint_as_float(rr[1]);
}
__device__ __forceinline__ void rwkv_prep_tile(Frame& F, int tile, const f16_t* PROJ16, const f16_t* LSLAB, const float* mu, const float* w0, const f16_t* W2T, const float* a0, const f16_t* A2T, const f16_t* G2T,
                                               const float* k_k, const float* k_a, float* lwout, f16_t* kmod, f16_t* Aout, f16_t* Bout, f16_t* gout) {
    typedef _Float16 f16x8 __attribute__((ext_vector_type(8))); typedef float f32x16 __attribute__((ext_vector_type(16)));
    constexpr int SXS = 592;
    LAS unsigned char* sx = F.lds + RING_OFF;
    const int lane = FLANE, tid = F.wave * 64 + lane, t0 = tile * 32, r32 = lane & 31, hi = lane >> 5;
    __syncthreads();
    for (int e = tid; e < 32 * 36; e += 512) {
        typedef unsigned short us8v __attribute__((ext_vector_type(8)));
        const int tok = e / 36, i8 = (e % 36) * 8, pos = (t0 + tok) & (S - 1);
        float cv[8], pv[8];
#pragma unroll
        for (int i = 0; i < 8; ++i) { cv[i] = 0.f; pv[i] = 0.f; }
#pragma unroll
        for (int sl = 0; sl < 4; ++sl) { const f16_t* cur = LSLAB + ((size_t)sl * T + t0 + tok) * 512 + i8;
            const us8v c8 = *(const GAS us8v*)cur; us8v p8 = c8; if (pos > 0) p8 = *(const GAS us8v*)(cur - 512);
#pragma unroll
            for (int i = 0; i < 8; ++i) { cv[i] += h2f(c8[i]); pv[i] += h2f(p8[i]); } }
        float f[8];
#pragma unroll
        for (int i = 0; i < 8; ++i) { const float xs = cv[i] + ((pos > 0 ? pv[i] : 0.f) - cv[i]) * mu[3072 + i8 + i];
            f[i] = i8 < 64 ? 1.f - 2.f / (1.f + __expf(2.f * xs)) : (i8 < 128 ? xs : 1.f / (1.f + __expf(-xs))); }
        *(LAS v4u*)(sx + tok * SXS + i8 * 2) = (v4u){pk2h(f[0], f[1]), pk2h(f[2], f[3]), pk2h(f[4], f[5]), pk2h(f[6], f[7])};
    }
    __syncthreads();
    const LAS unsigned char* ap = sx + r32 * SXS + hi * 16;
#pragma unroll 1
    for (int hd = 0; hd < 2; ++hd) {
        const int ch0 = 128 * F.wave + 64 * hd;
        f32x16 aw[2], aa[2], ag[2];
#pragma unroll
        for (int tt = 0; tt < 2; ++tt)
#pragma unroll
            for (int r = 0; r < 16; ++r) { aw[tt][r] = 0.f; aa[tt][r] = 0.f; ag[tt][r] = 0.f; }
#pragma unroll
        for (int tt = 0; tt < 2; ++tt) {
            const int n = ch0 + 32 * tt + r32;
            const f16_t* bw = W2T + (size_t)n * 64 + hi * 8; const f16_t* ba = A2T + (size_t)n * 64 + hi * 8; const f16_t* bg = G2T + (size_t)n * 160 + hi * 8;
#pragma unroll
            for (int ks = 0; ks < 4; ++ks) {
                aw[tt] = __builtin_amdgcn_mfma_f32_32x32x16_f16(*(const LAS f16x8*)(ap + ks * 32), *(const GAS f16x8*)(bw + ks * 16), aw[tt], 0, 0, 0);
                aa[tt] = __builtin_amdgcn_mfma_f32_32x32x16_f16(*(const LAS f16x8*)(ap + 128 + ks * 32), *(const GAS f16x8*)(ba + ks * 16), aa[tt], 0, 0, 0); }
#pragma unroll
            for (int ks = 0; ks < 10; ++ks)
                ag[tt] = __builtin_amdgcn_mfma_f32_32x32x16_f16(*(const LAS f16x8*)(ap + 256 + ks * 32), *(const GAS f16x8*)(bg + ks * 16), ag[tt], 0, 0, 0);
        }
        float k0[2][16];
        float pkk[2], pka[2], pmu[2], pw0[2], pa0[2];
#pragma unroll
        for (int tt = 0; tt < 2; ++tt) { const int n = ch0 + 32 * tt + r32; pkk[tt] = k_k[n]; pka[tt] = k_a[n]; pmu[tt] = mu[1024 + n]; pw0[tt] = w0[n]; pa0[tt] = a0[n]; }
#pragma unroll
        for (int rh = 0; rh < 2; ++rh) {
        float inv[8];
#pragma unroll
        for (int r = 8 * rh; r < 8 * rh + 8; ++r) { const int tok = t0 + (r & 3) + 8 * (r >> 2) + 4 * hi, pos = tok & (S - 1); float ss = 0.f;
#pragma unroll
            for (int tt = 0; tt < 2; ++tt) { const f16_t* cur = PROJ16 + (size_t)tok * PN + 4096 + ch0 + 32 * tt + r32;
                const float cv = h2f(cur[0]), pv = pos > 0 ? h2f(cur[-PN]) : 0.f; k0[tt][r] = cv + (pv - cv) * pmu[tt]; const float kq = k0[tt][r] * pkk[tt]; ss = fmaf(kq, kq, ss); }
            ss = sum32_x(ss); inv[r - 8 * rh] = __builtin_amdgcn_rsqf(fmaxf(ss, 1e-24f)); }
#pragma unroll
        for (int r = 8 * rh; r < 8 * rh + 8; ++r) { const int tok = t0 + (r & 3) + 8 * (r >> 2) + 4 * hi;
#pragma unroll
            for (int tt = 0; tt < 2; ++tt) { const size_t o = (size_t)tok * RWK + ch0 + 32 * tt + r32;
                const float z = -(pw0[tt] + aw[tt][r]); const float sp = z > 20.f ? z : __logf(1.f + __expf(z));
                lwout[o] = -__expf(-sp - 0.5f);
                const float asig = 1.f / (1.f + __expf(-(pa0[tt] + aa[tt][r]))); const float kk = k0[tt][r] * pkk[tt] * inv[r - 8 * rh];
                kmod[o] = __builtin_bit_cast(unsigned short, (_Float16)(k0[tt][r] * (1.f + (asig - 1.f) * pka[tt])));
                Aout[o] = __builtin_bit_cast(unsigned short, (_Float16)(-kk)); Bout[o] = __builtin_bit_cast(unsigned short, (_Float16)(kk * asig));
                gout[o] = __builtin_bit_cast(unsigned short, (_Float16)ag[tt][r]); } }
        }
    }
}
__device__ __forceinline__ float sum16_dpp(float x) {
    x += __builtin_bit_cast(float, __builtin_amdgcn_update_dpp(0, __builtin_bit_cast(int, x), 0xB1, 0xF, 0xF, true));
    x += __builtin_bit_cast(float, __builtin_amdgcn_update_dpp(0, __builtin_bit_cast(int, x), 0x4E, 0xF, 0xF, true));
    x += __builtin_bit_cast(float, __builtin_amdgcn_update_dpp(0, __builtin_bit_cast(int, x), 0x141, 0xF, 0xF, true));
    x += __builtin_bit_cast(float, __builtin_amdgcn_update_dpp(0, __builtin_bit_cast(int, x), 0x140, 0xF, 0xF, true));
    return x;
}
__device__ __forceinline__ f32x4 h4f(const f16_t* p) { typedef _Float16 h4_t __attribute__((ext_vector_type(4))); const h4_t v = *(const GAS h4_t*)p; return (f32x4){(float)v[0], (float)v[1], (float)v[2], (float)v[3]}; }
#ifndef REP_P0
#define REP_P0 1
#endif
#ifndef REP_PROJ
#define REP_PROJ 1
#endif
#ifndef REP_PLE
#define REP_PLE 1
#endif
#ifndef REP_CONV
#define REP_CONV 1
#endif
#ifndef REP_P2
#define REP_P2 1
#endif
#ifndef REP_P3
#define REP_P3 1
#endif
#ifndef PROBE_K
#define PROBE_K -1
#endif
#ifndef REP_P5
#define REP_P5 1
#endif
#ifndef REP_P8
#define REP_P8 1
#endif
#ifndef REP_P6
#define REP_P6 1
#endif
#ifndef REP_P7
#define REP_P7 1
#endif
struct Args { const float* in[37]; float* out; unsigned char* ws; int ph_lo, ph_hi, li, pad; };
__global__ void __launch_bounds__(NWAVES * 64, 2) mega_fwd(Args args) {
    extern __shared__ __attribute__((aligned(16))) unsigned char lds[];
    Frame F;
    F.lds = (LAS unsigned char*)lds; F.MISC = (volatile LAS unsigned*)(F.lds + MISC_OFF);
    F.wave = __builtin_amdgcn_readfirstlane(threadIdx.x >> 6);
    F.G = gridDim.x; { const int bx = blockIdx.x; F.vcu = (F.G % 8 == 0) ? (bx % 8) * (F.G / 8) + bx / 8 : bx; }
    unsigned char* ws = args.ws;
    F.ctl = (gu32*)(ws);
    for (int u = FTID; u < (LDS_BYTES - LDSCTL_OFF) / 4; u += NWAVES * 64) ((LAS unsigned*)(F.lds + LDSCTL_OFF))[u] = 0u;
    __syncthreads();
    XcdBarrier bar = xcd_barrier_post((unsigned*)(F.ctl + CW_BAR) + args.li * XCD_BAR_WORDS, F.MISC + 8);
    unsigned long long t0_ = 0, tk_ = 0; if (PROBE_K != -1) t0_ = __builtin_amdgcn_s_memrealtime();
    const int lo = args.ph_lo, hi = args.ph_hi;
#define IN(k) (lo <= (k) && (k) < hi)
#define BOTH(k) (IN(k) && IN((k) + 1))
    f16_t* WinT = (f16_t*)(ws + WS_WINT); f16_t* H16 = (f16_t*)(ws + WS_H16); f16_t* PROJ16 = (f16_t*)(ws + WS_PROJ16); float* DECAY = (float*)(ws + WS_DECAY); f16_t* KMOD = (f16_t*)(ws + WS_KMOD); f16_t* A16 = (f16_t*)(ws + WS_A16); f16_t* B16 = (f16_t*)(ws + WS_B16); f16_t* G16 = (f16_t*)(ws + WS_G16);
    f16_t* WoutT = (f16_t*)(ws + WS_WOUTT); f16_t* GateT = (f16_t*)(ws + WS_GATET); f16_t* PleT = (f16_t*)(ws + WS_PLET); f16_t* P16 = (f16_t*)(ws + WS_P16);
    f16_t* PW16 = (f16_t*)(ws + WS_PW16); f16_t* Y16 = (f16_t*)(ws + WS_Y16); float* ROWRS = (float*)(ws + WS_ROWRS);
    float* RT = (float*)(ws + WS_RT); f16_t* GUT = (f16_t*)(ws + WS_GUT); f16_t* DNT = (f16_t*)(ws + WS_DNT); f16_t* HID = (f16_t*)(ws + WS_HID); f16_t* FFN16 = (f16_t*)(ws + WS_FFN16); f16_t* H1_16 = (f16_t*)(ws + WS_H1_16);
    int* cnt = (int*)(ws + WS_CNT); int* ltok = (int*)(ws + WS_LTOK); int* lpair = (int*)(ws + WS_LPAIR); float* pairw = (float*)(ws + WS_PAIRW);
    const int gw = F.vcu * NWAVES + F.wave, NGW = F.G * NWAVES;
    if (IN(0)) for (int rep_ = 0; rep_ < REP_P0; ++rep_) {
        LAS float* scr = (LAS float*)(F.lds + RING_OFF + F.wave * 16384);
        constexpr int I_IN = (D / 64) * (NPROJ / 32);
        for (int it = gw; it < I_IN; it += NGW) p0_transpose_item(args.in[5], D, NPROJ, WinT, 0, scr, it, FLANE);
        constexpr int I_SQ = (D / 64) * (D / 32), I_PLE = (256 / 64) * (D / 32);
        for (int it = gw; it < 2 * I_SQ + I_PLE; it += NGW) {
            if (it < I_SQ) p0_transpose_item(args.in[22], D, D, WoutT, 0, scr, it, FLANE);
            else if (it < 2 * I_SQ) p0_transpose_item(args.in[36], D, D, GateT, 0, scr, it - I_SQ, FLANE);
            else p0_transpose_item(args.in[34], 256, D, PleT, 0, scr, it - 2 * I_SQ, FLANE);
        }
        { const GAS f32x4* pi = (const GAS f32x4*)args.in[1]; GAS unsigned long long* po = (GAS unsigned long long*)P16;
          for (int i = blockIdx.x * 512 + FTID; i < T * 256 / 4; i += F.G * 512) { const f32x4 v = pi[i]; po[i] = (unsigned long long)pk2h(v.x, v.y) | ((unsigned long long)pk2h(v.z, v.w) << 32); } }
        { GAS v4u* z = (GAS v4u*)(WinT + (size_t)NPROJ * D); const int nz = (PN - NPROJ) * D * 2 / 16;
          for (int i = blockIdx.x * 512 + FTID; i < nz; i += F.G * 512) z[i] = (v4u){0u, 0u, 0u, 0u}; }
        {
            f16_t* W2T = (f16_t*)(ws + WS_W2T); f16_t* A2T = (f16_t*)(ws + WS_A2T); f16_t* G2T = (f16_t*)(ws + WS_G2T);
            for (int i = blockIdx.x * 512 + FTID; i < 1024 * 288; i += F.G * 512) { const int n = i / 288, k = i % 288;
                if (k < 64) W2T[n * 64 + k] = __builtin_bit_cast(unsigned short, (_Float16)args.in[13][k * 1024 + n]);
                else if (k < 128) A2T[n * 64 + (k - 64)] = __builtin_bit_cast(unsigned short, (_Float16)args.in[15][(k - 64) * 1024 + n]);
                else G2T[n * 160 + (k - 128)] = __builtin_bit_cast(unsigned short, (_Float16)args.in[16][(k - 128) * 1024 + n]); } }
        if (blockIdx.x == 0) {
            const int tid = FTID; float* lamp = (float*)(ws + WS_LAM); float* biasT = (float*)(ws + WS_BIAS);
            if (tid < 64) { const float a = wave_sum_b(args.in[6][tid] * args.in[7][tid]), b2 = wave_sum_b(args.in[8][tid] * args.in[9][tid]); if (tid == 0) *lamp = expf(a) - expf(b2) + LAMBDA_INIT; }
            for (int i = tid; i < 8 * 129; i += 512) { const int hh = i / 129, n = i % 129; int bucket;
                if (n < 16) bucket = n; else { const int large = 16 + (int)(logf((float)n / 16.f) / 2.0794415416798357f * 16.f); bucket = large < 31 ? large : 31; }
                biasT[i] = args.in[4][bucket * 8 + hh]; }
        }
        for (int m = gw; m < T; m += NGW) ln_row_dual(FLANE, args.in[0] + (size_t)m * D, args.in[2], args.in[3], args.out + (size_t)m * D, H16 + (size_t)m * D);
        if (BOTH(0) && rep_ == REP_P0 - 1) xcd_barrier(bar); else __syncthreads();
    }
    if (PROBE_K == 0) tk_ = __builtin_amdgcn_s_memrealtime();
    if (IN(1)) {
        pg8::Gemm g{H16, WinT, T, 6144, D, D}; pg8::StaticOrder S; S.init(T, 6144, F.G, (int)blockIdx.x);
        pg8::EpiF16 E{PROJ16, PN, 4, att::C2};
        for (int rep_ = 0; rep_ < REP_PROJ; ++rep_) pg8::gemm_phase<pg8::EpiF16, pg8::StaticOrder, true>(F.lds + RING_OFF, g, S, E, F.wave);
        { pg8::Gemm gl{H16, WinT + (size_t)6144 * D, T, 512, 512, D}; pg8::SplitKOrder Sl{T / 256, 2, 4, F.G, (int)blockIdx.x};
          pg8::EpiSlab El{(f16_t*)(ws + WS_LSLAB), 512, (size_t)T * 512};
          pg8::gemm_phase<pg8::EpiSlab, pg8::SplitKOrder, true>(F.lds + RING_OFF, gl, Sl, El, F.wave); }
        for (int rep_ = 0; rep_ < REP_PLE; ++rep_) { pg8::Gemm g2{P16, PleT, T, D, 256, 256}; pg8::StaticOrder S2; S2.init(T, D, F.G, (int)blockIdx.x);
          pg8::EpiF16 E2{PW16, D, 0, 1.f};
          pg8::gemm_phase<pg8::EpiF16, pg8::StaticOrder, true>(F.lds + RING_OFF, g2, S2, E2, F.wave); }
        if (BOTH(1)) xcd_barrier(bar);
    }
    if (PROBE_K == 1) tk_ = __builtin_amdgcn_s_memrealtime();
    if (IN(2)) {
        for (int rep_ = 0; rep_ < REP_P2; ++rep_)
        if (F.vcu < T / 32) { const int tile = F.vcu;
            rwkv_prep_tile(F, tile, PROJ16, (const f16_t*)(ws + WS_LSLAB), args.in[11], args.in[12], (const f16_t*)(ws + WS_W2T), args.in[14], (const f16_t*)(ws + WS_A2T), (const f16_t*)(ws + WS_G2T), args.in[17], args.in[18], DECAY, KMOD, A16, B16, G16);
            asm volatile("s_waitcnt vmcnt(0)" ::: "memory"); __syncthreads();
            { rk::ChunkIn nin; const int tl_ = (F.wave & 3) * 64 + FLANE, tg_ = tile * 32 + (tl_ >> 3), ps_ = tg_ & (S - 1), cb_ = (F.wave >> 2) * 64 + (tl_ & 7) * 8;
              rk::chunk_load(nin, tg_, ps_, cb_, ws);
              for (int hA = 0; hA < 16; hA += 2) {
                  rk::chunk_pair(F.lds + RING_OFF, F.wave, tile, hA, nin, hA + 2 < 16, args.in[11], args.in[19], ws); } }
            __syncthreads();
        }
        if (BOTH(2)) xcd_barrier(bar);
    }
    if (PROBE_K == 2) tk_ = __builtin_amdgcn_s_memrealtime();
    if (IN(3)) {
        if (F.vcu < 64) rk::scan_unit(F.lds + RING_OFF, F.wave, F.vcu, ws + WS_CHK, (const float*)(ws + WS_BONUS), PROJ16, args.in[11], G16, args.in[20], args.in[21], Y16);
        {
            const float lam = *(const float*)(ws + WS_LAM);
            volatile LAS unsigned* qslot = F.MISC + 12;
            for (;;) {
                __syncthreads();
                if (FTID == 0) *qslot = __hip_atomic_fetch_add(F.ctl + CW_ATTQ, 1u, __ATOMIC_RELAXED, __HIP_MEMORY_SCOPE_AGENT);
                __syncthreads();
                const int u = (int)__builtin_amdgcn_readfirstlane(*qslot);
                if (u >= 512) break;
                const int qb = 15 - (u >> 5), bh = u & 31;
                att::attn_unit<8>(F.lds + RING_OFF, F.wave, bh >> 3, bh & 7, qb, PROJ16, Y16, (const float*)(ws + WS_BIAS) + (bh & 7) * 129, lam, args.in[10]);
            }
        }
        if (BOTH(3)) xcd_barrier(bar);
    }
    if (PROBE_K == 3) tk_ = __builtin_amdgcn_s_memrealtime();
    if (IN(4)) {
        for (int rep_ = 0; rep_ < REP_CONV; ++rep_) {
            __syncthreads();
        LAS float* scr = (LAS float*)(F.lds + RING_OFF + F.wave * 16384);
        for (int it = gw; it < NE * 1536; it += NGW) {
            const int e = it / 1536, r = it % 1536;
            if (r < 512) p0_transpose_item_gu(args.in[29] + (size_t)e * D * 512, D, 512, GUT + (size_t)e * 1024 * D, 0, scr, r, FLANE);
            else if (r < 1024) p0_transpose_item_gu(args.in[30] + (size_t)e * D * 512, D, 512, GUT + (size_t)e * 1024 * D, 1, scr, r - 512, FLANE);
            else p0_transpose_item_gu(args.in[31] + (size_t)e * 512 * D, 512, D, DNT + (size_t)e * D * 512, -1, scr, r - 1024, FLANE);
        }
        for (int i = blockIdx.x * 512 + FTID; i < 36 * D; i += F.G * 512) { const int e = i / D, d = i % D; RT[i] = e < 4 ? args.in[25][d * 4 + e] : args.in[27][d * 32 + (e - 4)]; }
            asm volatile("s_waitcnt vmcnt(0) lgkmcnt(0)" ::: "memory"); __syncthreads();
        }
        pg8::Gemm g{Y16, WoutT, T, D, D, D}; pg8::StaticOrder S; S.init(T, D, F.G, (int)blockIdx.x);
        pg8::EpiResF32 E{args.out, D, ALPHA};
        pg8::gemm_phase<pg8::EpiResF32, pg8::StaticOrder, true>(F.lds + RING_OFF, g, S, E, F.wave);
        if (BOTH(4)) xcd_barrier(bar);
    }
    if (PROBE_K == 4) tk_ = __builtin_amdgcn_s_memrealtime();
    if (IN(5)) for (int rep_ = 0; rep_ < REP_P5; ++rep_) {
        const bool dry = rep_ < REP_P5 - 1;
        float* o32b = dry ? (float*)(ws + WS_CHK) : args.out; f16_t* o16b = dry ? (f16_t*)(ws + WS_CHK + 64 * MiB) : H1_16;
        const int lane = FLANE, tid = F.wave * 64 + lane;
        LAS float* rtb = (LAS float*)(F.lds + RING_OFF);
        LAS float* lg = (LAS float*)(F.lds + RING_OFF + 49152) + F.wave * 256;
        if (F.vcu < T / 32) {
            const int r0 = F.vcu * 32 + F.wave * 4;
            f32x4 v0[8], v1[8], v2[8], v3[8];
            { const GAS f32x4* xr = (const GAS f32x4*)(args.out + (size_t)r0 * D) + lane;
#pragma unroll
              for (int j = 0; j < 8; ++j) { v0[j] = xr[64 * j]; v1[j] = xr[64 * j + D / 4]; v2[j] = xr[64 * j + 2 * (D / 4)]; v3[j] = xr[64 * j + 3 * (D / 4)]; } }
            ln_norm(lane, v0, args.in[23], args.in[24]); ln_norm(lane, v1, args.in[23], args.in[24]); ln_norm(lane, v2, args.in[23], args.in[24]); ln_norm(lane, v3, args.in[23], args.in[24]);
            f32x4 stg[6];
#pragma unroll
            for (int i = 0; i < 6; ++i) stg[i] = *(const GAS f32x4*)(RT + 4 * (tid + 512 * i));
#pragma unroll 1
            for (int ec = 0; ec < 6; ++ec) {
                __syncthreads();
#pragma unroll
                for (int i = 0; i < 6; ++i) *(LAS f32x4*)(rtb + 4 * (tid + 512 * i)) = stg[i];
                { const int en = ec + 1 < 6 ? ec + 1 : ec;
#pragma unroll
                  for (int i = 0; i < 6; ++i) stg[i] = *(const GAS f32x4*)(RT + (size_t)en * 6 * D + 4 * (tid + 512 * i)); }
                __syncthreads();
                float a0[6], a1[6], a2[6], a3[6];
#pragma unroll
                for (int e = 0; e < 6; ++e) { a0[e] = 0.f; a1[e] = 0.f; a2[e] = 0.f; a3[e] = 0.f; }
#pragma unroll
                for (int j = 0; j < 8; ++j)
#pragma unroll
                    for (int e = 0; e < 6; ++e) { const f32x4 w = *(const LAS f32x4*)(rtb + e * D + 256 * j + 4 * lane);
                        a0[e] += (v0[j].x * w.x + v0[j].y * w.y) + (v0[j].z * w.z + v0[j].w * w.w);
                        a1[e] += (v1[j].x * w.x + v1[j].y * w.y) + (v1[j].z * w.z + v1[j].w * w.w);
                        a2[e] += (v2[j].x * w.x + v2[j].y * w.y) + (v2[j].z * w.z + v2[j].w * w.w);
                        a3[e] += (v3[j].x * w.x + v3[j].y * w.y) + (v3[j].z * w.z + v3[j].w * w.w); }
#pragma unroll
                for (int e = 0; e < 6; ++e) { a0[e] = wsum64(a0[e]); a1[e] = wsum64(a1[e]); a2[e] = wsum64(a2[e]); a3[e] = wsum64(a3[e]); }
                if (lane == 0) {
#pragma unroll
                    for (int e = 0; e < 6; ++e) { lg[ec * 6 + e] = a0[e]; lg[64 + ec * 6 + e] = a1[e]; lg[128 + ec * 6 + e] = a2[e]; lg[192 + ec * 6 + e] = a3[e]; } }
            }
            LDS_WAIT();
            if (lane < 4 && !dry) { float aa[36];
#pragma unroll
                for (int e = 0; e < 36; ++e) aa[e] = lg[lane * 64 + e];
                route_token(r0 + lane, aa, args.in[26], args.in[28], cnt, ltok, lpair, pairw); }
            LDS_WAIT();
            ln_store(lane, v0, o32b + (size_t)r0 * D, o16b + (size_t)r0 * D); ln_store(lane, v1, o32b + (size_t)(r0 + 1) * D, o16b + (size_t)(r0 + 1) * D);
            ln_store(lane, v2, o32b + (size_t)(r0 + 2) * D, o16b + (size_t)(r0 + 2) * D); ln_store(lane, v3, o32b + (size_t)(r0 + 3) * D, o16b + (size_t)(r0 + 3) * D);
        }
        if (BOTH(5) && !dry) xcd_barrier(bar); else __syncthreads();
    }
    if (PROBE_K == 5) tk_ = __builtin_amdgcn_s_memrealtime();
    if (IN(6)) {
        build_moe_table(F, cnt);
        pg8::Gemm g{H1_16, GUT, 0, 0, D, D}; pg8::MoeOrder<true> S{(const LAS int*)(F.lds + TAB_OFF), ltok, F.vcu, F.G, 4, (size_t)1024 * D * 2, 0};
        pg8::EpiGU E{HID};
        for (int rep_ = 0; rep_ < REP_P6; ++rep_) pg8::gemm_phase<pg8::EpiGU, pg8::MoeOrder<true>, true>(F.lds + RING_OFF, g, S, E, F.wave);
        if (BOTH(6)) xcd_barrier(bar);
    }
    if (PROBE_K == 6) tk_ = __builtin_amdgcn_s_memrealtime();
    if (IN(7)) {
        build_moe_table(F, cnt);
        const pg8::Gemm gU{H1_16, GUT, 0, 0, D, D}; const pg8::Gemm gD{HID, DNT, 0, 0, 512, 512};
        const pg8::EpiGU EU{HID}; const pg8::EpiDown ED{FFN16, lpair};
        if (F.vcu < 64) { pg8::MoeOrder<true> S{(const LAS int*)(F.lds + TAB_OFF), ltok, F.vcu, 64, 4, (size_t)1024 * D * 2, 1};
            pg8::gemm_phase<pg8::EpiGU, pg8::MoeOrder<true>, true>(F.lds + RING_OFF, gU, S, EU, F.wave); }
        else { pg8::MoeOrder<false> S{(const LAS int*)(F.lds + TAB_OFF), nullptr, F.vcu - 64, F.G - 64, 8, (size_t)D * 512 * 2, 0};
            pg8::gemm_phase<pg8::EpiDown, pg8::MoeOrder<false>, true>(F.lds + RING_OFF, gD, S, ED, F.wave); }
        xcd_barrier(bar);
        { pg8::MoeOrder<false> S{(const LAS int*)(F.lds + TAB_OFF), nullptr, F.vcu, F.G, 8, (size_t)D * 512 * 2, 1};
          pg8::gemm_phase<pg8::EpiDown, pg8::MoeOrder<false>, true>(F.lds + RING_OFF, gD, S, ED, F.wave); }
        if (BOTH(7)) xcd_barrier(bar);
    }
    if (PROBE_K == 7) tk_ = __builtin_amdgcn_s_memrealtime();
    if (IN(8)) for (int rep_ = 0; rep_ < REP_P8; ++rep_) {
        const bool dry = rep_ < REP_P8 - 1;
        float* o32b = dry ? (float*)(ws + WS_GUT) : args.out; f16_t* o16b = dry ? (f16_t*)(ws + WS_GUT + 64 * MiB) : Y16; float* rrs = dry ? (float*)(ws + WS_GUT + 100 * MiB) : ROWRS;
        typedef _Float16 h4_t __attribute__((ext_vector_type(4)));
        const int lane = FLANE;
        for (int m = gw; m < T; m += NGW) {
            f32x4 v[8]; const GAS f32x4* xr = (const GAS f32x4*)(args.out + (size_t)m * D) + lane;
            const GAS h4_t* f0 = (const GAS h4_t*)(FFN16 + (size_t)(2 * m) * D) + lane; const GAS h4_t* f1 = (const GAS h4_t*)(FFN16 + (size_t)(2 * m + 1) * D) + lane;
            const GAS h4_t* pr = (const GAS h4_t*)(PW16 + (size_t)m * D) + lane;
            const float w0 = pairw[2 * m], w1 = pairw[2 * m + 1]; float q = 0.f;
#pragma unroll
            for (int j = 0; j < 8; ++j) { const f32x4 x = xr[64 * j]; const h4_t a = f0[64 * j], c = f1[64 * j], pv = pr[64 * j];
                v[j].x = ALPHA * x.x + w0 * (float)a[0] + w1 * (float)c[0]; v[j].y = ALPHA * x.y + w0 * (float)a[1] + w1 * (float)c[1];
                v[j].z = ALPHA * x.z + w0 * (float)a[2] + w1 * (float)c[2]; v[j].w = ALPHA * x.w + w0 * (float)a[3] + w1 * (float)c[3];
                q += ((float)pv[0] * (float)pv[0] + (float)pv[1] * (float)pv[1]) + ((float)pv[2] * (float)pv[2] + (float)pv[3] * (float)pv[3]); }
            ln_regs(lane, v, args.in[32], args.in[33], o32b + (size_t)m * D, o16b + (size_t)m * D);
            q = wave_sum_b(q);
            if (lane == 0) rrs[m] = __builtin_amdgcn_rsqf(q * (1.f / D) + LN_EPS);
        }
        if (BOTH(8) && !dry) xcd_barrier(bar); else __syncthreads();
    }
    if (PROBE_K == 8) tk_ = __builtin_amdgcn_s_memrealtime();
    if (IN(9)) {
        pg8::Gemm g{Y16, GateT, T, D, D, D}; pg8::StaticOrder S; S.init(T, D, F.G, (int)blockIdx.x);
        pg8::EpiFinal E{args.out, D, PW16, ROWRS, args.in[35]};
        pg8::gemm_phase<pg8::EpiFinal, pg8::StaticOrder, true>(F.lds + RING_OFF, g, S, E, F.wave);
    }
    if (PROBE_K != -1) {
        if (PROBE_K == 9) tk_ = __builtin_amdgcn_s_memrealtime();
        xcd_barrier(bar);
        if (blockIdx.x == 0 && FTID == 0) args.out[0] += (PROBE_K == -2) ? 100000.f : (float)(tk_ - t0_);
    }
#undef IN
#undef BOTH
}

extern "C" void kernel_launch(void* const* d_in, const int* in_sizes, int n_in, void* d_out, int out_size, void* d_ws, size_t ws_size, hipStream_t stream) {
    static int grid = 0;
    if (grid == 0) {
        if (ws_size < WS_END2 || n_in != 37 || out_size != T * D) { fprintf(stderr, "kernel_launch: bad ws/n_in/out: %zu %d %d\n", ws_size, n_in, out_size); grid = -1; return; }
        int dev = 0, cus = 0;
        if (hipGetDevice(&dev) != hipSuccess || hipDeviceGetAttribute(&cus, hipDeviceAttributeMultiprocessorCount, dev) != hipSuccess) { grid = -1; return; }
        if (hipFuncSetAttribute((const void*)mega_fwd, hipFuncAttributeMaxDynamicSharedMemorySize, LDS_BYTES) != hipSuccess) { fprintf(stderr, "kernel_launch: hipFuncSetAttribute failed\n"); grid = -1; return; }
        if (cus != 256) { fprintf(stderr, "kernel_launch: built for a 256-CU device, found %d\n", cus); grid = -1; return; }
        grid = cus;
    }
    if (grid < 0) return;
    (void)hipMemsetAsync(d_ws, 0, CTL_ZERO_BYTES, stream);
    Args a{}; for (int i = 0; i < 37; ++i) a.in[i] = (const float*)d_in[i]; a.out = (float*)d_out; a.ws = (unsigned char*)d_ws; a.ph_lo = 0; a.ph_hi = 10; a.li = 0;
    hipLaunchKernelGGL(mega_fwd, dim3(grid), dim3(NWAVES * 64), LDS_BYTES, stream, a);
}
```

```cpp
#include <hip/hip_runtime.h>
#include <cstdio>
#include <cstdint>
#include <cmath>

constexpr int NB = 4, S = 2048, D = 2048, T = NB * S;
constexpr int NPROJ = 6432;
constexpr int RWK = 1024;
constexpr int COL_Q = 0, COL_K = 1024, COL_V = 2048, COL_RW = 3072;
constexpr int NH = 8, NRH = 16;
constexpr int NE = 32;
constexpr float LN_EPS = 1e-5f;
constexpr float ALPHA = 1.189207115002721f;
constexpr float LAMBDA_INIT = 0.2f;

constexpr size_t MiB = 1u << 20;
constexpr size_t WS_CNT = 0;
constexpr size_t WS_LTOK = 1 * MiB;
constexpr size_t WS_LPAIR = 2 * MiB;
constexpr size_t WS_PAIRW = 3 * MiB;
constexpr size_t WS_RT = 3 * MiB + 128 * 1024;
constexpr size_t WS_LAM = 3 * MiB + 512 * 1024;
constexpr size_t WS_BIAS = 3 * MiB + 512 * 1024 + 1024;
constexpr size_t WS_ROWRS = 3 * MiB + 768 * 1024;
constexpr size_t WS_WINT = 4 * MiB;
constexpr size_t WS_WOUTT = 30 * MiB;
constexpr size_t WS_GATET = 38 * MiB;
constexpr size_t WS_PLET = 46 * MiB;
constexpr size_t WS_P16 = 47 * MiB;
constexpr size_t WS_W2T = 51 * MiB;
constexpr size_t WS_A2T = 51 * MiB + 128 * 1024;
constexpr size_t WS_G2T = 51 * MiB + 256 * 1024;
constexpr size_t WS_CHK = 52 * MiB;
constexpr size_t WS_BONUS = 148 * MiB;
constexpr size_t WS_LSLAB = 150 * MiB;
constexpr size_t WS_GUT = 348 * MiB;
constexpr size_t WS_DNT = 150 * MiB;
constexpr size_t WS_PROJ16 = 244 * MiB;
constexpr size_t WS_FFN16 = 52 * MiB;
constexpr size_t WS_HID = 116 * MiB;
constexpr size_t WS_DECAY = 348 * MiB;
constexpr size_t WS_KMOD = 380 * MiB;
constexpr size_t WS_A16 = 396 * MiB;
constexpr size_t WS_B16 = 412 * MiB;
constexpr size_t WS_G16 = 214 * MiB;
constexpr size_t WS_H16 = 444 * MiB;
constexpr size_t WS_H1_16 = 244 * MiB;
constexpr size_t WS_Y16 = 476 * MiB;
constexpr size_t WS_PW16 = 508 * MiB;
constexpr size_t WS_END2 = 540 * MiB;

namespace pg8 {
#define PG8_LAS __attribute__((address_space(3)))
typedef unsigned short f16_t;
typedef _Float16 f16x8 __attribute__((ext_vector_type(8)));
typedef float f32x4 __attribute__((ext_vector_type(4)));
typedef unsigned u32x4 __attribute__((ext_vector_type(4)));
constexpr int BM = 256, BK = 64, HALF = 128, HTB = HALF * BK * 2  , STAGE_BYTES = 8 * HTB, NXCD = 8, WGM = 8;

__host__ __device__ __forceinline__ int lds_byte(int r, int c) { const int st = (r >> 4) * 2 + (c >> 5), rr = r & 15, cc = c & 31, ob = rr * 64 + cc * 2; return st * 1024 + (ob ^ (((ob >> 9) & 1) << 5)); }
__host__ __device__ __forceinline__ void stage_rc(int b, int& R, int& C) { const int st = b / 1024, sb = b % 1024, swz = sb ^ (((sb >> 9) & 1) << 5); R = (st >> 1) * 16 + swz / 64; C = (st & 1) * 32 + (swz % 64) / 2; }
__host__ __device__ __forceinline__ int perm32(int rho) { const int n = rho >> 4, i = rho & 15; return 8 * (i >> 2) + 4 * n + (i & 3); }

__device__ __forceinline__ int lane_id() { int l; asm volatile("v_mbcnt_lo_u32_b32 %0, -1, 0\n\tv_mbcnt_hi_u32_b32 %0, -1, %0" : "=v"(l)); return l; }
struct Unit { int pm, pn, e, rb, cnt; };
struct Gemm { const f16_t* A; const f16_t* Bt; int M, N, K, ld; };

struct StaticOrder {
    int nM, nN, nwg, G, c;
    __host__ __device__ void init(int M, int N, int G_, int c_) { nM = M / BM; nN = N / BM; nwg = nM * nN; G = G_; c = c_; }
    __host__ __device__ bool next(int i, Unit& u) const {
        const long L = (long)i * G + c; if (L >= nwg) return false;
        int wgid = (int)L; { const int q = nwg / NXCD, r = nwg % NXCD, xcd = wgid % NXCD, off = wgid / NXCD; wgid = (xcd < r ? xcd * (q + 1) : r * (q + 1) + (xcd - r) * q) + off; }
        const int nig = WGM * nN, gid = wgid / nig, fm = gid * WGM, gsz = (nM - fm) < WGM ? (nM - fm) : WGM;
        u.pm = fm + ((wgid % nig) % gsz); u.pn = (wgid % nig) / gsz; return true;
    }
    __device__ __forceinline__ void a_ready(const Unit&) const {}
    __device__ __forceinline__ void done(const Unit&) const {}
    __device__ __forceinline__ const char* a_base(const Gemm& g, const Unit& u) const { return (const char*)g.A + (size_t)u.pm * ((size_t)BM * g.ld * 2); }
    __device__ __forceinline__ const char* b_base(const Gemm& g, const Unit& u) const { return (const char*)g.Bt + (size_t)u.pn * ((size_t)BM * g.ld * 2); }
    __device__ __forceinline__ void a_voff(const Gemm& g, const Unit&, int tid, unsigned (&va)[2][2]) const {
#pragma unroll
        for (int i = 0; i < 2; ++i) { int R, C; stage_rc(tid * 16 + i * 8192, R, C); va[0][i] = (unsigned)(R * g.ld + C) * 2u; va[1][i] = va[0][i] + (unsigned)(HALF * g.ld * 2); }
    }
};
struct SplitKOrder {
    int nM, nN, nks, G, c;
    __device__ __forceinline__ bool next(int i, Unit& u) const { const int L = i * G + c; if (L >= nM * nN * nks) return false; u.e = L / (nM * nN); const int rem = L % (nM * nN); u.pn = rem / nM; u.pm = rem % nM; u.rb = 0; u.cnt = 0; return true; }
    __device__ __forceinline__ void a_ready(const Unit&) const {}
    __device__ __forceinline__ void done(const Unit&) const {}
    __device__ __forceinline__ const char* a_base(const Gemm& g, const Unit& u) const { return (const char*)g.A + (size_t)u.pm * ((size_t)BM * g.ld * 2) + (size_t)u.e * g.K * 2; }
    __device__ __forceinline__ const char* b_base(const Gemm& g, const Unit& u) const { return (const char*)g.Bt + (size_t)u.pn * ((size_t)BM * g.ld * 2) + (size_t)u.e * g.K * 2; }
    __device__ __forceinline__ void a_voff(const Gemm& g, const Unit&, int tid, unsigned (&va)[2][2]) const {
#pragma unroll
        for (int i = 0; i < 2; ++i) { int R, C; stage_rc(tid * 16 + i * 8192, R, C); va[0][i] = (unsigned)(R * g.ld + C) * 2u; va[1][i] = va[0][i] + (unsigned)(HALF * g.ld * 2); }
    }
};
template <bool GATHER> struct MoeOrder {
    const PG8_LAS int* tab; const int* list; int vcu, G, ntn; size_t estride; int cls;
    __device__ __forceinline__ bool next(int i, Unit& u) const {
        const int L = vcu + i * G; const int base = cls ? 98 : 65; const int tot = tab[base + 32] * ntn; if (L >= tot) return false;
        int e = 0; while (tab[base + 1 + e] * ntn <= L) ++e;
        const int nbk = tab[base + 1 + e] - tab[base + e], q = L - tab[base + e] * ntn; const int rb = q % nbk + (cls ? 2 : 0);
        u.e = __builtin_amdgcn_readfirstlane(e); u.pn = __builtin_amdgcn_readfirstlane(q / nbk); u.rb = __builtin_amdgcn_readfirstlane(rb);
        u.pm = __builtin_amdgcn_readfirstlane(tab[32 + e] + rb); u.cnt = __builtin_amdgcn_readfirstlane(tab[e]); return true;
    }
    __device__ __forceinline__ void a_ready(const Unit&) const {}
    __device__ __forceinline__ void done(const Unit&) const {}
    __device__ __forceinline__ const char* a_base(const Gemm& g, const Unit& u) const { return GATHER ? (const char*)g.A : (const char*)g.A + (size_t)u.pm * ((size_t)BM * g.ld * 2); }
    __device__ __forceinline__ const char* b_base(const Gemm& g, const Unit& u) const { return (const char*)g.Bt + (size_t)u.e * estride + (size_t)u.pn * ((size_t)BM * g.ld * 2); }
    __device__ __forceinline__ void a_voff(const Gemm& g, const Unit& u, int tid, unsigned (&va)[2][2]) const {
#pragma unroll
        for (int i = 0; i < 2; ++i) { int R, C; stage_rc(tid * 16 + i * 8192, R, C);
            if (GATHER) {
#pragma unroll
                for (int h = 0; h < 2; ++h) { int idx = u.rb * BM + h * HALF + R; idx = idx < u.cnt ? idx : u.cnt - 1; const int tok = list[u.e * 8192 + idx]; va[h][i] = (unsigned)(tok * g.ld + C) * 2u; }
            } else { va[0][i] = (unsigned)(R * g.ld + C) * 2u; va[1][i] = va[0][i] + (unsigned)(HALF * g.ld * 2); } }
    }
};


typedef _Float16 h2_t __attribute__((ext_vector_type(2)));
__device__ __forceinline__ unsigned cvt_pk_f16(float lo, float hi) { h2_t v = {(_Float16)lo, (_Float16)hi}; return __builtin_bit_cast(unsigned, v); }
struct EpiF16 {
    static constexpr bool PERM = true, AFTER_DRAIN = false;
    f16_t* O; int ldc; int ntile0; float scale0;
    __device__ __forceinline__ void operator()(const f32x4 (&acc)[2][2][4][2], const Unit& u, int wr, int wc, int fr, int fq) const {
        const int row0 = u.pm * BM + wr * 64 + fr; const int col0 = u.pn * BM + wc * 32 + 8 * fq;
        const float sc = (u.pn < ntile0) ? scale0 : 1.f;
#pragma unroll
        for (int ai = 0; ai < 2; ++ai)
#pragma unroll
            for (int m = 0; m < 4; ++m) { f16_t* rowp = O + (size_t)(row0 + ai * HALF + m * 16) * ldc + col0;
#pragma unroll
                for (int bj = 0; bj < 2; ++bj) { f32x4 v0 = acc[ai][bj][m][0] * sc, v1 = acc[ai][bj][m][1] * sc;
                    u32x4 w; w.x = cvt_pk_f16(v0[0], v0[1]); w.y = cvt_pk_f16(v0[2], v0[3]); w.z = cvt_pk_f16(v1[0], v1[1]); w.w = cvt_pk_f16(v1[2], v1[3]);
                    *(u32x4*)(rowp + bj * HALF) = w; } }
    }
};


struct EpiSlab {
    static constexpr bool PERM = true, AFTER_DRAIN = false;
    f16_t* O; int ldc; size_t slab;
    __device__ __forceinline__ void operator()(const f32x4 (&acc)[2][2][4][2], const Unit& u, int wr, int wc, int fr, int fq) const {
        const int row0 = u.pm * BM + wr * 64 + fr; const int col0 = u.pn * BM + wc * 32 + 8 * fq; f16_t* Ob = O + (size_t)u.e * slab;
#pragma unroll
        for (int ai = 0; ai < 2; ++ai)
#pragma unroll
            for (int m = 0; m < 4; ++m) { f16_t* rowp = Ob + (size_t)(row0 + ai * HALF + m * 16) * ldc + col0;
#pragma unroll
                for (int bj = 0; bj < 2; ++bj) { const f32x4 v0 = acc[ai][bj][m][0], v1 = acc[ai][bj][m][1];
                    u32x4 w; w.x = cvt_pk_f16(v0[0], v0[1]); w.y = cvt_pk_f16(v0[2], v0[3]); w.z = cvt_pk_f16(v1[0], v1[1]); w.w = cvt_pk_f16(v1[2], v1[3]);
                    *(u32x4*)(rowp + bj * HALF) = w; } }
    }
};
struct EpiResF32 {
    static constexpr bool PERM = false, AFTER_DRAIN = false;
    float* io; int ldc; float alpha;
    __device__ __forceinline__ void operator()(const f32x4 (&acc)[2][2][4][2], const Unit& u, int wr, int wc, int fr, int fq) const {
        const int row0 = u.pm * BM + wr * 64 + fr; const int col0 = u.pn * BM + wc * 32 + 4 * fq;
#pragma unroll
        for (int ai = 0; ai < 2; ++ai)
#pragma unroll
            for (int m = 0; m < 4; ++m) { float* rowp = io + (size_t)(row0 + ai * HALF + m * 16) * ldc + col0;
#pragma unroll
                for (int bj = 0; bj < 2; ++bj)
#pragma unroll
                    for (int n = 0; n < 2; ++n) { f32x4* p = (f32x4*)(rowp + bj * HALF + n * 16); const f32x4 r = *p; *p = r * alpha + acc[ai][bj][m][n]; } }
    }
};
struct EpiFinal {
    static constexpr bool PERM = false, AFTER_DRAIN = false;
    float* io; int ldc; const f16_t* pw; const float* rowrs; const float* g;
    __device__ __forceinline__ void operator()(const f32x4 (&acc)[2][2][4][2], const Unit& u, int wr, int wc, int fr, int fq) const {
        typedef _Float16 h4_t __attribute__((ext_vector_type(4)));
        const int row0 = u.pm * BM + wr * 64 + fr; const int col0 = u.pn * BM + wc * 32 + 4 * fq;
#pragma unroll
        for (int ai = 0; ai < 2; ++ai)
#pragma unroll
            for (int m = 0; m < 4; ++m) { const int row = row0 + ai * HALF + m * 16; const size_t off = (size_t)row * ldc + col0;
                const float rs = rowrs[row];
#pragma unroll
                for (int bj = 0; bj < 2; ++bj)
#pragma unroll
                    for (int n = 0; n < 2; ++n) { f32x4* p = (f32x4*)(io + off + bj * HALF + n * 16); const f32x4 hv = *p; const h4_t pv = *(const h4_t*)(pw + off + bj * HALF + n * 16);
                        const f32x4 gv = *(const f32x4*)(g + col0 + bj * HALF + n * 16);
                        const f32x4 a = acc[ai][bj][m][n]; f32x4 o;
#pragma unroll
                        for (int c = 0; c < 4; ++c) o[c] = hv[c] + (1.f / (1.f + __expf(-a[c]))) * ((float)pv[c] * rs) * gv[c];
                        *p = o; }
                asm volatile("" ::: "memory"); }
    }
};

struct EpiGU {
    static constexpr bool PERM = true, AFTER_DRAIN = false;
    f16_t* O;
    __device__ __forceinline__ void operator()(const f32x4 (&acc)[2][2][4][2], const Unit& u, int wr, int wc, int fr, int fq) const {
        const int row0 = u.pm * BM + wr * 64 + fr; const int col0 = u.pn * HALF + wc * 32 + 8 * fq;
#pragma unroll
        for (int ai = 0; ai < 2; ++ai)
#pragma unroll
            for (int m = 0; m < 4; ++m) { f16_t* rowp = O + (size_t)(row0 + ai * HALF + m * 16) * 512 + col0; float o[8];
#pragma unroll
                for (int n = 0; n < 2; ++n)
#pragma unroll
                    for (int c = 0; c < 4; ++c) { const float gt = acc[ai][0][m][n][c], up = acc[ai][1][m][n][c]; o[n * 4 + c] = gt / (1.f + __expf(-gt)) * up; }
                u32x4 w; w.x = cvt_pk_f16(o[0], o[1]); w.y = cvt_pk_f16(o[2], o[3]); w.z = cvt_pk_f16(o[4], o[5]); w.w = cvt_pk_f16(o[6], o[7]);
                *(u32x4*)rowp = w; }
    }
};
struct EpiDown {
    static constexpr bool PERM = true, AFTER_DRAIN = false;
    f16_t* O; const int* lpair;
    __device__ __forceinline__ void operator()(const f32x4 (&acc)[2][2][4][2], const Unit& u, int wr, int wc, int fr, int fq) const {
        const int r0 = u.rb * BM + wr * 64 + fr; const int col0 = u.pn * BM + wc * 32 + 8 * fq;
#pragma unroll
        for (int ai = 0; ai < 2; ++ai)
#pragma unroll
            for (int m = 0; m < 4; ++m) { const int r = r0 + ai * HALF + m * 16;
                if (r < u.cnt) { const int pair = lpair[u.e * 8192 + r]; f16_t* rowp = O + (size_t)pair * 2048 + col0;
#pragma unroll
                    for (int bj = 0; bj < 2; ++bj) { const f32x4 v0 = acc[ai][bj][m][0], v1 = acc[ai][bj][m][1];
                        u32x4 w; w.x = cvt_pk_f16(v0[0], v0[1]); w.y = cvt_pk_f16(v0[2], v0[3]); w.z = cvt_pk_f16(v1[0], v1[1]); w.w = cvt_pk_f16(v1[2], v1[3]);
                        *(u32x4*)(rowp + bj * HALF) = w; } } }
    }
};
template <class Epi, class Sched, bool ALIGN_EPI = false, bool SP2 = true>
__device__ __forceinline__ void gemm_phase(PG8_LAS unsigned char* lds, const Gemm g, const Sched& S, const Epi& E, const int wid) {
    static_assert(SP2, "only the SP2 K-loop is kept in this file");
    const int lane = lane_id(), tid = wid * 64 + lane, wr = wid >> 2, wc = wid & 3, fr = lane & 15, fq = lane >> 4;
    const int K = g.ld, nt = g.K / BK;
    unsigned voffB[2];
#pragma unroll
    for (int i = 0; i < 2; ++i) { int R, C; stage_rc(tid * 16 + i * 8192, R, C); const int Rb = Epi::PERM ? ((R & ~31) + perm32(R & 31)) : R;
        voffB[i] = (unsigned)(Rb * K + C) * 2u; }
    const size_t kstep = (size_t)(BK * 2);
    const size_t hstep = (size_t)HALF * K * 2;
    const unsigned ldsw = (unsigned)wid * 1024u;
    const int aoff = lds_byte(wr * 64 + fr, fq * 8), boff = lds_byte(wc * 32 + fr, fq * 8);
#define PG8_SA(b, h) (((b) * 2 + (h)) * HTB)
#define PG8_SB(b, h) ((4 + (b) * 2 + (h)) * HTB)
#define PG8_STAGE(bufoff, gbase, voff) do { _Pragma("unroll") for (int _i = 0; _i < 2; ++_i) \
        __builtin_amdgcn_global_load_lds((const unsigned*)((const char*)(gbase) + (voff)[_i]), (PG8_LAS unsigned*)(lds + (bufoff) + ldsw + _i * 8192), 16, 0, 0); } while (0)
#define PG8_LDA(dst, b, h) do { _Pragma("unroll") for (int m = 0; m < 4; ++m) _Pragma("unroll") for (int k = 0; k < 2; ++k) dst[m][k] = *(const PG8_LAS f16x8*)(lds + PG8_SA(b, h) + aoff + m * 2048 + k * 1024); } while (0)
#define PG8_LDB(dst, b, h) do { _Pragma("unroll") for (int n = 0; n < 2; ++n) _Pragma("unroll") for (int k = 0; k < 2; ++k) dst[n][k] = *(const PG8_LAS f16x8*)(lds + PG8_SB(b, h) + boff + n * 2048 + k * 1024); } while (0)
#define PG8_MMA(ai, bj, At, Bt) do { __builtin_amdgcn_s_setprio(1); _Pragma("unroll") for (int m = 0; m < 4; ++m) _Pragma("unroll") for (int n = 0; n < 2; ++n) _Pragma("unroll") for (int k = 0; k < 2; ++k) \
        acc[ai][bj][m][n] = __builtin_amdgcn_mfma_f32_16x16x32_f16(Bt[n][k], At[m][k], acc[ai][bj][m][n], 0, 0, 0); __builtin_amdgcn_s_setprio(0); } while (0)
#define PG8_WAIT_V(n) asm volatile("s_waitcnt vmcnt(" #n ")" ::: "memory")
#define PG8_WAIT_L(n) asm volatile("s_waitcnt lgkmcnt(" #n ")" ::: "memory")
#define PG8_BAR __builtin_amdgcn_s_barrier()
#define PG8_SCHED __builtin_amdgcn_sched_barrier(0)
    Unit cur, nxt; int ui = 0;
    if (!S.next(0, cur)) return;
    f32x4 acc[2][2][4][2];
#pragma unroll
    for (int a = 0; a < 2; ++a)
#pragma unroll
        for (int b = 0; b < 2; ++b)
#pragma unroll
            for (int m = 0; m < 4; ++m)
#pragma unroll
                for (int n = 0; n < 2; ++n) acc[a][b][m][n] = (f32x4){0.f, 0.f, 0.f, 0.f};
    f16x8 At[4][2], B0[2][2], B1[2][2];
    const char* cA = S.a_base(g, cur); const char* cB = S.b_base(g, cur);
    unsigned vaC[2][2];
    S.a_voff(g, cur, tid, vaC);
    S.a_ready(cur);
    PG8_STAGE(PG8_SB(0, 0), cB, voffB); PG8_STAGE(PG8_SB(0, 1), cB + hstep, voffB); PG8_STAGE(PG8_SA(0, 0), cA, vaC[0]); PG8_STAGE(PG8_SA(0, 1), cA, vaC[1]);
    if (wr == 1) PG8_BAR;
    PG8_WAIT_V(2); PG8_BAR;
    PG8_STAGE(PG8_SB(1, 0), cB + kstep, voffB); PG8_STAGE(PG8_SA(1, 0), cA + kstep, vaC[0]); PG8_STAGE(PG8_SB(1, 1), cB + hstep + kstep, voffB);
    PG8_WAIT_V(6); PG8_BAR;
    for (;;) {
        const bool has_next = S.next(ui + 1, nxt);
        const char* nA = has_next ? S.a_base(g, nxt) : cA; const char* nB = has_next ? S.b_base(g, nxt) : cB;
        for (int t = 0; t < nt; t += 2) {
            const bool last = (t == nt - 2);

            const char* a1 = cA + (size_t)(t + 1) * kstep;
            const char* a2 = last ? nA : cA + (size_t)(t + 2) * kstep; const char* b2 = last ? nB : cB + (size_t)(t + 2) * kstep;
            const char* a3 = a2 + kstep; const char* b3 = b2 + kstep;
            if (last && has_next) S.a_ready(nxt);
            PG8_LDB(B0, 0, 0); PG8_LDB(B1, 0, 1); PG8_SCHED; PG8_LDA(At, 0, 0); PG8_STAGE(PG8_SA(1, 1), a1, vaC[1]);
            if (last && has_next) S.a_voff(g, nxt, wid * 64 + lane_id(), vaC);
            PG8_WAIT_V(8); PG8_WAIT_L(0); PG8_BAR; PG8_MMA(0, 0, At, B0); PG8_MMA(0, 1, At, B1); PG8_BAR; PG8_SCHED;
            PG8_LDA(At, 0, 1); PG8_STAGE(PG8_SB(0, 0), b2, voffB); PG8_STAGE(PG8_SB(0, 1), b2 + hstep, voffB); PG8_STAGE(PG8_SA(0, 0), a2, vaC[0]);
            PG8_WAIT_V(8); PG8_WAIT_L(0); PG8_BAR; PG8_MMA(1, 0, At, B0); PG8_MMA(1, 1, At, B1); PG8_BAR; PG8_SCHED;
            PG8_LDB(B0, 1, 0); PG8_LDB(B1, 1, 1); PG8_SCHED; PG8_LDA(At, 1, 0); PG8_STAGE(PG8_SA(0, 1), a2, vaC[1]);
            PG8_WAIT_V(8); PG8_WAIT_L(0); PG8_BAR; PG8_MMA(0, 0, At, B0); PG8_MMA(0, 1, At, B1); PG8_BAR; PG8_SCHED;
            PG8_LDA(At, 1, 1); PG8_STAGE(PG8_SB(1, 0), b3, voffB); PG8_STAGE(PG8_SB(1, 1), b3 + hstep, voffB); PG8_STAGE(PG8_SA(1, 0), a3, vaC[0]);
            PG8_WAIT_V(8); PG8_WAIT_L(0); PG8_BAR; PG8_MMA(1, 0, At, B0); PG8_MMA(1, 1, At, B1); PG8_BAR; PG8_SCHED;
        }
        if constexpr (ALIGN_EPI) { if (wr == 0) PG8_BAR; }
        { const int l2 = lane_id(); E(acc, cur, wr, wc, l2 & 15, l2 >> 4); } S.done(cur);
        if (!has_next) break;
#pragma unroll
        for (int a = 0; a < 2; ++a)
#pragma unroll
            for (int b = 0; b < 2; ++b)
#pragma unroll
                for (int m = 0; m < 4; ++m)
#pragma unroll
                    for (int n = 0; n < 2; ++n) acc[a][b][m][n] = (f32x4){0.f, 0.f, 0.f, 0.f};
        cur = nxt; cA = nA; cB = nB; ++ui;
        if constexpr (ALIGN_EPI) { if (wr == 1) PG8_BAR; }
    }
    PG8_WAIT_V(0);
    if constexpr (!ALIGN_EPI) { if (wr == 0) PG8_BAR; }
    PG8_BAR;
#undef PG8_SA
#undef PG8_SB
#undef PG8_STAGE
#undef PG8_LDA
#undef PG8_LDB
#undef PG8_MMA
#undef PG8_WAIT_V
#undef PG8_WAIT_L
#undef PG8_BAR
#undef PG8_SCHED
}
}

constexpr int PN = 6656;
namespace att {
#define ALAS __attribute__((address_space(3)))
typedef _Float16 f16x8 __attribute__((ext_vector_type(8)));
typedef float f32x16 __attribute__((ext_vector_type(16)));
typedef short v4i16_t __attribute__((ext_vector_type(4)));
typedef unsigned u32x4 __attribute__((ext_vector_type(4)));
constexpr int SLOT = 16384, L_K = 0, L_V = 3 * SLOT, L_SCR = 6 * SLOT, L_TAB = L_SCR + 2048, L_END = L_TAB + 1024;
constexpr int L_XB = 0, L_STG = 65536;
constexpr float LOG2E = 1.4426950408889634f;
constexpr float C2 = 0.125f * LOG2E;
__device__ __forceinline__ int crow(int r, int hi) { return (r & 3) + 8 * (r >> 2) + 4 * hi; }
__device__ __forceinline__ void glds16(const void* g, ALAS unsigned char* l) { __builtin_amdgcn_global_load_lds((const unsigned*)g, (ALAS unsigned*)l, 16, 0, 0); }
__device__ __forceinline__ float xhalf(float v, int hi) { auto rr = __builtin_amdgcn_permlane32_swap(__float_as_uint(v), __float_as_uint(v), false, false); return hi ? __uint_as_float(rr[0]) : __uint_as_float(rr[1]); }
__device__ __forceinline__ unsigned pkh(float lo, float hi) { typedef _Float16 h2 __attribute__((ext_vector_type(2))); h2 v = {(_Float16)lo, (_Float16)hi}; return __builtin_bit_cast(unsigned, v); }
__device__ __forceinline__ v4i16_t vtr(const ALAS unsigned char* p) { return __builtin_amdgcn_ds_read_tr16_b64_v4i16((ALAS v4i16_t*)p); }

template <int THR>
__device__ __forceinline__ void attn_unit(ALAS unsigned char* lds, const int wave, const int b, const int h, const int qb, const unsigned short* PROJ, unsigned short* Y,
                                          const float* biasG, const float lam, const float* subln_g) {
    const int lane = pg8::lane_id(), r32 = lane & 31, hi = lane >> 5;
    const int c = wave >> 2, w4 = wave & 3;
    const int q0 = qb * 128, qw0 = q0 + 32 * w4, q = qw0 + r32;
    const size_t rowbase = (size_t)b * S;
    { ALAS float* tabL = (ALAS float*)(lds + L_TAB); const int tid = wave * 64 + lane; if (tid < 129) tabL[tid] = biasG[tid] * LOG2E; }
    f16x8 qf[4];
    { const unsigned short* Qp = PROJ + (rowbase + q) * PN + h * 128 + c * 64 + hi * 8;
#pragma unroll
      for (int d0 = 0; d0 < 4; ++d0) qf[d0] = *(const f16x8*)(Qp + d0 * 16); }
    const int krow0 = 8 * wave + (lane >> 4), krow1 = krow0 + 4;
    const unsigned short* ksrc0 = PROJ + (rowbase + krow0) * PN + 1024 + h * 128 + (((lane & 15) ^ (krow0 & 15)) * 8);
    const unsigned short* ksrc1 = PROJ + (rowbase + krow1) * PN + 1024 + h * 128 + (((lane & 15) ^ (krow1 & 15)) * 8);
    const unsigned short* vsrc0 = PROJ + (rowbase + 16 * ((2 * wave) & 3) + (lane >> 2)) * PN + 2048 + h * 128 + 32 * ((2 * wave) >> 2) + (lane & 3) * 8;
    ALAS unsigned char* kdst = lds + L_K + (2 * wave) * 1024; ALAS unsigned char* vdst = lds + L_V + (2 * wave) * 1024;
#define ATT_ISSUE(t, slot) do { const size_t go_ = (size_t)(t) * 64 * PN; \
        glds16(ksrc0 + go_, kdst + (slot) * SLOT); glds16(ksrc1 + go_, kdst + (slot) * SLOT + 1024); \
        glds16(vsrc0 + go_, vdst + (slot) * SLOT); glds16(vsrc0 + go_ + (size_t)16 * PN, vdst + (slot) * SLOT + 1024); } while (0)
    const int NT = (q0 + 128) / 64;
    ATT_ISSUE(0, 0); ATT_ISSUE(1, 1);
    ALAS float* wsf = (ALAS float*)(lds + L_SCR) + wave * 64;
    const ALAS float* tabL = (const ALAS float*)(lds + L_TAB);
    const float bfar = biasG[128] * LOG2E;
    float mhat = 0.f, l = 0.f;
    f32x16 o[4];
#pragma unroll
    for (int d = 0; d < 4; ++d)
#pragma unroll
        for (int r = 0; r < 16; ++r) o[d][r] = 0.f;
    f32x16 negm;
#pragma unroll
    for (int r = 0; r < 16; ++r) negm[r] = bfar;
    int slot = 0;
    for (int t = 0; t < NT; ++t) {
        if (t + 1 < NT) asm volatile("s_waitcnt vmcnt(4)" ::: "memory"); else asm volatile("s_waitcnt vmcnt(0)" ::: "memory");
        __builtin_amdgcn_s_barrier();
        asm volatile("" ::: "memory");
        if (t + 2 < NT) { const int s2 = slot == 0 ? 2 : slot - 1; ATT_ISSUE(t + 2, s2); }
        const int k0 = t * 64;
        if (k0 <= qw0 + 31) {
            const ALAS unsigned char* Ks = lds + L_K + slot * SLOT + r32 * 256;
            const int kx = r32 & 15, kc0 = 8 * c + hi;
            const int ko[4] = {((kc0 + 0) ^ kx) << 4, ((kc0 + 2) ^ kx) << 4, ((kc0 + 4) ^ kx) << 4, ((kc0 + 6) ^ kx) << 4};
            const ALAS unsigned char* Vs = lds + L_V + slot * SLOT + (4 * hi + ((lane & 15) >> 2)) * 64 + ((lane >> 4) & 1) * 32 + (lane & 3) * 8;
            f32x16 p0, p1;
            const bool nearb = (k0 + 63 + 128 > qw0);
            if (nearb) {
                f32x16 c0, c1;
#pragma unroll
                for (int r = 0; r < 16; ++r) { int rel = q - (k0 + crow(r, hi)); int i0 = rel < 0 ? 0 : (rel > 128 ? 128 : rel); int rel1 = rel - 32; int i1 = rel1 < 0 ? 0 : (rel1 > 128 ? 128 : rel1);
                    c0[r] = tabL[i0] - mhat; c1[r] = tabL[i1] - mhat; }
#pragma unroll
                for (int d0 = 0; d0 < 4; ++d0) { const f16x8 a0 = *(const ALAS f16x8*)(Ks + ko[d0]), a1 = *(const ALAS f16x8*)(Ks + ko[d0] + 8192);
                    p0 = __builtin_amdgcn_mfma_f32_32x32x16_f16(a0, qf[d0], d0 == 0 ? c0 : p0, 0, 0, 0); p1 = __builtin_amdgcn_mfma_f32_32x32x16_f16(a1, qf[d0], d0 == 0 ? c1 : p1, 0, 0, 0); }
                if (k0 + 63 > qw0) {
#pragma unroll
                    for (int r = 0; r < 16; ++r) { const int kv = k0 + crow(r, hi); if (kv > q) p0[r] = -INFINITY; if (kv + 32 > q) p1[r] = -INFINITY; }
                }
            } else {
#pragma unroll
                for (int d0 = 0; d0 < 4; ++d0) { const f16x8 a0 = *(const ALAS f16x8*)(Ks + ko[d0]), a1 = *(const ALAS f16x8*)(Ks + ko[d0] + 8192);
                    p0 = __builtin_amdgcn_mfma_f32_32x32x16_f16(a0, qf[d0], d0 == 0 ? negm : p0, 0, 0, 0); p1 = __builtin_amdgcn_mfma_f32_32x32x16_f16(a1, qf[d0], d0 == 0 ? negm : p1, 0, 0, 0); }
            }
            float rm = fmaxf(p0[0], p1[0]);
#pragma unroll
            for (int r = 1; r < 16; ++r) rm = fmaxf(rm, fmaxf(p0[r], p1[r]));
            rm = fmaxf(rm, xhalf(rm, hi));
            const bool first = (t == 0);
            if (first || __any(rm > (float)THR)) {
                const float dl = first ? rm : fmaxf(rm, 0.f);
                mhat += dl;
#pragma unroll
                for (int r = 0; r < 16; ++r) { p0[r] -= dl; p1[r] -= dl; }
#pragma unroll
                for (int r = 0; r < 16; ++r) negm[r] = bfar - mhat;
                if (!first) {
                    const float f = __builtin_amdgcn_exp2f(-dl); l *= f;
                    if (hi == 0) wsf[r32] = f;
                    asm volatile("s_waitcnt lgkmcnt(0)" ::: "memory");
#pragma unroll
                    for (int r = 0; r < 16; ++r) { const float fr_ = wsf[crow(r, hi)];
#pragma unroll
                        for (int d = 0; d < 4; ++d) o[d][r] *= fr_; }
                }
            }
            float sacc = 0.f;
#pragma unroll
            for (int r = 0; r < 16; ++r) { p0[r] = __builtin_amdgcn_exp2f(p0[r]); p1[r] = __builtin_amdgcn_exp2f(p1[r]); sacc += p0[r] + p1[r]; }
            l += sacc;
            u32x4 pw[4];
#pragma unroll
            for (int s = 0; s < 2; ++s) {
                pw[s] = (u32x4){pkh(p0[8 * s], p0[8 * s + 1]), pkh(p0[8 * s + 2], p0[8 * s + 3]), pkh(p0[8 * s + 4], p0[8 * s + 5]), pkh(p0[8 * s + 6], p0[8 * s + 7])};
                pw[2 + s] = (u32x4){pkh(p1[8 * s], p1[8 * s + 1]), pkh(p1[8 * s + 2], p1[8 * s + 3]), pkh(p1[8 * s + 4], p1[8 * s + 5]), pkh(p1[8 * s + 6], p1[8 * s + 7])};
            }
#pragma unroll
            for (int d = 0; d < 4; ++d) {
#pragma unroll
                for (int s = 0; s < 4; ++s) {
                    const v4i16_t lo = vtr(Vs + (d * 4 + s) * 1024), hi4 = vtr(Vs + (d * 4 + s) * 1024 + 512);
                    typedef short s16x8 __attribute__((ext_vector_type(8)));
                    const s16x8 bv = {lo[0], lo[1], lo[2], lo[3], hi4[0], hi4[1], hi4[2], hi4[3]};
                    o[d] = __builtin_amdgcn_mfma_f32_32x32x16_f16(__builtin_bit_cast(f16x8, pw[s]), __builtin_bit_cast(f16x8, bv), o[d], 0, 0, 0);
                }
            }
        }
        slot = slot == 2 ? 0 : slot + 1;
    }
#undef ATT_ISSUE
    l += xhalf(l, hi);
    if (hi == 0) wsf[r32] = 1.0f / l;
    asm volatile("s_waitcnt lgkmcnt(0)" ::: "memory");
#pragma unroll
    for (int r = 0; r < 16; ++r) { const float f = wsf[crow(r, hi)];
#pragma unroll
        for (int d = 0; d < 4; ++d) o[d][r] *= f; }
    asm volatile("s_waitcnt lgkmcnt(0)" ::: "memory"); __builtin_amdgcn_s_barrier(); asm volatile("" ::: "memory");
    ALAS float* xb = (ALAS float*)(lds + L_XB) + w4 * 4096 + lane;
    if (c == 1) {
#pragma unroll
        for (int d = 0; d < 4; ++d)
#pragma unroll
            for (int r = 0; r < 16; ++r) xb[(d * 16 + r) * 64] = o[d][r];
    }
    asm volatile("s_waitcnt lgkmcnt(0)" ::: "memory"); __builtin_amdgcn_s_barrier(); asm volatile("" ::: "memory");
    if (c == 0) {
        float sc[16];
#pragma unroll
        for (int r = 0; r < 16; ++r) { float ss = 0.f;
#pragma unroll
            for (int d = 0; d < 4; ++d) { o[d][r] -= lam * xb[(d * 16 + r) * 64]; ss += o[d][r] * o[d][r]; }
            ss += __shfl_xor(ss, 1); ss += __shfl_xor(ss, 2); ss += __shfl_xor(ss, 4); ss += __shfl_xor(ss, 8); ss += __shfl_xor(ss, 16);
            sc[r] = __builtin_amdgcn_rsqf(ss * (1.f / 128.f) + LN_EPS) * (1.f - LAMBDA_INIT); }
        ALAS _Float16* stg = (ALAS _Float16*)(lds + L_STG + w4 * 8192);
#pragma unroll
        for (int d = 0; d < 4; ++d) { const float gg = subln_g[32 * d + r32];
#pragma unroll
            for (int r = 0; r < 16; ++r) stg[crow(r, hi) * 128 + 32 * d + r32] = (_Float16)(o[d][r] * sc[r] * gg); }
        asm volatile("s_waitcnt lgkmcnt(0)" ::: "memory");
        unsigned short* Yw = Y + (rowbase + qw0) * D + h * 128;
#pragma unroll
        for (int i = 0; i < 8; ++i) { const int row = i * 4 + (lane >> 4), ch = lane & 15; const u32x4 v = *(const ALAS u32x4*)((const ALAS unsigned char*)stg + row * 256 + ch * 16);
            *(u32x4*)(Yw + (size_t)row * D + ch * 8) = v; }
    }
    asm volatile("s_waitcnt lgkmcnt(0)" ::: "memory"); __builtin_amdgcn_s_barrier(); asm volatile("" ::: "memory");
}
#undef ALAS
}

namespace rk {
#define RLAS __attribute__((address_space(3)))
#define RGAS __attribute__((address_space(1)))
typedef __bf16 bf16x8 __attribute__((ext_vector_type(8)));
typedef _Float16 f16x8 __attribute__((ext_vector_type(8)));
typedef float f32x16 __attribute__((ext_vector_type(16)));
typedef float f32x4 __attribute__((ext_vector_type(4)));
typedef unsigned u32x4 __attribute__((ext_vector_type(4)));
typedef unsigned short us8 __attribute__((ext_vector_type(8)));
constexpr int C = 32;
constexpr int TS = 144, CS = 80;
constexpr int O_AT = 0, O_RT = 4608, O_BT = 9216, O_KT = 13824;
constexpr int O_AAB = 0, O_AAK = 4608, O_ARB = 7168, O_ARK = 9728;
constexpr int O_PIMG = 0, O_QIMG = 8192;
constexpr int O_VT = 18432, O_KH = 23552, O_BH = 28672;
constexpr int O_X0 = 33792;
constexpr int O_RH = 50688;
constexpr int O_GAM = 55296;
constexpr int HALF_BYTES = 57344;
constexpr int CHK_BYTES = 24576, CK_P = 0, CK_Q = 8192, CK_G = 12288, CK_Y = 20480;
__device__ __forceinline__ int crow(int r, int hi) { return (r & 3) + 8 * (r >> 2) + 4 * hi; }
__device__ __forceinline__ unsigned pkb(float lo, float hi) { typedef float f2 __attribute__((ext_vector_type(2))); typedef __bf16 b2 __attribute__((ext_vector_type(2))); f2 v = {lo, hi}; b2 w = __builtin_convertvector(v, b2); return __builtin_bit_cast(unsigned, w); }
__device__ __forceinline__ unsigned pkh(float lo, float hi) { typedef _Float16 h2 __attribute__((ext_vector_type(2))); h2 v = {(_Float16)lo, (_Float16)hi}; return __builtin_bit_cast(unsigned, v); }
__device__ __forceinline__ float h2f(unsigned short u) { return (float)__builtin_bit_cast(_Float16, u); }
__device__ __forceinline__ unsigned short f2h(float f) { return __builtin_bit_cast(unsigned short, (_Float16)f); }
__device__ __forceinline__ float sum8(float x) {
    x += __builtin_bit_cast(float, __builtin_amdgcn_update_dpp(0, __builtin_bit_cast(int, x), 0xB1, 0xF, 0xF, true));
    x += __builtin_bit_cast(float, __builtin_amdgcn_update_dpp(0, __builtin_bit_cast(int, x), 0x4E, 0xF, 0xF, true));
    x += __builtin_bit_cast(float, __builtin_amdgcn_update_dpp(0, __builtin_bit_cast(int, x), 0x141, 0xF, 0xF, true));
    return x;
}
__device__ __forceinline__ int frag_pos(int m, int c) { return (((c >> 4) * 64 + m + 32 * ((c >> 2) & 1)) * 8) + ((c >> 3) & 1) * 4 + (c & 3); }

struct ChunkIn { f32x4 l0, l1; us8 a8, b8, k8, rc, rp, vc, vp; };
__device__ __forceinline__ void chunk_load(ChunkIn& in, int tglob, int pos, int chb, const unsigned char* ws) {
    const unsigned short* PROJ16 = (const unsigned short*)(ws + WS_PROJ16); const float* LW = (const float*)(ws + WS_DECAY); const unsigned short* KMOD = (const unsigned short*)(ws + WS_KMOD);
    const unsigned short* A16 = (const unsigned short*)(ws + WS_A16); const unsigned short* B16 = (const unsigned short*)(ws + WS_B16);
    in.l0 = *(const RGAS f32x4*)(LW + (size_t)tglob * RWK + chb); in.l1 = *(const RGAS f32x4*)(LW + (size_t)tglob * RWK + chb + 4);
    in.a8 = *(const RGAS us8*)(A16 + (size_t)tglob * RWK + chb); in.b8 = *(const RGAS us8*)(B16 + (size_t)tglob * RWK + chb); in.k8 = *(const RGAS us8*)(KMOD + (size_t)tglob * RWK + chb);
    const unsigned short* cur = PROJ16 + (size_t)tglob * PN + 3072 + chb;
    in.rc = *(const RGAS us8*)cur; in.vc = *(const RGAS us8*)(cur + 2048); in.rp = in.rc; in.vp = in.vc; if (pos > 0) { in.rp = *(const RGAS us8*)(cur - PN); in.vp = *(const RGAS us8*)(cur - PN + 2048); }
}
__device__ __forceinline__ void chunk_pair(RLAS unsigned char* lds, const int wave, const int tile, const int hA, ChunkIn& in, const bool has_next, const float* mu, const float* r_k, unsigned char* ws) {
    unsigned char* CHK = ws + WS_CHK; float* BONUS = (float*)(ws + WS_BONUS);
    const int lane = pg8::lane_id(), hf = wave >> 2, q = wave & 3, r32 = lane & 31, hi = lane >> 5;
    const int h = hA + hf;
    RLAS unsigned char* L = lds + hf * HALF_BYTES;
    const int t = q * 64 + lane;
    const int tok = t >> 3, c8 = (t & 7) * 8;
    const int tglob = tile * C + tok, pos = tglob & (S - 1), bidx = tglob >> 11;
    const int chb = h * 64 + c8;
    float lw[8], av[8], bv[8], kv[8], rv[8], vv[8];
    { lw[0] = in.l0.x; lw[1] = in.l0.y; lw[2] = in.l0.z; lw[3] = in.l0.w; lw[4] = in.l1.x; lw[5] = in.l1.y; lw[6] = in.l1.z; lw[7] = in.l1.w;
      const f32x4 m0 = *(const RGAS f32x4*)(mu + chb), m1 = *(const RGAS f32x4*)(mu + chb + 4), n0 = *(const RGAS f32x4*)(mu + 2048 + chb), n1 = *(const RGAS f32x4*)(mu + 2048 + chb + 4);
      const float mr[8] = {m0.x, m0.y, m0.z, m0.w, m1.x, m1.y, m1.z, m1.w}, mv[8] = {n0.x, n0.y, n0.z, n0.w, n1.x, n1.y, n1.z, n1.w};
#pragma unroll
      for (int i = 0; i < 8; ++i) { av[i] = h2f(in.a8[i]); bv[i] = h2f(in.b8[i]); kv[i] = h2f(in.k8[i]);
          const float rcf = h2f(in.rc[i]), rpf = pos > 0 ? h2f(in.rp[i]) : 0.f, vcf = h2f(in.vc[i]), vpf = pos > 0 ? h2f(in.vp[i]) : 0.f;
          rv[i] = rcf + (rpf - rcf) * mr[i]; vv[i] = vcf + (vpf - vcf) * mv[i]; } }
    { const f32x4 k0 = *(const RGAS f32x4*)(r_k + chb), k1 = *(const RGAS f32x4*)(r_k + chb + 4); const float rk8[8] = {k0.x, k0.y, k0.z, k0.w, k1.x, k1.y, k1.z, k1.w};
      float bs = 0.f;
#pragma unroll
      for (int i = 0; i < 8; ++i) bs += rv[i] * kv[i] * rk8[i];
      bs = sum8(bs); if ((t & 7) == 0) BONUS[(size_t)tglob * 16 + h] = bs; }
    RLAS float* lwL = (RLAS float*)(L + O_X0 + 64 * 132);
    __syncthreads();
#pragma unroll
    for (int i = 0; i < 8; ++i) lwL[tok * 65 + c8 + i] = lw[i];
    __syncthreads();
    { RLAS float* part = (RLAS float*)(L + O_GAM) + 64;
      const int ch = t & 63, seg = t >> 6; float sg = 0.f;
#pragma unroll
      for (int k = 0; k < 8; ++k) sg += lwL[(8 * seg + k) * 65 + ch];
      part[seg * 64 + ch] = sg;
      __syncthreads();
      float g = 0.f;
#pragma unroll
      for (int s2 = 0; s2 < 3; ++s2) if (s2 < seg) g += part[s2 * 64 + ch];
#pragma unroll
      for (int k = 0; k < 8; ++k) { g += lwL[(8 * seg + k) * 65 + ch]; lwL[(8 * seg + k) * 65 + ch] = g; } }
    __syncthreads();
    {
        float G[8], GL[8];
#pragma unroll
        for (int i = 0; i < 8; ++i) { G[i] = lwL[tok * 65 + c8 + i]; GL[i] = lwL[31 * 65 + c8 + i]; }
        float at[8], rt[8], bt[8], kt[8], bh[8], kh[8];
#pragma unroll
        for (int i = 0; i < 8; ++i) { const float eg = __expf(G[i]), eng = __expf(-G[i]), egm = __expf(G[i] - lw[i]), egl = __expf(GL[i] - G[i]);
            at[i] = av[i] * egm; rt[i] = rv[i] * eg; bt[i] = bv[i] * eng; kt[i] = kv[i] * eng; bh[i] = bv[i] * egl; kh[i] = kv[i] * egl; }
        *(RLAS u32x4*)(L + O_AT + tok * TS + c8 * 2) = (u32x4){pkb(at[0], at[1]), pkb(at[2], at[3]), pkb(at[4], at[5]), pkb(at[6], at[7])};
        *(RLAS u32x4*)(L + O_RT + tok * TS + c8 * 2) = (u32x4){pkb(rt[0], rt[1]), pkb(rt[2], rt[3]), pkb(rt[4], rt[5]), pkb(rt[6], rt[7])};
        *(RLAS u32x4*)(L + O_BT + tok * TS + c8 * 2) = (u32x4){pkb(bt[0], bt[1]), pkb(bt[2], bt[3]), pkb(bt[4], bt[5]), pkb(bt[6], bt[7])};
        *(RLAS u32x4*)(L + O_KT + tok * TS + c8 * 2) = (u32x4){pkb(kt[0], kt[1]), pkb(kt[2], kt[3]), pkb(kt[4], kt[5]), pkb(kt[6], kt[7])};
        *(RLAS u32x4*)(L + O_RH + tok * TS + c8 * 2) = (u32x4){pkh(rt[0], rt[1]), pkh(rt[2], rt[3]), pkh(rt[4], rt[5]), pkh(rt[6], rt[7])};
#pragma unroll
        for (int i = 0; i < 8; ++i) { const int ch = c8 + i;
            *(RLAS unsigned short*)(L + O_VT + ch * CS + tok * 2) = f2h(vv[i]); *(RLAS unsigned short*)(L + O_KH + ch * CS + tok * 2) = f2h(kh[i]); *(RLAS unsigned short*)(L + O_BH + ch * CS + tok * 2) = f2h(bh[i]);
            ((RLAS float*)(L + O_X0))[ch * 33 + tok] = at[i];
            if (tok == C - 1) ((RLAS float*)(L + O_GAM))[ch] = __expf(GL[i]); }
    }
    __syncthreads();
    {
        const RLAS unsigned char* Lp = L + (q < 2 ? O_AT : O_RT) + r32 * TS + hi * 16; const RLAS unsigned char* Rp = L + ((q & 1) ? O_KT : O_BT) + r32 * TS + hi * 16;
        f32x16 acc;
#pragma unroll
        for (int r = 0; r < 16; ++r) acc[r] = 0.f;
#pragma unroll
        for (int ks = 0; ks < 4; ++ks) acc = __builtin_amdgcn_mfma_f32_32x32x16_bf16(*(const RLAS bf16x8*)(Lp + ks * 32), *(const RLAS bf16x8*)(Rp + ks * 32), acc, 0, 0, 0);
#pragma unroll
        for (int r = 0; r < 16; ++r) { const int tau = crow(r, hi); const bool keep = (q < 2) ? (r32 < tau) : (r32 <= tau); acc[r] = keep ? acc[r] : 0.f; }
        __syncthreads();
        if (q == 0) {
#pragma unroll
            for (int r = 0; r < 16; ++r) ((RLAS float*)(L + O_AAB))[r32 * 36 + crow(r, hi)] = acc[r];
        } else {
            RLAS unsigned char* o = L + (q == 1 ? O_AAK : (q == 2 ? O_ARB : O_ARK));
#pragma unroll
            for (int r = 0; r < 16; ++r) *(RLAS unsigned short*)(o + crow(r, hi) * CS + r32 * 2) = f2h(acc[r]);
        }
    }
    __syncthreads();
    const int J = q & 1, part = q >> 1;
    if (part == 1) {
        f32x16 accX;
#pragma unroll
        for (int r = 0; r < 16; ++r) accX[r] = 0.f;
        const RLAS unsigned char* Vp = L + O_VT + (32 * J + r32) * CS + hi * 16; const RLAS unsigned char* Ap = L + O_AAK + r32 * CS + hi * 16;
#pragma unroll
        for (int ks = 0; ks < 2; ++ks) accX = __builtin_amdgcn_mfma_f32_32x32x16_f16(*(const RLAS f16x8*)(Ap + ks * 32), *(const RLAS f16x8*)(Vp + ks * 32), accX, 0, 0, 0);
#pragma unroll
        for (int r = 0; r < 16; ++r) ((RLAS float*)(L + O_X0))[(64 + 32 * J + r32) * 33 + crow(r, hi)] = accX[r];
    }
    __syncthreads();
    float z[C];
    if (q < 2) {
        const RLAS float* xc = (const RLAS float*)(L + O_X0) + (64 * q + lane) * 33;
#pragma unroll
        for (int k = 0; k < C; ++k) z[k] = xc[k];
    }
    __syncthreads();
    if (q < 2) {
        const RLAS float* AabT = (const RLAS float*)(L + O_AAB);
#pragma unroll
        for (int sx = 0; sx < C - 1; ++sx) {
            const float zs = z[sx];
#pragma unroll
            for (int t4 = (sx + 1) / 4; t4 < C / 4; ++t4) { const f32x4 aa = *(const RLAS f32x4*)(AabT + sx * 36 + 4 * t4);
                if (4 * t4 + 0 > sx) z[4 * t4 + 0] = fmaf(aa.x, zs, z[4 * t4 + 0]); if (4 * t4 + 1 > sx) z[4 * t4 + 1] = fmaf(aa.y, zs, z[4 * t4 + 1]);
                if (4 * t4 + 2 > sx) z[4 * t4 + 2] = fmaf(aa.z, zs, z[4 * t4 + 2]); if (4 * t4 + 3 > sx) z[4 * t4 + 3] = fmaf(aa.w, zs, z[4 * t4 + 3]); }
        }
        RLAS unsigned char* zr = L + O_X0 + (64 * q + lane) * CS;
#pragma unroll
        for (int k8 = 0; k8 < 4; ++k8) *(RLAS u32x4*)(zr + k8 * 16) = (u32x4){pkh(z[8 * k8], z[8 * k8 + 1]), pkh(z[8 * k8 + 2], z[8 * k8 + 3]), pkh(z[8 * k8 + 4], z[8 * k8 + 5]), pkh(z[8 * k8 + 6], z[8 * k8 + 7])};
    }
    __syncthreads();
    f32x16 accQ, accP, accA, accB;
#pragma unroll
    for (int r = 0; r < 16; ++r) { accA[r] = 0.f; accB[r] = 0.f; }
    {
        const RLAS unsigned char* Vp = L + O_VT + (32 * J + r32) * CS + hi * 16;
        const RLAS unsigned char* Kp = L + O_KH + (32 * part + r32) * CS + hi * 16;
        const RLAS unsigned char* Ap = L + O_ARK + r32 * CS + hi * 16;
#pragma unroll
        for (int ks = 0; ks < 2; ++ks) { const f16x8 vf = *(const RLAS f16x8*)(Vp + ks * 32);
            if (part == 0) accA = __builtin_amdgcn_mfma_f32_32x32x16_f16(*(const RLAS f16x8*)(Ap + ks * 32), vf, accA, 0, 0, 0);
            accB = __builtin_amdgcn_mfma_f32_32x32x16_f16(*(const RLAS f16x8*)(Kp + ks * 32), vf, accB, 0, 0, 0); }
    }
    {
        const RLAS float* gam = (const RLAS float*)(L + O_GAM);
#pragma unroll
        for (int r = 0; r < 16; ++r) { const int m = crow(r, hi);
            accQ[r] = h2f(*(const RLAS unsigned short*)(L + O_RH + m * TS + (32 * J + r32) * 2));
            accP[r] = (J == part && m == r32) ? gam[32 * J + r32] : 0.f; }
        const RLAS unsigned char* Zw = L + O_X0 + (32 * J + r32) * CS + hi * 16; const RLAS unsigned char* Zu = Zw + 64 * CS;
        const RLAS unsigned char* Bp = L + O_BH + (32 * part + r32) * CS + hi * 16; const RLAS unsigned char* Rb = L + O_ARB + r32 * CS + hi * 16;
#pragma unroll
        for (int ks = 0; ks < 2; ++ks) { const f16x8 zw = *(const RLAS f16x8*)(Zw + ks * 32), zu = *(const RLAS f16x8*)(Zu + ks * 32), bf = *(const RLAS f16x8*)(Bp + ks * 32);
            accP = __builtin_amdgcn_mfma_f32_32x32x16_f16(bf, zw, accP, 0, 0, 0);
            accB = __builtin_amdgcn_mfma_f32_32x32x16_f16(bf, zu, accB, 0, 0, 0);
            if (part == 0) { const f16x8 rb = *(const RLAS f16x8*)(Rb + ks * 32);
                accQ = __builtin_amdgcn_mfma_f32_32x32x16_f16(rb, zw, accQ, 0, 0, 0);
                accA = __builtin_amdgcn_mfma_f32_32x32x16_f16(rb, zu, accA, 0, 0, 0); } }
    }
    __syncthreads();
    { int tg2 = tglob, cb2 = has_next ? chb + 128 : chb; asm volatile("" : "+v"(tg2), "+v"(cb2)); chunk_load(in, tg2, pos, cb2, ws); }
    unsigned char* rec = CHK + ((size_t)((bidx * 16 + h) * (S / C)) + (size_t)(pos >> 5)) * CHK_BYTES;
    { u32x4 w0, w1; w0 = (u32x4){pkh(accB[0], accB[1]), pkh(accB[2], accB[3]), pkh(accB[4], accB[5]), pkh(accB[6], accB[7])}; w1 = (u32x4){pkh(accB[8], accB[9]), pkh(accB[10], accB[11]), pkh(accB[12], accB[13]), pkh(accB[14], accB[15])};
      RGAS u32x4* g = (RGAS u32x4*)(rec + CK_G + ((part * 2 + J) * 64 + lane) * 32); g[0] = w0; g[1] = w1;
      if (part == 0) { w0 = (u32x4){pkh(accA[0], accA[1]), pkh(accA[2], accA[3]), pkh(accA[4], accA[5]), pkh(accA[6], accA[7])}; w1 = (u32x4){pkh(accA[8], accA[9]), pkh(accA[10], accA[11]), pkh(accA[12], accA[13]), pkh(accA[14], accA[15])};
          RGAS u32x4* y = (RGAS u32x4*)(rec + CK_Y + (J * 64 + lane) * 32); y[0] = w0; y[1] = w1; } }
    {
        RLAS unsigned short* pimg = (RLAS unsigned short*)(L + O_PIMG) + ((part * 2 + J) * 2) * 512;
        RLAS unsigned short* qimg = (RLAS unsigned short*)(L + O_QIMG) + (J * 2) * 512;
#pragma unroll
        for (int r = 0; r < 16; ++r) { const int fp = frag_pos(crow(r, hi), r32); pimg[fp] = f2h(accP[r]); if (part == 0) qimg[fp] = f2h(accQ[r]); }
    }
    __syncthreads();
    { const RLAS u32x4* src = (const RLAS u32x4*)(L + O_PIMG); RGAS u32x4* dst = (RGAS u32x4*)(rec + CK_P);
#pragma unroll
      for (int i = 0; i < 3; ++i) dst[i * 256 + t] = src[i * 256 + t]; }
}

__device__ __forceinline__ void scan_unit(RLAS unsigned char* lds, const int wave, const int bh, const unsigned char* CHK, const float* BONUS, const unsigned short* PROJ16, const float* mu,
                                          const unsigned short* G16, const float* lnx_g, const float* lnx_b, unsigned short* Y16) {
    const int lane = pg8::lane_id(), r32 = lane & 31, hi = lane >> 5;
    const int b = bh >> 4, h = bh & 15;
    RLAS float* ytile = (RLAS float*)lds;
    constexpr int RING0 = 18432, NSL = 4;
    const unsigned char* rec0 = CHK + (size_t)bh * (S / C) * CHK_BYTES;
    constexpr int NCH = S / C;
    __syncthreads();
    if (wave >= 6) {
        const int p0 = (wave - 6) * 12;
#define RK_DMA(c) do { const unsigned char* src_ = rec0 + (size_t)(c) * CHK_BYTES + p0 * 1024 + lane * 16; RLAS unsigned char* dst_ = lds + RING0 + ((c) & (NSL - 1)) * CHK_BYTES + p0 * 1024; \
            _Pragma("unroll") for (int j_ = 0; j_ < 12; ++j_) __builtin_amdgcn_global_load_lds((const unsigned*)(src_ + j_ * 1024), (RLAS unsigned*)(dst_ + j_ * 1024), 16, 0, 0); } while (0)
        RK_DMA(0); RK_DMA(1); RK_DMA(2);
        for (int c = 0; c <= NCH; ++c) {
            if (c + 2 < NCH) asm volatile("s_waitcnt vmcnt(24)" ::: "memory"); else if (c + 1 < NCH) asm volatile("s_waitcnt vmcnt(12)" ::: "memory"); else asm volatile("s_waitcnt vmcnt(0)" ::: "memory");
            __builtin_amdgcn_s_barrier(); asm volatile("" ::: "memory");
            if (c + 3 < NCH) RK_DMA(c + 3);
        }
#undef RK_DMA
    } else if (wave < 2) {
        const int J = wave;
        f32x16 H0, H1;
#pragma unroll
        for (int r = 0; r < 16; ++r) { H0[r] = 0.f; H1[r] = 0.f; }
        for (int c = 0; c <= NCH; ++c) {
            asm volatile("s_waitcnt lgkmcnt(0)" ::: "memory"); __builtin_amdgcn_s_barrier(); asm volatile("" ::: "memory");
            if (c == NCH) break;
            const RLAS unsigned char* rec = lds + RING0 + (c & (NSL - 1)) * CHK_BYTES;
            u32x4 hb[4];
            hb[0] = (u32x4){pkh(H0[0], H0[1]), pkh(H0[2], H0[3]), pkh(H0[4], H0[5]), pkh(H0[6], H0[7])}; hb[1] = (u32x4){pkh(H0[8], H0[9]), pkh(H0[10], H0[11]), pkh(H0[12], H0[13]), pkh(H0[14], H0[15])};
            hb[2] = (u32x4){pkh(H1[0], H1[1]), pkh(H1[2], H1[3]), pkh(H1[4], H1[5]), pkh(H1[6], H1[7])}; hb[3] = (u32x4){pkh(H1[8], H1[9]), pkh(H1[10], H1[11]), pkh(H1[12], H1[13]), pkh(H1[14], H1[15])};
            f32x16 y, n0, n1;
#define RK_UNPK(dst, w0, w1) do { const f16x8 a_ = __builtin_bit_cast(f16x8, w0), b_ = __builtin_bit_cast(f16x8, w1); \
            _Pragma("unroll") for (int i_ = 0; i_ < 8; ++i_) { dst[i_] = (float)a_[i_]; dst[8 + i_] = (float)b_[i_]; } } while (0)
            { const u32x4 y0 = *(const RLAS u32x4*)(rec + CK_Y + (J * 64 + lane) * 32), y1 = *(const RLAS u32x4*)(rec + CK_Y + (J * 64 + lane) * 32 + 16); RK_UNPK(y, y0, y1);
              const u32x4 g0 = *(const RLAS u32x4*)(rec + CK_G + (J * 64 + lane) * 32), g1 = *(const RLAS u32x4*)(rec + CK_G + (J * 64 + lane) * 32 + 16); RK_UNPK(n0, g0, g1);
              const u32x4 g2 = *(const RLAS u32x4*)(rec + CK_G + ((2 + J) * 64 + lane) * 32), g3 = *(const RLAS u32x4*)(rec + CK_G + ((2 + J) * 64 + lane) * 32 + 16); RK_UNPK(n1, g2, g3); }
#pragma unroll
            for (int ks = 0; ks < 4; ++ks) {
                const f16x8 hf = __builtin_bit_cast(f16x8, hb[ks]);
                y = __builtin_amdgcn_mfma_f32_32x32x16_f16(*(const RLAS f16x8*)(rec + CK_Q + (ks * 64 + lane) * 16), hf, y, 0, 0, 0);
                n0 = __builtin_amdgcn_mfma_f32_32x32x16_f16(*(const RLAS f16x8*)(rec + CK_P + (ks * 64 + lane) * 16), hf, n0, 0, 0, 0);
                n1 = __builtin_amdgcn_mfma_f32_32x32x16_f16(*(const RLAS f16x8*)(rec + CK_P + ((4 + ks) * 64 + lane) * 16), hf, n1, 0, 0, 0);
            }
#undef RK_UNPK
            H0 = n0; H1 = n1;
            RLAS float* yt = ytile + (c & 1) * (32 * 68);
#pragma unroll
            for (int r = 0; r < 16; ++r) yt[crow(r, hi) * 68 + 32 * J + r32] = y[r];
        }
    } else {
        const int p = wave - 2, v8 = (lane & 7) * 8, trow = 8 * p + (lane >> 3);
        float lg[8], lb[8], mv[8];
#pragma unroll
        for (int i = 0; i < 8; ++i) { lg[i] = lnx_g[h * 64 + v8 + i]; lb[i] = lnx_b[h * 64 + v8 + i]; mv[i] = mu[2048 + h * 64 + v8 + i]; }
        struct PSlot { float bon; us8 vc, vp, g8; };
        PSlot ps[4];
#define RK_PLOAD(SL, cc_) do { const int pos_ = (cc_) * C + trow; const size_t tok_ = (size_t)b * S + pos_; ps[SL].bon = BONUS[tok_ * 16 + h]; \
            const unsigned short* cur_ = PROJ16 + tok_ * PN + 5120 + h * 64 + v8; ps[SL].vc = *(const RGAS us8*)cur_; ps[SL].vp = ps[SL].vc; if (pos_ > 0) ps[SL].vp = *(const RGAS us8*)(cur_ - PN); \
            ps[SL].g8 = *(const RGAS us8*)(G16 + tok_ * RWK + h * 64 + v8); } while (0)
#define RK_PSTEP(SL, cc_) do { \
            asm volatile("s_waitcnt lgkmcnt(0)" ::: "memory"); __builtin_amdgcn_s_barrier(); asm volatile("" ::: "memory"); \
            if ((cc_) >= 0) { const int cc = (cc_); \
                const float bon = ps[SL].bon; const us8 vc = ps[SL].vc, vp = ps[SL].vp, g8 = ps[SL].g8; \
                if (cc + 4 < NCH) RK_PLOAD(SL, cc + 4); \
                const RLAS float* yt = ytile + (cc & 1) * (32 * 68) + trow * 68 + v8; \
                const f32x4 ya = *(const RLAS f32x4*)yt, yb = *(const RLAS f32x4*)(yt + 4); \
                float yv[8] = {ya.x, ya.y, ya.z, ya.w, yb.x, yb.y, yb.z, yb.w}; \
                float sm = 0.f; \
                _Pragma("unroll") for (int i = 0; i < 8; ++i) sm += yv[i]; \
                const float mean = sum8(sm) * (1.f / 64.f); float sq = 0.f; \
                _Pragma("unroll") for (int i = 0; i < 8; ++i) { yv[i] -= mean; sq += yv[i] * yv[i]; } \
                const float rstd = __builtin_amdgcn_rsqf(sum8(sq) * (1.f / 64.f) + 64e-5f); \
                const int pos = cc * C + trow; const size_t tok = (size_t)b * S + pos; \
                float o[8]; \
                _Pragma("unroll") for (int i = 0; i < 8; ++i) { const float vcf = h2f(vc[i]), vpf = pos > 0 ? h2f(vp[i]) : 0.f; const float vx = vcf + (vpf - vcf) * mv[i]; \
                    o[i] = (yv[i] * rstd * lg[i] + lb[i] + bon * vx) * h2f(g8[i]); } \
                *(RGAS u32x4*)(Y16 + tok * D + 1024 + h * 64 + v8) = (u32x4){pkh(o[0], o[1]), pkh(o[2], o[3]), pkh(o[4], o[5]), pkh(o[6], o[7])}; } } while (0)
        RK_PLOAD(0, 0); RK_PLOAD(1, 1); RK_PLOAD(2, 2); RK_PLOAD(3, 3);
        for (int cb = 0; cb < NCH; cb += 4) {
            RK_PSTEP(3, cb - 1); RK_PSTEP(0, cb); RK_PSTEP(1, cb + 1); RK_PSTEP(2, cb + 2);
        }
        RK_PSTEP(3, NCH - 1);
#undef RK_PSTEP
#undef RK_PLOAD
    }
    __syncthreads();
}
#undef RLAS
#undef RGAS
}

constexpr int NWAVES = 8;
constexpr int RING_OFF = 0, RING_BYTES = 131072;
constexpr int LDSCTL_OFF = RING_BYTES, MISC_OFF = LDSCTL_OFF + 320;
constexpr int LDS_BYTES = 147456;
#define GAS __attribute__((address_space(1)))
#define LAS __attribute__((address_space(3)))
typedef unsigned v4u __attribute__((ext_vector_type(4)));
typedef float f32x4 __attribute__((ext_vector_type(4)));
typedef GAS unsigned gu32;
#define RLX_AGENT __ATOMIC_RELAXED, __HIP_MEMORY_SCOPE_AGENT
#define LDS_WAIT() asm volatile("s_waitcnt lgkmcnt(0)" ::: "memory")
#define VM_WAIT() asm volatile("s_waitcnt vmcnt(0)" ::: "memory")
constexpr int CW_CONVQ = 65;
constexpr int CW_ATTQ = 64;
constexpr int CW_BAR = 4096;
constexpr size_t CTL_ZERO_BYTES = 64 * 1024;

#define XB_TMO      128
#define XB_XCNT(j)  (256  + 64 * (j))
#define XB_XSUB(j)  (1280 + 64 * (j))
#define XB_XGEN(j)  (2304 + 64 * (j))
#define XB_TOP      3328
#define XB_TOPGEN   3392
#define XCD_BAR_WORDS 3456
#define XB_SPIN_CAP (1u << 18)

__device__ __forceinline__ unsigned xb_ld(unsigned* p)              { return __hip_atomic_load(p, __ATOMIC_RELAXED, __HIP_MEMORY_SCOPE_AGENT); }
__device__ __forceinline__ unsigned xb_add(unsigned* p, unsigned v) { return __hip_atomic_fetch_add(p, v, __ATOMIC_RELAXED, __HIP_MEMORY_SCOPE_AGENT); }
__device__ __forceinline__ unsigned xb_xcc_id() { return (unsigned)__builtin_amdgcn_s_getreg((3 << 11) | 20) & 0xFu; }
#define XB_SPIN(cond, bar) do { unsigned _sp = 0; while (cond) { __builtin_amdgcn_s_sleep(1); \
    if ((++_sp & 255u) == 0u) { if (xb_ld(&(bar)[XB_TMO])) break; if (_sp > XB_SPIN_CAP) { atomicAdd(&(bar)[XB_TMO], 1u); break; } } } } while (0)

struct XcdBarrier {
    unsigned* bar; unsigned x; bool w0;
    volatile LAS unsigned* st;
};

__device__ __forceinline__ XcdBarrier xcd_barrier_post(unsigned* bar, volatile LAS unsigned* st) {
    XcdBarrier b; b.bar = bar; b.x = xb_xcc_id(); b.st = st; b.w0 = (__builtin_amdgcn_readfirstlane(threadIdx.x >> 6) == 0);
    if (__builtin_amdgcn_readfirstlane(threadIdx.x >> 6) == 0 && pg8::lane_id() == 0) (void)xb_add(&bar[XB_XCNT(b.x)], 1u);
    return b;
}
__device__ __forceinline__ void xcd_barrier_complete(unsigned* bar, unsigned x, unsigned& nloc, unsigned& nx) {
    const unsigned G = gridDim.x * gridDim.y * gridDim.z;
    unsigned sum, cnt, mine, sp = 0u;
    for (;;) {
        sum = 0u; cnt = 0u; mine = 0u;
#pragma unroll
        for (unsigned j = 0; j < 16; ++j) { const unsigned c = xb_ld(&bar[XB_XCNT(j)]); sum += c; cnt += (c > 0u) ? 1u : 0u; mine = (j == x) ? c : mine; }
        if (sum == G) break;
        __builtin_amdgcn_s_sleep(1);
        if ((++sp & 255u) == 0u) { if (xb_ld(&bar[XB_TMO])) break; if (sp > XB_SPIN_CAP) { atomicAdd(&bar[XB_TMO], 1u); break; } }
    }
    nloc = mine > 0u ? mine : 1u; nx = cnt > 0u ? cnt : 1u;
}

__device__ __forceinline__ void xcd_barrier(const XcdBarrier& b) {
    asm volatile("s_waitcnt vmcnt(0)" ::: "memory");
    __syncthreads();
    if (b.w0 && pg8::lane_id() == 0) {
        unsigned* bar = b.bar;
        __builtin_amdgcn_s_waitcnt(0);
        unsigned nloc = b.st[0], nx = b.st[1];
        if (nloc == 0u) { xcd_barrier_complete(bar, b.x, nloc, nx); b.st[0] = nloc; b.st[1] = nx; }
        const unsigned old = xb_add(&bar[XB_XSUB(b.x)], 1u);
        const unsigned gen = old / nloc;
        if (old + 1u == (gen + 1u) * nloc) {
            __builtin_amdgcn_fence(__ATOMIC_RELEASE, "agent");
            asm volatile("s_waitcnt vmcnt(0)" ::: "memory");
            const unsigned og = xb_add(&bar[XB_TOP], 1u);
            const unsigned tg = og / nx;
            if (og + 1u == (tg + 1u) * nx) xb_add(&bar[XB_TOPGEN], 1u);
            else XB_SPIN(xb_ld(&bar[XB_TOPGEN]) == tg, bar);
            __builtin_amdgcn_fence(__ATOMIC_ACQUIRE, "agent");
            xb_add(&bar[XB_XGEN(b.x)], 1u);
            asm volatile("s_waitcnt vmcnt(0)" ::: "memory");
        } else {
            XB_SPIN(xb_ld(&bar[XB_XGEN(b.x)]) == gen, bar);
            __builtin_amdgcn_fence(__ATOMIC_ACQUIRE, "agent");
            asm volatile("s_waitcnt vmcnt(0)" ::: "memory");
        }
    }
    __syncthreads();
}


typedef unsigned short f16_t;
typedef _Float16 h2v __attribute__((ext_vector_type(2)));
__device__ __forceinline__ unsigned pk2h(float lo, float hi) { h2v v = {(_Float16)lo, (_Float16)hi}; return __builtin_bit_cast(unsigned, v); }

struct Frame {
    LAS unsigned char* lds; volatile LAS unsigned* MISC; gu32* ctl;
    int wave, vcu, G;
};
#define FTID (F.wave * 64 + pg8::lane_id())
#define FLANE (pg8::lane_id())
__device__ __forceinline__ void p0_transpose_item(const float* W, int K, int N, f16_t* WT, int row_off, LAS float* scr, int item, int lane) {
    const int nblk = N / 32, kb = item / nblk, nb = item % nblk, k0 = 64 * kb, n0 = 32 * nb;
#pragma unroll 8
    for (int i = 0; i < 32; ++i) { const int kk = 2 * i + (lane >> 5); scr[kk * 33 + (lane & 31)] = W[(size_t)(k0 + kk) * N + n0 + (lane & 31)]; }
    LDS_WAIT(); asm volatile("" ::: "memory");
    const int c = lane & 7;
#pragma unroll
    for (int j = 0; j < 4; ++j) { const int n = (lane >> 3) + 8 * j; const LAS float* s = scr + (8 * c) * 33 + n;
        v4u o; o.x = pk2h(s[0 * 33], s[1 * 33]); o.y = pk2h(s[2 * 33], s[3 * 33]); o.z = pk2h(s[4 * 33], s[5 * 33]); o.w = pk2h(s[6 * 33], s[7 * 33]);
        *(GAS v4u*)(WT + (size_t)(row_off + n0 + n) * K + k0 + 8 * c) = o; }
    LDS_WAIT(); asm volatile("" ::: "memory");
}
#ifndef TP_LD
#define TP_LD(p) (*(p))
#endif
struct TpDesc { const float* W; f16_t* WT; int K, N, row_off, item; };
__device__ __forceinline__ void tp_load(float (&r)[32], const TpDesc& d, int lane) {
    const int nblk = d.N / 32, kb = d.item / nblk, nb = d.item % nblk, k0 = 64 * kb, n0 = 32 * nb;
#pragma unroll
    for (int i = 0; i < 32; ++i) r[i] = TP_LD(d.W + (size_t)(k0 + 2 * i + (lane >> 5)) * d.N + n0 + (lane & 31));
}
__device__ __forceinline__ void tp_emit(const TpDesc& d, LAS float* scr, int lane) {
    const int nblk = d.N / 32, kb = d.item / nblk, nb = d.item % nblk, k0 = 64 * kb, n0 = 32 * nb, c = lane & 7;
#pragma unroll
    for (int j = 0; j < 4; ++j) { const int n = (lane >> 3) + 8 * j; const LAS float* sp = scr + (8 * c) * 33 + n;
        v4u o; o.x = pk2h(sp[0 * 33], sp[1 * 33]); o.y = pk2h(sp[2 * 33], sp[3 * 33]); o.z = pk2h(sp[4 * 33], sp[5 * 33]); o.w = pk2h(sp[6 * 33], sp[7 * 33]);
        *(GAS v4u*)(d.WT + (size_t)(d.row_off + n0 + n) * d.K + k0 + 8 * c) = o; }
}
template <class MK> __device__ __forceinline__ void tp_stream(int first, int n, int stride, MK mk, LAS float* scr, int lane) {
    if (first >= n) return;
    float r[32]; int it = first; TpDesc d = mk(it); tp_load(r, d, lane);
    for (;;) {
#pragma unroll
        for (int i = 0; i < 32; ++i) scr[(2 * i + (lane >> 5)) * 33 + (lane & 31)] = r[i];
        LDS_WAIT(); asm volatile("" ::: "memory");
        const int nit = it + stride; const bool more = nit < n; TpDesc dn = d;
        if (more) { dn = mk(nit); tp_load(r, dn, lane); }
        tp_emit(d, scr, lane);
        LDS_WAIT(); asm volatile("" ::: "memory");
        if (!more) break;
        it = nit; d = dn;
    }
}
__device__ __forceinline__ float wave_sum_b(float v) {
#pragma unroll
    for (int o = 1; o < 64; o <<= 1) v += __shfl_xor(v, o);
    return v;
}
__device__ __forceinline__ void ln_row_dual(int lane, const float* xrow, const float* g, const float* b, float* o32, f16_t* o16) {
    const GAS f32x4* xr = (const GAS f32x4*)xrow + lane;
    f32x4 v[8]; float s = 0.f;
#pragma unroll
    for (int j = 0; j < 8; ++j) { v[j] = xr[64 * j]; s += (v[j].x + v[j].y) + (v[j].z + v[j].w); }
    const float mean = wave_sum_b(s) * (1.f / D); float s2 = 0.f;
#pragma unroll
    for (int j = 0; j < 8; ++j) { v[j] = v[j] - mean; s2 += (v[j].x * v[j].x + v[j].y * v[j].y) + (v[j].z * v[j].z + v[j].w * v[j].w); }
    const float rstd = __builtin_amdgcn_rsqf(wave_sum_b(s2) * (1.f / D) + LN_EPS);
    const GAS f32x4* g4 = (const GAS f32x4*)g + lane; const GAS f32x4* b4 = (const GAS f32x4*)b + lane;
    GAS f32x4* o4 = (GAS f32x4*)o32 + lane; GAS unsigned long long* o8 = (GAS unsigned long long*)o16 + lane;
#pragma unroll
    for (int j = 0; j < 8; ++j) { const f32x4 o = v[j] * rstd * g4[64 * j] + b4[64 * j]; o4[64 * j] = o;
        o8[64 * j] = (unsigned long long)pk2h(o.x, o.y) | ((unsigned long long)pk2h(o.z, o.w) << 32); }
}


__device__ __forceinline__ void p0_transpose_item_gu(const float* W, int K, int N, f16_t* WT, int gu_s, LAS float* scr, int item, int lane) {
    const int nblk = N / 32, nb = item % nblk; const int row_off = gu_s < 0 ? 0 : 128 * (nb >> 2) + 128 * gu_s;
    p0_transpose_item(W, K, N, WT, row_off, scr, item, lane);
}
__device__ __forceinline__ void ln_norm(int lane, f32x4 (&v)[8], const float* g, const float* b) {
    float s = 0.f;
#pragma unroll
    for (int j = 0; j < 8; ++j) s += (v[j].x + v[j].y) + (v[j].z + v[j].w);
    const float mean = wave_sum_b(s) * (1.f / D); float s2 = 0.f;
#pragma unroll
    for (int j = 0; j < 8; ++j) { v[j] = v[j] - mean; s2 += (v[j].x * v[j].x + v[j].y * v[j].y) + (v[j].z * v[j].z + v[j].w * v[j].w); }
    const float rstd = __builtin_amdgcn_rsqf(wave_sum_b(s2) * (1.f / D) + LN_EPS);
    const GAS f32x4* g4 = (const GAS f32x4*)g + lane; const GAS f32x4* b4 = (const GAS f32x4*)b + lane;
#pragma unroll
    for (int j = 0; j < 8; ++j) v[j] = v[j] * rstd * g4[64 * j] + b4[64 * j];
}
__device__ __forceinline__ void ln_store(int lane, const f32x4 (&v)[8], float* o32, f16_t* o16) {
    GAS f32x4* o4 = (GAS f32x4*)o32 + lane; GAS unsigned long long* o8 = (GAS unsigned long long*)o16 + lane;
#pragma unroll
    for (int j = 0; j < 8; ++j) { o4[64 * j] = v[j]; o8[64 * j] = (unsigned long long)pk2h(v[j].x, v[j].y) | ((unsigned long long)pk2h(v[j].z, v[j].w) << 32); }
}
__device__ __forceinline__ void ln_regs(int lane, f32x4 (&v)[8], const float* g, const float* b, float* o32, f16_t* o16) { ln_norm(lane, v, g, b); ln_store(lane, v, o32, o16); }
__device__ __forceinline__ void route_token(int tok, const float (&acc)[36], const float* gb, const float* eb, int* cnt, int* ltok, int* lpair, float* pairw) {
    float gl[4]; float gm = -3.0e38f; int gi = 0;
#pragma unroll
    for (int i = 0; i < 4; ++i) { gl[i] = acc[i] + gb[i]; if (gl[i] > gm) { gm = gl[i]; gi = i; } }
    float gs = 0.f;
#pragma unroll
    for (int i = 0; i < 4; ++i) gs += __expf(gl[i] - gm);
    const float gtop = 1.f / gs;
    float el[8]; float em = -3.0e38f; int e0 = 0;
#pragma unroll
    for (int i = 0; i < 8; ++i) { float v = 0.f;
#pragma unroll
        for (int g = 0; g < 4; ++g) if (g == gi) v = acc[4 + g * 8 + i] + eb[g * 8 + i];
        el[i] = v; if (v > em) { em = v; e0 = i; } }
    float em2 = -3.0e38f; int e1 = 0;
#pragma unroll
    for (int i = 0; i < 8; ++i) if (i != e0 && el[i] > em2) { em2 = el[i]; e1 = i; }
    const float x1 = __expf(em2 - em);
    const float w0 = 1.f / (1.f + x1), w1 = x1 / (1.f + x1);
    const int ea = gi * 8 + e0, ebb = gi * 8 + e1;
    const int p0 = atomicAdd(&cnt[ea], 1); ltok[ea * 8192 + p0] = tok; lpair[ea * 8192 + p0] = tok * 2;
    const int p1 = atomicAdd(&cnt[ebb], 1); ltok[ebb * 8192 + p1] = tok; lpair[ebb * 8192 + p1] = tok * 2 + 1;
    pairw[tok * 2] = w0 * gtop; pairw[tok * 2 + 1] = w1 * gtop;
}
constexpr int TAB_OFF = LDSCTL_OFF + 1024;
__device__ __forceinline__ void build_moe_table(Frame& F, const int* cnt) {
    LAS int* tab = (LAS int*)(F.lds + TAB_OFF);
    const int tid = FTID;
    if (tid < 32) tab[tid] = __hip_atomic_load(cnt + tid, __ATOMIC_RELAXED, __HIP_MEMORY_SCOPE_AGENT);
    __syncthreads();
    if (tid == 0) { int p = 0, pa = 0, pb = 0; for (int e = 0; e < 32; ++e) { const int nb = (tab[e] + 255) >> 8, na = nb < 2 ? nb : 2;
            tab[32 + e] = p; tab[65 + e] = pa; tab[98 + e] = pb; p += nb; pa += na; pb += nb - na; } tab[64] = p; tab[97] = pa; tab[130] = pb; }
    __syncthreads();
}

__device__ __forceinline__ float sum8_dpp(float x) {
    x += __builtin_bit_cast(float, __builtin_amdgcn_update_dpp(0, __builtin_bit_cast(int, x), 0xB1, 0xF, 0xF, true));
    x += __builtin_bit_cast(float, __builtin_amdgcn_update_dpp(0, __builtin_bit_cast(int, x), 0x4E, 0xF, 0xF, true));
    x += __builtin_bit_cast(float, __builtin_amdgcn_update_dpp(0, __builtin_bit_cast(int, x), 0x141, 0xF, 0xF, true));
    return x;
}
__device__ __forceinline__ float h2f(unsigned short u) { return (float)__builtin_bit_cast(_Float16, u); }
__device__ __forceinline__ float sum32_x(float x) {
    x += __builtin_bit_cast(float, __builtin_amdgcn_update_dpp(0, __builtin_bit_cast(int, x), 0xB1, 0xF, 0xF, true));
    x += __builtin_bit_cast(float, __builtin_amdgcn_update_dpp(0, __builtin_bit_cast(int, x), 0x4E, 0xF, 0xF, true));
    x += __builtin_bit_cast(float, __builtin_amdgcn_update_dpp(0, __builtin_bit_cast(int, x), 0x141, 0xF, 0xF, true));
    x += __builtin_bit_cast(float, __builtin_amdgcn_update_dpp(0, __builtin_bit_cast(int, x), 0x140, 0xF, 0xF, true));
    x += __builtin_bit_cast(float, __builtin_amdgcn_ds_bpermute((pg8::lane_id() ^ 16) << 2, __builtin_bit_cast(int, x)));
    return x;
}
__device__ __forceinline__ float wsum64(float x) {
    x = sum32_x(x); auto rr = __builtin_amdgcn_permlane32_swap(__float_as_uint(x), __float_as_uint(x), false, false); return __uint_as_float(rr[0]) + __uint_as_float(rr[1]);
}
__device__ __forceinline__ void rwkv_prep_tile(Frame& F, int tile, const f16_t* PROJ16, const f16_t* LSLAB, const float* mu, const float* w0, const f16_t* W2T, const float* a0, const f16_t* A2T, const f16_t* G2T,
                                               const float* k_k, const float* k_a, float* lwout, f16_t* kmod, f16_t* Aout, f16_t* Bout, f16_t* gout) {
    typedef _Float16 f16x8 __attribute__((ext_vector_type(8))); typedef float f32x16 __attribute__((ext_vector_type(16)));
    constexpr int SXS = 592;
    LAS unsigned char* sx = F.lds + RING_OFF;
    const int lane = FLANE, tid = F.wave * 64 + lane, t0 = tile * 32, r32 = lane & 31, hi = lane >> 5;
    __syncthreads();
    for (int e = tid; e < 32 * 36; e += 512) {
        typedef unsigned short us8v __attribute__((ext_vector_type(8)));
        const int tok = e / 36, i8 = (e % 36) * 8, pos = (t0 + tok) & (S - 1);
        float cv[8], pv[8];
#pragma unroll
        for (int i = 0; i < 8; ++i) { cv[i] = 0.f; pv[i] = 0.f; }
#pragma unroll
        for (int sl = 0; sl < 4; ++sl) { const f16_t* cur = LSLAB + ((size_t)sl * T + t0 + tok) * 512 + i8;
            const us8v c8 = *(const GAS us8v*)cur; us8v p8 = c8; if (pos > 0) p8 = *(const GAS us8v*)(cur - 512);
#pragma unroll
            for (int i = 0; i < 8; ++i) { cv[i] += h2f(c8[i]); pv[i] += h2f(p8[i]); } }
        float f[8];
#pragma unroll
        for (int i = 0; i < 8; ++i) { const float xs = cv[i] + ((pos > 0 ? pv[i] : 0.f) - cv[i]) * mu[3072 + i8 + i];
            f[i] = i8 < 64 ? 1.f - 2.f / (1.f + __expf(2.f * xs)) : (i8 < 128 ? xs : 1.f / (1.f + __expf(-xs))); }
        *(LAS v4u*)(sx + tok * SXS + i8 * 2) = (v4u){pk2h(f[0], f[1]), pk2h(f[2], f[3]), pk2h(f[4], f[5]), pk2h(f[6], f[7])};
    }
    __syncthreads();
    const LAS unsigned char* ap = sx + r32 * SXS + hi * 16;
#pragma unroll 1
    for (int hd = 0; hd < 2; ++hd) {
        const int ch0 = 128 * F.wave + 64 * hd;
        f32x16 aw[2], aa[2], ag[2];
#pragma unroll
        for (int tt = 0; tt < 2; ++tt)
#pragma unroll
            for (int r = 0; r < 16; ++r) { aw[tt][r] = 0.f; aa[tt][r] = 0.f; ag[tt][r] = 0.f; }
#pragma unroll
        for (int tt = 0; tt < 2; ++tt) {
            const int n = ch0 + 32 * tt + r32;
            const f16_t* bw = W2T + (size_t)n * 64 + hi * 8; const f16_t* ba = A2T + (size_t)n * 64 + hi * 8; const f16_t* bg = G2T + (size_t)n * 160 + hi * 8;
#pragma unroll
            for (int ks = 0; ks < 4; ++ks) {
                aw[tt] = __builtin_amdgcn_mfma_f32_32x32x16_f16(*(const LAS f16x8*)(ap + ks * 32), *(const GAS f16x8*)(bw + ks * 16), aw[tt], 0, 0, 0);
                aa[tt] = __builtin_amdgcn_mfma_f32_32x32x16_f16(*(const LAS f16x8*)(ap + 128 + ks * 32), *(const GAS f16x8*)(ba + ks * 16), aa[tt], 0, 0, 0); }
#pragma unroll
            for (int ks = 0; ks < 10; ++ks)
                ag[tt] = __builtin_amdgcn_mfma_f32_32x32x16_f16(*(const LAS f16x8*)(ap + 256 + ks * 32), *(const GAS f16x8*)(bg + ks * 16), ag[tt], 0, 0, 0);
        }
        float k0[2][16];
        float pkk[2], pka[2], pmu[2], pw0[2], pa0[2];
#pragma unroll
        for (int tt = 0; tt < 2; ++tt) { const int n = ch0 + 32 * tt + r32; pkk[tt] = k_k[n]; pka[tt] = k_a[n]; pmu[tt] = mu[1024 + n]; pw0[tt] = w0[n]; pa0[tt] = a0[n]; }
#pragma unroll
        for (int rh = 0; rh < 2; ++rh) {
        float inv[8];
#pragma unroll
        for (int r = 8 * rh; r < 8 * rh + 8; ++r) { const int tok = t0 + (r & 3) + 8 * (r >> 2) + 4 * hi, pos = tok & (S - 1); float ss = 0.f;
#pragma unroll
            for (int tt = 0; tt < 2; ++tt) { const f16_t* cur = PROJ16 + (size_t)tok * PN + 4096 + ch0 + 32 * tt + r32;
                const float cv = h2f(cur[0]), pv = pos > 0 ? h2f(cur[-PN]) : 0.f; k0[tt][r] = cv + (pv - cv) * pmu[tt]; const float kq = k0[tt][r] * pkk[tt]; ss = fmaf(kq, kq, ss); }
            ss = sum32_x(ss); inv[r - 8 * rh] = __builtin_amdgcn_rsqf(fmaxf(ss, 1e-24f)); }
#pragma unroll
        for (int r = 8 * rh; r < 8 * rh + 8; ++r) { const int tok = t0 + (r & 3) + 8 * (r >> 2) + 4 * hi;
#pragma unroll
            for (int tt = 0; tt < 2; ++tt) { const size_t o = (size_t)tok * RWK + ch0 + 32 * tt + r32;
                const float z = -(pw0[tt] + aw[tt][r]); const float sp = z > 20.f ? z : __logf(1.f + __expf(z));
                lwout[o] = -__expf(-sp - 0.5f);
                const float asig = 1.f / (1.f + __expf(-(pa0[tt] + aa[tt][r]))); const float kk = k0[tt][r] * pkk[tt] * inv[r - 8 * rh];
                kmod[o] = __builtin_bit_cast(unsigned short, (_Float16)(k0[tt][r] * (1.f + (asig - 1.f) * pka[tt])));
                Aout[o] = __builtin_bit_cast(unsigned short, (_Float16)(-kk)); Bout[o] = __builtin_bit_cast(unsigned short, (_Float16)(kk * asig));
                gout[o] = __builtin_bit_cast(unsigned short, (_Float16)ag[tt][r]); } }
        }
    }
}
__device__ __forceinline__ float sum16_dpp(float x) {
    x += __builtin_bit_cast(float, __builtin_amdgcn_update_dpp(0, __builtin_bit_cast(int, x), 0xB1, 0xF, 0xF, true));
    x += __builtin_bit_cast(float, __builtin_amdgcn_update_dpp(0, __builtin_bit_cast(int, x), 0x4E, 0xF, 0xF, true));
    x += __builtin_bit_cast(float, __builtin_amdgcn_update_dpp(0, __builtin_bit_cast(int, x), 0x141, 0xF, 0xF, true));
    x += __builtin_bit_cast(float, __builtin_amdgcn_update_dpp(0, __builtin_bit_cast(int, x), 0x140, 0xF, 0xF, true));
    return x;
}
__device__ __forceinline__ f32x4 h4f(const f16_t* p) { typedef _Float16 h4_t __attribute__((ext_vector_type(4))); const h4_t v = *(const GAS h4_t*)p; return (f32x4){(float)v[0], (float)v[1], (float)v[2], (float)v[3]}; }
#ifndef REP_P0
#define REP_P0 1
#endif
#ifndef REP_PROJ
#define REP_PROJ 1
#endif
#ifndef REP_PLE
#define REP_PLE 1
#endif
#ifndef REP_CONV
#define REP_CONV 1
#endif
#ifndef REP_P2
#define REP_P2 1
#endif
#ifndef CONV_RATE
#define CONV_RATE 768
#endif
#ifndef REP_P3
#define REP_P3 1
#endif
#ifndef PROBE_K
#define PROBE_K -1
#endif
#ifndef REP_P5
#define REP_P5 1
#endif
#ifndef REP_P8
#define REP_P8 1
#endif
#ifndef REP_P6
#define REP_P6 1
#endif
#ifndef REP_P7
#define REP_P7 1
#endif
struct Args { const float* in[37]; float* out; unsigned char* ws; int ph_lo, ph_hi, li, pad; };
__global__ void __launch_bounds__(NWAVES * 64, 2) mega_fwd(Args args) {
    extern __shared__ __attribute__((aligned(16))) unsigned char lds[];
    Frame F;
    F.lds = (LAS unsigned char*)lds; F.MISC = (volatile LAS unsigned*)(F.lds + MISC_OFF);
    F.wave = __builtin_amdgcn_readfirstlane(threadIdx.x >> 6);
    F.G = gridDim.x; { const int bx = blockIdx.x; F.vcu = (F.G % 8 == 0) ? (bx % 8) * (F.G / 8) + bx / 8 : bx; }
    unsigned char* ws = args.ws;
    F.ctl = (gu32*)(ws);
    for (int u = FTID; u < (LDS_BYTES - LDSCTL_OFF) / 4; u += NWAVES * 64) ((LAS unsigned*)(F.lds + LDSCTL_OFF))[u] = 0u;
    __syncthreads();
    XcdBarrier bar = xcd_barrier_post((unsigned*)(F.ctl + CW_BAR) + args.li * XCD_BAR_WORDS, F.MISC + 8);
    unsigned long long t0_ = 0, tk_ = 0; if (PROBE_K != -1) t0_ = __builtin_amdgcn_s_memrealtime();
    const int lo = args.ph_lo, hi = args.ph_hi;
#define IN(k) (lo <= (k) && (k) < hi)
#define BOTH(k) (IN(k) && IN((k) + 1))
    f16_t* WinT = (f16_t*)(ws + WS_WINT); f16_t* H16 = (f16_t*)(ws + WS_H16); f16_t* PROJ16 = (f16_t*)(ws + WS_PROJ16); float* DECAY = (float*)(ws + WS_DECAY); f16_t* KMOD = (f16_t*)(ws + WS_KMOD); f16_t* A16 = (f16_t*)(ws + WS_A16); f16_t* B16 = (f16_t*)(ws + WS_B16); f16_t* G16 = (f16_t*)(ws + WS_G16);
    f16_t* WoutT = (f16_t*)(ws + WS_WOUTT); f16_t* GateT = (f16_t*)(ws + WS_GATET); f16_t* PleT = (f16_t*)(ws + WS_PLET); f16_t* P16 = (f16_t*)(ws + WS_P16);
    f16_t* PW16 = (f16_t*)(ws + WS_PW16); f16_t* Y16 = (f16_t*)(ws + WS_Y16); float* ROWRS = (float*)(ws + WS_ROWRS);
    float* RT = (float*)(ws + WS_RT); f16_t* GUT = (f16_t*)(ws + WS_GUT); f16_t* DNT = (f16_t*)(ws + WS_DNT); f16_t* HID = (f16_t*)(ws + WS_HID); f16_t* FFN16 = (f16_t*)(ws + WS_FFN16); f16_t* H1_16 = (f16_t*)(ws + WS_H1_16);
    int* cnt = (int*)(ws + WS_CNT); int* ltok = (int*)(ws + WS_LTOK); int* lpair = (int*)(ws + WS_LPAIR); float* pairw = (float*)(ws + WS_PAIRW);
    const int gw = F.vcu * NWAVES + F.wave, NGW = F.G * NWAVES;
    if (IN(0)) for (int rep_ = 0; rep_ < REP_P0; ++rep_) {
        LAS float* scr = (LAS float*)(F.lds + RING_OFF + F.wave * 16384);
        constexpr int I_IN = (D / 64) * (NPROJ / 32);
        for (int it = gw; it < I_IN; it += NGW) p0_transpose_item(args.in[5], D, NPROJ, WinT, 0, scr, it, FLANE);
        constexpr int I_SQ = (D / 64) * (D / 32), I_PLE = (256 / 64) * (D / 32);
        for (int it = gw; it < 2 * I_SQ + I_PLE; it += NGW) {
            if (it < I_SQ) p0_transpose_item(args.in[22], D, D, WoutT, 0, scr, it, FLANE);
            else if (it < 2 * I_SQ) p0_transpose_item(args.in[36], D, D, GateT, 0, scr, it - I_SQ, FLANE);
            else p0_transpose_item(args.in[34], 256, D, PleT, 0, scr, it - 2 * I_SQ, FLANE);
        }
        { const GAS f32x4* pi = (const GAS f32x4*)args.in[1]; GAS unsigned long long* po = (GAS unsigned long long*)P16;
          for (int i = blockIdx.x * 512 + FTID; i < T * 256 / 4; i += F.G * 512) { const f32x4 v = pi[i]; po[i] = (unsigned long long)pk2h(v.x, v.y) | ((unsigned long long)pk2h(v.z, v.w) << 32); } }
        { GAS v4u* z = (GAS v4u*)(WinT + (size_t)NPROJ * D); const int nz = (PN - NPROJ) * D * 2 / 16;
          for (int i = blockIdx.x * 512 + FTID; i < nz; i += F.G * 512) z[i] = (v4u){0u, 0u, 0u, 0u}; }
        {
            f16_t* W2T = (f16_t*)(ws + WS_W2T); f16_t* A2T = (f16_t*)(ws + WS_A2T); f16_t* G2T = (f16_t*)(ws + WS_G2T);
            for (int i = blockIdx.x * 512 + FTID; i < 1024 * 288; i += F.G * 512) { const int n = i / 288, k = i % 288;
                if (k < 64) W2T[n * 64 + k] = __builtin_bit_cast(unsigned short, (_Float16)args.in[13][k * 1024 + n]);
                else if (k < 128) A2T[n * 64 + (k - 64)] = __builtin_bit_cast(unsigned short, (_Float16)args.in[15][(k - 64) * 1024 + n]);
                else G2T[n * 160 + (k - 128)] = __builtin_bit_cast(unsigned short, (_Float16)args.in[16][(k - 128) * 1024 + n]); } }
        if (blockIdx.x == 0) {
            const int tid = FTID; float* lamp = (float*)(ws + WS_LAM); float* biasT = (float*)(ws + WS_BIAS);
            if (tid < 64) { const float a = wave_sum_b(args.in[6][tid] * args.in[7][tid]), b2 = wave_sum_b(args.in[8][tid] * args.in[9][tid]); if (tid == 0) *lamp = expf(a) - expf(b2) + LAMBDA_INIT; }
            for (int i = tid; i < 8 * 129; i += 512) { const int hh = i / 129, n = i % 129; int bucket;
                if (n < 16) bucket = n; else { const int large = 16 + (int)(logf((float)n / 16.f) / 2.0794415416798357f * 16.f); bucket = large < 31 ? large : 31; }
                biasT[i] = args.in[4][bucket * 8 + hh]; }
        }
        for (int m = gw; m < T; m += NGW) ln_row_dual(FLANE, args.in[0] + (size_t)m * D, args.in[2], args.in[3], args.out + (size_t)m * D, H16 + (size_t)m * D);
        if (BOTH(0) && rep_ == REP_P0 - 1) xcd_barrier(bar); else __syncthreads();
    }
    if (PROBE_K == 0) tk_ = __builtin_amdgcn_s_memrealtime();
    if (IN(1)) {
        pg8::Gemm g{H16, WinT, T, 6144, D, D}; pg8::StaticOrder S; S.init(T, 6144, F.G, (int)blockIdx.x);
        pg8::EpiF16 E{PROJ16, PN, 4, att::C2};
        for (int rep_ = 0; rep_ < REP_PROJ; ++rep_) pg8::gemm_phase<pg8::EpiF16, pg8::StaticOrder, true>(F.lds + RING_OFF, g, S, E, F.wave);
        { pg8::Gemm gl{H16, WinT + (size_t)6144 * D, T, 512, 512, D}; pg8::SplitKOrder Sl{T / 256, 2, 4, F.G, (int)blockIdx.x};
          pg8::EpiSlab El{(f16_t*)(ws + WS_LSLAB), 512, (size_t)T * 512};
          pg8::gemm_phase<pg8::EpiSlab, pg8::SplitKOrder, true>(F.lds + RING_OFF, gl, Sl, El, F.wave); }
        for (int rep_ = 0; rep_ < REP_PLE; ++rep_) { pg8::Gemm g2{P16, PleT, T, D, 256, 256}; pg8::StaticOrder S2; S2.init(T, D, F.G, (int)blockIdx.x);
          pg8::EpiF16 E2{PW16, D, 0, 1.f};
          pg8::gemm_phase<pg8::EpiF16, pg8::StaticOrder, true>(F.lds + RING_OFF, g2, S2, E2, F.wave); }
        if (BOTH(1)) xcd_barrier(bar);
    }
    if (PROBE_K == 1) tk_ = __builtin_amdgcn_s_memrealtime();
    if (IN(2)) {
        for (int rep_ = 0; rep_ < REP_P2; ++rep_)
        if (F.vcu < T / 32) { const int tile = F.vcu;
            rwkv_prep_tile(F, tile, PROJ16, (const f16_t*)(ws + WS_LSLAB), args.in[11], args.in[12], (const f16_t*)(ws + WS_W2T), args.in[14], (const f16_t*)(ws + WS_A2T), (const f16_t*)(ws + WS_G2T), args.in[17], args.in[18], DECAY, KMOD, A16, B16, G16);
            asm volatile("s_waitcnt vmcnt(0)" ::: "memory"); __syncthreads();
            { rk::ChunkIn nin; const int tl_ = (F.wave & 3) * 64 + FLANE, tg_ = tile * 32 + (tl_ >> 3), ps_ = tg_ & (S - 1), cb_ = (F.wave >> 2) * 64 + (tl_ & 7) * 8;
              rk::chunk_load(nin, tg_, ps_, cb_, ws);
              for (int hA = 0; hA < 16; hA += 2) {
                  rk::chunk_pair(F.lds + RING_OFF, F.wave, tile, hA, nin, hA + 2 < 16, args.in[11], args.in[19], ws); } }
            __syncthreads();
        }
        if (BOTH(2)) xcd_barrier(bar);
    }
    if (PROBE_K == 2) tk_ = __builtin_amdgcn_s_memrealtime();
    if (IN(3)) {
        if (F.vcu < 64) rk::scan_unit(F.lds + RING_OFF, F.wave, F.vcu, ws + WS_CHK, (const float*)(ws + WS_BONUS), PROJ16, args.in[11], G16, args.in[20], args.in[21], Y16);
        {
            const float lam = *(const float*)(ws + WS_LAM);
            volatile LAS unsigned* qslot = F.MISC + 12;
            const float* wg = args.in[29]; const float* wu = args.in[30]; const float* wd = args.in[31];
            auto conv_batch = [&]() -> bool {
                __syncthreads();
                if (FTID == 0) qslot[1] = __hip_atomic_fetch_add(F.ctl + CW_CONVQ, 1u, __ATOMIC_RELAXED, __HIP_MEMORY_SCOPE_AGENT);
                __syncthreads();
                const int q = (int)__builtin_amdgcn_readfirstlane(qslot[1]);
                if (q >= NE * 1536 / 64) return false;
                LAS float* scr = (LAS float*)(F.lds + RING_OFF + F.wave * 16384);
                tp_stream(q * 64 + F.wave, q * 64 + 64, 8, [=](int it) { const int e = it / 1536, r = it % 1536;
                    if (r < 1024) { const int rr = r & 511, nb = rr % 16; return TpDesc{(r < 512 ? wg : wu) + (size_t)e * D * 512, GUT + (size_t)e * 1024 * D, D, 512, 128 * (nb >> 2) + (r < 512 ? 0 : 128), rr}; }
                    return TpDesc{wd + (size_t)e * 512 * D, DNT + (size_t)e * D * 512, 512, D, 0, r - 1024}; }, scr, FLANE);
                return true;
            };
            int credit = 0;
            for (;;) {
                __syncthreads();
                if (FTID == 0) *qslot = __hip_atomic_fetch_add(F.ctl + CW_ATTQ, 1u, __ATOMIC_RELAXED, __HIP_MEMORY_SCOPE_AGENT);
                __syncthreads();
                const int u = (int)__builtin_amdgcn_readfirstlane(*qslot);
                if (u >= 512) break;
                const int qb = 15 - (u >> 5), bh = u & 31;
                att::attn_unit<8>(F.lds + RING_OFF, F.wave, bh >> 3, bh & 7, qb, PROJ16, Y16, (const float*)(ws + WS_BIAS) + (bh & 7) * 129, lam, args.in[10]);
                credit += 2 * (qb + 1) * CONV_RATE;
                while (credit >= 8704) { credit -= 8704; if (!conv_batch()) { credit = 0; break; } }
            }
            while (conv_batch()) {}
        }
        if (BOTH(3)) xcd_barrier(bar);
    }
    if (PROBE_K == 3) tk_ = __builtin_amdgcn_s_memrealtime();
    if (IN(4)) {
        for (int i = blockIdx.x * 512 + FTID; i < 36 * D; i += F.G * 512) { const int e = i / D, d = i % D; RT[i] = e < 4 ? args.in[25][d * 4 + e] : args.in[27][d * 32 + (e - 4)]; }
        pg8::Gemm g{Y16, WoutT, T, D, D, D}; pg8::StaticOrder S; S.init(T, D, F.G, (int)blockIdx.x);
        pg8::EpiResF32 E{args.out, D, ALPHA};
        pg8::gemm_phase<pg8::EpiResF32, pg8::StaticOrder, true>(F.lds + RING_OFF, g, S, E, F.wave);
        if (BOTH(4)) xcd_barrier(bar);
    }
    if (PROBE_K == 4) tk_ = __builtin_amdgcn_s_memrealtime();
    if (IN(5)) for (int rep_ = 0; rep_ < REP_P5; ++rep_) {
        const bool dry = rep_ < REP_P5 - 1;
        float* o32b = dry ? (float*)(ws + WS_CHK) : args.out; f16_t* o16b = dry ? (f16_t*)(ws + WS_CHK + 64 * MiB) : H1_16;
        const int lane = FLANE, tid = F.wave * 64 + lane;
        LAS float* rtb = (LAS float*)(F.lds + RING_OFF);
        LAS float* lg = (LAS float*)(F.lds + RING_OFF + 49152) + F.wave * 256;
        if (F.vcu < T / 32) {
            const int r0 = F.vcu * 32 + F.wave * 4;
            f32x4 v0[8], v1[8], v2[8], v3[8];
            { const GAS f32x4* xr = (const GAS f32x4*)(args.out + (size_t)r0 * D) + lane;
#pragma unroll
              for (int j = 0; j < 8; ++j) { v0[j] = xr[64 * j]; v1[j] = xr[64 * j + D / 4]; v2[j] = xr[64 * j + 2 * (D / 4)]; v3[j] = xr[64 * j + 3 * (D / 4)]; } }
            ln_norm(lane, v0, args.in[23], args.in[24]); ln_norm(lane, v1, args.in[23], args.in[24]); ln_norm(lane, v2, args.in[23], args.in[24]); ln_norm(lane, v3, args.in[23], args.in[24]);
            f32x4 stg[6];
#pragma unroll
            for (int i = 0; i < 6; ++i) stg[i] = *(const GAS f32x4*)(RT + 4 * (tid + 512 * i));
#pragma unroll 1
            for (int ec = 0; ec < 6; ++ec) {
                __syncthreads();
#pragma unroll
                for (int i = 0; i < 6; ++i) *(LAS f32x4*)(rtb + 4 * (tid + 512 * i)) = stg[i];
                { const int en = ec + 1 < 6 ? ec + 1 : ec;
#pragma unroll
                  for (int i = 0; i < 6; ++i) stg[i] = *(const GAS f32x4*)(RT + (size_t)en * 6 * D + 4 * (tid + 512 * i)); }
                __syncthreads();
                float a0[6], a1[6], a2[6], a3[6];
#pragma unroll
                for (int e = 0; e < 6; ++e) { a0[e] = 0.f; a1[e] = 0.f; a2[e] = 0.f; a3[e] = 0.f; }
#pragma unroll
                for (int j = 0; j < 8; ++j)
#pragma unroll
                    for (int e = 0; e < 6; ++e) { const f32x4 w = *(const LAS f32x4*)(rtb + e * D + 256 * j + 4 * lane);
                        a0[e] += (v0[j].x * w.x + v0[j].y * w.y) + (v0[j].z * w.z + v0[j].w * w.w);
                        a1[e] += (v1[j].x * w.x + v1[j].y * w.y) + (v1[j].z * w.z + v1[j].w * w.w);
                        a2[e] += (v2[j].x * w.x + v2[j].y * w.y) + (v2[j].z * w.z + v2[j].w * w.w);
                        a3[e] += (v3[j].x * w.x + v3[j].y * w.y) + (v3[j].z * w.z + v3[j].w * w.w); }
#pragma unroll
                for (int e = 0; e < 6; ++e) { a0[e] = wsum64(a0[e]); a1[e] = wsum64(a1[e]); a2[e] = wsum64(a2[e]); a3[e] = wsum64(a3[e]); }
                if (lane == 0) {
#pragma unroll
                    for (int e = 0; e < 6; ++e) { lg[ec * 6 + e] = a0[e]; lg[64 + ec * 6 + e] = a1[e]; lg[128 + ec * 6 + e] = a2[e]; lg[192 + ec * 6 + e] = a3[e]; } }
            }
            LDS_WAIT();
            if (lane < 4 && !dry) { float aa[36];
#pragma unroll
                for (int e = 0; e < 36; ++e) aa[e] = lg[lane * 64 + e];
                route_token(r0 + lane, aa, args.in[26], args.in[28], cnt, ltok, lpair, pairw); }
            LDS_WAIT();
            ln_store(lane, v0, o32b + (size_t)r0 * D, o16b + (size_t)r0 * D); ln_store(lane, v1, o32b + (size_t)(r0 + 1) * D, o16b + (size_t)(r0 + 1) * D);
            ln_store(lane, v2, o32b + (size_t)(r0 + 2) * D, o16b + (size_t)(r0 + 2) * D); ln_store(lane, v3, o32b + (size_t)(r0 + 3) * D, o16b + (size_t)(r0 + 3) * D);
        }
        if (BOTH(5) && !dry) xcd_barrier(bar); else __syncthreads();
    }
    if (PROBE_K == 5) tk_ = __builtin_amdgcn_s_memrealtime();
    if (IN(6)) {
        build_moe_table(F, cnt);
        pg8::Gemm g{H1_16, GUT, 0, 0, D, D}; pg8::MoeOrder<true> S{(const LAS int*)(F.lds + TAB_OFF), ltok, F.vcu, F.G, 4, (size_t)1024 * D * 2, 0};
        pg8::EpiGU E{HID};
        for (int rep_ = 0; rep_ < REP_P6; ++rep_) pg8::gemm_phase<pg8::EpiGU, pg8::MoeOrder<true>, true>(F.lds + RING_OFF, g, S, E, F.wave);
        if (BOTH(6)) xcd_barrier(bar);
    }
    if (PROBE_K == 6) tk_ = __builtin_amdgcn_s_memrealtime();
    if (IN(7)) {
        build_moe_table(F, cnt);
        const pg8::Gemm gU{H1_16, GUT, 0, 0, D, D}; const pg8::Gemm gD{HID, DNT, 0, 0, 512, 512};
        const pg8::EpiGU EU{HID}; const pg8::EpiDown ED{FFN16, lpair};
        if (F.vcu < 64) { pg8::MoeOrder<true> S{(const LAS int*)(F.lds + TAB_OFF), ltok, F.vcu, 64, 4, (size_t)1024 * D * 2, 1};
            pg8::gemm_phase<pg8::EpiGU, pg8::MoeOrder<true>, true>(F.lds + RING_OFF, gU, S, EU, F.wave); }
        else { pg8::MoeOrder<false> S{(const LAS int*)(F.lds + TAB_OFF), nullptr, F.vcu - 64, F.G - 64, 8, (size_t)D * 512 * 2, 0};
            pg8::gemm_phase<pg8::EpiDown, pg8::MoeOrder<false>, true>(F.lds + RING_OFF, gD, S, ED, F.wave); }
        xcd_barrier(bar);
        { pg8::MoeOrder<false> S{(const LAS int*)(F.lds + TAB_OFF), nullptr, F.vcu, F.G, 8, (size_t)D * 512 * 2, 1};
          pg8::gemm_phase<pg8::EpiDown, pg8::MoeOrder<false>, true>(F.lds + RING_OFF, gD, S, ED, F.wave); }
        if (BOTH(7)) xcd_barrier(bar);
    }
    if (PROBE_K == 7) tk_ = __builtin_amdgcn_s_memrealtime();
    if (IN(8)) for (int rep_ = 0; rep_ < REP_P8; ++rep_) {
        const bool dry = rep_ < REP_P8 - 1;
        float* o32b = dry ? (float*)(ws + WS_GUT) : args.out; f16_t* o16b = dry ? (f16_t*)(ws + WS_GUT + 64 * MiB) : Y16; float* rrs = dry ? (float*)(ws + WS_GUT + 100 * MiB) : ROWRS;
        typedef _Float16 h4_t __attribute__((ext_vector_type(4)));
        const int lane = FLANE;
        for (int m = gw; m < T; m += NGW) {
            f32x4 v[8]; const GAS f32x4* xr = (const GAS f32x4*)(args.out + (size_t)m * D) + lane;
            const GAS h4_t* f0 = (const GAS h4_t*)(FFN16 + (size_t)(2 * m) * D) + lane; const GAS h4_t* f1 = (const GAS h4_t*)(FFN16 + (size_t)(2 * m + 1) * D) + lane;
            const GAS h4_t* pr = (const GAS h4_t*)(PW16 + (size_t)m * D) + lane;
            const float w0 = pairw[2 * m], w1 = pairw[2 * m + 1]; float q = 0.f;
#pragma unroll
            for (int j = 0; j < 8; ++j) { const f32x4 x = xr[64 * j]; const h4_t a = f0[64 * j], c = f1[64 * j], pv = pr[64 * j];
                v[j].x = ALPHA * x.x + w0 * (float)a[0] + w1 * (float)c[0]; v[j].y = ALPHA * x.y + w0 * (float)a[1] + w1 * (float)c[1];
                v[j].z = ALPHA * x.z + w0 * (float)a[2] + w1 * (float)c[2]; v[j].w = ALPHA * x.w + w0 * (float)a[3] + w1 * (float)c[3];
                q += ((float)pv[0] * (float)pv[0] + (float)pv[1] * (float)pv[1]) + ((float)pv[2] * (float)pv[2] + (float)pv[3] * (float)pv[3]); }
            ln_regs(lane, v, args.in[32], args.in[33], o32b + (size_t)m * D, o16b + (size_t)m * D);
            q = wave_sum_b(q);
            if (lane == 0) rrs[m] = __builtin_amdgcn_rsqf(q * (1.f / D) + LN_EPS);
        }
        if (BOTH(8) && !dry) xcd_barrier(bar); else __syncthreads();
    }
    if (PROBE_K == 8) tk_ = __builtin_amdgcn_s_memrealtime();
    if (IN(9)) {
        pg8::Gemm g{Y16, GateT, T, D, D, D}; pg8::StaticOrder S; S.init(T, D, F.G, (int)blockIdx.x);
        pg8::EpiFinal E{args.out, D, PW16, ROWRS, args.in[35]};
        pg8::gemm_phase<pg8::EpiFinal, pg8::StaticOrder, true>(F.lds + RING_OFF, g, S, E, F.wave);
    }
    if (PROBE_K != -1) {
        if (PROBE_K == 9) tk_ = __builtin_amdgcn_s_memrealtime();
        xcd_barrier(bar);
        if (blockIdx.x == 0 && FTID == 0) args.out[0] += (PROBE_K == -2) ? 100000.f : (float)(tk_ - t0_);
    }
#undef IN
#undef BOTH
}

extern "C" void kernel_launch(void* const* d_in, const int* in_sizes, int n_in, void* d_out, int out_size, void* d_ws, size_t ws_size, hipStream_t stream) {
    static int grid = 0;
    if (grid == 0) {
        if (ws_size < WS_END2 || n_in != 37 || out_size != T * D) { fprintf(stderr, "kernel_launch: bad ws/n_in/out: %zu %d %d\n", ws_size, n_in, out_size); grid = -1; return; }
        int dev = 0, cus = 0;
        if (hipGetDevice(&dev) != hipSuccess || hipDeviceGetAttribute(&cus, hipDeviceAttributeMultiprocessorCount, dev) != hipSuccess) { grid = -1; return; }
        if (hipFuncSetAttribute((const void*)mega_fwd, hipFuncAttributeMaxDynamicSharedMemorySize, LDS_BYTES) != hipSuccess) { fprintf(stderr, "kernel_launch: hipFuncSetAttribute failed\n"); grid = -1; return; }
        if (cus != 256) { fprintf(stderr, "kernel_launch: built for a 256-CU device, found %d\n", cus); grid = -1; return; }
        grid = cus;
    }
    if (grid < 0) return;
    (void)hipMemsetAsync(d_ws, 0, CTL_ZERO_BYTES, stream);
    Args a{}; for (int i = 0; i < 37; ++i) a.in[i] = (const float*)d_in[i]; a.out = (float*)d_out; a.ws = (unsigned char*)d_ws; a.ph_lo = 0; a.ph_hi = 10; a.li = 0;
    hipLaunchKernelGGL(mega_fwd, dim3(grid), dim3(NWAVES * 64), LDS_BYTES, stream, a);
}
```

```cpp
#include <hip/hip_runtime.h>
#include <cstdio>
#include <cstdint>
#include <cmath>

constexpr int NB = 4, S = 2048, D = 2048, T = NB * S;
constexpr int NPROJ = 6432;
constexpr int RWK = 1024;
constexpr int COL_Q = 0, COL_K = 1024, COL_V = 2048, COL_RW = 3072;
constexpr int NH = 8, NRH = 16;
constexpr int NE = 32;
constexpr float LN_EPS = 1e-5f;
constexpr float ALPHA = 1.189207115002721f;
constexpr float LAMBDA_INIT = 0.2f;

constexpr size_t MiB = 1u << 20;
constexpr size_t WS_CNT = 0;
constexpr size_t WS_LTOK = 1 * MiB;
constexpr size_t WS_LPAIR = 2 * MiB;
constexpr size_t WS_PAIRW = 3 * MiB;
constexpr size_t WS_RT = 3 * MiB + 128 * 1024;
constexpr size_t WS_LAM = 3 * MiB + 512 * 1024;
constexpr size_t WS_BIAS = 3 * MiB + 512 * 1024 + 1024;
constexpr size_t WS_ROWRS = 3 * MiB + 768 * 1024;
constexpr size_t WS_ROWST = 3 * MiB + 832 * 1024;
constexpr size_t WS_WINT = 4 * MiB;
constexpr size_t WS_WOUTT = 30 * MiB;
constexpr size_t WS_GATET = 38 * MiB;
constexpr size_t WS_PLET = 46 * MiB;
constexpr size_t WS_P16 = 47 * MiB;
constexpr size_t WS_W2T = 51 * MiB;
constexpr size_t WS_A2T = 51 * MiB + 128 * 1024;
constexpr size_t WS_G2T = 51 * MiB + 256 * 1024;
constexpr size_t WS_CHK = 52 * MiB;
constexpr size_t WS_BONUS = 148 * MiB;
constexpr size_t WS_LSLAB = 150 * MiB;
constexpr size_t WS_GUT = 348 * MiB;
constexpr size_t WS_DNT = 150 * MiB;
constexpr size_t WS_PROJ16 = 244 * MiB;
constexpr size_t WS_FFN16 = 52 * MiB;
constexpr size_t WS_HID = 116 * MiB;
constexpr size_t WS_DECAY = 348 * MiB;
constexpr size_t WS_KMOD = 380 * MiB;
constexpr size_t WS_A16 = 396 * MiB;
constexpr size_t WS_B16 = 412 * MiB;
constexpr size_t WS_G16 = 214 * MiB;
constexpr size_t WS_H16 = 444 * MiB;
constexpr size_t WS_H1_16 = 244 * MiB;
constexpr size_t WS_Y16 = 476 * MiB;
constexpr size_t WS_PW16 = 508 * MiB;
constexpr size_t WS_END2 = 540 * MiB;

namespace pg8 {
#define PG8_LAS __attribute__((address_space(3)))
typedef unsigned short f16_t;
typedef _Float16 f16x8 __attribute__((ext_vector_type(8)));
typedef float f32x4 __attribute__((ext_vector_type(4)));
typedef unsigned u32x4 __attribute__((ext_vector_type(4)));
constexpr int BM = 256, BK = 64, HALF = 128, HTB = HALF * BK * 2  , STAGE_BYTES = 8 * HTB, NXCD = 8, WGM = 8;

__host__ __device__ __forceinline__ int lds_byte(int r, int c) { const int st = (r >> 4) * 2 + (c >> 5), rr = r & 15, cc = c & 31, ob = rr * 64 + cc * 2; return st * 1024 + (ob ^ (((ob >> 9) & 1) << 5)); }
__host__ __device__ __forceinline__ void stage_rc(int b, int& R, int& C) { const int st = b / 1024, sb = b % 1024, swz = sb ^ (((sb >> 9) & 1) << 5); R = (st >> 1) * 16 + swz / 64; C = (st & 1) * 32 + (swz % 64) / 2; }
__host__ __device__ __forceinline__ int perm32(int rho) { const int n = rho >> 4, i = rho & 15; return 8 * (i >> 2) + 4 * n + (i & 3); }

__device__ __forceinline__ int lane_id() { int l; asm volatile("v_mbcnt_lo_u32_b32 %0, -1, 0\n\tv_mbcnt_hi_u32_b32 %0, -1, %0" : "=v"(l)); return l; }
struct Unit { int pm, pn, e, rb, cnt; };
struct Gemm { const f16_t* A; const f16_t* Bt; int M, N, K, ld; };

struct StaticOrder {
    int nM, nN, nwg, G, c;
    __host__ __device__ void init(int M, int N, int G_, int c_) { nM = M / BM; nN = N / BM; nwg = nM * nN; G = G_; c = c_; }
    __host__ __device__ bool next(int i, Unit& u) const {
        const long L = (long)i * G + c; if (L >= nwg) return false;
        int wgid = (int)L; { const int q = nwg / NXCD, r = nwg % NXCD, xcd = wgid % NXCD, off = wgid / NXCD; wgid = (xcd < r ? xcd * (q + 1) : r * (q + 1) + (xcd - r) * q) + off; }
        const int nig = WGM * nN, gid = wgid / nig, fm = gid * WGM, gsz = (nM - fm) < WGM ? (nM - fm) : WGM;
        u.pm = fm + ((wgid % nig) % gsz); u.pn = (wgid % nig) / gsz; return true;
    }
    __device__ __forceinline__ void a_ready(const Unit&) const {}
    __device__ __forceinline__ void done(const Unit&) const {}
    __device__ __forceinline__ const char* a_base(const Gemm& g, const Unit& u) const { return (const char*)g.A + (size_t)u.pm * ((size_t)BM * g.ld * 2); }
    __device__ __forceinline__ const char* b_base(const Gemm& g, const Unit& u) const { return (const char*)g.Bt + (size_t)u.pn * ((size_t)BM * g.ld * 2); }
    __device__ __forceinline__ void a_voff(const Gemm& g, const Unit&, int tid, unsigned (&va)[2][2]) const {
#pragma unroll
        for (int i = 0; i < 2; ++i) { int R, C; stage_rc(tid * 16 + i * 8192, R, C); va[0][i] = (unsigned)(R * g.ld + C) * 2u; va[1][i] = va[0][i] + (unsigned)(HALF * g.ld * 2); }
    }
};
struct SplitKOrder {
    int nM, nN, nks, G, c;
    __device__ __forceinline__ bool next(int i, Unit& u) const { const int L = i * G + c; if (L >= nM * nN * nks) return false; u.e = L / (nM * nN); const int rem = L % (nM * nN); u.pn = rem / nM; u.pm = rem % nM; u.rb = 0; u.cnt = 0; return true; }
    __device__ __forceinline__ void a_ready(const Unit&) const {}
    __device__ __forceinline__ void done(const Unit&) const {}
    __device__ __forceinline__ const char* a_base(const Gemm& g, const Unit& u) const { return (const char*)g.A + (size_t)u.pm * ((size_t)BM * g.ld * 2) + (size_t)u.e * g.K * 2; }
    __device__ __forceinline__ const char* b_base(const Gemm& g, const Unit& u) const { return (const char*)g.Bt + (size_t)u.pn * ((size_t)BM * g.ld * 2) + (size_t)u.e * g.K * 2; }
    __device__ __forceinline__ void a_voff(const Gemm& g, const Unit&, int tid, unsigned (&va)[2][2]) const {
#pragma unroll
        for (int i = 0; i < 2; ++i) { int R, C; stage_rc(tid * 16 + i * 8192, R, C); va[0][i] = (unsigned)(R * g.ld + C) * 2u; va[1][i] = va[0][i] + (unsigned)(HALF * g.ld * 2); }
    }
};
template <bool GATHER> struct MoeOrder {
    const PG8_LAS int* tab; const int* list; int vcu, G, ntn; size_t estride; int cls;
    __device__ __forceinline__ bool next(int i, Unit& u) const {
        const int L = vcu + i * G; const int base = cls ? 98 : 65; const int tot = tab[base + 32] * ntn; if (L >= tot) return false;
        int e = 0; while (tab[base + 1 + e] * ntn <= L) ++e;
        const int nbk = tab[base + 1 + e] - tab[base + e], q = L - tab[base + e] * ntn; const int rb = q % nbk + (cls ? 2 : 0);
        u.e = __builtin_amdgcn_readfirstlane(e); u.pn = __builtin_amdgcn_readfirstlane(q / nbk); u.rb = __builtin_amdgcn_readfirstlane(rb);
        u.pm = __builtin_amdgcn_readfirstlane(tab[32 + e] + rb); u.cnt = __builtin_amdgcn_readfirstlane(tab[e]); return true;
    }
    __device__ __forceinline__ void a_ready(const Unit&) const {}
    __device__ __forceinline__ void done(const Unit&) const {}
    __device__ __forceinline__ const char* a_base(const Gemm& g, const Unit& u) const { return GATHER ? (const char*)g.A : (const char*)g.A + (size_t)u.pm * ((size_t)BM * g.ld * 2); }
    __device__ __forceinline__ const char* b_base(const Gemm& g, const Unit& u) const { return (const char*)g.Bt + (size_t)u.e * estride + (size_t)u.pn * ((size_t)BM * g.ld * 2); }
    __device__ __forceinline__ void a_voff(const Gemm& g, const Unit& u, int tid, unsigned (&va)[2][2]) const {
#pragma unroll
        for (int i = 0; i < 2; ++i) { int R, C; stage_rc(tid * 16 + i * 8192, R, C);
            if (GATHER) {
#pragma unroll
                for (int h = 0; h < 2; ++h) { int idx = u.rb * BM + h * HALF + R; idx = idx < u.cnt ? idx : u.cnt - 1; const int tok = list[u.e * 8192 + idx]; va[h][i] = (unsigned)(tok * g.ld + C) * 2u; }
            } else { va[0][i] = (unsigned)(R * g.ld + C) * 2u; va[1][i] = va[0][i] + (unsigned)(HALF * g.ld * 2); } }
    }
};


typedef _Float16 h2_t __attribute__((ext_vector_type(2)));
__device__ __forceinline__ unsigned cvt_pk_f16(float lo, float hi) { h2_t v = {(_Float16)lo, (_Float16)hi}; return __builtin_bit_cast(unsigned, v); }
struct EpiF16 {
    static constexpr bool PERM = true, AFTER_DRAIN = false;
    f16_t* O; int ldc; int ntile0; float scale0;
    __device__ __forceinline__ void operator()(const f32x4 (&acc)[2][2][4][2], const Unit& u, int wr, int wc, int fr, int fq) const {
        const int row0 = u.pm * BM + wr * 64 + fr; const int col0 = u.pn * BM + wc * 32 + 8 * fq;
        const float sc = (u.pn < ntile0) ? scale0 : 1.f;
#pragma unroll
        for (int ai = 0; ai < 2; ++ai)
#pragma unroll
            for (int m = 0; m < 4; ++m) { f16_t* rowp = O + (size_t)(row0 + ai * HALF + m * 16) * ldc + col0;
#pragma unroll
                for (int bj = 0; bj < 2; ++bj) { f32x4 v0 = acc[ai][bj][m][0] * sc, v1 = acc[ai][bj][m][1] * sc;
                    u32x4 w; w.x = cvt_pk_f16(v0[0], v0[1]); w.y = cvt_pk_f16(v0[2], v0[3]); w.z = cvt_pk_f16(v1[0], v1[1]); w.w = cvt_pk_f16(v1[2], v1[3]);
                    *(u32x4*)(rowp + bj * HALF) = w; } }
    }
};


struct EpiSlab {
    static constexpr bool PERM = true, AFTER_DRAIN = false;
    f16_t* O; int ldc; size_t slab;
    __device__ __forceinline__ void operator()(const f32x4 (&acc)[2][2][4][2], const Unit& u, int wr, int wc, int fr, int fq) const {
        const int row0 = u.pm * BM + wr * 64 + fr; const int col0 = u.pn * BM + wc * 32 + 8 * fq; f16_t* Ob = O + (size_t)u.e * slab;
#pragma unroll
        for (int ai = 0; ai < 2; ++ai)
#pragma unroll
            for (int m = 0; m < 4; ++m) { f16_t* rowp = Ob + (size_t)(row0 + ai * HALF + m * 16) * ldc + col0;
#pragma unroll
                for (int bj = 0; bj < 2; ++bj) { const f32x4 v0 = acc[ai][bj][m][0], v1 = acc[ai][bj][m][1];
                    u32x4 w; w.x = cvt_pk_f16(v0[0], v0[1]); w.y = cvt_pk_f16(v0[2], v0[3]); w.z = cvt_pk_f16(v1[0], v1[1]); w.w = cvt_pk_f16(v1[2], v1[3]);
                    *(u32x4*)(rowp + bj * HALF) = w; } }
    }
};
struct EpiResF32 {
    static constexpr bool PERM = false, AFTER_DRAIN = false;
    float* io; int ldc; float alpha;
    __device__ __forceinline__ void operator()(const f32x4 (&acc)[2][2][4][2], const Unit& u, int wr, int wc, int fr, int fq) const {
        const int row0 = u.pm * BM + wr * 64 + fr; const int col0 = u.pn * BM + wc * 32 + 4 * fq;
#pragma unroll
        for (int ai = 0; ai < 2; ++ai)
#pragma unroll
            for (int m = 0; m < 4; ++m) { float* rowp = io + (size_t)(row0 + ai * HALF + m * 16) * ldc + col0;
#pragma unroll
                for (int bj = 0; bj < 2; ++bj)
#pragma unroll
                    for (int n = 0; n < 2; ++n) { f32x4* p = (f32x4*)(rowp + bj * HALF + n * 16); const f32x4 r = *p; *p = r * alpha + acc[ai][bj][m][n]; } }
    }
};
struct EpiResLN {
    static constexpr bool PERM = false, AFTER_DRAIN = false;
    const float* x; float* out; int ldc; float alpha; const float2* st; const float* g; const float* b;
    __device__ __forceinline__ void operator()(const f32x4 (&acc)[2][2][4][2], const Unit& u, int wr, int wc, int fr, int fq) const {
        const int row0 = u.pm * BM + wr * 64 + fr; const int col0 = u.pn * BM + wc * 32 + 4 * fq;
        f32x4 gg[2][2], bb[2][2];
#pragma unroll
        for (int bj = 0; bj < 2; ++bj)
#pragma unroll
            for (int n = 0; n < 2; ++n) { gg[bj][n] = *(const f32x4*)(g + col0 + bj * HALF + n * 16); bb[bj][n] = *(const f32x4*)(b + col0 + bj * HALF + n * 16); }
#pragma unroll
        for (int ai = 0; ai < 2; ++ai)
#pragma unroll
            for (int m = 0; m < 4; ++m) { const int row = row0 + ai * HALF + m * 16; const float2 ms = st[row];
                const float* xp = x + (size_t)row * ldc + col0; float* op = out + (size_t)row * ldc + col0;
#pragma unroll
                for (int bj = 0; bj < 2; ++bj)
#pragma unroll
                    for (int n = 0; n < 2; ++n) { const f32x4 r = *(const f32x4*)(xp + bj * HALF + n * 16);
                        const f32x4 h = (r - ms.x) * ms.y * gg[bj][n] + bb[bj][n]; *(f32x4*)(op + bj * HALF + n * 16) = h * alpha + acc[ai][bj][m][n]; } }
    }
};
struct EpiFinal {
    static constexpr bool PERM = false, AFTER_DRAIN = false;
    float* io; int ldc; const f16_t* pw; const float* rowrs; const float* g;
    __device__ __forceinline__ void operator()(const f32x4 (&acc)[2][2][4][2], const Unit& u, int wr, int wc, int fr, int fq) const {
        typedef _Float16 h4_t __attribute__((ext_vector_type(4)));
        const int row0 = u.pm * BM + wr * 64 + fr; const int col0 = u.pn * BM + wc * 32 + 4 * fq;
#pragma unroll
        for (int ai = 0; ai < 2; ++ai)
#pragma unroll
            for (int m = 0; m < 4; ++m) { const int row = row0 + ai * HALF + m * 16; const size_t off = (size_t)row * ldc + col0;
                const float rs = rowrs[row];
#pragma unroll
                for (int bj = 0; bj < 2; ++bj)
#pragma unroll
                    for (int n = 0; n < 2; ++n) { f32x4* p = (f32x4*)(io + off + bj * HALF + n * 16); const f32x4 hv = *p; const h4_t pv = *(const h4_t*)(pw + off + bj * HALF + n * 16);
                        const f32x4 gv = *(const f32x4*)(g + col0 + bj * HALF + n * 16);
                        const f32x4 a = acc[ai][bj][m][n]; f32x4 o;
#pragma unroll
                        for (int c = 0; c < 4; ++c) o[c] = hv[c] + (1.f / (1.f + __expf(-a[c]))) * ((float)pv[c] * rs) * gv[c];
                        *p = o; }
                asm volatile("" ::: "memory"); }
    }
};

struct EpiGU {
    static constexpr bool PERM = true, AFTER_DRAIN = false;
    f16_t* O;
    __device__ __forceinline__ void operator()(const f32x4 (&acc)[2][2][4][2], const Unit& u, int wr, int wc, int fr, int fq) const {
        const int row0 = u.pm * BM + wr * 64 + fr; const int col0 = u.pn * HALF + wc * 32 + 8 * fq;
#pragma unroll
        for (int ai = 0; ai < 2; ++ai)
#pragma unroll
            for (int m = 0; m < 4; ++m) { f16_t* rowp = O + (size_t)(row0 + ai * HALF + m * 16) * 512 + col0; float o[8];
#pragma unroll
                for (int n = 0; n < 2; ++n)
#pragma unroll
                    for (int c = 0; c < 4; ++c) { const float gt = acc[ai][0][m][n][c], up = acc[ai][1][m][n][c]; o[n * 4 + c] = gt / (1.f + __expf(-gt)) * up; }
                u32x4 w; w.x = cvt_pk_f16(o[0], o[1]); w.y = cvt_pk_f16(o[2], o[3]); w.z = cvt_pk_f16(o[4], o[5]); w.w = cvt_pk_f16(o[6], o[7]);
                *(u32x4*)rowp = w; }
    }
};
struct EpiDown {
    static constexpr bool PERM = true, AFTER_DRAIN = false;
    f16_t* O; const int* lpair;
    __device__ __forceinline__ void operator()(const f32x4 (&acc)[2][2][4][2], const Unit& u, int wr, int wc, int fr, int fq) const {
        const int r0 = u.rb * BM + wr * 64 + fr; const int col0 = u.pn * BM + wc * 32 + 8 * fq;
#pragma unroll
        for (int ai = 0; ai < 2; ++ai)
#pragma unroll
            for (int m = 0; m < 4; ++m) { const int r = r0 + ai * HALF + m * 16;
                if (r < u.cnt) { const int pair = lpair[u.e * 8192 + r]; f16_t* rowp = O + (size_t)pair * 2048 + col0;
#pragma unroll
                    for (int bj = 0; bj < 2; ++bj) { const f32x4 v0 = acc[ai][bj][m][0], v1 = acc[ai][bj][m][1];
                        u32x4 w; w.x = cvt_pk_f16(v0[0], v0[1]); w.y = cvt_pk_f16(v0[2], v0[3]); w.z = cvt_pk_f16(v1[0], v1[1]); w.w = cvt_pk_f16(v1[2], v1[3]);
                        *(u32x4*)(rowp + bj * HALF) = w; } } }
    }
};
template <class Epi, class Sched, bool ALIGN_EPI = false, bool SP2 = true>
__device__ __forceinline__ void gemm_phase(PG8_LAS unsigned char* lds, const Gemm g, const Sched& S, const Epi& E, const int wid) {
    static_assert(SP2, "only the SP2 K-loop is kept in this file");
    const int lane = lane_id(), tid = wid * 64 + lane, wr = wid >> 2, wc = wid & 3, fr = lane & 15, fq = lane >> 4;
    const int K = g.ld, nt = g.K / BK;
    unsigned voffB[2];
#pragma unroll
    for (int i = 0; i < 2; ++i) { int R, C; stage_rc(tid * 16 + i * 8192, R, C); const int Rb = Epi::PERM ? ((R & ~31) + perm32(R & 31)) : R;
        voffB[i] = (unsigned)(Rb * K + C) * 2u; }
    const size_t kstep = (size_t)(BK * 2);
    const size_t hstep = (size_t)HALF * K * 2;
    const unsigned ldsw = (unsigned)wid * 1024u;
    const int aoff = lds_byte(wr * 64 + fr, fq * 8), boff = lds_byte(wc * 32 + fr, fq * 8);
#define PG8_SA(b, h) (((b) * 2 + (h)) * HTB)
#define PG8_SB(b, h) ((4 + (b) * 2 + (h)) * HTB)
#define PG8_STAGE(bufoff, gbase, voff) do { _Pragma("unroll") for (int _i = 0; _i < 2; ++_i) \
        __builtin_amdgcn_global_load_lds((const unsigned*)((const char*)(gbase) + (voff)[_i]), (PG8_LAS unsigned*)(lds + (bufoff) + ldsw + _i * 8192), 16, 0, 0); } while (0)
#define PG8_LDA(dst, b, h) do { _Pragma("unroll") for (int m = 0; m < 4; ++m) _Pragma("unroll") for (int k = 0; k < 2; ++k) dst[m][k] = *(const PG8_LAS f16x8*)(lds + PG8_SA(b, h) + aoff + m * 2048 + k * 1024); } while (0)
#define PG8_LDB(dst, b, h) do { _Pragma("unroll") for (int n = 0; n < 2; ++n) _Pragma("unroll") for (int k = 0; k < 2; ++k) dst[n][k] = *(const PG8_LAS f16x8*)(lds + PG8_SB(b, h) + boff + n * 2048 + k * 1024); } while (0)
#define PG8_MMA(ai, bj, At, Bt) do { __builtin_amdgcn_s_setprio(1); _Pragma("unroll") for (int m = 0; m < 4; ++m) _Pragma("unroll") for (int n = 0; n < 2; ++n) _Pragma("unroll") for (int k = 0; k < 2; ++k) \
        acc[ai][bj][m][n] = __builtin_amdgcn_mfma_f32_16x16x32_f16(Bt[n][k], At[m][k], acc[ai][bj][m][n], 0, 0, 0); __builtin_amdgcn_s_setprio(0); } while (0)
#define PG8_WAIT_V(n) asm volatile("s_waitcnt vmcnt(" #n ")" ::: "memory")
#define PG8_WAIT_L(n) asm volatile("s_waitcnt lgkmcnt(" #n ")" ::: "memory")
#define PG8_BAR __builtin_amdgcn_s_barrier()
#define PG8_SCHED __builtin_amdgcn_sched_barrier(0)
    Unit cur, nxt; int ui = 0;
    if (!S.next(0, cur)) return;
    f32x4 acc[2][2][4][2];
#pragma unroll
    for (int a = 0; a < 2; ++a)
#pragma unroll
        for (int b = 0; b < 2; ++b)
#pragma unroll
            for (int m = 0; m < 4; ++m)
#pragma unroll
                for (int n = 0; n < 2; ++n) acc[a][b][m][n] = (f32x4){0.f, 0.f, 0.f, 0.f};
    f16x8 At[4][2], B0[2][2], B1[2][2];
    const char* cA = S.a_base(g, cur); const char* cB = S.b_base(g, cur);
    unsigned vaC[2][2];
    S.a_voff(g, cur, tid, vaC);
    S.a_ready(cur);
    PG8_STAGE(PG8_SB(0, 0), cB, voffB); PG8_STAGE(PG8_SB(0, 1), cB + hstep, voffB); PG8_STAGE(PG8_SA(0, 0), cA, vaC[0]); PG8_STAGE(PG8_SA(0, 1), cA, vaC[1]);
    if (wr == 1) PG8_BAR;
    PG8_WAIT_V(2); PG8_BAR;
    PG8_STAGE(PG8_SB(1, 0), cB + kstep, voffB); PG8_STAGE(PG8_SA(1, 0), cA + kstep, vaC[0]); PG8_STAGE(PG8_SB(1, 1), cB + hstep + kstep, voffB);
    PG8_WAIT_V(6); PG8_BAR;
    for (;;) {
        const bool has_next = S.next(ui + 1, nxt);
        const char* nA = has_next ? S.a_base(g, nxt) : cA; const char* nB = has_next ? S.b_base(g, nxt) : cB;
        for (int t = 0; t < nt; t += 2) {
            const bool last = (t == nt - 2);

            const char* a1 = cA + (size_t)(t + 1) * kstep;
            const char* a2 = last ? nA : cA + (size_t)(t + 2) * kstep; const char* b2 = last ? nB : cB + (size_t)(t + 2) * kstep;
            const char* a3 = a2 + kstep; const char* b3 = b2 + kstep;
            if (last && has_next) S.a_ready(nxt);
            PG8_LDB(B0, 0, 0); PG8_LDB(B1, 0, 1); PG8_SCHED; PG8_LDA(At, 0, 0); PG8_STAGE(PG8_SA(1, 1), a1, vaC[1]);
            if (last && has_next) S.a_voff(g, nxt, wid * 64 + lane_id(), vaC);
            PG8_WAIT_V(8); PG8_WAIT_L(0); PG8_BAR; PG8_MMA(0, 0, At, B0); PG8_MMA(0, 1, At, B1); PG8_BAR; PG8_SCHED;
            PG8_LDA(At, 0, 1); PG8_STAGE(PG8_SB(0, 0), b2, voffB); PG8_STAGE(PG8_SB(0, 1), b2 + hstep, voffB); PG8_STAGE(PG8_SA(0, 0), a2, vaC[0]);
            PG8_WAIT_V(8); PG8_WAIT_L(0); PG8_BAR; PG8_MMA(1, 0, At, B0); PG8_MMA(1, 1, At, B1); PG8_BAR; PG8_SCHED;
            PG8_LDB(B0, 1, 0); PG8_LDB(B1, 1, 1); PG8_SCHED; PG8_LDA(At, 1, 0); PG8_STAGE(PG8_SA(0, 1), a2, vaC[1]);
            PG8_WAIT_V(8); PG8_WAIT_L(0); PG8_BAR; PG8_MMA(0, 0, At, B0); PG8_MMA(0, 1, At, B1); PG8_BAR; PG8_SCHED;
            PG8_LDA(At, 1, 1); PG8_STAGE(PG8_SB(1, 0), b3, voffB); PG8_STAGE(PG8_SB(1, 1), b3 + hstep, voffB); PG8_STAGE(PG8_SA(1, 0), a3, vaC[0]);
            PG8_WAIT_V(8); PG8_WAIT_L(0); PG8_BAR; PG8_MMA(1, 0, At, B0); PG8_MMA(1, 1, At, B1); PG8_BAR; PG8_SCHED;
        }
        if constexpr (ALIGN_EPI) { if (wr == 0) PG8_BAR; }
        { const int l2 = lane_id(); E(acc, cur, wr, wc, l2 & 15, l2 >> 4); } S.done(cur);
        if (!has_next) break;
#pragma unroll
        for (int a = 0; a < 2; ++a)
#pragma unroll
            for (int b = 0; b < 2; ++b)
#pragma unroll
                for (int m = 0; m < 4; ++m)
#pragma unroll
                    for (int n = 0; n < 2; ++n) acc[a][b][m][n] = (f32x4){0.f, 0.f, 0.f, 0.f};
        cur = nxt; cA = nA; cB = nB; ++ui;
        if constexpr (ALIGN_EPI) { if (wr == 1) PG8_BAR; }
    }
    PG8_WAIT_V(0);
    if constexpr (!ALIGN_EPI) { if (wr == 0) PG8_BAR; }
    PG8_BAR;
#undef PG8_SA
#undef PG8_SB
#undef PG8_STAGE
#undef PG8_LDA
#undef PG8_LDB
#undef PG8_MMA
#undef PG8_WAIT_V
#undef PG8_WAIT_L
#undef PG8_BAR
#undef PG8_SCHED
}
}

constexpr int PN = 6656;
namespace att {
#define ALAS __attribute__((address_space(3)))
typedef _Float16 f16x8 __attribute__((ext_vector_type(8)));
typedef float f32x16 __attribute__((ext_vector_type(16)));
typedef short v4i16_t __attribute__((ext_vector_type(4)));
typedef unsigned u32x4 __attribute__((ext_vector_type(4)));
constexpr int SLOT = 16384, L_K = 0, L_V = 3 * SLOT, L_SCR = 6 * SLOT, L_TAB = L_SCR + 2048, L_END = L_TAB + 1024;
constexpr int L_XB = 0, L_STG = 65536;
constexpr float LOG2E = 1.4426950408889634f;
constexpr float C2 = 0.125f * LOG2E;
__device__ __forceinline__ int crow(int r, int hi) { return (r & 3) + 8 * (r >> 2) + 4 * hi; }
__device__ __forceinline__ void glds16(const void* g, ALAS unsigned char* l) { __builtin_amdgcn_global_load_lds((const unsigned*)g, (ALAS unsigned*)l, 16, 0, 0); }
__device__ __forceinline__ float xhalf(float v, int hi) { auto rr = __builtin_amdgcn_permlane32_swap(__float_as_uint(v), __float_as_uint(v), false, false); return hi ? __uint_as_float(rr[0]) : __uint_as_float(rr[1]); }
__device__ __forceinline__ unsigned pkh(float lo, float hi) { typedef _Float16 h2 __attribute__((ext_vector_type(2))); h2 v = {(_Float16)lo, (_Float16)hi}; return __builtin_bit_cast(unsigned, v); }
__device__ __forceinline__ v4i16_t vtr(const ALAS unsigned char* p) { return __builtin_amdgcn_ds_read_tr16_b64_v4i16((ALAS v4i16_t*)p); }

template <int THR>
__device__ __forceinline__ void attn_unit(ALAS unsigned char* lds, const int wave, const int b, const int h, const int qb, const unsigned short* PROJ, unsigned short* Y,
                                          const float* biasG, const float lam, const float* subln_g) {
    const int lane = pg8::lane_id(), r32 = lane & 31, hi = lane >> 5;
    const int c = wave >> 2, w4 = wave & 3;
    const int q0 = qb * 128, qw0 = q0 + 32 * w4, q = qw0 + r32;
    const size_t rowbase = (size_t)b * S;
    { ALAS float* tabL = (ALAS float*)(lds + L_TAB); const int tid = wave * 64 + lane; if (tid < 129) tabL[tid] = biasG[tid] * LOG2E; }
    f16x8 qf[4];
    { const unsigned short* Qp = PROJ + (rowbase + q) * PN + h * 128 + c * 64 + hi * 8;
#pragma unroll
      for (int d0 = 0; d0 < 4; ++d0) qf[d0] = *(const f16x8*)(Qp + d0 * 16); }
    const int krow0 = 8 * wave + (lane >> 4), krow1 = krow0 + 4;
    const unsigned short* ksrc0 = PROJ + (rowbase + krow0) * PN + 1024 + h * 128 + (((lane & 15) ^ (krow0 & 15)) * 8);
    const unsigned short* ksrc1 = PROJ + (rowbase + krow1) * PN + 1024 + h * 128 + (((lane & 15) ^ (krow1 & 15)) * 8);
    const unsigned short* vsrc0 = PROJ + (rowbase + 16 * ((2 * wave) & 3) + (lane >> 2)) * PN + 2048 + h * 128 + 32 * ((2 * wave) >> 2) + (lane & 3) * 8;
    ALAS unsigned char* kdst = lds + L_K + (2 * wave) * 1024; ALAS unsigned char* vdst = lds + L_V + (2 * wave) * 1024;
#define ATT_ISSUE(t, slot) do { const size_t go_ = (size_t)(t) * 64 * PN; \
        glds16(ksrc0 + go_, kdst + (slot) * SLOT); glds16(ksrc1 + go_, kdst + (slot) * SLOT + 1024); \
        glds16(vsrc0 + go_, vdst + (slot) * SLOT); glds16(vsrc0 + go_ + (size_t)16 * PN, vdst + (slot) * SLOT + 1024); } while (0)
    const int NT = (q0 + 128) / 64;
    ATT_ISSUE(0, 0); ATT_ISSUE(1, 1);
    ALAS float* wsf = (ALAS float*)(lds + L_SCR) + wave * 64;
    const ALAS float* tabL = (const ALAS float*)(lds + L_TAB);
    const float bfar = biasG[128] * LOG2E;
    float mhat = 0.f, l = 0.f;
    f32x16 o[4];
#pragma unroll
    for (int d = 0; d < 4; ++d)
#pragma unroll
        for (int r = 0; r < 16; ++r) o[d][r] = 0.f;
    f32x16 negm;
#pragma unroll
    for (int r = 0; r < 16; ++r) negm[r] = bfar;
    int slot = 0;
    for (int t = 0; t < NT; ++t) {
        if (t + 1 < NT) asm volatile("s_waitcnt vmcnt(4)" ::: "memory"); else asm volatile("s_waitcnt vmcnt(0)" ::: "memory");
        __builtin_amdgcn_s_barrier();
        asm volatile("" ::: "memory");
        if (t + 2 < NT) { const int s2 = slot == 0 ? 2 : slot - 1; ATT_ISSUE(t + 2, s2); }
        const int k0 = t * 64;
        if (k0 <= qw0 + 31) {
            const ALAS unsigned char* Ks = lds + L_K + slot * SLOT + r32 * 256;
            const int kx = r32 & 15, kc0 = 8 * c + hi;
            const int ko[4] = {((kc0 + 0) ^ kx) << 4, ((kc0 + 2) ^ kx) << 4, ((kc0 + 4) ^ kx) << 4, ((kc0 + 6) ^ kx) << 4};
            const ALAS unsigned char* Vs = lds + L_V + slot * SLOT + (4 * hi + ((lane & 15) >> 2)) * 64 + ((lane >> 4) & 1) * 32 + (lane & 3) * 8;
            f32x16 p0, p1;
            const bool nearb = (k0 + 63 + 128 > qw0);
            if (nearb) {
                f32x16 c0, c1;
#pragma unroll
                for (int r = 0; r < 16; ++r) { int rel = q - (k0 + crow(r, hi)); int i0 = rel < 0 ? 0 : (rel > 128 ? 128 : rel); int rel1 = rel - 32; int i1 = rel1 < 0 ? 0 : (rel1 > 128 ? 128 : rel1);
                    c0[r] = tabL[i0] - mhat; c1[r] = tabL[i1] - mhat; }
#pragma unroll
                for (int d0 = 0; d0 < 4; ++d0) { const f16x8 a0 = *(const ALAS f16x8*)(Ks + ko[d0]), a1 = *(const ALAS f16x8*)(Ks + ko[d0] + 8192);
                    p0 = __builtin_amdgcn_mfma_f32_32x32x16_f16(a0, qf[d0], d0 == 0 ? c0 : p0, 0, 0, 0); p1 = __builtin_amdgcn_mfma_f32_32x32x16_f16(a1, qf[d0], d0 == 0 ? c1 : p1, 0, 0, 0); }
                if (k0 + 63 > qw0) {
#pragma unroll
                    for (int r = 0; r < 16; ++r) { const int kv = k0 + crow(r, hi); if (kv > q) p0[r] = -INFINITY; if (kv + 32 > q) p1[r] = -INFINITY; }
                }
            } else {
#pragma unroll
                for (int d0 = 0; d0 < 4; ++d0) { const f16x8 a0 = *(const ALAS f16x8*)(Ks + ko[d0]), a1 = *(const ALAS f16x8*)(Ks + ko[d0] + 8192);
                    p0 = __builtin_amdgcn_mfma_f32_32x32x16_f16(a0, qf[d0], d0 == 0 ? negm : p0, 0, 0, 0); p1 = __builtin_amdgcn_mfma_f32_32x32x16_f16(a1, qf[d0], d0 == 0 ? negm : p1, 0, 0, 0); }
            }
            float rm = fmaxf(p0[0], p1[0]);
#pragma unroll
            for (int r = 1; r < 16; ++r) rm = fmaxf(rm, fmaxf(p0[r], p1[r]));
            rm = fmaxf(rm, xhalf(rm, hi));
            const bool first = (t == 0);
            if (first || __any(rm > (float)THR)) {
                const float dl = first ? rm : fmaxf(rm, 0.f);
                mhat += dl;
#pragma unroll
                for (int r = 0; r < 16; ++r) { p0[r] -= dl; p1[r] -= dl; }
#pragma unroll
                for (int r = 0; r < 16; ++r) negm[r] = bfar - mhat;
                if (!first) {
                    const float f = __builtin_amdgcn_exp2f(-dl); l *= f;
                    if (hi == 0) wsf[r32] = f;
                    asm volatile("s_waitcnt lgkmcnt(0)" ::: "memory");
#pragma unroll
                    for (int r = 0; r < 16; ++r) { const float fr_ = wsf[crow(r, hi)];
#pragma unroll
                        for (int d = 0; d < 4; ++d) o[d][r] *= fr_; }
                }
            }
            float sacc = 0.f;
#pragma unroll
            for (int r = 0; r < 16; ++r) { p0[r] = __builtin_amdgcn_exp2f(p0[r]); p1[r] = __builtin_amdgcn_exp2f(p1[r]); sacc += p0[r] + p1[r]; }
            l += sacc;
            u32x4 pw[4];
#pragma unroll
            for (int s = 0; s < 2; ++s) {
                pw[s] = (u32x4){pkh(p0[8 * s], p0[8 * s + 1]), pkh(p0[8 * s + 2], p0[8 * s + 3]), pkh(p0[8 * s + 4], p0[8 * s + 5]), pkh(p0[8 * s + 6], p0[8 * s + 7])};
                pw[2 + s] = (u32x4){pkh(p1[8 * s], p1[8 * s + 1]), pkh(p1[8 * s + 2], p1[8 * s + 3]), pkh(p1[8 * s + 4], p1[8 * s + 5]), pkh(p1[8 * s + 6], p1[8 * s + 7])};
            }
#pragma unroll
            for (int d = 0; d < 4; ++d) {
#pragma unroll
                for (int s = 0; s < 4; ++s) {
                    const v4i16_t lo = vtr(Vs + (d * 4 + s) * 1024), hi4 = vtr(Vs + (d * 4 + s) * 1024 + 512);
                    typedef short s16x8 __attribute__((ext_vector_type(8)));
                    const s16x8 bv = {lo[0], lo[1], lo[2], lo[3], hi4[0], hi4[1], hi4[2], hi4[3]};
                    o[d] = __builtin_amdgcn_mfma_f32_32x32x16_f16(__builtin_bit_cast(f16x8, pw[s]), __builtin_bit_cast(f16x8, bv), o[d], 0, 0, 0);
                }
            }
        }
        slot = slot == 2 ? 0 : slot + 1;
    }
#undef ATT_ISSUE
    l += xhalf(l, hi);
    if (hi == 0) wsf[r32] = 1.0f / l;
    asm volatile("s_waitcnt lgkmcnt(0)" ::: "memory");
#pragma unroll
    for (int r = 0; r < 16; ++r) { const float f = wsf[crow(r, hi)];
#pragma unroll
        for (int d = 0; d < 4; ++d) o[d][r] *= f; }
    asm volatile("s_waitcnt lgkmcnt(0)" ::: "memory"); __builtin_amdgcn_s_barrier(); asm volatile("" ::: "memory");
    ALAS float* xb = (ALAS float*)(lds + L_XB) + w4 * 4096 + lane;
    if (c == 1) {
#pragma unroll
        for (int d = 0; d < 4; ++d)
#pragma unroll
            for (int r = 0; r < 16; ++r) xb[(d * 16 + r) * 64] = o[d][r];
    }
    asm volatile("s_waitcnt lgkmcnt(0)" ::: "memory"); __builtin_amdgcn_s_barrier(); asm volatile("" ::: "memory");
    if (c == 0) {
        float sc[16];
#pragma unroll
        for (int r = 0; r < 16; ++r) { float ss = 0.f;
#pragma unroll
            for (int d = 0; d < 4; ++d) { o[d][r] -= lam * xb[(d * 16 + r) * 64]; ss += o[d][r] * o[d][r]; }
            ss += __shfl_xor(ss, 1); ss += __shfl_xor(ss, 2); ss += __shfl_xor(ss, 4); ss += __shfl_xor(ss, 8); ss += __shfl_xor(ss, 16);
            sc[r] = __builtin_amdgcn_rsqf(ss * (1.f / 128.f) + LN_EPS) * (1.f - LAMBDA_INIT); }
        ALAS _Float16* stg = (ALAS _Float16*)(lds + L_STG + w4 * 8192);
#pragma unroll
        for (int d = 0; d < 4; ++d) { const float gg = subln_g[32 * d + r32];
#pragma unroll
            for (int r = 0; r < 16; ++r) stg[crow(r, hi) * 128 + 32 * d + r32] = (_Float16)(o[d][r] * sc[r] * gg); }
        asm volatile("s_waitcnt lgkmcnt(0)" ::: "memory");
        unsigned short* Yw = Y + (rowbase + qw0) * D + h * 128;
#pragma unroll
        for (int i = 0; i < 8; ++i) { const int row = i * 4 + (lane >> 4), ch = lane & 15; const u32x4 v = *(const ALAS u32x4*)((const ALAS unsigned char*)stg + row * 256 + ch * 16);
            *(u32x4*)(Yw + (size_t)row * D + ch * 8) = v; }
    }
    asm volatile("s_waitcnt lgkmcnt(0)" ::: "memory"); __builtin_amdgcn_s_barrier(); asm volatile("" ::: "memory");
}
#undef ALAS
}

namespace rk {
#define RLAS __attribute__((address_space(3)))
#define RGAS __attribute__((address_space(1)))
typedef __bf16 bf16x8 __attribute__((ext_vector_type(8)));
typedef _Float16 f16x8 __attribute__((ext_vector_type(8)));
typedef float f32x16 __attribute__((ext_vector_type(16)));
typedef float f32x4 __attribute__((ext_vector_type(4)));
typedef unsigned u32x4 __attribute__((ext_vector_type(4)));
typedef unsigned short us8 __attribute__((ext_vector_type(8)));
constexpr int C = 32;
constexpr int TS = 144, CS = 80;
constexpr int O_AT = 0, O_RT = 4608, O_BT = 9216, O_KT = 13824;
constexpr int O_AAB = 0, O_AAK = 4608, O_ARB = 7168, O_ARK = 9728;
constexpr int O_PIMG = 0, O_QIMG = 8192;
constexpr int O_VT = 18432, O_KH = 23552, O_BH = 28672;
constexpr int O_X0 = 33792;
constexpr int O_RH = 50688;
constexpr int O_GAM = 55296;
constexpr int HALF_BYTES = 57344;
constexpr int CHK_BYTES = 24576, CK_P = 0, CK_Q = 8192, CK_G = 12288, CK_Y = 20480;
__device__ __forceinline__ int crow(int r, int hi) { return (r & 3) + 8 * (r >> 2) + 4 * hi; }
__device__ __forceinline__ unsigned pkb(float lo, float hi) { typedef float f2 __attribute__((ext_vector_type(2))); typedef __bf16 b2 __attribute__((ext_vector_type(2))); f2 v = {lo, hi}; b2 w = __builtin_convertvector(v, b2); return __builtin_bit_cast(unsigned, w); }
__device__ __forceinline__ unsigned pkh(float lo, float hi) { typedef _Float16 h2 __attribute__((ext_vector_type(2))); h2 v = {(_Float16)lo, (_Float16)hi}; return __builtin_bit_cast(unsigned, v); }
__device__ __forceinline__ float h2f(unsigned short u) { return (float)__builtin_bit_cast(_Float16, u); }
__device__ __forceinline__ unsigned short f2h(float f) { return __builtin_bit_cast(unsigned short, (_Float16)f); }
__device__ __forceinline__ float sum8(float x) {
    x += __builtin_bit_cast(float, __builtin_amdgcn_update_dpp(0, __builtin_bit_cast(int, x), 0xB1, 0xF, 0xF, true));
    x += __builtin_bit_cast(float, __builtin_amdgcn_update_dpp(0, __builtin_bit_cast(int, x), 0x4E, 0xF, 0xF, true));
    x += __builtin_bit_cast(float, __builtin_amdgcn_update_dpp(0, __builtin_bit_cast(int, x), 0x141, 0xF, 0xF, true));
    return x;
}
__device__ __forceinline__ int frag_pos(int m, int c) { return (((c >> 4) * 64 + m + 32 * ((c >> 2) & 1)) * 8) + ((c >> 3) & 1) * 4 + (c & 3); }

struct ChunkIn { f32x4 l0, l1; us8 a8, b8, k8, rc, rp, vc, vp; };
__device__ __forceinline__ void chunk_load(ChunkIn& in, int tglob, int pos, int chb, const unsigned char* ws) {
    const unsigned short* PROJ16 = (const unsigned short*)(ws + WS_PROJ16); const float* LW = (const float*)(ws + WS_DECAY); const unsigned short* KMOD = (const unsigned short*)(ws + WS_KMOD);
    const unsigned short* A16 = (const unsigned short*)(ws + WS_A16); const unsigned short* B16 = (const unsigned short*)(ws + WS_B16);
    in.l0 = *(const RGAS f32x4*)(LW + (size_t)tglob * RWK + chb); in.l1 = *(const RGAS f32x4*)(LW + (size_t)tglob * RWK + chb + 4);
    in.a8 = *(const RGAS us8*)(A16 + (size_t)tglob * RWK + chb); in.b8 = *(const RGAS us8*)(B16 + (size_t)tglob * RWK + chb); in.k8 = *(const RGAS us8*)(KMOD + (size_t)tglob * RWK + chb);
    const unsigned short* cur = PROJ16 + (size_t)tglob * PN + 3072 + chb;
    in.rc = *(const RGAS us8*)cur; in.vc = *(const RGAS us8*)(cur + 2048); in.rp = in.rc; in.vp = in.vc; if (pos > 0) { in.rp = *(const RGAS us8*)(cur - PN); in.vp = *(const RGAS us8*)(cur - PN + 2048); }
}
__device__ __forceinline__ void chunk_pair(RLAS unsigned char* lds, const int wave, const int tile, const int hA, ChunkIn& in, const bool has_next, const float* mu, const float* r_k, unsigned char* ws) {
    unsigned char* CHK = ws + WS_CHK; float* BONUS = (float*)(ws + WS_BONUS);
    const int lane = pg8::lane_id(), hf = wave >> 2, q = wave & 3, r32 = lane & 31, hi = lane >> 5;
    const int h = hA + hf;
    RLAS unsigned char* L = lds + hf * HALF_BYTES;
    const int t = q * 64 + lane;
    const int tok = t >> 3, c8 = (t & 7) * 8;
    const int tglob = tile * C + tok, pos = tglob & (S - 1), bidx = tglob >> 11;
    const int chb = h * 64 + c8;
    float lw[8], av[8], bv[8], kv[8], rv[8], vv[8];
    { lw[0] = in.l0.x; lw[1] = in.l0.y; lw[2] = in.l0.z; lw[3] = in.l0.w; lw[4] = in.l1.x; lw[5] = in.l1.y; lw[6] = in.l1.z; lw[7] = in.l1.w;
      const f32x4 m0 = *(const RGAS f32x4*)(mu + chb), m1 = *(const RGAS f32x4*)(mu + chb + 4), n0 = *(const RGAS f32x4*)(mu + 2048 + chb), n1 = *(const RGAS f32x4*)(mu + 2048 + chb + 4);
      const float mr[8] = {m0.x, m0.y, m0.z, m0.w, m1.x, m1.y, m1.z, m1.w}, mv[8] = {n0.x, n0.y, n0.z, n0.w, n1.x, n1.y, n1.z, n1.w};
#pragma unroll
      for (int i = 0; i < 8; ++i) { av[i] = h2f(in.a8[i]); bv[i] = h2f(in.b8[i]); kv[i] = h2f(in.k8[i]);
          const float rcf = h2f(in.rc[i]), rpf = pos > 0 ? h2f(in.rp[i]) : 0.f, vcf = h2f(in.vc[i]), vpf = pos > 0 ? h2f(in.vp[i]) : 0.f;
          rv[i] = rcf + (rpf - rcf) * mr[i]; vv[i] = vcf + (vpf - vcf) * mv[i]; } }
    { const f32x4 k0 = *(const RGAS f32x4*)(r_k + chb), k1 = *(const RGAS f32x4*)(r_k + chb + 4); const float rk8[8] = {k0.x, k0.y, k0.z, k0.w, k1.x, k1.y, k1.z, k1.w};
      float bs = 0.f;
#pragma unroll
      for (int i = 0; i < 8; ++i) bs += rv[i] * kv[i] * rk8[i];
      bs = sum8(bs); if ((t & 7) == 0) BONUS[(size_t)tglob * 16 + h] = bs; }
    RLAS float* lwL = (RLAS float*)(L + O_X0 + 64 * 132);
    __syncthreads();
#pragma unroll
    for (int i = 0; i < 8; ++i) lwL[tok * 65 + c8 + i] = lw[i];
    __syncthreads();
    { RLAS float* part = (RLAS float*)(L + O_GAM) + 64;
      const int ch = t & 63, seg = t >> 6; float sg = 0.f;
#pragma unroll
      for (int k = 0; k < 8; ++k) sg += lwL[(8 * seg + k) * 65 + ch];
      part[seg * 64 + ch] = sg;
      __syncthreads();
      float g = 0.f;
#pragma unroll
      for (int s2 = 0; s2 < 3; ++s2) if (s2 < seg) g += part[s2 * 64 + ch];
#pragma unroll
      for (int k = 0; k < 8; ++k) { g += lwL[(8 * seg + k) * 65 + ch]; lwL[(8 * seg + k) * 65 + ch] = g; } }
    __syncthreads();
    {
        float G[8], GL[8];
#pragma unroll
        for (int i = 0; i < 8; ++i) { G[i] = lwL[tok * 65 + c8 + i]; GL[i] = lwL[31 * 65 + c8 + i]; }
        float at[8], rt[8], bt[8], kt[8], bh[8], kh[8];
#pragma unroll
        for (int i = 0; i < 8; ++i) { const float eg = __expf(G[i]), eng = __expf(-G[i]), egm = __expf(G[i] - lw[i]), egl = __expf(GL[i] - G[i]);
            at[i] = av[i] * egm; rt[i] = rv[i] * eg; bt[i] = bv[i] * eng; kt[i] = kv[i] * eng; bh[i] = bv[i] * egl; kh[i] = kv[i] * egl; }
        *(RLAS u32x4*)(L + O_AT + tok * TS + c8 * 2) = (u32x4){pkb(at[0], at[1]), pkb(at[2], at[3]), pkb(at[4], at[5]), pkb(at[6], at[7])};
        *(RLAS u32x4*)(L + O_RT + tok * TS + c8 * 2) = (u32x4){pkb(rt[0], rt[1]), pkb(rt[2], rt[3]), pkb(rt[4], rt[5]), pkb(rt[6], rt[7])};
        *(RLAS u32x4*)(L + O_BT + tok * TS + c8 * 2) = (u32x4){pkb(bt[0], bt[1]), pkb(bt[2], bt[3]), pkb(bt[4], bt[5]), pkb(bt[6], bt[7])};
        *(RLAS u32x4*)(L + O_KT + tok * TS + c8 * 2) = (u32x4){pkb(kt[0], kt[1]), pkb(kt[2], kt[3]), pkb(kt[4], kt[5]), pkb(kt[6], kt[7])};
        *(RLAS u32x4*)(L + O_RH + tok * TS + c8 * 2) = (u32x4){pkh(rt[0], rt[1]), pkh(rt[2], rt[3]), pkh(rt[4], rt[5]), pkh(rt[6], rt[7])};
#pragma unroll
        for (int i = 0; i < 8; ++i) { const int ch = c8 + i;
            *(RLAS unsigned short*)(L + O_VT + ch * CS + tok * 2) = f2h(vv[i]); *(RLAS unsigned short*)(L + O_KH + ch * CS + tok * 2) = f2h(kh[i]); *(RLAS unsigned short*)(L + O_BH + ch * CS + tok * 2) = f2h(bh[i]);
            ((RLAS float*)(L + O_X0))[ch * 33 + tok] = at[i];
            if (tok == C - 1) ((RLAS float*)(L + O_GAM))[ch] = __expf(GL[i]); }
    }
    __syncthreads();
    {
        const RLAS unsigned char* Lp = L + (q < 2 ? O_AT : O_RT) + r32 * TS + hi * 16; const RLAS unsigned char* Rp = L + ((q & 1) ? O_KT : O_BT) + r32 * TS + hi * 16;
        f32x16 acc;
#pragma unroll
        for (int r = 0; r < 16; ++r) acc[r] = 0.f;
#pragma unroll
        for (int ks = 0; ks < 4; ++ks) acc = __builtin_amdgcn_mfma_f32_32x32x16_bf16(*(const RLAS bf16x8*)(Lp + ks * 32), *(const RLAS bf16x8*)(Rp + ks * 32), acc, 0, 0, 0);
#pragma unroll
        for (int r = 0; r < 16; ++r) { const int tau = crow(r, hi); const bool keep = (q < 2) ? (r32 < tau) : (r32 <= tau); acc[r] = keep ? acc[r] : 0.f; }
        __syncthreads();
        if (q == 0) {
#pragma unroll
            for (int r = 0; r < 16; ++r) ((RLAS float*)(L + O_AAB))[r32 * 36 + crow(r, hi)] = acc[r];
        } else {
            RLAS unsigned char* o = L + (q == 1 ? O_AAK : (q == 2 ? O_ARB : O_ARK));
#pragma unroll
            for (int r = 0; r < 16; ++r) *(RLAS unsigned short*)(o + crow(r, hi) * CS + r32 * 2) = f2h(acc[r]);
        }
    }
    __syncthreads();
    const int J = q & 1, part = q >> 1;
    if (part == 1) {
        f32x16 accX;
#pragma unroll
        for (int r = 0; r < 16; ++r) accX[r] = 0.f;
        const RLAS unsigned char* Vp = L + O_VT + (32 * J + r32) * CS + hi * 16; const RLAS unsigned char* Ap = L + O_AAK + r32 * CS + hi * 16;
#pragma unroll
        for (int ks = 0; ks < 2; ++ks) accX = __builtin_amdgcn_mfma_f32_32x32x16_f16(*(const RLAS f16x8*)(Ap + ks * 32), *(const RLAS f16x8*)(Vp + ks * 32), accX, 0, 0, 0);
#pragma unroll
        for (int r = 0; r < 16; ++r) ((RLAS float*)(L + O_X0))[(64 + 32 * J + r32) * 33 + crow(r, hi)] = accX[r];
    }
    __syncthreads();
    float z[C];
    if (q < 2) {
        const RLAS float* xc = (const RLAS float*)(L + O_X0) + (64 * q + lane) * 33;
#pragma unroll
        for (int k = 0; k < C; ++k) z[k] = xc[k];
    }
    __syncthreads();
    if (q < 2) {
        const RLAS float* AabT = (const RLAS float*)(L + O_AAB);
#pragma unroll
        for (int sx = 0; sx < C - 1; ++sx) {
            const float zs = z[sx];
#pragma unroll
            for (int t4 = (sx + 1) / 4; t4 < C / 4; ++t4) { const f32x4 aa = *(const RLAS f32x4*)(AabT + sx * 36 + 4 * t4);
                if (4 * t4 + 0 > sx) z[4 * t4 + 0] = fmaf(aa.x, zs, z[4 * t4 + 0]); if (4 * t4 + 1 > sx) z[4 * t4 + 1] = fmaf(aa.y, zs, z[4 * t4 + 1]);
                if (4 * t4 + 2 > sx) z[4 * t4 + 2] = fmaf(aa.z, zs, z[4 * t4 + 2]); if (4 * t4 + 3 > sx) z[4 * t4 + 3] = fmaf(aa.w, zs, z[4 * t4 + 3]); }
        }
        RLAS unsigned char* zr = L + O_X0 + (64 * q + lane) * CS;
#pragma unroll
        for (int k8 = 0; k8 < 4; ++k8) *(RLAS u32x4*)(zr + k8 * 16) = (u32x4){pkh(z[8 * k8], z[8 * k8 + 1]), pkh(z[8 * k8 + 2], z[8 * k8 + 3]), pkh(z[8 * k8 + 4], z[8 * k8 + 5]), pkh(z[8 * k8 + 6], z[8 * k8 + 7])};
    }
    __syncthreads();
    f32x16 accQ, accP, accA, accB;
#pragma unroll
    for (int r = 0; r < 16; ++r) { accA[r] = 0.f; accB[r] = 0.f; }
    {
        const RLAS unsigned char* Vp = L + O_VT + (32 * J + r32) * CS + hi * 16;
        const RLAS unsigned char* Kp = L + O_KH + (32 * part + r32) * CS + hi * 16;
        const RLAS unsigned char* Ap = L + O_ARK + r32 * CS + hi * 16;
#pragma unroll
        for (int ks = 0; ks < 2; ++ks) { const f16x8 vf = *(const RLAS f16x8*)(Vp + ks * 32);
            if (part == 0) accA = __builtin_amdgcn_mfma_f32_32x32x16_f16(*(const RLAS f16x8*)(Ap + ks * 32), vf, accA, 0, 0, 0);
            accB = __builtin_amdgcn_mfma_f32_32x32x16_f16(*(const RLAS f16x8*)(Kp + ks * 32), vf, accB, 0, 0, 0); }
    }
    {
        const RLAS float* gam = (const RLAS float*)(L + O_GAM);
#pragma unroll
        for (int r = 0; r < 16; ++r) { const int m = crow(r, hi);
            accQ[r] = h2f(*(const RLAS unsigned short*)(L + O_RH + m * TS + (32 * J + r32) * 2));
            accP[r] = (J == part && m == r32) ? gam[32 * J + r32] : 0.f; }
        const RLAS unsigned char* Zw = L + O_X0 + (32 * J + r32) * CS + hi * 16; const RLAS unsigned char* Zu = Zw + 64 * CS;
        const RLAS unsigned char* Bp = L + O_BH + (32 * part + r32) * CS + hi * 16; const RLAS unsigned char* Rb = L + O_ARB + r32 * CS + hi * 16;
#pragma unroll
        for (int ks = 0; ks < 2; ++ks) { const f16x8 zw = *(const RLAS f16x8*)(Zw + ks * 32), zu = *(const RLAS f16x8*)(Zu + ks * 32), bf = *(const RLAS f16x8*)(Bp + ks * 32);
            accP = __builtin_amdgcn_mfma_f32_32x32x16_f16(bf, zw, accP, 0, 0, 0);
            accB = __builtin_amdgcn_mfma_f32_32x32x16_f16(bf, zu, accB, 0, 0, 0);
            if (part == 0) { const f16x8 rb = *(const RLAS f16x8*)(Rb + ks * 32);
                accQ = __builtin_amdgcn_mfma_f32_32x32x16_f16(rb, zw, accQ, 0, 0, 0);
                accA = __builtin_amdgcn_mfma_f32_32x32x16_f16(rb, zu, accA, 0, 0, 0); } }
    }
    __syncthreads();
    { int tg2 = tglob, cb2 = has_next ? chb + 128 : chb; asm volatile("" : "+v"(tg2), "+v"(cb2)); chunk_load(in, tg2, pos, cb2, ws); }
    unsigned char* rec = CHK + ((size_t)((bidx * 16 + h) * (S / C)) + (size_t)(pos >> 5)) * CHK_BYTES;
    { u32x4 w0, w1; w0 = (u32x4){pkh(accB[0], accB[1]), pkh(accB[2], accB[3]), pkh(accB[4], accB[5]), pkh(accB[6], accB[7])}; w1 = (u32x4){pkh(accB[8], accB[9]), pkh(accB[10], accB[11]), pkh(accB[12], accB[13]), pkh(accB[14], accB[15])};
      RGAS u32x4* g = (RGAS u32x4*)(rec + CK_G + ((part * 2 + J) * 64 + lane) * 32); g[0] = w0; g[1] = w1;
      if (part == 0) { w0 = (u32x4){pkh(accA[0], accA[1]), pkh(accA[2], accA[3]), pkh(accA[4], accA[5]), pkh(accA[6], accA[7])}; w1 = (u32x4){pkh(accA[8], accA[9]), pkh(accA[10], accA[11]), pkh(accA[12], accA[13]), pkh(accA[14], accA[15])};
          RGAS u32x4* y = (RGAS u32x4*)(rec + CK_Y + (J * 64 + lane) * 32); y[0] = w0; y[1] = w1; } }
    {
        RLAS unsigned short* pimg = (RLAS unsigned short*)(L + O_PIMG) + ((part * 2 + J) * 2) * 512;
        RLAS unsigned short* qimg = (RLAS unsigned short*)(L + O_QIMG) + (J * 2) * 512;
#pragma unroll
        for (int r = 0; r < 16; ++r) { const int fp = frag_pos(crow(r, hi), r32); pimg[fp] = f2h(accP[r]); if (part == 0) qimg[fp] = f2h(accQ[r]); }
    }
    __syncthreads();
    { const RLAS u32x4* src = (const RLAS u32x4*)(L + O_PIMG); RGAS u32x4* dst = (RGAS u32x4*)(rec + CK_P);
#pragma unroll
      for (int i = 0; i < 3; ++i) dst[i * 256 + t] = src[i * 256 + t]; }
}

__device__ __forceinline__ void scan_unit(RLAS unsigned char* lds, const int wave, const int bh, const unsigned char* CHK, const float* BONUS, const unsigned short* PROJ16, const float* mu,
                                          const unsigned short* G16, const float* lnx_g, const float* lnx_b, unsigned short* Y16) {
    const int lane = pg8::lane_id(), r32 = lane & 31, hi = lane >> 5;
    const int b = bh >> 4, h = bh & 15;
    RLAS float* ytile = (RLAS float*)lds;
    constexpr int RING0 = 18432, NSL = 4;
    const unsigned char* rec0 = CHK + (size_t)bh * (S / C) * CHK_BYTES;
    constexpr int NCH = S / C;
    __syncthreads();
    if (wave >= 6) {
        const int p0 = (wave - 6) * 12;
#define RK_DMA(c) do { const unsigned char* src_ = rec0 + (size_t)(c) * CHK_BYTES + p0 * 1024 + lane * 16; RLAS unsigned char* dst_ = lds + RING0 + ((c) & (NSL - 1)) * CHK_BYTES + p0 * 1024; \
            _Pragma("unroll") for (int j_ = 0; j_ < 12; ++j_) __builtin_amdgcn_global_load_lds((const unsigned*)(src_ + j_ * 1024), (RLAS unsigned*)(dst_ + j_ * 1024), 16, 0, 0); } while (0)
        RK_DMA(0); RK_DMA(1); RK_DMA(2);
        for (int c = 0; c <= NCH; ++c) {
            if (c + 2 < NCH) asm volatile("s_waitcnt vmcnt(24)" ::: "memory"); else if (c + 1 < NCH) asm volatile("s_waitcnt vmcnt(12)" ::: "memory"); else asm volatile("s_waitcnt vmcnt(0)" ::: "memory");
            __builtin_amdgcn_s_barrier(); asm volatile("" ::: "memory");
            if (c + 3 < NCH) RK_DMA(c + 3);
        }
#undef RK_DMA
    } else if (wave < 2) {
        const int J = wave;
        f32x16 H0, H1;
#pragma unroll
        for (int r = 0; r < 16; ++r) { H0[r] = 0.f; H1[r] = 0.f; }
        for (int c = 0; c <= NCH; ++c) {
            asm volatile("s_waitcnt lgkmcnt(0)" ::: "memory"); __builtin_amdgcn_s_barrier(); asm volatile("" ::: "memory");
            if (c == NCH) break;
            const RLAS unsigned char* rec = lds + RING0 + (c & (NSL - 1)) * CHK_BYTES;
            u32x4 hb[4];
            hb[0] = (u32x4){pkh(H0[0], H0[1]), pkh(H0[2], H0[3]), pkh(H0[4], H0[5]), pkh(H0[6], H0[7])}; hb[1] = (u32x4){pkh(H0[8], H0[9]), pkh(H0[10], H0[11]), pkh(H0[12], H0[13]), pkh(H0[14], H0[15])};
            hb[2] = (u32x4){pkh(H1[0], H1[1]), pkh(H1[2], H1[3]), pkh(H1[4], H1[5]), pkh(H1[6], H1[7])}; hb[3] = (u32x4){pkh(H1[8], H1[9]), pkh(H1[10], H1[11]), pkh(H1[12], H1[13]), pkh(H1[14], H1[15])};
            f32x16 y, n0, n1;
#define RK_UNPK(dst, w0, w1) do { const f16x8 a_ = __builtin_bit_cast(f16x8, w0), b_ = __builtin_bit_cast(f16x8, w1); \
            _Pragma("unroll") for (int i_ = 0; i_ < 8; ++i_) { dst[i_] = (float)a_[i_]; dst[8 + i_] = (float)b_[i_]; } } while (0)
            { const u32x4 y0 = *(const RLAS u32x4*)(rec + CK_Y + (J * 64 + lane) * 32), y1 = *(const RLAS u32x4*)(rec + CK_Y + (J * 64 + lane) * 32 + 16); RK_UNPK(y, y0, y1);
              const u32x4 g0 = *(const RLAS u32x4*)(rec + CK_G + (J * 64 + lane) * 32), g1 = *(const RLAS u32x4*)(rec + CK_G + (J * 64 + lane) * 32 + 16); RK_UNPK(n0, g0, g1);
              const u32x4 g2 = *(const RLAS u32x4*)(rec + CK_G + ((2 + J) * 64 + lane) * 32), g3 = *(const RLAS u32x4*)(rec + CK_G + ((2 + J) * 64 + lane) * 32 + 16); RK_UNPK(n1, g2, g3); }
#pragma unroll
            for (int ks = 0; ks < 4; ++ks) {
                const f16x8 hf = __builtin_bit_cast(f16x8, hb[ks]);
                y = __builtin_amdgcn_mfma_f32_32x32x16_f16(*(const RLAS f16x8*)(rec + CK_Q + (ks * 64 + lane) * 16), hf, y, 0, 0, 0);
                n0 = __builtin_amdgcn_mfma_f32_32x32x16_f16(*(const RLAS f16x8*)(rec + CK_P + (ks * 64 + lane) * 16), hf, n0, 0, 0, 0);
                n1 = __builtin_amdgcn_mfma_f32_32x32x16_f16(*(const RLAS f16x8*)(rec + CK_P + ((4 + ks) * 64 + lane) * 16), hf, n1, 0, 0, 0);
            }
#undef RK_UNPK
            H0 = n0; H1 = n1;
            RLAS float* yt = ytile + (c & 1) * (32 * 68);
#pragma unroll
            for (int r = 0; r < 16; ++r) yt[crow(r, hi) * 68 + 32 * J + r32] = y[r];
        }
    } else {
        const int p = wave - 2, v8 = (lane & 7) * 8, trow = 8 * p + (lane >> 3);
        float lg[8], lb[8], mv[8];
#pragma unroll
        for (int i = 0; i < 8; ++i) { lg[i] = lnx_g[h * 64 + v8 + i]; lb[i] = lnx_b[h * 64 + v8 + i]; mv[i] = mu[2048 + h * 64 + v8 + i]; }
        struct PSlot { float bon; us8 vc, vp, g8; };
        PSlot ps[4];
#define RK_PLOAD(SL, cc_) do { const int pos_ = (cc_) * C + trow; const size_t tok_ = (size_t)b * S + pos_; ps[SL].bon = BONUS[tok_ * 16 + h]; \
            const unsigned short* cur_ = PROJ16 + tok_ * PN + 5120 + h * 64 + v8; ps[SL].vc = *(const RGAS us8*)cur_; ps[SL].vp = ps[SL].vc; if (pos_ > 0) ps[SL].vp = *(const RGAS us8*)(cur_ - PN); \
            ps[SL].g8 = *(const RGAS us8*)(G16 + tok_ * RWK + h * 64 + v8); } while (0)
#define RK_PSTEP(SL, cc_) do { \
            asm volatile("s_waitcnt lgkmcnt(0)" ::: "memory"); __builtin_amdgcn_s_barrier(); asm volatile("" ::: "memory"); \
            if ((cc_) >= 0) { const int cc = (cc_); \
                const float bon = ps[SL].bon; const us8 vc = ps[SL].vc, vp = ps[SL].vp, g8 = ps[SL].g8; \
                if (cc + 4 < NCH) RK_PLOAD(SL, cc + 4); \
                const RLAS float* yt = ytile + (cc & 1) * (32 * 68) + trow * 68 + v8; \
                const f32x4 ya = *(const RLAS f32x4*)yt, yb = *(const RLAS f32x4*)(yt + 4); \
                float yv[8] = {ya.x, ya.y, ya.z, ya.w, yb.x, yb.y, yb.z, yb.w}; \
                float sm = 0.f; \
                _Pragma("unroll") for (int i = 0; i < 8; ++i) sm += yv[i]; \
                const float mean = sum8(sm) * (1.f / 64.f); float sq = 0.f; \
                _Pragma("unroll") for (int i = 0; i < 8; ++i) { yv[i] -= mean; sq += yv[i] * yv[i]; } \
                const float rstd = __builtin_amdgcn_rsqf(sum8(sq) * (1.f / 64.f) + 64e-5f); \
                const int pos = cc * C + trow; const size_t tok = (size_t)b * S + pos; \
                float o[8]; \
                _Pragma("unroll") for (int i = 0; i < 8; ++i) { const float vcf = h2f(vc[i]), vpf = pos > 0 ? h2f(vp[i]) : 0.f; const float vx = vcf + (vpf - vcf) * mv[i]; \
                    o[i] = (yv[i] * rstd * lg[i] + lb[i] + bon * vx) * h2f(g8[i]); } \
                *(RGAS u32x4*)(Y16 + tok * D + 1024 + h * 64 + v8) = (u32x4){pkh(o[0], o[1]), pkh(o[2], o[3]), pkh(o[4], o[5]), pkh(o[6], o[7])}; } } while (0)
        RK_PLOAD(0, 0); RK_PLOAD(1, 1); RK_PLOAD(2, 2); RK_PLOAD(3, 3);
        for (int cb = 0; cb < NCH; cb += 4) {
            RK_PSTEP(3, cb - 1); RK_PSTEP(0, cb); RK_PSTEP(1, cb + 1); RK_PSTEP(2, cb + 2);
        }
        RK_PSTEP(3, NCH - 1);
#undef RK_PSTEP
#undef RK_PLOAD
    }
    __syncthreads();
}
#undef RLAS
#undef RGAS
}

constexpr int NWAVES = 8;
constexpr int RING_OFF = 0, RING_BYTES = 131072;
constexpr int LDSCTL_OFF = RING_BYTES, MISC_OFF = LDSCTL_OFF + 320;
constexpr int LDS_BYTES = 147456;
#define GAS __attribute__((address_space(1)))
#define LAS __attribute__((address_space(3)))
typedef unsigned v4u __attribute__((ext_vector_type(4)));
typedef float f32x4 __attribute__((ext_vector_type(4)));
typedef GAS unsigned gu32;
#define RLX_AGENT __ATOMIC_RELAXED, __HIP_MEMORY_SCOPE_AGENT
#define LDS_WAIT() asm volatile("s_waitcnt lgkmcnt(0)" ::: "memory")
#define VM_WAIT() asm volatile("s_waitcnt vmcnt(0)" ::: "memory")
constexpr int CW_CONVQ = 65;
constexpr int CW_ATTQ = 64;
constexpr int CW_BAR = 4096;
constexpr size_t CTL_ZERO_BYTES = 64 * 1024;

#define XB_TMO      128
#define XB_XCNT(j)  (256  + 64 * (j))
#define XB_XSUB(j)  (1280 + 64 * (j))
#define XB_XGEN(j)  (2304 + 64 * (j))
#define XB_TOP      3328
#define XB_TOPGEN   3392
#define XCD_BAR_WORDS 3456
#define XB_SPIN_CAP (1u << 18)

__device__ __forceinline__ unsigned xb_ld(unsigned* p)              { return __hip_atomic_load(p, __ATOMIC_RELAXED, __HIP_MEMORY_SCOPE_AGENT); }
__device__ __forceinline__ unsigned xb_add(unsigned* p, unsigned v) { return __hip_atomic_fetch_add(p, v, __ATOMIC_RELAXED, __HIP_MEMORY_SCOPE_AGENT); }
__device__ __forceinline__ unsigned xb_xcc_id() { return (unsigned)__builtin_amdgcn_s_getreg((3 << 11) | 20) & 0xFu; }
#define XB_SPIN(cond, bar) do { unsigned _sp = 0; while (cond) { __builtin_amdgcn_s_sleep(1); \
    if ((++_sp & 255u) == 0u) { if (xb_ld(&(bar)[XB_TMO])) break; if (_sp > XB_SPIN_CAP) { atomicAdd(&(bar)[XB_TMO], 1u); break; } } } } while (0)

struct XcdBarrier {
    unsigned* bar; unsigned x; bool w0;
    volatile LAS unsigned* st;
};

__device__ __forceinline__ XcdBarrier xcd_barrier_post(unsigned* bar, volatile LAS unsigned* st) {
    XcdBarrier b; b.bar = bar; b.x = xb_xcc_id(); b.st = st; b.w0 = (__builtin_amdgcn_readfirstlane(threadIdx.x >> 6) == 0);
    if (__builtin_amdgcn_readfirstlane(threadIdx.x >> 6) == 0 && pg8::lane_id() == 0) (void)xb_add(&bar[XB_XCNT(b.x)], 1u);
    return b;
}
__device__ __forceinline__ void xcd_barrier_complete(unsigned* bar, unsigned x, unsigned& nloc, unsigned& nx) {
    const unsigned G = gridDim.x * gridDim.y * gridDim.z;
    unsigned sum, cnt, mine, sp = 0u;
    for (;;) {
        sum = 0u; cnt = 0u; mine = 0u;
#pragma unroll
        for (unsigned j = 0; j < 16; ++j) { const unsigned c = xb_ld(&bar[XB_XCNT(j)]); sum += c; cnt += (c > 0u) ? 1u : 0u; mine = (j == x) ? c : mine; }
        if (sum == G) break;
        __builtin_amdgcn_s_sleep(1);
        if ((++sp & 255u) == 0u) { if (xb_ld(&bar[XB_TMO])) break; if (sp > XB_SPIN_CAP) { atomicAdd(&bar[XB_TMO], 1u); break; } }
    }
    nloc = mine > 0u ? mine : 1u; nx = cnt > 0u ? cnt : 1u;
}

__device__ __forceinline__ void xcd_barrier(const XcdBarrier& b) {
    asm volatile("s_waitcnt vmcnt(0)" ::: "memory");
    __syncthreads();
    if (b.w0 && pg8::lane_id() == 0) {
        unsigned* bar = b.bar;
        __builtin_amdgcn_s_waitcnt(0);
        unsigned nloc = b.st[0], nx = b.st[1];
        if (nloc == 0u) { xcd_barrier_complete(bar, b.x, nloc, nx); b.st[0] = nloc; b.st[1] = nx; }
        const unsigned old = xb_add(&bar[XB_XSUB(b.x)], 1u);
        const unsigned gen = old / nloc;
        if (old + 1u == (gen + 1u) * nloc) {
            __builtin_amdgcn_fence(__ATOMIC_RELEASE, "agent");
            asm volatile("s_waitcnt vmcnt(0)" ::: "memory");
            const unsigned og = xb_add(&bar[XB_TOP], 1u);
            const unsigned tg = og / nx;
            if (og + 1u == (tg + 1u) * nx) xb_add(&bar[XB_TOPGEN], 1u);
            else XB_SPIN(xb_ld(&bar[XB_TOPGEN]) == tg, bar);
            __builtin_amdgcn_fence(__ATOMIC_ACQUIRE, "agent");
            xb_add(&bar[XB_XGEN(b.x)], 1u);
            asm volatile("s_waitcnt vmcnt(0)" ::: "memory");
        } else {
            XB_SPIN(xb_ld(&bar[XB_XGEN(b.x)]) == gen, bar);
            __builtin_amdgcn_fence(__ATOMIC_ACQUIRE, "agent");
            asm volatile("s_waitcnt vmcnt(0)" ::: "memory");
        }
    }
    __syncthreads();
}


typedef unsigned short f16_t;
typedef _Float16 h2v __attribute__((ext_vector_type(2)));
__device__ __forceinline__ unsigned pk2h(float lo, float hi) { h2v v = {(_Float16)lo, (_Float16)hi}; return __builtin_bit_cast(unsigned, v); }

struct Frame {
    LAS unsigned char* lds; volatile LAS unsigned* MISC; gu32* ctl;
    int wave, vcu, G;
};
#define FTID (F.wave * 64 + pg8::lane_id())
#define FLANE (pg8::lane_id())
__device__ __forceinline__ void p0_transpose_item(const float* W, int K, int N, f16_t* WT, int row_off, LAS float* scr, int item, int lane) {
    const int nblk = N / 32, kb = item / nblk, nb = item % nblk, k0 = 64 * kb, n0 = 32 * nb;
#pragma unroll 8
    for (int i = 0; i < 32; ++i) { const int kk = 2 * i + (lane >> 5); scr[kk * 33 + (lane & 31)] = W[(size_t)(k0 + kk) * N + n0 + (lane & 31)]; }
    LDS_WAIT(); asm volatile("" ::: "memory");
    const int c = lane & 7;
#pragma unroll
    for (int j = 0; j < 4; ++j) { const int n = (lane >> 3) + 8 * j; const LAS float* s = scr + (8 * c) * 33 + n;
        v4u o; o.x = pk2h(s[0 * 33], s[1 * 33]); o.y = pk2h(s[2 * 33], s[3 * 33]); o.z = pk2h(s[4 * 33], s[5 * 33]); o.w = pk2h(s[6 * 33], s[7 * 33]);
        *(GAS v4u*)(WT + (size_t)(row_off + n0 + n) * K + k0 + 8 * c) = o; }
    LDS_WAIT(); asm volatile("" ::: "memory");
}
#ifndef TP_LD
#define TP_LD(p) (*(p))
#endif
struct TpDesc { const float* W; f16_t* WT; int K, N, row_off, item; };
__device__ __forceinline__ void tp_load(float (&r)[32], const TpDesc& d, int lane) {
    const int nblk = d.N / 32, kb = d.item / nblk, nb = d.item % nblk, k0 = 64 * kb, n0 = 32 * nb;
#pragma unroll
    for (int i = 0; i < 32; ++i) r[i] = TP_LD(d.W + (size_t)(k0 + 2 * i + (lane >> 5)) * d.N + n0 + (lane & 31));
}
__device__ __forceinline__ void tp_emit(const TpDesc& d, LAS float* scr, int lane) {
    const int nblk = d.N / 32, kb = d.item / nblk, nb = d.item % nblk, k0 = 64 * kb, n0 = 32 * nb, c = lane & 7;
#pragma unroll
    for (int j = 0; j < 4; ++j) { const int n = (lane >> 3) + 8 * j; const LAS float* sp = scr + (8 * c) * 33 + n;
        v4u o; o.x = pk2h(sp[0 * 33], sp[1 * 33]); o.y = pk2h(sp[2 * 33], sp[3 * 33]); o.z = pk2h(sp[4 * 33], sp[5 * 33]); o.w = pk2h(sp[6 * 33], sp[7 * 33]);
        *(GAS v4u*)(d.WT + (size_t)(d.row_off + n0 + n) * d.K + k0 + 8 * c) = o; }
}
template <class MK> __device__ __forceinline__ void tp_stream(int first, int n, int stride, MK mk, LAS float* scr, int lane) {
    if (first >= n) return;
    float r[32]; int it = first; TpDesc d = mk(it); tp_load(r, d, lane);
    for (;;) {
#pragma unroll
        for (int i = 0; i < 32; ++i) scr[(2 * i + (lane >> 5)) * 33 + (lane & 31)] = r[i];
        LDS_WAIT(); asm volatile("" ::: "memory");
        const int nit = it + stride; const bool more = nit < n; TpDesc dn = d;
        if (more) { dn = mk(nit); tp_load(r, dn, lane); }
        tp_emit(d, scr, lane);
        LDS_WAIT(); asm volatile("" ::: "memory");
        if (!more) break;
        it = nit; d = dn;
    }
}
#ifndef TPD_AUX
#define TPD_AUX 2
#endif
__device__ __forceinline__ void tpd_load(const TpDesc& d, LAS unsigned char* buf, int lane) {
    const int nblk = d.N / 32, kb = d.item / nblk, nb = d.item % nblk, k0 = 64 * kb, n0 = 32 * nb;
    const float* src = d.W + (size_t)(k0 + (lane >> 3)) * d.N + n0;
#pragma unroll
    for (int j = 0; j < 8; ++j) __builtin_amdgcn_global_load_lds((const unsigned*)(src + (size_t)(8 * j) * d.N + 4 * ((lane & 7) ^ j)), (LAS unsigned*)(buf + j * 1024), 16, 0, TPD_AUX);
}
__device__ __forceinline__ void tpd_emit(const TpDesc& d, const LAS unsigned char* buf, int lane) {
    const int nblk = d.N / 32, kb = d.item / nblk, nb = d.item % nblk, k0 = 64 * kb, n0 = 32 * nb, c = lane & 7;
#pragma unroll
    for (int j = 0; j < 4; ++j) { const int n = (lane >> 3) + 8 * j; const LAS float* sp = (const LAS float*)(buf + (8 * c) * 128 + (((n >> 2) ^ c) * 16) + (n & 3) * 4);
        v4u o; o.x = pk2h(sp[0 * 32], sp[1 * 32]); o.y = pk2h(sp[2 * 32], sp[3 * 32]); o.z = pk2h(sp[4 * 32], sp[5 * 32]); o.w = pk2h(sp[6 * 32], sp[7 * 32]);
        __builtin_nontemporal_store(o, (GAS v4u*)(d.WT + (size_t)(d.row_off + n0 + n) * d.K + k0 + 8 * c)); }
}
template <class MK> __device__ __forceinline__ void tpd_stream(int first, int n, int stride, MK mk, LAS unsigned char* buf, int lane) {
    for (int it = first; it < n; it += 2 * stride) {
        const bool two = it + stride < n;
        const TpDesc d0 = mk(it); const TpDesc d1 = mk(two ? it + stride : it);
        tpd_load(d0, buf, lane); if (two) tpd_load(d1, buf + 8192, lane);
        asm volatile("s_waitcnt vmcnt(0)" ::: "memory");
        tpd_emit(d0, buf, lane); if (two) tpd_emit(d1, buf + 8192, lane);
        LDS_WAIT(); asm volatile("" ::: "memory");
    }
}
__device__ __forceinline__ float wave_sum_b(float v) {
#pragma unroll
    for (int o = 1; o < 64; o <<= 1) v += __shfl_xor(v, o);
    return v;
}
__device__ __forceinline__ void ln_row_dual(int lane, const float* xrow, const float* g, const float* b, float* o32, f16_t* o16) {
    const GAS f32x4* xr = (const GAS f32x4*)xrow + lane;
    f32x4 v[8]; float s = 0.f;
#pragma unroll
    for (int j = 0; j < 8; ++j) { v[j] = xr[64 * j]; s += (v[j].x + v[j].y) + (v[j].z + v[j].w); }
    const float mean = wave_sum_b(s) * (1.f / D); float s2 = 0.f;
#pragma unroll
    for (int j = 0; j < 8; ++j) { v[j] = v[j] - mean; s2 += (v[j].x * v[j].x + v[j].y * v[j].y) + (v[j].z * v[j].z + v[j].w * v[j].w); }
    const float rstd = __builtin_amdgcn_rsqf(wave_sum_b(s2) * (1.f / D) + LN_EPS);
    const GAS f32x4* g4 = (const GAS f32x4*)g + lane; const GAS f32x4* b4 = (const GAS f32x4*)b + lane;
    GAS f32x4* o4 = (GAS f32x4*)o32 + lane; GAS unsigned long long* o8 = (GAS unsigned long long*)o16 + lane;
#pragma unroll
    for (int j = 0; j < 8; ++j) { const f32x4 o = v[j] * rstd * g4[64 * j] + b4[64 * j]; o4[64 * j] = o;
        o8[64 * j] = (unsigned long long)pk2h(o.x, o.y) | ((unsigned long long)pk2h(o.z, o.w) << 32); }
}


__device__ __forceinline__ void ln_row_f16(int lane, const float* xrow, const float* g, const float* b, f16_t* o16, float2* st) {
    const GAS f32x4* xr = (const GAS f32x4*)xrow + lane;
    f32x4 v[8]; float s = 0.f;
#pragma unroll
    for (int j = 0; j < 8; ++j) { v[j] = xr[64 * j]; s += (v[j].x + v[j].y) + (v[j].z + v[j].w); }
    const float mean = wave_sum_b(s) * (1.f / D); float s2 = 0.f;
#pragma unroll
    for (int j = 0; j < 8; ++j) { v[j] = v[j] - mean; s2 += (v[j].x * v[j].x + v[j].y * v[j].y) + (v[j].z * v[j].z + v[j].w * v[j].w); }
    const float rstd = __builtin_amdgcn_rsqf(wave_sum_b(s2) * (1.f / D) + LN_EPS);
    const GAS f32x4* g4 = (const GAS f32x4*)g + lane; const GAS f32x4* b4 = (const GAS f32x4*)b + lane;
    GAS unsigned long long* o8 = (GAS unsigned long long*)o16 + lane;
#pragma unroll
    for (int j = 0; j < 8; ++j) { const f32x4 o = v[j] * rstd * g4[64 * j] + b4[64 * j];
        o8[64 * j] = (unsigned long long)pk2h(o.x, o.y) | ((unsigned long long)pk2h(o.z, o.w) << 32); }
    if (lane == 0) *st = make_float2(mean, rstd);
}

__device__ __forceinline__ void p0_transpose_item_gu(const float* W, int K, int N, f16_t* WT, int gu_s, LAS float* scr, int item, int lane) {
    const int nblk = N / 32, nb = item % nblk; const int row_off = gu_s < 0 ? 0 : 128 * (nb >> 2) + 128 * gu_s;
    p0_transpose_item(W, K, N, WT, row_off, scr, item, lane);
}
__device__ __forceinline__ void ln_norm(int lane, f32x4 (&v)[8], const float* g, const float* b) {
    float s = 0.f;
#pragma unroll
    for (int j = 0; j < 8; ++j) s += (v[j].x + v[j].y) + (v[j].z + v[j].w);
    const float mean = wave_sum_b(s) * (1.f / D); float s2 = 0.f;
#pragma unroll
    for (int j = 0; j < 8; ++j) { v[j] = v[j] - mean; s2 += (v[j].x * v[j].x + v[j].y * v[j].y) + (v[j].z * v[j].z + v[j].w * v[j].w); }
    const float rstd = __builtin_amdgcn_rsqf(wave_sum_b(s2) * (1.f / D) + LN_EPS);
    const GAS f32x4* g4 = (const GAS f32x4*)g + lane; const GAS f32x4* b4 = (const GAS f32x4*)b + lane;
#pragma unroll
    for (int j = 0; j < 8; ++j) v[j] = v[j] * rstd * g4[64 * j] + b4[64 * j];
}
__device__ __forceinline__ void ln_store(int lane, const f32x4 (&v)[8], float* o32, f16_t* o16) {
    GAS f32x4* o4 = (GAS f32x4*)o32 + lane; GAS unsigned long long* o8 = (GAS unsigned long long*)o16 + lane;
#pragma unroll
    for (int j = 0; j < 8; ++j) { o4[64 * j] = v[j]; o8[64 * j] = (unsigned long long)pk2h(v[j].x, v[j].y) | ((unsigned long long)pk2h(v[j].z, v[j].w) << 32); }
}
__device__ __forceinline__ void ln_store16(int lane, const f32x4 (&v)[8], f16_t* o16) {
    GAS unsigned long long* o8 = (GAS unsigned long long*)o16 + lane;
#pragma unroll
    for (int j = 0; j < 8; ++j) o8[64 * j] = (unsigned long long)pk2h(v[j].x, v[j].y) | ((unsigned long long)pk2h(v[j].z, v[j].w) << 32);
}
__device__ __forceinline__ void ln_regs(int lane, f32x4 (&v)[8], const float* g, const float* b, float* o32, f16_t* o16) { ln_norm(lane, v, g, b); ln_store(lane, v, o32, o16); }
__device__ __forceinline__ void route_token(int tok, const float (&acc)[36], const float* gb, const float* eb, int* cnt, int* ltok, int* lpair, float* pairw) {
    float gl[4]; float gm = -3.0e38f; int gi = 0;
#pragma unroll
    for (int i = 0; i < 4; ++i) { gl[i] = acc[i] + gb[i]; if (gl[i] > gm) { gm = gl[i]; gi = i; } }
    float gs = 0.f;
#pragma unroll
    for (int i = 0; i < 4; ++i) gs += __expf(gl[i] - gm);
    const float gtop = 1.f / gs;
    float el[8]; float em = -3.0e38f; int e0 = 0;
#pragma unroll
    for (int i = 0; i < 8; ++i) { float v = 0.f;
#pragma unroll
        for (int g = 0; g < 4; ++g) if (g == gi) v = acc[4 + g * 8 + i] + eb[g * 8 + i];
        el[i] = v; if (v > em) { em = v; e0 = i; } }
    float em2 = -3.0e38f; int e1 = 0;
#pragma unroll
    for (int i = 0; i < 8; ++i) if (i != e0 && el[i] > em2) { em2 = el[i]; e1 = i; }
    const float x1 = __expf(em2 - em);
    const float w0 = 1.f / (1.f + x1), w1 = x1 / (1.f + x1);
    const int ea = gi * 8 + e0, ebb = gi * 8 + e1;
    const int p0 = atomicAdd(&cnt[ea], 1); ltok[ea * 8192 + p0] = tok; lpair[ea * 8192 + p0] = tok * 2;
    const int p1 = atomicAdd(&cnt[ebb], 1); ltok[ebb * 8192 + p1] = tok; lpair[ebb * 8192 + p1] = tok * 2 + 1;
    pairw[tok * 2] = w0 * gtop; pairw[tok * 2 + 1] = w1 * gtop;
}
constexpr int TAB_OFF = LDSCTL_OFF + 1024;
__device__ __forceinline__ void build_moe_table(Frame& F, const int* cnt) {
    LAS int* tab = (LAS int*)(F.lds + TAB_OFF);
    const int tid = FTID;
    if (tid < 32) tab[tid] = __hip_atomic_load(cnt + tid, __ATOMIC_RELAXED, __HIP_MEMORY_SCOPE_AGENT);
    __syncthreads();
    if (tid == 0) { int p = 0, pa = 0, pb = 0; for (int e = 0; e < 32; ++e) { const int nb = (tab[e] + 255) >> 8, na = nb < 2 ? nb : 2;
            tab[32 + e] = p; tab[65 + e] = pa; tab[98 + e] = pb; p += nb; pa += na; pb += nb - na; } tab[64] = p; tab[97] = pa; tab[130] = pb; }
    __syncthreads();
}

__device__ __forceinline__ float sum8_dpp(float x) {
    x += __builtin_bit_cast(float, __builtin_amdgcn_update_dpp(0, __builtin_bit_cast(int, x), 0xB1, 0xF, 0xF, true));
    x += __builtin_bit_cast(float, __builtin_amdgcn_update_dpp(0, __builtin_bit_cast(int, x), 0x4E, 0xF, 0xF, true));
    x += __builtin_bit_cast(float, __builtin_amdgcn_update_dpp(0, __builtin_bit_cast(int, x), 0x141, 0xF, 0xF, true));
    return x;
}
__device__ __forceinline__ float h2f(unsigned short u) { return (float)__builtin_bit_cast(_Float16, u); }
__device__ __forceinline__ float sum32_x(float x) {
    x += __builtin_bit_cast(float, __builtin_amdgcn_update_dpp(0, __builtin_bit_cast(int, x), 0xB1, 0xF, 0xF, true));
    x += __builtin_bit_cast(float, __builtin_amdgcn_update_dpp(0, __builtin_bit_cast(int, x), 0x4E, 0xF, 0xF, true));
    x += __builtin_bit_cast(float, __builtin_amdgcn_update_dpp(0, __builtin_bit_cast(int, x), 0x141, 0xF, 0xF, true));
    x += __builtin_bit_cast(float, __builtin_amdgcn_update_dpp(0, __builtin_bit_cast(int, x), 0x140, 0xF, 0xF, true));
    x += __builtin_bit_cast(float, __builtin_amdgcn_ds_bpermute((pg8::lane_id() ^ 16) << 2, __builtin_bit_cast(int, x)));
    return x;
}
__device__ __forceinline__ float wsum64(float x) {
    x = sum32_x(x); auto rr = __builtin_amdgcn_permlane32_swap(__float_as_uint(x), __float_as_uint(x), false, false); return __uint_as_float(rr[0]) + __uint_as_float(rr[1]);
}
__device__ __forceinline__ void rwkv_prep_tile(Frame& F, int tile, const f16_t* PROJ16, const f16_t* LSLAB, const float* mu, const float* w0, const f16_t* W2T, const float* a0, const f16_t* A2T, const f16_t* G2T,
                                               const float* k_k, const float* k_a, float* lwout, f16_t* kmod, f16_t* Aout, f16_t* Bout, f16_t* gout) {
    typedef _Float16 f16x8 __attribute__((ext_vector_type(8))); typedef float f32x16 __attribute__((ext_vector_type(16)));
    constexpr int SXS = 592;
    LAS unsigned char* sx = F.lds + RING_OFF;
    const int lane = FLANE, tid = F.wave * 64 + lane, t0 = tile * 32, r32 = lane & 31, hi = lane >> 5;
    __syncthreads();
    for (int e = tid; e < 32 * 36; e += 512) {
        typedef unsigned short us8v __attribute__((ext_vector_type(8)));
        const int tok = e / 36, i8 = (e % 36) * 8, pos = (t0 + tok) & (S - 1);
        float cv[8], pv[8];
#pragma unroll
        for (int i = 0; i < 8; ++i) { cv[i] = 0.f; pv[i] = 0.f; }
#pragma unroll
        for (int sl = 0; sl < 4; ++sl) { const f16_t* cur = LSLAB + ((size_t)sl * T + t0 + tok) * 512 + i8;
            const us8v c8 = *(const GAS us8v*)cur; us8v p8 = c8; if (pos > 0) p8 = *(const GAS us8v*)(cur - 512);
#pragma unroll
            for (int i = 0; i < 8; ++i) { cv[i] += h2f(c8[i]); pv[i] += h2f(p8[i]); } }
        float f[8];
#pragma unroll
        for (int i = 0; i < 8; ++i) { const float xs = cv[i] + ((pos > 0 ? pv[i] : 0.f) - cv[i]) * mu[3072 + i8 + i];
            f[i] = i8 < 64 ? 1.f - 2.f / (1.f + __expf(2.f * xs)) : (i8 < 128 ? xs : 1.f / (1.f + __expf(-xs))); }
        *(LAS v4u*)(sx + tok * SXS + i8 * 2) = (v4u){pk2h(f[0], f[1]), pk2h(f[2], f[3]), pk2h(f[4], f[5]), pk2h(f[6], f[7])};
    }
    __syncthreads();
    const LAS unsigned char* ap = sx + r32 * SXS + hi * 16;
#pragma unroll 1
    for (int hd = 0; hd < 2; ++hd) {
        const int ch0 = 128 * F.wave + 64 * hd;
        f32x16 aw[2], aa[2], ag[2];
#pragma unroll
        for (int tt = 0; tt < 2; ++tt)
#pragma unroll
            for (int r = 0; r < 16; ++r) { aw[tt][r] = 0.f; aa[tt][r] = 0.f; ag[tt][r] = 0.f; }
#pragma unroll
        for (int tt = 0; tt < 2; ++tt) {
            const int n = ch0 + 32 * tt + r32;
            const f16_t* bw = W2T + (size_t)n * 64 + hi * 8; const f16_t* ba = A2T + (size_t)n * 64 + hi * 8; const f16_t* bg = G2T + (size_t)n * 160 + hi * 8;
#pragma unroll
            for (int ks = 0; ks < 4; ++ks) {
                aw[tt] = __builtin_amdgcn_mfma_f32_32x32x16_f16(*(const LAS f16x8*)(ap + ks * 32), *(const GAS f16x8*)(bw + ks * 16), aw[tt], 0, 0, 0);
                aa[tt] = __builtin_amdgcn_mfma_f32_32x32x16_f16(*(const LAS f16x8*)(ap + 128 + ks * 32), *(const GAS f16x8*)(ba + ks * 16), aa[tt], 0, 0, 0); }
#pragma unroll
            for (int ks = 0; ks < 10; ++ks)
                ag[tt] = __builtin_amdgcn_mfma_f32_32x32x16_f16(*(const LAS f16x8*)(ap + 256 + ks * 32), *(const GAS f16x8*)(bg + ks * 16), ag[tt], 0, 0, 0);
        }
        float k0[2][16];
        float pkk[2], pka[2], pmu[2], pw0[2], pa0[2];
#pragma unroll
        for (int tt = 0; tt < 2; ++tt) { const int n = ch0 + 32 * tt + r32; pkk[tt] = k_k[n]; pka[tt] = k_a[n]; pmu[tt] = mu[1024 + n]; pw0[tt] = w0[n]; pa0[tt] = a0[n]; }
#pragma unroll
        for (int rh = 0; rh < 2; ++rh) {
        float inv[8];
#pragma unroll
        for (int r = 8 * rh; r < 8 * rh + 8; ++r) { const int tok = t0 + (r & 3) + 8 * (r >> 2) + 4 * hi, pos = tok & (S - 1); float ss = 0.f;
#pragma unroll
            for (int tt = 0; tt < 2; ++tt) { const f16_t* cur = PROJ16 + (size_t)tok * PN + 4096 + ch0 + 32 * tt + r32;
                const float cv = h2f(cur[0]), pv = pos > 0 ? h2f(cur[-PN]) : 0.f; k0[tt][r] = cv + (pv - cv) * pmu[tt]; const float kq = k0[tt][r] * pkk[tt]; ss = fmaf(kq, kq, ss); }
            ss = sum32_x(ss); inv[r - 8 * rh] = __builtin_amdgcn_rsqf(fmaxf(ss, 1e-24f)); }
#pragma unroll
        for (int r = 8 * rh; r < 8 * rh + 8; ++r) { const int tok = t0 + (r & 3) + 8 * (r >> 2) + 4 * hi;
#pragma unroll
            for (int tt = 0; tt < 2; ++tt) { const size_t o = (size_t)tok * RWK + ch0 + 32 * tt + r32;
                const float z = -(pw0[tt] + aw[tt][r]); const float sp = z > 20.f ? z : __logf(1.f + __expf(z));
                lwout[o] = -__expf(-sp - 0.5f);
                const float asig = 1.f / (1.f + __expf(-(pa0[tt] + aa[tt][r]))); const float kk = k0[tt][r] * pkk[tt] * inv[r - 8 * rh];
                kmod[o] = __builtin_bit_cast(unsigned short, (_Float16)(k0[tt][r] * (1.f + (asig - 1.f) * pka[tt])));
                Aout[o] = __builtin_bit_cast(unsigned short, (_Float16)(-kk)); Bout[o] = __builtin_bit_cast(unsigned short, (_Float16)(kk * asig));
                gout[o] = __builtin_bit_cast(unsigned short, (_Float16)ag[tt][r]); } }
        }
    }
}
__device__ __forceinline__ float sum16_dpp(float x) {
    x += __builtin_bit_cast(float, __builtin_amdgcn_update_dpp(0, __builtin_bit_cast(int, x), 0xB1, 0xF, 0xF, true));
    x += __builtin_bit_cast(float, __builtin_amdgcn_update_dpp(0, __builtin_bit_cast(int, x), 0x4E, 0xF, 0xF, true));
    x += __builtin_bit_cast(float, __builtin_amdgcn_update_dpp(0, __builtin_bit_cast(int, x), 0x141, 0xF, 0xF, true));
    x += __builtin_bit_cast(float, __builtin_amdgcn_update_dpp(0, __builtin_bit_cast(int, x), 0x140, 0xF, 0xF, true));
    return x;
}
__device__ __forceinline__ f32x4 h4f(const f16_t* p) { typedef _Float16 h4_t __attribute__((ext_vector_type(4))); const h4_t v = *(const GAS h4_t*)p; return (f32x4){(float)v[0], (float)v[1], (float)v[2], (float)v[3]}; }
#ifndef REP_P0
#define REP_P0 1
#endif
#ifndef REP_PROJ
#define REP_PROJ 1
#endif
#ifndef REP_PLE
#define REP_PLE 1
#endif
#ifndef REP_CONV
#define REP_CONV 1
#endif
#ifndef REP_P2
#define REP_P2 1
#endif
#ifndef CONV_RATE
#define CONV_RATE 768
#endif
#ifndef REP_P3
#define REP_P3 1
#endif
#ifndef PROBE_K
#define PROBE_K -1
#endif
#ifndef PROBE_J
#define PROBE_J -1
#endif
#ifndef PROBE_SCALE
#define PROBE_SCALE 1e-3f
#endif
#ifndef REP_P5
#define REP_P5 1
#endif
#ifndef REP_P8
#define REP_P8 1
#endif
#ifndef REP_P6
#define REP_P6 1
#endif
#ifndef REP_P7
#define REP_P7 1
#endif
struct Args { const float* in[37]; float* out; unsigned char* ws; int ph_lo, ph_hi, li, pad; };
__global__ void __launch_bounds__(NWAVES * 64, 2) mega_fwd(Args args) {
    extern __shared__ __attribute__((aligned(16))) unsigned char lds[];
    Frame F;
    F.lds = (LAS unsigned char*)lds; F.MISC = (volatile LAS unsigned*)(F.lds + MISC_OFF);
    F.wave = __builtin_amdgcn_readfirstlane(threadIdx.x >> 6);
    F.G = gridDim.x; { const int bx = blockIdx.x; F.vcu = (F.G % 8 == 0) ? (bx % 8) * (F.G / 8) + bx / 8 : bx; }
    unsigned char* ws = args.ws;
    F.ctl = (gu32*)(ws);
    for (int u = FTID; u < (LDS_BYTES - LDSCTL_OFF) / 4; u += NWAVES * 64) ((LAS unsigned*)(F.lds + LDSCTL_OFF))[u] = 0u;
    __syncthreads();
    XcdBarrier bar = xcd_barrier_post((unsigned*)(F.ctl + CW_BAR) + args.li * XCD_BAR_WORDS, F.MISC + 8);
    unsigned long long t0_ = 0, tk_ = 0; if (PROBE_K != -1) t0_ = __builtin_amdgcn_s_memrealtime();
    const int lo = args.ph_lo, hi = args.ph_hi;
#define IN(k) (lo <= (k) && (k) < hi)
#define BOTH(k) (IN(k) && IN((k) + 1))
    f16_t* WinT = (f16_t*)(ws + WS_WINT); f16_t* H16 = (f16_t*)(ws + WS_H16); f16_t* PROJ16 = (f16_t*)(ws + WS_PROJ16); float* DECAY = (float*)(ws + WS_DECAY); f16_t* KMOD = (f16_t*)(ws + WS_KMOD); f16_t* A16 = (f16_t*)(ws + WS_A16); f16_t* B16 = (f16_t*)(ws + WS_B16); f16_t* G16 = (f16_t*)(ws + WS_G16);
    f16_t* WoutT = (f16_t*)(ws + WS_WOUTT); f16_t* GateT = (f16_t*)(ws + WS_GATET); f16_t* PleT = (f16_t*)(ws + WS_PLET); f16_t* P16 = (f16_t*)(ws + WS_P16);
    f16_t* PW16 = (f16_t*)(ws + WS_PW16); f16_t* Y16 = (f16_t*)(ws + WS_Y16); float* ROWRS = (float*)(ws + WS_ROWRS);
    float* RT = (float*)(ws + WS_RT); f16_t* GUT = (f16_t*)(ws + WS_GUT); f16_t* DNT = (f16_t*)(ws + WS_DNT); f16_t* HID = (f16_t*)(ws + WS_HID); f16_t* FFN16 = (f16_t*)(ws + WS_FFN16); f16_t* H1_16 = (f16_t*)(ws + WS_H1_16);
    int* cnt = (int*)(ws + WS_CNT); int* ltok = (int*)(ws + WS_LTOK); int* lpair = (int*)(ws + WS_LPAIR); float* pairw = (float*)(ws + WS_PAIRW);
    const int gw = F.vcu * NWAVES + F.wave, NGW = F.G * NWAVES;
    if (IN(0)) for (int rep_ = 0; rep_ < REP_P0; ++rep_) {
        LAS float* scr = (LAS float*)(F.lds + RING_OFF + F.wave * 16384);
        constexpr int I_IN = (D / 64) * (NPROJ / 32);
        for (int it = gw; it < I_IN; it += NGW) p0_transpose_item(args.in[5], D, NPROJ, WinT, 0, scr, it, FLANE);
        constexpr int I_SQ = (D / 64) * (D / 32), I_PLE = (256 / 64) * (D / 32);
        for (int it = gw; it < 2 * I_SQ + I_PLE; it += NGW) {
            if (it < I_SQ) p0_transpose_item(args.in[22], D, D, WoutT, 0, scr, it, FLANE);
            else if (it < 2 * I_SQ) p0_transpose_item(args.in[36], D, D, GateT, 0, scr, it - I_SQ, FLANE);
            else p0_transpose_item(args.in[34], 256, D, PleT, 0, scr, it - 2 * I_SQ, FLANE);
        }
        { const GAS f32x4* pi = (const GAS f32x4*)args.in[1]; GAS unsigned long long* po = (GAS unsigned long long*)P16;
          for (int i = blockIdx.x * 512 + FTID; i < T * 256 / 4; i += F.G * 512) { const f32x4 v = pi[i]; po[i] = (unsigned long long)pk2h(v.x, v.y) | ((unsigned long long)pk2h(v.z, v.w) << 32); } }
        { GAS v4u* z = (GAS v4u*)(WinT + (size_t)NPROJ * D); const int nz = (PN - NPROJ) * D * 2 / 16;
          for (int i = blockIdx.x * 512 + FTID; i < nz; i += F.G * 512) z[i] = (v4u){0u, 0u, 0u, 0u}; }
        {
            f16_t* W2T = (f16_t*)(ws + WS_W2T); f16_t* A2T = (f16_t*)(ws + WS_A2T); f16_t* G2T = (f16_t*)(ws + WS_G2T);
            for (int i = blockIdx.x * 512 + FTID; i < 1024 * 288; i += F.G * 512) { const int n = i / 288, k = i % 288;
                if (k < 64) W2T[n * 64 + k] = __builtin_bit_cast(unsigned short, (_Float16)args.in[13][k * 1024 + n]);
                else if (k < 128) A2T[n * 64 + (k - 64)] = __builtin_bit_cast(unsigned short, (_Float16)args.in[15][(k - 64) * 1024 + n]);
                else G2T[n * 160 + (k - 128)] = __builtin_bit_cast(unsigned short, (_Float16)args.in[16][(k - 128) * 1024 + n]); } }
        if (blockIdx.x == 0) {
            const int tid = FTID; float* lamp = (float*)(ws + WS_LAM); float* biasT = (float*)(ws + WS_BIAS);
            if (tid < 64) { const float a = wave_sum_b(args.in[6][tid] * args.in[7][tid]), b2 = wave_sum_b(args.in[8][tid] * args.in[9][tid]); if (tid == 0) *lamp = expf(a) - expf(b2) + LAMBDA_INIT; }
            for (int i = tid; i < 8 * 129; i += 512) { const int hh = i / 129, n = i % 129; int bucket;
                if (n < 16) bucket = n; else { const int large = 16 + (int)(logf((float)n / 16.f) / 2.0794415416798357f * 16.f); bucket = large < 31 ? large : 31; }
                biasT[i] = args.in[4][bucket * 8 + hh]; }
        }
        for (int m = gw; m < T; m += NGW) ln_row_f16(FLANE, args.in[0] + (size_t)m * D, args.in[2], args.in[3], H16 + (size_t)m * D, (float2*)(ws + WS_ROWST) + m);
        if (BOTH(0) && rep_ == REP_P0 - 1) xcd_barrier(bar); else __syncthreads();
    }
    if (PROBE_K == 0) tk_ = __builtin_amdgcn_s_memrealtime();
    if (PROBE_J == 0) t0_ = __builtin_amdgcn_s_memrealtime();
    if (IN(1)) {
        pg8::Gemm g{H16, WinT, T, 6144, D, D}; pg8::StaticOrder S; S.init(T, 6144, F.G, (int)blockIdx.x);
        pg8::EpiF16 E{PROJ16, PN, 4, att::C2};
        for (int rep_ = 0; rep_ < REP_PROJ; ++rep_) pg8::gemm_phase<pg8::EpiF16, pg8::StaticOrder, true>(F.lds + RING_OFF, g, S, E, F.wave);
        { pg8::Gemm gl{H16, WinT + (size_t)6144 * D, T, 512, 512, D}; pg8::SplitKOrder Sl{T / 256, 2, 4, F.G, (int)blockIdx.x};
          pg8::EpiSlab El{(f16_t*)(ws + WS_LSLAB), 512, (size_t)T * 512};
          pg8::gemm_phase<pg8::EpiSlab, pg8::SplitKOrder, true>(F.lds + RING_OFF, gl, Sl, El, F.wave); }
        for (int rep_ = 0; rep_ < REP_PLE; ++rep_) { pg8::Gemm g2{P16, PleT, T, D, 256, 256}; pg8::StaticOrder S2; S2.init(T, D, F.G, (int)blockIdx.x);
          pg8::EpiF16 E2{PW16, D, 0, 1.f};
          pg8::gemm_phase<pg8::EpiF16, pg8::StaticOrder, true>(F.lds + RING_OFF, g2, S2, E2, F.wave); }
        if (BOTH(1)) xcd_barrier(bar);
    }
    if (PROBE_K == 1) tk_ = __builtin_amdgcn_s_memrealtime();
    if (PROBE_J == 1) t0_ = __builtin_amdgcn_s_memrealtime();
    if (IN(2)) {
        for (int rep_ = 0; rep_ < REP_P2; ++rep_)
        if (F.vcu < T / 32) { const int tile = F.vcu;
            rwkv_prep_tile(F, tile, PROJ16, (const f16_t*)(ws + WS_LSLAB), args.in[11], args.in[12], (const f16_t*)(ws + WS_W2T), args.in[14], (const f16_t*)(ws + WS_A2T), (const f16_t*)(ws + WS_G2T), args.in[17], args.in[18], DECAY, KMOD, A16, B16, G16);
            asm volatile("s_waitcnt vmcnt(0)" ::: "memory"); __syncthreads();
            { rk::ChunkIn nin; const int tl_ = (F.wave & 3) * 64 + FLANE, tg_ = tile * 32 + (tl_ >> 3), ps_ = tg_ & (S - 1), cb_ = (F.wave >> 2) * 64 + (tl_ & 7) * 8;
              rk::chunk_load(nin, tg_, ps_, cb_, ws);
              for (int hA = 0; hA < 16; hA += 2) {
                  rk::chunk_pair(F.lds + RING_OFF, F.wave, tile, hA, nin, hA + 2 < 16, args.in[11], args.in[19], ws); } }
            __syncthreads();
        }
        if (BOTH(2)) xcd_barrier(bar);
    }
    if (PROBE_K == 2) tk_ = __builtin_amdgcn_s_memrealtime();
    if (PROBE_J == 2) t0_ = __builtin_amdgcn_s_memrealtime();
    if (IN(3)) {
        if (F.vcu < 64) rk::scan_unit(F.lds + RING_OFF, F.wave, F.vcu, ws + WS_CHK, (const float*)(ws + WS_BONUS), PROJ16, args.in[11], G16, args.in[20], args.in[21], Y16);
        {
            const float lam = *(const float*)(ws + WS_LAM);
            volatile LAS unsigned* qslot = F.MISC + 12;
            const float* wg = args.in[29]; const float* wu = args.in[30]; const float* wd = args.in[31];
            auto conv_batch = [&]() -> bool {
                __syncthreads();
                if (FTID == 0) qslot[1] = __hip_atomic_fetch_add(F.ctl + CW_CONVQ, 1u, __ATOMIC_RELAXED, __HIP_MEMORY_SCOPE_AGENT);
                __syncthreads();
                const int q = (int)__builtin_amdgcn_readfirstlane(qslot[1]);
                if (q >= NE * 1536 / 64) return false;
                LAS unsigned char* scr = F.lds + RING_OFF + F.wave * 16384;
                tpd_stream(q * 64 + F.wave, q * 64 + 64, 8, [=](int it) { const int e = it / 1536, r = it % 1536;
                    if (r < 1024) { const int rr = r & 511, nb = rr % 16; return TpDesc{(r < 512 ? wg : wu) + (size_t)e * D * 512, GUT + (size_t)e * 1024 * D, D, 512, 128 * (nb >> 2) + (r < 512 ? 0 : 128), rr}; }
                    return TpDesc{wd + (size_t)e * 512 * D, DNT + (size_t)e * D * 512, 512, D, 0, r - 1024}; }, scr, FLANE);
                return true;
            };
            int credit = 0;
            for (;;) {
                __syncthreads();
                if (FTID == 0) *qslot = __hip_atomic_fetch_add(F.ctl + CW_ATTQ, 1u, __ATOMIC_RELAXED, __HIP_MEMORY_SCOPE_AGENT);
                __syncthreads();
                const int u = (int)__builtin_amdgcn_readfirstlane(*qslot);
                if (u >= 512) break;
                const int qb = 15 - (u >> 5), bh = u & 31;
                att::attn_unit<8>(F.lds + RING_OFF, F.wave, bh >> 3, bh & 7, qb, PROJ16, Y16, (const float*)(ws + WS_BIAS) + (bh & 7) * 129, lam, args.in[10]);
                credit += 2 * (qb + 1) * CONV_RATE;
                while (credit >= 8704) { credit -= 8704; if (!conv_batch()) { credit = 0; break; } }
            }
            while (conv_batch()) {}
        }
        if (BOTH(3)) xcd_barrier(bar);
    }
    if (PROBE_K == 3) tk_ = __builtin_amdgcn_s_memrealtime();
    if (PROBE_J == 3) t0_ = __builtin_amdgcn_s_memrealtime();
    if (IN(4)) {
        for (int i = blockIdx.x * 512 + FTID; i < 36 * D; i += F.G * 512) { const int e = i / D, d = i % D; RT[i] = e < 4 ? args.in[25][d * 4 + e] : args.in[27][d * 32 + (e - 4)]; }
        pg8::Gemm g{Y16, WoutT, T, D, D, D}; pg8::StaticOrder S; S.init(T, D, F.G, (int)blockIdx.x);
        pg8::EpiResLN E{args.in[0], args.out, D, ALPHA, (const float2*)(ws + WS_ROWST), args.in[2], args.in[3]};
        pg8::gemm_phase<pg8::EpiResLN, pg8::StaticOrder, true>(F.lds + RING_OFF, g, S, E, F.wave);
        if (BOTH(4)) xcd_barrier(bar);
    }
    if (PROBE_K == 4) tk_ = __builtin_amdgcn_s_memrealtime();
    if (PROBE_J == 4) t0_ = __builtin_amdgcn_s_memrealtime();
    if (IN(5)) for (int rep_ = 0; rep_ < REP_P5; ++rep_) {
        const bool dry = rep_ < REP_P5 - 1;
        f16_t* o16b = dry ? (f16_t*)(ws + WS_CHK + 64 * MiB) : H1_16;
        const int lane = FLANE, tid = F.wave * 64 + lane;
        LAS float* rtb = (LAS float*)(F.lds + RING_OFF);
        LAS float* lg = (LAS float*)(F.lds + RING_OFF + 49152) + F.wave * 256;
        if (F.vcu < T / 32) {
            const int r0 = F.vcu * 32 + F.wave * 4;
            f32x4 v0[8], v1[8], v2[8], v3[8];
            { const GAS f32x4* xr = (const GAS f32x4*)(args.out + (size_t)r0 * D) + lane;
#pragma unroll
              for (int j = 0; j < 8; ++j) { v0[j] = xr[64 * j]; v1[j] = xr[64 * j + D / 4]; v2[j] = xr[64 * j + 2 * (D / 4)]; v3[j] = xr[64 * j + 3 * (D / 4)]; } }
            ln_norm(lane, v0, args.in[23], args.in[24]); ln_norm(lane, v1, args.in[23], args.in[24]); asm volatile("" ::: "memory"); ln_norm(lane, v2, args.in[23], args.in[24]); ln_norm(lane, v3, args.in[23], args.in[24]);
            f32x4 stg[6];
#pragma unroll
            for (int i = 0; i < 6; ++i) stg[i] = *(const GAS f32x4*)(RT + 4 * (tid + 512 * i));
#pragma unroll 1
            for (int ec = 0; ec < 6; ++ec) {
                __syncthreads();
#pragma unroll
                for (int i = 0; i < 6; ++i) *(LAS f32x4*)(rtb + 4 * (tid + 512 * i)) = stg[i];
                { const int en = ec + 1 < 6 ? ec + 1 : ec;
#pragma unroll
                  for (int i = 0; i < 6; ++i) stg[i] = *(const GAS f32x4*)(RT + (size_t)en * 6 * D + 4 * (tid + 512 * i)); }
                __syncthreads();
                float a0[6], a1[6], a2[6], a3[6];
#pragma unroll
                for (int e = 0; e < 6; ++e) { a0[e] = 0.f; a1[e] = 0.f; a2[e] = 0.f; a3[e] = 0.f; }
#pragma unroll
                for (int j = 0; j < 8; ++j)
#pragma unroll
                    for (int e = 0; e < 6; ++e) { const f32x4 w = *(const LAS f32x4*)(rtb + e * D + 256 * j + 4 * lane);
                        a0[e] += (v0[j].x * w.x + v0[j].y * w.y) + (v0[j].z * w.z + v0[j].w * w.w);
                        a1[e] += (v1[j].x * w.x + v1[j].y * w.y) + (v1[j].z * w.z + v1[j].w * w.w);
                        a2[e] += (v2[j].x * w.x + v2[j].y * w.y) + (v2[j].z * w.z + v2[j].w * w.w);
                        a3[e] += (v3[j].x * w.x + v3[j].y * w.y) + (v3[j].z * w.z + v3[j].w * w.w); }
#pragma unroll
                for (int e = 0; e < 6; ++e) { a0[e] = wsum64(a0[e]); a1[e] = wsum64(a1[e]); a2[e] = wsum64(a2[e]); a3[e] = wsum64(a3[e]); }
                if (lane == 0) {
#pragma unroll
                    for (int e = 0; e < 6; ++e) { lg[ec * 6 + e] = a0[e]; lg[64 + ec * 6 + e] = a1[e]; lg[128 + ec * 6 + e] = a2[e]; lg[192 + ec * 6 + e] = a3[e]; } }
            }
            LDS_WAIT();
            if (lane < 4 && !dry) { float aa[36];
#pragma unroll
                for (int e = 0; e < 36; ++e) aa[e] = lg[lane * 64 + e];
                route_token(r0 + lane, aa, args.in[26], args.in[28], cnt, ltok, lpair, pairw); }
            LDS_WAIT();
            ln_store16(lane, v0, o16b + (size_t)r0 * D); ln_store16(lane, v1, o16b + (size_t)(r0 + 1) * D);
            ln_store16(lane, v2, o16b + (size_t)(r0 + 2) * D); ln_store16(lane, v3, o16b + (size_t)(r0 + 3) * D);
        }
        if (BOTH(5) && !dry) xcd_barrier(bar); else __syncthreads();
    }
    if (PROBE_K == 5) tk_ = __builtin_amdgcn_s_memrealtime();
    if (PROBE_J == 5) t0_ = __builtin_amdgcn_s_memrealtime();
    if (IN(6)) {
        build_moe_table(F, cnt);
        pg8::Gemm g{H1_16, GUT, 0, 0, D, D}; pg8::MoeOrder<true> S{(const LAS int*)(F.lds + TAB_OFF), ltok, F.vcu, F.G, 4, (size_t)1024 * D * 2, 0};
        pg8::EpiGU E{HID};
        for (int rep_ = 0; rep_ < REP_P6; ++rep_) pg8::gemm_phase<pg8::EpiGU, pg8::MoeOrder<true>, true>(F.lds + RING_OFF, g, S, E, F.wave);
        if (BOTH(6)) xcd_barrier(bar);
    }
    if (PROBE_K == 6) tk_ = __builtin_amdgcn_s_memrealtime();
    if (PROBE_J == 6) t0_ = __builtin_amdgcn_s_memrealtime();
    if (IN(7)) {
        build_moe_table(F, cnt);
        const pg8::Gemm gU{H1_16, GUT, 0, 0, D, D}; const pg8::Gemm gD{HID, DNT, 0, 0, 512, 512};
        const pg8::EpiGU EU{HID}; const pg8::EpiDown ED{FFN16, lpair};
        if (F.vcu < 64) { pg8::MoeOrder<true> S{(const LAS int*)(F.lds + TAB_OFF), ltok, F.vcu, 64, 4, (size_t)1024 * D * 2, 1};
            pg8::gemm_phase<pg8::EpiGU, pg8::MoeOrder<true>, true>(F.lds + RING_OFF, gU, S, EU, F.wave); }
        else { pg8::MoeOrder<false> S{(const LAS int*)(F.lds + TAB_OFF), nullptr, F.vcu - 64, F.G - 64, 8, (size_t)D * 512 * 2, 0};
            pg8::gemm_phase<pg8::EpiDown, pg8::MoeOrder<false>, true>(F.lds + RING_OFF, gD, S, ED, F.wave); }
        xcd_barrier(bar);
        { pg8::MoeOrder<false> S{(const LAS int*)(F.lds + TAB_OFF), nullptr, F.vcu, F.G, 8, (size_t)D * 512 * 2, 1};
          pg8::gemm_phase<pg8::EpiDown, pg8::MoeOrder<false>, true>(F.lds + RING_OFF, gD, S, ED, F.wave); }
        if (BOTH(7)) xcd_barrier(bar);
    }
    if (PROBE_K == 7) tk_ = __builtin_amdgcn_s_memrealtime();
    if (PROBE_J == 7) t0_ = __builtin_amdgcn_s_memrealtime();
    if (IN(8)) for (int rep_ = 0; rep_ < REP_P8; ++rep_) {
        const bool dry = rep_ < REP_P8 - 1;
        float* o32b = dry ? (float*)(ws + WS_GUT) : args.out; f16_t* o16b = dry ? (f16_t*)(ws + WS_GUT + 64 * MiB) : Y16; float* rrs = dry ? (float*)(ws + WS_GUT + 100 * MiB) : ROWRS;
        typedef _Float16 h4_t __attribute__((ext_vector_type(4)));
        const int lane = FLANE;
        for (int m = gw; m < T; m += NGW) {
            f32x4 v[8]; const GAS f32x4* xr = (const GAS f32x4*)(args.out + (size_t)m * D) + lane;
            const GAS h4_t* f0 = (const GAS h4_t*)(FFN16 + (size_t)(2 * m) * D) + lane; const GAS h4_t* f1 = (const GAS h4_t*)(FFN16 + (size_t)(2 * m + 1) * D) + lane;
            const GAS h4_t* pr = (const GAS h4_t*)(PW16 + (size_t)m * D) + lane;
            const float w0 = pairw[2 * m], w1 = pairw[2 * m + 1]; float q = 0.f;
#pragma unroll
            for (int j = 0; j < 8; ++j) v[j] = xr[64 * j];
            ln_norm(lane, v, args.in[23], args.in[24]);
#pragma unroll
            for (int j = 0; j < 8; ++j) { const f32x4 x = v[j]; const h4_t a = f0[64 * j], c = f1[64 * j], pv = pr[64 * j];
                v[j].x = ALPHA * x.x + w0 * (float)a[0] + w1 * (float)c[0]; v[j].y = ALPHA * x.y + w0 * (float)a[1] + w1 * (float)c[1];
                v[j].z = ALPHA * x.z + w0 * (float)a[2] + w1 * (float)c[2]; v[j].w = ALPHA * x.w + w0 * (float)a[3] + w1 * (float)c[3];
                q += ((float)pv[0] * (float)pv[0] + (float)pv[1] * (float)pv[1]) + ((float)pv[2] * (float)pv[2] + (float)pv[3] * (float)pv[3]); }
            ln_regs(lane, v, args.in[32], args.in[33], o32b + (size_t)m * D, o16b + (size_t)m * D);
            q = wave_sum_b(q);
            if (lane == 0) rrs[m] = __builtin_amdgcn_rsqf(q * (1.f / D) + LN_EPS);
        }
        if (BOTH(8) && !dry) xcd_barrier(bar); else __syncthreads();
    }
    if (PROBE_K == 8) tk_ = __builtin_amdgcn_s_memrealtime();
    if (PROBE_J == 8) t0_ = __builtin_amdgcn_s_memrealtime();
    if (IN(9)) {
        pg8::Gemm g{Y16, GateT, T, D, D, D}; pg8::StaticOrder S; S.init(T, D, F.G, (int)blockIdx.x);
        pg8::EpiFinal E{args.out, D, PW16, ROWRS, args.in[35]};
        pg8::gemm_phase<pg8::EpiFinal, pg8::StaticOrder, true>(F.lds + RING_OFF, g, S, E, F.wave);
    }
    if (PROBE_K != -1) {
        if (PROBE_K == 9) tk_ = __builtin_amdgcn_s_memrealtime();
        xcd_barrier(bar);
        if (blockIdx.x == 0 && FTID == 0) args.out[0] += (PROBE_K == -2) ? 100000.f : (float)(tk_ - t0_) * PROBE_SCALE;
    }
#undef IN
#undef BOTH
}

extern "C" void kernel_launch(void* const* d_in, const int* in_sizes, int n_in, void* d_out, int out_size, void* d_ws, size_t ws_size, hipStream_t stream) {
    static int grid = 0;
    if (grid == 0) {
        if (ws_size < WS_END2 || n_in != 37 || out_size != T * D) { fprintf(stderr, "kernel_launch: bad ws/n_in/out: %zu %d %d\n", ws_size, n_in, out_size); grid = -1; return; }
        int dev = 0, cus = 0;
        if (hipGetDevice(&dev) != hipSuccess || hipDeviceGetAttribute(&cus, hipDeviceAttributeMultiprocessorCount, dev) != hipSuccess) { grid = -1; return; }
        if (hipFuncSetAttribute((const void*)mega_fwd, hipFuncAttributeMaxDynamicSharedMemorySize, LDS_BYTES) != hipSuccess) { fprintf(stderr, "kernel_launch: hipFuncSetAttribute failed\n"); grid = -1; return; }
        if (cus != 256) { fprintf(stderr, "kernel_launch: built for a 256-CU device, found %d\n", cus); grid = -1; return; }
        grid = cus;
    }
    if (grid < 0) return;
    (void)hipMemsetAsync(d_ws, 0, CTL_ZERO_BYTES, stream);
    Args a{}; for (int i = 0; i < 37; ++i) a.in[i] = (const float*)d_in[i]; a.out = (float*)d_out; a.ws = (unsigned char*)d_ws; a.ph_lo = 0; a.ph_hi = 10; a.li = 0;
    hipLaunchKernelGGL(mega_fwd, dim3(grid), dim3(NWAVES * 64), LDS_BYTES, stream, a);
}
```

```cpp
#include <hip/hip_runtime.h>
#include <cstdio>
#include <cstdint>
#include <cmath>

constexpr int NB = 4, S = 2048, D = 2048, T = NB * S;
constexpr int NPROJ = 6432;
constexpr int RWK = 1024;
constexpr int COL_Q = 0, COL_K = 1024, COL_V = 2048, COL_RW = 3072;
constexpr int NH = 8, NRH = 16;
constexpr int NE = 32;
constexpr float LN_EPS = 1e-5f;
constexpr float ALPHA = 1.189207115002721f;
constexpr float LAMBDA_INIT = 0.2f;

constexpr size_t MiB = 1u << 20;
constexpr size_t WS_CNT = 0;
constexpr size_t WS_LTOK = 1 * MiB;
constexpr size_t WS_LPAIR = 2 * MiB;
constexpr size_t WS_PAIRW = 3 * MiB;
constexpr size_t WS_RT = 3 * MiB + 128 * 1024;
constexpr size_t WS_LAM = 3 * MiB + 512 * 1024;
constexpr size_t WS_BIAS = 3 * MiB + 512 * 1024 + 1024;
constexpr size_t WS_ROWRS = 3 * MiB + 768 * 1024;
constexpr size_t WS_ROWST = 3 * MiB + 832 * 1024;
constexpr size_t WS_WINT = 4 * MiB;
constexpr size_t WS_WOUTT = 30 * MiB;
constexpr size_t WS_GATET = 38 * MiB;
constexpr size_t WS_PLET = 46 * MiB;
constexpr size_t WS_P16 = 47 * MiB;
constexpr size_t WS_W2T = 51 * MiB;
constexpr size_t WS_A2T = 51 * MiB + 128 * 1024;
constexpr size_t WS_G2T = 51 * MiB + 256 * 1024;
constexpr size_t WS_CHK = 52 * MiB;
constexpr size_t WS_BONUS = 148 * MiB;
constexpr size_t WS_LSLAB = 150 * MiB;
constexpr size_t WS_GUT = 348 * MiB;
constexpr size_t WS_DNT = 150 * MiB;
constexpr size_t WS_PROJ16 = 244 * MiB;
constexpr size_t WS_FFN16 = 52 * MiB;
constexpr size_t WS_HID = 116 * MiB;
constexpr size_t WS_DECAY = 348 * MiB;
constexpr size_t WS_KMOD = 380 * MiB;
constexpr size_t WS_A16 = 396 * MiB;
constexpr size_t WS_B16 = 412 * MiB;
constexpr size_t WS_G16 = 214 * MiB;
constexpr size_t WS_H16 = 444 * MiB;
constexpr size_t WS_H1_16 = 244 * MiB;
constexpr size_t WS_Y16 = 476 * MiB;
constexpr size_t WS_PW16 = 508 * MiB;
constexpr size_t WS_END2 = 540 * MiB;

namespace pg8 {
#define PG8_LAS __attribute__((address_space(3)))
typedef unsigned short f16_t;
typedef _Float16 f16x8 __attribute__((ext_vector_type(8)));
typedef float f32x4 __attribute__((ext_vector_type(4)));
typedef unsigned u32x4 __attribute__((ext_vector_type(4)));
constexpr int BM = 256, BK = 64, HALF = 128, HTB = HALF * BK * 2  , STAGE_BYTES = 8 * HTB, NXCD = 8, WGM = 8;

__host__ __device__ __forceinline__ int lds_byte(int r, int c) { const int st = (r >> 4) * 2 + (c >> 5), rr = r & 15, cc = c & 31, ob = rr * 64 + cc * 2; return st * 1024 + (ob ^ (((ob >> 9) & 1) << 5)); }
__host__ __device__ __forceinline__ void stage_rc(int b, int& R, int& C) { const int st = b / 1024, sb = b % 1024, swz = sb ^ (((sb >> 9) & 1) << 5); R = (st >> 1) * 16 + swz / 64; C = (st & 1) * 32 + (swz % 64) / 2; }
__host__ __device__ __forceinline__ int perm32(int rho) { const int n = rho >> 4, i = rho & 15; return 8 * (i >> 2) + 4 * n + (i & 3); }

__device__ __forceinline__ int lane_id() { int l; asm volatile("v_mbcnt_lo_u32_b32 %0, -1, 0\n\tv_mbcnt_hi_u32_b32 %0, -1, %0" : "=v"(l)); return l; }
struct Unit { int pm, pn, e, rb, cnt; };
struct Gemm { const f16_t* A; const f16_t* Bt; int M, N, K, ld; };

struct StaticOrder {
    int nM, nN, nwg, G, c;
    __host__ __device__ void init(int M, int N, int G_, int c_) { nM = M / BM; nN = N / BM; nwg = nM * nN; G = G_; c = c_; }
    __host__ __device__ bool next(int i, Unit& u) const {
        const long L = (long)i * G + c; if (L >= nwg) return false;
        int wgid = (int)L; { const int q = nwg / NXCD, r = nwg % NXCD, xcd = wgid % NXCD, off = wgid / NXCD; wgid = (xcd < r ? xcd * (q + 1) : r * (q + 1) + (xcd - r) * q) + off; }
        const int nig = WGM * nN, gid = wgid / nig, fm = gid * WGM, gsz = (nM - fm) < WGM ? (nM - fm) : WGM;
        u.pm = fm + ((wgid % nig) % gsz); u.pn = (wgid % nig) / gsz; return true;
    }
    __device__ __forceinline__ void a_ready(const Unit&) const {}
    __device__ __forceinline__ void done(const Unit&) const {}
    __device__ __forceinline__ const char* a_base(const Gemm& g, const Unit& u) const { return (const char*)g.A + (size_t)u.pm * ((size_t)BM * g.ld * 2); }
    __device__ __forceinline__ const char* b_base(const Gemm& g, const Unit& u) const { return (const char*)g.Bt + (size_t)u.pn * ((size_t)BM * g.ld * 2); }
    __device__ __forceinline__ void a_voff(const Gemm& g, const Unit&, int tid, unsigned (&va)[2][2]) const {
#pragma unroll
        for (int i = 0; i < 2; ++i) { int R, C; stage_rc(tid * 16 + i * 8192, R, C); va[0][i] = (unsigned)(R * g.ld + C) * 2u; va[1][i] = va[0][i] + (unsigned)(HALF * g.ld * 2); }
    }
};
struct SplitKOrder {
    int nM, nN, nks, G, c;
    __device__ __forceinline__ bool next(int i, Unit& u) const { const int L = i * G + c; if (L >= nM * nN * nks) return false; u.e = L / (nM * nN); const int rem = L % (nM * nN); u.pn = rem / nM; u.pm = rem % nM; u.rb = 0; u.cnt = 0; return true; }
    __device__ __forceinline__ void a_ready(const Unit&) const {}
    __device__ __forceinline__ void done(const Unit&) const {}
    __device__ __forceinline__ const char* a_base(const Gemm& g, const Unit& u) const { return (const char*)g.A + (size_t)u.pm * ((size_t)BM * g.ld * 2) + (size_t)u.e * g.K * 2; }
    __device__ __forceinline__ const char* b_base(const Gemm& g, const Unit& u) const { return (const char*)g.Bt + (size_t)u.pn * ((size_t)BM * g.ld * 2) + (size_t)u.e * g.K * 2; }
    __device__ __forceinline__ void a_voff(const Gemm& g, const Unit&, int tid, unsigned (&va)[2][2]) const {
#pragma unroll
        for (int i = 0; i < 2; ++i) { int R, C; stage_rc(tid * 16 + i * 8192, R, C); va[0][i] = (unsigned)(R * g.ld + C) * 2u; va[1][i] = va[0][i] + (unsigned)(HALF * g.ld * 2); }
    }
};
template <bool GATHER> struct MoeOrder {
    const PG8_LAS int* tab; const int* list; int vcu, G, ntn; size_t estride; int cls;
    __device__ __forceinline__ bool next(int i, Unit& u) const {
        const int L = vcu + i * G; const int base = cls ? 98 : 65; const int tot = tab[base + 32] * ntn; if (L >= tot) return false;
        int e = 0; while (tab[base + 1 + e] * ntn <= L) ++e;
        const int nbk = tab[base + 1 + e] - tab[base + e], q = L - tab[base + e] * ntn; const int rb = q % nbk + (cls ? 2 : 0);
        u.e = __builtin_amdgcn_readfirstlane(e); u.pn = __builtin_amdgcn_readfirstlane(q / nbk); u.rb = __builtin_amdgcn_readfirstlane(rb);
        u.pm = __builtin_amdgcn_readfirstlane(tab[32 + e] + rb); u.cnt = __builtin_amdgcn_readfirstlane(tab[e]); return true;
    }
    __device__ __forceinline__ void a_ready(const Unit&) const {}
    __device__ __forceinline__ void done(const Unit&) const {}
    __device__ __forceinline__ const char* a_base(const Gemm& g, const Unit& u) const { return GATHER ? (const char*)g.A : (const char*)g.A + (size_t)u.pm * ((size_t)BM * g.ld * 2); }
    __device__ __forceinline__ const char* b_base(const Gemm& g, const Unit& u) const { return (const char*)g.Bt + (size_t)u.e * estride + (size_t)u.pn * ((size_t)BM * g.ld * 2); }
    __device__ __forceinline__ void a_voff(const Gemm& g, const Unit& u, int tid, unsigned (&va)[2][2]) const {
#pragma unroll
        for (int i = 0; i < 2; ++i) { int R, C; stage_rc(tid * 16 + i * 8192, R, C);
            if (GATHER) {
#pragma unroll
                for (int h = 0; h < 2; ++h) { int idx = u.rb * BM + h * HALF + R; idx = idx < u.cnt ? idx : u.cnt - 1; const int tok = list[u.e * 8192 + idx]; va[h][i] = (unsigned)(tok * g.ld + C) * 2u; }
            } else { va[0][i] = (unsigned)(R * g.ld + C) * 2u; va[1][i] = va[0][i] + (unsigned)(HALF * g.ld * 2); } }
    }
};


typedef _Float16 h2_t __attribute__((ext_vector_type(2)));
__device__ __forceinline__ unsigned cvt_pk_f16(float lo, float hi) { h2_t v = {(_Float16)lo, (_Float16)hi}; return __builtin_bit_cast(unsigned, v); }
struct EpiF16 {
    static constexpr bool PERM = true, AFTER_DRAIN = false;
    f16_t* O; int ldc; int ntile0; float scale0;
    __device__ __forceinline__ void operator()(const f32x4 (&acc)[2][2][4][2], const Unit& u, int wr, int wc, int fr, int fq) const {
        const int row0 = u.pm * BM + wr * 64 + fr; const int col0 = u.pn * BM + wc * 32 + 8 * fq;
        const float sc = (u.pn < ntile0) ? scale0 : 1.f;
#pragma unroll
        for (int ai = 0; ai < 2; ++ai)
#pragma unroll
            for (int m = 0; m < 4; ++m) { f16_t* rowp = O + (size_t)(row0 + ai * HALF + m * 16) * ldc + col0;
#pragma unroll
                for (int bj = 0; bj < 2; ++bj) { f32x4 v0 = acc[ai][bj][m][0] * sc, v1 = acc[ai][bj][m][1] * sc;
                    u32x4 w; w.x = cvt_pk_f16(v0[0], v0[1]); w.y = cvt_pk_f16(v0[2], v0[3]); w.z = cvt_pk_f16(v1[0], v1[1]); w.w = cvt_pk_f16(v1[2], v1[3]);
                    *(u32x4*)(rowp + bj * HALF) = w; } }
    }
};


struct EpiSlab {
    static constexpr bool PERM = true, AFTER_DRAIN = false;
    f16_t* O; int ldc; size_t slab;
    __device__ __forceinline__ void operator()(const f32x4 (&acc)[2][2][4][2], const Unit& u, int wr, int wc, int fr, int fq) const {
        const int row0 = u.pm * BM + wr * 64 + fr; const int col0 = u.pn * BM + wc * 32 + 8 * fq; f16_t* Ob = O + (size_t)u.e * slab;
#pragma unroll
        for (int ai = 0; ai < 2; ++ai)
#pragma unroll
            for (int m = 0; m < 4; ++m) { f16_t* rowp = Ob + (size_t)(row0 + ai * HALF + m * 16) * ldc + col0;
#pragma unroll
                for (int bj = 0; bj < 2; ++bj) { const f32x4 v0 = acc[ai][bj][m][0], v1 = acc[ai][bj][m][1];
                    u32x4 w; w.x = cvt_pk_f16(v0[0], v0[1]); w.y = cvt_pk_f16(v0[2], v0[3]); w.z = cvt_pk_f16(v1[0], v1[1]); w.w = cvt_pk_f16(v1[2], v1[3]);
                    *(u32x4*)(rowp + bj * HALF) = w; } }
    }
};
struct EpiResF32 {
    static constexpr bool PERM = false, AFTER_DRAIN = false;
    float* io; int ldc; float alpha;
    __device__ __forceinline__ void operator()(const f32x4 (&acc)[2][2][4][2], const Unit& u, int wr, int wc, int fr, int fq) const {
        const int row0 = u.pm * BM + wr * 64 + fr; const int col0 = u.pn * BM + wc * 32 + 4 * fq;
#pragma unroll
        for (int ai = 0; ai < 2; ++ai)
#pragma unroll
            for (int m = 0; m < 4; ++m) { float* rowp = io + (size_t)(row0 + ai * HALF + m * 16) * ldc + col0;
#pragma unroll
                for (int bj = 0; bj < 2; ++bj)
#pragma unroll
                    for (int n = 0; n < 2; ++n) { f32x4* p = (f32x4*)(rowp + bj * HALF + n * 16); const f32x4 r = *p; *p = r * alpha + acc[ai][bj][m][n]; } }
    }
};
struct EpiResLN {
    static constexpr bool PERM = false, AFTER_DRAIN = false;
    const float* x; float* out; int ldc; float alpha; const float2* st; const float* g; const float* b;
    __device__ __forceinline__ void operator()(const f32x4 (&acc)[2][2][4][2], const Unit& u, int wr, int wc, int fr, int fq) const {
        const int row0 = u.pm * BM + wr * 64 + fr; const int col0 = u.pn * BM + wc * 32 + 4 * fq;
        f32x4 gg[2][2], bb[2][2];
#pragma unroll
        for (int bj = 0; bj < 2; ++bj)
#pragma unroll
            for (int n = 0; n < 2; ++n) { gg[bj][n] = *(const f32x4*)(g + col0 + bj * HALF + n * 16); bb[bj][n] = *(const f32x4*)(b + col0 + bj * HALF + n * 16); }
#pragma unroll
        for (int ai = 0; ai < 2; ++ai)
#pragma unroll
            for (int m = 0; m < 4; ++m) { const int row = row0 + ai * HALF + m * 16; const float2 ms = st[row];
                const float* xp = x + (size_t)row * ldc + col0; float* op = out + (size_t)row * ldc + col0;
#pragma unroll
                for (int bj = 0; bj < 2; ++bj)
#pragma unroll
                    for (int n = 0; n < 2; ++n) { const f32x4 r = *(const f32x4*)(xp + bj * HALF + n * 16);
                        const f32x4 h = (r - ms.x) * ms.y * gg[bj][n] + bb[bj][n]; *(f32x4*)(op + bj * HALF + n * 16) = h * alpha + acc[ai][bj][m][n]; } }
    }
};
struct EpiFinal {
    static constexpr bool PERM = false, AFTER_DRAIN = false;
    float* out; int ldc; const f16_t* h2; const f16_t* pw; const float* rowrs; const float* g;
    __device__ __forceinline__ void operator()(const f32x4 (&acc)[2][2][4][2], const Unit& u, int wr, int wc, int fr, int fq) const {
        typedef _Float16 h4_t __attribute__((ext_vector_type(4)));
        const int row0 = u.pm * BM + wr * 64 + fr; const int col0 = u.pn * BM + wc * 32 + 4 * fq;
#pragma unroll
        for (int ai = 0; ai < 2; ++ai)
#pragma unroll
            for (int m = 0; m < 4; ++m) { const int row = row0 + ai * HALF + m * 16; const size_t off = (size_t)row * ldc + col0;
                const float rs = rowrs[row];
#pragma unroll
                for (int bj = 0; bj < 2; ++bj)
#pragma unroll
                    for (int n = 0; n < 2; ++n) { const h4_t hv = *(const h4_t*)(h2 + off + bj * HALF + n * 16); const h4_t pv = *(const h4_t*)(pw + off + bj * HALF + n * 16);
                        const f32x4 gv = *(const f32x4*)(g + col0 + bj * HALF + n * 16);
                        const f32x4 a = acc[ai][bj][m][n]; f32x4 o;
#pragma unroll
                        for (int c = 0; c < 4; ++c) o[c] = (float)hv[c] + (1.f / (1.f + __expf(-a[c]))) * ((float)pv[c] * rs) * gv[c];
                        *(f32x4*)(out + off + bj * HALF + n * 16) = o; }
                asm volatile("" ::: "memory"); }
    }
};

struct EpiGU {
    static constexpr bool PERM = true, AFTER_DRAIN = false;
    f16_t* O;
    __device__ __forceinline__ void operator()(const f32x4 (&acc)[2][2][4][2], const Unit& u, int wr, int wc, int fr, int fq) const {
        const int row0 = u.pm * BM + wr * 64 + fr; const int col0 = u.pn * HALF + wc * 32 + 8 * fq;
#pragma unroll
        for (int ai = 0; ai < 2; ++ai)
#pragma unroll
            for (int m = 0; m < 4; ++m) { f16_t* rowp = O + (size_t)(row0 + ai * HALF + m * 16) * 512 + col0; float o[8];
#pragma unroll
                for (int n = 0; n < 2; ++n)
#pragma unroll
                    for (int c = 0; c < 4; ++c) { const float gt = acc[ai][0][m][n][c], up = acc[ai][1][m][n][c]; o[n * 4 + c] = gt / (1.f + __expf(-gt)) * up; }
                u32x4 w; w.x = cvt_pk_f16(o[0], o[1]); w.y = cvt_pk_f16(o[2], o[3]); w.z = cvt_pk_f16(o[4], o[5]); w.w = cvt_pk_f16(o[6], o[7]);
                *(u32x4*)rowp = w; }
    }
};
struct EpiDown {
    static constexpr bool PERM = true, AFTER_DRAIN = false;
    f16_t* O; const int* lpair;
    __device__ __forceinline__ void operator()(const f32x4 (&acc)[2][2][4][2], const Unit& u, int wr, int wc, int fr, int fq) const {
        const int r0 = u.rb * BM + wr * 64 + fr; const int col0 = u.pn * BM + wc * 32 + 8 * fq;
#pragma unroll
        for (int ai = 0; ai < 2; ++ai)
#pragma unroll
            for (int m = 0; m < 4; ++m) { const int r = r0 + ai * HALF + m * 16;
                if (r < u.cnt) { const int pair = lpair[u.e * 8192 + r]; f16_t* rowp = O + (size_t)pair * 2048 + col0;
#pragma unroll
                    for (int bj = 0; bj < 2; ++bj) { const f32x4 v0 = acc[ai][bj][m][0], v1 = acc[ai][bj][m][1];
                        u32x4 w; w.x = cvt_pk_f16(v0[0], v0[1]); w.y = cvt_pk_f16(v0[2], v0[3]); w.z = cvt_pk_f16(v1[0], v1[1]); w.w = cvt_pk_f16(v1[2], v1[3]);
                        *(u32x4*)(rowp + bj * HALF) = w; } } }
    }
};
template <class Epi, class Sched, bool ALIGN_EPI = false, bool SP2 = true>
__device__ __forceinline__ void gemm_phase(PG8_LAS unsigned char* lds, const Gemm g, const Sched& S, const Epi& E, const int wid) {
    static_assert(SP2, "only the SP2 K-loop is kept in this file");
    const int lane = lane_id(), tid = wid * 64 + lane, wr = wid >> 2, wc = wid & 3, fr = lane & 15, fq = lane >> 4;
    const int K = g.ld, nt = g.K / BK;
    unsigned voffB[2];
#pragma unroll
    for (int i = 0; i < 2; ++i) { int R, C; stage_rc(tid * 16 + i * 8192, R, C); const int Rb = Epi::PERM ? ((R & ~31) + perm32(R & 31)) : R;
        voffB[i] = (unsigned)(Rb * K + C) * 2u; }
    const size_t kstep = (size_t)(BK * 2);
    const size_t hstep = (size_t)HALF * K * 2;
    const unsigned ldsw = (unsigned)wid * 1024u;
    const int aoff = lds_byte(wr * 64 + fr, fq * 8), boff = lds_byte(wc * 32 + fr, fq * 8);
#define PG8_SA(b, h) (((b) * 2 + (h)) * HTB)
#define PG8_SB(b, h) ((4 + (b) * 2 + (h)) * HTB)
#define PG8_STAGE(bufoff, gbase, voff) do { _Pragma("unroll") for (int _i = 0; _i < 2; ++_i) \
        __builtin_amdgcn_global_load_lds((const unsigned*)((const char*)(gbase) + (voff)[_i]), (PG8_LAS unsigned*)(lds + (bufoff) + ldsw + _i * 8192), 16, 0, 0); } while (0)
#define PG8_LDA(dst, b, h) do { _Pragma("unroll") for (int m = 0; m < 4; ++m) _Pragma("unroll") for (int k = 0; k < 2; ++k) dst[m][k] = *(const PG8_LAS f16x8*)(lds + PG8_SA(b, h) + aoff + m * 2048 + k * 1024); } while (0)
#define PG8_LDB(dst, b, h) do { _Pragma("unroll") for (int n = 0; n < 2; ++n) _Pragma("unroll") for (int k = 0; k < 2; ++k) dst[n][k] = *(const PG8_LAS f16x8*)(lds + PG8_SB(b, h) + boff + n * 2048 + k * 1024); } while (0)
#define PG8_MMA(ai, bj, At, Bt) do { __builtin_amdgcn_s_setprio(1); _Pragma("unroll") for (int m = 0; m < 4; ++m) _Pragma("unroll") for (int n = 0; n < 2; ++n) _Pragma("unroll") for (int k = 0; k < 2; ++k) \
        acc[ai][bj][m][n] = __builtin_amdgcn_mfma_f32_16x16x32_f16(Bt[n][k], At[m][k], acc[ai][bj][m][n], 0, 0, 0); __builtin_amdgcn_s_setprio(0); } while (0)
#define PG8_WAIT_V(n) asm volatile("s_waitcnt vmcnt(" #n ")" ::: "memory")
#define PG8_WAIT_L(n) asm volatile("s_waitcnt lgkmcnt(" #n ")" ::: "memory")
#define PG8_BAR __builtin_amdgcn_s_barrier()
#define PG8_SCHED __builtin_amdgcn_sched_barrier(0)
    Unit cur, nxt; int ui = 0;
    if (!S.next(0, cur)) return;
    f32x4 acc[2][2][4][2];
#pragma unroll
    for (int a = 0; a < 2; ++a)
#pragma unroll
        for (int b = 0; b < 2; ++b)
#pragma unroll
            for (int m = 0; m < 4; ++m)
#pragma unroll
                for (int n = 0; n < 2; ++n) acc[a][b][m][n] = (f32x4){0.f, 0.f, 0.f, 0.f};
    f16x8 At[4][2], B0[2][2], B1[2][2];
    const char* cA = S.a_base(g, cur); const char* cB = S.b_base(g, cur);
    unsigned vaC[2][2];
    S.a_voff(g, cur, tid, vaC);
    S.a_ready(cur);
    PG8_STAGE(PG8_SB(0, 0), cB, voffB); PG8_STAGE(PG8_SB(0, 1), cB + hstep, voffB); PG8_STAGE(PG8_SA(0, 0), cA, vaC[0]); PG8_STAGE(PG8_SA(0, 1), cA, vaC[1]);
    if (wr == 1) PG8_BAR;
    PG8_WAIT_V(2); PG8_BAR;
    PG8_STAGE(PG8_SB(1, 0), cB + kstep, voffB); PG8_STAGE(PG8_SA(1, 0), cA + kstep, vaC[0]); PG8_STAGE(PG8_SB(1, 1), cB + hstep + kstep, voffB);
    PG8_WAIT_V(6); PG8_BAR;
    for (;;) {
        const bool has_next = S.next(ui + 1, nxt);
        const char* nA = has_next ? S.a_base(g, nxt) : cA; const char* nB = has_next ? S.b_base(g, nxt) : cB;
        for (int t = 0; t < nt; t += 2) {
            const bool last = (t == nt - 2);

            const char* a1 = cA + (size_t)(t + 1) * kstep;
            const char* a2 = last ? nA : cA + (size_t)(t + 2) * kstep; const char* b2 = last ? nB : cB + (size_t)(t + 2) * kstep;
            const char* a3 = a2 + kstep; const char* b3 = b2 + kstep;
            if (last && has_next) S.a_ready(nxt);
            PG8_LDB(B0, 0, 0); PG8_LDB(B1, 0, 1); PG8_SCHED; PG8_LDA(At, 0, 0); PG8_STAGE(PG8_SA(1, 1), a1, vaC[1]);
            if (last && has_next) S.a_voff(g, nxt, wid * 64 + lane_id(), vaC);
            PG8_WAIT_V(8); PG8_WAIT_L(0); PG8_BAR; PG8_MMA(0, 0, At, B0); PG8_MMA(0, 1, At, B1); PG8_BAR; PG8_SCHED;
            PG8_LDA(At, 0, 1); PG8_STAGE(PG8_SB(0, 0), b2, voffB); PG8_STAGE(PG8_SB(0, 1), b2 + hstep, voffB); PG8_STAGE(PG8_SA(0, 0), a2, vaC[0]);
            PG8_WAIT_V(8); PG8_WAIT_L(0); PG8_BAR; PG8_MMA(1, 0, At, B0); PG8_MMA(1, 1, At, B1); PG8_BAR; PG8_SCHED;
            PG8_LDB(B0, 1, 0); PG8_LDB(B1, 1, 1); PG8_SCHED; PG8_LDA(At, 1, 0); PG8_STAGE(PG8_SA(0, 1), a2, vaC[1]);
            PG8_WAIT_V(8); PG8_WAIT_L(0); PG8_BAR; PG8_MMA(0, 0, At, B0); PG8_MMA(0, 1, At, B1); PG8_BAR; PG8_SCHED;
            PG8_LDA(At, 1, 1); PG8_STAGE(PG8_SB(1, 0), b3, voffB); PG8_STAGE(PG8_SB(1, 1), b3 + hstep, voffB); PG8_STAGE(PG8_SA(1, 0), a3, vaC[0]);
            PG8_WAIT_V(8); PG8_WAIT_L(0); PG8_BAR; PG8_MMA(1, 0, At, B0); PG8_MMA(1, 1, At, B1); PG8_BAR; PG8_SCHED;
        }
        if constexpr (ALIGN_EPI) { if (wr == 0) PG8_BAR; }
        { const int l2 = lane_id(); E(acc, cur, wr, wc, l2 & 15, l2 >> 4); } S.done(cur);
        if (!has_next) break;
#pragma unroll
        for (int a = 0; a < 2; ++a)
#pragma unroll
            for (int b = 0; b < 2; ++b)
#pragma unroll
                for (int m = 0; m < 4; ++m)
#pragma unroll
                    for (int n = 0; n < 2; ++n) acc[a][b][m][n] = (f32x4){0.f, 0.f, 0.f, 0.f};
        cur = nxt; cA = nA; cB = nB; ++ui;
        if constexpr (ALIGN_EPI) { if (wr == 1) PG8_BAR; }
    }
    PG8_WAIT_V(0);
    if constexpr (!ALIGN_EPI) { if (wr == 0) PG8_BAR; }
    PG8_BAR;
#undef PG8_SA
#undef PG8_SB
#undef PG8_STAGE
#undef PG8_LDA
#undef PG8_LDB
#undef PG8_MMA
#undef PG8_WAIT_V
#undef PG8_WAIT_L
#undef PG8_BAR
#undef PG8_SCHED
}
}

constexpr int PN = 6656;
namespace att {
#define ALAS __attribute__((address_space(3)))
typedef _Float16 f16x8 __attribute__((ext_vector_type(8)));
typedef float f32x16 __attribute__((ext_vector_type(16)));
typedef short v4i16_t __attribute__((ext_vector_type(4)));
typedef unsigned u32x4 __attribute__((ext_vector_type(4)));
constexpr int SLOT = 16384, L_K = 0, L_V = 3 * SLOT, L_SCR = 6 * SLOT, L_TAB = L_SCR + 2048, L_END = L_TAB + 1024;
constexpr int L_XB = 0, L_STG = 65536;
constexpr float LOG2E = 1.4426950408889634f;
constexpr float C2 = 0.125f * LOG2E;
__device__ __forceinline__ int crow(int r, int hi) { return (r & 3) + 8 * (r >> 2) + 4 * hi; }
__device__ __forceinline__ void glds16(const void* g, ALAS unsigned char* l) { __builtin_amdgcn_global_load_lds((const unsigned*)g, (ALAS unsigned*)l, 16, 0, 0); }
__device__ __forceinline__ float xhalf(float v, int hi) { auto rr = __builtin_amdgcn_permlane32_swap(__float_as_uint(v), __float_as_uint(v), false, false); return hi ? __uint_as_float(rr[0]) : __uint_as_float(rr[1]); }
__device__ __forceinline__ unsigned pkh(float lo, float hi) { typedef _Float16 h2 __attribute__((ext_vector_type(2))); h2 v = {(_Float16)lo, (_Float16)hi}; return __builtin_bit_cast(unsigned, v); }
__device__ __forceinline__ v4i16_t vtr(const ALAS unsigned char* p) { return __builtin_amdgcn_ds_read_tr16_b64_v4i16((ALAS v4i16_t*)p); }

template <int THR>
__device__ __forceinline__ void attn_unit(ALAS unsigned char* lds, const int wave, const int b, const int h, const int qb, const unsigned short* PROJ, unsigned short* Y,
                                          const float* biasG, const float lam, const float* subln_g) {
    const int lane = pg8::lane_id(), r32 = lane & 31, hi = lane >> 5;
    const int c = wave >> 2, w4 = wave & 3;
    const int q0 = qb * 128, qw0 = q0 + 32 * w4, q = qw0 + r32;
    const size_t rowbase = (size_t)b * S;
    { ALAS float* tabL = (ALAS float*)(lds + L_TAB); const int tid = wave * 64 + lane; if (tid < 129) tabL[tid] = biasG[tid] * LOG2E; }
    f16x8 qf[4];
    { const unsigned short* Qp = PROJ + (rowbase + q) * PN + h * 128 + c * 64 + hi * 8;
#pragma unroll
      for (int d0 = 0; d0 < 4; ++d0) qf[d0] = *(const f16x8*)(Qp + d0 * 16); }
    const int krow0 = 8 * wave + (lane >> 4), krow1 = krow0 + 4;
    const unsigned short* ksrc0 = PROJ + (rowbase + krow0) * PN + 1024 + h * 128 + (((lane & 15) ^ (krow0 & 15)) * 8);
    const unsigned short* ksrc1 = PROJ + (rowbase + krow1) * PN + 1024 + h * 128 + (((lane & 15) ^ (krow1 & 15)) * 8);
    const unsigned short* vsrc0 = PROJ + (rowbase + 16 * ((2 * wave) & 3) + (lane >> 2)) * PN + 2048 + h * 128 + 32 * ((2 * wave) >> 2) + (lane & 3) * 8;
    ALAS unsigned char* kdst = lds + L_K + (2 * wave) * 1024; ALAS unsigned char* vdst = lds + L_V + (2 * wave) * 1024;
#define ATT_ISSUE(t, slot) do { const size_t go_ = (size_t)(t) * 64 * PN; \
        glds16(ksrc0 + go_, kdst + (slot) * SLOT); glds16(ksrc1 + go_, kdst + (slot) * SLOT + 1024); \
        glds16(vsrc0 + go_, vdst + (slot) * SLOT); glds16(vsrc0 + go_ + (size_t)16 * PN, vdst + (slot) * SLOT + 1024); } while (0)
    const int NT = (q0 + 128) / 64;
    ATT_ISSUE(0, 0); ATT_ISSUE(1, 1);
    ALAS float* wsf = (ALAS float*)(lds + L_SCR) + wave * 64;
    const ALAS float* tabL = (const ALAS float*)(lds + L_TAB);
    const float bfar = biasG[128] * LOG2E;
    float mhat = 0.f, l = 0.f;
    f32x16 o[4];
#pragma unroll
    for (int d = 0; d < 4; ++d)
#pragma unroll
        for (int r = 0; r < 16; ++r) o[d][r] = 0.f;
    f32x16 negm;
#pragma unroll
    for (int r = 0; r < 16; ++r) negm[r] = bfar;
    int slot = 0;
    for (int t = 0; t < NT; ++t) {
        if (t + 1 < NT) asm volatile("s_waitcnt vmcnt(4)" ::: "memory"); else asm volatile("s_waitcnt vmcnt(0)" ::: "memory");
        __builtin_amdgcn_s_barrier();
        asm volatile("" ::: "memory");
        if (t + 2 < NT) { const int s2 = slot == 0 ? 2 : slot - 1; ATT_ISSUE(t + 2, s2); }
        const int k0 = t * 64;
        if (k0 <= qw0 + 31) {
            const ALAS unsigned char* Ks = lds + L_K + slot * SLOT + r32 * 256;
            const int kx = r32 & 15, kc0 = 8 * c + hi;
            const int ko[4] = {((kc0 + 0) ^ kx) << 4, ((kc0 + 2) ^ kx) << 4, ((kc0 + 4) ^ kx) << 4, ((kc0 + 6) ^ kx) << 4};
            const ALAS unsigned char* Vs = lds + L_V + slot * SLOT + (4 * hi + ((lane & 15) >> 2)) * 64 + ((lane >> 4) & 1) * 32 + (lane & 3) * 8;
            f32x16 p0, p1;
            const bool nearb = (k0 + 63 + 128 > qw0);
            if (nearb) {
                f32x16 c0, c1;
#pragma unroll
                for (int r = 0; r < 16; ++r) { int rel = q - (k0 + crow(r, hi)); int i0 = rel < 0 ? 0 : (rel > 128 ? 128 : rel); int rel1 = rel - 32; int i1 = rel1 < 0 ? 0 : (rel1 > 128 ? 128 : rel1);
                    c0[r] = tabL[i0] - mhat; c1[r] = tabL[i1] - mhat; }
#pragma unroll
                for (int d0 = 0; d0 < 4; ++d0) { const f16x8 a0 = *(const ALAS f16x8*)(Ks + ko[d0]), a1 = *(const ALAS f16x8*)(Ks + ko[d0] + 8192);
                    p0 = __builtin_amdgcn_mfma_f32_32x32x16_f16(a0, qf[d0], d0 == 0 ? c0 : p0, 0, 0, 0); p1 = __builtin_amdgcn_mfma_f32_32x32x16_f16(a1, qf[d0], d0 == 0 ? c1 : p1, 0, 0, 0); }
                if (k0 + 63 > qw0) {
#pragma unroll
                    for (int r = 0; r < 16; ++r) { const int kv = k0 + crow(r, hi); if (kv > q) p0[r] = -INFINITY; if (kv + 32 > q) p1[r] = -INFINITY; }
                }
            } else {
#pragma unroll
                for (int d0 = 0; d0 < 4; ++d0) { const f16x8 a0 = *(const ALAS f16x8*)(Ks + ko[d0]), a1 = *(const ALAS f16x8*)(Ks + ko[d0] + 8192);
                    p0 = __builtin_amdgcn_mfma_f32_32x32x16_f16(a0, qf[d0], d0 == 0 ? negm : p0, 0, 0, 0); p1 = __builtin_amdgcn_mfma_f32_32x32x16_f16(a1, qf[d0], d0 == 0 ? negm : p1, 0, 0, 0); }
            }
            float rm = fmaxf(p0[0], p1[0]);
#pragma unroll
            for (int r = 1; r < 16; ++r) rm = fmaxf(rm, fmaxf(p0[r], p1[r]));
            rm = fmaxf(rm, xhalf(rm, hi));
            const bool first = (t == 0);
            if (first || __any(rm > (float)THR)) {
                const float dl = first ? rm : fmaxf(rm, 0.f);
                mhat += dl;
#pragma unroll
                for (int r = 0; r < 16; ++r) { p0[r] -= dl; p1[r] -= dl; }
#pragma unroll
                for (int r = 0; r < 16; ++r) negm[r] = bfar - mhat;
                if (!first) {
                    const float f = __builtin_amdgcn_exp2f(-dl); l *= f;
                    if (hi == 0) wsf[r32] = f;
                    asm volatile("s_waitcnt lgkmcnt(0)" ::: "memory");
#pragma unroll
                    for (int r = 0; r < 16; ++r) { const float fr_ = wsf[crow(r, hi)];
#pragma unroll
                        for (int d = 0; d < 4; ++d) o[d][r] *= fr_; }
                }
            }
            float sacc = 0.f;
#pragma unroll
            for (int r = 0; r < 16; ++r) { p0[r] = __builtin_amdgcn_exp2f(p0[r]); p1[r] = __builtin_amdgcn_exp2f(p1[r]); sacc += p0[r] + p1[r]; }
            l += sacc;
            u32x4 pw[4];
#pragma unroll
            for (int s = 0; s < 2; ++s) {
                pw[s] = (u32x4){pkh(p0[8 * s], p0[8 * s + 1]), pkh(p0[8 * s + 2], p0[8 * s + 3]), pkh(p0[8 * s + 4], p0[8 * s + 5]), pkh(p0[8 * s + 6], p0[8 * s + 7])};
                pw[2 + s] = (u32x4){pkh(p1[8 * s], p1[8 * s + 1]), pkh(p1[8 * s + 2], p1[8 * s + 3]), pkh(p1[8 * s + 4], p1[8 * s + 5]), pkh(p1[8 * s + 6], p1[8 * s + 7])};
            }
#pragma unroll
            for (int d = 0; d < 4; ++d) {
#pragma unroll
                for (int s = 0; s < 4; ++s) {
                    const v4i16_t lo = vtr(Vs + (d * 4 + s) * 1024), hi4 = vtr(Vs + (d * 4 + s) * 1024 + 512);
                    typedef short s16x8 __attribute__((ext_vector_type(8)));
                    const s16x8 bv = {lo[0], lo[1], lo[2], lo[3], hi4[0], hi4[1], hi4[2], hi4[3]};
                    o[d] = __builtin_amdgcn_mfma_f32_32x32x16_f16(__builtin_bit_cast(f16x8, pw[s]), __builtin_bit_cast(f16x8, bv), o[d], 0, 0, 0);
                }
            }
        }
        slot = slot == 2 ? 0 : slot + 1;
    }
#undef ATT_ISSUE
    l += xhalf(l, hi);
    if (hi == 0) wsf[r32] = 1.0f / l;
    asm volatile("s_waitcnt lgkmcnt(0)" ::: "memory");
#pragma unroll
    for (int r = 0; r < 16; ++r) { const float f = wsf[crow(r, hi)];
#pragma unroll
        for (int d = 0; d < 4; ++d) o[d][r] *= f; }
    asm volatile("s_waitcnt lgkmcnt(0)" ::: "memory"); __builtin_amdgcn_s_barrier(); asm volatile("" ::: "memory");
    ALAS float* xb = (ALAS float*)(lds + L_XB) + w4 * 4096 + lane;
    if (c == 1) {
#pragma unroll
        for (int d = 0; d < 4; ++d)
#pragma unroll
            for (int r = 0; r < 16; ++r) xb[(d * 16 + r) * 64] = o[d][r];
    }
    asm volatile("s_waitcnt lgkmcnt(0)" ::: "memory"); __builtin_amdgcn_s_barrier(); asm volatile("" ::: "memory");
    if (c == 0) {
        float sc[16];
#pragma unroll
        for (int r = 0; r < 16; ++r) { float ss = 0.f;
#pragma unroll
            for (int d = 0; d < 4; ++d) { o[d][r] -= lam * xb[(d * 16 + r) * 64]; ss += o[d][r] * o[d][r]; }
            ss += __shfl_xor(ss, 1); ss += __shfl_xor(ss, 2); ss += __shfl_xor(ss, 4); ss += __shfl_xor(ss, 8); ss += __shfl_xor(ss, 16);
            sc[r] = __builtin_amdgcn_rsqf(ss * (1.f / 128.f) + LN_EPS) * (1.f - LAMBDA_INIT); }
        ALAS _Float16* stg = (ALAS _Float16*)(lds + L_STG + w4 * 8192);
#pragma unroll
        for (int d = 0; d < 4; ++d) { const float gg = subln_g[32 * d + r32];
#pragma unroll
            for (int r = 0; r < 16; ++r) stg[crow(r, hi) * 128 + 32 * d + r32] = (_Float16)(o[d][r] * sc[r] * gg); }
        asm volatile("s_waitcnt lgkmcnt(0)" ::: "memory");
        unsigned short* Yw = Y + (rowbase + qw0) * D + h * 128;
#pragma unroll
        for (int i = 0; i < 8; ++i) { const int row = i * 4 + (lane >> 4), ch = lane & 15; const u32x4 v = *(const ALAS u32x4*)((const ALAS unsigned char*)stg + row * 256 + ch * 16);
            *(u32x4*)(Yw + (size_t)row * D + ch * 8) = v; }
    }
    asm volatile("s_waitcnt lgkmcnt(0)" ::: "memory"); __builtin_amdgcn_s_barrier(); asm volatile("" ::: "memory");
}
#undef ALAS
}

namespace rk {
#define RLAS __attribute__((address_space(3)))
#define RGAS __attribute__((address_space(1)))
typedef __bf16 bf16x8 __attribute__((ext_vector_type(8)));
typedef _Float16 f16x8 __attribute__((ext_vector_type(8)));
typedef float f32x16 __attribute__((ext_vector_type(16)));
typedef float f32x4 __attribute__((ext_vector_type(4)));
typedef unsigned u32x4 __attribute__((ext_vector_type(4)));
typedef unsigned short us8 __attribute__((ext_vector_type(8)));
constexpr int C = 32;
constexpr int TS = 144, CS = 80;
constexpr int O_AT = 0, O_RT = 4608, O_BT = 9216, O_KT = 13824;
constexpr int O_AAB = 0, O_AAK = 4608, O_ARB = 7168, O_ARK = 9728;
constexpr int O_PIMG = 0, O_QIMG = 8192;
constexpr int O_VT = 18432, O_KH = 23552, O_BH = 28672;
constexpr int O_X0 = 33792;
constexpr int O_RH = 50688;
constexpr int O_GAM = 55296;
constexpr int HALF_BYTES = 57344;
constexpr int CHK_BYTES = 24576, CK_P = 0, CK_Q = 8192, CK_G = 12288, CK_Y = 20480;
__device__ __forceinline__ int crow(int r, int hi) { return (r & 3) + 8 * (r >> 2) + 4 * hi; }
__device__ __forceinline__ unsigned pkb(float lo, float hi) { typedef float f2 __attribute__((ext_vector_type(2))); typedef __bf16 b2 __attribute__((ext_vector_type(2))); f2 v = {lo, hi}; b2 w = __builtin_convertvector(v, b2); return __builtin_bit_cast(unsigned, w); }
__device__ __forceinline__ unsigned pkh(float lo, float hi) { typedef _Float16 h2 __attribute__((ext_vector_type(2))); h2 v = {(_Float16)lo, (_Float16)hi}; return __builtin_bit_cast(unsigned, v); }
__device__ __forceinline__ float h2f(unsigned short u) { return (float)__builtin_bit_cast(_Float16, u); }
__device__ __forceinline__ unsigned short f2h(float f) { return __builtin_bit_cast(unsigned short, (_Float16)f); }
__device__ __forceinline__ float sum8(float x) {
    x += __builtin_bit_cast(float, __builtin_amdgcn_update_dpp(0, __builtin_bit_cast(int, x), 0xB1, 0xF, 0xF, true));
    x += __builtin_bit_cast(float, __builtin_amdgcn_update_dpp(0, __builtin_bit_cast(int, x), 0x4E, 0xF, 0xF, true));
    x += __builtin_bit_cast(float, __builtin_amdgcn_update_dpp(0, __builtin_bit_cast(int, x), 0x141, 0xF, 0xF, true));
    return x;
}
__device__ __forceinline__ int frag_pos(int m, int c) { return (((c >> 4) * 64 + m + 32 * ((c >> 2) & 1)) * 8) + ((c >> 3) & 1) * 4 + (c & 3); }

struct ChunkIn { f32x4 l0, l1; us8 a8, b8, k8, rc, rp, vc, vp; };
__device__ __forceinline__ void chunk_load(ChunkIn& in, int tglob, int pos, int chb, const unsigned char* ws) {
    const unsigned short* PROJ16 = (const unsigned short*)(ws + WS_PROJ16); const float* LW = (const float*)(ws + WS_DECAY); const unsigned short* KMOD = (const unsigned short*)(ws + WS_KMOD);
    const unsigned short* A16 = (const unsigned short*)(ws + WS_A16); const unsigned short* B16 = (const unsigned short*)(ws + WS_B16);
    in.l0 = *(const RGAS f32x4*)(LW + (size_t)tglob * RWK + chb); in.l1 = *(const RGAS f32x4*)(LW + (size_t)tglob * RWK + chb + 4);
    in.a8 = *(const RGAS us8*)(A16 + (size_t)tglob * RWK + chb); in.b8 = *(const RGAS us8*)(B16 + (size_t)tglob * RWK + chb); in.k8 = *(const RGAS us8*)(KMOD + (size_t)tglob * RWK + chb);
    const unsigned short* cur = PROJ16 + (size_t)tglob * PN + 3072 + chb;
    in.rc = *(const RGAS us8*)cur; in.vc = *(const RGAS us8*)(cur + 2048); in.rp = in.rc; in.vp = in.vc; if (pos > 0) { in.rp = *(const RGAS us8*)(cur - PN); in.vp = *(const RGAS us8*)(cur - PN + 2048); }
}
__device__ __forceinline__ void chunk_pair(RLAS unsigned char* lds, const int wave, const int tile, const int hA, ChunkIn& in, const bool has_next, const float* mu, const float* r_k, unsigned char* ws) {
    unsigned char* CHK = ws + WS_CHK; float* BONUS = (float*)(ws + WS_BONUS);
    const int lane = pg8::lane_id(), hf = wave >> 2, q = wave & 3, r32 = lane & 31, hi = lane >> 5;
    const int h = hA + hf;
    RLAS unsigned char* L = lds + hf * HALF_BYTES;
    const int t = q * 64 + lane;
    const int tok = t >> 3, c8 = (t & 7) * 8;
    const int tglob = tile * C + tok, pos = tglob & (S - 1), bidx = tglob >> 11;
    const int chb = h * 64 + c8;
    float lw[8], av[8], bv[8], kv[8], rv[8], vv[8];
    { lw[0] = in.l0.x; lw[1] = in.l0.y; lw[2] = in.l0.z; lw[3] = in.l0.w; lw[4] = in.l1.x; lw[5] = in.l1.y; lw[6] = in.l1.z; lw[7] = in.l1.w;
      const f32x4 m0 = *(const RGAS f32x4*)(mu + chb), m1 = *(const RGAS f32x4*)(mu + chb + 4), n0 = *(const RGAS f32x4*)(mu + 2048 + chb), n1 = *(const RGAS f32x4*)(mu + 2048 + chb + 4);
      const float mr[8] = {m0.x, m0.y, m0.z, m0.w, m1.x, m1.y, m1.z, m1.w}, mv[8] = {n0.x, n0.y, n0.z, n0.w, n1.x, n1.y, n1.z, n1.w};
#pragma unroll
      for (int i = 0; i < 8; ++i) { av[i] = h2f(in.a8[i]); bv[i] = h2f(in.b8[i]); kv[i] = h2f(in.k8[i]);
          const float rcf = h2f(in.rc[i]), rpf = pos > 0 ? h2f(in.rp[i]) : 0.f, vcf = h2f(in.vc[i]), vpf = pos > 0 ? h2f(in.vp[i]) : 0.f;
          rv[i] = rcf + (rpf - rcf) * mr[i]; vv[i] = vcf + (vpf - vcf) * mv[i]; } }
    { const f32x4 k0 = *(const RGAS f32x4*)(r_k + chb), k1 = *(const RGAS f32x4*)(r_k + chb + 4); const float rk8[8] = {k0.x, k0.y, k0.z, k0.w, k1.x, k1.y, k1.z, k1.w};
      float bs = 0.f;
#pragma unroll
      for (int i = 0; i < 8; ++i) bs += rv[i] * kv[i] * rk8[i];
      bs = sum8(bs); if ((t & 7) == 0) BONUS[(size_t)tglob * 16 + h] = bs; }
    RLAS float* lwL = (RLAS float*)(L + O_X0 + 64 * 132);
    __syncthreads();
#pragma unroll
    for (int i = 0; i < 8; ++i) lwL[tok * 65 + c8 + i] = lw[i];
    __syncthreads();
    { RLAS float* part = (RLAS float*)(L + O_GAM) + 64;
      const int ch = t & 63, seg = t >> 6; float sg = 0.f;
#pragma unroll
      for (int k = 0; k < 8; ++k) sg += lwL[(8 * seg + k) * 65 + ch];
      part[seg * 64 + ch] = sg;
      __syncthreads();
      float g = 0.f;
#pragma unroll
      for (int s2 = 0; s2 < 3; ++s2) if (s2 < seg) g += part[s2 * 64 + ch];
#pragma unroll
      for (int k = 0; k < 8; ++k) { g += lwL[(8 * seg + k) * 65 + ch]; lwL[(8 * seg + k) * 65 + ch] = g; } }
    __syncthreads();
    {
        float G[8], GL[8];
#pragma unroll
        for (int i = 0; i < 8; ++i) { G[i] = lwL[tok * 65 + c8 + i]; GL[i] = lwL[31 * 65 + c8 + i]; }
        float at[8], rt[8], bt[8], kt[8], bh[8], kh[8];
#pragma unroll
        for (int i = 0; i < 8; ++i) { const float eg = __expf(G[i]), eng = __expf(-G[i]), egm = __expf(G[i] - lw[i]), egl = __expf(GL[i] - G[i]);
            at[i] = av[i] * egm; rt[i] = rv[i] * eg; bt[i] = bv[i] * eng; kt[i] = kv[i] * eng; bh[i] = bv[i] * egl; kh[i] = kv[i] * egl; }
        *(RLAS u32x4*)(L + O_AT + tok * TS + c8 * 2) = (u32x4){pkb(at[0], at[1]), pkb(at[2], at[3]), pkb(at[4], at[5]), pkb(at[6], at[7])};
        *(RLAS u32x4*)(L + O_RT + tok * TS + c8 * 2) = (u32x4){pkb(rt[0], rt[1]), pkb(rt[2], rt[3]), pkb(rt[4], rt[5]), pkb(rt[6], rt[7])};
        *(RLAS u32x4*)(L + O_BT + tok * TS + c8 * 2) = (u32x4){pkb(bt[0], bt[1]), pkb(bt[2], bt[3]), pkb(bt[4], bt[5]), pkb(bt[6], bt[7])};
        *(RLAS u32x4*)(L + O_KT + tok * TS + c8 * 2) = (u32x4){pkb(kt[0], kt[1]), pkb(kt[2], kt[3]), pkb(kt[4], kt[5]), pkb(kt[6], kt[7])};
        *(RLAS u32x4*)(L + O_RH + tok * TS + c8 * 2) = (u32x4){pkh(rt[0], rt[1]), pkh(rt[2], rt[3]), pkh(rt[4], rt[5]), pkh(rt[6], rt[7])};
#pragma unroll
        for (int i = 0; i < 8; ++i) { const int ch = c8 + i;
            *(RLAS unsigned short*)(L + O_VT + ch * CS + tok * 2) = f2h(vv[i]); *(RLAS unsigned short*)(L + O_KH + ch * CS + tok * 2) = f2h(kh[i]); *(RLAS unsigned short*)(L + O_BH + ch * CS + tok * 2) = f2h(bh[i]);
            ((RLAS float*)(L + O_X0))[ch * 33 + tok] = at[i];
            if (tok == C - 1) ((RLAS float*)(L + O_GAM))[ch] = __expf(GL[i]); }
    }
    __syncthreads();
    {
        const RLAS unsigned char* Lp = L + (q < 2 ? O_AT : O_RT) + r32 * TS + hi * 16; const RLAS unsigned char* Rp = L + ((q & 1) ? O_KT : O_BT) + r32 * TS + hi * 16;
        f32x16 acc;
#pragma unroll
        for (int r = 0; r < 16; ++r) acc[r] = 0.f;
#pragma unroll
        for (int ks = 0; ks < 4; ++ks) acc = __builtin_amdgcn_mfma_f32_32x32x16_bf16(*(const RLAS bf16x8*)(Lp + ks * 32), *(const RLAS bf16x8*)(Rp + ks * 32), acc, 0, 0, 0);
#pragma unroll
        for (int r = 0; r < 16; ++r) { const int tau = crow(r, hi); const bool keep = (q < 2) ? (r32 < tau) : (r32 <= tau); acc[r] = keep ? acc[r] : 0.f; }
        __syncthreads();
        if (q == 0) {
#pragma unroll
            for (int r = 0; r < 16; ++r) ((RLAS float*)(L + O_AAB))[r32 * 36 + crow(r, hi)] = acc[r];
        } else {
            RLAS unsigned char* o = L + (q == 1 ? O_AAK : (q == 2 ? O_ARB : O_ARK));
#pragma unroll
            for (int r = 0; r < 16; ++r) *(RLAS unsigned short*)(o + crow(r, hi) * CS + r32 * 2) = f2h(acc[r]);
        }
    }
    __syncthreads();
    const int J = q & 1, part = q >> 1;
    if (part == 1) {
        f32x16 accX;
#pragma unroll
        for (int r = 0; r < 16; ++r) accX[r] = 0.f;
        const RLAS unsigned char* Vp = L + O_VT + (32 * J + r32) * CS + hi * 16; const RLAS unsigned char* Ap = L + O_AAK + r32 * CS + hi * 16;
#pragma unroll
        for (int ks = 0; ks < 2; ++ks) accX = __builtin_amdgcn_mfma_f32_32x32x16_f16(*(const RLAS f16x8*)(Ap + ks * 32), *(const RLAS f16x8*)(Vp + ks * 32), accX, 0, 0, 0);
#pragma unroll
        for (int r = 0; r < 16; ++r) ((RLAS float*)(L + O_X0))[(64 + 32 * J + r32) * 33 + crow(r, hi)] = accX[r];
    }
    __syncthreads();
    float z[C];
    if (q < 2) {
        const RLAS float* xc = (const RLAS float*)(L + O_X0) + (64 * q + lane) * 33;
#pragma unroll
        for (int k = 0; k < C; ++k) z[k] = xc[k];
    }
    __syncthreads();
    if (q < 2) {
        const RLAS float* AabT = (const RLAS float*)(L + O_AAB);
#pragma unroll
        for (int sx = 0; sx < C - 1; ++sx) {
            const float zs = z[sx];
#pragma unroll
            for (int t4 = (sx + 1) / 4; t4 < C / 4; ++t4) { const f32x4 aa = *(const RLAS f32x4*)(AabT + sx * 36 + 4 * t4);
                if (4 * t4 + 0 > sx) z[4 * t4 + 0] = fmaf(aa.x, zs, z[4 * t4 + 0]); if (4 * t4 + 1 > sx) z[4 * t4 + 1] = fmaf(aa.y, zs, z[4 * t4 + 1]);
                if (4 * t4 + 2 > sx) z[4 * t4 + 2] = fmaf(aa.z, zs, z[4 * t4 + 2]); if (4 * t4 + 3 > sx) z[4 * t4 + 3] = fmaf(aa.w, zs, z[4 * t4 + 3]); }
        }
        RLAS unsigned char* zr = L + O_X0 + (64 * q + lane) * CS;
#pragma unroll
        for (int k8 = 0; k8 < 4; ++k8) *(RLAS u32x4*)(zr + k8 * 16) = (u32x4){pkh(z[8 * k8], z[8 * k8 + 1]), pkh(z[8 * k8 + 2], z[8 * k8 + 3]), pkh(z[8 * k8 + 4], z[8 * k8 + 5]), pkh(z[8 * k8 + 6], z[8 * k8 + 7])};
    }
    __syncthreads();
    f32x16 accQ, accP, accA, accB;
#pragma unroll
    for (int r = 0; r < 16; ++r) { accA[r] = 0.f; accB[r] = 0.f; }
    {
        const RLAS unsigned char* Vp = L + O_VT + (32 * J + r32) * CS + hi * 16;
        const RLAS unsigned char* Kp = L + O_KH + (32 * part + r32) * CS + hi * 16;
        const RLAS unsigned char* Ap = L + O_ARK + r32 * CS + hi * 16;
#pragma unroll
        for (int ks = 0; ks < 2; ++ks) { const f16x8 vf = *(const RLAS f16x8*)(Vp + ks * 32);
            if (part == 0) accA = __builtin_amdgcn_mfma_f32_32x32x16_f16(*(const RLAS f16x8*)(Ap + ks * 32), vf, accA, 0, 0, 0);
            accB = __builtin_amdgcn_mfma_f32_32x32x16_f16(*(const RLAS f16x8*)(Kp + ks * 32), vf, accB, 0, 0, 0); }
    }
    {
        const RLAS float* gam = (const RLAS float*)(L + O_GAM);
#pragma unroll
        for (int r = 0; r < 16; ++r) { const int m = crow(r, hi);
            accQ[r] = h2f(*(const RLAS unsigned short*)(L + O_RH + m * TS + (32 * J + r32) * 2));
            accP[r] = (J == part && m == r32) ? gam[32 * J + r32] : 0.f; }
        const RLAS unsigned char* Zw = L + O_X0 + (32 * J + r32) * CS + hi * 16; const RLAS unsigned char* Zu = Zw + 64 * CS;
        const RLAS unsigned char* Bp = L + O_BH + (32 * part + r32) * CS + hi * 16; const RLAS unsigned char* Rb = L + O_ARB + r32 * CS + hi * 16;
#pragma unroll
        for (int ks = 0; ks < 2; ++ks) { const f16x8 zw = *(const RLAS f16x8*)(Zw + ks * 32), zu = *(const RLAS f16x8*)(Zu + ks * 32), bf = *(const RLAS f16x8*)(Bp + ks * 32);
            accP = __builtin_amdgcn_mfma_f32_32x32x16_f16(bf, zw, accP, 0, 0, 0);
            accB = __builtin_amdgcn_mfma_f32_32x32x16_f16(bf, zu, accB, 0, 0, 0);
            if (part == 0) { const f16x8 rb = *(const RLAS f16x8*)(Rb + ks * 32);
                accQ = __builtin_amdgcn_mfma_f32_32x32x16_f16(rb, zw, accQ, 0, 0, 0);
                accA = __builtin_amdgcn_mfma_f32_32x32x16_f16(rb, zu, accA, 0, 0, 0); } }
    }
    __syncthreads();
    { int tg2 = tglob, cb2 = has_next ? chb + 128 : chb; asm volatile("" : "+v"(tg2), "+v"(cb2)); chunk_load(in, tg2, pos, cb2, ws); }
    unsigned char* rec = CHK + ((size_t)((bidx * 16 + h) * (S / C)) + (size_t)(pos >> 5)) * CHK_BYTES;
    { u32x4 w0, w1; w0 = (u32x4){pkh(accB[0], accB[1]), pkh(accB[2], accB[3]), pkh(accB[4], accB[5]), pkh(accB[6], accB[7])}; w1 = (u32x4){pkh(accB[8], accB[9]), pkh(accB[10], accB[11]), pkh(accB[12], accB[13]), pkh(accB[14], accB[15])};
      RGAS u32x4* g = (RGAS u32x4*)(rec + CK_G + ((part * 2 + J) * 64 + lane) * 32); g[0] = w0; g[1] = w1;
      if (part == 0) { w0 = (u32x4){pkh(accA[0], accA[1]), pkh(accA[2], accA[3]), pkh(accA[4], accA[5]), pkh(accA[6], accA[7])}; w1 = (u32x4){pkh(accA[8], accA[9]), pkh(accA[10], accA[11]), pkh(accA[12], accA[13]), pkh(accA[14], accA[15])};
          RGAS u32x4* y = (RGAS u32x4*)(rec + CK_Y + (J * 64 + lane) * 32); y[0] = w0; y[1] = w1; } }
    {
        RLAS unsigned short* pimg = (RLAS unsigned short*)(L + O_PIMG) + ((part * 2 + J) * 2) * 512;
        RLAS unsigned short* qimg = (RLAS unsigned short*)(L + O_QIMG) + (J * 2) * 512;
#pragma unroll
        for (int r = 0; r < 16; ++r) { const int fp = frag_pos(crow(r, hi), r32); pimg[fp] = f2h(accP[r]); if (part == 0) qimg[fp] = f2h(accQ[r]); }
    }
    __syncthreads();
    { const RLAS u32x4* src = (const RLAS u32x4*)(L + O_PIMG); RGAS u32x4* dst = (RGAS u32x4*)(rec + CK_P);
#pragma unroll
      for (int i = 0; i < 3; ++i) dst[i * 256 + t] = src[i * 256 + t]; }
}

__device__ __forceinline__ void scan_unit(RLAS unsigned char* lds, const int wave, const int bh, const unsigned char* CHK, const float* BONUS, const unsigned short* PROJ16, const float* mu,
                                          const unsigned short* G16, const float* lnx_g, const float* lnx_b, unsigned short* Y16) {
    const int lane = pg8::lane_id(), r32 = lane & 31, hi = lane >> 5;
    const int b = bh >> 4, h = bh & 15;
    RLAS float* ytile = (RLAS float*)lds;
    constexpr int RING0 = 18432, NSL = 4;
    const unsigned char* rec0 = CHK + (size_t)bh * (S / C) * CHK_BYTES;
    constexpr int NCH = S / C;
    __syncthreads();
    if (wave >= 6) {
        const int p0 = (wave - 6) * 12;
#define RK_DMA(c) do { const unsigned char* src_ = rec0 + (size_t)(c) * CHK_BYTES + p0 * 1024 + lane * 16; RLAS unsigned char* dst_ = lds + RING0 + ((c) & (NSL - 1)) * CHK_BYTES + p0 * 1024; \
            _Pragma("unroll") for (int j_ = 0; j_ < 12; ++j_) __builtin_amdgcn_global_load_lds((const unsigned*)(src_ + j_ * 1024), (RLAS unsigned*)(dst_ + j_ * 1024), 16, 0, 0); } while (0)
        RK_DMA(0); RK_DMA(1); RK_DMA(2);
        for (int c = 0; c <= NCH; ++c) {
            if (c + 2 < NCH) asm volatile("s_waitcnt vmcnt(24)" ::: "memory"); else if (c + 1 < NCH) asm volatile("s_waitcnt vmcnt(12)" ::: "memory"); else asm volatile("s_waitcnt vmcnt(0)" ::: "memory");
            __builtin_amdgcn_s_barrier(); asm volatile("" ::: "memory");
            if (c + 3 < NCH) RK_DMA(c + 3);
        }
#undef RK_DMA
    } else if (wave < 2) {
        const int J = wave;
        f32x16 H0, H1;
#pragma unroll
        for (int r = 0; r < 16; ++r) { H0[r] = 0.f; H1[r] = 0.f; }
        for (int c = 0; c <= NCH; ++c) {
            asm volatile("s_waitcnt lgkmcnt(0)" ::: "memory"); __builtin_amdgcn_s_barrier(); asm volatile("" ::: "memory");
            if (c == NCH) break;
            const RLAS unsigned char* rec = lds + RING0 + (c & (NSL - 1)) * CHK_BYTES;
            u32x4 hb[4];
            hb[0] = (u32x4){pkh(H0[0], H0[1]), pkh(H0[2], H0[3]), pkh(H0[4], H0[5]), pkh(H0[6], H0[7])}; hb[1] = (u32x4){pkh(H0[8], H0[9]), pkh(H0[10], H0[11]), pkh(H0[12], H0[13]), pkh(H0[14], H0[15])};
            hb[2] = (u32x4){pkh(H1[0], H1[1]), pkh(H1[2], H1[3]), pkh(H1[4], H1[5]), pkh(H1[6], H1[7])}; hb[3] = (u32x4){pkh(H1[8], H1[9]), pkh(H1[10], H1[11]), pkh(H1[12], H1[13]), pkh(H1[14], H1[15])};
            f32x16 y, n0, n1;
#define RK_UNPK(dst, w0, w1) do { const f16x8 a_ = __builtin_bit_cast(f16x8, w0), b_ = __builtin_bit_cast(f16x8, w1); \
            _Pragma("unroll") for (int i_ = 0; i_ < 8; ++i_) { dst[i_] = (float)a_[i_]; dst[8 + i_] = (float)b_[i_]; } } while (0)
            { const u32x4 y0 = *(const RLAS u32x4*)(rec + CK_Y + (J * 64 + lane) * 32), y1 = *(const RLAS u32x4*)(rec + CK_Y + (J * 64 + lane) * 32 + 16); RK_UNPK(y, y0, y1);
              const u32x4 g0 = *(const RLAS u32x4*)(rec + CK_G + (J * 64 + lane) * 32), g1 = *(const RLAS u32x4*)(rec + CK_G + (J * 64 + lane) * 32 + 16); RK_UNPK(n0, g0, g1);
              const u32x4 g2 = *(const RLAS u32x4*)(rec + CK_G + ((2 + J) * 64 + lane) * 32), g3 = *(const RLAS u32x4*)(rec + CK_G + ((2 + J) * 64 + lane) * 32 + 16); RK_UNPK(n1, g2, g3); }
#pragma unroll
            for (int ks = 0; ks < 4; ++ks) {
                const f16x8 hf = __builtin_bit_cast(f16x8, hb[ks]);
                y = __builtin_amdgcn_mfma_f32_32x32x16_f16(*(const RLAS f16x8*)(rec + CK_Q + (ks * 64 + lane) * 16), hf, y, 0, 0, 0);
                n0 = __builtin_amdgcn_mfma_f32_32x32x16_f16(*(const RLAS f16x8*)(rec + CK_P + (ks * 64 + lane) * 16), hf, n0, 0, 0, 0);
                n1 = __builtin_amdgcn_mfma_f32_32x32x16_f16(*(const RLAS f16x8*)(rec + CK_P + ((4 + ks) * 64 + lane) * 16), hf, n1, 0, 0, 0);
            }
#undef RK_UNPK
            H0 = n0; H1 = n1;
            RLAS float* yt = ytile + (c & 1) * (32 * 68);
#pragma unroll
            for (int r = 0; r < 16; ++r) yt[crow(r, hi) * 68 + 32 * J + r32] = y[r];
        }
    } else {
        const int p = wave - 2, v8 = (lane & 7) * 8, trow = 8 * p + (lane >> 3);
        float lg[8], lb[8], mv[8];
#pragma unroll
        for (int i = 0; i < 8; ++i) { lg[i] = lnx_g[h * 64 + v8 + i]; lb[i] = lnx_b[h * 64 + v8 + i]; mv[i] = mu[2048 + h * 64 + v8 + i]; }
        struct PSlot { float bon; us8 vc, vp, g8; };
        PSlot ps[4];
#define RK_PLOAD(SL, cc_) do { const int pos_ = (cc_) * C + trow; const size_t tok_ = (size_t)b * S + pos_; ps[SL].bon = BONUS[tok_ * 16 + h]; \
            const unsigned short* cur_ = PROJ16 + tok_ * PN + 5120 + h * 64 + v8; ps[SL].vc = *(const RGAS us8*)cur_; ps[SL].vp = ps[SL].vc; if (pos_ > 0) ps[SL].vp = *(const RGAS us8*)(cur_ - PN); \
            ps[SL].g8 = *(const RGAS us8*)(G16 + tok_ * RWK + h * 64 + v8); } while (0)
#define RK_PSTEP(SL, cc_) do { \
            asm volatile("s_waitcnt lgkmcnt(0)" ::: "memory"); __builtin_amdgcn_s_barrier(); asm volatile("" ::: "memory"); \
            if ((cc_) >= 0) { const int cc = (cc_); \
                const float bon = ps[SL].bon; const us8 vc = ps[SL].vc, vp = ps[SL].vp, g8 = ps[SL].g8; \
                if (cc + 4 < NCH) RK_PLOAD(SL, cc + 4); \
                const RLAS float* yt = ytile + (cc & 1) * (32 * 68) + trow * 68 + v8; \
                const f32x4 ya = *(const RLAS f32x4*)yt, yb = *(const RLAS f32x4*)(yt + 4); \
                float yv[8] = {ya.x, ya.y, ya.z, ya.w, yb.x, yb.y, yb.z, yb.w}; \
                float sm = 0.f; \
                _Pragma("unroll") for (int i = 0; i < 8; ++i) sm += yv[i]; \
                const float mean = sum8(sm) * (1.f / 64.f); float sq = 0.f; \
                _Pragma("unroll") for (int i = 0; i < 8; ++i) { yv[i] -= mean; sq += yv[i] * yv[i]; } \
                const float rstd = __builtin_amdgcn_rsqf(sum8(sq) * (1.f / 64.f) + 64e-5f); \
                const int pos = cc * C + trow; const size_t tok = (size_t)b * S + pos; \
                float o[8]; \
                _Pragma("unroll") for (int i = 0; i < 8; ++i) { const float vcf = h2f(vc[i]), vpf = pos > 0 ? h2f(vp[i]) : 0.f; const float vx = vcf + (vpf - vcf) * mv[i]; \
                    o[i] = (yv[i] * rstd * lg[i] + lb[i] + bon * vx) * h2f(g8[i]); } \
                *(RGAS u32x4*)(Y16 + tok * D + 1024 + h * 64 + v8) = (u32x4){pkh(o[0], o[1]), pkh(o[2], o[3]), pkh(o[4], o[5]), pkh(o[6], o[7])}; } } while (0)
        RK_PLOAD(0, 0); RK_PLOAD(1, 1); RK_PLOAD(2, 2); RK_PLOAD(3, 3);
        for (int cb = 0; cb < NCH; cb += 4) {
            RK_PSTEP(3, cb - 1); RK_PSTEP(0, cb); RK_PSTEP(1, cb + 1); RK_PSTEP(2, cb + 2);
        }
        RK_PSTEP(3, NCH - 1);
#undef RK_PSTEP
#undef RK_PLOAD
    }
    __syncthreads();
}
#undef RLAS
#undef RGAS
}

constexpr int NWAVES = 8;
constexpr int RING_OFF = 0, RING_BYTES = 131072;
constexpr int LDSCTL_OFF = RING_BYTES, MISC_OFF = LDSCTL_OFF + 320;
constexpr int LDS_BYTES = 147456;
#define GAS __attribute__((address_space(1)))
#define LAS __attribute__((address_space(3)))
typedef unsigned v4u __attribute__((ext_vector_type(4)));
typedef float f32x4 __attribute__((ext_vector_type(4)));
typedef GAS unsigned gu32;
#define RLX_AGENT __ATOMIC_RELAXED, __HIP_MEMORY_SCOPE_AGENT
#define LDS_WAIT() asm volatile("s_waitcnt lgkmcnt(0)" ::: "memory")
#define VM_WAIT() asm volatile("s_waitcnt vmcnt(0)" ::: "memory")
constexpr int CW_CONVQ = 65;
constexpr int CW_ATTQ = 64;
constexpr int CW_BAR = 4096;
constexpr size_t CTL_ZERO_BYTES = 64 * 1024;

#define XB_TMO      128
#define XB_XCNT(j)  (256  + 64 * (j))
#define XB_XSUB(j)  (1280 + 64 * (j))
#define XB_XGEN(j)  (2304 + 64 * (j))
#define XB_TOP      3328
#define XB_TOPGEN   3392
#define XCD_BAR_WORDS 3456
#define XB_SPIN_CAP (1u << 18)

__device__ __forceinline__ unsigned xb_ld(unsigned* p)              { return __hip_atomic_load(p, __ATOMIC_RELAXED, __HIP_MEMORY_SCOPE_AGENT); }
__device__ __forceinline__ unsigned xb_add(unsigned* p, unsigned v) { return __hip_atomic_fetch_add(p, v, __ATOMIC_RELAXED, __HIP_MEMORY_SCOPE_AGENT); }
__device__ __forceinline__ unsigned xb_xcc_id() { return (unsigned)__builtin_amdgcn_s_getreg((3 << 11) | 20) & 0xFu; }
#define XB_SPIN(cond, bar) do { unsigned _sp = 0; while (cond) { __builtin_amdgcn_s_sleep(1); \
    if ((++_sp & 255u) == 0u) { if (xb_ld(&(bar)[XB_TMO])) break; if (_sp > XB_SPIN_CAP) { atomicAdd(&(bar)[XB_TMO], 1u); break; } } } } while (0)

struct XcdBarrier {
    unsigned* bar; unsigned x; bool w0;
    volatile LAS unsigned* st;
};

__device__ __forceinline__ XcdBarrier xcd_barrier_post(unsigned* bar, volatile LAS unsigned* st) {
    XcdBarrier b; b.bar = bar; b.x = xb_xcc_id(); b.st = st; b.w0 = (__builtin_amdgcn_readfirstlane(threadIdx.x >> 6) == 0);
    if (__builtin_amdgcn_readfirstlane(threadIdx.x >> 6) == 0 && pg8::lane_id() == 0) (void)xb_add(&bar[XB_XCNT(b.x)], 1u);
    return b;
}
__device__ __forceinline__ void xcd_barrier_complete(unsigned* bar, unsigned x, unsigned& nloc, unsigned& nx) {
    const unsigned G = gridDim.x * gridDim.y * gridDim.z;
    unsigned sum, cnt, mine, sp = 0u;
    for (;;) {
        sum = 0u; cnt = 0u; mine = 0u;
#pragma unroll
        for (unsigned j = 0; j < 16; ++j) { const unsigned c = xb_ld(&bar[XB_XCNT(j)]); sum += c; cnt += (c > 0u) ? 1u : 0u; mine = (j == x) ? c : mine; }
        if (sum == G) break;
        __builtin_amdgcn_s_sleep(1);
        if ((++sp & 255u) == 0u) { if (xb_ld(&bar[XB_TMO])) break; if (sp > XB_SPIN_CAP) { atomicAdd(&bar[XB_TMO], 1u); break; } }
    }
    nloc = mine > 0u ? mine : 1u; nx = cnt > 0u ? cnt : 1u;
}

__device__ __forceinline__ void xcd_barrier(const XcdBarrier& b) {
    asm volatile("s_waitcnt vmcnt(0)" ::: "memory");
    __syncthreads();
    if (b.w0 && pg8::lane_id() == 0) {
        unsigned* bar = b.bar;
        __builtin_amdgcn_s_waitcnt(0);
        unsigned nloc = b.st[0], nx = b.st[1];
        if (nloc == 0u) { xcd_barrier_complete(bar, b.x, nloc, nx); b.st[0] = nloc; b.st[1] = nx; }
        const unsigned old = xb_add(&bar[XB_XSUB(b.x)], 1u);
        const unsigned gen = old / nloc;
        if (old + 1u == (gen + 1u) * nloc) {
            __builtin_amdgcn_fence(__ATOMIC_RELEASE, "agent");
            asm volatile("s_waitcnt vmcnt(0)" ::: "memory");
            const unsigned og = xb_add(&bar[XB_TOP], 1u);
            const unsigned tg = og / nx;
            if (og + 1u == (tg + 1u) * nx) xb_add(&bar[XB_TOPGEN], 1u);
            else XB_SPIN(xb_ld(&bar[XB_TOPGEN]) == tg, bar);
            __builtin_amdgcn_fence(__ATOMIC_ACQUIRE, "agent");
            xb_add(&bar[XB_XGEN(b.x)], 1u);
            asm volatile("s_waitcnt vmcnt(0)" ::: "memory");
        } else {
            XB_SPIN(xb_ld(&bar[XB_XGEN(b.x)]) == gen, bar);
            __builtin_amdgcn_fence(__ATOMIC_ACQUIRE, "agent");
            asm volatile("s_waitcnt vmcnt(0)" ::: "memory");
        }
    }
    __syncthreads();
}


typedef unsigned short f16_t;
typedef _Float16 h2v __attribute__((ext_vector_type(2)));
__device__ __forceinline__ unsigned pk2h(float lo, float hi) { h2v v = {(_Float16)lo, (_Float16)hi}; return __builtin_bit_cast(unsigned, v); }

struct Frame {
    LAS unsigned char* lds; volatile LAS unsigned* MISC; gu32* ctl;
    int wave, vcu, G;
};
#define FTID (F.wave * 64 + pg8::lane_id())
#define FLANE (pg8::lane_id())
__device__ __forceinline__ void p0_transpose_item(const float* W, int K, int N, f16_t* WT, int row_off, LAS float* scr, int item, int lane) {
    const int nblk = N / 32, kb = item / nblk, nb = item % nblk, k0 = 64 * kb, n0 = 32 * nb;
#pragma unroll 8
    for (int i = 0; i < 32; ++i) { const int kk = 2 * i + (lane >> 5); scr[kk * 33 + (lane & 31)] = W[(size_t)(k0 + kk) * N + n0 + (lane & 31)]; }
    LDS_WAIT(); asm volatile("" ::: "memory");
    const int c = lane & 7;
#pragma unroll
    for (int j = 0; j < 4; ++j) { const int n = (lane >> 3) + 8 * j; const LAS float* s = scr + (8 * c) * 33 + n;
        v4u o; o.x = pk2h(s[0 * 33], s[1 * 33]); o.y = pk2h(s[2 * 33], s[3 * 33]); o.z = pk2h(s[4 * 33], s[5 * 33]); o.w = pk2h(s[6 * 33], s[7 * 33]);
        *(GAS v4u*)(WT + (size_t)(row_off + n0 + n) * K + k0 + 8 * c) = o; }
    LDS_WAIT(); asm volatile("" ::: "memory");
}
#ifndef TP_LD
#define TP_LD(p) (*(p))
#endif
struct TpDesc { const float* W; f16_t* WT; int K, N, row_off, item; };
__device__ __forceinline__ void tp_load(float (&r)[32], const TpDesc& d, int lane) {
    const int nblk = d.N / 32, kb = d.item / nblk, nb = d.item % nblk, k0 = 64 * kb, n0 = 32 * nb;
#pragma unroll
    for (int i = 0; i < 32; ++i) r[i] = TP_LD(d.W + (size_t)(k0 + 2 * i + (lane >> 5)) * d.N + n0 + (lane & 31));
}
__device__ __forceinline__ void tp_emit(const TpDesc& d, LAS float* scr, int lane) {
    const int nblk = d.N / 32, kb = d.item / nblk, nb = d.item % nblk, k0 = 64 * kb, n0 = 32 * nb, c = lane & 7;
#pragma unroll
    for (int j = 0; j < 4; ++j) { const int n = (lane >> 3) + 8 * j; const LAS float* sp = scr + (8 * c) * 33 + n;
        v4u o; o.x = pk2h(sp[0 * 33], sp[1 * 33]); o.y = pk2h(sp[2 * 33], sp[3 * 33]); o.z = pk2h(sp[4 * 33], sp[5 * 33]); o.w = pk2h(sp[6 * 33], sp[7 * 33]);
        *(GAS v4u*)(d.WT + (size_t)(d.row_off + n0 + n) * d.K + k0 + 8 * c) = o; }
}
template <class MK> __device__ __forceinline__ void tp_stream(int first, int n, int stride, MK mk, LAS float* scr, int lane) {
    if (first >= n) return;
    float r[32]; int it = first; TpDesc d = mk(it); tp_load(r, d, lane);
    for (;;) {
#pragma unroll
        for (int i = 0; i < 32; ++i) scr[(2 * i + (lane >> 5)) * 33 + (lane & 31)] = r[i];
        LDS_WAIT(); asm volatile("" ::: "memory");
        const int nit = it + stride; const bool more = nit < n; TpDesc dn = d;
        if (more) { dn = mk(nit); tp_load(r, dn, lane); }
        tp_emit(d, scr, lane);
        LDS_WAIT(); asm volatile("" ::: "memory");
        if (!more) break;
        it = nit; d = dn;
    }
}
#ifndef TPD_AUX
#define TPD_AUX 2
#endif
__device__ __forceinline__ void tpd_load(const TpDesc& d, LAS unsigned char* buf, int lane) {
    const int nblk = d.N / 32, kb = d.item / nblk, nb = d.item % nblk, k0 = 64 * kb, n0 = 32 * nb;
    const float* src = d.W + (size_t)(k0 + (lane >> 3)) * d.N + n0;
#pragma unroll
    for (int j = 0; j < 8; ++j) __builtin_amdgcn_global_load_lds((const unsigned*)(src + (size_t)(8 * j) * d.N + 4 * ((lane & 7) ^ j)), (LAS unsigned*)(buf + j * 1024), 16, 0, TPD_AUX);
}
__device__ __forceinline__ void tpd_emit(const TpDesc& d, const LAS unsigned char* buf, int lane) {
    const int nblk = d.N / 32, kb = d.item / nblk, nb = d.item % nblk, k0 = 64 * kb, n0 = 32 * nb, c = lane & 7;
#pragma unroll
    for (int j = 0; j < 4; ++j) { const int n = (lane >> 3) + 8 * j; const LAS float* sp = (const LAS float*)(buf + (8 * c) * 128 + (((n >> 2) ^ c) * 16) + (n & 3) * 4);
        v4u o; o.x = pk2h(sp[0 * 32], sp[1 * 32]); o.y = pk2h(sp[2 * 32], sp[3 * 32]); o.z = pk2h(sp[4 * 32], sp[5 * 32]); o.w = pk2h(sp[6 * 32], sp[7 * 32]);
        __builtin_nontemporal_store(o, (GAS v4u*)(d.WT + (size_t)(d.row_off + n0 + n) * d.K + k0 + 8 * c)); }
}
template <class MK> __device__ __forceinline__ void tpd_stream(int first, int n, int stride, MK mk, LAS unsigned char* buf, int lane) {
    for (int it = first; it < n; it += 2 * stride) {
        const bool two = it + stride < n;
        const TpDesc d0 = mk(it); const TpDesc d1 = mk(two ? it + stride : it);
        tpd_load(d0, buf, lane); if (two) tpd_load(d1, buf + 8192, lane);
        asm volatile("s_waitcnt vmcnt(0)" ::: "memory");
        tpd_emit(d0, buf, lane); if (two) tpd_emit(d1, buf + 8192, lane);
        LDS_WAIT(); asm volatile("" ::: "memory");
    }
}
__device__ __forceinline__ float wave_sum_b(float v) {
#pragma unroll
    for (int o = 1; o < 64; o <<= 1) v += __shfl_xor(v, o);
    return v;
}
__device__ __forceinline__ void ln_row_dual(int lane, const float* xrow, const float* g, const float* b, float* o32, f16_t* o16) {
    const GAS f32x4* xr = (const GAS f32x4*)xrow + lane;
    f32x4 v[8]; float s = 0.f;
#pragma unroll
    for (int j = 0; j < 8; ++j) { v[j] = xr[64 * j]; s += (v[j].x + v[j].y) + (v[j].z + v[j].w); }
    const float mean = wave_sum_b(s) * (1.f / D); float s2 = 0.f;
#pragma unroll
    for (int j = 0; j < 8; ++j) { v[j] = v[j] - mean; s2 += (v[j].x * v[j].x + v[j].y * v[j].y) + (v[j].z * v[j].z + v[j].w * v[j].w); }
    const float rstd = __builtin_amdgcn_rsqf(wave_sum_b(s2) * (1.f / D) + LN_EPS);
    const GAS f32x4* g4 = (const GAS f32x4*)g + lane; const GAS f32x4* b4 = (const GAS f32x4*)b + lane;
    GAS f32x4* o4 = (GAS f32x4*)o32 + lane; GAS unsigned long long* o8 = (GAS unsigned long long*)o16 + lane;
#pragma unroll
    for (int j = 0; j < 8; ++j) { const f32x4 o = v[j] * rstd * g4[64 * j] + b4[64 * j]; o4[64 * j] = o;
        o8[64 * j] = (unsigned long long)pk2h(o.x, o.y) | ((unsigned long long)pk2h(o.z, o.w) << 32); }
}


__device__ __forceinline__ void ln_row_f16(int lane, const float* xrow, const float* g, const float* b, f16_t* o16, float2* st) {
    const GAS f32x4* xr = (const GAS f32x4*)xrow + lane;
    f32x4 v[8]; float s = 0.f;
#pragma unroll
    for (int j = 0; j < 8; ++j) { v[j] = xr[64 * j]; s += (v[j].x + v[j].y) + (v[j].z + v[j].w); }
    const float mean = wave_sum_b(s) * (1.f / D); float s2 = 0.f;
#pragma unroll
    for (int j = 0; j < 8; ++j) { v[j] = v[j] - mean; s2 += (v[j].x * v[j].x + v[j].y * v[j].y) + (v[j].z * v[j].z + v[j].w * v[j].w); }
    const float rstd = __builtin_amdgcn_rsqf(wave_sum_b(s2) * (1.f / D) + LN_EPS);
    const GAS f32x4* g4 = (const GAS f32x4*)g + lane; const GAS f32x4* b4 = (const GAS f32x4*)b + lane;
    GAS unsigned long long* o8 = (GAS unsigned long long*)o16 + lane;
#pragma unroll
    for (int j = 0; j < 8; ++j) { const f32x4 o = v[j] * rstd * g4[64 * j] + b4[64 * j];
        o8[64 * j] = (unsigned long long)pk2h(o.x, o.y) | ((unsigned long long)pk2h(o.z, o.w) << 32); }
    if (lane == 0) *st = make_float2(mean, rstd);
}

__device__ __forceinline__ void p0_transpose_item_gu(const float* W, int K, int N, f16_t* WT, int gu_s, LAS float* scr, int item, int lane) {
    const int nblk = N / 32, nb = item % nblk; const int row_off = gu_s < 0 ? 0 : 128 * (nb >> 2) + 128 * gu_s;
    p0_transpose_item(W, K, N, WT, row_off, scr, item, lane);
}
__device__ __forceinline__ void ln_norm(int lane, f32x4 (&v)[8], const float* g, const float* b) {
    float s = 0.f;
#pragma unroll
    for (int j = 0; j < 8; ++j) s += (v[j].x + v[j].y) + (v[j].z + v[j].w);
    const float mean = wave_sum_b(s) * (1.f / D); float s2 = 0.f;
#pragma unroll
    for (int j = 0; j < 8; ++j) { v[j] = v[j] - mean; s2 += (v[j].x * v[j].x + v[j].y * v[j].y) + (v[j].z * v[j].z + v[j].w * v[j].w); }
    const float rstd = __builtin_amdgcn_rsqf(wave_sum_b(s2) * (1.f / D) + LN_EPS);
    const GAS f32x4* g4 = (const GAS f32x4*)g + lane; const GAS f32x4* b4 = (const GAS f32x4*)b + lane;
#pragma unroll
    for (int j = 0; j < 8; ++j) v[j] = v[j] * rstd * g4[64 * j] + b4[64 * j];
}
__device__ __forceinline__ void ln_store(int lane, const f32x4 (&v)[8], float* o32, f16_t* o16) {
    GAS f32x4* o4 = (GAS f32x4*)o32 + lane; GAS unsigned long long* o8 = (GAS unsigned long long*)o16 + lane;
#pragma unroll
    for (int j = 0; j < 8; ++j) { o4[64 * j] = v[j]; o8[64 * j] = (unsigned long long)pk2h(v[j].x, v[j].y) | ((unsigned long long)pk2h(v[j].z, v[j].w) << 32); }
}
__device__ __forceinline__ void ln_store16(int lane, const f32x4 (&v)[8], f16_t* o16) {
    GAS unsigned long long* o8 = (GAS unsigned long long*)o16 + lane;
#pragma unroll
    for (int j = 0; j < 8; ++j) o8[64 * j] = (unsigned long long)pk2h(v[j].x, v[j].y) | ((unsigned long long)pk2h(v[j].z, v[j].w) << 32);
}
__device__ __forceinline__ void ln_regs(int lane, f32x4 (&v)[8], const float* g, const float* b, float* o32, f16_t* o16) { ln_norm(lane, v, g, b); ln_store(lane, v, o32, o16); }
__device__ __forceinline__ void route_token(int tok, const float (&acc)[36], const float* gb, const float* eb, int* cnt, int* ltok, int* lpair, float* pairw) {
    float gl[4]; float gm = -3.0e38f; int gi = 0;
#pragma unroll
    for (int i = 0; i < 4; ++i) { gl[i] = acc[i] + gb[i]; if (gl[i] > gm) { gm = gl[i]; gi = i; } }
    float gs = 0.f;
#pragma unroll
    for (int i = 0; i < 4; ++i) gs += __expf(gl[i] - gm);
    const float gtop = 1.f / gs;
    float el[8]; float em = -3.0e38f; int e0 = 0;
#pragma unroll
    for (int i = 0; i < 8; ++i) { float v = 0.f;
#pragma unroll
        for (int g = 0; g < 4; ++g) if (g == gi) v = acc[4 + g * 8 + i] + eb[g * 8 + i];
        el[i] = v; if (v > em) { em = v; e0 = i; } }
    float em2 = -3.0e38f; int e1 = 0;
#pragma unroll
    for (int i = 0; i < 8; ++i) if (i != e0 && el[i] > em2) { em2 = el[i]; e1 = i; }
    const float x1 = __expf(em2 - em);
    const float w0 = 1.f / (1.f + x1), w1 = x1 / (1.f + x1);
    const int ea = gi * 8 + e0, ebb = gi * 8 + e1;
    const int p0 = atomicAdd(&cnt[ea], 1); ltok[ea * 8192 + p0] = tok; lpair[ea * 8192 + p0] = tok * 2;
    const int p1 = atomicAdd(&cnt[ebb], 1); ltok[ebb * 8192 + p1] = tok; lpair[ebb * 8192 + p1] = tok * 2 + 1;
    pairw[tok * 2] = w0 * gtop; pairw[tok * 2 + 1] = w1 * gtop;
}
constexpr int TAB_OFF = LDSCTL_OFF + 1024;
__device__ __forceinline__ void build_moe_table(Frame& F, const int* cnt) {
    LAS int* tab = (LAS int*)(F.lds + TAB_OFF);
    const int tid = FTID;
    if (tid < 32) tab[tid] = __hip_atomic_load(cnt + tid, __ATOMIC_RELAXED, __HIP_MEMORY_SCOPE_AGENT);
    __syncthreads();
    if (tid == 0) { int p = 0, pa = 0, pb = 0; for (int e = 0; e < 32; ++e) { const int nb = (tab[e] + 255) >> 8, na = nb < 2 ? nb : 2;
            tab[32 + e] = p; tab[65 + e] = pa; tab[98 + e] = pb; p += nb; pa += na; pb += nb - na; } tab[64] = p; tab[97] = pa; tab[130] = pb; }
    __syncthreads();
}

__device__ __forceinline__ float sum8_dpp(float x) {
    x += __builtin_bit_cast(float, __builtin_amdgcn_update_dpp(0, __builtin_bit_cast(int, x), 0xB1, 0xF, 0xF, true));
    x += __builtin_bit_cast(float, __builtin_amdgcn_update_dpp(0, __builtin_bit_cast(int, x), 0x4E, 0xF, 0xF, true));
    x += __builtin_bit_cast(float, __builtin_amdgcn_update_dpp(0, __builtin_bit_cast(int, x), 0x141, 0xF, 0xF, true));
    return x;
}
__device__ __forceinline__ float h2f(unsigned short u) { return (float)__builtin_bit_cast(_Float16, u); }
__device__ __forceinline__ float sum32_x(float x) {
    x += __builtin_bit_cast(float, __builtin_amdgcn_update_dpp(0, __builtin_bit_cast(int, x), 0xB1, 0xF, 0xF, true));
    x += __builtin_bit_cast(float, __builtin_amdgcn_update_dpp(0, __builtin_bit_cast(int, x), 0x4E, 0xF, 0xF, true));
    x += __builtin_bit_cast(float, __builtin_amdgcn_update_dpp(0, __builtin_bit_cast(int, x), 0x141, 0xF, 0xF, true));
    x += __builtin_bit_cast(float, __builtin_amdgcn_update_dpp(0, __builtin_bit_cast(int, x), 0x140, 0xF, 0xF, true));
    x += __builtin_bit_cast(float, __builtin_amdgcn_ds_bpermute((pg8::lane_id() ^ 16) << 2, __builtin_bit_cast(int, x)));
    return x;
}
__device__ __forceinline__ float wsum64(float x) {
    x = sum32_x(x); auto rr = __builtin_amdgcn_permlane32_swap(__float_as_uint(x), __float_as_uint(x), false, false); return __uint_as_float(rr[0]) + __uint_as_float(rr[1]);
}
__device__ __forceinline__ void rwkv_prep_tile(Frame& F, int tile, const f16_t* PROJ16, const f16_t* LSLAB, const float* mu, const float* w0, const f16_t* W2T, const float* a0, const f16_t* A2T, const f16_t* G2T,
                                               const float* k_k, const float* k_a, float* lwout, f16_t* kmod, f16_t* Aout, f16_t* Bout, f16_t* gout) {
    typedef _Float16 f16x8 __attribute__((ext_vector_type(8))); typedef float f32x16 __attribute__((ext_vector_type(16)));
    constexpr int SXS = 592;
    LAS unsigned char* sx = F.lds + RING_OFF;
    const int lane = FLANE, tid = F.wave * 64 + lane, t0 = tile * 32, r32 = lane & 31, hi = lane >> 5;
    __syncthreads();
    for (int e = tid; e < 32 * 36; e += 512) {
        typedef unsigned short us8v __attribute__((ext_vector_type(8)));
        const int tok = e / 36, i8 = (e % 36) * 8, pos = (t0 + tok) & (S - 1);
        float cv[8], pv[8];
#pragma unroll
        for (int i = 0; i < 8; ++i) { cv[i] = 0.f; pv[i] = 0.f; }
#pragma unroll
        for (int sl = 0; sl < 4; ++sl) { const f16_t* cur = LSLAB + ((size_t)sl * T + t0 + tok) * 512 + i8;
            const us8v c8 = *(const GAS us8v*)cur; us8v p8 = c8; if (pos > 0) p8 = *(const GAS us8v*)(cur - 512);
#pragma unroll
            for (int i = 0; i < 8; ++i) { cv[i] += h2f(c8[i]); pv[i] += h2f(p8[i]); } }
        float f[8];
#pragma unroll
        for (int i = 0; i < 8; ++i) { const float xs = cv[i] + ((pos > 0 ? pv[i] : 0.f) - cv[i]) * mu[3072 + i8 + i];
            f[i] = i8 < 64 ? 1.f - 2.f / (1.f + __expf(2.f * xs)) : (i8 < 128 ? xs : 1.f / (1.f + __expf(-xs))); }
        *(LAS v4u*)(sx + tok * SXS + i8 * 2) = (v4u){pk2h(f[0], f[1]), pk2h(f[2], f[3]), pk2h(f[4], f[5]), pk2h(f[6], f[7])};
    }
    __syncthreads();
    const LAS unsigned char* ap = sx + r32 * SXS + hi * 16;
#pragma unroll 1
    for (int hd = 0; hd < 2; ++hd) {
        const int ch0 = 128 * F.wave + 64 * hd;
        f32x16 aw[2], aa[2], ag[2];
#pragma unroll
        for (int tt = 0; tt < 2; ++tt)
#pragma unroll
            for (int r = 0; r < 16; ++r) { aw[tt][r] = 0.f; aa[tt][r] = 0.f; ag[tt][r] = 0.f; }
#pragma unroll
        for (int tt = 0; tt < 2; ++tt) {
            const int n = ch0 + 32 * tt + r32;
            const f16_t* bw = W2T + (size_t)n * 64 + hi * 8; const f16_t* ba = A2T + (size_t)n * 64 + hi * 8; const f16_t* bg = G2T + (size_t)n * 160 + hi * 8;
#pragma unroll
            for (int ks = 0; ks < 4; ++ks) {
                aw[tt] = __builtin_amdgcn_mfma_f32_32x32x16_f16(*(const LAS f16x8*)(ap + ks * 32), *(const GAS f16x8*)(bw + ks * 16), aw[tt], 0, 0, 0);
                aa[tt] = __builtin_amdgcn_mfma_f32_32x32x16_f16(*(const LAS f16x8*)(ap + 128 + ks * 32), *(const GAS f16x8*)(ba + ks * 16), aa[tt], 0, 0, 0); }
#pragma unroll
            for (int ks = 0; ks < 10; ++ks)
                ag[tt] = __builtin_amdgcn_mfma_f32_32x32x16_f16(*(const LAS f16x8*)(ap + 256 + ks * 32), *(const GAS f16x8*)(bg + ks * 16), ag[tt], 0, 0, 0);
        }
        float k0[2][16];
        float pkk[2], pka[2], pmu[2], pw0[2], pa0[2];
#pragma unroll
        for (int tt = 0; tt < 2; ++tt) { const int n = ch0 + 32 * tt + r32; pkk[tt] = k_k[n]; pka[tt] = k_a[n]; pmu[tt] = mu[1024 + n]; pw0[tt] = w0[n]; pa0[tt] = a0[n]; }
#pragma unroll
        for (int rh = 0; rh < 2; ++rh) {
        float inv[8];
#pragma unroll
        for (int r = 8 * rh; r < 8 * rh + 8; ++r) { const int tok = t0 + (r & 3) + 8 * (r >> 2) + 4 * hi, pos = tok & (S - 1); float ss = 0.f;
#pragma unroll
            for (int tt = 0; tt < 2; ++tt) { const f16_t* cur = PROJ16 + (size_t)tok * PN + 4096 + ch0 + 32 * tt + r32;
                const float cv = h2f(cur[0]), pv = pos > 0 ? h2f(cur[-PN]) : 0.f; k0[tt][r] = cv + (pv - cv) * pmu[tt]; const float kq = k0[tt][r] * pkk[tt]; ss = fmaf(kq, kq, ss); }
            ss = sum32_x(ss); inv[r - 8 * rh] = __builtin_amdgcn_rsqf(fmaxf(ss, 1e-24f)); }
#pragma unroll
        for (int r = 8 * rh; r < 8 * rh + 8; ++r) { const int tok = t0 + (r & 3) + 8 * (r >> 2) + 4 * hi;
#pragma unroll
            for (int tt = 0; tt < 2; ++tt) { const size_t o = (size_t)tok * RWK + ch0 + 32 * tt + r32;
                const float z = -(pw0[tt] + aw[tt][r]); const float sp = z > 20.f ? z : __logf(1.f + __expf(z));
                lwout[o] = -__expf(-sp - 0.5f);
                const float asig = 1.f / (1.f + __expf(-(pa0[tt] + aa[tt][r]))); const float kk = k0[tt][r] * pkk[tt] * inv[r - 8 * rh];
                kmod[o] = __builtin_bit_cast(unsigned short, (_Float16)(k0[tt][r] * (1.f + (asig - 1.f) * pka[tt])));
                Aout[o] = __builtin_bit_cast(unsigned short, (_Float16)(-kk)); Bout[o] = __builtin_bit_cast(unsigned short, (_Float16)(kk * asig));
                gout[o] = __builtin_bit_cast(unsigned short, (_Float16)ag[tt][r]); } }
        }
    }
}
__device__ __forceinline__ float sum16_dpp(float x) {
    x += __builtin_bit_cast(float, __builtin_amdgcn_update_dpp(0, __builtin_bit_cast(int, x), 0xB1, 0xF, 0xF, true));
    x += __builtin_bit_cast(float, __builtin_amdgcn_update_dpp(0, __builtin_bit_cast(int, x), 0x4E, 0xF, 0xF, true));
    x += __builtin_bit_cast(float, __builtin_amdgcn_update_dpp(0, __builtin_bit_cast(int, x), 0x141, 0xF, 0xF, true));
    x += __builtin_bit_cast(float, __builtin_amdgcn_update_dpp(0, __builtin_bit_cast(int, x), 0x140, 0xF, 0xF, true));
    return x;
}
__device__ __forceinline__ f32x4 h4f(const f16_t* p) { typedef _Float16 h4_t __attribute__((ext_vector_type(4))); const h4_t v = *(const GAS h4_t*)p; return (f32x4){(float)v[0], (float)v[1], (float)v[2], (float)v[3]}; }
#ifndef REP_P0
#define REP_P0 1
#endif
#ifndef REP_PROJ
#define REP_PROJ 1
#endif
#ifndef REP_PLE
#define REP_PLE 1
#endif
#ifndef REP_CONV
#define REP_CONV 1
#endif
#ifndef REP_P2
#define REP_P2 1
#endif
#ifndef CONV_RATE
#define CONV_RATE 768
#endif
#ifndef REP_P3
#define REP_P3 1
#endif
#ifndef PROBE_K
#define PROBE_K -1
#endif
#ifndef PROBE_J
#define PROBE_J -1
#endif
#ifndef PROBE_SCALE
#define PROBE_SCALE 1e-3f
#endif
#ifndef REP_P5
#define REP_P5 1
#endif
#ifndef REP_P8
#define REP_P8 1
#endif
#ifndef REP_P6
#define REP_P6 1
#endif
#ifndef REP_P7
#define REP_P7 1
#endif
struct Args { const float* in[37]; float* out; unsigned char* ws; int ph_lo, ph_hi, li, pad; };
__global__ void __launch_bounds__(NWAVES * 64, 2) mega_fwd(Args args) {
    extern __shared__ __attribute__((aligned(16))) unsigned char lds[];
    Frame F;
    F.lds = (LAS unsigned char*)lds; F.MISC = (volatile LAS unsigned*)(F.lds + MISC_OFF);
    F.wave = __builtin_amdgcn_readfirstlane(threadIdx.x >> 6);
    F.G = gridDim.x; { const int bx = blockIdx.x; F.vcu = (F.G % 8 == 0) ? (bx % 8) * (F.G / 8) + bx / 8 : bx; }
    unsigned char* ws = args.ws;
    F.ctl = (gu32*)(ws);
    for (int u = FTID; u < (LDS_BYTES - LDSCTL_OFF) / 4; u += NWAVES * 64) ((LAS unsigned*)(F.lds + LDSCTL_OFF))[u] = 0u;
    __syncthreads();
    XcdBarrier bar = xcd_barrier_post((unsigned*)(F.ctl + CW_BAR) + args.li * XCD_BAR_WORDS, F.MISC + 8);
    unsigned long long t0_ = 0, tk_ = 0; if (PROBE_K != -1) t0_ = __builtin_amdgcn_s_memrealtime();
    const int lo = args.ph_lo, hi = args.ph_hi;
#define IN(k) (lo <= (k) && (k) < hi)
#define BOTH(k) (IN(k) && IN((k) + 1))
    f16_t* WinT = (f16_t*)(ws + WS_WINT); f16_t* H16 = (f16_t*)(ws + WS_H16); f16_t* PROJ16 = (f16_t*)(ws + WS_PROJ16); float* DECAY = (float*)(ws + WS_DECAY); f16_t* KMOD = (f16_t*)(ws + WS_KMOD); f16_t* A16 = (f16_t*)(ws + WS_A16); f16_t* B16 = (f16_t*)(ws + WS_B16); f16_t* G16 = (f16_t*)(ws + WS_G16);
    f16_t* WoutT = (f16_t*)(ws + WS_WOUTT); f16_t* GateT = (f16_t*)(ws + WS_GATET); f16_t* PleT = (f16_t*)(ws + WS_PLET); f16_t* P16 = (f16_t*)(ws + WS_P16);
    f16_t* PW16 = (f16_t*)(ws + WS_PW16); f16_t* Y16 = (f16_t*)(ws + WS_Y16); float* ROWRS = (float*)(ws + WS_ROWRS);
    float* RT = (float*)(ws + WS_RT); f16_t* GUT = (f16_t*)(ws + WS_GUT); f16_t* DNT = (f16_t*)(ws + WS_DNT); f16_t* HID = (f16_t*)(ws + WS_HID); f16_t* FFN16 = (f16_t*)(ws + WS_FFN16); f16_t* H1_16 = (f16_t*)(ws + WS_H1_16);
    int* cnt = (int*)(ws + WS_CNT); int* ltok = (int*)(ws + WS_LTOK); int* lpair = (int*)(ws + WS_LPAIR); float* pairw = (float*)(ws + WS_PAIRW);
    const int gw = F.vcu * NWAVES + F.wave, NGW = F.G * NWAVES;
    if (IN(0)) for (int rep_ = 0; rep_ < REP_P0; ++rep_) {
        LAS float* scr = (LAS float*)(F.lds + RING_OFF + F.wave * 16384);
        constexpr int I_IN = (D / 64) * (NPROJ / 32);
        for (int it = gw; it < I_IN; it += NGW) p0_transpose_item(args.in[5], D, NPROJ, WinT, 0, scr, it, FLANE);
        constexpr int I_SQ = (D / 64) * (D / 32), I_PLE = (256 / 64) * (D / 32);
        for (int it = gw; it < 2 * I_SQ + I_PLE; it += NGW) {
            if (it < I_SQ) p0_transpose_item(args.in[22], D, D, WoutT, 0, scr, it, FLANE);
            else if (it < 2 * I_SQ) p0_transpose_item(args.in[36], D, D, GateT, 0, scr, it - I_SQ, FLANE);
            else p0_transpose_item(args.in[34], 256, D, PleT, 0, scr, it - 2 * I_SQ, FLANE);
        }
        { const GAS f32x4* pi = (const GAS f32x4*)args.in[1]; GAS unsigned long long* po = (GAS unsigned long long*)P16;
          for (int i = blockIdx.x * 512 + FTID; i < T * 256 / 4; i += F.G * 512) { const f32x4 v = pi[i]; po[i] = (unsigned long long)pk2h(v.x, v.y) | ((unsigned long long)pk2h(v.z, v.w) << 32); } }
        { GAS v4u* z = (GAS v4u*)(WinT + (size_t)NPROJ * D); const int nz = (PN - NPROJ) * D * 2 / 16;
          for (int i = blockIdx.x * 512 + FTID; i < nz; i += F.G * 512) z[i] = (v4u){0u, 0u, 0u, 0u}; }
        {
            f16_t* W2T = (f16_t*)(ws + WS_W2T); f16_t* A2T = (f16_t*)(ws + WS_A2T); f16_t* G2T = (f16_t*)(ws + WS_G2T);
            for (int i = blockIdx.x * 512 + FTID; i < 1024 * 288; i += F.G * 512) { const int n = i / 288, k = i % 288;
                if (k < 64) W2T[n * 64 + k] = __builtin_bit_cast(unsigned short, (_Float16)args.in[13][k * 1024 + n]);
                else if (k < 128) A2T[n * 64 + (k - 64)] = __builtin_bit_cast(unsigned short, (_Float16)args.in[15][(k - 64) * 1024 + n]);
                else G2T[n * 160 + (k - 128)] = __builtin_bit_cast(unsigned short, (_Float16)args.in[16][(k - 128) * 1024 + n]); } }
        if (blockIdx.x == 0) {
            const int tid = FTID; float* lamp = (float*)(ws + WS_LAM); float* biasT = (float*)(ws + WS_BIAS);
            if (tid < 64) { const float a = wave_sum_b(args.in[6][tid] * args.in[7][tid]), b2 = wave_sum_b(args.in[8][tid] * args.in[9][tid]); if (tid == 0) *lamp = expf(a) - expf(b2) + LAMBDA_INIT; }
            for (int i = tid; i < 8 * 129; i += 512) { const int hh = i / 129, n = i % 129; int bucket;
                if (n < 16) bucket = n; else { const int large = 16 + (int)(logf((float)n / 16.f) / 2.0794415416798357f * 16.f); bucket = large < 31 ? large : 31; }
                biasT[i] = args.in[4][bucket * 8 + hh]; }
        }
        for (int m = gw; m < T; m += NGW) ln_row_f16(FLANE, args.in[0] + (size_t)m * D, args.in[2], args.in[3], H16 + (size_t)m * D, (float2*)(ws + WS_ROWST) + m);
        if (BOTH(0) && rep_ == REP_P0 - 1) xcd_barrier(bar); else __syncthreads();
    }
    if (PROBE_K == 0) tk_ = __builtin_amdgcn_s_memrealtime();
    if (PROBE_J == 0) t0_ = __builtin_amdgcn_s_memrealtime();
    if (IN(1)) {
        pg8::Gemm g{H16, WinT, T, 6144, D, D}; pg8::StaticOrder S; S.init(T, 6144, F.G, (int)blockIdx.x);
        pg8::EpiF16 E{PROJ16, PN, 4, att::C2};
        for (int rep_ = 0; rep_ < REP_PROJ; ++rep_) pg8::gemm_phase<pg8::EpiF16, pg8::StaticOrder, true>(F.lds + RING_OFF, g, S, E, F.wave);
        { pg8::Gemm gl{H16, WinT + (size_t)6144 * D, T, 512, 512, D}; pg8::SplitKOrder Sl{T / 256, 2, 4, F.G, (int)blockIdx.x};
          pg8::EpiSlab El{(f16_t*)(ws + WS_LSLAB), 512, (size_t)T * 512};
          pg8::gemm_phase<pg8::EpiSlab, pg8::SplitKOrder, true>(F.lds + RING_OFF, gl, Sl, El, F.wave); }
        for (int rep_ = 0; rep_ < REP_PLE; ++rep_) { pg8::Gemm g2{P16, PleT, T, D, 256, 256}; pg8::StaticOrder S2; S2.init(T, D, F.G, (int)blockIdx.x);
          pg8::EpiF16 E2{PW16, D, 0, 1.f};
          pg8::gemm_phase<pg8::EpiF16, pg8::StaticOrder, true>(F.lds + RING_OFF, g2, S2, E2, F.wave); }
        if (BOTH(1)) xcd_barrier(bar);
    }
    if (PROBE_K == 1) tk_ = __builtin_amdgcn_s_memrealtime();
    if (PROBE_J == 1) t0_ = __builtin_amdgcn_s_memrealtime();
    if (IN(2)) {
        for (int rep_ = 0; rep_ < REP_P2; ++rep_)
        if (F.vcu < T / 32) { const int tile = F.vcu;
            rwkv_prep_tile(F, tile, PROJ16, (const f16_t*)(ws + WS_LSLAB), args.in[11], args.in[12], (const f16_t*)(ws + WS_W2T), args.in[14], (const f16_t*)(ws + WS_A2T), (const f16_t*)(ws + WS_G2T), args.in[17], args.in[18], DECAY, KMOD, A16, B16, G16);
            asm volatile("s_waitcnt vmcnt(0)" ::: "memory"); __syncthreads();
            { rk::ChunkIn nin; const int tl_ = (F.wave & 3) * 64 + FLANE, tg_ = tile * 32 + (tl_ >> 3), ps_ = tg_ & (S - 1), cb_ = (F.wave >> 2) * 64 + (tl_ & 7) * 8;
              rk::chunk_load(nin, tg_, ps_, cb_, ws);
              for (int hA = 0; hA < 16; hA += 2) {
                  rk::chunk_pair(F.lds + RING_OFF, F.wave, tile, hA, nin, hA + 2 < 16, args.in[11], args.in[19], ws); } }
            __syncthreads();
        }
        if (BOTH(2)) xcd_barrier(bar);
    }
    if (PROBE_K == 2) tk_ = __builtin_amdgcn_s_memrealtime();
    if (PROBE_J == 2) t0_ = __builtin_amdgcn_s_memrealtime();
    if (IN(3)) {
        if (F.vcu < 64) rk::scan_unit(F.lds + RING_OFF, F.wave, F.vcu, ws + WS_CHK, (const float*)(ws + WS_BONUS), PROJ16, args.in[11], G16, args.in[20], args.in[21], Y16);
        {
            const float lam = *(const float*)(ws + WS_LAM);
            volatile LAS unsigned* qslot = F.MISC + 12;
            const float* wg = args.in[29]; const float* wu = args.in[30]; const float* wd = args.in[31];
            auto conv_batch = [&]() -> bool {
                __syncthreads();
                if (FTID == 0) qslot[1] = __hip_atomic_fetch_add(F.ctl + CW_CONVQ, 1u, __ATOMIC_RELAXED, __HIP_MEMORY_SCOPE_AGENT);
                __syncthreads();
                const int q = (int)__builtin_amdgcn_readfirstlane(qslot[1]);
                if (q >= NE * 1536 / 64) return false;
                LAS unsigned char* scr = F.lds + RING_OFF + F.wave * 16384;
                tpd_stream(q * 64 + F.wave, q * 64 + 64, 8, [=](int it) { const int e = it / 1536, r = it % 1536;
                    if (r < 1024) { const int rr = r & 511, nb = rr % 16; return TpDesc{(r < 512 ? wg : wu) + (size_t)e * D * 512, GUT + (size_t)e * 1024 * D, D, 512, 128 * (nb >> 2) + (r < 512 ? 0 : 128), rr}; }
                    return TpDesc{wd + (size_t)e * 512 * D, DNT + (size_t)e * D * 512, 512, D, 0, r - 1024}; }, scr, FLANE);
                return true;
            };
            int credit = 0;
            for (;;) {
                __syncthreads();
                if (FTID == 0) *qslot = __hip_atomic_fetch_add(F.ctl + CW_ATTQ, 1u, __ATOMIC_RELAXED, __HIP_MEMORY_SCOPE_AGENT);
                __syncthreads();
                const int u = (int)__builtin_amdgcn_readfirstlane(*qslot);
                if (u >= 512) break;
                const int qb = 15 - (u >> 5), bh = u & 31;
                att::attn_unit<8>(F.lds + RING_OFF, F.wave, bh >> 3, bh & 7, qb, PROJ16, Y16, (const float*)(ws + WS_BIAS) + (bh & 7) * 129, lam, args.in[10]);
                credit += 2 * (qb + 1) * CONV_RATE;
                while (credit >= 8704) { credit -= 8704; if (!conv_batch()) { credit = 0; break; } }
            }
            while (conv_batch()) {}
        }
        if (BOTH(3)) xcd_barrier(bar);
    }
    if (PROBE_K == 3) tk_ = __builtin_amdgcn_s_memrealtime();
    if (PROBE_J == 3) t0_ = __builtin_amdgcn_s_memrealtime();
    if (IN(4)) {
        for (int i = blockIdx.x * 512 + FTID; i < 36 * D; i += F.G * 512) { const int e = i / D, d = i % D; RT[i] = e < 4 ? args.in[25][d * 4 + e] : args.in[27][d * 32 + (e - 4)]; }
        pg8::Gemm g{Y16, WoutT, T, D, D, D}; pg8::StaticOrder S; S.init(T, D, F.G, (int)blockIdx.x);
        pg8::EpiResLN E{args.in[0], args.out, D, ALPHA, (const float2*)(ws + WS_ROWST), args.in[2], args.in[3]};
        pg8::gemm_phase<pg8::EpiResLN, pg8::StaticOrder, true>(F.lds + RING_OFF, g, S, E, F.wave);
        if (BOTH(4)) xcd_barrier(bar);
    }
    if (PROBE_K == 4) tk_ = __builtin_amdgcn_s_memrealtime();
    if (PROBE_J == 4) t0_ = __builtin_amdgcn_s_memrealtime();
    if (IN(5)) for (int rep_ = 0; rep_ < REP_P5; ++rep_) {
        const bool dry = rep_ < REP_P5 - 1;
        f16_t* o16b = dry ? (f16_t*)(ws + WS_CHK + 64 * MiB) : H1_16;
        const int lane = FLANE, tid = F.wave * 64 + lane;
        LAS float* rtb = (LAS float*)(F.lds + RING_OFF);
        LAS float* lg = (LAS float*)(F.lds + RING_OFF + 49152) + F.wave * 256;
        if (F.vcu < T / 32) {
            const int r0 = F.vcu * 32 + F.wave * 4;
            f32x4 v0[8], v1[8], v2[8], v3[8];
            { const GAS f32x4* xr = (const GAS f32x4*)(args.out + (size_t)r0 * D) + lane;
#pragma unroll
              for (int j = 0; j < 8; ++j) { v0[j] = xr[64 * j]; v1[j] = xr[64 * j + D / 4]; v2[j] = xr[64 * j + 2 * (D / 4)]; v3[j] = xr[64 * j + 3 * (D / 4)]; } }
            ln_norm(lane, v0, args.in[23], args.in[24]); ln_norm(lane, v1, args.in[23], args.in[24]); asm volatile("" ::: "memory"); ln_norm(lane, v2, args.in[23], args.in[24]); ln_norm(lane, v3, args.in[23], args.in[24]);
            f32x4 stg[6];
#pragma unroll
            for (int i = 0; i < 6; ++i) stg[i] = *(const GAS f32x4*)(RT + 4 * (tid + 512 * i));
#pragma unroll 1
            for (int ec = 0; ec < 6; ++ec) {
                __syncthreads();
#pragma unroll
                for (int i = 0; i < 6; ++i) *(LAS f32x4*)(rtb + 4 * (tid + 512 * i)) = stg[i];
                { const int en = ec + 1 < 6 ? ec + 1 : ec;
#pragma unroll
                  for (int i = 0; i < 6; ++i) stg[i] = *(const GAS f32x4*)(RT + (size_t)en * 6 * D + 4 * (tid + 512 * i)); }
                __syncthreads();
                float a0[6], a1[6], a2[6], a3[6];
#pragma unroll
                for (int e = 0; e < 6; ++e) { a0[e] = 0.f; a1[e] = 0.f; a2[e] = 0.f; a3[e] = 0.f; }
#pragma unroll
                for (int j = 0; j < 8; ++j)
#pragma unroll
                    for (int e = 0; e < 6; ++e) { const f32x4 w = *(const LAS f32x4*)(rtb + e * D + 256 * j + 4 * lane);
                        a0[e] += (v0[j].x * w.x + v0[j].y * w.y) + (v0[j].z * w.z + v0[j].w * w.w);
                        a1[e] += (v1[j].x * w.x + v1[j].y * w.y) + (v1[j].z * w.z + v1[j].w * w.w);
                        a2[e] += (v2[j].x * w.x + v2[j].y * w.y) + (v2[j].z * w.z + v2[j].w * w.w);
                        a3[e] += (v3[j].x * w.x + v3[j].y * w.y) + (v3[j].z * w.z + v3[j].w * w.w); }
#pragma unroll
                for (int e = 0; e < 6; ++e) { a0[e] = wsum64(a0[e]); a1[e] = wsum64(a1[e]); a2[e] = wsum64(a2[e]); a3[e] = wsum64(a3[e]); }
                if (lane == 0) {
#pragma unroll
                    for (int e = 0; e < 6; ++e) { lg[ec * 6 + e] = a0[e]; lg[64 + ec * 6 + e] = a1[e]; lg[128 + ec * 6 + e] = a2[e]; lg[192 + ec * 6 + e] = a3[e]; } }
            }
            LDS_WAIT();
            if (lane < 4 && !dry) { float aa[36];
#pragma unroll
                for (int e = 0; e < 36; ++e) aa[e] = lg[lane * 64 + e];
                route_token(r0 + lane, aa, args.in[26], args.in[28], cnt, ltok, lpair, pairw); }
            LDS_WAIT();
            ln_store16(lane, v0, o16b + (size_t)r0 * D); ln_store16(lane, v1, o16b + (size_t)(r0 + 1) * D);
            ln_store16(lane, v2, o16b + (size_t)(r0 + 2) * D); ln_store16(lane, v3, o16b + (size_t)(r0 + 3) * D);
        }
        if (BOTH(5) && !dry) xcd_barrier(bar); else __syncthreads();
    }
    if (PROBE_K == 5) tk_ = __builtin_amdgcn_s_memrealtime();
    if (PROBE_J == 5) t0_ = __builtin_amdgcn_s_memrealtime();
    if (IN(6)) {
        build_moe_table(F, cnt);
        pg8::Gemm g{H1_16, GUT, 0, 0, D, D}; pg8::MoeOrder<true> S{(const LAS int*)(F.lds + TAB_OFF), ltok, F.vcu, F.G, 4, (size_t)1024 * D * 2, 0};
        pg8::EpiGU E{HID};
        for (int rep_ = 0; rep_ < REP_P6; ++rep_) pg8::gemm_phase<pg8::EpiGU, pg8::MoeOrder<true>, true>(F.lds + RING_OFF, g, S, E, F.wave);
        if (BOTH(6)) xcd_barrier(bar);
    }
    if (PROBE_K == 6) tk_ = __builtin_amdgcn_s_memrealtime();
    if (PROBE_J == 6) t0_ = __builtin_amdgcn_s_memrealtime();
    if (IN(7)) {
        build_moe_table(F, cnt);
        const pg8::Gemm gU{H1_16, GUT, 0, 0, D, D}; const pg8::Gemm gD{HID, DNT, 0, 0, 512, 512};
        const pg8::EpiGU EU{HID}; const pg8::EpiDown ED{FFN16, lpair};
        if (F.vcu < 64) { pg8::MoeOrder<true> S{(const LAS int*)(F.lds + TAB_OFF), ltok, F.vcu, 64, 4, (size_t)1024 * D * 2, 1};
            pg8::gemm_phase<pg8::EpiGU, pg8::MoeOrder<true>, true>(F.lds + RING_OFF, gU, S, EU, F.wave); }
        else { pg8::MoeOrder<false> S{(const LAS int*)(F.lds + TAB_OFF), nullptr, F.vcu - 64, F.G - 64, 8, (size_t)D * 512 * 2, 0};
            pg8::gemm_phase<pg8::EpiDown, pg8::MoeOrder<false>, true>(F.lds + RING_OFF, gD, S, ED, F.wave); }
        xcd_barrier(bar);
        { pg8::MoeOrder<false> S{(const LAS int*)(F.lds + TAB_OFF), nullptr, F.vcu, F.G, 8, (size_t)D * 512 * 2, 1};
          pg8::gemm_phase<pg8::EpiDown, pg8::MoeOrder<false>, true>(F.lds + RING_OFF, gD, S, ED, F.wave); }
        if (BOTH(7)) xcd_barrier(bar);
    }
    if (PROBE_K == 7) tk_ = __builtin_amdgcn_s_memrealtime();
    if (PROBE_J == 7) t0_ = __builtin_amdgcn_s_memrealtime();
    if (IN(8)) for (int rep_ = 0; rep_ < REP_P8; ++rep_) {
        const bool dry = rep_ < REP_P8 - 1;
        f16_t* o16b = dry ? (f16_t*)(ws + WS_GUT + 64 * MiB) : Y16; float* rrs = dry ? (float*)(ws + WS_GUT + 100 * MiB) : ROWRS;
        typedef _Float16 h4_t __attribute__((ext_vector_type(4)));
        const int lane = FLANE;
        for (int m = gw; m < T; m += NGW) {
            f32x4 v[8]; const GAS f32x4* xr = (const GAS f32x4*)(args.out + (size_t)m * D) + lane;
            const GAS h4_t* f0 = (const GAS h4_t*)(FFN16 + (size_t)(2 * m) * D) + lane; const GAS h4_t* f1 = (const GAS h4_t*)(FFN16 + (size_t)(2 * m + 1) * D) + lane;
            const GAS h4_t* pr = (const GAS h4_t*)(PW16 + (size_t)m * D) + lane;
            const float w0 = pairw[2 * m], w1 = pairw[2 * m + 1]; float q = 0.f;
#pragma unroll
            for (int j = 0; j < 8; ++j) v[j] = xr[64 * j];
            ln_norm(lane, v, args.in[23], args.in[24]);
#pragma unroll
            for (int j = 0; j < 8; ++j) { const f32x4 x = v[j]; const h4_t a = f0[64 * j], c = f1[64 * j], pv = pr[64 * j];
                v[j].x = ALPHA * x.x + w0 * (float)a[0] + w1 * (float)c[0]; v[j].y = ALPHA * x.y + w0 * (float)a[1] + w1 * (float)c[1];
                v[j].z = ALPHA * x.z + w0 * (float)a[2] + w1 * (float)c[2]; v[j].w = ALPHA * x.w + w0 * (float)a[3] + w1 * (float)c[3];
                q += ((float)pv[0] * (float)pv[0] + (float)pv[1] * (float)pv[1]) + ((float)pv[2] * (float)pv[2] + (float)pv[3] * (float)pv[3]); }
            ln_norm(lane, v, args.in[32], args.in[33]); ln_store16(lane, v, o16b + (size_t)m * D);
            q = wave_sum_b(q);
            if (lane == 0) rrs[m] = __builtin_amdgcn_rsqf(q * (1.f / D) + LN_EPS);
        }
        if (BOTH(8) && !dry) xcd_barrier(bar); else __syncthreads();
    }
    if (PROBE_K == 8) tk_ = __builtin_amdgcn_s_memrealtime();
    if (PROBE_J == 8) t0_ = __builtin_amdgcn_s_memrealtime();
    if (IN(9)) {
        pg8::Gemm g{Y16, GateT, T, D, D, D}; pg8::StaticOrder S; S.init(T, D, F.G, (int)blockIdx.x);
        pg8::EpiFinal E{args.out, D, Y16, PW16, ROWRS, args.in[35]};
        pg8::gemm_phase<pg8::EpiFinal, pg8::StaticOrder, true>(F.lds + RING_OFF, g, S, E, F.wave);
    }
    if (PROBE_K != -1) {
        if (PROBE_K == 9) tk_ = __builtin_amdgcn_s_memrealtime();
        xcd_barrier(bar);
        if (blockIdx.x == 0 && FTID == 0) args.out[0] += (PROBE_K == -2) ? 100000.f : (float)(tk_ - t0_) * PROBE_SCALE;
    }
#undef IN
#undef BOTH
}

extern "C" void kernel_launch(void* const* d_in, const int* in_sizes, int n_in, void* d_out, int out_size, void* d_ws, size_t ws_size, hipStream_t stream) {
    static int grid = 0;
    if (grid == 0) {
        if (ws_size < WS_END2 || n_in != 37 || out_size != T * D) { fprintf(stderr, "kernel_launch: bad ws/n_in/out: %zu %d %d\n", ws_size, n_in, out_size); grid = -1; return; }
        int dev = 0, cus = 0;
        if (hipGetDevice(&dev) != hipSuccess || hipDeviceGetAttribute(&cus, hipDeviceAttributeMultiprocessorCount, dev) != hipSuccess) { grid = -1; return; }
        if (hipFuncSetAttribute((const void*)mega_fwd, hipFuncAttributeMaxDynamicSharedMemorySize, LDS_BYTES) != hipSuccess) { fprintf(stderr, "kernel_launch: hipFuncSetAttribute failed\n"); grid = -1; return; }
        if (cus != 256) { fprintf(stderr, "kernel_launch: built for a 256-CU device, found %d\n", cus); grid = -1; return; }
        grid = cus;
    }
    if (grid < 0) return;
    (void)hipMemsetAsync(d_ws, 0, CTL_ZERO_BYTES, stream);
    Args a{}; for (int i = 0; i < 37; ++i) a.in[i] = (const float*)d_in[i]; a.out = (float*)d_out; a.ws = (unsigned char*)d_ws; a.ph_lo = 0; a.ph_hi = 10; a.li = 0;
    hipLaunchKernelGGL(mega_fwd, dim3(grid), dim3(NWAVES * 64), LDS_BYTES, stream, a);
}
```

```cpp
#include <hip/hip_runtime.h>
#include <cstdio>
#include <cstdint>
#include <cmath>

constexpr int NB = 4, S = 2048, D = 2048, T = NB * S;
constexpr int NPROJ = 6432;
constexpr int RWK = 1024;
constexpr int COL_Q = 0, COL_K = 1024, COL_V = 2048, COL_RW = 3072;
constexpr int NH = 8, NRH = 16;
constexpr int NE = 32;
constexpr float LN_EPS = 1e-5f;
constexpr float ALPHA = 1.189207115002721f;
constexpr float LAMBDA_INIT = 0.2f;

constexpr size_t MiB = 1u << 20;
constexpr size_t WS_CNT = 4096;
constexpr int CNT_STRIDE = 32;
constexpr size_t WS_LTOK = 1 * MiB;
constexpr size_t WS_LPAIR = 2 * MiB;
constexpr size_t WS_PAIRW = 3 * MiB;
constexpr size_t WS_RT = 3 * MiB + 128 * 1024;
constexpr size_t WS_LAM = 3 * MiB + 512 * 1024;
constexpr size_t WS_BIAS = 3 * MiB + 512 * 1024 + 1024;
constexpr size_t WS_ROWRS = 3 * MiB + 768 * 1024;
constexpr size_t WS_ROWST = 3 * MiB + 832 * 1024;
constexpr size_t WS_WINT = 4 * MiB;
constexpr size_t WS_WOUTT = 30 * MiB;
constexpr size_t WS_GATET = 38 * MiB;
constexpr size_t WS_PLET = 46 * MiB;
constexpr size_t WS_P16 = 47 * MiB;
constexpr size_t WS_W2T = 51 * MiB;
constexpr size_t WS_A2T = 51 * MiB + 128 * 1024;
constexpr size_t WS_G2T = 51 * MiB + 256 * 1024;
constexpr size_t WS_CHK = 52 * MiB;
constexpr size_t WS_BONUS = 148 * MiB;
constexpr size_t WS_LSLAB = 150 * MiB;
constexpr size_t WS_GUT = 348 * MiB;
constexpr size_t WS_DNT = 150 * MiB;
constexpr size_t WS_PROJ16 = 244 * MiB;
constexpr size_t WS_FFN16 = 52 * MiB;
constexpr size_t WS_HID = 116 * MiB;
constexpr size_t WS_DECAY = 348 * MiB;
constexpr size_t WS_KMOD = 380 * MiB;
constexpr size_t WS_A16 = 396 * MiB;
constexpr size_t WS_B16 = 412 * MiB;
constexpr size_t WS_G16 = 214 * MiB;
constexpr size_t WS_H16 = 444 * MiB;
constexpr size_t WS_H1_16 = 244 * MiB;
constexpr size_t WS_Y16 = 476 * MiB;
constexpr size_t WS_PW16 = 508 * MiB;
constexpr size_t WS_END2 = 540 * MiB;

namespace pg8 {
#define PG8_LAS __attribute__((address_space(3)))
typedef unsigned short f16_t;
typedef _Float16 f16x8 __attribute__((ext_vector_type(8)));
typedef float f32x4 __attribute__((ext_vector_type(4)));
typedef unsigned u32x4 __attribute__((ext_vector_type(4)));
constexpr int BM = 256, BK = 64, HALF = 128, HTB = HALF * BK * 2  , STAGE_BYTES = 8 * HTB, NXCD = 8, WGM = 8;

__host__ __device__ __forceinline__ int lds_byte(int r, int c) { const int st = (r >> 4) * 2 + (c >> 5), rr = r & 15, cc = c & 31, ob = rr * 64 + cc * 2; return st * 1024 + (ob ^ (((ob >> 9) & 1) << 5)); }
__host__ __device__ __forceinline__ void stage_rc(int b, int& R, int& C) { const int st = b / 1024, sb = b % 1024, swz = sb ^ (((sb >> 9) & 1) << 5); R = (st >> 1) * 16 + swz / 64; C = (st & 1) * 32 + (swz % 64) / 2; }
__host__ __device__ __forceinline__ int perm32(int rho) { const int n = rho >> 4, i = rho & 15; return 8 * (i >> 2) + 4 * n + (i & 3); }

__device__ __forceinline__ int lane_id() { int l; asm volatile("v_mbcnt_lo_u32_b32 %0, -1, 0\n\tv_mbcnt_hi_u32_b32 %0, -1, %0" : "=v"(l)); return l; }
struct Unit { int pm, pn, e, rb, cnt; };
struct Gemm { const f16_t* A; const f16_t* Bt; int M, N, K, ld; };

struct StaticOrder {
    int nM, nN, nwg, G, c;
    __host__ __device__ void init(int M, int N, int G_, int c_) { nM = M / BM; nN = N / BM; nwg = nM * nN; G = G_; c = c_; }
    __host__ __device__ bool next(int i, Unit& u) const {
        const long L = (long)i * G + c; if (L >= nwg) return false;
        int wgid = (int)L; { const int q = nwg / NXCD, r = nwg % NXCD, xcd = wgid % NXCD, off = wgid / NXCD; wgid = (xcd < r ? xcd * (q + 1) : r * (q + 1) + (xcd - r) * q) + off; }
        const int nig = WGM * nN, gid = wgid / nig, fm = gid * WGM, gsz = (nM - fm) < WGM ? (nM - fm) : WGM;
        u.pm = fm + ((wgid % nig) % gsz); u.pn = (wgid % nig) / gsz; return true;
    }
    __device__ __forceinline__ void a_ready(const Unit&) const {}
    __device__ __forceinline__ void done(const Unit&) const {}
    __device__ __forceinline__ const char* a_base(const Gemm& g, const Unit& u) const { return (const char*)g.A + (size_t)u.pm * ((size_t)BM * g.ld * 2); }
    __device__ __forceinline__ const char* b_base(const Gemm& g, const Unit& u) const { return (const char*)g.Bt + (size_t)u.pn * ((size_t)BM * g.ld * 2); }
    __device__ __forceinline__ void a_voff(const Gemm& g, const Unit&, int tid, unsigned (&va)[2][2]) const {
#pragma unroll
        for (int i = 0; i < 2; ++i) { int R, C; stage_rc(tid * 16 + i * 8192, R, C); va[0][i] = (unsigned)(R * g.ld + C) * 2u; va[1][i] = va[0][i] + (unsigned)(HALF * g.ld * 2); }
    }
};
struct SplitKOrder {
    int nM, nN, nks, G, c;
    __device__ __forceinline__ bool next(int i, Unit& u) const { const int L = i * G + c; if (L >= nM * nN * nks) return false; u.e = L / (nM * nN); const int rem = L % (nM * nN); u.pn = rem / nM; u.pm = rem % nM; u.rb = 0; u.cnt = 0; return true; }
    __device__ __forceinline__ void a_ready(const Unit&) const {}
    __device__ __forceinline__ void done(const Unit&) const {}
    __device__ __forceinline__ const char* a_base(const Gemm& g, const Unit& u) const { return (const char*)g.A + (size_t)u.pm * ((size_t)BM * g.ld * 2) + (size_t)u.e * g.K * 2; }
    __device__ __forceinline__ const char* b_base(const Gemm& g, const Unit& u) const { return (const char*)g.Bt + (size_t)u.pn * ((size_t)BM * g.ld * 2) + (size_t)u.e * g.K * 2; }
    __device__ __forceinline__ void a_voff(const Gemm& g, const Unit&, int tid, unsigned (&va)[2][2]) const {
#pragma unroll
        for (int i = 0; i < 2; ++i) { int R, C; stage_rc(tid * 16 + i * 8192, R, C); va[0][i] = (unsigned)(R * g.ld + C) * 2u; va[1][i] = va[0][i] + (unsigned)(HALF * g.ld * 2); }
    }
};
template <bool GATHER> struct MoeOrder {
    const PG8_LAS int* tab; const int* list; int vcu, G, ntn; size_t estride; int cls;
    __device__ __forceinline__ bool next(int i, Unit& u) const {
        const int L = vcu + i * G; const int base = cls ? 98 : 65; const int tot = tab[base + 32] * ntn; if (L >= tot) return false;
        int e = 0; while (tab[base + 1 + e] * ntn <= L) ++e;
        const int nbk = tab[base + 1 + e] - tab[base + e], q = L - tab[base + e] * ntn; const int rb = q % nbk + (cls ? 2 : 0);
        u.e = __builtin_amdgcn_readfirstlane(e); u.pn = __builtin_amdgcn_readfirstlane(q / nbk); u.rb = __builtin_amdgcn_readfirstlane(rb);
        u.pm = __builtin_amdgcn_readfirstlane(tab[32 + e] + rb); u.cnt = __builtin_amdgcn_readfirstlane(tab[e]); return true;
    }
    __device__ __forceinline__ void a_ready(const Unit&) const {}
    __device__ __forceinline__ void done(const Unit&) const {}
    __device__ __forceinline__ const char* a_base(const Gemm& g, const Unit& u) const { return GATHER ? (const char*)g.A : (const char*)g.A + (size_t)u.pm * ((size_t)BM * g.ld * 2); }
    __device__ __forceinline__ const char* b_base(const Gemm& g, const Unit& u) const { return (const char*)g.Bt + (size_t)u.e * estride + (size_t)u.pn * ((size_t)BM * g.ld * 2); }
    __device__ __forceinline__ void a_voff(const Gemm& g, const Unit& u, int tid, unsigned (&va)[2][2]) const {
#pragma unroll
        for (int i = 0; i < 2; ++i) { int R, C; stage_rc(tid * 16 + i * 8192, R, C);
            if (GATHER) {
#pragma unroll
                for (int h = 0; h < 2; ++h) { int idx = u.rb * BM + h * HALF + R; idx = idx < u.cnt ? idx : u.cnt - 1; const int tok = list[u.e * 8192 + idx]; va[h][i] = (unsigned)(tok * g.ld + C) * 2u; }
            } else { va[0][i] = (unsigned)(R * g.ld + C) * 2u; va[1][i] = va[0][i] + (unsigned)(HALF * g.ld * 2); } }
    }
};


typedef _Float16 h2_t __attribute__((ext_vector_type(2)));
__device__ __forceinline__ unsigned cvt_pk_f16(float lo, float hi) { h2_t v = {(_Float16)lo, (_Float16)hi}; return __builtin_bit_cast(unsigned, v); }
struct EpiF16 {
    static constexpr bool PERM = true, AFTER_DRAIN = false;
    f16_t* O; int ldc; int ntile0; float scale0;
    __device__ __forceinline__ void operator()(const f32x4 (&acc)[2][2][4][2], const Unit& u, int wr, int wc, int fr, int fq) const {
        const int row0 = u.pm * BM + wr * 64 + fr; const int col0 = u.pn * BM + wc * 32 + 8 * fq;
        const float sc = (u.pn < ntile0) ? scale0 : 1.f;
#pragma unroll
        for (int ai = 0; ai < 2; ++ai)
#pragma unroll
            for (int m = 0; m < 4; ++m) { f16_t* rowp = O + (size_t)(row0 + ai * HALF + m * 16) * ldc + col0;
#pragma unroll
                for (int bj = 0; bj < 2; ++bj) { f32x4 v0 = acc[ai][bj][m][0] * sc, v1 = acc[ai][bj][m][1] * sc;
                    u32x4 w; w.x = cvt_pk_f16(v0[0], v0[1]); w.y = cvt_pk_f16(v0[2], v0[3]); w.z = cvt_pk_f16(v1[0], v1[1]); w.w = cvt_pk_f16(v1[2], v1[3]);
                    *(u32x4*)(rowp + bj * HALF) = w; } }
    }
};


struct EpiSlab {
    static constexpr bool PERM = true, AFTER_DRAIN = false;
    f16_t* O; int ldc; size_t slab;
    __device__ __forceinline__ void operator()(const f32x4 (&acc)[2][2][4][2], const Unit& u, int wr, int wc, int fr, int fq) const {
        const int row0 = u.pm * BM + wr * 64 + fr; const int col0 = u.pn * BM + wc * 32 + 8 * fq; f16_t* Ob = O + (size_t)u.e * slab;
#pragma unroll
        for (int ai = 0; ai < 2; ++ai)
#pragma unroll
            for (int m = 0; m < 4; ++m) { f16_t* rowp = Ob + (size_t)(row0 + ai * HALF + m * 16) * ldc + col0;
#pragma unroll
                for (int bj = 0; bj < 2; ++bj) { const f32x4 v0 = acc[ai][bj][m][0], v1 = acc[ai][bj][m][1];
                    u32x4 w; w.x = cvt_pk_f16(v0[0], v0[1]); w.y = cvt_pk_f16(v0[2], v0[3]); w.z = cvt_pk_f16(v1[0], v1[1]); w.w = cvt_pk_f16(v1[2], v1[3]);
                    *(u32x4*)(rowp + bj * HALF) = w; } }
    }
};
struct EpiResF32 {
    static constexpr bool PERM = false, AFTER_DRAIN = false;
    float* io; int ldc; float alpha;
    __device__ __forceinline__ void operator()(const f32x4 (&acc)[2][2][4][2], const Unit& u, int wr, int wc, int fr, int fq) const {
        const int row0 = u.pm * BM + wr * 64 + fr; const int col0 = u.pn * BM + wc * 32 + 4 * fq;
#pragma unroll
        for (int ai = 0; ai < 2; ++ai)
#pragma unroll
            for (int m = 0; m < 4; ++m) { float* rowp = io + (size_t)(row0 + ai * HALF + m * 16) * ldc + col0;
#pragma unroll
                for (int bj = 0; bj < 2; ++bj)
#pragma unroll
                    for (int n = 0; n < 2; ++n) { f32x4* p = (f32x4*)(rowp + bj * HALF + n * 16); const f32x4 r = *p; *p = r * alpha + acc[ai][bj][m][n]; } }
    }
};
struct EpiResLN {
    static constexpr bool PERM = false, AFTER_DRAIN = false;
    const float* x; float* out; int ldc; float alpha; const float2* st; const float* g; const float* b;
    __device__ __forceinline__ void operator()(const f32x4 (&acc)[2][2][4][2], const Unit& u, int wr, int wc, int fr, int fq) const {
        const int row0 = u.pm * BM + wr * 64 + fr; const int col0 = u.pn * BM + wc * 32 + 4 * fq;
        f32x4 gg[2][2], bb[2][2];
#pragma unroll
        for (int bj = 0; bj < 2; ++bj)
#pragma unroll
            for (int n = 0; n < 2; ++n) { gg[bj][n] = *(const f32x4*)(g + col0 + bj * HALF + n * 16); bb[bj][n] = *(const f32x4*)(b + col0 + bj * HALF + n * 16); }
#pragma unroll
        for (int ai = 0; ai < 2; ++ai)
#pragma unroll
            for (int m = 0; m < 4; ++m) { const int row = row0 + ai * HALF + m * 16; const float2 ms = st[row];
                const float* xp = x + (size_t)row * ldc + col0; float* op = out + (size_t)row * ldc + col0;
#pragma unroll
                for (int bj = 0; bj < 2; ++bj)
#pragma unroll
                    for (int n = 0; n < 2; ++n) { const f32x4 r = *(const f32x4*)(xp + bj * HALF + n * 16);
                        const f32x4 h = (r - ms.x) * ms.y * gg[bj][n] + bb[bj][n]; *(f32x4*)(op + bj * HALF + n * 16) = h * alpha + acc[ai][bj][m][n]; } }
    }
};
struct EpiFinal {
    static constexpr bool PERM = false, AFTER_DRAIN = false;
    float* out; int ldc; const f16_t* h2; const f16_t* pw; const float* rowrs; const float* g;
    __device__ __forceinline__ void operator()(const f32x4 (&acc)[2][2][4][2], const Unit& u, int wr, int wc, int fr, int fq) const {
        typedef _Float16 h4_t __attribute__((ext_vector_type(4)));
        const int row0 = u.pm * BM + wr * 64 + fr; const int col0 = u.pn * BM + wc * 32 + 4 * fq;
#pragma unroll
        for (int ai = 0; ai < 2; ++ai)
#pragma unroll
            for (int m = 0; m < 4; ++m) { const int row = row0 + ai * HALF + m * 16; const size_t off = (size_t)row * ldc + col0;
                const float rs = rowrs[row];
#pragma unroll
                for (int bj = 0; bj < 2; ++bj)
#pragma unroll
                    for (int n = 0; n < 2; ++n) { const h4_t hv = *(const h4_t*)(h2 + off + bj * HALF + n * 16); const h4_t pv = *(const h4_t*)(pw + off + bj * HALF + n * 16);
                        const f32x4 gv = *(const f32x4*)(g + col0 + bj * HALF + n * 16);
                        const f32x4 a = acc[ai][bj][m][n]; f32x4 o;
#pragma unroll
                        for (int c = 0; c < 4; ++c) o[c] = (float)hv[c] + (1.f / (1.f + __expf(-a[c]))) * ((float)pv[c] * rs) * gv[c];
                        *(f32x4*)(out + off + bj * HALF + n * 16) = o; }
                asm volatile("" ::: "memory"); }
    }
};

struct EpiGU {
    static constexpr bool PERM = true, AFTER_DRAIN = false;
    f16_t* O;
    __device__ __forceinline__ void operator()(const f32x4 (&acc)[2][2][4][2], const Unit& u, int wr, int wc, int fr, int fq) const {
        const int row0 = u.pm * BM + wr * 64 + fr; const int col0 = u.pn * HALF + wc * 32 + 8 * fq;
#pragma unroll
        for (int ai = 0; ai < 2; ++ai)
#pragma unroll
            for (int m = 0; m < 4; ++m) { f16_t* rowp = O + (size_t)(row0 + ai * HALF + m * 16) * 512 + col0; float o[8];
#pragma unroll
                for (int n = 0; n < 2; ++n)
#pragma unroll
                    for (int c = 0; c < 4; ++c) { const float gt = acc[ai][0][m][n][c], up = acc[ai][1][m][n][c]; o[n * 4 + c] = gt / (1.f + __expf(-gt)) * up; }
                u32x4 w; w.x = cvt_pk_f16(o[0], o[1]); w.y = cvt_pk_f16(o[2], o[3]); w.z = cvt_pk_f16(o[4], o[5]); w.w = cvt_pk_f16(o[6], o[7]);
                *(u32x4*)rowp = w; }
    }
};
struct EpiDown {
    static constexpr bool PERM = true, AFTER_DRAIN = false;
    f16_t* O; const int* lpair;
    __device__ __forceinline__ void operator()(const f32x4 (&acc)[2][2][4][2], const Unit& u, int wr, int wc, int fr, int fq) const {
        const int r0 = u.rb * BM + wr * 64 + fr; const int col0 = u.pn * BM + wc * 32 + 8 * fq;
#pragma unroll
        for (int ai = 0; ai < 2; ++ai)
#pragma unroll
            for (int m = 0; m < 4; ++m) { const int r = r0 + ai * HALF + m * 16;
                if (r < u.cnt) { const int pair = lpair[u.e * 8192 + r]; f16_t* rowp = O + (size_t)pair * 2048 + col0;
#pragma unroll
                    for (int bj = 0; bj < 2; ++bj) { const f32x4 v0 = acc[ai][bj][m][0], v1 = acc[ai][bj][m][1];
                        u32x4 w; w.x = cvt_pk_f16(v0[0], v0[1]); w.y = cvt_pk_f16(v0[2], v0[3]); w.z = cvt_pk_f16(v1[0], v1[1]); w.w = cvt_pk_f16(v1[2], v1[3]);
                        *(u32x4*)(rowp + bj * HALF) = w; } } }
    }
};
template <class Epi, class Sched, bool ALIGN_EPI = false, bool SP2 = true>
__device__ __forceinline__ void gemm_phase(PG8_LAS unsigned char* lds, const Gemm g, const Sched& S, const Epi& E, const int wid) {
    static_assert(SP2, "only the SP2 K-loop is kept in this file");
    const int lane = lane_id(), tid = wid * 64 + lane, wr = wid >> 2, wc = wid & 3, fr = lane & 15, fq = lane >> 4;
    const int K = g.ld, nt = g.K / BK;
    unsigned voffB[2];
#pragma unroll
    for (int i = 0; i < 2; ++i) { int R, C; stage_rc(tid * 16 + i * 8192, R, C); const int Rb = Epi::PERM ? ((R & ~31) + perm32(R & 31)) : R;
        voffB[i] = (unsigned)(Rb * K + C) * 2u; }
    const size_t kstep = (size_t)(BK * 2);
    const size_t hstep = (size_t)HALF * K * 2;
    const unsigned ldsw = (unsigned)wid * 1024u;
    const int aoff = lds_byte(wr * 64 + fr, fq * 8), boff = lds_byte(wc * 32 + fr, fq * 8);
#define PG8_SA(b, h) (((b) * 2 + (h)) * HTB)
#define PG8_SB(b, h) ((4 + (b) * 2 + (h)) * HTB)
#define PG8_STAGE(bufoff, gbase, voff) do { _Pragma("unroll") for (int _i = 0; _i < 2; ++_i) \
        __builtin_amdgcn_global_load_lds((const unsigned*)((const char*)(gbase) + (voff)[_i]), (PG8_LAS unsigned*)(lds + (bufoff) + ldsw + _i * 8192), 16, 0, 0); } while (0)
#define PG8_LDA(dst, b, h) do { _Pragma("unroll") for (int m = 0; m < 4; ++m) _Pragma("unroll") for (int k = 0; k < 2; ++k) dst[m][k] = *(const PG8_LAS f16x8*)(lds + PG8_SA(b, h) + aoff + m * 2048 + k * 1024); } while (0)
#define PG8_LDB(dst, b, h) do { _Pragma("unroll") for (int n = 0; n < 2; ++n) _Pragma("unroll") for (int k = 0; k < 2; ++k) dst[n][k] = *(const PG8_LAS f16x8*)(lds + PG8_SB(b, h) + boff + n * 2048 + k * 1024); } while (0)
#define PG8_MMA(ai, bj, At, Bt) do { __builtin_amdgcn_s_setprio(1); _Pragma("unroll") for (int m = 0; m < 4; ++m) _Pragma("unroll") for (int n = 0; n < 2; ++n) _Pragma("unroll") for (int k = 0; k < 2; ++k) \
        acc[ai][bj][m][n] = __builtin_amdgcn_mfma_f32_16x16x32_f16(Bt[n][k], At[m][k], acc[ai][bj][m][n], 0, 0, 0); __builtin_amdgcn_s_setprio(0); } while (0)
#define PG8_WAIT_V(n) asm volatile("s_waitcnt vmcnt(" #n ")" ::: "memory")
#define PG8_WAIT_L(n) asm volatile("s_waitcnt lgkmcnt(" #n ")" ::: "memory")
#define PG8_BAR __builtin_amdgcn_s_barrier()
#define PG8_SCHED __builtin_amdgcn_sched_barrier(0)
    Unit cur, nxt; int ui = 0;
    if (!S.next(0, cur)) return;
    f32x4 acc[2][2][4][2];
#pragma unroll
    for (int a = 0; a < 2; ++a)
#pragma unroll
        for (int b = 0; b < 2; ++b)
#pragma unroll
            for (int m = 0; m < 4; ++m)
#pragma unroll
                for (int n = 0; n < 2; ++n) acc[a][b][m][n] = (f32x4){0.f, 0.f, 0.f, 0.f};
    f16x8 At[4][2], B0[2][2], B1[2][2];
    const char* cA = S.a_base(g, cur); const char* cB = S.b_base(g, cur);
    unsigned vaC[2][2];
    S.a_voff(g, cur, tid, vaC);
    S.a_ready(cur);
    PG8_STAGE(PG8_SB(0, 0), cB, voffB); PG8_STAGE(PG8_SB(0, 1), cB + hstep, voffB); PG8_STAGE(PG8_SA(0, 0), cA, vaC[0]); PG8_STAGE(PG8_SA(0, 1), cA, vaC[1]);
    if (wr == 1) PG8_BAR;
    PG8_WAIT_V(2); PG8_BAR;
    PG8_STAGE(PG8_SB(1, 0), cB + kstep, voffB); PG8_STAGE(PG8_SA(1, 0), cA + kstep, vaC[0]); PG8_STAGE(PG8_SB(1, 1), cB + hstep + kstep, voffB);
    PG8_WAIT_V(6); PG8_BAR;
    for (;;) {
        const bool has_next = S.next(ui + 1, nxt);
        const char* nA = has_next ? S.a_base(g, nxt) : cA; const char* nB = has_next ? S.b_base(g, nxt) : cB;
        for (int t = 0; t < nt; t += 2) {
            const bool last = (t == nt - 2);

            const char* a1 = cA + (size_t)(t + 1) * kstep;
            const char* a2 = last ? nA : cA + (size_t)(t + 2) * kstep; const char* b2 = last ? nB : cB + (size_t)(t + 2) * kstep;
            const char* a3 = a2 + kstep; const char* b3 = b2 + kstep;
            if (last && has_next) S.a_ready(nxt);
            PG8_LDB(B0, 0, 0); PG8_LDB(B1, 0, 1); PG8_SCHED; PG8_LDA(At, 0, 0); PG8_STAGE(PG8_SA(1, 1), a1, vaC[1]);
            if (last && has_next) S.a_voff(g, nxt, wid * 64 + lane_id(), vaC);
            PG8_WAIT_V(8); PG8_WAIT_L(0); PG8_BAR; PG8_MMA(0, 0, At, B0); PG8_MMA(0, 1, At, B1); PG8_BAR; PG8_SCHED;
            PG8_LDA(At, 0, 1); PG8_STAGE(PG8_SB(0, 0), b2, voffB); PG8_STAGE(PG8_SB(0, 1), b2 + hstep, voffB); PG8_STAGE(PG8_SA(0, 0), a2, vaC[0]);
            PG8_WAIT_V(8); PG8_WAIT_L(0); PG8_BAR; PG8_MMA(1, 0, At, B0); PG8_MMA(1, 1, At, B1); PG8_BAR; PG8_SCHED;
            PG8_LDB(B0, 1, 0); PG8_LDB(B1, 1, 1); PG8_SCHED; PG8_LDA(At, 1, 0); PG8_STAGE(PG8_SA(0, 1), a2, vaC[1]);
            PG8_WAIT_V(8); PG8_WAIT_L(0); PG8_BAR; PG8_MMA(0, 0, At, B0); PG8_MMA(0, 1, At, B1); PG8_BAR; PG8_SCHED;
            PG8_LDA(At, 1, 1); PG8_STAGE(PG8_SB(1, 0), b3, voffB); PG8_STAGE(PG8_SB(1, 1), b3 + hstep, voffB); PG8_STAGE(PG8_SA(1, 0), a3, vaC[0]);
            PG8_WAIT_V(8); PG8_WAIT_L(0); PG8_BAR; PG8_MMA(1, 0, At, B0); PG8_MMA(1, 1, At, B1); PG8_BAR; PG8_SCHED;
        }
        if constexpr (ALIGN_EPI) { if (wr == 0) PG8_BAR; }
        { const int l2 = lane_id(); E(acc, cur, wr, wc, l2 & 15, l2 >> 4); } S.done(cur);
        if (!has_next) break;
#pragma unroll
        for (int a = 0; a < 2; ++a)
#pragma unroll
            for (int b = 0; b < 2; ++b)
#pragma unroll
                for (int m = 0; m < 4; ++m)
#pragma unroll
                    for (int n = 0; n < 2; ++n) acc[a][b][m][n] = (f32x4){0.f, 0.f, 0.f, 0.f};
        cur = nxt; cA = nA; cB = nB; ++ui;
        if constexpr (ALIGN_EPI) { if (wr == 1) PG8_BAR; }
    }
    PG8_WAIT_V(0);
    if constexpr (!ALIGN_EPI) { if (wr == 0) PG8_BAR; }
    PG8_BAR;
#undef PG8_SA
#undef PG8_SB
#undef PG8_STAGE
#undef PG8_LDA
#undef PG8_LDB
#undef PG8_MMA
#undef PG8_WAIT_V
#undef PG8_WAIT_L
#undef PG8_BAR
#undef PG8_SCHED
}
}

constexpr int PN = 6656;
namespace att {
#define ALAS __attribute__((address_space(3)))
typedef _Float16 f16x8 __attribute__((ext_vector_type(8)));
typedef float f32x16 __attribute__((ext_vector_type(16)));
typedef short v4i16_t __attribute__((ext_vector_type(4)));
typedef unsigned u32x4 __attribute__((ext_vector_type(4)));
constexpr int SLOT = 16384, L_K = 0, L_V = 3 * SLOT, L_SCR = 6 * SLOT, L_TAB = L_SCR + 2048, L_END = L_TAB + 1024;
constexpr int L_XB = 0, L_STG = 65536;
constexpr float LOG2E = 1.4426950408889634f;
constexpr float C2 = 0.125f * LOG2E;
__device__ __forceinline__ int crow(int r, int hi) { return (r & 3) + 8 * (r >> 2) + 4 * hi; }
__device__ __forceinline__ void glds16(const void* g, ALAS unsigned char* l) { __builtin_amdgcn_global_load_lds((const unsigned*)g, (ALAS unsigned*)l, 16, 0, 0); }
__device__ __forceinline__ float xhalf(float v, int hi) { auto rr = __builtin_amdgcn_permlane32_swap(__float_as_uint(v), __float_as_uint(v), false, false); return hi ? __uint_as_float(rr[0]) : __uint_as_float(rr[1]); }
__device__ __forceinline__ unsigned pkh(float lo, float hi) { typedef _Float16 h2 __attribute__((ext_vector_type(2))); h2 v = {(_Float16)lo, (_Float16)hi}; return __builtin_bit_cast(unsigned, v); }
__device__ __forceinline__ v4i16_t vtr(const ALAS unsigned char* p) { return __builtin_amdgcn_ds_read_tr16_b64_v4i16((ALAS v4i16_t*)p); }

template <int THR>
__device__ __forceinline__ void attn_unit(ALAS unsigned char* lds, const int wave, const int b, const int h, const int qb, const unsigned short* PROJ, unsigned short* Y,
                                          const float* biasG, const float lam, const float* subln_g) {
    const int lane = pg8::lane_id(), r32 = lane & 31, hi = lane >> 5;
    const int c = wave >> 2, w4 = wave & 3;
    const int q0 = qb * 128, qw0 = q0 + 32 * w4, q = qw0 + r32;
    const size_t rowbase = (size_t)b * S;
    { ALAS float* tabL = (ALAS float*)(lds + L_TAB); const int tid = wave * 64 + lane; if (tid < 129) tabL[tid] = biasG[tid] * LOG2E; }
    f16x8 qf[4];
    { const unsigned short* Qp = PROJ + (rowbase + q) * PN + h * 128 + c * 64 + hi * 8;
#pragma unroll
      for (int d0 = 0; d0 < 4; ++d0) qf[d0] = *(const f16x8*)(Qp + d0 * 16); }
    const int krow0 = 8 * wave + (lane >> 4), krow1 = krow0 + 4;
    const unsigned short* ksrc0 = PROJ + (rowbase + krow0) * PN + 1024 + h * 128 + (((lane & 15) ^ (krow0 & 15)) * 8);
    const unsigned short* ksrc1 = PROJ + (rowbase + krow1) * PN + 1024 + h * 128 + (((lane & 15) ^ (krow1 & 15)) * 8);
    const unsigned short* vsrc0 = PROJ + (rowbase + 16 * ((2 * wave) & 3) + (lane >> 2)) * PN + 2048 + h * 128 + 32 * ((2 * wave) >> 2) + (lane & 3) * 8;
    ALAS unsigned char* kdst = lds + L_K + (2 * wave) * 1024; ALAS unsigned char* vdst = lds + L_V + (2 * wave) * 1024;
#define ATT_ISSUE(t, slot) do { const size_t go_ = (size_t)(t) * 64 * PN; \
        glds16(ksrc0 + go_, kdst + (slot) * SLOT); glds16(ksrc1 + go_, kdst + (slot) * SLOT + 1024); \
        glds16(vsrc0 + go_, vdst + (slot) * SLOT); glds16(vsrc0 + go_ + (size_t)16 * PN, vdst + (slot) * SLOT + 1024); } while (0)
    const int NT = (q0 + 128) / 64;
    ATT_ISSUE(0, 0); ATT_ISSUE(1, 1);
    ALAS float* wsf = (ALAS float*)(lds + L_SCR) + wave * 64;
    const ALAS float* tabL = (const ALAS float*)(lds + L_TAB);
    const float bfar = biasG[128] * LOG2E;
    float mhat = 0.f, l = 0.f;
    f32x16 o[4];
#pragma unroll
    for (int d = 0; d < 4; ++d)
#pragma unroll
        for (int r = 0; r < 16; ++r) o[d][r] = 0.f;
    f32x16 negm;
#pragma unroll
    for (int r = 0; r < 16; ++r) negm[r] = bfar;
    int slot = 0;
    for (int t = 0; t < NT; ++t) {
        if (t + 1 < NT) asm volatile("s_waitcnt vmcnt(4)" ::: "memory"); else asm volatile("s_waitcnt vmcnt(0)" ::: "memory");
        __builtin_amdgcn_s_barrier();
        asm volatile("" ::: "memory");
        if (t + 2 < NT) { const int s2 = slot == 0 ? 2 : slot - 1; ATT_ISSUE(t + 2, s2); }
        const int k0 = t * 64;
        if (k0 <= qw0 + 31) {
            const ALAS unsigned char* Ks = lds + L_K + slot * SLOT + r32 * 256;
            const int kx = r32 & 15, kc0 = 8 * c + hi;
            const int ko[4] = {((kc0 + 0) ^ kx) << 4, ((kc0 + 2) ^ kx) << 4, ((kc0 + 4) ^ kx) << 4, ((kc0 + 6) ^ kx) << 4};
            const ALAS unsigned char* Vs = lds + L_V + slot * SLOT + (4 * hi + ((lane & 15) >> 2)) * 64 + ((lane >> 4) & 1) * 32 + (lane & 3) * 8;
            f32x16 p0, p1;
            const bool nearb = (k0 + 63 + 128 > qw0);
            if (nearb) {
                f32x16 c0, c1;
#pragma unroll
                for (int r = 0; r < 16; ++r) { int rel = q - (k0 + crow(r, hi)); int i0 = rel < 0 ? 0 : (rel > 128 ? 128 : rel); int rel1 = rel - 32; int i1 = rel1 < 0 ? 0 : (rel1 > 128 ? 128 : rel1);
                    c0[r] = tabL[i0] - mhat; c1[r] = tabL[i1] - mhat; }
#pragma unroll
                for (int d0 = 0; d0 < 4; ++d0) { const f16x8 a0 = *(const ALAS f16x8*)(Ks + ko[d0]), a1 = *(const ALAS f16x8*)(Ks + ko[d0] + 8192);
                    p0 = __builtin_amdgcn_mfma_f32_32x32x16_f16(a0, qf[d0], d0 == 0 ? c0 : p0, 0, 0, 0); p1 = __builtin_amdgcn_mfma_f32_32x32x16_f16(a1, qf[d0], d0 == 0 ? c1 : p1, 0, 0, 0); }
                if (k0 + 63 > qw0) {
#pragma unroll
                    for (int r = 0; r < 16; ++r) { const int kv = k0 + crow(r, hi); if (kv > q) p0[r] = -INFINITY; if (kv + 32 > q) p1[r] = -INFINITY; }
                }
            } else {
#pragma unroll
                for (int d0 = 0; d0 < 4; ++d0) { const f16x8 a0 = *(const ALAS f16x8*)(Ks + ko[d0]), a1 = *(const ALAS f16x8*)(Ks + ko[d0] + 8192);
                    p0 = __builtin_amdgcn_mfma_f32_32x32x16_f16(a0, qf[d0], d0 == 0 ? negm : p0, 0, 0, 0); p1 = __builtin_amdgcn_mfma_f32_32x32x16_f16(a1, qf[d0], d0 == 0 ? negm : p1, 0, 0, 0); }
            }
            float rm = fmaxf(p0[0], p1[0]);
#pragma unroll
            for (int r = 1; r < 16; ++r) rm = fmaxf(rm, fmaxf(p0[r], p1[r]));
            rm = fmaxf(rm, xhalf(rm, hi));
            const bool first = (t == 0);
            if (first || __any(rm > (float)THR)) {
                const float dl = first ? rm : fmaxf(rm, 0.f);
                mhat += dl;
#pragma unroll
                for (int r = 0; r < 16; ++r) { p0[r] -= dl; p1[r] -= dl; }
#pragma unroll
                for (int r = 0; r < 16; ++r) negm[r] = bfar - mhat;
                if (!first) {
                    const float f = __builtin_amdgcn_exp2f(-dl); l *= f;
                    if (hi == 0) wsf[r32] = f;
                    asm volatile("s_waitcnt lgkmcnt(0)" ::: "memory");
#pragma unroll
                    for (int r = 0; r < 16; ++r) { const float fr_ = wsf[crow(r, hi)];
#pragma unroll
                        for (int d = 0; d < 4; ++d) o[d][r] *= fr_; }
                }
            }
            float sacc = 0.f;
#pragma unroll
            for (int r = 0; r < 16; ++r) { p0[r] = __builtin_amdgcn_exp2f(p0[r]); p1[r] = __builtin_amdgcn_exp2f(p1[r]); sacc += p0[r] + p1[r]; }
            l += sacc;
            u32x4 pw[4];
#pragma unroll
            for (int s = 0; s < 2; ++s) {
                pw[s] = (u32x4){pkh(p0[8 * s], p0[8 * s + 1]), pkh(p0[8 * s + 2], p0[8 * s + 3]), pkh(p0[8 * s + 4], p0[8 * s + 5]), pkh(p0[8 * s + 6], p0[8 * s + 7])};
                pw[2 + s] = (u32x4){pkh(p1[8 * s], p1[8 * s + 1]), pkh(p1[8 * s + 2], p1[8 * s + 3]), pkh(p1[8 * s + 4], p1[8 * s + 5]), pkh(p1[8 * s + 6], p1[8 * s + 7])};
            }
#pragma unroll
            for (int d = 0; d < 4; ++d) {
#pragma unroll
                for (int s = 0; s < 4; ++s) {
                    const v4i16_t lo = vtr(Vs + (d * 4 + s) * 1024), hi4 = vtr(Vs + (d * 4 + s) * 1024 + 512);
                    typedef short s16x8 __attribute__((ext_vector_type(8)));
                    const s16x8 bv = {lo[0], lo[1], lo[2], lo[3], hi4[0], hi4[1], hi4[2], hi4[3]};
                    o[d] = __builtin_amdgcn_mfma_f32_32x32x16_f16(__builtin_bit_cast(f16x8, pw[s]), __builtin_bit_cast(f16x8, bv), o[d], 0, 0, 0);
                }
            }
        }
        slot = slot == 2 ? 0 : slot + 1;
    }
#undef ATT_ISSUE
    l += xhalf(l, hi);
    if (hi == 0) wsf[r32] = 1.0f / l;
    asm volatile("s_waitcnt lgkmcnt(0)" ::: "memory");
#pragma unroll
    for (int r = 0; r < 16; ++r) { const float f = wsf[crow(r, hi)];
#pragma unroll
        for (int d = 0; d < 4; ++d) o[d][r] *= f; }
    asm volatile("s_waitcnt lgkmcnt(0)" ::: "memory"); __builtin_amdgcn_s_barrier(); asm volatile("" ::: "memory");
    ALAS float* xb = (ALAS float*)(lds + L_XB) + w4 * 4096 + lane;
    if (c == 1) {
#pragma unroll
        for (int d = 0; d < 4; ++d)
#pragma unroll
            for (int r = 0; r < 16; ++r) xb[(d * 16 + r) * 64] = o[d][r];
    }
    asm volatile("s_waitcnt lgkmcnt(0)" ::: "memory"); __builtin_amdgcn_s_barrier(); asm volatile("" ::: "memory");
    if (c == 0) {
        float sc[16];
#pragma unroll
        for (int r = 0; r < 16; ++r) { float ss = 0.f;
#pragma unroll
            for (int d = 0; d < 4; ++d) { o[d][r] -= lam * xb[(d * 16 + r) * 64]; ss += o[d][r] * o[d][r]; }
            ss += __shfl_xor(ss, 1); ss += __shfl_xor(ss, 2); ss += __shfl_xor(ss, 4); ss += __shfl_xor(ss, 8); ss += __shfl_xor(ss, 16);
            sc[r] = __builtin_amdgcn_rsqf(ss * (1.f / 128.f) + LN_EPS) * (1.f - LAMBDA_INIT); }
        ALAS _Float16* stg = (ALAS _Float16*)(lds + L_STG + w4 * 8192);
#pragma unroll
        for (int d = 0; d < 4; ++d) { const float gg = subln_g[32 * d + r32];
#pragma unroll
            for (int r = 0; r < 16; ++r) stg[crow(r, hi) * 128 + 32 * d + r32] = (_Float16)(o[d][r] * sc[r] * gg); }
        asm volatile("s_waitcnt lgkmcnt(0)" ::: "memory");
        unsigned short* Yw = Y + (rowbase + qw0) * D + h * 128;
#pragma unroll
        for (int i = 0; i < 8; ++i) { const int row = i * 4 + (lane >> 4), ch = lane & 15; const u32x4 v = *(const ALAS u32x4*)((const ALAS unsigned char*)stg + row * 256 + ch * 16);
            *(u32x4*)(Yw + (size_t)row * D + ch * 8) = v; }
    }
    asm volatile("s_waitcnt lgkmcnt(0)" ::: "memory"); __builtin_amdgcn_s_barrier(); asm volatile("" ::: "memory");
}
#undef ALAS
}

namespace rk {
#define RLAS __attribute__((address_space(3)))
#define RGAS __attribute__((address_space(1)))
typedef __bf16 bf16x8 __attribute__((ext_vector_type(8)));
typedef _Float16 f16x8 __attribute__((ext_vector_type(8)));
typedef float f32x16 __attribute__((ext_vector_type(16)));
typedef float f32x4 __attribute__((ext_vector_type(4)));
typedef unsigned u32x4 __attribute__((ext_vector_type(4)));
typedef unsigned short us8 __attribute__((ext_vector_type(8)));
constexpr int C = 32;
constexpr int TS = 144, CS = 80;
constexpr int O_AT = 0, O_RT = 4608, O_BT = 9216, O_KT = 13824;
constexpr int O_AAB = 0, O_AAK = 4608, O_ARB = 7168, O_ARK = 9728;
constexpr int O_PIMG = 0, O_QIMG = 8192;
constexpr int O_VT = 18432, O_KH = 23552, O_BH = 28672;
constexpr int O_X0 = 33792;
constexpr int O_RH = 50688;
constexpr int O_GAM = 55296;
constexpr int HALF_BYTES = 57344;
constexpr int CHK_BYTES = 24576, CK_P = 0, CK_Q = 8192, CK_G = 12288, CK_Y = 20480;
__device__ __forceinline__ int crow(int r, int hi) { return (r & 3) + 8 * (r >> 2) + 4 * hi; }
__device__ __forceinline__ unsigned pkb(float lo, float hi) { typedef float f2 __attribute__((ext_vector_type(2))); typedef __bf16 b2 __attribute__((ext_vector_type(2))); f2 v = {lo, hi}; b2 w = __builtin_convertvector(v, b2); return __builtin_bit_cast(unsigned, w); }
__device__ __forceinline__ unsigned pkh(float lo, float hi) { typedef _Float16 h2 __attribute__((ext_vector_type(2))); h2 v = {(_Float16)lo, (_Float16)hi}; return __builtin_bit_cast(unsigned, v); }
__device__ __forceinline__ float h2f(unsigned short u) { return (float)__builtin_bit_cast(_Float16, u); }
__device__ __forceinline__ unsigned short f2h(float f) { return __builtin_bit_cast(unsigned short, (_Float16)f); }
__device__ __forceinline__ float sum8(float x) {
    x += __builtin_bit_cast(float, __builtin_amdgcn_update_dpp(0, __builtin_bit_cast(int, x), 0xB1, 0xF, 0xF, true));
    x += __builtin_bit_cast(float, __builtin_amdgcn_update_dpp(0, __builtin_bit_cast(int, x), 0x4E, 0xF, 0xF, true));
    x += __builtin_bit_cast(float, __builtin_amdgcn_update_dpp(0, __builtin_bit_cast(int, x), 0x141, 0xF, 0xF, true));
    return x;
}
__device__ __forceinline__ int frag_pos(int m, int c) { return (((c >> 4) * 64 + m + 32 * ((c >> 2) & 1)) * 8) + ((c >> 3) & 1) * 4 + (c & 3); }

struct ChunkIn { f32x4 l0, l1; us8 a8, b8, k8, rc, rp, vc, vp; };
__device__ __forceinline__ void chunk_load(ChunkIn& in, int tglob, int pos, int chb, const unsigned char* ws) {
    const unsigned short* PROJ16 = (const unsigned short*)(ws + WS_PROJ16); const float* LW = (const float*)(ws + WS_DECAY); const unsigned short* KMOD = (const unsigned short*)(ws + WS_KMOD);
    const unsigned short* A16 = (const unsigned short*)(ws + WS_A16); const unsigned short* B16 = (const unsigned short*)(ws + WS_B16);
    in.l0 = *(const RGAS f32x4*)(LW + (size_t)tglob * RWK + chb); in.l1 = *(const RGAS f32x4*)(LW + (size_t)tglob * RWK + chb + 4);
    in.a8 = *(const RGAS us8*)(A16 + (size_t)tglob * RWK + chb); in.b8 = *(const RGAS us8*)(B16 + (size_t)tglob * RWK + chb); in.k8 = *(const RGAS us8*)(KMOD + (size_t)tglob * RWK + chb);
    const unsigned short* cur = PROJ16 + (size_t)tglob * PN + 3072 + chb;
    in.rc = *(const RGAS us8*)cur; in.vc = *(const RGAS us8*)(cur + 2048); in.rp = in.rc; in.vp = in.vc; if (pos > 0) { in.rp = *(const RGAS us8*)(cur - PN); in.vp = *(const RGAS us8*)(cur - PN + 2048); }
}
__device__ __forceinline__ void chunk_pair(RLAS unsigned char* lds, const int wave, const int tile, const int hA, ChunkIn& in, const bool has_next, const float* mu, const float* r_k, unsigned char* ws) {
    unsigned char* CHK = ws + WS_CHK; float* BONUS = (float*)(ws + WS_BONUS);
    const int lane = pg8::lane_id(), hf = wave >> 2, q = wave & 3, r32 = lane & 31, hi = lane >> 5;
    const int h = hA + hf;
    RLAS unsigned char* L = lds + hf * HALF_BYTES;
    const int t = q * 64 + lane;
    const int tok = t >> 3, c8 = (t & 7) * 8;
    const int tglob = tile * C + tok, pos = tglob & (S - 1), bidx = tglob >> 11;
    const int chb = h * 64 + c8;
    float lw[8], av[8], bv[8], kv[8], rv[8], vv[8];
    { lw[0] = in.l0.x; lw[1] = in.l0.y; lw[2] = in.l0.z; lw[3] = in.l0.w; lw[4] = in.l1.x; lw[5] = in.l1.y; lw[6] = in.l1.z; lw[7] = in.l1.w;
      const f32x4 m0 = *(const RGAS f32x4*)(mu + chb), m1 = *(const RGAS f32x4*)(mu + chb + 4), n0 = *(const RGAS f32x4*)(mu + 2048 + chb), n1 = *(const RGAS f32x4*)(mu + 2048 + chb + 4);
      const float mr[8] = {m0.x, m0.y, m0.z, m0.w, m1.x, m1.y, m1.z, m1.w}, mv[8] = {n0.x, n0.y, n0.z, n0.w, n1.x, n1.y, n1.z, n1.w};
#pragma unroll
      for (int i = 0; i < 8; ++i) { av[i] = h2f(in.a8[i]); bv[i] = h2f(in.b8[i]); kv[i] = h2f(in.k8[i]);
          const float rcf = h2f(in.rc[i]), rpf = pos > 0 ? h2f(in.rp[i]) : 0.f, vcf = h2f(in.vc[i]), vpf = pos > 0 ? h2f(in.vp[i]) : 0.f;
          rv[i] = rcf + (rpf - rcf) * mr[i]; vv[i] = vcf + (vpf - vcf) * mv[i]; } }
    { const f32x4 k0 = *(const RGAS f32x4*)(r_k + chb), k1 = *(const RGAS f32x4*)(r_k + chb + 4); const float rk8[8] = {k0.x, k0.y, k0.z, k0.w, k1.x, k1.y, k1.z, k1.w};
      float bs = 0.f;
#pragma unroll
      for (int i = 0; i < 8; ++i) bs += rv[i] * kv[i] * rk8[i];
      bs = sum8(bs); if ((t & 7) == 0) BONUS[(size_t)tglob * 16 + h] = bs; }
    RLAS float* lwL = (RLAS float*)(L + O_X0 + 64 * 132);
    __syncthreads();
#pragma unroll
    for (int i = 0; i < 8; ++i) lwL[tok * 65 + c8 + i] = lw[i];
    __syncthreads();
    { RLAS float* part = (RLAS float*)(L + O_GAM) + 64;
      const int ch = t & 63, seg = t >> 6; float sg = 0.f;
#pragma unroll
      for (int k = 0; k < 8; ++k) sg += lwL[(8 * seg + k) * 65 + ch];
      part[seg * 64 + ch] = sg;
      __syncthreads();
      float g = 0.f;
#pragma unroll
      for (int s2 = 0; s2 < 3; ++s2) if (s2 < seg) g += part[s2 * 64 + ch];
#pragma unroll
      for (int k = 0; k < 8; ++k) { g += lwL[(8 * seg + k) * 65 + ch]; lwL[(8 * seg + k) * 65 + ch] = g; } }
    __syncthreads();
    {
        float G[8], GL[8];
#pragma unroll
        for (int i = 0; i < 8; ++i) { G[i] = lwL[tok * 65 + c8 + i]; GL[i] = lwL[31 * 65 + c8 + i]; }
        float at[8], rt[8], bt[8], kt[8], bh[8], kh[8];
#pragma unroll
        for (int i = 0; i < 8; ++i) { const float eg = __expf(G[i]), eng = __expf(-G[i]), egm = __expf(G[i] - lw[i]), egl = __expf(GL[i] - G[i]);
            at[i] = av[i] * egm; rt[i] = rv[i] * eg; bt[i] = bv[i] * eng; kt[i] = kv[i] * eng; bh[i] = bv[i] * egl; kh[i] = kv[i] * egl; }
        *(RLAS u32x4*)(L + O_AT + tok * TS + c8 * 2) = (u32x4){pkb(at[0], at[1]), pkb(at[2], at[3]), pkb(at[4], at[5]), pkb(at[6], at[7])};
        *(RLAS u32x4*)(L + O_RT + tok * TS + c8 * 2) = (u32x4){pkb(rt[0], rt[1]), pkb(rt[2], rt[3]), pkb(rt[4], rt[5]), pkb(rt[6], rt[7])};
        *(RLAS u32x4*)(L + O_BT + tok * TS + c8 * 2) = (u32x4){pkb(bt[0], bt[1]), pkb(bt[2], bt[3]), pkb(bt[4], bt[5]), pkb(bt[6], bt[7])};
        *(RLAS u32x4*)(L + O_KT + tok * TS + c8 * 2) = (u32x4){pkb(kt[0], kt[1]), pkb(kt[2], kt[3]), pkb(kt[4], kt[5]), pkb(kt[6], kt[7])};
        *(RLAS u32x4*)(L + O_RH + tok * TS + c8 * 2) = (u32x4){pkh(rt[0], rt[1]), pkh(rt[2], rt[3]), pkh(rt[4], rt[5]), pkh(rt[6], rt[7])};
#pragma unroll
        for (int i = 0; i < 8; ++i) { const int ch = c8 + i;
            *(RLAS unsigned short*)(L + O_VT + ch * CS + tok * 2) = f2h(vv[i]); *(RLAS unsigned short*)(L + O_KH + ch * CS + tok * 2) = f2h(kh[i]); *(RLAS unsigned short*)(L + O_BH + ch * CS + tok * 2) = f2h(bh[i]);
            ((RLAS float*)(L + O_X0))[ch * 33 + tok] = at[i];
            if (tok == C - 1) ((RLAS float*)(L + O_GAM))[ch] = __expf(GL[i]); }
    }
    __syncthreads();
    {
        const RLAS unsigned char* Lp = L + (q < 2 ? O_AT : O_RT) + r32 * TS + hi * 16; const RLAS unsigned char* Rp = L + ((q & 1) ? O_KT : O_BT) + r32 * TS + hi * 16;
        f32x16 acc;
#pragma unroll
        for (int r = 0; r < 16; ++r) acc[r] = 0.f;
#pragma unroll
        for (int ks = 0; ks < 4; ++ks) acc = __builtin_amdgcn_mfma_f32_32x32x16_bf16(*(const RLAS bf16x8*)(Lp + ks * 32), *(const RLAS bf16x8*)(Rp + ks * 32), acc, 0, 0, 0);
#pragma unroll
        for (int r = 0; r < 16; ++r) { const int tau = crow(r, hi); const bool keep = (q < 2) ? (r32 < tau) : (r32 <= tau); acc[r] = keep ? acc[r] : 0.f; }
        __syncthreads();
        if (q == 0) {
#pragma unroll
            for (int r = 0; r < 16; ++r) ((RLAS float*)(L + O_AAB))[r32 * 36 + crow(r, hi)] = acc[r];
        } else {
            RLAS unsigned char* o = L + (q == 1 ? O_AAK : (q == 2 ? O_ARB : O_ARK));
#pragma unroll
            for (int r = 0; r < 16; ++r) *(RLAS unsigned short*)(o + crow(r, hi) * CS + r32 * 2) = f2h(acc[r]);
        }
    }
    __syncthreads();
    const int J = q & 1, part = q >> 1;
    if (part == 1) {
        f32x16 accX;
#pragma unroll
        for (int r = 0; r < 16; ++r) accX[r] = 0.f;
        const RLAS unsigned char* Vp = L + O_VT + (32 * J + r32) * CS + hi * 16; const RLAS unsigned char* Ap = L + O_AAK + r32 * CS + hi * 16;
#pragma unroll
        for (int ks = 0; ks < 2; ++ks) accX = __builtin_amdgcn_mfma_f32_32x32x16_f16(*(const RLAS f16x8*)(Ap + ks * 32), *(const RLAS f16x8*)(Vp + ks * 32), accX, 0, 0, 0);
#pragma unroll
        for (int r = 0; r < 16; ++r) ((RLAS float*)(L + O_X0))[(64 + 32 * J + r32) * 33 + crow(r, hi)] = accX[r];
    }
    __syncthreads();
    float z[C];
    if (q < 2) {
        const RLAS float* xc = (const RLAS float*)(L + O_X0) + (64 * q + lane) * 33;
#pragma unroll
        for (int k = 0; k < C; ++k) z[k] = xc[k];
    }
    __syncthreads();
    if (q < 2) {
        const RLAS float* AabT = (const RLAS float*)(L + O_AAB);
#pragma unroll
        for (int sx = 0; sx < C - 1; ++sx) {
            const float zs = z[sx];
#pragma unroll
            for (int t4 = (sx + 1) / 4; t4 < C / 4; ++t4) { const f32x4 aa = *(const RLAS f32x4*)(AabT + sx * 36 + 4 * t4);
                if (4 * t4 + 0 > sx) z[4 * t4 + 0] = fmaf(aa.x, zs, z[4 * t4 + 0]); if (4 * t4 + 1 > sx) z[4 * t4 + 1] = fmaf(aa.y, zs, z[4 * t4 + 1]);
                if (4 * t4 + 2 > sx) z[4 * t4 + 2] = fmaf(aa.z, zs, z[4 * t4 + 2]); if (4 * t4 + 3 > sx) z[4 * t4 + 3] = fmaf(aa.w, zs, z[4 * t4 + 3]); }
        }
        RLAS unsigned char* zr = L + O_X0 + (64 * q + lane) * CS;
#pragma unroll
        for (int k8 = 0; k8 < 4; ++k8) *(RLAS u32x4*)(zr + k8 * 16) = (u32x4){pkh(z[8 * k8], z[8 * k8 + 1]), pkh(z[8 * k8 + 2], z[8 * k8 + 3]), pkh(z[8 * k8 + 4], z[8 * k8 + 5]), pkh(z[8 * k8 + 6], z[8 * k8 + 7])};
    }
    __syncthreads();
    f32x16 accQ, accP, accA, accB;
#pragma unroll
    for (int r = 0; r < 16; ++r) { accA[r] = 0.f; accB[r] = 0.f; }
    {
        const RLAS unsigned char* Vp = L + O_VT + (32 * J + r32) * CS + hi * 16;
        const RLAS unsigned char* Kp = L + O_KH + (32 * part + r32) * CS + hi * 16;
        const RLAS unsigned char* Ap = L + O_ARK + r32 * CS + hi * 16;
#pragma unroll
        for (int ks = 0; ks < 2; ++ks) { const f16x8 vf = *(const RLAS f16x8*)(Vp + ks * 32);
            if (part == 0) accA = __builtin_amdgcn_mfma_f32_32x32x16_f16(*(const RLAS f16x8*)(Ap + ks * 32), vf, accA, 0, 0, 0);
            accB = __builtin_amdgcn_mfma_f32_32x32x16_f16(*(const RLAS f16x8*)(Kp + ks * 32), vf, accB, 0, 0, 0); }
    }
    {
        const RLAS float* gam = (const RLAS float*)(L + O_GAM);
#pragma unroll
        for (int r = 0; r < 16; ++r) { const int m = crow(r, hi);
            accQ[r] = h2f(*(const RLAS unsigned short*)(L + O_RH + m * TS + (32 * J + r32) * 2));
            accP[r] = (J == part && m == r32) ? gam[32 * J + r32] : 0.f; }
        const RLAS unsigned char* Zw = L + O_X0 + (32 * J + r32) * CS + hi * 16; const RLAS unsigned char* Zu = Zw + 64 * CS;
        const RLAS unsigned char* Bp = L + O_BH + (32 * part + r32) * CS + hi * 16; const RLAS unsigned char* Rb = L + O_ARB + r32 * CS + hi * 16;
#pragma unroll
        for (int ks = 0; ks < 2; ++ks) { const f16x8 zw = *(const RLAS f16x8*)(Zw + ks * 32), zu = *(const RLAS f16x8*)(Zu + ks * 32), bf = *(const RLAS f16x8*)(Bp + ks * 32);
            accP = __builtin_amdgcn_mfma_f32_32x32x16_f16(bf, zw, accP, 0, 0, 0);
            accB = __builtin_amdgcn_mfma_f32_32x32x16_f16(bf, zu, accB, 0, 0, 0);
            if (part == 0) { const f16x8 rb = *(const RLAS f16x8*)(Rb + ks * 32);
                accQ = __builtin_amdgcn_mfma_f32_32x32x16_f16(rb, zw, accQ, 0, 0, 0);
                accA = __builtin_amdgcn_mfma_f32_32x32x16_f16(rb, zu, accA, 0, 0, 0); } }
    }
    __syncthreads();
    { int tg2 = tglob, cb2 = has_next ? chb + 128 : chb; asm volatile("" : "+v"(tg2), "+v"(cb2)); chunk_load(in, tg2, pos, cb2, ws); }
    unsigned char* rec = CHK + ((size_t)((bidx * 16 + h) * (S / C)) + (size_t)(pos >> 5)) * CHK_BYTES;
    { u32x4 w0, w1; w0 = (u32x4){pkh(accB[0], accB[1]), pkh(accB[2], accB[3]), pkh(accB[4], accB[5]), pkh(accB[6], accB[7])}; w1 = (u32x4){pkh(accB[8], accB[9]), pkh(accB[10], accB[11]), pkh(accB[12], accB[13]), pkh(accB[14], accB[15])};
      RGAS u32x4* g = (RGAS u32x4*)(rec + CK_G + ((part * 2 + J) * 64 + lane) * 32); g[0] = w0; g[1] = w1;
      if (part == 0) { w0 = (u32x4){pkh(accA[0], accA[1]), pkh(accA[2], accA[3]), pkh(accA[4], accA[5]), pkh(accA[6], accA[7])}; w1 = (u32x4){pkh(accA[8], accA[9]), pkh(accA[10], accA[11]), pkh(accA[12], accA[13]), pkh(accA[14], accA[15])};
          RGAS u32x4* y = (RGAS u32x4*)(rec + CK_Y + (J * 64 + lane) * 32); y[0] = w0; y[1] = w1; } }
    {
        RLAS unsigned short* pimg = (RLAS unsigned short*)(L + O_PIMG) + ((part * 2 + J) * 2) * 512;
        RLAS unsigned short* qimg = (RLAS unsigned short*)(L + O_QIMG) + (J * 2) * 512;
#pragma unroll
        for (int r = 0; r < 16; ++r) { const int fp = frag_pos(crow(r, hi), r32); pimg[fp] = f2h(accP[r]); if (part == 0) qimg[fp] = f2h(accQ[r]); }
    }
    __syncthreads();
    { const RLAS u32x4* src = (const RLAS u32x4*)(L + O_PIMG); RGAS u32x4* dst = (RGAS u32x4*)(rec + CK_P);
#pragma unroll
      for (int i = 0; i < 3; ++i) dst[i * 256 + t] = src[i * 256 + t]; }
}

__device__ __forceinline__ void scan_unit(RLAS unsigned char* lds, const int wave, const int bh, const unsigned char* CHK, const float* BONUS, const unsigned short* PROJ16, const float* mu,
                                          const unsigned short* G16, const float* lnx_g, const float* lnx_b, unsigned short* Y16) {
    const int lane = pg8::lane_id(), r32 = lane & 31, hi = lane >> 5;
    const int b = bh >> 4, h = bh & 15;
    RLAS float* ytile = (RLAS float*)lds;
    constexpr int RING0 = 18432, NSL = 4;
    const unsigned char* rec0 = CHK + (size_t)bh * (S / C) * CHK_BYTES;
    constexpr int NCH = S / C;
    __syncthreads();
    if (wave >= 6) {
        const int p0 = (wave - 6) * 12;
#define RK_DMA(c) do { const unsigned char* src_ = rec0 + (size_t)(c) * CHK_BYTES + p0 * 1024 + lane * 16; RLAS unsigned char* dst_ = lds + RING0 + ((c) & (NSL - 1)) * CHK_BYTES + p0 * 1024; \
            _Pragma("unroll") for (int j_ = 0; j_ < 12; ++j_) __builtin_amdgcn_global_load_lds((const unsigned*)(src_ + j_ * 1024), (RLAS unsigned*)(dst_ + j_ * 1024), 16, 0, 0); } while (0)
        RK_DMA(0); RK_DMA(1); RK_DMA(2);
        for (int c = 0; c <= NCH; ++c) {
            if (c + 2 < NCH) asm volatile("s_waitcnt vmcnt(24)" ::: "memory"); else if (c + 1 < NCH) asm volatile("s_waitcnt vmcnt(12)" ::: "memory"); else asm volatile("s_waitcnt vmcnt(0)" ::: "memory");
            __builtin_amdgcn_s_barrier(); asm volatile("" ::: "memory");
            if (c + 3 < NCH) RK_DMA(c + 3);
        }
#undef RK_DMA
    } else if (wave < 2) {
        const int J = wave;
        f32x16 H0, H1;
#pragma unroll
        for (int r = 0; r < 16; ++r) { H0[r] = 0.f; H1[r] = 0.f; }
        for (int c = 0; c <= NCH; ++c) {
            asm volatile("s_waitcnt lgkmcnt(0)" ::: "memory"); __builtin_amdgcn_s_barrier(); asm volatile("" ::: "memory");
            if (c == NCH) break;
            const RLAS unsigned char* rec = lds + RING0 + (c & (NSL - 1)) * CHK_BYTES;
            u32x4 hb[4];
            hb[0] = (u32x4){pkh(H0[0], H0[1]), pkh(H0[2], H0[3]), pkh(H0[4], H0[5]), pkh(H0[6], H0[7])}; hb[1] = (u32x4){pkh(H0[8], H0[9]), pkh(H0[10], H0[11]), pkh(H0[12], H0[13]), pkh(H0[14], H0[15])};
            hb[2] = (u32x4){pkh(H1[0], H1[1]), pkh(H1[2], H1[3]), pkh(H1[4], H1[5]), pkh(H1[6], H1[7])}; hb[3] = (u32x4){pkh(H1[8], H1[9]), pkh(H1[10], H1[11]), pkh(H1[12], H1[13]), pkh(H1[14], H1[15])};
            f32x16 y, n0, n1;
#define RK_UNPK(dst, w0, w1) do { const f16x8 a_ = __builtin_bit_cast(f16x8, w0), b_ = __builtin_bit_cast(f16x8, w1); \
            _Pragma("unroll") for (int i_ = 0; i_ < 8; ++i_) { dst[i_] = (float)a_[i_]; dst[8 + i_] = (float)b_[i_]; } } while (0)
            { const u32x4 y0 = *(const RLAS u32x4*)(rec + CK_Y + (J * 64 + lane) * 32), y1 = *(const RLAS u32x4*)(rec + CK_Y + (J * 64 + lane) * 32 + 16); RK_UNPK(y, y0, y1);
              const u32x4 g0 = *(const RLAS u32x4*)(rec + CK_G + (J * 64 + lane) * 32), g1 = *(const RLAS u32x4*)(rec + CK_G + (J * 64 + lane) * 32 + 16); RK_UNPK(n0, g0, g1);
              const u32x4 g2 = *(const RLAS u32x4*)(rec + CK_G + ((2 + J) * 64 + lane) * 32), g3 = *(const RLAS u32x4*)(rec + CK_G + ((2 + J) * 64 + lane) * 32 + 16); RK_UNPK(n1, g2, g3); }
#pragma unroll
            for (int ks = 0; ks < 4; ++ks) {
                const f16x8 hf = __builtin_bit_cast(f16x8, hb[ks]);
                y = __builtin_amdgcn_mfma_f32_32x32x16_f16(*(const RLAS f16x8*)(rec + CK_Q + (ks * 64 + lane) * 16), hf, y, 0, 0, 0);
                n0 = __builtin_amdgcn_mfma_f32_32x32x16_f16(*(const RLAS f16x8*)(rec + CK_P + (ks * 64 + lane) * 16), hf, n0, 0, 0, 0);
                n1 = __builtin_amdgcn_mfma_f32_32x32x16_f16(*(const RLAS f16x8*)(rec + CK_P + ((4 + ks) * 64 + lane) * 16), hf, n1, 0, 0, 0);
            }
#undef RK_UNPK
            H0 = n0; H1 = n1;
            RLAS float* yt = ytile + (c & 1) * (32 * 68);
#pragma unroll
            for (int r = 0; r < 16; ++r) yt[crow(r, hi) * 68 + 32 * J + r32] = y[r];
        }
    } else {
        const int p = wave - 2, v8 = (lane & 7) * 8, trow = 8 * p + (lane >> 3);
        float lg[8], lb[8], mv[8];
#pragma unroll
        for (int i = 0; i < 8; ++i) { lg[i] = lnx_g[h * 64 + v8 + i]; lb[i] = lnx_b[h * 64 + v8 + i]; mv[i] = mu[2048 + h * 64 + v8 + i]; }
        struct PSlot { float bon; us8 vc, vp, g8; };
        PSlot ps[4];
#define RK_PLOAD(SL, cc_) do { const int pos_ = (cc_) * C + trow; const size_t tok_ = (size_t)b * S + pos_; ps[SL].bon = BONUS[tok_ * 16 + h]; \
            const unsigned short* cur_ = PROJ16 + tok_ * PN + 5120 + h * 64 + v8; ps[SL].vc = *(const RGAS us8*)cur_; ps[SL].vp = ps[SL].vc; if (pos_ > 0) ps[SL].vp = *(const RGAS us8*)(cur_ - PN); \
            ps[SL].g8 = *(const RGAS us8*)(G16 + tok_ * RWK + h * 64 + v8); } while (0)
#define RK_PSTEP(SL, cc_) do { \
            asm volatile("s_waitcnt lgkmcnt(0)" ::: "memory"); __builtin_amdgcn_s_barrier(); asm volatile("" ::: "memory"); \
            if ((cc_) >= 0) { const int cc = (cc_); \
                const float bon = ps[SL].bon; const us8 vc = ps[SL].vc, vp = ps[SL].vp, g8 = ps[SL].g8; \
                if (cc + 4 < NCH) RK_PLOAD(SL, cc + 4); \
                const RLAS float* yt = ytile + (cc & 1) * (32 * 68) + trow * 68 + v8; \
                const f32x4 ya = *(const RLAS f32x4*)yt, yb = *(const RLAS f32x4*)(yt + 4); \
                float yv[8] = {ya.x, ya.y, ya.z, ya.w, yb.x, yb.y, yb.z, yb.w}; \
                float sm = 0.f; \
                _Pragma("unroll") for (int i = 0; i < 8; ++i) sm += yv[i]; \
                const float mean = sum8(sm) * (1.f / 64.f); float sq = 0.f; \
                _Pragma("unroll") for (int i = 0; i < 8; ++i) { yv[i] -= mean; sq += yv[i] * yv[i]; } \
                const float rstd = __builtin_amdgcn_rsqf(sum8(sq) * (1.f / 64.f) + 64e-5f); \
                const int pos = cc * C + trow; const size_t tok = (size_t)b * S + pos; \
                float o[8]; \
                _Pragma("unroll") for (int i = 0; i < 8; ++i) { const float vcf = h2f(vc[i]), vpf = pos > 0 ? h2f(vp[i]) : 0.f; const float vx = vcf + (vpf - vcf) * mv[i]; \
                    o[i] = (yv[i] * rstd * lg[i] + lb[i] + bon * vx) * h2f(g8[i]); } \
                *(RGAS u32x4*)(Y16 + tok * D + 1024 + h * 64 + v8) = (u32x4){pkh(o[0], o[1]), pkh(o[2], o[3]), pkh(o[4], o[5]), pkh(o[6], o[7])}; } } while (0)
        RK_PLOAD(0, 0); RK_PLOAD(1, 1); RK_PLOAD(2, 2); RK_PLOAD(3, 3);
        for (int cb = 0; cb < NCH; cb += 4) {
            RK_PSTEP(3, cb - 1); RK_PSTEP(0, cb); RK_PSTEP(1, cb + 1); RK_PSTEP(2, cb + 2);
        }
        RK_PSTEP(3, NCH - 1);
#undef RK_PSTEP
#undef RK_PLOAD
    }
    __syncthreads();
}
#undef RLAS
#undef RGAS
}

constexpr int NWAVES = 8;
constexpr int RING_OFF = 0, RING_BYTES = 131072;
constexpr int LDSCTL_OFF = RING_BYTES, MISC_OFF = LDSCTL_OFF + 320;
constexpr int LDS_BYTES = 147456;
#define GAS __attribute__((address_space(1)))
#define LAS __attribute__((address_space(3)))
typedef unsigned v4u __attribute__((ext_vector_type(4)));
typedef float f32x4 __attribute__((ext_vector_type(4)));
typedef GAS unsigned gu32;
#define RLX_AGENT __ATOMIC_RELAXED, __HIP_MEMORY_SCOPE_AGENT
#define LDS_WAIT() asm volatile("s_waitcnt lgkmcnt(0)" ::: "memory")
#define VM_WAIT() asm volatile("s_waitcnt vmcnt(0)" ::: "memory")
constexpr int CW_CONVQ = 65;
constexpr int CW_ATTQ = 64;
constexpr int CW_BAR = 4096;
constexpr size_t CTL_ZERO_BYTES = 64 * 1024;

#define XB_TMO      128
#define XB_XCNT(j)  (256  + 64 * (j))
#define XB_XSUB(j)  (1280 + 64 * (j))
#define XB_XGEN(j)  (2304 + 64 * (j))
#define XB_TOP      3328
#define XB_TOPGEN   3392
#define XCD_BAR_WORDS 3456
#define XB_SPIN_CAP (1u << 18)

__device__ __forceinline__ unsigned xb_ld(unsigned* p)              { return __hip_atomic_load(p, __ATOMIC_RELAXED, __HIP_MEMORY_SCOPE_AGENT); }
__device__ __forceinline__ unsigned xb_add(unsigned* p, unsigned v) { return __hip_atomic_fetch_add(p, v, __ATOMIC_RELAXED, __HIP_MEMORY_SCOPE_AGENT); }
__device__ __forceinline__ unsigned xb_xcc_id() { return (unsigned)__builtin_amdgcn_s_getreg((3 << 11) | 20) & 0xFu; }
#define XB_SPIN(cond, bar) do { unsigned _sp = 0; while (cond) { __builtin_amdgcn_s_sleep(1); \
    if ((++_sp & 255u) == 0u) { if (xb_ld(&(bar)[XB_TMO])) break; if (_sp > XB_SPIN_CAP) { atomicAdd(&(bar)[XB_TMO], 1u); break; } } } } while (0)

struct XcdBarrier {
    unsigned* bar; unsigned x; bool w0;
    volatile LAS unsigned* st;
};

__device__ __forceinline__ XcdBarrier xcd_barrier_post(unsigned* bar, volatile LAS unsigned* st) {
    XcdBarrier b; b.bar = bar; b.x = xb_xcc_id(); b.st = st; b.w0 = (__builtin_amdgcn_readfirstlane(threadIdx.x >> 6) == 0);
    if (__builtin_amdgcn_readfirstlane(threadIdx.x >> 6) == 0 && pg8::lane_id() == 0) (void)xb_add(&bar[XB_XCNT(b.x)], 1u);
    return b;
}
__device__ __forceinline__ void xcd_barrier_complete(unsigned* bar, unsigned x, unsigned& nloc, unsigned& nx) {
    const unsigned G = gridDim.x * gridDim.y * gridDim.z;
    unsigned sum, cnt, mine, sp = 0u;
    for (;;) {
        sum = 0u; cnt = 0u; mine = 0u;
#pragma unroll
        for (unsigned j = 0; j < 16; ++j) { const unsigned c = xb_ld(&bar[XB_XCNT(j)]); sum += c; cnt += (c > 0u) ? 1u : 0u; mine = (j == x) ? c : mine; }
        if (sum == G) break;
        __builtin_amdgcn_s_sleep(1);
        if ((++sp & 255u) == 0u) { if (xb_ld(&bar[XB_TMO])) break; if (sp > XB_SPIN_CAP) { atomicAdd(&bar[XB_TMO], 1u); break; } }
    }
    nloc = mine > 0u ? mine : 1u; nx = cnt > 0u ? cnt : 1u;
}

__device__ __forceinline__ void xcd_barrier(const XcdBarrier& b) {
    asm volatile("s_waitcnt vmcnt(0)" ::: "memory");
    __syncthreads();
    if (b.w0 && pg8::lane_id() == 0) {
        unsigned* bar = b.bar;
        __builtin_amdgcn_s_waitcnt(0);
        unsigned nloc = b.st[0], nx = b.st[1];
        if (nloc == 0u) { xcd_barrier_complete(bar, b.x, nloc, nx); b.st[0] = nloc; b.st[1] = nx; }
        const unsigned old = xb_add(&bar[XB_XSUB(b.x)], 1u);
        const unsigned gen = old / nloc;
        if (old + 1u == (gen + 1u) * nloc) {
            __builtin_amdgcn_fence(__ATOMIC_RELEASE, "agent");
            asm volatile("s_waitcnt vmcnt(0)" ::: "memory");
            const unsigned og = xb_add(&bar[XB_TOP], 1u);
            const unsigned tg = og / nx;
            if (og + 1u == (tg + 1u) * nx) xb_add(&bar[XB_TOPGEN], 1u);
            else XB_SPIN(xb_ld(&bar[XB_TOPGEN]) == tg, bar);
            __builtin_amdgcn_fence(__ATOMIC_ACQUIRE, "agent");
            xb_add(&bar[XB_XGEN(b.x)], 1u);
            asm volatile("s_waitcnt vmcnt(0)" ::: "memory");
        } else {
            XB_SPIN(xb_ld(&bar[XB_XGEN(b.x)]) == gen, bar);
            __builtin_amdgcn_fence(__ATOMIC_ACQUIRE, "agent");
            asm volatile("s_waitcnt vmcnt(0)" ::: "memory");
        }
    }
    __syncthreads();
}


typedef unsigned short f16_t;
typedef _Float16 h2v __attribute__((ext_vector_type(2)));
__device__ __forceinline__ unsigned pk2h(float lo, float hi) { h2v v = {(_Float16)lo, (_Float16)hi}; return __builtin_bit_cast(unsigned, v); }

struct Frame {
    LAS unsigned char* lds; volatile LAS unsigned* MISC; gu32* ctl;
    int wave, vcu, G;
};
#define FTID (F.wave * 64 + pg8::lane_id())
#define FLANE (pg8::lane_id())
__device__ __forceinline__ void p0_transpose_item(const float* W, int K, int N, f16_t* WT, int row_off, LAS float* scr, int item, int lane) {
    const int nblk = N / 32, kb = item / nblk, nb = item % nblk, k0 = 64 * kb, n0 = 32 * nb;
#pragma unroll 8
    for (int i = 0; i < 32; ++i) { const int kk = 2 * i + (lane >> 5); scr[kk * 33 + (lane & 31)] = W[(size_t)(k0 + kk) * N + n0 + (lane & 31)]; }
    LDS_WAIT(); asm volatile("" ::: "memory");
    const int c = lane & 7;
#pragma unroll
    for (int j = 0; j < 4; ++j) { const int n = (lane >> 3) + 8 * j; const LAS float* s = scr + (8 * c) * 33 + n;
        v4u o; o.x = pk2h(s[0 * 33], s[1 * 33]); o.y = pk2h(s[2 * 33], s[3 * 33]); o.z = pk2h(s[4 * 33], s[5 * 33]); o.w = pk2h(s[6 * 33], s[7 * 33]);
        *(GAS v4u*)(WT + (size_t)(row_off + n0 + n) * K + k0 + 8 * c) = o; }
    LDS_WAIT(); asm volatile("" ::: "memory");
}
#ifndef TP_LD
#define TP_LD(p) (*(p))
#endif
struct TpDesc { const float* W; f16_t* WT; int K, N, row_off, item; };
__device__ __forceinline__ void tp_load(float (&r)[32], const TpDesc& d, int lane) {
    const int nblk = d.N / 32, kb = d.item / nblk, nb = d.item % nblk, k0 = 64 * kb, n0 = 32 * nb;
#pragma unroll
    for (int i = 0; i < 32; ++i) r[i] = TP_LD(d.W + (size_t)(k0 + 2 * i + (lane >> 5)) * d.N + n0 + (lane & 31));
}
__device__ __forceinline__ void tp_emit(const TpDesc& d, LAS float* scr, int lane) {
    const int nblk = d.N / 32, kb = d.item / nblk, nb = d.item % nblk, k0 = 64 * kb, n0 = 32 * nb, c = lane & 7;
#pragma unroll
    for (int j = 0; j < 4; ++j) { const int n = (lane >> 3) + 8 * j; const LAS float* sp = scr + (8 * c) * 33 + n;
        v4u o; o.x = pk2h(sp[0 * 33], sp[1 * 33]); o.y = pk2h(sp[2 * 33], sp[3 * 33]); o.z = pk2h(sp[4 * 33], sp[5 * 33]); o.w = pk2h(sp[6 * 33], sp[7 * 33]);
        *(GAS v4u*)(d.WT + (size_t)(d.row_off + n0 + n) * d.K + k0 + 8 * c) = o; }
}
template <class MK> __device__ __forceinline__ void tp_stream(int first, int n, int stride, MK mk, LAS float* scr, int lane) {
    if (first >= n) return;
    float r[32]; int it = first; TpDesc d = mk(it); tp_load(r, d, lane);
    for (;;) {
#pragma unroll
        for (int i = 0; i < 32; ++i) scr[(2 * i + (lane >> 5)) * 33 + (lane & 31)] = r[i];
        LDS_WAIT(); asm volatile("" ::: "memory");
        const int nit = it + stride; const bool more = nit < n; TpDesc dn = d;
        if (more) { dn = mk(nit); tp_load(r, dn, lane); }
        tp_emit(d, scr, lane);
        LDS_WAIT(); asm volatile("" ::: "memory");
        if (!more) break;
        it = nit; d = dn;
    }
}
#ifndef TPD_AUX
#define TPD_AUX 2
#endif
__device__ __forceinline__ void tpd_load(const TpDesc& d, LAS unsigned char* buf, int lane) {
    const int nblk = d.N / 32, kb = d.item / nblk, nb = d.item % nblk, k0 = 64 * kb, n0 = 32 * nb;
    const float* src = d.W + (size_t)(k0 + (lane >> 3)) * d.N + n0;
#pragma unroll
    for (int j = 0; j < 8; ++j) __builtin_amdgcn_global_load_lds((const unsigned*)(src + (size_t)(8 * j) * d.N + 4 * ((lane & 7) ^ j)), (LAS unsigned*)(buf + j * 1024), 16, 0, TPD_AUX);
}
__device__ __forceinline__ void tpd_emit(const TpDesc& d, const LAS unsigned char* buf, int lane) {
    const int nblk = d.N / 32, kb = d.item / nblk, nb = d.item % nblk, k0 = 64 * kb, n0 = 32 * nb, c = lane & 7;
#pragma unroll
    for (int j = 0; j < 4; ++j) { const int n = (lane >> 3) + 8 * j; const LAS float* sp = (const LAS float*)(buf + (8 * c) * 128 + (((n >> 2) ^ c) * 16) + (n & 3) * 4);
        v4u o; o.x = pk2h(sp[0 * 32], sp[1 * 32]); o.y = pk2h(sp[2 * 32], sp[3 * 32]); o.z = pk2h(sp[4 * 32], sp[5 * 32]); o.w = pk2h(sp[6 * 32], sp[7 * 32]);
        __builtin_nontemporal_store(o, (GAS v4u*)(d.WT + (size_t)(d.row_off + n0 + n) * d.K + k0 + 8 * c)); }
}
template <class MK> __device__ __forceinline__ void tpd_stream(int first, int n, int stride, MK mk, LAS unsigned char* buf, int lane) {
    for (int it = first; it < n; it += 2 * stride) {
        const bool two = it + stride < n;
        const TpDesc d0 = mk(it); const TpDesc d1 = mk(two ? it + stride : it);
        tpd_load(d0, buf, lane); if (two) tpd_load(d1, buf + 8192, lane);
        asm volatile("s_waitcnt vmcnt(0)" ::: "memory");
        tpd_emit(d0, buf, lane); if (two) tpd_emit(d1, buf + 8192, lane);
        LDS_WAIT(); asm volatile("" ::: "memory");
    }
}
__device__ __forceinline__ float wave_sum_b(float v) {
#pragma unroll
    for (int o = 1; o < 64; o <<= 1) v += __shfl_xor(v, o);
    return v;
}
__device__ __forceinline__ void ln_row_dual(int lane, const float* xrow, const float* g, const float* b, float* o32, f16_t* o16) {
    const GAS f32x4* xr = (const GAS f32x4*)xrow + lane;
    f32x4 v[8]; float s = 0.f;
#pragma unroll
    for (int j = 0; j < 8; ++j) { v[j] = xr[64 * j]; s += (v[j].x + v[j].y) + (v[j].z + v[j].w); }
    const float mean = wave_sum_b(s) * (1.f / D); float s2 = 0.f;
#pragma unroll
    for (int j = 0; j < 8; ++j) { v[j] = v[j] - mean; s2 += (v[j].x * v[j].x + v[j].y * v[j].y) + (v[j].z * v[j].z + v[j].w * v[j].w); }
    const float rstd = __builtin_amdgcn_rsqf(wave_sum_b(s2) * (1.f / D) + LN_EPS);
    const GAS f32x4* g4 = (const GAS f32x4*)g + lane; const GAS f32x4* b4 = (const GAS f32x4*)b + lane;
    GAS f32x4* o4 = (GAS f32x4*)o32 + lane; GAS unsigned long long* o8 = (GAS unsigned long long*)o16 + lane;
#pragma unroll
    for (int j = 0; j < 8; ++j) { const f32x4 o = v[j] * rstd * g4[64 * j] + b4[64 * j]; o4[64 * j] = o;
        o8[64 * j] = (unsigned long long)pk2h(o.x, o.y) | ((unsigned long long)pk2h(o.z, o.w) << 32); }
}


__device__ __forceinline__ void ln_row_f16(int lane, const float* xrow, const float* g, const float* b, f16_t* o16, float2* st) {
    const GAS f32x4* xr = (const GAS f32x4*)xrow + lane;
    f32x4 v[8]; float s = 0.f;
#pragma unroll
    for (int j = 0; j < 8; ++j) { v[j] = xr[64 * j]; s += (v[j].x + v[j].y) + (v[j].z + v[j].w); }
    const float mean = wave_sum_b(s) * (1.f / D); float s2 = 0.f;
#pragma unroll
    for (int j = 0; j < 8; ++j) { v[j] = v[j] - mean; s2 += (v[j].x * v[j].x + v[j].y * v[j].y) + (v[j].z * v[j].z + v[j].w * v[j].w); }
    const float rstd = __builtin_amdgcn_rsqf(wave_sum_b(s2) * (1.f / D) + LN_EPS);
    const GAS f32x4* g4 = (const GAS f32x4*)g + lane; const GAS f32x4* b4 = (const GAS f32x4*)b + lane;
    GAS unsigned long long* o8 = (GAS unsigned long long*)o16 + lane;
#pragma unroll
    for (int j = 0; j < 8; ++j) { const f32x4 o = v[j] * rstd * g4[64 * j] + b4[64 * j];
        o8[64 * j] = (unsigned long long)pk2h(o.x, o.y) | ((unsigned long long)pk2h(o.z, o.w) << 32); }
    if (lane == 0) *st = make_float2(mean, rstd);
}

__device__ __forceinline__ void p0_transpose_item_gu(const float* W, int K, int N, f16_t* WT, int gu_s, LAS float* scr, int item, int lane) {
    const int nblk = N / 32, nb = item % nblk; const int row_off = gu_s < 0 ? 0 : 128 * (nb >> 2) + 128 * gu_s;
    p0_transpose_item(W, K, N, WT, row_off, scr, item, lane);
}
__device__ __forceinline__ void ln_norm(int lane, f32x4 (&v)[8], const float* g, const float* b) {
    float s = 0.f;
#pragma unroll
    for (int j = 0; j < 8; ++j) s += (v[j].x + v[j].y) + (v[j].z + v[j].w);
    const float mean = wave_sum_b(s) * (1.f / D); float s2 = 0.f;
#pragma unroll
    for (int j = 0; j < 8; ++j) { v[j] = v[j] - mean; s2 += (v[j].x * v[j].x + v[j].y * v[j].y) + (v[j].z * v[j].z + v[j].w * v[j].w); }
    const float rstd = __builtin_amdgcn_rsqf(wave_sum_b(s2) * (1.f / D) + LN_EPS);
    const GAS f32x4* g4 = (const GAS f32x4*)g + lane; const GAS f32x4* b4 = (const GAS f32x4*)b + lane;
#pragma unroll
    for (int j = 0; j < 8; ++j) v[j] = v[j] * rstd * g4[64 * j] + b4[64 * j];
}
__device__ __forceinline__ void ln_store(int lane, const f32x4 (&v)[8], float* o32, f16_t* o16) {
    GAS f32x4* o4 = (GAS f32x4*)o32 + lane; GAS unsigned long long* o8 = (GAS unsigned long long*)o16 + lane;
#pragma unroll
    for (int j = 0; j < 8; ++j) { o4[64 * j] = v[j]; o8[64 * j] = (unsigned long long)pk2h(v[j].x, v[j].y) | ((unsigned long long)pk2h(v[j].z, v[j].w) << 32); }
}
__device__ __forceinline__ void ln_store16(int lane, const f32x4 (&v)[8], f16_t* o16) {
    GAS unsigned long long* o8 = (GAS unsigned long long*)o16 + lane;
#pragma unroll
    for (int j = 0; j < 8; ++j) o8[64 * j] = (unsigned long long)pk2h(v[j].x, v[j].y) | ((unsigned long long)pk2h(v[j].z, v[j].w) << 32);
}
__device__ __forceinline__ void ln_regs(int lane, f32x4 (&v)[8], const float* g, const float* b, float* o32, f16_t* o16) { ln_norm(lane, v, g, b); ln_store(lane, v, o32, o16); }
__device__ __forceinline__ void rt_stage(const float* src, LAS unsigned char* dst, int wave, int lane) {
#pragma unroll
    for (int i = 0; i < 6; ++i) __builtin_amdgcn_global_load_lds((const unsigned*)(src + 4 * (wave * 64 + lane + 512 * i)), (LAS unsigned*)(dst + (wave * 64 + 512 * i) * 16), 16, 0, 0);
}
__device__ __forceinline__ void route_pick(const float (&acc)[36], const float* gb, const float* eb, int& ea, int& ebb, float& wa, float& wb) {
    float gl[4]; float gm = -3.0e38f; int gi = 0;
#pragma unroll
    for (int i = 0; i < 4; ++i) { gl[i] = acc[i] + gb[i]; if (gl[i] > gm) { gm = gl[i]; gi = i; } }
    float gs = 0.f;
#pragma unroll
    for (int i = 0; i < 4; ++i) gs += __expf(gl[i] - gm);
    const float gtop = 1.f / gs;
    float el[8]; float em = -3.0e38f; int e0 = 0;
#pragma unroll
    for (int i = 0; i < 8; ++i) { float v = 0.f;
#pragma unroll
        for (int g = 0; g < 4; ++g) if (g == gi) v = acc[4 + g * 8 + i] + eb[g * 8 + i];
        el[i] = v; if (v > em) { em = v; e0 = i; } }
    float em2 = -3.0e38f; int e1 = 0;
#pragma unroll
    for (int i = 0; i < 8; ++i) if (i != e0 && el[i] > em2) { em2 = el[i]; e1 = i; }
    const float x1 = __expf(em2 - em);
    const float w0 = 1.f / (1.f + x1), w1 = x1 / (1.f + x1);
    ea = gi * 8 + e0; ebb = gi * 8 + e1; wa = w0 * gtop; wb = w1 * gtop;
}
constexpr int TAB_OFF = LDSCTL_OFF + 1024;
__device__ __forceinline__ void build_moe_table(Frame& F, const int* cnt) {
    LAS int* tab = (LAS int*)(F.lds + TAB_OFF);
    const int tid = FTID;
    if (tid < 32) tab[tid] = __hip_atomic_load(cnt + tid * CNT_STRIDE, __ATOMIC_RELAXED, __HIP_MEMORY_SCOPE_AGENT);
    __syncthreads();
    if (tid == 0) { int p = 0, pa = 0, pb = 0; for (int e = 0; e < 32; ++e) { const int nb = (tab[e] + 255) >> 8, na = nb < 2 ? nb : 2;
            tab[32 + e] = p; tab[65 + e] = pa; tab[98 + e] = pb; p += nb; pa += na; pb += nb - na; } tab[64] = p; tab[97] = pa; tab[130] = pb; }
    __syncthreads();
}

__device__ __forceinline__ float sum8_dpp(float x) {
    x += __builtin_bit_cast(float, __builtin_amdgcn_update_dpp(0, __builtin_bit_cast(int, x), 0xB1, 0xF, 0xF, true));
    x += __builtin_bit_cast(float, __builtin_amdgcn_update_dpp(0, __builtin_bit_cast(int, x), 0x4E, 0xF, 0xF, true));
    x += __builtin_bit_cast(float, __builtin_amdgcn_update_dpp(0, __builtin_bit_cast(int, x), 0x141, 0xF, 0xF, true));
    return x;
}
__device__ __forceinline__ float h2f(unsigned short u) { return (float)__builtin_bit_cast(_Float16, u); }
__device__ __forceinline__ float sum32_x(float x) {
    x += __builtin_bit_cast(float, __builtin_amdgcn_update_dpp(0, __builtin_bit_cast(int, x), 0xB1, 0xF, 0xF, true));
    x += __builtin_bit_cast(float, __builtin_amdgcn_update_dpp(0, __builtin_bit_cast(int, x), 0x4E, 0xF, 0xF, true));
    x += __builtin_bit_cast(float, __builtin_amdgcn_update_dpp(0, __builtin_bit_cast(int, x), 0x141, 0xF, 0xF, true));
    x += __builtin_bit_cast(float, __builtin_amdgcn_update_dpp(0, __builtin_bit_cast(int, x), 0x140, 0xF, 0xF, true));
    x += __builtin_bit_cast(float, __builtin_amdgcn_ds_bpermute((pg8::lane_id() ^ 16) << 2, __builtin_bit_cast(int, x)));
    return x;
}
__device__ __forceinline__ float wsum64(float x) {
    x = sum32_x(x); auto rr = __builtin_amdgcn_permlane32_swap(__float_as_uint(x), __float_as_uint(x), false, false); return __uint_as_float(rr[0]) + __uint_as_float(rr[1]);
}
__device__ __forceinline__ void rwkv_prep_tile(Frame& F, int tile, const f16_t* PROJ16, const f16_t* LSLAB, const float* mu, const float* w0, const f16_t* W2T, const float* a0, const f16_t* A2T, const f16_t* G2T,
                                               const float* k_k, const float* k_a, float* lwout, f16_t* kmod, f16_t* Aout, f16_t* Bout, f16_t* gout) {
    typedef _Float16 f16x8 __attribute__((ext_vector_type(8))); typedef float f32x16 __attribute__((ext_vector_type(16)));
    constexpr int SXS = 592;
    LAS unsigned char* sx = F.lds + RING_OFF;
    const int lane = FLANE, tid = F.wave * 64 + lane, t0 = tile * 32, r32 = lane & 31, hi = lane >> 5;
    __syncthreads();
    for (int e = tid; e < 32 * 36; e += 512) {
        typedef unsigned short us8v __attribute__((ext_vector_type(8)));
        const int tok = e / 36, i8 = (e % 36) * 8, pos = (t0 + tok) & (S - 1);
        float cv[8], pv[8];
#pragma unroll
        for (int i = 0; i < 8; ++i) { cv[i] = 0.f; pv[i] = 0.f; }
#pragma unroll
        for (int sl = 0; sl < 4; ++sl) { const f16_t* cur = LSLAB + ((size_t)sl * T + t0 + tok) * 512 + i8;
            const us8v c8 = *(const GAS us8v*)cur; us8v p8 = c8; if (pos > 0) p8 = *(const GAS us8v*)(cur - 512);
#pragma unroll
            for (int i = 0; i < 8; ++i) { cv[i] += h2f(c8[i]); pv[i] += h2f(p8[i]); } }
        float f[8];
#pragma unroll
        for (int i = 0; i < 8; ++i) { const float xs = cv[i] + ((pos > 0 ? pv[i] : 0.f) - cv[i]) * mu[3072 + i8 + i];
            f[i] = i8 < 64 ? 1.f - 2.f / (1.f + __expf(2.f * xs)) : (i8 < 128 ? xs : 1.f / (1.f + __expf(-xs))); }
        *(LAS v4u*)(sx + tok * SXS + i8 * 2) = (v4u){pk2h(f[0], f[1]), pk2h(f[2], f[3]), pk2h(f[4], f[5]), pk2h(f[6], f[7])};
    }
    __syncthreads();
    const LAS unsigned char* ap = sx + r32 * SXS + hi * 16;
#pragma unroll 1
    for (int hd = 0; hd < 2; ++hd) {
        const int ch0 = 128 * F.wave + 64 * hd;
        f32x16 aw[2], aa[2], ag[2];
#pragma unroll
        for (int tt = 0; tt < 2; ++tt)
#pragma unroll
            for (int r = 0; r < 16; ++r) { aw[tt][r] = 0.f; aa[tt][r] = 0.f; ag[tt][r] = 0.f; }
#pragma unroll
        for (int tt = 0; tt < 2; ++tt) {
            const int n = ch0 + 32 * tt + r32;
            const f16_t* bw = W2T + (size_t)n * 64 + hi * 8; const f16_t* ba = A2T + (size_t)n * 64 + hi * 8; const f16_t* bg = G2T + (size_t)n * 160 + hi * 8;
#pragma unroll
            for (int ks = 0; ks < 4; ++ks) {
                aw[tt] = __builtin_amdgcn_mfma_f32_32x32x16_f16(*(const LAS f16x8*)(ap + ks * 32), *(const GAS f16x8*)(bw + ks * 16), aw[tt], 0, 0, 0);
                aa[tt] = __builtin_amdgcn_mfma_f32_32x32x16_f16(*(const LAS f16x8*)(ap + 128 + ks * 32), *(const GAS f16x8*)(ba + ks * 16), aa[tt], 0, 0, 0); }
#pragma unroll
            for (int ks = 0; ks < 10; ++ks)
                ag[tt] = __builtin_amdgcn_mfma_f32_32x32x16_f16(*(const LAS f16x8*)(ap + 256 + ks * 32), *(const GAS f16x8*)(bg + ks * 16), ag[tt], 0, 0, 0);
        }
        float k0[2][16];
        float pkk[2], pka[2], pmu[2], pw0[2], pa0[2];
#pragma unroll
        for (int tt = 0; tt < 2; ++tt) { const int n = ch0 + 32 * tt + r32; pkk[tt] = k_k[n]; pka[tt] = k_a[n]; pmu[tt] = mu[1024 + n]; pw0[tt] = w0[n]; pa0[tt] = a0[n]; }
#pragma unroll
        for (int rh = 0; rh < 2; ++rh) {
        float inv[8];
#pragma unroll
        for (int r = 8 * rh; r < 8 * rh + 8; ++r) { const int tok = t0 + (r & 3) + 8 * (r >> 2) + 4 * hi, pos = tok & (S - 1); float ss = 0.f;
#pragma unroll
            for (int tt = 0; tt < 2; ++tt) { const f16_t* cur = PROJ16 + (size_t)tok * PN + 4096 + ch0 + 32 * tt + r32;
                const float cv = h2f(cur[0]), pv = pos > 0 ? h2f(cur[-PN]) : 0.f; k0[tt][r] = cv + (pv - cv) * pmu[tt]; const float kq = k0[tt][r] * pkk[tt]; ss = fmaf(kq, kq, ss); }
            ss = sum32_x(ss); inv[r - 8 * rh] = __builtin_amdgcn_rsqf(fmaxf(ss, 1e-24f)); }
#pragma unroll
        for (int r = 8 * rh; r < 8 * rh + 8; ++r) { const int tok = t0 + (r & 3) + 8 * (r >> 2) + 4 * hi;
#pragma unroll
            for (int tt = 0; tt < 2; ++tt) { const size_t o = (size_t)tok * RWK + ch0 + 32 * tt + r32;
                const float z = -(pw0[tt] + aw[tt][r]); const float sp = z > 20.f ? z : __logf(1.f + __expf(z));
                lwout[o] = -__expf(-sp - 0.5f);
                const float asig = 1.f / (1.f + __expf(-(pa0[tt] + aa[tt][r]))); const float kk = k0[tt][r] * pkk[tt] * inv[r - 8 * rh];
                kmod[o] = __builtin_bit_cast(unsigned short, (_Float16)(k0[tt][r] * (1.f + (asig - 1.f) * pka[tt])));
                Aout[o] = __builtin_bit_cast(unsigned short, (_Float16)(-kk)); Bout[o] = __builtin_bit_cast(unsigned short, (_Float16)(kk * asig));
                gout[o] = __builtin_bit_cast(unsigned short, (_Float16)ag[tt][r]); } }
        }
    }
}
__device__ __forceinline__ float sum16_dpp(float x) {
    x += __builtin_bit_cast(float, __builtin_amdgcn_update_dpp(0, __builtin_bit_cast(int, x), 0xB1, 0xF, 0xF, true));
    x += __builtin_bit_cast(float, __builtin_amdgcn_update_dpp(0, __builtin_bit_cast(int, x), 0x4E, 0xF, 0xF, true));
    x += __builtin_bit_cast(float, __builtin_amdgcn_update_dpp(0, __builtin_bit_cast(int, x), 0x141, 0xF, 0xF, true));
    x += __builtin_bit_cast(float, __builtin_amdgcn_update_dpp(0, __builtin_bit_cast(int, x), 0x140, 0xF, 0xF, true));
    return x;
}
__device__ __forceinline__ f32x4 h4f(const f16_t* p) { typedef _Float16 h4_t __attribute__((ext_vector_type(4))); const h4_t v = *(const GAS h4_t*)p; return (f32x4){(float)v[0], (float)v[1], (float)v[2], (float)v[3]}; }
#ifndef REP_P0
#define REP_P0 1
#endif
#ifndef REP_PROJ
#define REP_PROJ 1
#endif
#ifndef REP_PLE
#define REP_PLE 1
#endif
#ifndef REP_CONV
#define REP_CONV 1
#endif
#ifndef REP_P2
#define REP_P2 1
#endif
#ifndef CONV_RATE
#define CONV_RATE 768
#endif
#ifndef REP_P3
#define REP_P3 1
#endif
#ifndef PROBE_K
#define PROBE_K -1
#endif
#ifndef PROBE_J
#define PROBE_J -1
#endif
#ifndef PROBE_SCALE
#define PROBE_SCALE 1e-3f
#endif
#ifndef REP_P5
#define REP_P5 1
#endif
#ifndef REP_P8
#define REP_P8 1
#endif
#ifndef REP_P6
#define REP_P6 1
#endif
#ifndef REP_P7
#define REP_P7 1
#endif
struct Args { const float* in[37]; float* out; unsigned char* ws; int ph_lo, ph_hi, li, pad; };
__global__ void __launch_bounds__(NWAVES * 64, 2) mega_fwd(Args args) {
    extern __shared__ __attribute__((aligned(16))) unsigned char lds[];
    Frame F;
    F.lds = (LAS unsigned char*)lds; F.MISC = (volatile LAS unsigned*)(F.lds + MISC_OFF);
    F.wave = __builtin_amdgcn_readfirstlane(threadIdx.x >> 6);
    F.G = gridDim.x; { const int bx = blockIdx.x; F.vcu = (F.G % 8 == 0) ? (bx % 8) * (F.G / 8) + bx / 8 : bx; }
    unsigned char* ws = args.ws;
    F.ctl = (gu32*)(ws);
    for (int u = FTID; u < (LDS_BYTES - LDSCTL_OFF) / 4; u += NWAVES * 64) ((LAS unsigned*)(F.lds + LDSCTL_OFF))[u] = 0u;
    __syncthreads();
    XcdBarrier bar = xcd_barrier_post((unsigned*)(F.ctl + CW_BAR) + args.li * XCD_BAR_WORDS, F.MISC + 8);
    unsigned long long t0_ = 0, tk_ = 0; if (PROBE_K != -1) t0_ = __builtin_amdgcn_s_memrealtime();
    const int lo = args.ph_lo, hi = args.ph_hi;
#define IN(k) (lo <= (k) && (k) < hi)
#define BOTH(k) (IN(k) && IN((k) + 1))
    f16_t* WinT = (f16_t*)(ws + WS_WINT); f16_t* H16 = (f16_t*)(ws + WS_H16); f16_t* PROJ16 = (f16_t*)(ws + WS_PROJ16); float* DECAY = (float*)(ws + WS_DECAY); f16_t* KMOD = (f16_t*)(ws + WS_KMOD); f16_t* A16 = (f16_t*)(ws + WS_A16); f16_t* B16 = (f16_t*)(ws + WS_B16); f16_t* G16 = (f16_t*)(ws + WS_G16);
    f16_t* WoutT = (f16_t*)(ws + WS_WOUTT); f16_t* GateT = (f16_t*)(ws + WS_GATET); f16_t* PleT = (f16_t*)(ws + WS_PLET); f16_t* P16 = (f16_t*)(ws + WS_P16);
    f16_t* PW16 = (f16_t*)(ws + WS_PW16); f16_t* Y16 = (f16_t*)(ws + WS_Y16); float* ROWRS = (float*)(ws + WS_ROWRS);
    float* RT = (float*)(ws + WS_RT); f16_t* GUT = (f16_t*)(ws + WS_GUT); f16_t* DNT = (f16_t*)(ws + WS_DNT); f16_t* HID = (f16_t*)(ws + WS_HID); f16_t* FFN16 = (f16_t*)(ws + WS_FFN16); f16_t* H1_16 = (f16_t*)(ws + WS_H1_16);
    int* cnt = (int*)(ws + WS_CNT); int* ltok = (int*)(ws + WS_LTOK); int* lpair = (int*)(ws + WS_LPAIR); float* pairw = (float*)(ws + WS_PAIRW);
    const int gw = F.vcu * NWAVES + F.wave, NGW = F.G * NWAVES;
    if (IN(0)) for (int rep_ = 0; rep_ < REP_P0; ++rep_) {
        LAS float* scr = (LAS float*)(F.lds + RING_OFF + F.wave * 16384);
        constexpr int I_IN = (D / 64) * (NPROJ / 32);
        for (int it = gw; it < I_IN; it += NGW) p0_transpose_item(args.in[5], D, NPROJ, WinT, 0, scr, it, FLANE);
        constexpr int I_SQ = (D / 64) * (D / 32), I_PLE = (256 / 64) * (D / 32);
        for (int it = gw; it < 2 * I_SQ + I_PLE; it += NGW) {
            if (it < I_SQ) p0_transpose_item(args.in[22], D, D, WoutT, 0, scr, it, FLANE);
            else if (it < 2 * I_SQ) p0_transpose_item(args.in[36], D, D, GateT, 0, scr, it - I_SQ, FLANE);
            else p0_transpose_item(args.in[34], 256, D, PleT, 0, scr, it - 2 * I_SQ, FLANE);
        }
        { const GAS f32x4* pi = (const GAS f32x4*)args.in[1]; GAS unsigned long long* po = (GAS unsigned long long*)P16;
          for (int i = blockIdx.x * 512 + FTID; i < T * 256 / 4; i += F.G * 512) { const f32x4 v = pi[i]; po[i] = (unsigned long long)pk2h(v.x, v.y) | ((unsigned long long)pk2h(v.z, v.w) << 32); } }
        { GAS v4u* z = (GAS v4u*)(WinT + (size_t)NPROJ * D); const int nz = (PN - NPROJ) * D * 2 / 16;
          for (int i = blockIdx.x * 512 + FTID; i < nz; i += F.G * 512) z[i] = (v4u){0u, 0u, 0u, 0u}; }
        {
            f16_t* W2T = (f16_t*)(ws + WS_W2T); f16_t* A2T = (f16_t*)(ws + WS_A2T); f16_t* G2T = (f16_t*)(ws + WS_G2T);
            for (int i = blockIdx.x * 512 + FTID; i < 1024 * 288; i += F.G * 512) { const int n = i / 288, k = i % 288;
                if (k < 64) W2T[n * 64 + k] = __builtin_bit_cast(unsigned short, (_Float16)args.in[13][k * 1024 + n]);
                else if (k < 128) A2T[n * 64 + (k - 64)] = __builtin_bit_cast(unsigned short, (_Float16)args.in[15][(k - 64) * 1024 + n]);
                else G2T[n * 160 + (k - 128)] = __builtin_bit_cast(unsigned short, (_Float16)args.in[16][(k - 128) * 1024 + n]); } }
        if (blockIdx.x == 0) {
            const int tid = FTID; float* lamp = (float*)(ws + WS_LAM); float* biasT = (float*)(ws + WS_BIAS);
            if (tid < 64) { const float a = wave_sum_b(args.in[6][tid] * args.in[7][tid]), b2 = wave_sum_b(args.in[8][tid] * args.in[9][tid]); if (tid == 0) *lamp = expf(a) - expf(b2) + LAMBDA_INIT; }
            for (int i = tid; i < 8 * 129; i += 512) { const int hh = i / 129, n = i % 129; int bucket;
                if (n < 16) bucket = n; else { const int large = 16 + (int)(logf((float)n / 16.f) / 2.0794415416798357f * 16.f); bucket = large < 31 ? large : 31; }
                biasT[i] = args.in[4][bucket * 8 + hh]; }
        }
        for (int m = gw; m < T; m += NGW) ln_row_f16(FLANE, args.in[0] + (size_t)m * D, args.in[2], args.in[3], H16 + (size_t)m * D, (float2*)(ws + WS_ROWST) + m);
        if (BOTH(0) && rep_ == REP_P0 - 1) xcd_barrier(bar); else __syncthreads();
    }
    if (PROBE_K == 0) tk_ = __builtin_amdgcn_s_memrealtime();
    if (PROBE_J == 0) t0_ = __builtin_amdgcn_s_memrealtime();
    if (IN(1)) {
        pg8::Gemm g{H16, WinT, T, 6144, D, D}; pg8::StaticOrder S; S.init(T, 6144, F.G, (int)blockIdx.x);
        pg8::EpiF16 E{PROJ16, PN, 4, att::C2};
        for (int rep_ = 0; rep_ < REP_PROJ; ++rep_) pg8::gemm_phase<pg8::EpiF16, pg8::StaticOrder, true>(F.lds + RING_OFF, g, S, E, F.wave);
        { pg8::Gemm gl{H16, WinT + (size_t)6144 * D, T, 512, 512, D}; pg8::SplitKOrder Sl{T / 256, 2, 4, F.G, (int)blockIdx.x};
          pg8::EpiSlab El{(f16_t*)(ws + WS_LSLAB), 512, (size_t)T * 512};
          pg8::gemm_phase<pg8::EpiSlab, pg8::SplitKOrder, true>(F.lds + RING_OFF, gl, Sl, El, F.wave); }
        for (int rep_ = 0; rep_ < REP_PLE; ++rep_) { pg8::Gemm g2{P16, PleT, T, D, 256, 256}; pg8::StaticOrder S2; S2.init(T, D, F.G, (int)blockIdx.x);
          pg8::EpiF16 E2{PW16, D, 0, 1.f};
          pg8::gemm_phase<pg8::EpiF16, pg8::StaticOrder, true>(F.lds + RING_OFF, g2, S2, E2, F.wave); }
        if (BOTH(1)) xcd_barrier(bar);
    }
    if (PROBE_K == 1) tk_ = __builtin_amdgcn_s_memrealtime();
    if (PROBE_J == 1) t0_ = __builtin_amdgcn_s_memrealtime();
    if (IN(2)) {
        for (int rep_ = 0; rep_ < REP_P2; ++rep_)
        if (F.vcu < T / 32) { const int tile = F.vcu;
            rwkv_prep_tile(F, tile, PROJ16, (const f16_t*)(ws + WS_LSLAB), args.in[11], args.in[12], (const f16_t*)(ws + WS_W2T), args.in[14], (const f16_t*)(ws + WS_A2T), (const f16_t*)(ws + WS_G2T), args.in[17], args.in[18], DECAY, KMOD, A16, B16, G16);
            asm volatile("s_waitcnt vmcnt(0)" ::: "memory"); __syncthreads();
            { rk::ChunkIn nin; const int tl_ = (F.wave & 3) * 64 + FLANE, tg_ = tile * 32 + (tl_ >> 3), ps_ = tg_ & (S - 1), cb_ = (F.wave >> 2) * 64 + (tl_ & 7) * 8;
              rk::chunk_load(nin, tg_, ps_, cb_, ws);
              for (int hA = 0; hA < 16; hA += 2) {
                  rk::chunk_pair(F.lds + RING_OFF, F.wave, tile, hA, nin, hA + 2 < 16, args.in[11], args.in[19], ws); } }
            __syncthreads();
        }
        if (BOTH(2)) xcd_barrier(bar);
    }
    if (PROBE_K == 2) tk_ = __builtin_amdgcn_s_memrealtime();
    if (PROBE_J == 2) t0_ = __builtin_amdgcn_s_memrealtime();
    if (IN(3)) {
        if (F.vcu < 64) rk::scan_unit(F.lds + RING_OFF, F.wave, F.vcu, ws + WS_CHK, (const float*)(ws + WS_BONUS), PROJ16, args.in[11], G16, args.in[20], args.in[21], Y16);
        {
            const float lam = *(const float*)(ws + WS_LAM);
            volatile LAS unsigned* qslot = F.MISC + 12;
            const float* wg = args.in[29]; const float* wu = args.in[30]; const float* wd = args.in[31];
            auto conv_batch = [&]() -> bool {
                __syncthreads();
                if (FTID == 0) qslot[1] = __hip_atomic_fetch_add(F.ctl + CW_CONVQ, 1u, __ATOMIC_RELAXED, __HIP_MEMORY_SCOPE_AGENT);
                __syncthreads();
                const int q = (int)__builtin_amdgcn_readfirstlane(qslot[1]);
                if (q >= NE * 1536 / 64) return false;
                LAS unsigned char* scr = F.lds + RING_OFF + F.wave * 16384;
                tpd_stream(q * 64 + F.wave, q * 64 + 64, 8, [=](int it) { const int e = it / 1536, r = it % 1536;
                    if (r < 1024) { const int rr = r & 511, nb = rr % 16; return TpDesc{(r < 512 ? wg : wu) + (size_t)e * D * 512, GUT + (size_t)e * 1024 * D, D, 512, 128 * (nb >> 2) + (r < 512 ? 0 : 128), rr}; }
                    return TpDesc{wd + (size_t)e * 512 * D, DNT + (size_t)e * D * 512, 512, D, 0, r - 1024}; }, scr, FLANE);
                return true;
            };
            int credit = 0;
            for (;;) {
                __syncthreads();
                if (FTID == 0) *qslot = __hip_atomic_fetch_add(F.ctl + CW_ATTQ, 1u, __ATOMIC_RELAXED, __HIP_MEMORY_SCOPE_AGENT);
                __syncthreads();
                const int u = (int)__builtin_amdgcn_readfirstlane(*qslot);
                if (u >= 512) break;
                const int qb = 15 - (u >> 5), bh = u & 31;
                att::attn_unit<8>(F.lds + RING_OFF, F.wave, bh >> 3, bh & 7, qb, PROJ16, Y16, (const float*)(ws + WS_BIAS) + (bh & 7) * 129, lam, args.in[10]);
                credit += 2 * (qb + 1) * CONV_RATE;
                while (credit >= 8704) { credit -= 8704; if (!conv_batch()) { credit = 0; break; } }
            }
            while (conv_batch()) {}
        }
        if (BOTH(3)) xcd_barrier(bar);
    }
    if (PROBE_K == 3) tk_ = __builtin_amdgcn_s_memrealtime();
    if (PROBE_J == 3) t0_ = __builtin_amdgcn_s_memrealtime();
    if (IN(4)) {
        for (int i = blockIdx.x * 512 + FTID; i < 36 * D; i += F.G * 512) { const int e = i / D, d = i % D; RT[i] = e < 4 ? args.in[25][d * 4 + e] : args.in[27][d * 32 + (e - 4)]; }
        pg8::Gemm g{Y16, WoutT, T, D, D, D}; pg8::StaticOrder S; S.init(T, D, F.G, (int)blockIdx.x);
        pg8::EpiResLN E{args.in[0], args.out, D, ALPHA, (const float2*)(ws + WS_ROWST), args.in[2], args.in[3]};
        pg8::gemm_phase<pg8::EpiResLN, pg8::StaticOrder, true>(F.lds + RING_OFF, g, S, E, F.wave);
        if (BOTH(4)) xcd_barrier(bar);
    }
    if (PROBE_K == 4) tk_ = __builtin_amdgcn_s_memrealtime();
    if (PROBE_J == 4) t0_ = __builtin_amdgcn_s_memrealtime();
    if (IN(5)) for (int rep_ = 0; rep_ < REP_P5; ++rep_) {
        const bool dry = rep_ < REP_P5 - 1;
        f16_t* o16b = dry ? (f16_t*)(ws + WS_CHK + 64 * MiB) : H1_16;
        const int lane = FLANE, tid = F.wave * 64 + lane;
        LAS float* lg = (LAS float*)(F.lds + RING_OFF + 49152) + F.wave * 256;
        LAS int* lcnt = (LAS int*)(F.lds + RING_OFF + 106496);
        if (F.wave == 0 && lane < 32) lcnt[lane] = 0;
        if (F.vcu < T / 32) {
            const int r0 = F.vcu * 32 + F.wave * 4;
            f32x4 v0[8], v1[8], v2[8], v3[8];
            { const GAS f32x4* xr = (const GAS f32x4*)(args.out + (size_t)r0 * D) + lane;
#pragma unroll
              for (int j = 0; j < 8; ++j) { v0[j] = xr[64 * j]; v1[j] = xr[64 * j + D / 4]; v2[j] = xr[64 * j + 2 * (D / 4)]; v3[j] = xr[64 * j + 3 * (D / 4)]; } }
            rt_stage(RT, F.lds + RING_OFF, F.wave, lane);
            ln_norm(lane, v0, args.in[23], args.in[24]); ln_norm(lane, v1, args.in[23], args.in[24]); asm volatile("" ::: "memory"); ln_norm(lane, v2, args.in[23], args.in[24]); ln_norm(lane, v3, args.in[23], args.in[24]);
#pragma unroll 1
            for (int ec = 0; ec < 6; ++ec) {
                asm volatile("s_waitcnt vmcnt(0)" ::: "memory"); __syncthreads();
                if (ec + 1 < 6) rt_stage(RT + (size_t)(ec + 1) * 6 * D, F.lds + RING_OFF + ((ec + 1) & 1) * 57344, F.wave, lane);
                const LAS float* rtb = (const LAS float*)(F.lds + RING_OFF + (ec & 1) * 57344);
                float a0[6], a1[6], a2[6], a3[6];
                typedef float f32x2 __attribute__((ext_vector_type(2)));
#pragma unroll
                for (int eh = 0; eh < 2; ++eh) {
                    f32x2 c0[3], c1[3], c2[3], c3[3];
#pragma unroll
                    for (int e = 0; e < 3; ++e) { c0[e] = 0.f; c1[e] = 0.f; c2[e] = 0.f; c3[e] = 0.f; }
#pragma unroll
                    for (int j = 0; j < 8; ++j)
#pragma unroll
                        for (int e = 0; e < 3; ++e) { const f32x4 w = *(const LAS f32x4*)(rtb + (3 * eh + e) * D + 256 * j + 4 * lane); const f32x2 wl = w.xy, wh = w.zw;
                            c0[e] += v0[j].xy * wl; c0[e] += v0[j].zw * wh; c1[e] += v1[j].xy * wl; c1[e] += v1[j].zw * wh;
                            c2[e] += v2[j].xy * wl; c2[e] += v2[j].zw * wh; c3[e] += v3[j].xy * wl; c3[e] += v3[j].zw * wh; }
#pragma unroll
                    for (int e = 0; e < 3; ++e) { a0[3 * eh + e] = c0[e].x + c0[e].y; a1[3 * eh + e] = c1[e].x + c1[e].y; a2[3 * eh + e] = c2[e].x + c2[e].y; a3[3 * eh + e] = c3[e].x + c3[e].y; }
                }
#pragma unroll
                for (int e = 0; e < 6; ++e) { a0[e] = wsum64(a0[e]); a1[e] = wsum64(a1[e]); a2[e] = wsum64(a2[e]); a3[e] = wsum64(a3[e]); }
                if (lane == 0) {
#pragma unroll
                    for (int e = 0; e < 6; ++e) { lg[ec * 6 + e] = a0[e]; lg[64 + ec * 6 + e] = a1[e]; lg[128 + ec * 6 + e] = a2[e]; lg[192 + ec * 6 + e] = a3[e]; } }
            }
            LDS_WAIT();
            int ea = 0, ebb = 0, pl0 = 0, pl1 = 0; float wa = 0.f, wb = 0.f;
            if (lane < 4 && !dry) { float aa[36];
#pragma unroll
                for (int e = 0; e < 36; ++e) aa[e] = lg[lane * 64 + e];
                route_pick(aa, args.in[26], args.in[28], ea, ebb, wa, wb);
                pl0 = __hip_atomic_fetch_add(lcnt + ea, 1, __ATOMIC_RELAXED, __HIP_MEMORY_SCOPE_WORKGROUP); pl1 = __hip_atomic_fetch_add(lcnt + ebb, 1, __ATOMIC_RELAXED, __HIP_MEMORY_SCOPE_WORKGROUP); }
            __syncthreads();
            if (F.wave == 0 && lane < 32 && !dry) { const int c = lcnt[lane]; int base = 0; if (c) base = atomicAdd(&cnt[lane * CNT_STRIDE], c); lcnt[32 + lane] = base; }
            __syncthreads();
            if (lane < 4 && !dry) { const int tok = r0 + lane; const int p0 = lcnt[32 + ea] + pl0, p1 = lcnt[32 + ebb] + pl1;
                ltok[ea * 8192 + p0] = tok; lpair[ea * 8192 + p0] = tok * 2; ltok[ebb * 8192 + p1] = tok; lpair[ebb * 8192 + p1] = tok * 2 + 1;
                pairw[tok * 2] = wa; pairw[tok * 2 + 1] = wb; }
            ln_store16(lane, v0, o16b + (size_t)r0 * D); ln_store16(lane, v1, o16b + (size_t)(r0 + 1) * D);
            ln_store16(lane, v2, o16b + (size_t)(r0 + 2) * D); ln_store16(lane, v3, o16b + (size_t)(r0 + 3) * D);
        }
        if (BOTH(5) && !dry) xcd_barrier(bar); else __syncthreads();
    }
    if (PROBE_K == 5) tk_ = __builtin_amdgcn_s_memrealtime();
    if (PROBE_J == 5) t0_ = __builtin_amdgcn_s_memrealtime();
    if (IN(6)) {
        build_moe_table(F, cnt);
        pg8::Gemm g{H1_16, GUT, 0, 0, D, D}; pg8::MoeOrder<true> S{(const LAS int*)(F.lds + TAB_OFF), ltok, F.vcu, F.G, 4, (size_t)1024 * D * 2, 0};
        pg8::EpiGU E{HID};
        for (int rep_ = 0; rep_ < REP_P6; ++rep_) pg8::gemm_phase<pg8::EpiGU, pg8::MoeOrder<true>, true>(F.lds + RING_OFF, g, S, E, F.wave);
        if (BOTH(6)) xcd_barrier(bar);
    }
    if (PROBE_K == 6) tk_ = __builtin_amdgcn_s_memrealtime();
    if (PROBE_J == 6) t0_ = __builtin_amdgcn_s_memrealtime();
    if (IN(7)) {
        build_moe_table(F, cnt);
        const pg8::Gemm gU{H1_16, GUT, 0, 0, D, D}; const pg8::Gemm gD{HID, DNT, 0, 0, 512, 512};
        const pg8::EpiGU EU{HID}; const pg8::EpiDown ED{FFN16, lpair};
        if (F.vcu < 64) { pg8::MoeOrder<true> S{(const LAS int*)(F.lds + TAB_OFF), ltok, F.vcu, 64, 4, (size_t)1024 * D * 2, 1};
            pg8::gemm_phase<pg8::EpiGU, pg8::MoeOrder<true>, true>(F.lds + RING_OFF, gU, S, EU, F.wave); }
        else { pg8::MoeOrder<false> S{(const LAS int*)(F.lds + TAB_OFF), nullptr, F.vcu - 64, F.G - 64, 8, (size_t)D * 512 * 2, 0};
            pg8::gemm_phase<pg8::EpiDown, pg8::MoeOrder<false>, true>(F.lds + RING_OFF, gD, S, ED, F.wave); }
        xcd_barrier(bar);
        { pg8::MoeOrder<false> S{(const LAS int*)(F.lds + TAB_OFF), nullptr, F.vcu, F.G, 8, (size_t)D * 512 * 2, 1};
          pg8::gemm_phase<pg8::EpiDown, pg8::MoeOrder<false>, true>(F.lds + RING_OFF, gD, S, ED, F.wave); }
        if (BOTH(7)) xcd_barrier(bar);
    }
    if (PROBE_K == 7) tk_ = __builtin_amdgcn_s_memrealtime();
    if (PROBE_J == 7) t0_ = __builtin_amdgcn_s_memrealtime();
    if (IN(8)) for (int rep_ = 0; rep_ < REP_P8; ++rep_) {
        const bool dry = rep_ < REP_P8 - 1;
        f16_t* o16b = dry ? (f16_t*)(ws + WS_GUT + 64 * MiB) : Y16; float* rrs = dry ? (float*)(ws + WS_GUT + 100 * MiB) : ROWRS;
        typedef _Float16 h4_t __attribute__((ext_vector_type(4)));
        const int lane = FLANE;
        for (int m = gw; m < T; m += NGW) {
            f32x4 v[8]; const GAS h4_t* xr = (const GAS h4_t*)(H1_16 + (size_t)m * D) + lane;
            const GAS h4_t* f0 = (const GAS h4_t*)(FFN16 + (size_t)(2 * m) * D) + lane; const GAS h4_t* f1 = (const GAS h4_t*)(FFN16 + (size_t)(2 * m + 1) * D) + lane;
            const GAS h4_t* pr = (const GAS h4_t*)(PW16 + (size_t)m * D) + lane;
            const float w0 = pairw[2 * m], w1 = pairw[2 * m + 1]; float q = 0.f;
#pragma unroll
            for (int j = 0; j < 8; ++j) { const h4_t x = xr[64 * j]; const h4_t a = f0[64 * j], c = f1[64 * j], pv = pr[64 * j];
                v[j].x = ALPHA * (float)x[0] + w0 * (float)a[0] + w1 * (float)c[0]; v[j].y = ALPHA * (float)x[1] + w0 * (float)a[1] + w1 * (float)c[1];
                v[j].z = ALPHA * (float)x[2] + w0 * (float)a[2] + w1 * (float)c[2]; v[j].w = ALPHA * (float)x[3] + w0 * (float)a[3] + w1 * (float)c[3];
                q += ((float)pv[0] * (float)pv[0] + (float)pv[1] * (float)pv[1]) + ((float)pv[2] * (float)pv[2] + (float)pv[3] * (float)pv[3]); }
            ln_norm(lane, v, args.in[32], args.in[33]); ln_store16(lane, v, o16b + (size_t)m * D);
            q = wave_sum_b(q);
            if (lane == 0) rrs[m] = __builtin_amdgcn_rsqf(q * (1.f / D) + LN_EPS);
        }
        if (BOTH(8) && !dry) xcd_barrier(bar); else __syncthreads();
    }
    if (PROBE_K == 8) tk_ = __builtin_amdgcn_s_memrealtime();
    if (PROBE_J == 8) t0_ = __builtin_amdgcn_s_memrealtime();
    if (IN(9)) {
        pg8::Gemm g{Y16, GateT, T, D, D, D}; pg8::StaticOrder S; S.init(T, D, F.G, (int)blockIdx.x);
        pg8::EpiFinal E{args.out, D, Y16, PW16, ROWRS, args.in[35]};
        pg8::gemm_phase<pg8::EpiFinal, pg8::StaticOrder, true>(F.lds + RING_OFF, g, S, E, F.wave);
    }
    if (PROBE_K != -1) {
        if (PROBE_K == 9) tk_ = __builtin_amdgcn_s_memrealtime();
        xcd_barrier(bar);
        if (blockIdx.x == 0 && FTID == 0) args.out[0] += (PROBE_K == -2) ? 100000.f : (float)(tk_ - t0_) * PROBE_SCALE;
    }
#undef IN
#undef BOTH
}

extern "C" void kernel_launch(void* const* d_in, const int* in_sizes, int n_in, void* d_out, int out_size, void* d_ws, size_t ws_size, hipStream_t stream) {
    static int grid = 0;
    if (grid == 0) {
        if (ws_size < WS_END2 || n_in != 37 || out_size != T * D) { fprintf(stderr, "kernel_launch: bad ws/n_in/out: %zu %d %d\n", ws_size, n_in, out_size); grid = -1; return; }
        int dev = 0, cus = 0;
        if (hipGetDevice(&dev) != hipSuccess || hipDeviceGetAttribute(&cus, hipDeviceAttributeMultiprocessorCount, dev) != hipSuccess) { grid = -1; return; }
        if (hipFuncSetAttribute((const void*)mega_fwd, hipFuncAttributeMaxDynamicSharedMemorySize, LDS_BYTES) != hipSuccess) { fprintf(stderr, "kernel_launch: hipFuncSetAttribute failed\n"); grid = -1; return; }
        if (cus != 256) { fprintf(stderr, "kernel_launch: built for a 256-CU device, found %d\n", cus); grid = -1; return; }
        grid = cus;
    }
    if (grid < 0) return;
    (void)hipMemsetAsync(d_ws, 0, CTL_ZERO_BYTES, stream);
    Args a{}; for (int i = 0; i < 37; ++i) a.in[i] = (const float*)d_in[i]; a.out = (float*)d_out; a.ws = (unsigned char*)d_ws; a.ph_lo = 0; a.ph_hi = 10; a.li = 0;
    hipLaunchKernelGGL(mega_fwd, dim3(grid), dim3(NWAVES * 64), LDS_BYTES, stream, a);
}
```

```cpp
#include <hip/hip_runtime.h>
#include <cstdio>
#include <cstdint>
#include <cmath>

constexpr int NB = 4, S = 2048, D = 2048, T = NB * S;
constexpr int NPROJ = 6432;
constexpr int RWK = 1024;
constexpr int COL_Q = 0, COL_K = 1024, COL_V = 2048, COL_RW = 3072;
constexpr int NH = 8, NRH = 16;
constexpr int NE = 32;
constexpr float LN_EPS = 1e-5f;
constexpr float ALPHA = 1.189207115002721f;
constexpr float LAMBDA_INIT = 0.2f;

constexpr size_t MiB = 1u << 20;
constexpr size_t WS_CNT = 4096;
constexpr int CNT_STRIDE = 32;
constexpr size_t WS_LTOK = 1 * MiB;
constexpr size_t WS_LPAIR = 2 * MiB;
constexpr size_t WS_PAIRW = 3 * MiB;
constexpr size_t WS_RT = 3 * MiB + 128 * 1024;
constexpr size_t WS_LAM = 3 * MiB + 512 * 1024;
constexpr size_t WS_BIAS = 3 * MiB + 512 * 1024 + 1024;
constexpr size_t WS_ROWRS = 3 * MiB + 768 * 1024;
constexpr size_t WS_ROWST = 3 * MiB + 832 * 1024;
constexpr size_t WS_WINT = 4 * MiB;
constexpr size_t WS_WOUTT = 30 * MiB;
constexpr size_t WS_GATET = 38 * MiB;
constexpr size_t WS_PLET = 46 * MiB;
constexpr size_t WS_P16 = 47 * MiB;
constexpr size_t WS_W2T = 51 * MiB;
constexpr size_t WS_A2T = 51 * MiB + 128 * 1024;
constexpr size_t WS_G2T = 51 * MiB + 256 * 1024;
constexpr size_t WS_CHK = 52 * MiB;
constexpr size_t WS_BONUS = 148 * MiB;
constexpr size_t WS_LSLAB = 150 * MiB;
constexpr size_t WS_GUT = 348 * MiB;
constexpr size_t WS_DNT = 150 * MiB;
constexpr size_t WS_PROJ16 = 244 * MiB;
constexpr size_t WS_FFN16 = 52 * MiB;
constexpr size_t WS_HID = 116 * MiB;
constexpr size_t WS_DECAY = 348 * MiB;
constexpr size_t WS_KMOD = 380 * MiB;
constexpr size_t WS_A16 = 396 * MiB;
constexpr size_t WS_B16 = 412 * MiB;
constexpr size_t WS_G16 = 214 * MiB;
constexpr size_t WS_H16 = 444 * MiB;
constexpr size_t WS_H1_16 = 244 * MiB;
constexpr size_t WS_Y16 = 476 * MiB;
constexpr size_t WS_PW16 = 508 * MiB;
constexpr size_t WS_END2 = 540 * MiB;

namespace pg8 {
#define PG8_LAS __attribute__((address_space(3)))
typedef unsigned short f16_t;
typedef _Float16 f16x8 __attribute__((ext_vector_type(8)));
typedef float f32x4 __attribute__((ext_vector_type(4)));
typedef unsigned u32x4 __attribute__((ext_vector_type(4)));
constexpr int BM = 256, BK = 64, HALF = 128, HTB = HALF * BK * 2  , STAGE_BYTES = 8 * HTB, NXCD = 8, WGM = 8;

__host__ __device__ __forceinline__ int lds_byte(int r, int c) { const int st = (r >> 4) * 2 + (c >> 5), rr = r & 15, cc = c & 31, ob = rr * 64 + cc * 2; return st * 1024 + (ob ^ (((ob >> 9) & 1) << 5)); }
__host__ __device__ __forceinline__ void stage_rc(int b, int& R, int& C) { const int st = b / 1024, sb = b % 1024, swz = sb ^ (((sb >> 9) & 1) << 5); R = (st >> 1) * 16 + swz / 64; C = (st & 1) * 32 + (swz % 64) / 2; }
__host__ __device__ __forceinline__ int perm32(int rho) { const int n = rho >> 4, i = rho & 15; return 8 * (i >> 2) + 4 * n + (i & 3); }

__device__ __forceinline__ int lane_id() { int l; asm volatile("v_mbcnt_lo_u32_b32 %0, -1, 0\n\tv_mbcnt_hi_u32_b32 %0, -1, %0" : "=v"(l)); return l; }
struct Unit { int pm, pn, e, rb, cnt; };
struct Gemm { const f16_t* A; const f16_t* Bt; int M, N, K, ld; };

struct StaticOrder {
    int nM, nN, nwg, G, c;
    __host__ __device__ void init(int M, int N, int G_, int c_) { nM = M / BM; nN = N / BM; nwg = nM * nN; G = G_; c = c_; }
    __host__ __device__ bool next(int i, Unit& u) const {
        const long L = (long)i * G + c; if (L >= nwg) return false;
        int wgid = (int)L; { const int q = nwg / NXCD, r = nwg % NXCD, xcd = wgid % NXCD, off = wgid / NXCD; wgid = (xcd < r ? xcd * (q + 1) : r * (q + 1) + (xcd - r) * q) + off; }
        const int nig = WGM * nN, gid = wgid / nig, fm = gid * WGM, gsz = (nM - fm) < WGM ? (nM - fm) : WGM;
        u.pm = fm + ((wgid % nig) % gsz); u.pn = (wgid % nig) / gsz; return true;
    }
    __device__ __forceinline__ void a_ready(const Unit&) const {}
    __device__ __forceinline__ void done(const Unit&) const {}
    __device__ __forceinline__ const char* a_base(const Gemm& g, const Unit& u) const { return (const char*)g.A + (size_t)u.pm * ((size_t)BM * g.ld * 2); }
    __device__ __forceinline__ const char* b_base(const Gemm& g, const Unit& u) const { return (const char*)g.Bt + (size_t)u.pn * ((size_t)BM * g.ld * 2); }
    __device__ __forceinline__ void a_voff(const Gemm& g, const Unit&, int tid, unsigned (&va)[2][2]) const {
#pragma unroll
        for (int i = 0; i < 2; ++i) { int R, C; stage_rc(tid * 16 + i * 8192, R, C); va[0][i] = (unsigned)(R * g.ld + C) * 2u; va[1][i] = va[0][i] + (unsigned)(HALF * g.ld * 2); }
    }
};
struct SplitKOrder {
    int nM, nN, nks, G, c;
    __device__ __forceinline__ bool next(int i, Unit& u) const { const int L = i * G + c; if (L >= nM * nN * nks) return false; u.e = L / (nM * nN); const int rem = L % (nM * nN); u.pn = rem / nM; u.pm = rem % nM; u.rb = 0; u.cnt = 0; return true; }
    __device__ __forceinline__ void a_ready(const Unit&) const {}
    __device__ __forceinline__ void done(const Unit&) const {}
    __device__ __forceinline__ const char* a_base(const Gemm& g, const Unit& u) const { return (const char*)g.A + (size_t)u.pm * ((size_t)BM * g.ld * 2) + (size_t)u.e * g.K * 2; }
    __device__ __forceinline__ const char* b_base(const Gemm& g, const Unit& u) const { return (const char*)g.Bt + (size_t)u.pn * ((size_t)BM * g.ld * 2) + (size_t)u.e * g.K * 2; }
    __device__ __forceinline__ void a_voff(const Gemm& g, const Unit&, int tid, unsigned (&va)[2][2]) const {
#pragma unroll
        for (int i = 0; i < 2; ++i) { int R, C; stage_rc(tid * 16 + i * 8192, R, C); va[0][i] = (unsigned)(R * g.ld + C) * 2u; va[1][i] = va[0][i] + (unsigned)(HALF * g.ld * 2); }
    }
};
template <bool GATHER> struct MoeOrder {
    const PG8_LAS int* tab; const int* list; int vcu, G, ntn; size_t estride; int cls;
    __device__ __forceinline__ bool next(int i, Unit& u) const {
        const int L = vcu + i * G; const int base = cls ? 98 : 65; const int tot = tab[base + 32] * ntn; if (L >= tot) return false;
        int e = 0; while (tab[base + 1 + e] * ntn <= L) ++e;
        const int nbk = tab[base + 1 + e] - tab[base + e], q = L - tab[base + e] * ntn; const int rb = q % nbk + (cls ? 2 : 0);
        u.e = __builtin_amdgcn_readfirstlane(e); u.pn = __builtin_amdgcn_readfirstlane(q / nbk); u.rb = __builtin_amdgcn_readfirstlane(rb);
        u.pm = __builtin_amdgcn_readfirstlane(tab[32 + e] + rb); u.cnt = __builtin_amdgcn_readfirstlane(tab[e]); return true;
    }
    __device__ __forceinline__ void a_ready(const Unit&) const {}
    __device__ __forceinline__ void done(const Unit&) const {}
    __device__ __forceinline__ const char* a_base(const Gemm& g, const Unit& u) const { return GATHER ? (const char*)g.A : (const char*)g.A + (size_t)u.pm * ((size_t)BM * g.ld * 2); }
    __device__ __forceinline__ const char* b_base(const Gemm& g, const Unit& u) const { return (const char*)g.Bt + (size_t)u.e * estride + (size_t)u.pn * ((size_t)BM * g.ld * 2); }
    __device__ __forceinline__ void a_voff(const Gemm& g, const Unit& u, int tid, unsigned (&va)[2][2]) const {
#pragma unroll
        for (int i = 0; i < 2; ++i) { int R, C; stage_rc(tid * 16 + i * 8192, R, C);
            if (GATHER) {
#pragma unroll
                for (int h = 0; h < 2; ++h) { int idx = u.rb * BM + h * HALF + R; idx = idx < u.cnt ? idx : u.cnt - 1; const int tok = list[u.e * 8192 + idx]; va[h][i] = (unsigned)(tok * g.ld + C) * 2u; }
            } else { va[0][i] = (unsigned)(R * g.ld + C) * 2u; va[1][i] = va[0][i] + (unsigned)(HALF * g.ld * 2); } }
    }
};


typedef _Float16 h2_t __attribute__((ext_vector_type(2)));
__device__ __forceinline__ unsigned cvt_pk_f16(float lo, float hi) { h2_t v = {(_Float16)lo, (_Float16)hi}; return __builtin_bit_cast(unsigned, v); }
struct EpiF16 {
    static constexpr bool PERM = true, AFTER_DRAIN = false;
    f16_t* O; int ldc; int ntile0; float scale0;
    __device__ __forceinline__ void operator()(const f32x4 (&acc)[2][2][4][2], const Unit& u, int wr, int wc, int fr, int fq) const {
        const int row0 = u.pm * BM + wr * 64 + fr; const int col0 = u.pn * BM + wc * 32 + 8 * fq;
        const float sc = (u.pn < ntile0) ? scale0 : 1.f;
#pragma unroll
        for (int ai = 0; ai < 2; ++ai)
#pragma unroll
            for (int m = 0; m < 4; ++m) { f16_t* rowp = O + (size_t)(row0 + ai * HALF + m * 16) * ldc + col0;
#pragma unroll
                for (int bj = 0; bj < 2; ++bj) { f32x4 v0 = acc[ai][bj][m][0] * sc, v1 = acc[ai][bj][m][1] * sc;
                    u32x4 w; w.x = cvt_pk_f16(v0[0], v0[1]); w.y = cvt_pk_f16(v0[2], v0[3]); w.z = cvt_pk_f16(v1[0], v1[1]); w.w = cvt_pk_f16(v1[2], v1[3]);
                    *(u32x4*)(rowp + bj * HALF) = w; } }
    }
};


struct EpiSlab {
    static constexpr bool PERM = true, AFTER_DRAIN = false;
    f16_t* O; int ldc; size_t slab;
    __device__ __forceinline__ void operator()(const f32x4 (&acc)[2][2][4][2], const Unit& u, int wr, int wc, int fr, int fq) const {
        const int row0 = u.pm * BM + wr * 64 + fr; const int col0 = u.pn * BM + wc * 32 + 8 * fq; f16_t* Ob = O + (size_t)u.e * slab;
#pragma unroll
        for (int ai = 0; ai < 2; ++ai)
#pragma unroll
            for (int m = 0; m < 4; ++m) { f16_t* rowp = Ob + (size_t)(row0 + ai * HALF + m * 16) * ldc + col0;
#pragma unroll
                for (int bj = 0; bj < 2; ++bj) { const f32x4 v0 = acc[ai][bj][m][0], v1 = acc[ai][bj][m][1];
                    u32x4 w; w.x = cvt_pk_f16(v0[0], v0[1]); w.y = cvt_pk_f16(v0[2], v0[3]); w.z = cvt_pk_f16(v1[0], v1[1]); w.w = cvt_pk_f16(v1[2], v1[3]);
                    *(u32x4*)(rowp + bj * HALF) = w; } }
    }
};
struct EpiResF32 {
    static constexpr bool PERM = false, AFTER_DRAIN = false;
    float* io; int ldc; float alpha;
    __device__ __forceinline__ void operator()(const f32x4 (&acc)[2][2][4][2], const Unit& u, int wr, int wc, int fr, int fq) const {
        const int row0 = u.pm * BM + wr * 64 + fr; const int col0 = u.pn * BM + wc * 32 + 4 * fq;
#pragma unroll
        for (int ai = 0; ai < 2; ++ai)
#pragma unroll
            for (int m = 0; m < 4; ++m) { float* rowp = io + (size_t)(row0 + ai * HALF + m * 16) * ldc + col0;
#pragma unroll
                for (int bj = 0; bj < 2; ++bj)
#pragma unroll
                    for (int n = 0; n < 2; ++n) { f32x4* p = (f32x4*)(rowp + bj * HALF + n * 16); const f32x4 r = *p; *p = r * alpha + acc[ai][bj][m][n]; } }
    }
};
struct EpiResLN {
    static constexpr bool PERM = false, AFTER_DRAIN = false;
    const float* x; float* out; int ldc; float alpha; const float2* st; const float* g; const float* b;
    __device__ __forceinline__ void operator()(const f32x4 (&acc)[2][2][4][2], const Unit& u, int wr, int wc, int fr, int fq) const {
        const int row0 = u.pm * BM + wr * 64 + fr; const int col0 = u.pn * BM + wc * 32 + 4 * fq;
        f32x4 gg[2][2], bb[2][2];
#pragma unroll
        for (int bj = 0; bj < 2; ++bj)
#pragma unroll
            for (int n = 0; n < 2; ++n) { gg[bj][n] = *(const f32x4*)(g + col0 + bj * HALF + n * 16); bb[bj][n] = *(const f32x4*)(b + col0 + bj * HALF + n * 16); }
#pragma unroll
        for (int ai = 0; ai < 2; ++ai)
#pragma unroll
            for (int m = 0; m < 4; ++m) { const int row = row0 + ai * HALF + m * 16; const float2 ms = st[row];
                const float* xp = x + (size_t)row * ldc + col0; float* op = out + (size_t)row * ldc + col0;
#pragma unroll
                for (int bj = 0; bj < 2; ++bj)
#pragma unroll
                    for (int n = 0; n < 2; ++n) { const f32x4 r = *(const f32x4*)(xp + bj * HALF + n * 16);
                        const f32x4 h = (r - ms.x) * ms.y * gg[bj][n] + bb[bj][n]; *(f32x4*)(op + bj * HALF + n * 16) = h * alpha + acc[ai][bj][m][n]; } }
    }
};
struct EpiFinal {
    static constexpr bool PERM = false, AFTER_DRAIN = false;
    float* out; int ldc; const f16_t* h2; const f16_t* pw; const float* rowrs; const float* g;
    __device__ __forceinline__ void operator()(const f32x4 (&acc)[2][2][4][2], const Unit& u, int wr, int wc, int fr, int fq) const {
        typedef _Float16 h4_t __attribute__((ext_vector_type(4)));
        const int row0 = u.pm * BM + wr * 64 + fr; const int col0 = u.pn * BM + wc * 32 + 4 * fq;
#pragma unroll
        for (int ai = 0; ai < 2; ++ai)
#pragma unroll
            for (int m = 0; m < 4; ++m) { const int row = row0 + ai * HALF + m * 16; const size_t off = (size_t)row * ldc + col0;
                const float rs = rowrs[row];
#pragma unroll
                for (int bj = 0; bj < 2; ++bj)
#pragma unroll
                    for (int n = 0; n < 2; ++n) { const h4_t hv = *(const h4_t*)(h2 + off + bj * HALF + n * 16); const h4_t pv = *(const h4_t*)(pw + off + bj * HALF + n * 16);
                        const f32x4 gv = *(const f32x4*)(g + col0 + bj * HALF + n * 16);
                        const f32x4 a = acc[ai][bj][m][n]; f32x4 o;
#pragma unroll
                        for (int c = 0; c < 4; ++c) o[c] = (float)hv[c] + (1.f / (1.f + __expf(-a[c]))) * ((float)pv[c] * rs) * gv[c];
                        *(f32x4*)(out + off + bj * HALF + n * 16) = o; }
                asm volatile("" ::: "memory"); }
    }
};

struct EpiGU {
    static constexpr bool PERM = true, AFTER_DRAIN = false;
    f16_t* O;
    __device__ __forceinline__ void operator()(const f32x4 (&acc)[2][2][4][2], const Unit& u, int wr, int wc, int fr, int fq) const {
        const int row0 = u.pm * BM + wr * 64 + fr; const int col0 = u.pn * HALF + wc * 32 + 8 * fq;
#pragma unroll
        for (int ai = 0; ai < 2; ++ai)
#pragma unroll
            for (int m = 0; m < 4; ++m) { f16_t* rowp = O + (size_t)(row0 + ai * HALF + m * 16) * 512 + col0; float o[8];
#pragma unroll
                for (int n = 0; n < 2; ++n)
#pragma unroll
                    for (int c = 0; c < 4; ++c) { const float gt = acc[ai][0][m][n][c], up = acc[ai][1][m][n][c]; o[n * 4 + c] = gt / (1.f + __expf(-gt)) * up; }
                u32x4 w; w.x = cvt_pk_f16(o[0], o[1]); w.y = cvt_pk_f16(o[2], o[3]); w.z = cvt_pk_f16(o[4], o[5]); w.w = cvt_pk_f16(o[6], o[7]);
                *(u32x4*)rowp = w; }
    }
};
struct EpiDown {
    static constexpr bool PERM = true, AFTER_DRAIN = false;
    f16_t* O; const int* lpair;
    __device__ __forceinline__ void operator()(const f32x4 (&acc)[2][2][4][2], const Unit& u, int wr, int wc, int fr, int fq) const {
        const int r0 = u.rb * BM + wr * 64 + fr; const int col0 = u.pn * BM + wc * 32 + 8 * fq;
#pragma unroll
        for (int ai = 0; ai < 2; ++ai)
#pragma unroll
            for (int m = 0; m < 4; ++m) { const int r = r0 + ai * HALF + m * 16;
                if (r < u.cnt) { const int pair = lpair[u.e * 8192 + r]; f16_t* rowp = O + (size_t)pair * 2048 + col0;
#pragma unroll
                    for (int bj = 0; bj < 2; ++bj) { const f32x4 v0 = acc[ai][bj][m][0], v1 = acc[ai][bj][m][1];
                        u32x4 w; w.x = cvt_pk_f16(v0[0], v0[1]); w.y = cvt_pk_f16(v0[2], v0[3]); w.z = cvt_pk_f16(v1[0], v1[1]); w.w = cvt_pk_f16(v1[2], v1[3]);
                        *(u32x4*)(rowp + bj * HALF) = w; } } }
    }
};
template <class Epi, class Sched, bool ALIGN_EPI = false, bool SP2 = true>
__device__ __forceinline__ void gemm_phase(PG8_LAS unsigned char* lds, const Gemm g, const Sched& S, const Epi& E, const int wid) {
    static_assert(SP2, "only the SP2 K-loop is kept in this file");
    const int lane = lane_id(), tid = wid * 64 + lane, wr = wid >> 2, wc = wid & 3, fr = lane & 15, fq = lane >> 4;
    const int K = g.ld, nt = g.K / BK;
    unsigned voffB[2];
#pragma unroll
    for (int i = 0; i < 2; ++i) { int R, C; stage_rc(tid * 16 + i * 8192, R, C); const int Rb = Epi::PERM ? ((R & ~31) + perm32(R & 31)) : R;
        voffB[i] = (unsigned)(Rb * K + C) * 2u; }
    const size_t kstep = (size_t)(BK * 2);
    const size_t hstep = (size_t)HALF * K * 2;
    const unsigned ldsw = (unsigned)wid * 1024u;
    const int aoff = lds_byte(wr * 64 + fr, fq * 8), boff = lds_byte(wc * 32 + fr, fq * 8);
#define PG8_SA(b, h) (((b) * 2 + (h)) * HTB)
#define PG8_SB(b, h) ((4 + (b) * 2 + (h)) * HTB)
#define PG8_STAGE(bufoff, gbase, voff) do { _Pragma("unroll") for (int _i = 0; _i < 2; ++_i) \
        __builtin_amdgcn_global_load_lds((const unsigned*)((const char*)(gbase) + (voff)[_i]), (PG8_LAS unsigned*)(lds + (bufoff) + ldsw + _i * 8192), 16, 0, 0); } while (0)
#define PG8_LDA(dst, b, h) do { _Pragma("unroll") for (int m = 0; m < 4; ++m) _Pragma("unroll") for (int k = 0; k < 2; ++k) dst[m][k] = *(const PG8_LAS f16x8*)(lds + PG8_SA(b, h) + aoff + m * 2048 + k * 1024); } while (0)
#define PG8_LDB(dst, b, h) do { _Pragma("unroll") for (int n = 0; n < 2; ++n) _Pragma("unroll") for (int k = 0; k < 2; ++k) dst[n][k] = *(const PG8_LAS f16x8*)(lds + PG8_SB(b, h) + boff + n * 2048 + k * 1024); } while (0)
#define PG8_MMA(ai, bj, At, Bt) do { __builtin_amdgcn_s_setprio(1); _Pragma("unroll") for (int m = 0; m < 4; ++m) _Pragma("unroll") for (int n = 0; n < 2; ++n) _Pragma("unroll") for (int k = 0; k < 2; ++k) \
        acc[ai][bj][m][n] = __builtin_amdgcn_mfma_f32_16x16x32_f16(Bt[n][k], At[m][k], acc[ai][bj][m][n], 0, 0, 0); __builtin_amdgcn_s_setprio(0); } while (0)
#define PG8_WAIT_V(n) asm volatile("s_waitcnt vmcnt(" #n ")" ::: "memory")
#define PG8_WAIT_L(n) asm volatile("s_waitcnt lgkmcnt(" #n ")" ::: "memory")
#define PG8_BAR __builtin_amdgcn_s_barrier()
#define PG8_SCHED __builtin_amdgcn_sched_barrier(0)
    Unit cur, nxt; int ui = 0;
    if (!S.next(0, cur)) return;
    f32x4 acc[2][2][4][2];
#pragma unroll
    for (int a = 0; a < 2; ++a)
#pragma unroll
        for (int b = 0; b < 2; ++b)
#pragma unroll
            for (int m = 0; m < 4; ++m)
#pragma unroll
                for (int n = 0; n < 2; ++n) acc[a][b][m][n] = (f32x4){0.f, 0.f, 0.f, 0.f};
    f16x8 At[4][2], B0[2][2], B1[2][2];
    const char* cA = S.a_base(g, cur); const char* cB = S.b_base(g, cur);
    unsigned vaC[2][2];
    S.a_voff(g, cur, tid, vaC);
    S.a_ready(cur);
    PG8_STAGE(PG8_SB(0, 0), cB, voffB); PG8_STAGE(PG8_SB(0, 1), cB + hstep, voffB); PG8_STAGE(PG8_SA(0, 0), cA, vaC[0]); PG8_STAGE(PG8_SA(0, 1), cA, vaC[1]);
    if (wr == 1) PG8_BAR;
    PG8_WAIT_V(2); PG8_BAR;
    PG8_STAGE(PG8_SB(1, 0), cB + kstep, voffB); PG8_STAGE(PG8_SA(1, 0), cA + kstep, vaC[0]); PG8_STAGE(PG8_SB(1, 1), cB + hstep + kstep, voffB);
    PG8_WAIT_V(6); PG8_BAR;
    for (;;) {
        const bool has_next = S.next(ui + 1, nxt);
        const char* nA = has_next ? S.a_base(g, nxt) : cA; const char* nB = has_next ? S.b_base(g, nxt) : cB;
        for (int t = 0; t < nt; t += 2) {
            const bool last = (t == nt - 2);

            const char* a1 = cA + (size_t)(t + 1) * kstep;
            const char* a2 = last ? nA : cA + (size_t)(t + 2) * kstep; const char* b2 = last ? nB : cB + (size_t)(t + 2) * kstep;
            const char* a3 = a2 + kstep; const char* b3 = b2 + kstep;
            if (last && has_next) S.a_ready(nxt);
            PG8_LDB(B0, 0, 0); PG8_LDB(B1, 0, 1); PG8_SCHED; PG8_LDA(At, 0, 0); PG8_STAGE(PG8_SA(1, 1), a1, vaC[1]);
            if (last && has_next) S.a_voff(g, nxt, wid * 64 + lane_id(), vaC);
            PG8_WAIT_V(8); PG8_WAIT_L(0); PG8_BAR; PG8_MMA(0, 0, At, B0); PG8_MMA(0, 1, At, B1); PG8_BAR; PG8_SCHED;
            PG8_LDA(At, 0, 1); PG8_STAGE(PG8_SB(0, 0), b2, voffB); PG8_STAGE(PG8_SB(0, 1), b2 + hstep, voffB); PG8_STAGE(PG8_SA(0, 0), a2, vaC[0]);
            PG8_WAIT_V(8); PG8_WAIT_L(0); PG8_BAR; PG8_MMA(1, 0, At, B0); PG8_MMA(1, 1, At, B1); PG8_BAR; PG8_SCHED;
            PG8_LDB(B0, 1, 0); PG8_LDB(B1, 1, 1); PG8_SCHED; PG8_LDA(At, 1, 0); PG8_STAGE(PG8_SA(0, 1), a2, vaC[1]);
            PG8_WAIT_V(8); PG8_WAIT_L(0); PG8_BAR; PG8_MMA(0, 0, At, B0); PG8_MMA(0, 1, At, B1); PG8_BAR; PG8_SCHED;
            PG8_LDA(At, 1, 1); PG8_STAGE(PG8_SB(1, 0), b3, voffB); PG8_STAGE(PG8_SB(1, 1), b3 + hstep, voffB); PG8_STAGE(PG8_SA(1, 0), a3, vaC[0]);
            PG8_WAIT_V(8); PG8_WAIT_L(0); PG8_BAR; PG8_MMA(1, 0, At, B0); PG8_MMA(1, 1, At, B1); PG8_BAR; PG8_SCHED;
        }
        if constexpr (ALIGN_EPI) { if (wr == 0) PG8_BAR; }
        { const int l2 = lane_id(); E(acc, cur, wr, wc, l2 & 15, l2 >> 4); } S.done(cur);
        if (!has_next) break;
#pragma unroll
        for (int a = 0; a < 2; ++a)
#pragma unroll
            for (int b = 0; b < 2; ++b)
#pragma unroll
                for (int m = 0; m < 4; ++m)
#pragma unroll
                    for (int n = 0; n < 2; ++n) acc[a][b][m][n] = (f32x4){0.f, 0.f, 0.f, 0.f};
        cur = nxt; cA = nA; cB = nB; ++ui;
        if constexpr (ALIGN_EPI) { if (wr == 1) PG8_BAR; }
    }
    PG8_WAIT_V(0);
    if constexpr (!ALIGN_EPI) { if (wr == 0) PG8_BAR; }
    PG8_BAR;
#undef PG8_SA
#undef PG8_SB
#undef PG8_STAGE
#undef PG8_LDA
#undef PG8_LDB
#undef PG8_MMA
#undef PG8_WAIT_V
#undef PG8_WAIT_L
#undef PG8_BAR
#undef PG8_SCHED
}
}

constexpr int PN = 6656;
namespace att {
#define ALAS __attribute__((address_space(3)))
typedef _Float16 f16x8 __attribute__((ext_vector_type(8)));
typedef float f32x16 __attribute__((ext_vector_type(16)));
typedef short v4i16_t __attribute__((ext_vector_type(4)));
typedef unsigned u32x4 __attribute__((ext_vector_type(4)));
constexpr int SLOT = 16384, L_K = 0, L_V = 3 * SLOT, L_SCR = 6 * SLOT, L_TAB = L_SCR + 2048, L_END = L_TAB + 1024;
constexpr int L_XB = 0, L_STG = 65536;
constexpr float LOG2E = 1.4426950408889634f;
constexpr float C2 = 0.125f * LOG2E;
__device__ __forceinline__ int crow(int r, int hi) { return (r & 3) + 8 * (r >> 2) + 4 * hi; }
__device__ __forceinline__ void glds16(const void* g, ALAS unsigned char* l) { __builtin_amdgcn_global_load_lds((const unsigned*)g, (ALAS unsigned*)l, 16, 0, 0); }
__device__ __forceinline__ float xhalf(float v, int hi) { auto rr = __builtin_amdgcn_permlane32_swap(__float_as_uint(v), __float_as_uint(v), false, false); return hi ? __uint_as_float(rr[0]) : __uint_as_float(rr[1]); }
__device__ __forceinline__ unsigned pkh(float lo, float hi) { typedef _Float16 h2 __attribute__((ext_vector_type(2))); h2 v = {(_Float16)lo, (_Float16)hi}; return __builtin_bit_cast(unsigned, v); }
__device__ __forceinline__ v4i16_t vtr(const ALAS unsigned char* p) { return __builtin_amdgcn_ds_read_tr16_b64_v4i16((ALAS v4i16_t*)p); }

typedef int vfrag_t __attribute__((ext_vector_type(2)));
#define VFRAG vfrag_t
template <int OFF> __device__ __forceinline__ void vtr_asm(vfrag_t& r, unsigned a) { asm volatile("ds_read_b64_tr_b16 %0, %1 offset:%2" : "=v"(r) : "v"(a), "n"(OFF) : "memory"); }
#define VLOAD(vb, d) do { vtr_asm<(d) * 4096 + 0>(vb[0], vsa); vtr_asm<(d) * 4096 + 512>(vb[1], vsa); vtr_asm<(d) * 4096 + 1024>(vb[2], vsa); vtr_asm<(d) * 4096 + 1536>(vb[3], vsa); \
        vtr_asm<(d) * 4096 + 2048>(vb[4], vsa); vtr_asm<(d) * 4096 + 2560>(vb[5], vsa); vtr_asm<(d) * 4096 + 3072>(vb[6], vsa); vtr_asm<(d) * 4096 + 3584>(vb[7], vsa); } while (0)
#define VWAIT(n, vb) asm volatile("s_waitcnt lgkmcnt(" #n ")" : "+v"(vb[0]), "+v"(vb[1]), "+v"(vb[2]), "+v"(vb[3]), "+v"(vb[4]), "+v"(vb[5]), "+v"(vb[6]), "+v"(vb[7]) :: "memory")
#define VMUL(d, vb) do { _Pragma("unroll") for (int s_ = 0; s_ < 4; ++s_) { typedef int i32x4_ __attribute__((ext_vector_type(4))); \
        const i32x4_ bv_ = {vb[2 * s_][0], vb[2 * s_][1], vb[2 * s_ + 1][0], vb[2 * s_ + 1][1]}; \
        o[d] = __builtin_amdgcn_mfma_f32_32x32x16_f16(__builtin_bit_cast(f16x8, pw[s_]), __builtin_bit_cast(f16x8, bv_), o[d], 0, 0, 0); } } while (0)
template <int THR>
__device__ __forceinline__ void attn_unit(ALAS unsigned char* lds, const int wave, const int b, const int h, const int qb, const unsigned short* PROJ, unsigned short* Y,
                                          const float* biasG, const float lam, const float* subln_g) {
    const int lane = pg8::lane_id(), r32 = lane & 31, hi = lane >> 5;
    const int c = wave >> 2, w4 = wave & 3;
    const int q0 = qb * 128, qw0 = q0 + 32 * w4, q = qw0 + r32;
    const size_t rowbase = (size_t)b * S;
    { ALAS float* tabL = (ALAS float*)(lds + L_TAB); const int tid = wave * 64 + lane; if (tid < 129) tabL[tid] = biasG[tid] * LOG2E; }
    f16x8 qf[4];
    { const unsigned short* Qp = PROJ + (rowbase + q) * PN + h * 128 + c * 64 + hi * 8;
#pragma unroll
      for (int d0 = 0; d0 < 4; ++d0) qf[d0] = *(const f16x8*)(Qp + d0 * 16); }
    const int krow0 = 8 * wave + (lane >> 4), krow1 = krow0 + 4;
    const unsigned short* ksrc0 = PROJ + (rowbase + krow0) * PN + 1024 + h * 128 + (((lane & 15) ^ (krow0 & 15)) * 8);
    const unsigned short* ksrc1 = PROJ + (rowbase + krow1) * PN + 1024 + h * 128 + (((lane & 15) ^ (krow1 & 15)) * 8);
    const unsigned short* vsrc0 = PROJ + (rowbase + 16 * ((2 * wave) & 3) + (lane >> 2)) * PN + 2048 + h * 128 + 32 * ((2 * wave) >> 2) + (lane & 3) * 8;
    ALAS unsigned char* kdst = lds + L_K + (2 * wave) * 1024; ALAS unsigned char* vdst = lds + L_V + (2 * wave) * 1024;
#define ATT_ISSUE(t, slot) do { const size_t go_ = (size_t)(t) * 64 * PN; \
        glds16(ksrc0 + go_, kdst + (slot) * SLOT); glds16(ksrc1 + go_, kdst + (slot) * SLOT + 1024); \
        glds16(vsrc0 + go_, vdst + (slot) * SLOT); glds16(vsrc0 + go_ + (size_t)16 * PN, vdst + (slot) * SLOT + 1024); } while (0)
    const int NT = (q0 + 128) / 64;
    ATT_ISSUE(0, 0); ATT_ISSUE(1, 1);
    ALAS float* wsf = (ALAS float*)(lds + L_SCR) + wave * 64;
    const ALAS float* tabL = (const ALAS float*)(lds + L_TAB);
    const float bfar = biasG[128] * LOG2E;
    float mhat = 0.f, l = 0.f;
    f32x16 o[4];
#pragma unroll
    for (int d = 0; d < 4; ++d)
#pragma unroll
        for (int r = 0; r < 16; ++r) o[d][r] = 0.f;
    f32x16 negm;
#pragma unroll
    for (int r = 0; r < 16; ++r) negm[r] = bfar;
    int slot = 0;
    for (int t = 0; t < NT; ++t) {
        if (t + 1 < NT) asm volatile("s_waitcnt vmcnt(4)" ::: "memory"); else asm volatile("s_waitcnt vmcnt(0)" ::: "memory");
        __builtin_amdgcn_s_barrier();
        asm volatile("" ::: "memory");
        if (t + 2 < NT) { const int s2 = slot == 0 ? 2 : slot - 1; ATT_ISSUE(t + 2, s2); }
        const int k0 = t * 64;
        if (k0 <= qw0 + 31) {
            const ALAS unsigned char* Ks = lds + L_K + slot * SLOT + r32 * 256;
            const int kx = r32 & 15, kc0 = 8 * c + hi;
            const int ko[4] = {((kc0 + 0) ^ kx) << 4, ((kc0 + 2) ^ kx) << 4, ((kc0 + 4) ^ kx) << 4, ((kc0 + 6) ^ kx) << 4};
            const unsigned vsa = (unsigned)(__UINTPTR_TYPE__)(lds + L_V + slot * SLOT + (4 * hi + ((lane & 15) >> 2)) * 64 + ((lane >> 4) & 1) * 32 + (lane & 3) * 8);
            f16x8 ka[8];
#pragma unroll
            for (int d0 = 0; d0 < 4; ++d0) { ka[2 * d0] = *(const ALAS f16x8*)(Ks + ko[d0]); ka[2 * d0 + 1] = *(const ALAS f16x8*)(Ks + ko[d0] + 8192); }
            f32x16 p0, p1;
            const bool nearb = (k0 + 63 + 128 > qw0);
            if (nearb) {
                f32x16 c0, c1;
#pragma unroll
                for (int r = 0; r < 16; ++r) { int rel = q - (k0 + crow(r, hi)); int i0 = rel < 0 ? 0 : (rel > 128 ? 128 : rel); int rel1 = rel - 32; int i1 = rel1 < 0 ? 0 : (rel1 > 128 ? 128 : rel1);
                    c0[r] = tabL[i0] - mhat; c1[r] = tabL[i1] - mhat; }
#pragma unroll
                for (int d0 = 0; d0 < 4; ++d0) {
                    p0 = __builtin_amdgcn_mfma_f32_32x32x16_f16(ka[2 * d0], qf[d0], d0 == 0 ? c0 : p0, 0, 0, 0); p1 = __builtin_amdgcn_mfma_f32_32x32x16_f16(ka[2 * d0 + 1], qf[d0], d0 == 0 ? c1 : p1, 0, 0, 0); }
                if (k0 + 63 > qw0) {
#pragma unroll
                    for (int r = 0; r < 16; ++r) { const int kv = k0 + crow(r, hi); if (kv > q) p0[r] = -INFINITY; if (kv + 32 > q) p1[r] = -INFINITY; }
                }
            } else {
#pragma unroll
                for (int d0 = 0; d0 < 4; ++d0) {
                    p0 = __builtin_amdgcn_mfma_f32_32x32x16_f16(ka[2 * d0], qf[d0], d0 == 0 ? negm : p0, 0, 0, 0); p1 = __builtin_amdgcn_mfma_f32_32x32x16_f16(ka[2 * d0 + 1], qf[d0], d0 == 0 ? negm : p1, 0, 0, 0); }
            }
            VFRAG vb0[8], vb1[8];
            VLOAD(vb0, 0);
            float rm = fmaxf(p0[0], p1[0]);
#pragma unroll
            for (int r = 1; r < 16; ++r) rm = fmaxf(rm, fmaxf(p0[r], p1[r]));
            rm = fmaxf(rm, xhalf(rm, hi));
            const bool first = (t == 0);
            if (first || __any(rm > (float)THR)) {
                const float dl = first ? rm : fmaxf(rm, 0.f);
                mhat += dl;
#pragma unroll
                for (int r = 0; r < 16; ++r) { p0[r] -= dl; p1[r] -= dl; }
#pragma unroll
                for (int r = 0; r < 16; ++r) negm[r] = bfar - mhat;
                if (!first) {
                    const float f = __builtin_amdgcn_exp2f(-dl); l *= f;
                    if (hi == 0) wsf[r32] = f;
                    asm volatile("s_waitcnt lgkmcnt(0)" ::: "memory");
#pragma unroll
                    for (int r = 0; r < 16; ++r) { const float fr_ = wsf[crow(r, hi)];
#pragma unroll
                        for (int d = 0; d < 4; ++d) o[d][r] *= fr_; }
                }
            }
            float sacc = 0.f;
#pragma unroll
            for (int r = 0; r < 16; ++r) { p0[r] = __builtin_amdgcn_exp2f(p0[r]); p1[r] = __builtin_amdgcn_exp2f(p1[r]); sacc += p0[r] + p1[r]; }
            l += sacc;
            u32x4 pw[4];
#pragma unroll
            for (int s = 0; s < 2; ++s) {
                pw[s] = (u32x4){pkh(p0[8 * s], p0[8 * s + 1]), pkh(p0[8 * s + 2], p0[8 * s + 3]), pkh(p0[8 * s + 4], p0[8 * s + 5]), pkh(p0[8 * s + 6], p0[8 * s + 7])};
                pw[2 + s] = (u32x4){pkh(p1[8 * s], p1[8 * s + 1]), pkh(p1[8 * s + 2], p1[8 * s + 3]), pkh(p1[8 * s + 4], p1[8 * s + 5]), pkh(p1[8 * s + 6], p1[8 * s + 7])};
            }
            VLOAD(vb1, 1); VWAIT(8, vb0); VMUL(0, vb0);
            VLOAD(vb0, 2); VWAIT(8, vb1); VMUL(1, vb1);
            VLOAD(vb1, 3); VWAIT(8, vb0); VMUL(2, vb0);
            VWAIT(0, vb1); VMUL(3, vb1);
        }
        slot = slot == 2 ? 0 : slot + 1;
    }
#undef ATT_ISSUE
    l += xhalf(l, hi);
    if (hi == 0) wsf[r32] = 1.0f / l;
    asm volatile("s_waitcnt lgkmcnt(0)" ::: "memory");
#pragma unroll
    for (int r = 0; r < 16; ++r) { const float f = wsf[crow(r, hi)];
#pragma unroll
        for (int d = 0; d < 4; ++d) o[d][r] *= f; }
    asm volatile("s_waitcnt lgkmcnt(0)" ::: "memory"); __builtin_amdgcn_s_barrier(); asm volatile("" ::: "memory");
    ALAS float* xb = (ALAS float*)(lds + L_XB) + w4 * 4096 + lane;
    if (c == 1) {
#pragma unroll
        for (int d = 0; d < 4; ++d)
#pragma unroll
            for (int r = 0; r < 16; ++r) xb[(d * 16 + r) * 64] = o[d][r];
    }
    asm volatile("s_waitcnt lgkmcnt(0)" ::: "memory"); __builtin_amdgcn_s_barrier(); asm volatile("" ::: "memory");
    if (c == 0) {
        float sc[16];
#pragma unroll
        for (int r = 0; r < 16; ++r) { float ss = 0.f;
#pragma unroll
            for (int d = 0; d < 4; ++d) { o[d][r] -= lam * xb[(d * 16 + r) * 64]; ss += o[d][r] * o[d][r]; }
            ss += __shfl_xor(ss, 1); ss += __shfl_xor(ss, 2); ss += __shfl_xor(ss, 4); ss += __shfl_xor(ss, 8); ss += __shfl_xor(ss, 16);
            sc[r] = __builtin_amdgcn_rsqf(ss * (1.f / 128.f) + LN_EPS) * (1.f - LAMBDA_INIT); }
        ALAS _Float16* stg = (ALAS _Float16*)(lds + L_STG + w4 * 8192);
#pragma unroll
        for (int d = 0; d < 4; ++d) { const float gg = subln_g[32 * d + r32];
#pragma unroll
            for (int r = 0; r < 16; ++r) stg[crow(r, hi) * 128 + 32 * d + r32] = (_Float16)(o[d][r] * sc[r] * gg); }
        asm volatile("s_waitcnt lgkmcnt(0)" ::: "memory");
        unsigned short* Yw = Y + (rowbase + qw0) * D + h * 128;
#pragma unroll
        for (int i = 0; i < 8; ++i) { const int row = i * 4 + (lane >> 4), ch = lane & 15; const u32x4 v = *(const ALAS u32x4*)((const ALAS unsigned char*)stg + row * 256 + ch * 16);
            *(u32x4*)(Yw + (size_t)row * D + ch * 8) = v; }
    }
    asm volatile("s_waitcnt lgkmcnt(0)" ::: "memory"); __builtin_amdgcn_s_barrier(); asm volatile("" ::: "memory");
}
#undef ALAS
}

namespace rk {
#define RLAS __attribute__((address_space(3)))
#define RGAS __attribute__((address_space(1)))
typedef __bf16 bf16x8 __attribute__((ext_vector_type(8)));
typedef _Float16 f16x8 __attribute__((ext_vector_type(8)));
typedef float f32x16 __attribute__((ext_vector_type(16)));
typedef float f32x4 __attribute__((ext_vector_type(4)));
typedef unsigned u32x4 __attribute__((ext_vector_type(4)));
typedef unsigned short us8 __attribute__((ext_vector_type(8)));
constexpr int C = 32;
constexpr int TS = 144, CS = 80;
constexpr int O_AT = 0, O_RT = 4608, O_BT = 9216, O_KT = 13824;
constexpr int O_AAB = 0, O_AAK = 4608, O_ARB = 7168, O_ARK = 9728;
constexpr int O_PIMG = 0, O_QIMG = 8192;
constexpr int O_VT = 18432, O_KH = 23552, O_BH = 28672;
constexpr int O_X0 = 33792;
constexpr int O_RH = 50688;
constexpr int O_GAM = 55296;
constexpr int HALF_BYTES = 57344;
constexpr int CHK_BYTES = 24576, CK_P = 0, CK_Q = 8192, CK_G = 12288, CK_Y = 20480;
__device__ __forceinline__ int crow(int r, int hi) { return (r & 3) + 8 * (r >> 2) + 4 * hi; }
__device__ __forceinline__ unsigned pkb(float lo, float hi) { typedef float f2 __attribute__((ext_vector_type(2))); typedef __bf16 b2 __attribute__((ext_vector_type(2))); f2 v = {lo, hi}; b2 w = __builtin_convertvector(v, b2); return __builtin_bit_cast(unsigned, w); }
__device__ __forceinline__ unsigned pkh(float lo, float hi) { typedef _Float16 h2 __attribute__((ext_vector_type(2))); h2 v = {(_Float16)lo, (_Float16)hi}; return __builtin_bit_cast(unsigned, v); }
__device__ __forceinline__ float h2f(unsigned short u) { return (float)__builtin_bit_cast(_Float16, u); }
__device__ __forceinline__ unsigned short f2h(float f) { return __builtin_bit_cast(unsigned short, (_Float16)f); }
__device__ __forceinline__ float sum8(float x) {
    x += __builtin_bit_cast(float, __builtin_amdgcn_update_dpp(0, __builtin_bit_cast(int, x), 0xB1, 0xF, 0xF, true));
    x += __builtin_bit_cast(float, __builtin_amdgcn_update_dpp(0, __builtin_bit_cast(int, x), 0x4E, 0xF, 0xF, true));
    x += __builtin_bit_cast(float, __builtin_amdgcn_update_dpp(0, __builtin_bit_cast(int, x), 0x141, 0xF, 0xF, true));
    return x;
}
__device__ __forceinline__ int frag_pos(int m, int c) { return (((c >> 4) * 64 + m + 32 * ((c >> 2) & 1)) * 8) + ((c >> 3) & 1) * 4 + (c & 3); }

struct ChunkIn { f32x4 l0, l1; us8 a8, b8, k8, rc, rp, vc, vp; };
__device__ __forceinline__ void chunk_load(ChunkIn& in, int tglob, int pos, int chb, const unsigned char* ws) {
    const unsigned short* PROJ16 = (const unsigned short*)(ws + WS_PROJ16); const float* LW = (const float*)(ws + WS_DECAY); const unsigned short* KMOD = (const unsigned short*)(ws + WS_KMOD);
    const unsigned short* A16 = (const unsigned short*)(ws + WS_A16); const unsigned short* B16 = (const unsigned short*)(ws + WS_B16);
    in.l0 = *(const RGAS f32x4*)(LW + (size_t)tglob * RWK + chb); in.l1 = *(const RGAS f32x4*)(LW + (size_t)tglob * RWK + chb + 4);
    in.a8 = *(const RGAS us8*)(A16 + (size_t)tglob * RWK + chb); in.b8 = *(const RGAS us8*)(B16 + (size_t)tglob * RWK + chb); in.k8 = *(const RGAS us8*)(KMOD + (size_t)tglob * RWK + chb);
    const unsigned short* cur = PROJ16 + (size_t)tglob * PN + 3072 + chb;
    in.rc = *(const RGAS us8*)cur; in.vc = *(const RGAS us8*)(cur + 2048); in.rp = in.rc; in.vp = in.vc; if (pos > 0) { in.rp = *(const RGAS us8*)(cur - PN); in.vp = *(const RGAS us8*)(cur - PN + 2048); }
}
__device__ __forceinline__ void chunk_pair(RLAS unsigned char* lds, const int wave, const int tile, const int hA, ChunkIn& in, const bool has_next, const float* mu, const float* r_k, unsigned char* ws) {
    unsigned char* CHK = ws + WS_CHK; float* BONUS = (float*)(ws + WS_BONUS);
    const int lane = pg8::lane_id(), hf = wave >> 2, q = wave & 3, r32 = lane & 31, hi = lane >> 5;
    const int h = hA + hf;
    RLAS unsigned char* L = lds + hf * HALF_BYTES;
    const int t = q * 64 + lane;
    const int tok = t >> 3, c8 = (t & 7) * 8;
    const int tglob = tile * C + tok, pos = tglob & (S - 1), bidx = tglob >> 11;
    const int chb = h * 64 + c8;
    float lw[8], av[8], bv[8], kv[8], rv[8], vv[8];
    { lw[0] = in.l0.x; lw[1] = in.l0.y; lw[2] = in.l0.z; lw[3] = in.l0.w; lw[4] = in.l1.x; lw[5] = in.l1.y; lw[6] = in.l1.z; lw[7] = in.l1.w;
      const f32x4 m0 = *(const RGAS f32x4*)(mu + chb), m1 = *(const RGAS f32x4*)(mu + chb + 4), n0 = *(const RGAS f32x4*)(mu + 2048 + chb), n1 = *(const RGAS f32x4*)(mu + 2048 + chb + 4);
      const float mr[8] = {m0.x, m0.y, m0.z, m0.w, m1.x, m1.y, m1.z, m1.w}, mv[8] = {n0.x, n0.y, n0.z, n0.w, n1.x, n1.y, n1.z, n1.w};
#pragma unroll
      for (int i = 0; i < 8; ++i) { av[i] = h2f(in.a8[i]); bv[i] = h2f(in.b8[i]); kv[i] = h2f(in.k8[i]);
          const float rcf = h2f(in.rc[i]), rpf = pos > 0 ? h2f(in.rp[i]) : 0.f, vcf = h2f(in.vc[i]), vpf = pos > 0 ? h2f(in.vp[i]) : 0.f;
          rv[i] = rcf + (rpf - rcf) * mr[i]; vv[i] = vcf + (vpf - vcf) * mv[i]; } }
    { const f32x4 k0 = *(const RGAS f32x4*)(r_k + chb), k1 = *(const RGAS f32x4*)(r_k + chb + 4); const float rk8[8] = {k0.x, k0.y, k0.z, k0.w, k1.x, k1.y, k1.z, k1.w};
      float bs = 0.f;
#pragma unroll
      for (int i = 0; i < 8; ++i) bs += rv[i] * kv[i] * rk8[i];
      bs = sum8(bs); if ((t & 7) == 0) BONUS[(size_t)tglob * 16 + h] = bs; }
    RLAS float* lwL = (RLAS float*)(L + O_X0 + 64 * 132);
    __syncthreads();
#pragma unroll
    for (int i = 0; i < 8; ++i) lwL[tok * 65 + c8 + i] = lw[i];
    __syncthreads();
    { RLAS float* part = (RLAS float*)(L + O_GAM) + 64;
      const int ch = t & 63, seg = t >> 6; float sg = 0.f;
#pragma unroll
      for (int k = 0; k < 8; ++k) sg += lwL[(8 * seg + k) * 65 + ch];
      part[seg * 64 + ch] = sg;
      __syncthreads();
      float g = 0.f;
#pragma unroll
      for (int s2 = 0; s2 < 3; ++s2) if (s2 < seg) g += part[s2 * 64 + ch];
#pragma unroll
      for (int k = 0; k < 8; ++k) { g += lwL[(8 * seg + k) * 65 + ch]; lwL[(8 * seg + k) * 65 + ch] = g; } }
    __syncthreads();
    {
        float G[8], GL[8];
#pragma unroll
        for (int i = 0; i < 8; ++i) { G[i] = lwL[tok * 65 + c8 + i]; GL[i] = lwL[31 * 65 + c8 + i]; }
        float at[8], rt[8], bt[8], kt[8], bh[8], kh[8];
#pragma unroll
        for (int i = 0; i < 8; ++i) { const float eg = __expf(G[i]), eng = __expf(-G[i]), egm = __expf(G[i] - lw[i]), egl = __expf(GL[i] - G[i]);
            at[i] = av[i] * egm; rt[i] = rv[i] * eg; bt[i] = bv[i] * eng; kt[i] = kv[i] * eng; bh[i] = bv[i] * egl; kh[i] = kv[i] * egl; }
        *(RLAS u32x4*)(L + O_AT + tok * TS + c8 * 2) = (u32x4){pkb(at[0], at[1]), pkb(at[2], at[3]), pkb(at[4], at[5]), pkb(at[6], at[7])};
        *(RLAS u32x4*)(L + O_RT + tok * TS + c8 * 2) = (u32x4){pkb(rt[0], rt[1]), pkb(rt[2], rt[3]), pkb(rt[4], rt[5]), pkb(rt[6], rt[7])};
        *(RLAS u32x4*)(L + O_BT + tok * TS + c8 * 2) = (u32x4){pkb(bt[0], bt[1]), pkb(bt[2], bt[3]), pkb(bt[4], bt[5]), pkb(bt[6], bt[7])};
        *(RLAS u32x4*)(L + O_KT + tok * TS + c8 * 2) = (u32x4){pkb(kt[0], kt[1]), pkb(kt[2], kt[3]), pkb(kt[4], kt[5]), pkb(kt[6], kt[7])};
        *(RLAS u32x4*)(L + O_RH + tok * TS + c8 * 2) = (u32x4){pkh(rt[0], rt[1]), pkh(rt[2], rt[3]), pkh(rt[4], rt[5]), pkh(rt[6], rt[7])};
#pragma unroll
        for (int i = 0; i < 8; ++i) { const int ch = c8 + i;
            *(RLAS unsigned short*)(L + O_VT + ch * CS + tok * 2) = f2h(vv[i]); *(RLAS unsigned short*)(L + O_KH + ch * CS + tok * 2) = f2h(kh[i]); *(RLAS unsigned short*)(L + O_BH + ch * CS + tok * 2) = f2h(bh[i]);
            ((RLAS float*)(L + O_X0))[ch * 33 + tok] = at[i];
            if (tok == C - 1) ((RLAS float*)(L + O_GAM))[ch] = __expf(GL[i]); }
    }
    __syncthreads();
    {
        const RLAS unsigned char* Lp = L + (q < 2 ? O_AT : O_RT) + r32 * TS + hi * 16; const RLAS unsigned char* Rp = L + ((q & 1) ? O_KT : O_BT) + r32 * TS + hi * 16;
        f32x16 acc;
#pragma unroll
        for (int r = 0; r < 16; ++r) acc[r] = 0.f;
#pragma unroll
        for (int ks = 0; ks < 4; ++ks) acc = __builtin_amdgcn_mfma_f32_32x32x16_bf16(*(const RLAS bf16x8*)(Lp + ks * 32), *(const RLAS bf16x8*)(Rp + ks * 32), acc, 0, 0, 0);
#pragma unroll
        for (int r = 0; r < 16; ++r) { const int tau = crow(r, hi); const bool keep = (q < 2) ? (r32 < tau) : (r32 <= tau); acc[r] = keep ? acc[r] : 0.f; }
        __syncthreads();
        if (q == 0) {
#pragma unroll
            for (int r = 0; r < 16; ++r) ((RLAS float*)(L + O_AAB))[r32 * 36 + crow(r, hi)] = acc[r];
        } else {
            RLAS unsigned char* o = L + (q == 1 ? O_AAK : (q == 2 ? O_ARB : O_ARK));
#pragma unroll
            for (int r = 0; r < 16; ++r) *(RLAS unsigned short*)(o + crow(r, hi) * CS + r32 * 2) = f2h(acc[r]);
        }
    }
    __syncthreads();
    const int J = q & 1, part = q >> 1;
    if (part == 1) {
        f32x16 accX;
#pragma unroll
        for (int r = 0; r < 16; ++r) accX[r] = 0.f;
        const RLAS unsigned char* Vp = L + O_VT + (32 * J + r32) * CS + hi * 16; const RLAS unsigned char* Ap = L + O_AAK + r32 * CS + hi * 16;
#pragma unroll
        for (int ks = 0; ks < 2; ++ks) accX = __builtin_amdgcn_mfma_f32_32x32x16_f16(*(const RLAS f16x8*)(Ap + ks * 32), *(const RLAS f16x8*)(Vp + ks * 32), accX, 0, 0, 0);
#pragma unroll
        for (int r = 0; r < 16; ++r) ((RLAS float*)(L + O_X0))[(64 + 32 * J + r32) * 33 + crow(r, hi)] = accX[r];
    }
    __syncthreads();
    float z[C];
    if (q < 2) {
        const RLAS float* xc = (const RLAS float*)(L + O_X0) + (64 * q + lane) * 33;
#pragma unroll
        for (int k = 0; k < C; ++k) z[k] = xc[k];
    }
    __syncthreads();
    if (q < 2) {
        const RLAS float* AabT = (const RLAS float*)(L + O_AAB);
#pragma unroll
        for (int sx = 0; sx < C - 1; ++sx) {
            const float zs = z[sx];
#pragma unroll
            for (int t4 = (sx + 1) / 4; t4 < C / 4; ++t4) { const f32x4 aa = *(const RLAS f32x4*)(AabT + sx * 36 + 4 * t4);
                if (4 * t4 + 0 > sx) z[4 * t4 + 0] = fmaf(aa.x, zs, z[4 * t4 + 0]); if (4 * t4 + 1 > sx) z[4 * t4 + 1] = fmaf(aa.y, zs, z[4 * t4 + 1]);
                if (4 * t4 + 2 > sx) z[4 * t4 + 2] = fmaf(aa.z, zs, z[4 * t4 + 2]); if (4 * t4 + 3 > sx) z[4 * t4 + 3] = fmaf(aa.w, zs, z[4 * t4 + 3]); }
        }
        RLAS unsigned char* zr = L + O_X0 + (64 * q + lane) * CS;
#pragma unroll
        for (int k8 = 0; k8 < 4; ++k8) *(RLAS u32x4*)(zr + k8 * 16) = (u32x4){pkh(z[8 * k8], z[8 * k8 + 1]), pkh(z[8 * k8 + 2], z[8 * k8 + 3]), pkh(z[8 * k8 + 4], z[8 * k8 + 5]), pkh(z[8 * k8 + 6], z[8 * k8 + 7])};
    }
    __syncthreads();
    f32x16 accQ, accP, accA, accB;
#pragma unroll
    for (int r = 0; r < 16; ++r) { accA[r] = 0.f; accB[r] = 0.f; }
    {
        const RLAS unsigned char* Vp = L + O_VT + (32 * J + r32) * CS + hi * 16;
        const RLAS unsigned char* Kp = L + O_KH + (32 * part + r32) * CS + hi * 16;
        const RLAS unsigned char* Ap = L + O_ARK + r32 * CS + hi * 16;
#pragma unroll
        for (int ks = 0; ks < 2; ++ks) { const f16x8 vf = *(const RLAS f16x8*)(Vp + ks * 32);
            if (part == 0) accA = __builtin_amdgcn_mfma_f32_32x32x16_f16(*(const RLAS f16x8*)(Ap + ks * 32), vf, accA, 0, 0, 0);
            accB = __builtin_amdgcn_mfma_f32_32x32x16_f16(*(const RLAS f16x8*)(Kp + ks * 32), vf, accB, 0, 0, 0); }
    }
    {
        const RLAS float* gam = (const RLAS float*)(L + O_GAM);
#pragma unroll
        for (int r = 0; r < 16; ++r) { const int m = crow(r, hi);
            accQ[r] = h2f(*(const RLAS unsigned short*)(L + O_RH + m * TS + (32 * J + r32) * 2));
            accP[r] = (J == part && m == r32) ? gam[32 * J + r32] : 0.f; }
        const RLAS unsigned char* Zw = L + O_X0 + (32 * J + r32) * CS + hi * 16; const RLAS unsigned char* Zu = Zw + 64 * CS;
        const RLAS unsigned char* Bp = L + O_BH + (32 * part + r32) * CS + hi * 16; const RLAS unsigned char* Rb = L + O_ARB + r32 * CS + hi * 16;
#pragma unroll
        for (int ks = 0; ks < 2; ++ks) { const f16x8 zw = *(const RLAS f16x8*)(Zw + ks * 32), zu = *(const RLAS f16x8*)(Zu + ks * 32), bf = *(const RLAS f16x8*)(Bp + ks * 32);
            accP = __builtin_amdgcn_mfma_f32_32x32x16_f16(bf, zw, accP, 0, 0, 0);
            accB = __builtin_amdgcn_mfma_f32_32x32x16_f16(bf, zu, accB, 0, 0, 0);
            if (part == 0) { const f16x8 rb = *(const RLAS f16x8*)(Rb + ks * 32);
                accQ = __builtin_amdgcn_mfma_f32_32x32x16_f16(rb, zw, accQ, 0, 0, 0);
                accA = __builtin_amdgcn_mfma_f32_32x32x16_f16(rb, zu, accA, 0, 0, 0); } }
    }
    __syncthreads();
    { int tg2 = tglob, cb2 = has_next ? chb + 128 : chb; asm volatile("" : "+v"(tg2), "+v"(cb2)); chunk_load(in, tg2, pos, cb2, ws); }
    unsigned char* rec = CHK + ((size_t)((bidx * 16 + h) * (S / C)) + (size_t)(pos >> 5)) * CHK_BYTES;
    { u32x4 w0, w1; w0 = (u32x4){pkh(accB[0], accB[1]), pkh(accB[2], accB[3]), pkh(accB[4], accB[5]), pkh(accB[6], accB[7])}; w1 = (u32x4){pkh(accB[8], accB[9]), pkh(accB[10], accB[11]), pkh(accB[12], accB[13]), pkh(accB[14], accB[15])};
      RGAS u32x4* g = (RGAS u32x4*)(rec + CK_G + ((part * 2 + J) * 64 + lane) * 32); g[0] = w0; g[1] = w1;
      if (part == 0) { w0 = (u32x4){pkh(accA[0], accA[1]), pkh(accA[2], accA[3]), pkh(accA[4], accA[5]), pkh(accA[6], accA[7])}; w1 = (u32x4){pkh(accA[8], accA[9]), pkh(accA[10], accA[11]), pkh(accA[12], accA[13]), pkh(accA[14], accA[15])};
          RGAS u32x4* y = (RGAS u32x4*)(rec + CK_Y + (J * 64 + lane) * 32); y[0] = w0; y[1] = w1; } }
    {
        RLAS unsigned short* pimg = (RLAS unsigned short*)(L + O_PIMG) + ((part * 2 + J) * 2) * 512;
        RLAS unsigned short* qimg = (RLAS unsigned short*)(L + O_QIMG) + (J * 2) * 512;
#pragma unroll
        for (int r = 0; r < 16; ++r) { const int fp = frag_pos(crow(r, hi), r32); pimg[fp] = f2h(accP[r]); if (part == 0) qimg[fp] = f2h(accQ[r]); }
    }
    __syncthreads();
    { const RLAS u32x4* src = (const RLAS u32x4*)(L + O_PIMG); RGAS u32x4* dst = (RGAS u32x4*)(rec + CK_P);
#pragma unroll
      for (int i = 0; i < 3; ++i) dst[i * 256 + t] = src[i * 256 + t]; }
}

__device__ __forceinline__ void scan_unit(RLAS unsigned char* lds, const int wave, const int bh, const unsigned char* CHK, const float* BONUS, const unsigned short* PROJ16, const float* mu,
                                          const unsigned short* G16, const float* lnx_g, const float* lnx_b, unsigned short* Y16) {
    const int lane = pg8::lane_id(), r32 = lane & 31, hi = lane >> 5;
    const int b = bh >> 4, h = bh & 15;
    RLAS float* ytile = (RLAS float*)lds;
    constexpr int RING0 = 18432, NSL = 4;
    const unsigned char* rec0 = CHK + (size_t)bh * (S / C) * CHK_BYTES;
    constexpr int NCH = S / C;
    __syncthreads();
    if (wave >= 6) {
        const int p0 = (wave - 6) * 12;
#define RK_DMA(c) do { const unsigned char* src_ = rec0 + (size_t)(c) * CHK_BYTES + p0 * 1024 + lane * 16; RLAS unsigned char* dst_ = lds + RING0 + ((c) & (NSL - 1)) * CHK_BYTES + p0 * 1024; \
            _Pragma("unroll") for (int j_ = 0; j_ < 12; ++j_) __builtin_amdgcn_global_load_lds((const unsigned*)(src_ + j_ * 1024), (RLAS unsigned*)(dst_ + j_ * 1024), 16, 0, 0); } while (0)
        RK_DMA(0); RK_DMA(1); RK_DMA(2);
        for (int c = 0; c <= NCH; ++c) {
            if (c + 2 < NCH) asm volatile("s_waitcnt vmcnt(24)" ::: "memory"); else if (c + 1 < NCH) asm volatile("s_waitcnt vmcnt(12)" ::: "memory"); else asm volatile("s_waitcnt vmcnt(0)" ::: "memory");
            __builtin_amdgcn_s_barrier(); asm volatile("" ::: "memory");
            if (c + 3 < NCH) RK_DMA(c + 3);
        }
#undef RK_DMA
    } else if (wave < 2) {
        const int J = wave;
        f32x16 H0, H1;
#pragma unroll
        for (int r = 0; r < 16; ++r) { H0[r] = 0.f; H1[r] = 0.f; }
        for (int c = 0; c <= NCH; ++c) {
            asm volatile("s_waitcnt lgkmcnt(0)" ::: "memory"); __builtin_amdgcn_s_barrier(); asm volatile("" ::: "memory");
            if (c == NCH) break;
            const RLAS unsigned char* rec = lds + RING0 + (c & (NSL - 1)) * CHK_BYTES;
            u32x4 hb[4];
            hb[0] = (u32x4){pkh(H0[0], H0[1]), pkh(H0[2], H0[3]), pkh(H0[4], H0[5]), pkh(H0[6], H0[7])}; hb[1] = (u32x4){pkh(H0[8], H0[9]), pkh(H0[10], H0[11]), pkh(H0[12], H0[13]), pkh(H0[14], H0[15])};
            hb[2] = (u32x4){pkh(H1[0], H1[1]), pkh(H1[2], H1[3]), pkh(H1[4], H1[5]), pkh(H1[6], H1[7])}; hb[3] = (u32x4){pkh(H1[8], H1[9]), pkh(H1[10], H1[11]), pkh(H1[12], H1[13]), pkh(H1[14], H1[15])};
            f32x16 y, n0, n1;
#define RK_UNPK(dst, w0, w1) do { const f16x8 a_ = __builtin_bit_cast(f16x8, w0), b_ = __builtin_bit_cast(f16x8, w1); \
            _Pragma("unroll") for (int i_ = 0; i_ < 8; ++i_) { dst[i_] = (float)a_[i_]; dst[8 + i_] = (float)b_[i_]; } } while (0)
            { const u32x4 y0 = *(const RLAS u32x4*)(rec + CK_Y + (J * 64 + lane) * 32), y1 = *(const RLAS u32x4*)(rec + CK_Y + (J * 64 + lane) * 32 + 16); RK_UNPK(y, y0, y1);
              const u32x4 g0 = *(const RLAS u32x4*)(rec + CK_G + (J * 64 + lane) * 32), g1 = *(const RLAS u32x4*)(rec + CK_G + (J * 64 + lane) * 32 + 16); RK_UNPK(n0, g0, g1);
              const u32x4 g2 = *(const RLAS u32x4*)(rec + CK_G + ((2 + J) * 64 + lane) * 32), g3 = *(const RLAS u32x4*)(rec + CK_G + ((2 + J) * 64 + lane) * 32 + 16); RK_UNPK(n1, g2, g3); }
#pragma unroll
            for (int ks = 0; ks < 4; ++ks) {
                const f16x8 hf = __builtin_bit_cast(f16x8, hb[ks]);
                y = __builtin_amdgcn_mfma_f32_32x32x16_f16(*(const RLAS f16x8*)(rec + CK_Q + (ks * 64 + lane) * 16), hf, y, 0, 0, 0);
                n0 = __builtin_amdgcn_mfma_f32_32x32x16_f16(*(const RLAS f16x8*)(rec + CK_P + (ks * 64 + lane) * 16), hf, n0, 0, 0, 0);
                n1 = __builtin_amdgcn_mfma_f32_32x32x16_f16(*(const RLAS f16x8*)(rec + CK_P + ((4 + ks) * 64 + lane) * 16), hf, n1, 0, 0, 0);
            }
#undef RK_UNPK
            H0 = n0; H1 = n1;
            RLAS float* yt = ytile + (c & 1) * (32 * 68);
#pragma unroll
            for (int r = 0; r < 16; ++r) yt[crow(r, hi) * 68 + 32 * J + r32] = y[r];
        }
    } else {
        const int p = wave - 2, v8 = (lane & 7) * 8, trow = 8 * p + (lane >> 3);
        float lg[8], lb[8], mv[8];
#pragma unroll
        for (int i = 0; i < 8; ++i) { lg[i] = lnx_g[h * 64 + v8 + i]; lb[i] = lnx_b[h * 64 + v8 + i]; mv[i] = mu[2048 + h * 64 + v8 + i]; }
        struct PSlot { float bon; us8 vc, vp, g8; };
        PSlot ps[4];
#define RK_PLOAD(SL, cc_) do { const int pos_ = (cc_) * C + trow; const size_t tok_ = (size_t)b * S + pos_; ps[SL].bon = BONUS[tok_ * 16 + h]; \
            const unsigned short* cur_ = PROJ16 + tok_ * PN + 5120 + h * 64 + v8; ps[SL].vc = *(const RGAS us8*)cur_; ps[SL].vp = ps[SL].vc; if (pos_ > 0) ps[SL].vp = *(const RGAS us8*)(cur_ - PN); \
            ps[SL].g8 = *(const RGAS us8*)(G16 + tok_ * RWK + h * 64 + v8); } while (0)
#define RK_PSTEP(SL, cc_) do { \
            asm volatile("s_waitcnt lgkmcnt(0)" ::: "memory"); __builtin_amdgcn_s_barrier(); asm volatile("" ::: "memory"); \
            if ((cc_) >= 0) { const int cc = (cc_); \
                const float bon = ps[SL].bon; const us8 vc = ps[SL].vc, vp = ps[SL].vp, g8 = ps[SL].g8; \
                if (cc + 4 < NCH) RK_PLOAD(SL, cc + 4); \
                const RLAS float* yt = ytile + (cc & 1) * (32 * 68) + trow * 68 + v8; \
                const f32x4 ya = *(const RLAS f32x4*)yt, yb = *(const RLAS f32x4*)(yt + 4); \
                float yv[8] = {ya.x, ya.y, ya.z, ya.w, yb.x, yb.y, yb.z, yb.w}; \
                float sm = 0.f; \
                _Pragma("unroll") for (int i = 0; i < 8; ++i) sm += yv[i]; \
                const float mean = sum8(sm) * (1.f / 64.f); float sq = 0.f; \
                _Pragma("unroll") for (int i = 0; i < 8; ++i) { yv[i] -= mean; sq += yv[i] * yv[i]; } \
                const float rstd = __builtin_amdgcn_rsqf(sum8(sq) * (1.f / 64.f) + 64e-5f); \
                const int pos = cc * C + trow; const size_t tok = (size_t)b * S + pos; \
                float o[8]; \
                _Pragma("unroll") for (int i = 0; i < 8; ++i) { const float vcf = h2f(vc[i]), vpf = pos > 0 ? h2f(vp[i]) : 0.f; const float vx = vcf + (vpf - vcf) * mv[i]; \
                    o[i] = (yv[i] * rstd * lg[i] + lb[i] + bon * vx) * h2f(g8[i]); } \
                *(RGAS u32x4*)(Y16 + tok * D + 1024 + h * 64 + v8) = (u32x4){pkh(o[0], o[1]), pkh(o[2], o[3]), pkh(o[4], o[5]), pkh(o[6], o[7])}; } } while (0)
        RK_PLOAD(0, 0); RK_PLOAD(1, 1); RK_PLOAD(2, 2); RK_PLOAD(3, 3);
        for (int cb = 0; cb < NCH; cb += 4) {
            RK_PSTEP(3, cb - 1); RK_PSTEP(0, cb); RK_PSTEP(1, cb + 1); RK_PSTEP(2, cb + 2);
        }
        RK_PSTEP(3, NCH - 1);
#undef RK_PSTEP
#undef RK_PLOAD
    }
    __syncthreads();
}
#undef RLAS
#undef RGAS
}

constexpr int NWAVES = 8;
constexpr int RING_OFF = 0, RING_BYTES = 131072;
constexpr int LDSCTL_OFF = RING_BYTES, MISC_OFF = LDSCTL_OFF + 320;
constexpr int LDS_BYTES = 147456;
#define GAS __attribute__((address_space(1)))
#define LAS __attribute__((address_space(3)))
typedef unsigned v4u __attribute__((ext_vector_type(4)));
typedef float f32x4 __attribute__((ext_vector_type(4)));
typedef GAS unsigned gu32;
#define RLX_AGENT __ATOMIC_RELAXED, __HIP_MEMORY_SCOPE_AGENT
#define LDS_WAIT() asm volatile("s_waitcnt lgkmcnt(0)" ::: "memory")
#define VM_WAIT() asm volatile("s_waitcnt vmcnt(0)" ::: "memory")
constexpr int CW_CONVQ = 65;
constexpr int CW_ATTQ = 64;
constexpr int CW_BAR = 4096;
constexpr size_t CTL_ZERO_BYTES = 64 * 1024;

#define XB_TMO      128
#define XB_XCNT(j)  (256  + 64 * (j))
#define XB_XSUB(j)  (1280 + 64 * (j))
#define XB_XGEN(j)  (2304 + 64 * (j))
#define XB_TOP      3328
#define XB_TOPGEN   3392
#define XCD_BAR_WORDS 3456
#define XB_SPIN_CAP (1u << 18)

__device__ __forceinline__ unsigned xb_ld(unsigned* p)              { return __hip_atomic_load(p, __ATOMIC_RELAXED, __HIP_MEMORY_SCOPE_AGENT); }
__device__ __forceinline__ unsigned xb_add(unsigned* p, unsigned v) { return __hip_atomic_fetch_add(p, v, __ATOMIC_RELAXED, __HIP_MEMORY_SCOPE_AGENT); }
__device__ __forceinline__ unsigned xb_xcc_id() { return (unsigned)__builtin_amdgcn_s_getreg((3 << 11) | 20) & 0xFu; }
#define XB_SPIN(cond, bar) do { unsigned _sp = 0; while (cond) { __builtin_amdgcn_s_sleep(1); \
    if ((++_sp & 255u) == 0u) { if (xb_ld(&(bar)[XB_TMO])) break; if (_sp > XB_SPIN_CAP) { atomicAdd(&(bar)[XB_TMO], 1u); break; } } } } while (0)

struct XcdBarrier {
    unsigned* bar; unsigned x; bool w0;
    volatile LAS unsigned* st;
};

__device__ __forceinline__ XcdBarrier xcd_barrier_post(unsigned* bar, volatile LAS unsigned* st) {
    XcdBarrier b; b.bar = bar; b.x = xb_xcc_id(); b.st = st; b.w0 = (__builtin_amdgcn_readfirstlane(threadIdx.x >> 6) == 0);
    if (__builtin_amdgcn_readfirstlane(threadIdx.x >> 6) == 0 && pg8::lane_id() == 0) (void)xb_add(&bar[XB_XCNT(b.x)], 1u);
    return b;
}
__device__ __forceinline__ void xcd_barrier_complete(unsigned* bar, unsigned x, unsigned& nloc, unsigned& nx) {
    const unsigned G = gridDim.x * gridDim.y * gridDim.z;
    unsigned sum, cnt, mine, sp = 0u;
    for (;;) {
        sum = 0u; cnt = 0u; mine = 0u;
#pragma unroll
        for (unsigned j = 0; j < 16; ++j) { const unsigned c = xb_ld(&bar[XB_XCNT(j)]); sum += c; cnt += (c > 0u) ? 1u : 0u; mine = (j == x) ? c : mine; }
        if (sum == G) break;
        __builtin_amdgcn_s_sleep(1);
        if ((++sp & 255u) == 0u) { if (xb_ld(&bar[XB_TMO])) break; if (sp > XB_SPIN_CAP) { atomicAdd(&bar[XB_TMO], 1u); break; } }
    }
    nloc = mine > 0u ? mine : 1u; nx = cnt > 0u ? cnt : 1u;
}

__device__ __forceinline__ void xcd_barrier(const XcdBarrier& b) {
    asm volatile("s_waitcnt vmcnt(0)" ::: "memory");
    __syncthreads();
    if (b.w0 && pg8::lane_id() == 0) {
        unsigned* bar = b.bar;
        __builtin_amdgcn_s_waitcnt(0);
        unsigned nloc = b.st[0], nx = b.st[1];
        if (nloc == 0u) { xcd_barrier_complete(bar, b.x, nloc, nx); b.st[0] = nloc; b.st[1] = nx; }
        const unsigned old = xb_add(&bar[XB_XSUB(b.x)], 1u);
        const unsigned gen = old / nloc;
        if (old + 1u == (gen + 1u) * nloc) {
            __builtin_amdgcn_fence(__ATOMIC_RELEASE, "agent");
            asm volatile("s_waitcnt vmcnt(0)" ::: "memory");
            const unsigned og = xb_add(&bar[XB_TOP], 1u);
            const unsigned tg = og / nx;
            if (og + 1u == (tg + 1u) * nx) xb_add(&bar[XB_TOPGEN], 1u);
            else XB_SPIN(xb_ld(&bar[XB_TOPGEN]) == tg, bar);
            __builtin_amdgcn_fence(__ATOMIC_ACQUIRE, "agent");
            xb_add(&bar[XB_XGEN(b.x)], 1u);
            asm volatile("s_waitcnt vmcnt(0)" ::: "memory");
        } else {
            XB_SPIN(xb_ld(&bar[XB_XGEN(b.x)]) == gen, bar);
            __builtin_amdgcn_fence(__ATOMIC_ACQUIRE, "agent");
            asm volatile("s_waitcnt vmcnt(0)" ::: "memory");
        }
    }
    __syncthreads();
}


typedef unsigned short f16_t;
typedef _Float16 h2v __attribute__((ext_vector_type(2)));
__device__ __forceinline__ unsigned pk2h(float lo, float hi) { h2v v = {(_Float16)lo, (_Float16)hi}; return __builtin_bit_cast(unsigned, v); }

struct Frame {
    LAS unsigned char* lds; volatile LAS unsigned* MISC; gu32* ctl;
    int wave, vcu, G;
};
#define FTID (F.wave * 64 + pg8::lane_id())
#define FLANE (pg8::lane_id())
__device__ __forceinline__ void p0_transpose_item(const float* W, int K, int N, f16_t* WT, int row_off, LAS float* scr, int item, int lane) {
    const int nblk = N / 32, kb = item / nblk, nb = item % nblk, k0 = 64 * kb, n0 = 32 * nb;
#pragma unroll 8
    for (int i = 0; i < 32; ++i) { const int kk = 2 * i + (lane >> 5); scr[kk * 33 + (lane & 31)] = W[(size_t)(k0 + kk) * N + n0 + (lane & 31)]; }
    LDS_WAIT(); asm volatile("" ::: "memory");
    const int c = lane & 7;
#pragma unroll
    for (int j = 0; j < 4; ++j) { const int n = (lane >> 3) + 8 * j; const LAS float* s = scr + (8 * c) * 33 + n;
        v4u o; o.x = pk2h(s[0 * 33], s[1 * 33]); o.y = pk2h(s[2 * 33], s[3 * 33]); o.z = pk2h(s[4 * 33], s[5 * 33]); o.w = pk2h(s[6 * 33], s[7 * 33]);
        *(GAS v4u*)(WT + (size_t)(row_off + n0 + n) * K + k0 + 8 * c) = o; }
    LDS_WAIT(); asm volatile("" ::: "memory");
}
#ifndef TP_LD
#define TP_LD(p) (*(p))
#endif
struct TpDesc { const float* W; f16_t* WT; int K, N, row_off, item; };
__device__ __forceinline__ void tp_load(float (&r)[32], const TpDesc& d, int lane) {
    const int nblk = d.N / 32, kb = d.item / nblk, nb = d.item % nblk, k0 = 64 * kb, n0 = 32 * nb;
#pragma unroll
    for (int i = 0; i < 32; ++i) r[i] = TP_LD(d.W + (size_t)(k0 + 2 * i + (lane >> 5)) * d.N + n0 + (lane & 31));
}
__device__ __forceinline__ void tp_emit(const TpDesc& d, LAS float* scr, int lane) {
    const int nblk = d.N / 32, kb = d.item / nblk, nb = d.item % nblk, k0 = 64 * kb, n0 = 32 * nb, c = lane & 7;
#pragma unroll
    for (int j = 0; j < 4; ++j) { const int n = (lane >> 3) + 8 * j; const LAS float* sp = scr + (8 * c) * 33 + n;
        v4u o; o.x = pk2h(sp[0 * 33], sp[1 * 33]); o.y = pk2h(sp[2 * 33], sp[3 * 33]); o.z = pk2h(sp[4 * 33], sp[5 * 33]); o.w = pk2h(sp[6 * 33], sp[7 * 33]);
        *(GAS v4u*)(d.WT + (size_t)(d.row_off + n0 + n) * d.K + k0 + 8 * c) = o; }
}
template <class MK> __device__ __forceinline__ void tp_stream(int first, int n, int stride, MK mk, LAS float* scr, int lane) {
    if (first >= n) return;
    float r[32]; int it = first; TpDesc d = mk(it); tp_load(r, d, lane);
    for (;;) {
#pragma unroll
        for (int i = 0; i < 32; ++i) scr[(2 * i + (lane >> 5)) * 33 + (lane & 31)] = r[i];
        LDS_WAIT(); asm volatile("" ::: "memory");
        const int nit = it + stride; const bool more = nit < n; TpDesc dn = d;
        if (more) { dn = mk(nit); tp_load(r, dn, lane); }
        tp_emit(d, scr, lane);
        LDS_WAIT(); asm volatile("" ::: "memory");
        if (!more) break;
        it = nit; d = dn;
    }
}
#ifndef TPD_AUX
#define TPD_AUX 2
#endif
__device__ __forceinline__ void tpd_load(const TpDesc& d, LAS unsigned char* buf, int lane) {
    const int nblk = d.N / 32, kb = d.item / nblk, nb = d.item % nblk, k0 = 64 * kb, n0 = 32 * nb;
    const float* src = d.W + (size_t)(k0 + (lane >> 3)) * d.N + n0;
#pragma unroll
    for (int j = 0; j < 8; ++j) __builtin_amdgcn_global_load_lds((const unsigned*)(src + (size_t)(8 * j) * d.N + 4 * ((lane & 7) ^ j)), (LAS unsigned*)(buf + j * 1024), 16, 0, TPD_AUX);
}
__device__ __forceinline__ void tpd_emit(const TpDesc& d, const LAS unsigned char* buf, int lane) {
    const int nblk = d.N / 32, kb = d.item / nblk, nb = d.item % nblk, k0 = 64 * kb, n0 = 32 * nb, c = lane & 7;
#pragma unroll
    for (int j = 0; j < 4; ++j) { const int n = (lane >> 3) + 8 * j; const LAS float* sp = (const LAS float*)(buf + (8 * c) * 128 + (((n >> 2) ^ c) * 16) + (n & 3) * 4);
        v4u o; o.x = pk2h(sp[0 * 32], sp[1 * 32]); o.y = pk2h(sp[2 * 32], sp[3 * 32]); o.z = pk2h(sp[4 * 32], sp[5 * 32]); o.w = pk2h(sp[6 * 32], sp[7 * 32]);
        __builtin_nontemporal_store(o, (GAS v4u*)(d.WT + (size_t)(d.row_off + n0 + n) * d.K + k0 + 8 * c)); }
}
template <class MK> __device__ __forceinline__ void tpd_stream(int first, int n, int stride, MK mk, LAS unsigned char* buf, int lane) {
    for (int it = first; it < n; it += 2 * stride) {
        const bool two = it + stride < n;
        const TpDesc d0 = mk(it); const TpDesc d1 = mk(two ? it + stride : it);
        tpd_load(d0, buf, lane); if (two) tpd_load(d1, buf + 8192, lane);
        asm volatile("s_waitcnt vmcnt(0)" ::: "memory");
        tpd_emit(d0, buf, lane); if (two) tpd_emit(d1, buf + 8192, lane);
        LDS_WAIT(); asm volatile("" ::: "memory");
    }
}
__device__ __forceinline__ float wave_sum_b(float v) {
#pragma unroll
    for (int o = 1; o < 64; o <<= 1) v += __shfl_xor(v, o);
    return v;
}
__device__ __forceinline__ void ln_row_dual(int lane, const float* xrow, const float* g, const float* b, float* o32, f16_t* o16) {
    const GAS f32x4* xr = (const GAS f32x4*)xrow + lane;
    f32x4 v[8]; float s = 0.f;
#pragma unroll
    for (int j = 0; j < 8; ++j) { v[j] = xr[64 * j]; s += (v[j].x + v[j].y) + (v[j].z + v[j].w); }
    const float mean = wave_sum_b(s) * (1.f / D); float s2 = 0.f;
#pragma unroll
    for (int j = 0; j < 8; ++j) { v[j] = v[j] - mean; s2 += (v[j].x * v[j].x + v[j].y * v[j].y) + (v[j].z * v[j].z + v[j].w * v[j].w); }
    const float rstd = __builtin_amdgcn_rsqf(wave_sum_b(s2) * (1.f / D) + LN_EPS);
    const GAS f32x4* g4 = (const GAS f32x4*)g + lane; const GAS f32x4* b4 = (const GAS f32x4*)b + lane;
    GAS f32x4* o4 = (GAS f32x4*)o32 + lane; GAS unsigned long long* o8 = (GAS unsigned long long*)o16 + lane;
#pragma unroll
    for (int j = 0; j < 8; ++j) { const f32x4 o = v[j] * rstd * g4[64 * j] + b4[64 * j]; o4[64 * j] = o;
        o8[64 * j] = (unsigned long long)pk2h(o.x, o.y) | ((unsigned long long)pk2h(o.z, o.w) << 32); }
}


__device__ __forceinline__ void ln_row_f16(int lane, const float* xrow, const float* g, const float* b, f16_t* o16, float2* st) {
    const GAS f32x4* xr = (const GAS f32x4*)xrow + lane;
    f32x4 v[8]; float s = 0.f;
#pragma unroll
    for (int j = 0; j < 8; ++j) { v[j] = xr[64 * j]; s += (v[j].x + v[j].y) + (v[j].z + v[j].w); }
    const float mean = wave_sum_b(s) * (1.f / D); float s2 = 0.f;
#pragma unroll
    for (int j = 0; j < 8; ++j) { v[j] = v[j] - mean; s2 += (v[j].x * v[j].x + v[j].y * v[j].y) + (v[j].z * v[j].z + v[j].w * v[j].w); }
    const float rstd = __builtin_amdgcn_rsqf(wave_sum_b(s2) * (1.f / D) + LN_EPS);
    const GAS f32x4* g4 = (const GAS f32x4*)g + lane; const GAS f32x4* b4 = (const GAS f32x4*)b + lane;
    GAS unsigned long long* o8 = (GAS unsigned long long*)o16 + lane;
#pragma unroll
    for (int j = 0; j < 8; ++j) { const f32x4 o = v[j] * rstd * g4[64 * j] + b4[64 * j];
        o8[64 * j] = (unsigned long long)pk2h(o.x, o.y) | ((unsigned long long)pk2h(o.z, o.w) << 32); }
    if (lane == 0) *st = make_float2(mean, rstd);
}

__device__ __forceinline__ void p0_transpose_item_gu(const float* W, int K, int N, f16_t* WT, int gu_s, LAS float* scr, int item, int lane) {
    const int nblk = N / 32, nb = item % nblk; const int row_off = gu_s < 0 ? 0 : 128 * (nb >> 2) + 128 * gu_s;
    p0_transpose_item(W, K, N, WT, row_off, scr, item, lane);
}
__device__ __forceinline__ void ln_norm(int lane, f32x4 (&v)[8], const float* g, const float* b) {
    float s = 0.f;
#pragma unroll
    for (int j = 0; j < 8; ++j) s += (v[j].x + v[j].y) + (v[j].z + v[j].w);
    const float mean = wave_sum_b(s) * (1.f / D); float s2 = 0.f;
#pragma unroll
    for (int j = 0; j < 8; ++j) { v[j] = v[j] - mean; s2 += (v[j].x * v[j].x + v[j].y * v[j].y) + (v[j].z * v[j].z + v[j].w * v[j].w); }
    const float rstd = __builtin_amdgcn_rsqf(wave_sum_b(s2) * (1.f / D) + LN_EPS);
    const GAS f32x4* g4 = (const GAS f32x4*)g + lane; const GAS f32x4* b4 = (const GAS f32x4*)b + lane;
#pragma unroll
    for (int j = 0; j < 8; ++j) v[j] = v[j] * rstd * g4[64 * j] + b4[64 * j];
}
__device__ __forceinline__ void ln_store(int lane, const f32x4 (&v)[8], float* o32, f16_t* o16) {
    GAS f32x4* o4 = (GAS f32x4*)o32 + lane; GAS unsigned long long* o8 = (GAS unsigned long long*)o16 + lane;
#pragma unroll
    for (int j = 0; j < 8; ++j) { o4[64 * j] = v[j]; o8[64 * j] = (unsigned long long)pk2h(v[j].x, v[j].y) | ((unsigned long long)pk2h(v[j].z, v[j].w) << 32); }
}
__device__ __forceinline__ void ln_store16(int lane, const f32x4 (&v)[8], f16_t* o16) {
    GAS unsigned long long* o8 = (GAS unsigned long long*)o16 + lane;
#pragma unroll
    for (int j = 0; j < 8; ++j) o8[64 * j] = (unsigned long long)pk2h(v[j].x, v[j].y) | ((unsigned long long)pk2h(v[j].z, v[j].w) << 32);
}
__device__ __forceinline__ void ln_regs(int lane, f32x4 (&v)[8], const float* g, const float* b, float* o32, f16_t* o16) { ln_norm(lane, v, g, b); ln_store(lane, v, o32, o16); }
__device__ __forceinline__ void rt_stage(const float* src, LAS unsigned char* dst, int wave, int lane) {
#pragma unroll
    for (int i = 0; i < 6; ++i) __builtin_amdgcn_global_load_lds((const unsigned*)(src + 4 * (wave * 64 + lane + 512 * i)), (LAS unsigned*)(dst + (wave * 64 + 512 * i) * 16), 16, 0, 0);
}
__device__ __forceinline__ void route_pick(const float (&acc)[36], const float* gb, const float* eb, int& ea, int& ebb, float& wa, float& wb) {
    float gl[4]; float gm = -3.0e38f; int gi = 0;
#pragma unroll
    for (int i = 0; i < 4; ++i) { gl[i] = acc[i] + gb[i]; if (gl[i] > gm) { gm = gl[i]; gi = i; } }
    float gs = 0.f;
#pragma unroll
    for (int i = 0; i < 4; ++i) gs += __expf(gl[i] - gm);
    const float gtop = 1.f / gs;
    float el[8]; float em = -3.0e38f; int e0 = 0;
#pragma unroll
    for (int i = 0; i < 8; ++i) { float v = 0.f;
#pragma unroll
        for (int g = 0; g < 4; ++g) if (g == gi) v = acc[4 + g * 8 + i] + eb[g * 8 + i];
        el[i] = v; if (v > em) { em = v; e0 = i; } }
    float em2 = -3.0e38f; int e1 = 0;
#pragma unroll
    for (int i = 0; i < 8; ++i) if (i != e0 && el[i] > em2) { em2 = el[i]; e1 = i; }
    const float x1 = __expf(em2 - em);
    const float w0 = 1.f / (1.f + x1), w1 = x1 / (1.f + x1);
    ea = gi * 8 + e0; ebb = gi * 8 + e1; wa = w0 * gtop; wb = w1 * gtop;
}
constexpr int TAB_OFF = LDSCTL_OFF + 1024;
__device__ __forceinline__ void build_moe_table(Frame& F, const int* cnt) {
    LAS int* tab = (LAS int*)(F.lds + TAB_OFF);
    const int tid = FTID;
    if (tid < 32) tab[tid] = __hip_atomic_load(cnt + tid * CNT_STRIDE, __ATOMIC_RELAXED, __HIP_MEMORY_SCOPE_AGENT);
    __syncthreads();
    if (tid == 0) { int p = 0, pa = 0, pb = 0; for (int e = 0; e < 32; ++e) { const int nb = (tab[e] + 255) >> 8, na = nb < 2 ? nb : 2;
            tab[32 + e] = p; tab[65 + e] = pa; tab[98 + e] = pb; p += nb; pa += na; pb += nb - na; } tab[64] = p; tab[97] = pa; tab[130] = pb; }
    __syncthreads();
}

__device__ __forceinline__ float sum8_dpp(float x) {
    x += __builtin_bit_cast(float, __builtin_amdgcn_update_dpp(0, __builtin_bit_cast(int, x), 0xB1, 0xF, 0xF, true));
    x += __builtin_bit_cast(float, __builtin_amdgcn_update_dpp(0, __builtin_bit_cast(int, x), 0x4E, 0xF, 0xF, true));
    x += __builtin_bit_cast(float, __builtin_amdgcn_update_dpp(0, __builtin_bit_cast(int, x), 0x141, 0xF, 0xF, true));
    return x;
}
__device__ __forceinline__ float h2f(unsigned short u) { return (float)__builtin_bit_cast(_Float16, u); }
__device__ __forceinline__ float sum32_x(float x) {
    x += __builtin_bit_cast(float, __builtin_amdgcn_update_dpp(0, __builtin_bit_cast(int, x), 0xB1, 0xF, 0xF, true));
    x += __builtin_bit_cast(float, __builtin_amdgcn_update_dpp(0, __builtin_bit_cast(int, x), 0x4E, 0xF, 0xF, true));
    x += __builtin_bit_cast(float, __builtin_amdgcn_update_dpp(0, __builtin_bit_cast(int, x), 0x141, 0xF, 0xF, true));
    x += __builtin_bit_cast(float, __builtin_amdgcn_update_dpp(0, __builtin_bit_cast(int, x), 0x140, 0xF, 0xF, true));
    x += __builtin_bit_cast(float, __builtin_amdgcn_ds_bpermute((pg8::lane_id() ^ 16) << 2, __builtin_bit_cast(int, x)));
    return x;
}
__device__ __forceinline__ float wsum64(float x) {
    x = sum32_x(x); auto rr = __builtin_amdgcn_permlane32_swap(__float_as_uint(x), __float_as_uint(x), false, false); return __uint_as_float(rr[0]) + __uint_as_float(rr[1]);
}
__device__ __forceinline__ void rwkv_prep_tile(Frame& F, int tile, const f16_t* PROJ16, const f16_t* LSLAB, const float* mu, const float* w0, const f16_t* W2T, const float* a0, const f16_t* A2T, const f16_t* G2T,
                                               const float* k_k, const float* k_a, float* lwout, f16_t* kmod, f16_t* Aout, f16_t* Bout, f16_t* gout) {
    typedef _Float16 f16x8 __attribute__((ext_vector_type(8))); typedef float f32x16 __attribute__((ext_vector_type(16)));
    constexpr int SXS = 592;
    LAS unsigned char* sx = F.lds + RING_OFF;
    const int lane = FLANE, tid = F.wave * 64 + lane, t0 = tile * 32, r32 = lane & 31, hi = lane >> 5;
    __syncthreads();
    for (int e = tid; e < 32 * 36; e += 512) {
        typedef unsigned short us8v __attribute__((ext_vector_type(8)));
        const int tok = e / 36, i8 = (e % 36) * 8, pos = (t0 + tok) & (S - 1);
        float cv[8], pv[8];
#pragma unroll
        for (int i = 0; i < 8; ++i) { cv[i] = 0.f; pv[i] = 0.f; }
#pragma unroll
        for (int sl = 0; sl < 4; ++sl) { const f16_t* cur = LSLAB + ((size_t)sl * T + t0 + tok) * 512 + i8;
            const us8v c8 = *(const GAS us8v*)cur; us8v p8 = c8; if (pos > 0) p8 = *(const GAS us8v*)(cur - 512);
#pragma unroll
            for (int i = 0; i < 8; ++i) { cv[i] += h2f(c8[i]); pv[i] += h2f(p8[i]); } }
        float f[8];
#pragma unroll
        for (int i = 0; i < 8; ++i) { const float xs = cv[i] + ((pos > 0 ? pv[i] : 0.f) - cv[i]) * mu[3072 + i8 + i];
            f[i] = i8 < 64 ? 1.f - 2.f / (1.f + __expf(2.f * xs)) : (i8 < 128 ? xs : 1.f / (1.f + __expf(-xs))); }
        *(LAS v4u*)(sx + tok * SXS + i8 * 2) = (v4u){pk2h(f[0], f[1]), pk2h(f[2], f[3]), pk2h(f[4], f[5]), pk2h(f[6], f[7])};
    }
    __syncthreads();
    const LAS unsigned char* ap = sx + r32 * SXS + hi * 16;
#pragma unroll 1
    for (int hd = 0; hd < 2; ++hd) {
        const int ch0 = 128 * F.wave + 64 * hd;
        f32x16 aw[2], aa[2], ag[2];
#pragma unroll
        for (int tt = 0; tt < 2; ++tt)
#pragma unroll
            for (int r = 0; r < 16; ++r) { aw[tt][r] = 0.f; aa[tt][r] = 0.f; ag[tt][r] = 0.f; }
#pragma unroll
        for (int tt = 0; tt < 2; ++tt) {
            const int n = ch0 + 32 * tt + r32;
            const f16_t* bw = W2T + (size_t)n * 64 + hi * 8; const f16_t* ba = A2T + (size_t)n * 64 + hi * 8; const f16_t* bg = G2T + (size_t)n * 160 + hi * 8;
#pragma unroll
            for (int ks = 0; ks < 4; ++ks) {
                aw[tt] = __builtin_amdgcn_mfma_f32_32x32x16_f16(*(const LAS f16x8*)(ap + ks * 32), *(const GAS f16x8*)(bw + ks * 16), aw[tt], 0, 0, 0);
                aa[tt] = __builtin_amdgcn_mfma_f32_32x32x16_f16(*(const LAS f16x8*)(ap + 128 + ks * 32), *(const GAS f16x8*)(ba + ks * 16), aa[tt], 0, 0, 0); }
#pragma unroll
            for (int ks = 0; ks < 10; ++ks)
                ag[tt] = __builtin_amdgcn_mfma_f32_32x32x16_f16(*(const LAS f16x8*)(ap + 256 + ks * 32), *(const GAS f16x8*)(bg + ks * 16), ag[tt], 0, 0, 0);
        }
        float k0[2][16];
        float pkk[2], pka[2], pmu[2], pw0[2], pa0[2];
#pragma unroll
        for (int tt = 0; tt < 2; ++tt) { const int n = ch0 + 32 * tt + r32; pkk[tt] = k_k[n]; pka[tt] = k_a[n]; pmu[tt] = mu[1024 + n]; pw0[tt] = w0[n]; pa0[tt] = a0[n]; }
#pragma unroll
        for (int rh = 0; rh < 2; ++rh) {
        float inv[8];
#pragma unroll
        for (int r = 8 * rh; r < 8 * rh + 8; ++r) { const int tok = t0 + (r & 3) + 8 * (r >> 2) + 4 * hi, pos = tok & (S - 1); float ss = 0.f;
#pragma unroll
            for (int tt = 0; tt < 2; ++tt) { const f16_t* cur = PROJ16 + (size_t)tok * PN + 4096 + ch0 + 32 * tt + r32;
                const float cv = h2f(cur[0]), pv = pos > 0 ? h2f(cur[-PN]) : 0.f; k0[tt][r] = cv + (pv - cv) * pmu[tt]; const float kq = k0[tt][r] * pkk[tt]; ss = fmaf(kq, kq, ss); }
            ss = sum32_x(ss); inv[r - 8 * rh] = __builtin_amdgcn_rsqf(fmaxf(ss, 1e-24f)); }
#pragma unroll
        for (int r = 8 * rh; r < 8 * rh + 8; ++r) { const int tok = t0 + (r & 3) + 8 * (r >> 2) + 4 * hi;
#pragma unroll
            for (int tt = 0; tt < 2; ++tt) { const size_t o = (size_t)tok * RWK + ch0 + 32 * tt + r32;
                const float z = -(pw0[tt] + aw[tt][r]); const float sp = z > 20.f ? z : __logf(1.f + __expf(z));
                lwout[o] = -__expf(-sp - 0.5f);
                const float asig = 1.f / (1.f + __expf(-(pa0[tt] + aa[tt][r]))); const float kk = k0[tt][r] * pkk[tt] * inv[r - 8 * rh];
                kmod[o] = __builtin_bit_cast(unsigned short, (_Float16)(k0[tt][r] * (1.f + (asig - 1.f) * pka[tt])));
                Aout[o] = __builtin_bit_cast(unsigned short, (_Float16)(-kk)); Bout[o] = __builtin_bit_cast(unsigned short, (_Float16)(kk * asig));
                gout[o] = __builtin_bit_cast(unsigned short, (_Float16)ag[tt][r]); } }
        }
    }
}
__device__ __forceinline__ float sum16_dpp(float x) {
    x += __builtin_bit_cast(float, __builtin_amdgcn_update_dpp(0, __builtin_bit_cast(int, x), 0xB1, 0xF, 0xF, true));
    x += __builtin_bit_cast(float, __builtin_amdgcn_update_dpp(0, __builtin_bit_cast(int, x), 0x4E, 0xF, 0xF, true));
    x += __builtin_bit_cast(float, __builtin_amdgcn_update_dpp(0, __builtin_bit_cast(int, x), 0x141, 0xF, 0xF, true));
    x += __builtin_bit_cast(float, __builtin_amdgcn_update_dpp(0, __builtin_bit_cast(int, x), 0x140, 0xF, 0xF, true));
    return x;
}
__device__ __forceinline__ f32x4 h4f(const f16_t* p) { typedef _Float16 h4_t __attribute__((ext_vector_type(4))); const h4_t v = *(const GAS h4_t*)p; return (f32x4){(float)v[0], (float)v[1], (float)v[2], (float)v[3]}; }
#ifndef REP_P0
#define REP_P0 1
#endif
#ifndef REP_PROJ
#define REP_PROJ 1
#endif
#ifndef REP_PLE
#define REP_PLE 1
#endif
#ifndef REP_CONV
#define REP_CONV 1
#endif
#ifndef REP_P2
#define REP_P2 1
#endif
#ifndef CONV_RATE
#define CONV_RATE 768
#endif
#ifndef REP_P3
#define REP_P3 1
#endif
#ifndef PROBE_K
#define PROBE_K -1
#endif
#ifndef PROBE_J
#define PROBE_J -1
#endif
#ifndef PROBE_SCALE
#define PROBE_SCALE 1e-3f
#endif
#ifndef REP_P5
#define REP_P5 1
#endif
#ifndef REP_P8
#define REP_P8 1
#endif
#ifndef REP_P6
#define REP_P6 1
#endif
#ifndef REP_P7
#define REP_P7 1
#endif
struct Args { const float* in[37]; float* out; unsigned char* ws; int ph_lo, ph_hi, li, pad; };
__global__ void __launch_bounds__(NWAVES * 64, 2) mega_fwd(Args args) {
    extern __shared__ __attribute__((aligned(16))) unsigned char lds[];
    Frame F;
    F.lds = (LAS unsigned char*)lds; F.MISC = (volatile LAS unsigned*)(F.lds + MISC_OFF);
    F.wave = __builtin_amdgcn_readfirstlane(threadIdx.x >> 6);
    F.G = gridDim.x; { const int bx = blockIdx.x; F.vcu = (F.G % 8 == 0) ? (bx % 8) * (F.G / 8) + bx / 8 : bx; }
    unsigned char* ws = args.ws;
    F.ctl = (gu32*)(ws);
    for (int u = FTID; u < (LDS_BYTES - LDSCTL_OFF) / 4; u += NWAVES * 64) ((LAS unsigned*)(F.lds + LDSCTL_OFF))[u] = 0u;
    __syncthreads();
    XcdBarrier bar = xcd_barrier_post((unsigned*)(F.ctl + CW_BAR) + args.li * XCD_BAR_WORDS, F.MISC + 8);
    unsigned long long t0_ = 0, tk_ = 0; if (PROBE_K != -1) t0_ = __builtin_amdgcn_s_memrealtime();
    const int lo = args.ph_lo, hi = args.ph_hi;
#define IN(k) (lo <= (k) && (k) < hi)
#define BOTH(k) (IN(k) && IN((k) + 1))
    f16_t* WinT = (f16_t*)(ws + WS_WINT); f16_t* H16 = (f16_t*)(ws + WS_H16); f16_t* PROJ16 = (f16_t*)(ws + WS_PROJ16); float* DECAY = (float*)(ws + WS_DECAY); f16_t* KMOD = (f16_t*)(ws + WS_KMOD); f16_t* A16 = (f16_t*)(ws + WS_A16); f16_t* B16 = (f16_t*)(ws + WS_B16); f16_t* G16 = (f16_t*)(ws + WS_G16);
    f16_t* WoutT = (f16_t*)(ws + WS_WOUTT); f16_t* GateT = (f16_t*)(ws + WS_GATET); f16_t* PleT = (f16_t*)(ws + WS_PLET); f16_t* P16 = (f16_t*)(ws + WS_P16);
    f16_t* PW16 = (f16_t*)(ws + WS_PW16); f16_t* Y16 = (f16_t*)(ws + WS_Y16); float* ROWRS = (float*)(ws + WS_ROWRS);
    float* RT = (float*)(ws + WS_RT); f16_t* GUT = (f16_t*)(ws + WS_GUT); f16_t* DNT = (f16_t*)(ws + WS_DNT); f16_t* HID = (f16_t*)(ws + WS_HID); f16_t* FFN16 = (f16_t*)(ws + WS_FFN16); f16_t* H1_16 = (f16_t*)(ws + WS_H1_16);
    int* cnt = (int*)(ws + WS_CNT); int* ltok = (int*)(ws + WS_LTOK); int* lpair = (int*)(ws + WS_LPAIR); float* pairw = (float*)(ws + WS_PAIRW);
    const int gw = F.vcu * NWAVES + F.wave, NGW = F.G * NWAVES;
    if (IN(0)) for (int rep_ = 0; rep_ < REP_P0; ++rep_) {
        LAS float* scr = (LAS float*)(F.lds + RING_OFF + F.wave * 16384);
        constexpr int I_IN = (D / 64) * (NPROJ / 32);
        for (int it = gw; it < I_IN; it += NGW) p0_transpose_item(args.in[5], D, NPROJ, WinT, 0, scr, it, FLANE);
        constexpr int I_SQ = (D / 64) * (D / 32), I_PLE = (256 / 64) * (D / 32);
        for (int it = gw; it < 2 * I_SQ + I_PLE; it += NGW) {
            if (it < I_SQ) p0_transpose_item(args.in[22], D, D, WoutT, 0, scr, it, FLANE);
            else if (it < 2 * I_SQ) p0_transpose_item(args.in[36], D, D, GateT, 0, scr, it - I_SQ, FLANE);
            else p0_transpose_item(args.in[34], 256, D, PleT, 0, scr, it - 2 * I_SQ, FLANE);
        }
        { const GAS f32x4* pi = (const GAS f32x4*)args.in[1]; GAS unsigned long long* po = (GAS unsigned long long*)P16;
          for (int i = blockIdx.x * 512 + FTID; i < T * 256 / 4; i += F.G * 512) { const f32x4 v = pi[i]; po[i] = (unsigned long long)pk2h(v.x, v.y) | ((unsigned long long)pk2h(v.z, v.w) << 32); } }
        { GAS v4u* z = (GAS v4u*)(WinT + (size_t)NPROJ * D); const int nz = (PN - NPROJ) * D * 2 / 16;
          for (int i = blockIdx.x * 512 + FTID; i < nz; i += F.G * 512) z[i] = (v4u){0u, 0u, 0u, 0u}; }
        {
            f16_t* W2T = (f16_t*)(ws + WS_W2T); f16_t* A2T = (f16_t*)(ws + WS_A2T); f16_t* G2T = (f16_t*)(ws + WS_G2T);
            for (int i = blockIdx.x * 512 + FTID; i < 1024 * 288; i += F.G * 512) { const int n = i / 288, k = i % 288;
                if (k < 64) W2T[n * 64 + k] = __builtin_bit_cast(unsigned short, (_Float16)args.in[13][k * 1024 + n]);
                else if (k < 128) A2T[n * 64 + (k - 64)] = __builtin_bit_cast(unsigned short, (_Float16)args.in[15][(k - 64) * 1024 + n]);
                else G2T[n * 160 + (k - 128)] = __builtin_bit_cast(unsigned short, (_Float16)args.in[16][(k - 128) * 1024 + n]); } }
        if (blockIdx.x == 0) {
            const int tid = FTID; float* lamp = (float*)(ws + WS_LAM); float* biasT = (float*)(ws + WS_BIAS);
            if (tid < 64) { const float a = wave_sum_b(args.in[6][tid] * args.in[7][tid]), b2 = wave_sum_b(args.in[8][tid] * args.in[9][tid]); if (tid == 0) *lamp = expf(a) - expf(b2) + LAMBDA_INIT; }
            for (int i = tid; i < 8 * 129; i += 512) { const int hh = i / 129, n = i % 129; int bucket;
                if (n < 16) bucket = n; else { const int large = 16 + (int)(logf((float)n / 16.f) / 2.0794415416798357f * 16.f); bucket = large < 31 ? large : 31; }
                biasT[i] = args.in[4][bucket * 8 + hh]; }
        }
        for (int m = gw; m < T; m += NGW) ln_row_f16(FLANE, args.in[0] + (size_t)m * D, args.in[2], args.in[3], H16 + (size_t)m * D, (float2*)(ws + WS_ROWST) + m);
        if (BOTH(0) && rep_ == REP_P0 - 1) xcd_barrier(bar); else __syncthreads();
    }
    if (PROBE_K == 0) tk_ = __builtin_amdgcn_s_memrealtime();
    if (PROBE_J == 0) t0_ = __builtin_amdgcn_s_memrealtime();
    if (IN(1)) {
        pg8::Gemm g{H16, WinT, T, 6144, D, D}; pg8::StaticOrder S; S.init(T, 6144, F.G, (int)blockIdx.x);
        pg8::EpiF16 E{PROJ16, PN, 4, att::C2};
        for (int rep_ = 0; rep_ < REP_PROJ; ++rep_) pg8::gemm_phase<pg8::EpiF16, pg8::StaticOrder, true>(F.lds + RING_OFF, g, S, E, F.wave);
        { pg8::Gemm gl{H16, WinT + (size_t)6144 * D, T, 512, 512, D}; pg8::SplitKOrder Sl{T / 256, 2, 4, F.G, (int)blockIdx.x};
          pg8::EpiSlab El{(f16_t*)(ws + WS_LSLAB), 512, (size_t)T * 512};
          pg8::gemm_phase<pg8::EpiSlab, pg8::SplitKOrder, true>(F.lds + RING_OFF, gl, Sl, El, F.wave); }
        for (int rep_ = 0; rep_ < REP_PLE; ++rep_) { pg8::Gemm g2{P16, PleT, T, D, 256, 256}; pg8::StaticOrder S2; S2.init(T, D, F.G, (int)blockIdx.x);
          pg8::EpiF16 E2{PW16, D, 0, 1.f};
          pg8::gemm_phase<pg8::EpiF16, pg8::StaticOrder, true>(F.lds + RING_OFF, g2, S2, E2, F.wave); }
        if (BOTH(1)) xcd_barrier(bar);
    }
    if (PROBE_K == 1) tk_ = __builtin_amdgcn_s_memrealtime();
    if (PROBE_J == 1) t0_ = __builtin_amdgcn_s_memrealtime();
    if (IN(2)) {
        for (int rep_ = 0; rep_ < REP_P2; ++rep_)
        if (F.vcu < T / 32) { const int tile = F.vcu;
            rwkv_prep_tile(F, tile, PROJ16, (const f16_t*)(ws + WS_LSLAB), args.in[11], args.in[12], (const f16_t*)(ws + WS_W2T), args.in[14], (const f16_t*)(ws + WS_A2T), (const f16_t*)(ws + WS_G2T), args.in[17], args.in[18], DECAY, KMOD, A16, B16, G16);
            asm volatile("s_waitcnt vmcnt(0)" ::: "memory"); __syncthreads();
            { rk::ChunkIn nin; const int tl_ = (F.wave & 3) * 64 + FLANE, tg_ = tile * 32 + (tl_ >> 3), ps_ = tg_ & (S - 1), cb_ = (F.wave >> 2) * 64 + (tl_ & 7) * 8;
              rk::chunk_load(nin, tg_, ps_, cb_, ws);
              for (int hA = 0; hA < 16; hA += 2) {
                  rk::chunk_pair(F.lds + RING_OFF, F.wave, tile, hA, nin, hA + 2 < 16, args.in[11], args.in[19], ws); } }
            __syncthreads();
        }
        if (BOTH(2)) xcd_barrier(bar);
    }
    if (PROBE_K == 2) tk_ = __builtin_amdgcn_s_memrealtime();
    if (PROBE_J == 2) t0_ = __builtin_amdgcn_s_memrealtime();
    if (IN(3)) {
        if (F.vcu < 64) rk::scan_unit(F.lds + RING_OFF, F.wave, F.vcu, ws + WS_CHK, (const float*)(ws + WS_BONUS), PROJ16, args.in[11], G16, args.in[20], args.in[21], Y16);
        {
            const float lam = *(const float*)(ws + WS_LAM);
            volatile LAS unsigned* qslot = F.MISC + 12;
            const float* wg = args.in[29]; const float* wu = args.in[30]; const float* wd = args.in[31];
            auto conv_batch = [&]() -> bool {
                __syncthreads();
                if (FTID == 0) qslot[1] = __hip_atomic_fetch_add(F.ctl + CW_CONVQ, 1u, __ATOMIC_RELAXED, __HIP_MEMORY_SCOPE_AGENT);
                __syncthreads();
                const int q = (int)__builtin_amdgcn_readfirstlane(qslot[1]);
                if (q >= NE * 1536 / 64) return false;
                LAS unsigned char* scr = F.lds + RING_OFF + F.wave * 16384;
                tpd_stream(q * 64 + F.wave, q * 64 + 64, 8, [=](int it) { const int e = it / 1536, r = it % 1536;
                    if (r < 1024) { const int rr = r & 511, nb = rr % 16; return TpDesc{(r < 512 ? wg : wu) + (size_t)e * D * 512, GUT + (size_t)e * 1024 * D, D, 512, 128 * (nb >> 2) + (r < 512 ? 0 : 128), rr}; }
                    return TpDesc{wd + (size_t)e * 512 * D, DNT + (size_t)e * D * 512, 512, D, 0, r - 1024}; }, scr, FLANE);
                return true;
            };
            int credit = 0;
            for (;;) {
                __syncthreads();
                if (FTID == 0) *qslot = __hip_atomic_fetch_add(F.ctl + CW_ATTQ, 1u, __ATOMIC_RELAXED, __HIP_MEMORY_SCOPE_AGENT);
                __syncthreads();
                const int u = (int)__builtin_amdgcn_readfirstlane(*qslot);
                if (u >= 512) break;
                const int qb = 15 - (u >> 5), bh = u & 31;
                att::attn_unit<8>(F.lds + RING_OFF, F.wave, bh >> 3, bh & 7, qb, PROJ16, Y16, (const float*)(ws + WS_BIAS) + (bh & 7) * 129, lam, args.in[10]);
                credit += 2 * (qb + 1) * CONV_RATE;
                while (credit >= 8704) { credit -= 8704; if (!conv_batch()) { credit = 0; break; } }
            }
            while (conv_batch()) {}
        }
        if (BOTH(3)) xcd_barrier(bar);
    }
    if (PROBE_K == 3) tk_ = __builtin_amdgcn_s_memrealtime();
    if (PROBE_J == 3) t0_ = __builtin_amdgcn_s_memrealtime();
    if (IN(4)) {
        for (int i = blockIdx.x * 512 + FTID; i < 36 * D; i += F.G * 512) { const int e = i / D, d = i % D; RT[i] = e < 4 ? args.in[25][d * 4 + e] : args.in[27][d * 32 + (e - 4)]; }
        pg8::Gemm g{Y16, WoutT, T, D, D, D}; pg8::StaticOrder S; S.init(T, D, F.G, (int)blockIdx.x);
        pg8::EpiResLN E{args.in[0], args.out, D, ALPHA, (const float2*)(ws + WS_ROWST), args.in[2], args.in[3]};
        pg8::gemm_phase<pg8::EpiResLN, pg8::StaticOrder, true>(F.lds + RING_OFF, g, S, E, F.wave);
        if (BOTH(4)) xcd_barrier(bar);
    }
    if (PROBE_K == 4) tk_ = __builtin_amdgcn_s_memrealtime();
    if (PROBE_J == 4) t0_ = __builtin_amdgcn_s_memrealtime();
    if (IN(5)) for (int rep_ = 0; rep_ < REP_P5; ++rep_) {
        const bool dry = rep_ < REP_P5 - 1;
        f16_t* o16b = dry ? (f16_t*)(ws + WS_CHK + 64 * MiB) : H1_16;
        const int lane = FLANE, tid = F.wave * 64 + lane;
        LAS float* lg = (LAS float*)(F.lds + RING_OFF + 49152) + F.wave * 256;
        LAS int* lcnt = (LAS int*)(F.lds + RING_OFF + 106496);
        if (F.wave == 0 && lane < 32) lcnt[lane] = 0;
        if (F.vcu < T / 32) {
            const int r0 = F.vcu * 32 + F.wave * 4;
            f32x4 v0[8], v1[8], v2[8], v3[8];
            { const GAS f32x4* xr = (const GAS f32x4*)(args.out + (size_t)r0 * D) + lane;
#pragma unroll
              for (int j = 0; j < 8; ++j) { v0[j] = xr[64 * j]; v1[j] = xr[64 * j + D / 4]; v2[j] = xr[64 * j + 2 * (D / 4)]; v3[j] = xr[64 * j + 3 * (D / 4)]; } }
            rt_stage(RT, F.lds + RING_OFF, F.wave, lane);
            ln_norm(lane, v0, args.in[23], args.in[24]); ln_norm(lane, v1, args.in[23], args.in[24]); asm volatile("" ::: "memory"); ln_norm(lane, v2, args.in[23], args.in[24]); ln_norm(lane, v3, args.in[23], args.in[24]);
#pragma unroll 1
            for (int ec = 0; ec < 6; ++ec) {
                asm volatile("s_waitcnt vmcnt(0)" ::: "memory"); __syncthreads();
                if (ec + 1 < 6) rt_stage(RT + (size_t)(ec + 1) * 6 * D, F.lds + RING_OFF + ((ec + 1) & 1) * 57344, F.wave, lane);
                const LAS float* rtb = (const LAS float*)(F.lds + RING_OFF + (ec & 1) * 57344);
                float a0[6], a1[6], a2[6], a3[6];
                typedef float f32x2 __attribute__((ext_vector_type(2)));
#pragma unroll
                for (int eh = 0; eh < 2; ++eh) {
                    f32x2 c0[3], c1[3], c2[3], c3[3];
#pragma unroll
                    for (int e = 0; e < 3; ++e) { c0[e] = 0.f; c1[e] = 0.f; c2[e] = 0.f; c3[e] = 0.f; }
#pragma unroll
                    for (int j = 0; j < 8; ++j)
#pragma unroll
                        for (int e = 0; e < 3; ++e) { const f32x4 w = *(const LAS f32x4*)(rtb + (3 * eh + e) * D + 256 * j + 4 * lane); const f32x2 wl = w.xy, wh = w.zw;
                            c0[e] += v0[j].xy * wl; c0[e] += v0[j].zw * wh; c1[e] += v1[j].xy * wl; c1[e] += v1[j].zw * wh;
                            c2[e] += v2[j].xy * wl; c2[e] += v2[j].zw * wh; c3[e] += v3[j].xy * wl; c3[e] += v3[j].zw * wh; }
#pragma unroll
                    for (int e = 0; e < 3; ++e) { a0[3 * eh + e] = c0[e].x + c0[e].y; a1[3 * eh + e] = c1[e].x + c1[e].y; a2[3 * eh + e] = c2[e].x + c2[e].y; a3[3 * eh + e] = c3[e].x + c3[e].y; }
                }
#pragma unroll
                for (int e = 0; e < 6; ++e) { a0[e] = wsum64(a0[e]); a1[e] = wsum64(a1[e]); a2[e] = wsum64(a2[e]); a3[e] = wsum64(a3[e]); }
                if (lane == 0) {
#pragma unroll
                    for (int e = 0; e < 6; ++e) { lg[ec * 6 + e] = a0[e]; lg[64 + ec * 6 + e] = a1[e]; lg[128 + ec * 6 + e] = a2[e]; lg[192 + ec * 6 + e] = a3[e]; } }
            }
            LDS_WAIT();
            int ea = 0, ebb = 0, pl0 = 0, pl1 = 0; float wa = 0.f, wb = 0.f;
            if (lane < 4 && !dry) { float aa[36];
#pragma unroll
                for (int e = 0; e < 36; ++e) aa[e] = lg[lane * 64 + e];
                route_pick(aa, args.in[26], args.in[28], ea, ebb, wa, wb);
                pl0 = __hip_atomic_fetch_add(lcnt + ea, 1, __ATOMIC_RELAXED, __HIP_MEMORY_SCOPE_WORKGROUP); pl1 = __hip_atomic_fetch_add(lcnt + ebb, 1, __ATOMIC_RELAXED, __HIP_MEMORY_SCOPE_WORKGROUP); }
            __syncthreads();
            if (F.wave == 0 && lane < 32 && !dry) { const int c = lcnt[lane]; int base = 0; if (c) base = atomicAdd(&cnt[lane * CNT_STRIDE], c); lcnt[32 + lane] = base; }
            __syncthreads();
            if (lane < 4 && !dry) { const int tok = r0 + lane; const int p0 = lcnt[32 + ea] + pl0, p1 = lcnt[32 + ebb] + pl1;
                ltok[ea * 8192 + p0] = tok; lpair[ea * 8192 + p0] = tok * 2; ltok[ebb * 8192 + p1] = tok; lpair[ebb * 8192 + p1] = tok * 2 + 1;
                pairw[tok * 2] = wa; pairw[tok * 2 + 1] = wb; }
            ln_store16(lane, v0, o16b + (size_t)r0 * D); ln_store16(lane, v1, o16b + (size_t)(r0 + 1) * D);
            ln_store16(lane, v2, o16b + (size_t)(r0 + 2) * D); ln_store16(lane, v3, o16b + (size_t)(r0 + 3) * D);
        }
        if (BOTH(5) && !dry) xcd_barrier(bar); else __syncthreads();
    }
    if (PROBE_K == 5) tk_ = __builtin_amdgcn_s_memrealtime();
    if (PROBE_J == 5) t0_ = __builtin_amdgcn_s_memrealtime();
    if (IN(6)) {
        build_moe_table(F, cnt);
        pg8::Gemm g{H1_16, GUT, 0, 0, D, D}; pg8::MoeOrder<true> S{(const LAS int*)(F.lds + TAB_OFF), ltok, F.vcu, F.G, 4, (size_t)1024 * D * 2, 0};
        pg8::EpiGU E{HID};
        for (int rep_ = 0; rep_ < REP_P6; ++rep_) pg8::gemm_phase<pg8::EpiGU, pg8::MoeOrder<true>, true>(F.lds + RING_OFF, g, S, E, F.wave);
        if (BOTH(6)) xcd_barrier(bar);
    }
    if (PROBE_K == 6) tk_ = __builtin_amdgcn_s_memrealtime();
    if (PROBE_J == 6) t0_ = __builtin_amdgcn_s_memrealtime();
    if (IN(7)) {
        build_moe_table(F, cnt);
        const pg8::Gemm gU{H1_16, GUT, 0, 0, D, D}; const pg8::Gemm gD{HID, DNT, 0, 0, 512, 512};
        const pg8::EpiGU EU{HID}; const pg8::EpiDown ED{FFN16, lpair};
        if (F.vcu < 64) { pg8::MoeOrder<true> S{(const LAS int*)(F.lds + TAB_OFF), ltok, F.vcu, 64, 4, (size_t)1024 * D * 2, 1};
            pg8::gemm_phase<pg8::EpiGU, pg8::MoeOrder<true>, true>(F.lds + RING_OFF, gU, S, EU, F.wave); }
        else { pg8::MoeOrder<false> S{(const LAS int*)(F.lds + TAB_OFF), nullptr, F.vcu - 64, F.G - 64, 8, (size_t)D * 512 * 2, 0};
            pg8::gemm_phase<pg8::EpiDown, pg8::MoeOrder<false>, true>(F.lds + RING_OFF, gD, S, ED, F.wave); }
        xcd_barrier(bar);
        { pg8::MoeOrder<false> S{(const LAS int*)(F.lds + TAB_OFF), nullptr, F.vcu, F.G, 8, (size_t)D * 512 * 2, 1};
          pg8::gemm_phase<pg8::EpiDown, pg8::MoeOrder<false>, true>(F.lds + RING_OFF, gD, S, ED, F.wave); }
        if (BOTH(7)) xcd_barrier(bar);
    }
    if (PROBE_K == 7) tk_ = __builtin_amdgcn_s_memrealtime();
    if (PROBE_J == 7) t0_ = __builtin_amdgcn_s_memrealtime();
    if (IN(8)) for (int rep_ = 0; rep_ < REP_P8; ++rep_) {
        const bool dry = rep_ < REP_P8 - 1;
        f16_t* o16b = dry ? (f16_t*)(ws + WS_GUT + 64 * MiB) : Y16; float* rrs = dry ? (float*)(ws + WS_GUT + 100 * MiB) : ROWRS;
        typedef _Float16 h4_t __attribute__((ext_vector_type(4)));
        const int lane = FLANE;
        for (int m = gw; m < T; m += NGW) {
            f32x4 v[8]; const GAS h4_t* xr = (const GAS h4_t*)(H1_16 + (size_t)m * D) + lane;
            const GAS h4_t* f0 = (const GAS h4_t*)(FFN16 + (size_t)(2 * m) * D) + lane; const GAS h4_t* f1 = (const GAS h4_t*)(FFN16 + (size_t)(2 * m + 1) * D) + lane;
            const GAS h4_t* pr = (const GAS h4_t*)(PW16 + (size_t)m * D) + lane;
            const float w0 = pairw[2 * m], w1 = pairw[2 * m + 1]; float q = 0.f;
#pragma unroll
            for (int j = 0; j < 8; ++j) { const h4_t x = xr[64 * j]; const h4_t a = f0[64 * j], c = f1[64 * j], pv = pr[64 * j];
                v[j].x = ALPHA * (float)x[0] + w0 * (float)a[0] + w1 * (float)c[0]; v[j].y = ALPHA * (float)x[1] + w0 * (float)a[1] + w1 * (float)c[1];
                v[j].z = ALPHA * (float)x[2] + w0 * (float)a[2] + w1 * (float)c[2]; v[j].w = ALPHA * (float)x[3] + w0 * (float)a[3] + w1 * (float)c[3];
                q += ((float)pv[0] * (float)pv[0] + (float)pv[1] * (float)pv[1]) + ((float)pv[2] * (float)pv[2] + (float)pv[3] * (float)pv[3]); }
            ln_norm(lane, v, args.in[32], args.in[33]); ln_store16(lane, v, o16b + (size_t)m * D);
            q = wave_sum_b(q);
            if (lane == 0) rrs[m] = __builtin_amdgcn_rsqf(q * (1.f / D) + LN_EPS);
        }
        if (BOTH(8) && !dry) xcd_barrier(bar); else __syncthreads();
    }
    if (PROBE_K == 8) tk_ = __builtin_amdgcn_s_memrealtime();
    if (PROBE_J == 8) t0_ = __builtin_amdgcn_s_memrealtime();
    if (IN(9)) {
        pg8::Gemm g{Y16, GateT, T, D, D, D}; pg8::StaticOrder S; S.init(T, D, F.G, (int)blockIdx.x);
        pg8::EpiFinal E{args.out, D, Y16, PW16, ROWRS, args.in[35]};
        pg8::gemm_phase<pg8::EpiFinal, pg8::StaticOrder, true>(F.lds + RING_OFF, g, S, E, F.wave);
    }
    if (PROBE_K != -1) {
        if (PROBE_K == 9) tk_ = __builtin_amdgcn_s_memrealtime();
        xcd_barrier(bar);
        if (blockIdx.x == 0 && FTID == 0) args.out[0] += (PROBE_K == -2) ? 100000.f : (float)(tk_ - t0_) * PROBE_SCALE;
    }
#undef IN
#undef BOTH
}

extern "C" void kernel_launch(void* const* d_in, const int* in_sizes, int n_in, void* d_out, int out_size, void* d_ws, size_t ws_size, hipStream_t stream) {
    static int grid = 0;
    if (grid == 0) {
        if (ws_size < WS_END2 || n_in != 37 || out_size != T * D) { fprintf(stderr, "kernel_launch: bad ws/n_in/out: %zu %d %d\n", ws_size, n_in, out_size); grid = -1; return; }
        int dev = 0, cus = 0;
        if (hipGetDevice(&dev) != hipSuccess || hipDeviceGetAttribute(&cus, hipDeviceAttributeMultiprocessorCount, dev) != hipSuccess) { grid = -1; return; }
        if (hipFuncSetAttribute((const void*)mega_fwd, hipFuncAttributeMaxDynamicSharedMemorySize, LDS_BYTES) != hipSuccess) { fprintf(stderr, "kernel_launch: hipFuncSetAttribute failed\n"); grid = -1; return; }
        if (cus != 256) { fprintf(stderr, "kernel_launch: built for a 256-CU device, found %d\n", cus); grid = -1; return; }
        grid = cus;
    }
    if (grid < 0) return;
    (void)hipMemsetAsync(d_ws, 0, CTL_ZERO_BYTES, stream);
    Args a{}; for (int i = 0; i < 37; ++i) a.in[i] = (const float*)d_in[i]; a.out = (float*)d_out; a.ws = (unsigned char*)d_ws; a.ph_lo = 0; a.ph_hi = 10; a.li = 0;
    hipLaunchKernelGGL(mega_fwd, dim3(grid), dim3(NWAVES * 64), LDS_BYTES, stream, a);
}
```

```cpp
#include <hip/hip_runtime.h>
#include <cstdio>
#include <cstdint>
#include <cmath>

constexpr int NB = 4, S = 2048, D = 2048, T = NB * S;
constexpr int NPROJ = 6432;
constexpr int RWK = 1024;
constexpr int COL_Q = 0, COL_K = 1024, COL_V = 2048, COL_RW = 3072;
constexpr int NH = 8, NRH = 16;
constexpr int NE = 32;
constexpr float LN_EPS = 1e-5f;
constexpr float ALPHA = 1.189207115002721f;
constexpr float LAMBDA_INIT = 0.2f;

constexpr size_t MiB = 1u << 20;
constexpr size_t WS_CNT = 4096;
constexpr int CNT_STRIDE = 32;
constexpr size_t WS_LTOK = 1 * MiB;
constexpr size_t WS_LPAIR = 2 * MiB;
constexpr size_t WS_PAIRW = 3 * MiB;
constexpr size_t WS_RT = 3 * MiB + 128 * 1024;
constexpr size_t WS_LAM = 3 * MiB + 512 * 1024;
constexpr size_t WS_BIAS = 3 * MiB + 512 * 1024 + 1024;
constexpr size_t WS_ROWRS = 3 * MiB + 768 * 1024;
constexpr size_t WS_ROWST = 3 * MiB + 832 * 1024;
constexpr size_t WS_WINT = 4 * MiB;
constexpr size_t WS_WOUTT = 30 * MiB;
constexpr size_t WS_GATET = 38 * MiB;
constexpr size_t WS_PLET = 46 * MiB;
constexpr size_t WS_P16 = 47 * MiB;
constexpr size_t WS_W2T = 51 * MiB;
constexpr size_t WS_A2T = 51 * MiB + 128 * 1024;
constexpr size_t WS_G2T = 51 * MiB + 256 * 1024;
constexpr size_t WS_CHK = 52 * MiB;
constexpr size_t WS_BONUS = 148 * MiB;
constexpr size_t WS_LSLAB = 150 * MiB;
constexpr size_t WS_GUT = 348 * MiB;
constexpr size_t WS_DNT = 150 * MiB;
constexpr size_t WS_PROJ16 = 244 * MiB;
constexpr size_t WS_FFN16 = 52 * MiB;
constexpr size_t WS_HID = 116 * MiB;
constexpr size_t WS_DECAY = 348 * MiB;
constexpr size_t WS_KMOD = 380 * MiB;
constexpr size_t WS_A16 = 396 * MiB;
constexpr size_t WS_B16 = 412 * MiB;
constexpr size_t WS_G16 = 214 * MiB;
constexpr size_t WS_H16 = 444 * MiB;
constexpr size_t WS_H1_16 = 244 * MiB;
constexpr size_t WS_Y16 = 476 * MiB;
constexpr size_t WS_PW16 = 508 * MiB;
constexpr size_t WS_END2 = 540 * MiB;

namespace pg8 {
#define PG8_LAS __attribute__((address_space(3)))
typedef unsigned short f16_t;
typedef _Float16 f16x8 __attribute__((ext_vector_type(8)));
typedef float f32x4 __attribute__((ext_vector_type(4)));
typedef unsigned u32x4 __attribute__((ext_vector_type(4)));
constexpr int BM = 256, BK = 64, HALF = 128, HTB = HALF * BK * 2  , STAGE_BYTES = 8 * HTB, NXCD = 8, WGM = 8;

__host__ __device__ __forceinline__ int lds_byte(int r, int c) { const int st = (r >> 4) * 2 + (c >> 5), rr = r & 15, cc = c & 31, ob = rr * 64 + cc * 2; return st * 1024 + (ob ^ (((ob >> 9) & 1) << 5)); }
__host__ __device__ __forceinline__ void stage_rc(int b, int& R, int& C) { const int st = b / 1024, sb = b % 1024, swz = sb ^ (((sb >> 9) & 1) << 5); R = (st >> 1) * 16 + swz / 64; C = (st & 1) * 32 + (swz % 64) / 2; }
__host__ __device__ __forceinline__ int perm32(int rho) { const int n = rho >> 4, i = rho & 15; return 8 * (i >> 2) + 4 * n + (i & 3); }

__device__ __forceinline__ int lane_id() { int l; asm volatile("v_mbcnt_lo_u32_b32 %0, -1, 0\n\tv_mbcnt_hi_u32_b32 %0, -1, %0" : "=v"(l)); return l; }
struct Unit { int pm, pn, e, rb, cnt; };
struct Gemm { const f16_t* A; const f16_t* Bt; int M, N, K, ld; };

struct StaticOrder {
    int nM, nN, nwg, G, c;
    __host__ __device__ void init(int M, int N, int G_, int c_) { nM = M / BM; nN = N / BM; nwg = nM * nN; G = G_; c = c_; }
    __host__ __device__ bool next(int i, Unit& u) const {
        const long L = (long)i * G + c; if (L >= nwg) return false;
        int wgid = (int)L; { const int q = nwg / NXCD, r = nwg % NXCD, xcd = wgid % NXCD, off = wgid / NXCD; wgid = (xcd < r ? xcd * (q + 1) : r * (q + 1) + (xcd - r) * q) + off; }
        const int nig = WGM * nN, gid = wgid / nig, fm = gid * WGM, gsz = (nM - fm) < WGM ? (nM - fm) : WGM;
        u.pm = fm + ((wgid % nig) % gsz); u.pn = (wgid % nig) / gsz; return true;
    }
    __device__ __forceinline__ void a_ready(const Unit&) const {}
    __device__ __forceinline__ void done(const Unit&) const {}
    __device__ __forceinline__ const char* a_base(const Gemm& g, const Unit& u) const { return (const char*)g.A + (size_t)u.pm * ((size_t)BM * g.ld * 2); }
    __device__ __forceinline__ const char* b_base(const Gemm& g, const Unit& u) const { return (const char*)g.Bt + (size_t)u.pn * ((size_t)BM * g.ld * 2); }
    __device__ __forceinline__ void a_voff(const Gemm& g, const Unit&, int tid, unsigned (&va)[2][2]) const {
#pragma unroll
        for (int i = 0; i < 2; ++i) { int R, C; stage_rc(tid * 16 + i * 8192, R, C); va[0][i] = (unsigned)(R * g.ld + C) * 2u; va[1][i] = va[0][i] + (unsigned)(HALF * g.ld * 2); }
    }
};
struct SplitKOrder {
    int nM, nN, nks, G, c;
    __device__ __forceinline__ bool next(int i, Unit& u) const { const int L = i * G + c; if (L >= nM * nN * nks) return false; u.e = L / (nM * nN); const int rem = L % (nM * nN); u.pn = rem / nM; u.pm = rem % nM; u.rb = 0; u.cnt = 0; return true; }
    __device__ __forceinline__ void a_ready(const Unit&) const {}
    __device__ __forceinline__ void done(const Unit&) const {}
    __device__ __forceinline__ const char* a_base(const Gemm& g, const Unit& u) const { return (const char*)g.A + (size_t)u.pm * ((size_t)BM * g.ld * 2) + (size_t)u.e * g.K * 2; }
    __device__ __forceinline__ const char* b_base(const Gemm& g, const Unit& u) const { return (const char*)g.Bt + (size_t)u.pn * ((size_t)BM * g.ld * 2) + (size_t)u.e * g.K * 2; }
    __device__ __forceinline__ void a_voff(const Gemm& g, const Unit&, int tid, unsigned (&va)[2][2]) const {
#pragma unroll
        for (int i = 0; i < 2; ++i) { int R, C; stage_rc(tid * 16 + i * 8192, R, C); va[0][i] = (unsigned)(R * g.ld + C) * 2u; va[1][i] = va[0][i] + (unsigned)(HALF * g.ld * 2); }
    }
};
template <bool GATHER> struct MoeOrder {
    const PG8_LAS int* tab; const int* list; int vcu, G, ntn; size_t estride; int cls;
    __device__ __forceinline__ bool next(int i, Unit& u) const {
        const int L = vcu + i * G; const int base = cls ? 98 : 65; const int tot = tab[base + 32] * ntn; if (L >= tot) return false;
        int e = 0; while (tab[base + 1 + e] * ntn <= L) ++e;
        const int nbk = tab[base + 1 + e] - tab[base + e], q = L - tab[base + e] * ntn; const int rb = q % nbk + (cls ? 2 : 0);
        u.e = __builtin_amdgcn_readfirstlane(e); u.pn = __builtin_amdgcn_readfirstlane(q / nbk); u.rb = __builtin_amdgcn_readfirstlane(rb);
        u.pm = __builtin_amdgcn_readfirstlane(tab[32 + e] + rb); u.cnt = __builtin_amdgcn_readfirstlane(tab[e]); return true;
    }
    __device__ __forceinline__ void a_ready(const Unit&) const {}
    __device__ __forceinline__ void done(const Unit&) const {}
    __device__ __forceinline__ const char* a_base(const Gemm& g, const Unit& u) const { return GATHER ? (const char*)g.A : (const char*)g.A + (size_t)u.pm * ((size_t)BM * g.ld * 2); }
    __device__ __forceinline__ const char* b_base(const Gemm& g, const Unit& u) const { return (const char*)g.Bt + (size_t)u.e * estride + (size_t)u.pn * ((size_t)BM * g.ld * 2); }
    __device__ __forceinline__ void a_voff(const Gemm& g, const Unit& u, int tid, unsigned (&va)[2][2]) const {
#pragma unroll
        for (int i = 0; i < 2; ++i) { int R, C; stage_rc(tid * 16 + i * 8192, R, C);
            if (GATHER) {
#pragma unroll
                for (int h = 0; h < 2; ++h) { int idx = u.rb * BM + h * HALF + R; idx = idx < u.cnt ? idx : u.cnt - 1; const int tok = list[u.e * 8192 + idx]; va[h][i] = (unsigned)(tok * g.ld + C) * 2u; }
            } else { va[0][i] = (unsigned)(R * g.ld + C) * 2u; va[1][i] = va[0][i] + (unsigned)(HALF * g.ld * 2); } }
    }
};


typedef _Float16 h2_t __attribute__((ext_vector_type(2)));
__device__ __forceinline__ unsigned cvt_pk_f16(float lo, float hi) { h2_t v = {(_Float16)lo, (_Float16)hi}; return __builtin_bit_cast(unsigned, v); }
struct EpiF16 {
    static constexpr bool PERM = true, AFTER_DRAIN = false;
    f16_t* O; int ldc; int ntile0; float scale0;
    __device__ __forceinline__ void operator()(const f32x4 (&acc)[2][2][4][2], const Unit& u, int wr, int wc, int fr, int fq) const {
        const int row0 = u.pm * BM + wr * 64 + fr; const int col0 = u.pn * BM + wc * 32 + 8 * fq;
        const float sc = (u.pn < ntile0) ? scale0 : 1.f;
#pragma unroll
        for (int ai = 0; ai < 2; ++ai)
#pragma unroll
            for (int m = 0; m < 4; ++m) { f16_t* rowp = O + (size_t)(row0 + ai * HALF + m * 16) * ldc + col0;
#pragma unroll
                for (int bj = 0; bj < 2; ++bj) { f32x4 v0 = acc[ai][bj][m][0] * sc, v1 = acc[ai][bj][m][1] * sc;
                    u32x4 w; w.x = cvt_pk_f16(v0[0], v0[1]); w.y = cvt_pk_f16(v0[2], v0[3]); w.z = cvt_pk_f16(v1[0], v1[1]); w.w = cvt_pk_f16(v1[2], v1[3]);
                    *(u32x4*)(rowp + bj * HALF) = w; } }
    }
};


struct EpiSlab {
    static constexpr bool PERM = true, AFTER_DRAIN = false;
    f16_t* O; int ldc; size_t slab;
    __device__ __forceinline__ void operator()(const f32x4 (&acc)[2][2][4][2], const Unit& u, int wr, int wc, int fr, int fq) const {
        const int row0 = u.pm * BM + wr * 64 + fr; const int col0 = u.pn * BM + wc * 32 + 8 * fq; f16_t* Ob = O + (size_t)u.e * slab;
#pragma unroll
        for (int ai = 0; ai < 2; ++ai)
#pragma unroll
            for (int m = 0; m < 4; ++m) { f16_t* rowp = Ob + (size_t)(row0 + ai * HALF + m * 16) * ldc + col0;
#pragma unroll
                for (int bj = 0; bj < 2; ++bj) { const f32x4 v0 = acc[ai][bj][m][0], v1 = acc[ai][bj][m][1];
                    u32x4 w; w.x = cvt_pk_f16(v0[0], v0[1]); w.y = cvt_pk_f16(v0[2], v0[3]); w.z = cvt_pk_f16(v1[0], v1[1]); w.w = cvt_pk_f16(v1[2], v1[3]);
                    *(u32x4*)(rowp + bj * HALF) = w; } }
    }
};
struct EpiResF32 {
    static constexpr bool PERM = false, AFTER_DRAIN = false;
    float* io; int ldc; float alpha;
    __device__ __forceinline__ void operator()(const f32x4 (&acc)[2][2][4][2], const Unit& u, int wr, int wc, int fr, int fq) const {
        const int row0 = u.pm * BM + wr * 64 + fr; const int col0 = u.pn * BM + wc * 32 + 4 * fq;
#pragma unroll
        for (int ai = 0; ai < 2; ++ai)
#pragma unroll
            for (int m = 0; m < 4; ++m) { float* rowp = io + (size_t)(row0 + ai * HALF + m * 16) * ldc + col0;
#pragma unroll
                for (int bj = 0; bj < 2; ++bj)
#pragma unroll
                    for (int n = 0; n < 2; ++n) { f32x4* p = (f32x4*)(rowp + bj * HALF + n * 16); const f32x4 r = *p; *p = r * alpha + acc[ai][bj][m][n]; } }
    }
};
struct EpiResLN {
    static constexpr bool PERM = false, AFTER_DRAIN = false;
    const float* x; float* out; int ldc; float alpha; const float2* st; const float* g; const float* b;
    __device__ __forceinline__ void operator()(const f32x4 (&acc)[2][2][4][2], const Unit& u, int wr, int wc, int fr, int fq) const {
        const int row0 = u.pm * BM + wr * 64 + fr; const int col0 = u.pn * BM + wc * 32 + 4 * fq;
        f32x4 gg[2][2], bb[2][2];
#pragma unroll
        for (int bj = 0; bj < 2; ++bj)
#pragma unroll
            for (int n = 0; n < 2; ++n) { gg[bj][n] = *(const f32x4*)(g + col0 + bj * HALF + n * 16); bb[bj][n] = *(const f32x4*)(b + col0 + bj * HALF + n * 16); }
#pragma unroll
        for (int ai = 0; ai < 2; ++ai)
#pragma unroll
            for (int m = 0; m < 4; ++m) { const int row = row0 + ai * HALF + m * 16; const float2 ms = st[row];
                const float* xp = x + (size_t)row * ldc + col0; float* op = out + (size_t)row * ldc + col0;
#pragma unroll
                for (int bj = 0; bj < 2; ++bj)
#pragma unroll
                    for (int n = 0; n < 2; ++n) { const f32x4 r = *(const f32x4*)(xp + bj * HALF + n * 16);
                        const f32x4 h = (r - ms.x) * ms.y * gg[bj][n] + bb[bj][n]; *(f32x4*)(op + bj * HALF + n * 16) = h * alpha + acc[ai][bj][m][n]; } }
    }
};
struct EpiFinal {
    static constexpr bool PERM = false, AFTER_DRAIN = false;
    float* out; int ldc; const f16_t* h2; const f16_t* pw; const float* rowrs; const float* g;
    __device__ __forceinline__ void operator()(const f32x4 (&acc)[2][2][4][2], const Unit& u, int wr, int wc, int fr, int fq) const {
        typedef _Float16 h4_t __attribute__((ext_vector_type(4)));
        const int row0 = u.pm * BM + wr * 64 + fr; const int col0 = u.pn * BM + wc * 32 + 4 * fq;
#pragma unroll
        for (int ai = 0; ai < 2; ++ai)
#pragma unroll
            for (int m = 0; m < 4; ++m) { const int row = row0 + ai * HALF + m * 16; const size_t off = (size_t)row * ldc + col0;
                const float rs = rowrs[row];
#pragma unroll
                for (int bj = 0; bj < 2; ++bj)
#pragma unroll
                    for (int n = 0; n < 2; ++n) { const h4_t hv = *(const h4_t*)(h2 + off + bj * HALF + n * 16); const h4_t pv = *(const h4_t*)(pw + off + bj * HALF + n * 16);
                        const f32x4 gv = *(const f32x4*)(g + col0 + bj * HALF + n * 16);
                        const f32x4 a = acc[ai][bj][m][n]; f32x4 o;
#pragma unroll
                        for (int c = 0; c < 4; ++c) o[c] = (float)hv[c] + (1.f / (1.f + __expf(-a[c]))) * ((float)pv[c] * rs) * gv[c];
                        *(f32x4*)(out + off + bj * HALF + n * 16) = o; }
                asm volatile("" ::: "memory"); }
    }
};

struct EpiGU {
    static constexpr bool PERM = true, AFTER_DRAIN = false;
    f16_t* O;
    __device__ __forceinline__ void operator()(const f32x4 (&acc)[2][2][4][2], const Unit& u, int wr, int wc, int fr, int fq) const {
        const int row0 = u.pm * BM + wr * 64 + fr; const int col0 = u.pn * HALF + wc * 32 + 8 * fq;
#pragma unroll
        for (int ai = 0; ai < 2; ++ai)
#pragma unroll
            for (int m = 0; m < 4; ++m) { f16_t* rowp = O + (size_t)(row0 + ai * HALF + m * 16) * 512 + col0; float o[8];
#pragma unroll
                for (int n = 0; n < 2; ++n)
#pragma unroll
                    for (int c = 0; c < 4; ++c) { const float gt = acc[ai][0][m][n][c], up = acc[ai][1][m][n][c]; o[n * 4 + c] = gt / (1.f + __expf(-gt)) * up; }
                u32x4 w; w.x = cvt_pk_f16(o[0], o[1]); w.y = cvt_pk_f16(o[2], o[3]); w.z = cvt_pk_f16(o[4], o[5]); w.w = cvt_pk_f16(o[6], o[7]);
                *(u32x4*)rowp = w; }
    }
};
struct EpiDown {
    static constexpr bool PERM = true, AFTER_DRAIN = false;
    f16_t* O; const int* lpair;
    __device__ __forceinline__ void operator()(const f32x4 (&acc)[2][2][4][2], const Unit& u, int wr, int wc, int fr, int fq) const {
        const int r0 = u.rb * BM + wr * 64 + fr; const int col0 = u.pn * BM + wc * 32 + 8 * fq;
#pragma unroll
        for (int ai = 0; ai < 2; ++ai)
#pragma unroll
            for (int m = 0; m < 4; ++m) { const int r = r0 + ai * HALF + m * 16;
                if (r < u.cnt) { const int pair = lpair[u.e * 8192 + r]; f16_t* rowp = O + (size_t)pair * 2048 + col0;
#pragma unroll
                    for (int bj = 0; bj < 2; ++bj) { const f32x4 v0 = acc[ai][bj][m][0], v1 = acc[ai][bj][m][1];
                        u32x4 w; w.x = cvt_pk_f16(v0[0], v0[1]); w.y = cvt_pk_f16(v0[2], v0[3]); w.z = cvt_pk_f16(v1[0], v1[1]); w.w = cvt_pk_f16(v1[2], v1[3]);
                        *(u32x4*)(rowp + bj * HALF) = w; } } }
    }
};
template <class Epi, class Sched, bool ALIGN_EPI = false, bool SP2 = true>
__device__ __forceinline__ void gemm_phase(PG8_LAS unsigned char* lds, const Gemm g, const Sched& S, const Epi& E, const int wid) {
    static_assert(SP2, "only the SP2 K-loop is kept in this file");
    const int lane = lane_id(), tid = wid * 64 + lane, wr = wid >> 2, wc = wid & 3, fr = lane & 15, fq = lane >> 4;
    const int K = g.ld, nt = g.K / BK;
    unsigned voffB[2];
#pragma unroll
    for (int i = 0; i < 2; ++i) { int R, C; stage_rc(tid * 16 + i * 8192, R, C); const int Rb = Epi::PERM ? ((R & ~31) + perm32(R & 31)) : R;
        voffB[i] = (unsigned)(Rb * K + C) * 2u; }
    const size_t kstep = (size_t)(BK * 2);
    const size_t hstep = (size_t)HALF * K * 2;
    const unsigned ldsw = (unsigned)wid * 1024u;
    const int aoff = lds_byte(wr * 64 + fr, fq * 8), boff = lds_byte(wc * 32 + fr, fq * 8);
#define PG8_SA(b, h) (((b) * 2 + (h)) * HTB)
#define PG8_SB(b, h) ((4 + (b) * 2 + (h)) * HTB)
#define PG8_STAGE(bufoff, gbase, voff) do { _Pragma("unroll") for (int _i = 0; _i < 2; ++_i) \
        __builtin_amdgcn_global_load_lds((const unsigned*)((const char*)(gbase) + (voff)[_i]), (PG8_LAS unsigned*)(lds + (bufoff) + ldsw + _i * 8192), 16, 0, 0); } while (0)
#define PG8_LDA(dst, b, h) do { _Pragma("unroll") for (int m = 0; m < 4; ++m) _Pragma("unroll") for (int k = 0; k < 2; ++k) dst[m][k] = *(const PG8_LAS f16x8*)(lds + PG8_SA(b, h) + aoff + m * 2048 + k * 1024); } while (0)
#define PG8_LDB(dst, b, h) do { _Pragma("unroll") for (int n = 0; n < 2; ++n) _Pragma("unroll") for (int k = 0; k < 2; ++k) dst[n][k] = *(const PG8_LAS f16x8*)(lds + PG8_SB(b, h) + boff + n * 2048 + k * 1024); } while (0)
#define PG8_MMA(ai, bj, At, Bt) do { __builtin_amdgcn_s_setprio(1); _Pragma("unroll") for (int m = 0; m < 4; ++m) _Pragma("unroll") for (int n = 0; n < 2; ++n) _Pragma("unroll") for (int k = 0; k < 2; ++k) \
        acc[ai][bj][m][n] = __builtin_amdgcn_mfma_f32_16x16x32_f16(Bt[n][k], At[m][k], acc[ai][bj][m][n], 0, 0, 0); __builtin_amdgcn_s_setprio(0); } while (0)
#define PG8_WAIT_V(n) asm volatile("s_waitcnt vmcnt(" #n ")" ::: "memory")
#define PG8_WAIT_L(n) asm volatile("s_waitcnt lgkmcnt(" #n ")" ::: "memory")
#define PG8_BAR __builtin_amdgcn_s_barrier()
#define PG8_SCHED __builtin_amdgcn_sched_barrier(0)
    Unit cur, nxt; int ui = 0;
    if (!S.next(0, cur)) return;
    f32x4 acc[2][2][4][2];
#pragma unroll
    for (int a = 0; a < 2; ++a)
#pragma unroll
        for (int b = 0; b < 2; ++b)
#pragma unroll
            for (int m = 0; m < 4; ++m)
#pragma unroll
                for (int n = 0; n < 2; ++n) acc[a][b][m][n] = (f32x4){0.f, 0.f, 0.f, 0.f};
    f16x8 At[4][2], B0[2][2], B1[2][2];
    const char* cA = S.a_base(g, cur); const char* cB = S.b_base(g, cur);
    unsigned vaC[2][2];
    S.a_voff(g, cur, tid, vaC);
    S.a_ready(cur);
    PG8_STAGE(PG8_SB(0, 0), cB, voffB); PG8_STAGE(PG8_SB(0, 1), cB + hstep, voffB); PG8_STAGE(PG8_SA(0, 0), cA, vaC[0]); PG8_STAGE(PG8_SA(0, 1), cA, vaC[1]);
    if (wr == 1) PG8_BAR;
    PG8_WAIT_V(2); PG8_BAR;
    PG8_STAGE(PG8_SB(1, 0), cB + kstep, voffB); PG8_STAGE(PG8_SA(1, 0), cA + kstep, vaC[0]); PG8_STAGE(PG8_SB(1, 1), cB + hstep + kstep, voffB);
    PG8_WAIT_V(6); PG8_BAR;
    for (;;) {
        const bool has_next = S.next(ui + 1, nxt);
        const char* nA = has_next ? S.a_base(g, nxt) : cA; const char* nB = has_next ? S.b_base(g, nxt) : cB;
        for (int t = 0; t < nt; t += 2) {
            const bool last = (t == nt - 2);

            const char* a1 = cA + (size_t)(t + 1) * kstep;
            const char* a2 = last ? nA : cA + (size_t)(t + 2) * kstep; const char* b2 = last ? nB : cB + (size_t)(t + 2) * kstep;
            const char* a3 = a2 + kstep; const char* b3 = b2 + kstep;
            if (last && has_next) S.a_ready(nxt);
            PG8_LDB(B0, 0, 0); PG8_LDB(B1, 0, 1); PG8_SCHED; PG8_LDA(At, 0, 0); PG8_STAGE(PG8_SA(1, 1), a1, vaC[1]);
            if (last && has_next) S.a_voff(g, nxt, wid * 64 + lane_id(), vaC);
            PG8_WAIT_V(8); PG8_WAIT_L(0); PG8_BAR; PG8_MMA(0, 0, At, B0); PG8_MMA(0, 1, At, B1); PG8_BAR; PG8_SCHED;
            PG8_LDA(At, 0, 1); PG8_STAGE(PG8_SB(0, 0), b2, voffB); PG8_STAGE(PG8_SB(0, 1), b2 + hstep, voffB); PG8_STAGE(PG8_SA(0, 0), a2, vaC[0]);
            PG8_WAIT_V(8); PG8_WAIT_L(0); PG8_BAR; PG8_MMA(1, 0, At, B0); PG8_MMA(1, 1, At, B1); PG8_BAR; PG8_SCHED;
            PG8_LDB(B0, 1, 0); PG8_LDB(B1, 1, 1); PG8_SCHED; PG8_LDA(At, 1, 0); PG8_STAGE(PG8_SA(0, 1), a2, vaC[1]);
            PG8_WAIT_V(8); PG8_WAIT_L(0); PG8_BAR; PG8_MMA(0, 0, At, B0); PG8_MMA(0, 1, At, B1); PG8_BAR; PG8_SCHED;
            PG8_LDA(At, 1, 1); PG8_STAGE(PG8_SB(1, 0), b3, voffB); PG8_STAGE(PG8_SB(1, 1), b3 + hstep, voffB); PG8_STAGE(PG8_SA(1, 0), a3, vaC[0]);
            PG8_WAIT_V(8); PG8_WAIT_L(0); PG8_BAR; PG8_MMA(1, 0, At, B0); PG8_MMA(1, 1, At, B1); PG8_BAR; PG8_SCHED;
        }
        if constexpr (ALIGN_EPI) { if (wr == 0) PG8_BAR; }
        { const int l2 = lane_id(); E(acc, cur, wr, wc, l2 & 15, l2 >> 4); } S.done(cur);
        if (!has_next) break;
#pragma unroll
        for (int a = 0; a < 2; ++a)
#pragma unroll
            for (int b = 0; b < 2; ++b)
#pragma unroll
                for (int m = 0; m < 4; ++m)
#pragma unroll
                    for (int n = 0; n < 2; ++n) acc[a][b][m][n] = (f32x4){0.f, 0.f, 0.f, 0.f};
        cur = nxt; cA = nA; cB = nB; ++ui;
        if constexpr (ALIGN_EPI) { if (wr == 1) PG8_BAR; }
    }
    PG8_WAIT_V(0);
    if constexpr (!ALIGN_EPI) { if (wr == 0) PG8_BAR; }
    PG8_BAR;
#undef PG8_SA
#undef PG8_SB
#undef PG8_STAGE
#undef PG8_LDA
#undef PG8_LDB
#undef PG8_MMA
#undef PG8_WAIT_V
#undef PG8_WAIT_L
#undef PG8_BAR
#undef PG8_SCHED
}
}

constexpr int PN = 6656;
namespace att {
#define ALAS __attribute__((address_space(3)))
typedef _Float16 f16x8 __attribute__((ext_vector_type(8)));
typedef float f32x16 __attribute__((ext_vector_type(16)));
typedef short v4i16_t __attribute__((ext_vector_type(4)));
typedef unsigned u32x4 __attribute__((ext_vector_type(4)));
constexpr int SLOT = 16384, L_K = 0, L_V = 3 * SLOT, L_SCR = 6 * SLOT, L_TAB = L_SCR + 2048, L_END = L_TAB + 1024;
constexpr int L_XB = 0, L_STG = 65536;
constexpr float LOG2E = 1.4426950408889634f;
constexpr float C2 = 0.125f * LOG2E;
__device__ __forceinline__ int crow(int r, int hi) { return (r & 3) + 8 * (r >> 2) + 4 * hi; }
__device__ __forceinline__ void glds16(const void* g, ALAS unsigned char* l) { __builtin_amdgcn_global_load_lds((const unsigned*)g, (ALAS unsigned*)l, 16, 0, 0); }
__device__ __forceinline__ float xhalf(float v, int hi) { auto rr = __builtin_amdgcn_permlane32_swap(__float_as_uint(v), __float_as_uint(v), false, false); return hi ? __uint_as_float(rr[0]) : __uint_as_float(rr[1]); }
__device__ __forceinline__ unsigned pkh(float lo, float hi) { typedef _Float16 h2 __attribute__((ext_vector_type(2))); h2 v = {(_Float16)lo, (_Float16)hi}; return __builtin_bit_cast(unsigned, v); }
__device__ __forceinline__ v4i16_t vtr(const ALAS unsigned char* p) { return __builtin_amdgcn_ds_read_tr16_b64_v4i16((ALAS v4i16_t*)p); }

typedef int vfrag_t __attribute__((ext_vector_type(2)));
#define VFRAG vfrag_t
template <int OFF> __device__ __forceinline__ void vtr_asm(vfrag_t& r, unsigned a) { asm volatile("ds_read_b64_tr_b16 %0, %1 offset:%2" : "=v"(r) : "v"(a), "n"(OFF) : "memory"); }
#define VLOAD(vb, d) do { vtr_asm<(d) * 4096 + 0>(vb[0], vsa); vtr_asm<(d) * 4096 + 512>(vb[1], vsa); vtr_asm<(d) * 4096 + 1024>(vb[2], vsa); vtr_asm<(d) * 4096 + 1536>(vb[3], vsa); \
        vtr_asm<(d) * 4096 + 2048>(vb[4], vsa); vtr_asm<(d) * 4096 + 2560>(vb[5], vsa); vtr_asm<(d) * 4096 + 3072>(vb[6], vsa); vtr_asm<(d) * 4096 + 3584>(vb[7], vsa); } while (0)
#define VWAIT(n, vb) asm volatile("s_waitcnt lgkmcnt(" #n ")" : "+v"(vb[0]), "+v"(vb[1]), "+v"(vb[2]), "+v"(vb[3]), "+v"(vb[4]), "+v"(vb[5]), "+v"(vb[6]), "+v"(vb[7]) :: "memory")
#define VMUL(d, vb) do { _Pragma("unroll") for (int s_ = 0; s_ < 4; ++s_) { typedef int i32x4_ __attribute__((ext_vector_type(4))); \
        const i32x4_ bv_ = {vb[2 * s_][0], vb[2 * s_][1], vb[2 * s_ + 1][0], vb[2 * s_ + 1][1]}; \
        o[d] = __builtin_amdgcn_mfma_f32_32x32x16_f16(__builtin_bit_cast(f16x8, pw[s_]), __builtin_bit_cast(f16x8, bv_), o[d], 0, 0, 0); } } while (0)
template <int THR>
__device__ __forceinline__ void attn_unit(ALAS unsigned char* lds, const int wave, const int b, const int h, const int qb, const unsigned short* PROJ, unsigned short* Y,
                                          const float* biasG, const float lam, const float* subln_g) {
    const int lane = pg8::lane_id(), r32 = lane & 31, hi = lane >> 5;
    const int c = wave >> 2, w4 = wave & 3;
    const int q0 = qb * 128, qw0 = q0 + 32 * w4, q = qw0 + r32;
    const size_t rowbase = (size_t)b * S;
    { ALAS float* tabL = (ALAS float*)(lds + L_TAB); const int tid = wave * 64 + lane; if (tid < 129) tabL[tid] = biasG[tid] * LOG2E; }
    f16x8 qf[4];
    { const unsigned short* Qp = PROJ + (rowbase + q) * PN + h * 128 + c * 64 + hi * 8;
#pragma unroll
      for (int d0 = 0; d0 < 4; ++d0) qf[d0] = *(const f16x8*)(Qp + d0 * 16); }
    const int krow0 = 8 * wave + (lane >> 4), krow1 = krow0 + 4;
    const unsigned short* ksrc0 = PROJ + (rowbase + krow0) * PN + 1024 + h * 128 + (((lane & 15) ^ (krow0 & 15)) * 8);
    const unsigned short* ksrc1 = PROJ + (rowbase + krow1) * PN + 1024 + h * 128 + (((lane & 15) ^ (krow1 & 15)) * 8);
    const unsigned short* vsrc0 = PROJ + (rowbase + 16 * ((2 * wave) & 3) + (lane >> 2)) * PN + 2048 + h * 128 + 32 * ((2 * wave) >> 2) + (lane & 3) * 8;
    ALAS unsigned char* kdst = lds + L_K + (2 * wave) * 1024; ALAS unsigned char* vdst = lds + L_V + (2 * wave) * 1024;
#define ATT_ISSUE(t, slot) do { const size_t go_ = (size_t)(t) * 64 * PN; \
        glds16(ksrc0 + go_, kdst + (slot) * SLOT); glds16(ksrc1 + go_, kdst + (slot) * SLOT + 1024); \
        glds16(vsrc0 + go_, vdst + (slot) * SLOT); glds16(vsrc0 + go_ + (size_t)16 * PN, vdst + (slot) * SLOT + 1024); } while (0)
    const int NT = (q0 + 128) / 64;
    ATT_ISSUE(0, 0); ATT_ISSUE(1, 1);
    ALAS float* wsf = (ALAS float*)(lds + L_SCR) + wave * 64;
    const ALAS float* tabL = (const ALAS float*)(lds + L_TAB);
    const float bfar = biasG[128] * LOG2E;
    float mhat = 0.f, l = 0.f;
    f32x16 o[4];
#pragma unroll
    for (int d = 0; d < 4; ++d)
#pragma unroll
        for (int r = 0; r < 16; ++r) o[d][r] = 0.f;
    f32x16 negm;
#pragma unroll
    for (int r = 0; r < 16; ++r) negm[r] = bfar;
    int slot = 0;
    for (int t = 0; t < NT; ++t) {
        if (t + 1 < NT) asm volatile("s_waitcnt vmcnt(4)" ::: "memory"); else asm volatile("s_waitcnt vmcnt(0)" ::: "memory");
        __builtin_amdgcn_s_barrier();
        asm volatile("" ::: "memory");
        if (t + 2 < NT) { const int s2 = slot == 0 ? 2 : slot - 1; ATT_ISSUE(t + 2, s2); }
        const int k0 = t * 64;
        if (k0 <= qw0 + 31) {
            const ALAS unsigned char* Ks = lds + L_K + slot * SLOT + r32 * 256;
            const int kx = r32 & 15, kc0 = 8 * c + hi;
            const int ko[4] = {((kc0 + 0) ^ kx) << 4, ((kc0 + 2) ^ kx) << 4, ((kc0 + 4) ^ kx) << 4, ((kc0 + 6) ^ kx) << 4};
            const unsigned vsa = (unsigned)(__UINTPTR_TYPE__)(lds + L_V + slot * SLOT + (4 * hi + ((lane & 15) >> 2)) * 64 + ((lane >> 4) & 1) * 32 + (lane & 3) * 8);
            f16x8 ka[8];
#pragma unroll
            for (int d0 = 0; d0 < 4; ++d0) { ka[2 * d0] = *(const ALAS f16x8*)(Ks + ko[d0]); ka[2 * d0 + 1] = *(const ALAS f16x8*)(Ks + ko[d0] + 8192); }
            f32x16 p0, p1;
            const bool nearb = (k0 + 63 + 128 > qw0);
            if (nearb) {
                f32x16 c0, c1;
#pragma unroll
                for (int r = 0; r < 16; ++r) { int rel = q - (k0 + crow(r, hi)); int i0 = rel < 0 ? 0 : (rel > 128 ? 128 : rel); int rel1 = rel - 32; int i1 = rel1 < 0 ? 0 : (rel1 > 128 ? 128 : rel1);
                    c0[r] = tabL[i0] - mhat; c1[r] = tabL[i1] - mhat; }
#pragma unroll
                for (int d0 = 0; d0 < 4; ++d0) {
                    p0 = __builtin_amdgcn_mfma_f32_32x32x16_f16(ka[2 * d0], qf[d0], d0 == 0 ? c0 : p0, 0, 0, 0); p1 = __builtin_amdgcn_mfma_f32_32x32x16_f16(ka[2 * d0 + 1], qf[d0], d0 == 0 ? c1 : p1, 0, 0, 0); }
                if (k0 + 63 > qw0) {
#pragma unroll
                    for (int r = 0; r < 16; ++r) { const int kv = k0 + crow(r, hi); if (kv > q) p0[r] = -INFINITY; if (kv + 32 > q) p1[r] = -INFINITY; }
                }
            } else {
#pragma unroll
                for (int d0 = 0; d0 < 4; ++d0) {
                    p0 = __builtin_amdgcn_mfma_f32_32x32x16_f16(ka[2 * d0], qf[d0], d0 == 0 ? negm : p0, 0, 0, 0); p1 = __builtin_amdgcn_mfma_f32_32x32x16_f16(ka[2 * d0 + 1], qf[d0], d0 == 0 ? negm : p1, 0, 0, 0); }
            }
            VFRAG vb0[8], vb1[8];
            VLOAD(vb0, 0);
            float rm = fmaxf(p0[0], p1[0]);
#pragma unroll
            for (int r = 1; r < 16; ++r) rm = fmaxf(rm, fmaxf(p0[r], p1[r]));
            rm = fmaxf(rm, xhalf(rm, hi));
            const bool first = (t == 0);
            if (first || __any(rm > (float)THR)) {
                const float dl = first ? rm : fmaxf(rm, 0.f);
                mhat += dl;
#pragma unroll
                for (int r = 0; r < 16; ++r) { p0[r] -= dl; p1[r] -= dl; }
#pragma unroll
                for (int r = 0; r < 16; ++r) negm[r] = bfar - mhat;
                if (!first) {
                    const float f = __builtin_amdgcn_exp2f(-dl); l *= f;
                    if (hi == 0) wsf[r32] = f;
                    asm volatile("s_waitcnt lgkmcnt(0)" ::: "memory");
#pragma unroll
                    for (int r = 0; r < 16; ++r) { const float fr_ = wsf[crow(r, hi)];
#pragma unroll
                        for (int d = 0; d < 4; ++d) o[d][r] *= fr_; }
                }
            }
            float sacc = 0.f;
#pragma unroll
            for (int r = 0; r < 16; ++r) { p0[r] = __builtin_amdgcn_exp2f(p0[r]); p1[r] = __builtin_amdgcn_exp2f(p1[r]); sacc += p0[r] + p1[r]; }
            l += sacc;
            u32x4 pw[4];
#pragma unroll
            for (int s = 0; s < 2; ++s) {
                pw[s] = (u32x4){pkh(p0[8 * s], p0[8 * s + 1]), pkh(p0[8 * s + 2], p0[8 * s + 3]), pkh(p0[8 * s + 4], p0[8 * s + 5]), pkh(p0[8 * s + 6], p0[8 * s + 7])};
                pw[2 + s] = (u32x4){pkh(p1[8 * s], p1[8 * s + 1]), pkh(p1[8 * s + 2], p1[8 * s + 3]), pkh(p1[8 * s + 4], p1[8 * s + 5]), pkh(p1[8 * s + 6], p1[8 * s + 7])};
            }
            VLOAD(vb1, 1); VWAIT(8, vb0); VMUL(0, vb0);
            VLOAD(vb0, 2); VWAIT(8, vb1); VMUL(1, vb1);
            VLOAD(vb1, 3); VWAIT(8, vb0); VMUL(2, vb0);
            VWAIT(0, vb1); VMUL(3, vb1);
        }
        slot = slot == 2 ? 0 : slot + 1;
    }
#undef ATT_ISSUE
    l += xhalf(l, hi);
    if (hi == 0) wsf[r32] = 1.0f / l;
    asm volatile("s_waitcnt lgkmcnt(0)" ::: "memory");
#pragma unroll
    for (int r = 0; r < 16; ++r) { const float f = wsf[crow(r, hi)];
#pragma unroll
        for (int d = 0; d < 4; ++d) o[d][r] *= f; }
    asm volatile("s_waitcnt lgkmcnt(0)" ::: "memory"); __builtin_amdgcn_s_barrier(); asm volatile("" ::: "memory");
    ALAS float* xb = (ALAS float*)(lds + L_XB) + w4 * 4096 + lane;
    if (c == 1) {
#pragma unroll
        for (int d = 0; d < 4; ++d)
#pragma unroll
            for (int r = 0; r < 16; ++r) xb[(d * 16 + r) * 64] = o[d][r];
    }
    asm volatile("s_waitcnt lgkmcnt(0)" ::: "memory"); __builtin_amdgcn_s_barrier(); asm volatile("" ::: "memory");
    if (c == 0) {
        float sc[16];
#pragma unroll
        for (int r = 0; r < 16; ++r) { float ss = 0.f;
#pragma unroll
            for (int d = 0; d < 4; ++d) { o[d][r] -= lam * xb[(d * 16 + r) * 64]; ss += o[d][r] * o[d][r]; }
            ss += __shfl_xor(ss, 1); ss += __shfl_xor(ss, 2); ss += __shfl_xor(ss, 4); ss += __shfl_xor(ss, 8); ss += __shfl_xor(ss, 16);
            sc[r] = __builtin_amdgcn_rsqf(ss * (1.f / 128.f) + LN_EPS) * (1.f - LAMBDA_INIT); }
        ALAS _Float16* stg = (ALAS _Float16*)(lds + L_STG + w4 * 8192);
#pragma unroll
        for (int d = 0; d < 4; ++d) { const float gg = subln_g[32 * d + r32];
#pragma unroll
            for (int r = 0; r < 16; ++r) stg[crow(r, hi) * 128 + 32 * d + r32] = (_Float16)(o[d][r] * sc[r] * gg); }
        asm volatile("s_waitcnt lgkmcnt(0)" ::: "memory");
        unsigned short* Yw = Y + (rowbase + qw0) * D + h * 128;
#pragma unroll
        for (int i = 0; i < 8; ++i) { const int row = i * 4 + (lane >> 4), ch = lane & 15; const u32x4 v = *(const ALAS u32x4*)((const ALAS unsigned char*)stg + row * 256 + ch * 16);
            *(u32x4*)(Yw + (size_t)row * D + ch * 8) = v; }
    }
    asm volatile("s_waitcnt lgkmcnt(0)" ::: "memory"); __builtin_amdgcn_s_barrier(); asm volatile("" ::: "memory");
}
#undef ALAS
}

namespace rk {
#define RLAS __attribute__((address_space(3)))
#define RGAS __attribute__((address_space(1)))
typedef __bf16 bf16x8 __attribute__((ext_vector_type(8)));
typedef _Float16 f16x8 __attribute__((ext_vector_type(8)));
typedef float f32x16 __attribute__((ext_vector_type(16)));
typedef float f32x4 __attribute__((ext_vector_type(4)));
typedef unsigned u32x4 __attribute__((ext_vector_type(4)));
typedef unsigned short us8 __attribute__((ext_vector_type(8)));
constexpr int C = 32;
constexpr int TS = 144, CS = 80;
constexpr int O_AT = 0, O_RT = 4608, O_BT = 9216, O_KT = 13824;
constexpr int O_AAB = 0, O_AAK = 4608, O_ARB = 7168, O_ARK = 9728;
constexpr int O_PIMG = 0, O_QIMG = 8192;
constexpr int O_VT = 18432, O_KH = 23552, O_BH = 28672;
constexpr int O_X0 = 33792;
constexpr int O_RH = 50688;
constexpr int O_GAM = 55296;
constexpr int HALF_BYTES = 57344;
constexpr int CHK_BYTES = 24576, CK_P = 0, CK_Q = 8192, CK_G = 12288, CK_Y = 20480;
__device__ __forceinline__ int crow(int r, int hi) { return (r & 3) + 8 * (r >> 2) + 4 * hi; }
__device__ __forceinline__ unsigned pkb(float lo, float hi) { typedef float f2 __attribute__((ext_vector_type(2))); typedef __bf16 b2 __attribute__((ext_vector_type(2))); f2 v = {lo, hi}; b2 w = __builtin_convertvector(v, b2); return __builtin_bit_cast(unsigned, w); }
__device__ __forceinline__ unsigned pkh(float lo, float hi) { typedef _Float16 h2 __attribute__((ext_vector_type(2))); h2 v = {(_Float16)lo, (_Float16)hi}; return __builtin_bit_cast(unsigned, v); }
__device__ __forceinline__ float h2f(unsigned short u) { return (float)__builtin_bit_cast(_Float16, u); }
__device__ __forceinline__ unsigned short f2h(float f) { return __builtin_bit_cast(unsigned short, (_Float16)f); }
__device__ __forceinline__ float sum8(float x) {
    x += __builtin_bit_cast(float, __builtin_amdgcn_update_dpp(0, __builtin_bit_cast(int, x), 0xB1, 0xF, 0xF, true));
    x += __builtin_bit_cast(float, __builtin_amdgcn_update_dpp(0, __builtin_bit_cast(int, x), 0x4E, 0xF, 0xF, true));
    x += __builtin_bit_cast(float, __builtin_amdgcn_update_dpp(0, __builtin_bit_cast(int, x), 0x141, 0xF, 0xF, true));
    return x;
}
__device__ __forceinline__ int frag_pos(int m, int c) { return (((c >> 4) * 64 + m + 32 * ((c >> 2) & 1)) * 8) + ((c >> 3) & 1) * 4 + (c & 3); }

struct ChunkIn { f32x4 l0, l1; us8 a8, b8, k8, rc, rp, vc, vp; };
__device__ __forceinline__ void chunk_load(ChunkIn& in, int tglob, int pos, int chb, const unsigned char* ws) {
    const unsigned short* PROJ16 = (const unsigned short*)(ws + WS_PROJ16); const float* LW = (const float*)(ws + WS_DECAY); const unsigned short* KMOD = (const unsigned short*)(ws + WS_KMOD);
    const unsigned short* A16 = (const unsigned short*)(ws + WS_A16); const unsigned short* B16 = (const unsigned short*)(ws + WS_B16);
    in.l0 = *(const RGAS f32x4*)(LW + (size_t)tglob * RWK + chb); in.l1 = *(const RGAS f32x4*)(LW + (size_t)tglob * RWK + chb + 4);
    in.a8 = *(const RGAS us8*)(A16 + (size_t)tglob * RWK + chb); in.b8 = *(const RGAS us8*)(B16 + (size_t)tglob * RWK + chb); in.k8 = *(const RGAS us8*)(KMOD + (size_t)tglob * RWK + chb);
    const unsigned short* cur = PROJ16 + (size_t)tglob * PN + 3072 + chb;
    in.rc = *(const RGAS us8*)cur; in.vc = *(const RGAS us8*)(cur + 2048); in.rp = in.rc; in.vp = in.vc; if (pos > 0) { in.rp = *(const RGAS us8*)(cur - PN); in.vp = *(const RGAS us8*)(cur - PN + 2048); }
}
__device__ __forceinline__ void chunk_pair(RLAS unsigned char* lds, const int wave, const int tile, const int hA, ChunkIn& in, const bool has_next, const float* mu, const float* r_k, unsigned char* ws) {
    unsigned char* CHK = ws + WS_CHK; float* BONUS = (float*)(ws + WS_BONUS);
    const int lane = pg8::lane_id(), hf = wave >> 2, q = wave & 3, r32 = lane & 31, hi = lane >> 5;
    const int h = hA + hf;
    RLAS unsigned char* L = lds + hf * HALF_BYTES;
    const int t = q * 64 + lane;
    const int tok = t >> 3, c8 = (t & 7) * 8;
    const int tglob = tile * C + tok, pos = tglob & (S - 1), bidx = tglob >> 11;
    const int chb = h * 64 + c8;
    float lw[8], av[8], bv[8], kv[8], rv[8], vv[8];
    { lw[0] = in.l0.x; lw[1] = in.l0.y; lw[2] = in.l0.z; lw[3] = in.l0.w; lw[4] = in.l1.x; lw[5] = in.l1.y; lw[6] = in.l1.z; lw[7] = in.l1.w;
      const f32x4 m0 = *(const RGAS f32x4*)(mu + chb), m1 = *(const RGAS f32x4*)(mu + chb + 4), n0 = *(const RGAS f32x4*)(mu + 2048 + chb), n1 = *(const RGAS f32x4*)(mu + 2048 + chb + 4);
      const float mr[8] = {m0.x, m0.y, m0.z, m0.w, m1.x, m1.y, m1.z, m1.w}, mv[8] = {n0.x, n0.y, n0.z, n0.w, n1.x, n1.y, n1.z, n1.w};
#pragma unroll
      for (int i = 0; i < 8; ++i) { av[i] = h2f(in.a8[i]); bv[i] = h2f(in.b8[i]); kv[i] = h2f(in.k8[i]);
          const float rcf = h2f(in.rc[i]), rpf = pos > 0 ? h2f(in.rp[i]) : 0.f, vcf = h2f(in.vc[i]), vpf = pos > 0 ? h2f(in.vp[i]) : 0.f;
          rv[i] = rcf + (rpf - rcf) * mr[i]; vv[i] = vcf + (vpf - vcf) * mv[i]; } }
    { const f32x4 k0 = *(const RGAS f32x4*)(r_k + chb), k1 = *(const RGAS f32x4*)(r_k + chb + 4); const float rk8[8] = {k0.x, k0.y, k0.z, k0.w, k1.x, k1.y, k1.z, k1.w};
      float bs = 0.f;
#pragma unroll
      for (int i = 0; i < 8; ++i) bs += rv[i] * kv[i] * rk8[i];
      bs = sum8(bs); if ((t & 7) == 0) BONUS[(size_t)tglob * 16 + h] = bs; }
    RLAS float* lwL = (RLAS float*)(L + O_X0 + 64 * 132);
    __syncthreads();
#pragma unroll
    for (int i = 0; i < 8; ++i) lwL[tok * 65 + c8 + i] = lw[i];
    __syncthreads();
    { RLAS float* part = (RLAS float*)(L + O_GAM) + 64;
      const int ch = t & 63, seg = t >> 6; float sg = 0.f;
#pragma unroll
      for (int k = 0; k < 8; ++k) sg += lwL[(8 * seg + k) * 65 + ch];
      part[seg * 64 + ch] = sg;
      __syncthreads();
      float g = 0.f;
#pragma unroll
      for (int s2 = 0; s2 < 3; ++s2) if (s2 < seg) g += part[s2 * 64 + ch];
#pragma unroll
      for (int k = 0; k < 8; ++k) { g += lwL[(8 * seg + k) * 65 + ch]; lwL[(8 * seg + k) * 65 + ch] = g; } }
    __syncthreads();
    {
        float G[8], GL[8];
#pragma unroll
        for (int i = 0; i < 8; ++i) { G[i] = lwL[tok * 65 + c8 + i]; GL[i] = lwL[31 * 65 + c8 + i]; }
        float at[8], rt[8], bt[8], kt[8], bh[8], kh[8];
#pragma unroll
        for (int i = 0; i < 8; ++i) { const float eg = __expf(G[i]), eng = __expf(-G[i]), egm = __expf(G[i] - lw[i]), egl = __expf(GL[i] - G[i]);
            at[i] = av[i] * egm; rt[i] = rv[i] * eg; bt[i] = bv[i] * eng; kt[i] = kv[i] * eng; bh[i] = bv[i] * egl; kh[i] = kv[i] * egl; }
        *(RLAS u32x4*)(L + O_AT + tok * TS + c8 * 2) = (u32x4){pkb(at[0], at[1]), pkb(at[2], at[3]), pkb(at[4], at[5]), pkb(at[6], at[7])};
        *(RLAS u32x4*)(L + O_RT + tok * TS + c8 * 2) = (u32x4){pkb(rt[0], rt[1]), pkb(rt[2], rt[3]), pkb(rt[4], rt[5]), pkb(rt[6], rt[7])};
        *(RLAS u32x4*)(L + O_BT + tok * TS + c8 * 2) = (u32x4){pkb(bt[0], bt[1]), pkb(bt[2], bt[3]), pkb(bt[4], bt[5]), pkb(bt[6], bt[7])};
        *(RLAS u32x4*)(L + O_KT + tok * TS + c8 * 2) = (u32x4){pkb(kt[0], kt[1]), pkb(kt[2], kt[3]), pkb(kt[4], kt[5]), pkb(kt[6], kt[7])};
        *(RLAS u32x4*)(L + O_RH + tok * TS + c8 * 2) = (u32x4){pkh(rt[0], rt[1]), pkh(rt[2], rt[3]), pkh(rt[4], rt[5]), pkh(rt[6], rt[7])};
#pragma unroll
        for (int i = 0; i < 8; ++i) { const int ch = c8 + i;
            *(RLAS unsigned short*)(L + O_VT + ch * CS + tok * 2) = f2h(vv[i]); *(RLAS unsigned short*)(L + O_KH + ch * CS + tok * 2) = f2h(kh[i]); *(RLAS unsigned short*)(L + O_BH + ch * CS + tok * 2) = f2h(bh[i]);
            ((RLAS float*)(L + O_X0))[ch * 33 + tok] = at[i];
            if (tok == C - 1) ((RLAS float*)(L + O_GAM))[ch] = __expf(GL[i]); }
    }
    __syncthreads();
    {
        const RLAS unsigned char* Lp = L + (q < 2 ? O_AT : O_RT) + r32 * TS + hi * 16; const RLAS unsigned char* Rp = L + ((q & 1) ? O_KT : O_BT) + r32 * TS + hi * 16;
        f32x16 acc;
#pragma unroll
        for (int r = 0; r < 16; ++r) acc[r] = 0.f;
#pragma unroll
        for (int ks = 0; ks < 4; ++ks) acc = __builtin_amdgcn_mfma_f32_32x32x16_bf16(*(const RLAS bf16x8*)(Lp + ks * 32), *(const RLAS bf16x8*)(Rp + ks * 32), acc, 0, 0, 0);
#pragma unroll
        for (int r = 0; r < 16; ++r) { const int tau = crow(r, hi); const bool keep = (q < 2) ? (r32 < tau) : (r32 <= tau); acc[r] = keep ? acc[r] : 0.f; }
        __syncthreads();
        if (q == 0) {
#pragma unroll
            for (int r = 0; r < 16; ++r) ((RLAS float*)(L + O_AAB))[r32 * 36 + crow(r, hi)] = acc[r];
        } else {
            RLAS unsigned char* o = L + (q == 1 ? O_AAK : (q == 2 ? O_ARB : O_ARK));
#pragma unroll
            for (int r = 0; r < 16; ++r) *(RLAS unsigned short*)(o + crow(r, hi) * CS + r32 * 2) = f2h(acc[r]);
        }
    }
    __syncthreads();
    const int J = q & 1, part = q >> 1;
    if (part == 1) {
        f32x16 accX;
#pragma unroll
        for (int r = 0; r < 16; ++r) accX[r] = 0.f;
        const RLAS unsigned char* Vp = L + O_VT + (32 * J + r32) * CS + hi * 16; const RLAS unsigned char* Ap = L + O_AAK + r32 * CS + hi * 16;
#pragma unroll
        for (int ks = 0; ks < 2; ++ks) accX = __builtin_amdgcn_mfma_f32_32x32x16_f16(*(const RLAS f16x8*)(Ap + ks * 32), *(const RLAS f16x8*)(Vp + ks * 32), accX, 0, 0, 0);
#pragma unroll
        for (int r = 0; r < 16; ++r) ((RLAS float*)(L + O_X0))[(64 + 32 * J + r32) * 33 + crow(r, hi)] = accX[r];
    }
    __syncthreads();
    float z[C];
    if (q < 2) {
        const RLAS float* xc = (const RLAS float*)(L + O_X0) + (64 * q + lane) * 33;
#pragma unroll
        for (int k = 0; k < C; ++k) z[k] = xc[k];
    }
    __syncthreads();
    if (q < 2) {
        const RLAS float* AabT = (const RLAS float*)(L + O_AAB);
#pragma unroll
        for (int sx = 0; sx < C - 1; ++sx) {
            const float zs = z[sx];
#pragma unroll
            for (int t4 = (sx + 1) / 4; t4 < C / 4; ++t4) { const f32x4 aa = *(const RLAS f32x4*)(AabT + sx * 36 + 4 * t4);
                if (4 * t4 + 0 > sx) z[4 * t4 + 0] = fmaf(aa.x, zs, z[4 * t4 + 0]); if (4 * t4 + 1 > sx) z[4 * t4 + 1] = fmaf(aa.y, zs, z[4 * t4 + 1]);
                if (4 * t4 + 2 > sx) z[4 * t4 + 2] = fmaf(aa.z, zs, z[4 * t4 + 2]); if (4 * t4 + 3 > sx) z[4 * t4 + 3] = fmaf(aa.w, zs, z[4 * t4 + 3]); }
        }
        RLAS unsigned char* zr = L + O_X0 + (64 * q + lane) * CS;
#pragma unroll
        for (int k8 = 0; k8 < 4; ++k8) *(RLAS u32x4*)(zr + k8 * 16) = (u32x4){pkh(z[8 * k8], z[8 * k8 + 1]), pkh(z[8 * k8 + 2], z[8 * k8 + 3]), pkh(z[8 * k8 + 4], z[8 * k8 + 5]), pkh(z[8 * k8 + 6], z[8 * k8 + 7])};
    }
    __syncthreads();
    f32x16 accQ, accP, accA, accB;
#pragma unroll
    for (int r = 0; r < 16; ++r) { accA[r] = 0.f; accB[r] = 0.f; }
    {
        const RLAS unsigned char* Vp = L + O_VT + (32 * J + r32) * CS + hi * 16;
        const RLAS unsigned char* Kp = L + O_KH + (32 * part + r32) * CS + hi * 16;
        const RLAS unsigned char* Ap = L + O_ARK + r32 * CS + hi * 16;
#pragma unroll
        for (int ks = 0; ks < 2; ++ks) { const f16x8 vf = *(const RLAS f16x8*)(Vp + ks * 32);
            if (part == 0) accA = __builtin_amdgcn_mfma_f32_32x32x16_f16(*(const RLAS f16x8*)(Ap + ks * 32), vf, accA, 0, 0, 0);
            accB = __builtin_amdgcn_mfma_f32_32x32x16_f16(*(const RLAS f16x8*)(Kp + ks * 32), vf, accB, 0, 0, 0); }
    }
    {
        const RLAS float* gam = (const RLAS float*)(L + O_GAM);
#pragma unroll
        for (int r = 0; r < 16; ++r) { const int m = crow(r, hi);
            accQ[r] = h2f(*(const RLAS unsigned short*)(L + O_RH + m * TS + (32 * J + r32) * 2));
            accP[r] = (J == part && m == r32) ? gam[32 * J + r32] : 0.f; }
        const RLAS unsigned char* Zw = L + O_X0 + (32 * J + r32) * CS + hi * 16; const RLAS unsigned char* Zu = Zw + 64 * CS;
        const RLAS unsigned char* Bp = L + O_BH + (32 * part + r32) * CS + hi * 16; const RLAS unsigned char* Rb = L + O_ARB + r32 * CS + hi * 16;
#pragma unroll
        for (int ks = 0; ks < 2; ++ks) { const f16x8 zw = *(const RLAS f16x8*)(Zw + ks * 32), zu = *(const RLAS f16x8*)(Zu + ks * 32), bf = *(const RLAS f16x8*)(Bp + ks * 32);
            accP = __builtin_amdgcn_mfma_f32_32x32x16_f16(bf, zw, accP, 0, 0, 0);
            accB = __builtin_amdgcn_mfma_f32_32x32x16_f16(bf, zu, accB, 0, 0, 0);
            if (part == 0) { const f16x8 rb = *(const RLAS f16x8*)(Rb + ks * 32);
                accQ = __builtin_amdgcn_mfma_f32_32x32x16_f16(rb, zw, accQ, 0, 0, 0);
                accA = __builtin_amdgcn_mfma_f32_32x32x16_f16(rb, zu, accA, 0, 0, 0); } }
    }
    __syncthreads();
    { int tg2 = tglob, cb2 = has_next ? chb + 128 : chb; asm volatile("" : "+v"(tg2), "+v"(cb2)); chunk_load(in, tg2, pos, cb2, ws); }
    unsigned char* rec = CHK + ((size_t)((bidx * 16 + h) * (S / C)) + (size_t)(pos >> 5)) * CHK_BYTES;
    { u32x4 w0, w1; w0 = (u32x4){pkh(accB[0], accB[1]), pkh(accB[2], accB[3]), pkh(accB[4], accB[5]), pkh(accB[6], accB[7])}; w1 = (u32x4){pkh(accB[8], accB[9]), pkh(accB[10], accB[11]), pkh(accB[12], accB[13]), pkh(accB[14], accB[15])};
      RGAS u32x4* g = (RGAS u32x4*)(rec + CK_G + ((part * 2 + J) * 64 + lane) * 32); g[0] = w0; g[1] = w1;
      if (part == 0) { w0 = (u32x4){pkh(accA[0], accA[1]), pkh(accA[2], accA[3]), pkh(accA[4], accA[5]), pkh(accA[6], accA[7])}; w1 = (u32x4){pkh(accA[8], accA[9]), pkh(accA[10], accA[11]), pkh(accA[12], accA[13]), pkh(accA[14], accA[15])};
          RGAS u32x4* y = (RGAS u32x4*)(rec + CK_Y + (J * 64 + lane) * 32); y[0] = w0; y[1] = w1; } }
    {
        RLAS unsigned short* pimg = (RLAS unsigned short*)(L + O_PIMG) + ((part * 2 + J) * 2) * 512;
        RLAS unsigned short* qimg = (RLAS unsigned short*)(L + O_QIMG) + (J * 2) * 512;
#pragma unroll
        for (int r = 0; r < 16; ++r) { const int fp = frag_pos(crow(r, hi), r32); pimg[fp] = f2h(accP[r]); if (part == 0) qimg[fp] = f2h(accQ[r]); }
    }
    __syncthreads();
    { const RLAS u32x4* src = (const RLAS u32x4*)(L + O_PIMG); RGAS u32x4* dst = (RGAS u32x4*)(rec + CK_P);
#pragma unroll
      for (int i = 0; i < 3; ++i) dst[i * 256 + t] = src[i * 256 + t]; }
}

__device__ __forceinline__ void scan_unit(RLAS unsigned char* lds, const int wave, const int bh, const unsigned char* CHK, const float* BONUS, const unsigned short* PROJ16, const float* mu,
                                          const unsigned short* G16, const float* lnx_g, const float* lnx_b, unsigned short* Y16) {
    const int lane = pg8::lane_id(), r32 = lane & 31, hi = lane >> 5;
    const int b = bh >> 4, h = bh & 15;
    RLAS float* ytile = (RLAS float*)lds;
    constexpr int RING0 = 18432, NSL = 4;
    const unsigned char* rec0 = CHK + (size_t)bh * (S / C) * CHK_BYTES;
    constexpr int NCH = S / C;
    __syncthreads();
    if (wave >= 6) {
        const int p0 = (wave - 6) * 12;
#define RK_DMA(c) do { const unsigned char* src_ = rec0 + (size_t)(c) * CHK_BYTES + p0 * 1024 + lane * 16; RLAS unsigned char* dst_ = lds + RING0 + ((c) & (NSL - 1)) * CHK_BYTES + p0 * 1024; \
            _Pragma("unroll") for (int j_ = 0; j_ < 12; ++j_) __builtin_amdgcn_global_load_lds((const unsigned*)(src_ + j_ * 1024), (RLAS unsigned*)(dst_ + j_ * 1024), 16, 0, 0); } while (0)
        RK_DMA(0); RK_DMA(1); RK_DMA(2);
        for (int c = 0; c <= NCH; ++c) {
            if (c + 2 < NCH) asm volatile("s_waitcnt vmcnt(24)" ::: "memory"); else if (c + 1 < NCH) asm volatile("s_waitcnt vmcnt(12)" ::: "memory"); else asm volatile("s_waitcnt vmcnt(0)" ::: "memory");
            __builtin_amdgcn_s_barrier(); asm volatile("" ::: "memory");
            if (c + 3 < NCH) RK_DMA(c + 3);
        }
#undef RK_DMA
    } else if (wave < 2) {
        const int J = wave;
        f32x16 H0, H1;
#pragma unroll
        for (int r = 0; r < 16; ++r) { H0[r] = 0.f; H1[r] = 0.f; }
        for (int c = 0; c <= NCH; ++c) {
            asm volatile("s_waitcnt lgkmcnt(0)" ::: "memory"); __builtin_amdgcn_s_barrier(); asm volatile("" ::: "memory");
            if (c == NCH) break;
            const RLAS unsigned char* rec = lds + RING0 + (c & (NSL - 1)) * CHK_BYTES;
            u32x4 hb[4];
            hb[0] = (u32x4){pkh(H0[0], H0[1]), pkh(H0[2], H0[3]), pkh(H0[4], H0[5]), pkh(H0[6], H0[7])}; hb[1] = (u32x4){pkh(H0[8], H0[9]), pkh(H0[10], H0[11]), pkh(H0[12], H0[13]), pkh(H0[14], H0[15])};
            hb[2] = (u32x4){pkh(H1[0], H1[1]), pkh(H1[2], H1[3]), pkh(H1[4], H1[5]), pkh(H1[6], H1[7])}; hb[3] = (u32x4){pkh(H1[8], H1[9]), pkh(H1[10], H1[11]), pkh(H1[12], H1[13]), pkh(H1[14], H1[15])};
            f32x16 y, n0, n1;
#define RK_UNPK(dst, w0, w1) do { const f16x8 a_ = __builtin_bit_cast(f16x8, w0), b_ = __builtin_bit_cast(f16x8, w1); \
            _Pragma("unroll") for (int i_ = 0; i_ < 8; ++i_) { dst[i_] = (float)a_[i_]; dst[8 + i_] = (float)b_[i_]; } } while (0)
            { const u32x4 y0 = *(const RLAS u32x4*)(rec + CK_Y + (J * 64 + lane) * 32), y1 = *(const RLAS u32x4*)(rec + CK_Y + (J * 64 + lane) * 32 + 16); RK_UNPK(y, y0, y1);
              const u32x4 g0 = *(const RLAS u32x4*)(rec + CK_G + (J * 64 + lane) * 32), g1 = *(const RLAS u32x4*)(rec + CK_G + (J * 64 + lane) * 32 + 16); RK_UNPK(n0, g0, g1);
              const u32x4 g2 = *(const RLAS u32x4*)(rec + CK_G + ((2 + J) * 64 + lane) * 32), g3 = *(const RLAS u32x4*)(rec + CK_G + ((2 + J) * 64 + lane) * 32 + 16); RK_UNPK(n1, g2, g3); }
#pragma unroll
            for (int ks = 0; ks < 4; ++ks) {
                const f16x8 hf = __builtin_bit_cast(f16x8, hb[ks]);
                y = __builtin_amdgcn_mfma_f32_32x32x16_f16(*(const RLAS f16x8*)(rec + CK_Q + (ks * 64 + lane) * 16), hf, y, 0, 0, 0);
                n0 = __builtin_amdgcn_mfma_f32_32x32x16_f16(*(const RLAS f16x8*)(rec + CK_P + (ks * 64 + lane) * 16), hf, n0, 0, 0, 0);
                n1 = __builtin_amdgcn_mfma_f32_32x32x16_f16(*(const RLAS f16x8*)(rec + CK_P + ((4 + ks) * 64 + lane) * 16), hf, n1, 0, 0, 0);
            }
#undef RK_UNPK
            H0 = n0; H1 = n1;
            RLAS float* yt = ytile + (c & 1) * (32 * 68);
#pragma unroll
            for (int r = 0; r < 16; ++r) yt[crow(r, hi) * 68 + 32 * J + r32] = y[r];
        }
    } else {
        const int p = wave - 2, v8 = (lane & 7) * 8, trow = 8 * p + (lane >> 3);
        float lg[8], lb[8], mv[8];
#pragma unroll
        for (int i = 0; i < 8; ++i) { lg[i] = lnx_g[h * 64 + v8 + i]; lb[i] = lnx_b[h * 64 + v8 + i]; mv[i] = mu[2048 + h * 64 + v8 + i]; }
        struct PSlot { float bon; us8 vc, vp, g8; };
        PSlot ps[4];
#define RK_PLOAD(SL, cc_) do { const int pos_ = (cc_) * C + trow; const size_t tok_ = (size_t)b * S + pos_; ps[SL].bon = BONUS[tok_ * 16 + h]; \
            const unsigned short* cur_ = PROJ16 + tok_ * PN + 5120 + h * 64 + v8; ps[SL].vc = *(const RGAS us8*)cur_; ps[SL].vp = ps[SL].vc; if (pos_ > 0) ps[SL].vp = *(const RGAS us8*)(cur_ - PN); \
            ps[SL].g8 = *(const RGAS us8*)(G16 + tok_ * RWK + h * 64 + v8); } while (0)
#define RK_PSTEP(SL, cc_) do { \
            asm volatile("s_waitcnt lgkmcnt(0)" ::: "memory"); __builtin_amdgcn_s_barrier(); asm volatile("" ::: "memory"); \
            if ((cc_) >= 0) { const int cc = (cc_); \
                const float bon = ps[SL].bon; const us8 vc = ps[SL].vc, vp = ps[SL].vp, g8 = ps[SL].g8; \
                if (cc + 4 < NCH) RK_PLOAD(SL, cc + 4); \
                const RLAS float* yt = ytile + (cc & 1) * (32 * 68) + trow * 68 + v8; \
                const f32x4 ya = *(const RLAS f32x4*)yt, yb = *(const RLAS f32x4*)(yt + 4); \
                float yv[8] = {ya.x, ya.y, ya.z, ya.w, yb.x, yb.y, yb.z, yb.w}; \
                float sm = 0.f; \
                _Pragma("unroll") for (int i = 0; i < 8; ++i) sm += yv[i]; \
                const float mean = sum8(sm) * (1.f / 64.f); float sq = 0.f; \
                _Pragma("unroll") for (int i = 0; i < 8; ++i) { yv[i] -= mean; sq += yv[i] * yv[i]; } \
                const float rstd = __builtin_amdgcn_rsqf(sum8(sq) * (1.f / 64.f) + 64e-5f); \
                const int pos = cc * C + trow; const size_t tok = (size_t)b * S + pos; \
                float o[8]; \
                _Pragma("unroll") for (int i = 0; i < 8; ++i) { const float vcf = h2f(vc[i]), vpf = pos > 0 ? h2f(vp[i]) : 0.f; const float vx = vcf + (vpf - vcf) * mv[i]; \
                    o[i] = (yv[i] * rstd * lg[i] + lb[i] + bon * vx) * h2f(g8[i]); } \
                *(RGAS u32x4*)(Y16 + tok * D + 1024 + h * 64 + v8) = (u32x4){pkh(o[0], o[1]), pkh(o[2], o[3]), pkh(o[4], o[5]), pkh(o[6], o[7])}; } } while (0)
        RK_PLOAD(0, 0); RK_PLOAD(1, 1); RK_PLOAD(2, 2); RK_PLOAD(3, 3);
        for (int cb = 0; cb < NCH; cb += 4) {
            RK_PSTEP(3, cb - 1); RK_PSTEP(0, cb); RK_PSTEP(1, cb + 1); RK_PSTEP(2, cb + 2);
        }
        RK_PSTEP(3, NCH - 1);
#undef RK_PSTEP
#undef RK_PLOAD
    }
    __syncthreads();
}
#undef RLAS
#undef RGAS
}

constexpr int NWAVES = 8;
constexpr int RING_OFF = 0, RING_BYTES = 131072;
constexpr int LDSCTL_OFF = RING_BYTES, MISC_OFF = LDSCTL_OFF + 320;
constexpr int LDS_BYTES = 147456;
#define GAS __attribute__((address_space(1)))
#define LAS __attribute__((address_space(3)))
typedef unsigned v4u __attribute__((ext_vector_type(4)));
typedef float f32x4 __attribute__((ext_vector_type(4)));
typedef GAS unsigned gu32;
#define RLX_AGENT __ATOMIC_RELAXED, __HIP_MEMORY_SCOPE_AGENT
#define LDS_WAIT() asm volatile("s_waitcnt lgkmcnt(0)" ::: "memory")
#define VM_WAIT() asm volatile("s_waitcnt vmcnt(0)" ::: "memory")
constexpr int CW_CONVQ = 65;
constexpr int CW_ATTQ = 64;
constexpr int CW_BAR = 4096;
constexpr size_t CTL_ZERO_BYTES = 64 * 1024;

#define XB_TMO      128
#define XB_XCNT(j)  (256  + 64 * (j))
#define XB_XSUB(j)  (1280 + 64 * (j))
#define XB_XGEN(j)  (2304 + 64 * (j))
#define XB_TOP      3328
#define XB_TOPGEN   3392
#define XCD_BAR_WORDS 3456
#define XB_SPIN_CAP (1u << 18)

__device__ __forceinline__ unsigned xb_ld(unsigned* p)              { return __hip_atomic_load(p, __ATOMIC_RELAXED, __HIP_MEMORY_SCOPE_AGENT); }
__device__ __forceinline__ unsigned xb_add(unsigned* p, unsigned v) { return __hip_atomic_fetch_add(p, v, __ATOMIC_RELAXED, __HIP_MEMORY_SCOPE_AGENT); }
__device__ __forceinline__ unsigned xb_xcc_id() { return (unsigned)__builtin_amdgcn_s_getreg((3 << 11) | 20) & 0xFu; }
#define XB_SPIN(cond, bar) do { unsigned _sp = 0; while (cond) { __builtin_amdgcn_s_sleep(1); \
    if ((++_sp & 255u) == 0u) { if (xb_ld(&(bar)[XB_TMO])) break; if (_sp > XB_SPIN_CAP) { atomicAdd(&(bar)[XB_TMO], 1u); break; } } } } while (0)

struct XcdBarrier {
    unsigned* bar; unsigned x; bool w0;
    volatile LAS unsigned* st;
};

__device__ __forceinline__ XcdBarrier xcd_barrier_post(unsigned* bar, volatile LAS unsigned* st) {
    XcdBarrier b; b.bar = bar; b.x = xb_xcc_id(); b.st = st; b.w0 = (__builtin_amdgcn_readfirstlane(threadIdx.x >> 6) == 0);
    if (__builtin_amdgcn_readfirstlane(threadIdx.x >> 6) == 0 && pg8::lane_id() == 0) (void)xb_add(&bar[XB_XCNT(b.x)], 1u);
    return b;
}
__device__ __forceinline__ void xcd_barrier_complete(unsigned* bar, unsigned x, unsigned& nloc, unsigned& nx) {
    const unsigned G = gridDim.x * gridDim.y * gridDim.z;
    unsigned sum, cnt, mine, sp = 0u;
    for (;;) {
        sum = 0u; cnt = 0u; mine = 0u;
#pragma unroll
        for (unsigned j = 0; j < 16; ++j) { const unsigned c = xb_ld(&bar[XB_XCNT(j)]); sum += c; cnt += (c > 0u) ? 1u : 0u; mine = (j == x) ? c : mine; }
        if (sum == G) break;
        __builtin_amdgcn_s_sleep(1);
        if ((++sp & 255u) == 0u) { if (xb_ld(&bar[XB_TMO])) break; if (sp > XB_SPIN_CAP) { atomicAdd(&bar[XB_TMO], 1u); break; } }
    }
    nloc = mine > 0u ? mine : 1u; nx = cnt > 0u ? cnt : 1u;
}

__device__ __forceinline__ void xcd_barrier(const XcdBarrier& b) {
    asm volatile("s_waitcnt vmcnt(0)" ::: "memory");
    __syncthreads();
    if (b.w0 && pg8::lane_id() == 0) {
        unsigned* bar = b.bar;
        __builtin_amdgcn_s_waitcnt(0);
        unsigned nloc = b.st[0], nx = b.st[1];
        if (nloc == 0u) { xcd_barrier_complete(bar, b.x, nloc, nx); b.st[0] = nloc; b.st[1] = nx; }
        const unsigned old = xb_add(&bar[XB_XSUB(b.x)], 1u);
        const unsigned gen = old / nloc;
        if (old + 1u == (gen + 1u) * nloc) {
            __builtin_amdgcn_fence(__ATOMIC_RELEASE, "agent");
            asm volatile("s_waitcnt vmcnt(0)" ::: "memory");
            const unsigned og = xb_add(&bar[XB_TOP], 1u);
            const unsigned tg = og / nx;
            if (og + 1u == (tg + 1u) * nx) xb_add(&bar[XB_TOPGEN], 1u);
            else XB_SPIN(xb_ld(&bar[XB_TOPGEN]) == tg, bar);
            __builtin_amdgcn_fence(__ATOMIC_ACQUIRE, "agent");
            xb_add(&bar[XB_XGEN(b.x)], 1u);
            asm volatile("s_waitcnt vmcnt(0)" ::: "memory");
        } else {
            XB_SPIN(xb_ld(&bar[XB_XGEN(b.x)]) == gen, bar);
            __builtin_amdgcn_fence(__ATOMIC_ACQUIRE, "agent");
            asm volatile("s_waitcnt vmcnt(0)" ::: "memory");
        }
    }
    __syncthreads();
}


typedef unsigned short f16_t;
typedef _Float16 h2v __attribute__((ext_vector_type(2)));
__device__ __forceinline__ unsigned pk2h(float lo, float hi) { h2v v = {(_Float16)lo, (_Float16)hi}; return __builtin_bit_cast(unsigned, v); }

struct Frame {
    LAS unsigned char* lds; volatile LAS unsigned* MISC; gu32* ctl;
    int wave, vcu, G;
};
#define FTID (F.wave * 64 + pg8::lane_id())
#define FLANE (pg8::lane_id())
__device__ __forceinline__ void p0_transpose_item(const float* W, int K, int N, f16_t* WT, int row_off, LAS float* scr, int item, int lane) {
    const int nblk = N / 32, kb = item / nblk, nb = item % nblk, k0 = 64 * kb, n0 = 32 * nb;
#pragma unroll 8
    for (int i = 0; i < 32; ++i) { const int kk = 2 * i + (lane >> 5); scr[kk * 33 + (lane & 31)] = W[(size_t)(k0 + kk) * N + n0 + (lane & 31)]; }
    LDS_WAIT(); asm volatile("" ::: "memory");
    const int c = lane & 7;
#pragma unroll
    for (int j = 0; j < 4; ++j) { const int n = (lane >> 3) + 8 * j; const LAS float* s = scr + (8 * c) * 33 + n;
        v4u o; o.x = pk2h(s[0 * 33], s[1 * 33]); o.y = pk2h(s[2 * 33], s[3 * 33]); o.z = pk2h(s[4 * 33], s[5 * 33]); o.w = pk2h(s[6 * 33], s[7 * 33]);
        *(GAS v4u*)(WT + (size_t)(row_off + n0 + n) * K + k0 + 8 * c) = o; }
    LDS_WAIT(); asm volatile("" ::: "memory");
}
#ifndef TP_LD
#define TP_LD(p) (*(p))
#endif
struct TpDesc { const float* W; f16_t* WT; int K, N, row_off, item; };
__device__ __forceinline__ void tp_load(float (&r)[32], const TpDesc& d, int lane) {
    const int nblk = d.N / 32, kb = d.item / nblk, nb = d.item % nblk, k0 = 64 * kb, n0 = 32 * nb;
#pragma unroll
    for (int i = 0; i < 32; ++i) r[i] = TP_LD(d.W + (size_t)(k0 + 2 * i + (lane >> 5)) * d.N + n0 + (lane & 31));
}
__device__ __forceinline__ void tp_emit(const TpDesc& d, LAS float* scr, int lane) {
    const int nblk = d.N / 32, kb = d.item / nblk, nb = d.item % nblk, k0 = 64 * kb, n0 = 32 * nb, c = lane & 7;
#pragma unroll
    for (int j = 0; j < 4; ++j) { const int n = (lane >> 3) + 8 * j; const LAS float* sp = scr + (8 * c) * 33 + n;
        v4u o; o.x = pk2h(sp[0 * 33], sp[1 * 33]); o.y = pk2h(sp[2 * 33], sp[3 * 33]); o.z = pk2h(sp[4 * 33], sp[5 * 33]); o.w = pk2h(sp[6 * 33], sp[7 * 33]);
        *(GAS v4u*)(d.WT + (size_t)(d.row_off + n0 + n) * d.K + k0 + 8 * c) = o; }
}
template <class MK> __device__ __forceinline__ void tp_stream(int first, int n, int stride, MK mk, LAS float* scr, int lane) {
    if (first >= n) return;
    float r[32]; int it = first; TpDesc d = mk(it); tp_load(r, d, lane);
    for (;;) {
#pragma unroll
        for (int i = 0; i < 32; ++i) scr[(2 * i + (lane >> 5)) * 33 + (lane & 31)] = r[i];
        LDS_WAIT(); asm volatile("" ::: "memory");
        const int nit = it + stride; const bool more = nit < n; TpDesc dn = d;
        if (more) { dn = mk(nit); tp_load(r, dn, lane); }
        tp_emit(d, scr, lane);
        LDS_WAIT(); asm volatile("" ::: "memory");
        if (!more) break;
        it = nit; d = dn;
    }
}
#ifndef TPD_AUX
#define TPD_AUX 2
#endif
__device__ __forceinline__ void tpd_load(const TpDesc& d, LAS unsigned char* buf, int lane) {
    const int nblk = d.N / 32, kb = d.item / nblk, nb = d.item % nblk, k0 = 64 * kb, n0 = 32 * nb;
    const float* src = d.W + (size_t)(k0 + (lane >> 3)) * d.N + n0;
#pragma unroll
    for (int j = 0; j < 8; ++j) __builtin_amdgcn_global_load_lds((const unsigned*)(src + (size_t)(8 * j) * d.N + 4 * ((lane & 7) ^ j)), (LAS unsigned*)(buf + j * 1024), 16, 0, TPD_AUX);
}
__device__ __forceinline__ void tpd_emit(const TpDesc& d, const LAS unsigned char* buf, int lane) {
    const int nblk = d.N / 32, kb = d.item / nblk, nb = d.item % nblk, k0 = 64 * kb, n0 = 32 * nb, c = lane & 7;
#pragma unroll
    for (int j = 0; j < 4; ++j) { const int n = (lane >> 3) + 8 * j; const LAS float* sp = (const LAS float*)(buf + (8 * c) * 128 + (((n >> 2) ^ c) * 16) + (n & 3) * 4);
        v4u o; o.x = pk2h(sp[0 * 32], sp[1 * 32]); o.y = pk2h(sp[2 * 32], sp[3 * 32]); o.z = pk2h(sp[4 * 32], sp[5 * 32]); o.w = pk2h(sp[6 * 32], sp[7 * 32]);
        __builtin_nontemporal_store(o, (GAS v4u*)(d.WT + (size_t)(d.row_off + n0 + n) * d.K + k0 + 8 * c)); }
}
template <class MK> __device__ __forceinline__ void tpd_stream(int first, int n, int stride, MK mk, LAS unsigned char* buf, int lane) {
    if (first >= n) return;
    TpDesc cur = mk(first); tpd_load(cur, buf, lane);
    int inx = first + stride; bool has_nx = inx < n; TpDesc nx = cur; if (has_nx) { nx = mk(inx); tpd_load(nx, buf + 8192, lane); }
    unsigned cb = 0; bool first_it = true;
    for (;;) {
        if (first_it) { if (has_nx) asm volatile("s_waitcnt vmcnt(8)" ::: "memory"); else asm volatile("s_waitcnt vmcnt(0)" ::: "memory"); }
        else { if (has_nx) asm volatile("s_waitcnt vmcnt(12)" ::: "memory"); else asm volatile("s_waitcnt vmcnt(4)" ::: "memory"); }
        tpd_emit(cur, buf + cb, lane);
        LDS_WAIT(); asm volatile("" ::: "memory");
        if (!has_nx) break;
        const int inn = inx + stride; const bool has_nn = inn < n; TpDesc nn = nx;
        if (has_nn) { nn = mk(inn); tpd_load(nn, buf + cb, lane); }
        cur = nx; nx = nn; inx = inn; has_nx = has_nn; cb ^= 8192u; first_it = false;
    }
}
__device__ __forceinline__ float wave_sum_b(float v) {
#pragma unroll
    for (int o = 1; o < 64; o <<= 1) v += __shfl_xor(v, o);
    return v;
}
__device__ __forceinline__ void ln_row_dual(int lane, const float* xrow, const float* g, const float* b, float* o32, f16_t* o16) {
    const GAS f32x4* xr = (const GAS f32x4*)xrow + lane;
    f32x4 v[8]; float s = 0.f;
#pragma unroll
    for (int j = 0; j < 8; ++j) { v[j] = xr[64 * j]; s += (v[j].x + v[j].y) + (v[j].z + v[j].w); }
    const float mean = wave_sum_b(s) * (1.f / D); float s2 = 0.f;
#pragma unroll
    for (int j = 0; j < 8; ++j) { v[j] = v[j] - mean; s2 += (v[j].x * v[j].x + v[j].y * v[j].y) + (v[j].z * v[j].z + v[j].w * v[j].w); }
    const float rstd = __builtin_amdgcn_rsqf(wave_sum_b(s2) * (1.f / D) + LN_EPS);
    const GAS f32x4* g4 = (const GAS f32x4*)g + lane; const GAS f32x4* b4 = (const GAS f32x4*)b + lane;
    GAS f32x4* o4 = (GAS f32x4*)o32 + lane; GAS unsigned long long* o8 = (GAS unsigned long long*)o16 + lane;
#pragma unroll
    for (int j = 0; j < 8; ++j) { const f32x4 o = v[j] * rstd * g4[64 * j] + b4[64 * j]; o4[64 * j] = o;
        o8[64 * j] = (unsigned long long)pk2h(o.x, o.y) | ((unsigned long long)pk2h(o.z, o.w) << 32); }
}


__device__ __forceinline__ void ln_row_f16(int lane, const float* xrow, const float* g, const float* b, f16_t* o16, float2* st) {
    const GAS f32x4* xr = (const GAS f32x4*)xrow + lane;
    f32x4 v[8]; float s = 0.f;
#pragma unroll
    for (int j = 0; j < 8; ++j) { v[j] = xr[64 * j]; s += (v[j].x + v[j].y) + (v[j].z + v[j].w); }
    const float mean = wave_sum_b(s) * (1.f / D); float s2 = 0.f;
#pragma unroll
    for (int j = 0; j < 8; ++j) { v[j] = v[j] - mean; s2 += (v[j].x * v[j].x + v[j].y * v[j].y) + (v[j].z * v[j].z + v[j].w * v[j].w); }
    const float rstd = __builtin_amdgcn_rsqf(wave_sum_b(s2) * (1.f / D) + LN_EPS);
    const GAS f32x4* g4 = (const GAS f32x4*)g + lane; const GAS f32x4* b4 = (const GAS f32x4*)b + lane;
    GAS unsigned long long* o8 = (GAS unsigned long long*)o16 + lane;
#pragma unroll
    for (int j = 0; j < 8; ++j) { const f32x4 o = v[j] * rstd * g4[64 * j] + b4[64 * j];
        o8[64 * j] = (unsigned long long)pk2h(o.x, o.y) | ((unsigned long long)pk2h(o.z, o.w) << 32); }
    if (lane == 0) *st = make_float2(mean, rstd);
}

__device__ __forceinline__ void p0_transpose_item_gu(const float* W, int K, int N, f16_t* WT, int gu_s, LAS float* scr, int item, int lane) {
    const int nblk = N / 32, nb = item % nblk; const int row_off = gu_s < 0 ? 0 : 128 * (nb >> 2) + 128 * gu_s;
    p0_transpose_item(W, K, N, WT, row_off, scr, item, lane);
}
__device__ __forceinline__ void ln_norm(int lane, f32x4 (&v)[8], const float* g, const float* b) {
    float s = 0.f;
#pragma unroll
    for (int j = 0; j < 8; ++j) s += (v[j].x + v[j].y) + (v[j].z + v[j].w);
    const float mean = wave_sum_b(s) * (1.f / D); float s2 = 0.f;
#pragma unroll
    for (int j = 0; j < 8; ++j) { v[j] = v[j] - mean; s2 += (v[j].x * v[j].x + v[j].y * v[j].y) + (v[j].z * v[j].z + v[j].w * v[j].w); }
    const float rstd = __builtin_amdgcn_rsqf(wave_sum_b(s2) * (1.f / D) + LN_EPS);
    const GAS f32x4* g4 = (const GAS f32x4*)g + lane; const GAS f32x4* b4 = (const GAS f32x4*)b + lane;
#pragma unroll
    for (int j = 0; j < 8; ++j) v[j] = v[j] * rstd * g4[64 * j] + b4[64 * j];
}
__device__ __forceinline__ void ln_store(int lane, const f32x4 (&v)[8], float* o32, f16_t* o16) {
    GAS f32x4* o4 = (GAS f32x4*)o32 + lane; GAS unsigned long long* o8 = (GAS unsigned long long*)o16 + lane;
#pragma unroll
    for (int j = 0; j < 8; ++j) { o4[64 * j] = v[j]; o8[64 * j] = (unsigned long long)pk2h(v[j].x, v[j].y) | ((unsigned long long)pk2h(v[j].z, v[j].w) << 32); }
}
__device__ __forceinline__ void ln_store16(int lane, const f32x4 (&v)[8], f16_t* o16) {
    GAS unsigned long long* o8 = (GAS unsigned long long*)o16 + lane;
#pragma unroll
    for (int j = 0; j < 8; ++j) o8[64 * j] = (unsigned long long)pk2h(v[j].x, v[j].y) | ((unsigned long long)pk2h(v[j].z, v[j].w) << 32);
}
__device__ __forceinline__ void ln_regs(int lane, f32x4 (&v)[8], const float* g, const float* b, float* o32, f16_t* o16) { ln_norm(lane, v, g, b); ln_store(lane, v, o32, o16); }
__device__ __forceinline__ void rt_stage(const float* src, LAS unsigned char* dst, int wave, int lane) {
#pragma unroll
    for (int i = 0; i < 6; ++i) __builtin_amdgcn_global_load_lds((const unsigned*)(src + 4 * (wave * 64 + lane + 512 * i)), (LAS unsigned*)(dst + (wave * 64 + 512 * i) * 16), 16, 0, 0);
}
__device__ __forceinline__ void route_pick(const float (&acc)[36], const float* gb, const float* eb, int& ea, int& ebb, float& wa, float& wb) {
    float gl[4]; float gm = -3.0e38f; int gi = 0;
#pragma unroll
    for (int i = 0; i < 4; ++i) { gl[i] = acc[i] + gb[i]; if (gl[i] > gm) { gm = gl[i]; gi = i; } }
    float gs = 0.f;
#pragma unroll
    for (int i = 0; i < 4; ++i) gs += __expf(gl[i] - gm);
    const float gtop = 1.f / gs;
    float el[8]; float em = -3.0e38f; int e0 = 0;
#pragma unroll
    for (int i = 0; i < 8; ++i) { float v = 0.f;
#pragma unroll
        for (int g = 0; g < 4; ++g) if (g == gi) v = acc[4 + g * 8 + i] + eb[g * 8 + i];
        el[i] = v; if (v > em) { em = v; e0 = i; } }
    float em2 = -3.0e38f; int e1 = 0;
#pragma unroll
    for (int i = 0; i < 8; ++i) if (i != e0 && el[i] > em2) { em2 = el[i]; e1 = i; }
    const float x1 = __expf(em2 - em);
    const float w0 = 1.f / (1.f + x1), w1 = x1 / (1.f + x1);
    ea = gi * 8 + e0; ebb = gi * 8 + e1; wa = w0 * gtop; wb = w1 * gtop;
}
constexpr int TAB_OFF = LDSCTL_OFF + 1024;
__device__ __forceinline__ void build_moe_table(Frame& F, const int* cnt) {
    LAS int* tab = (LAS int*)(F.lds + TAB_OFF);
    const int tid = FTID;
    if (tid < 32) tab[tid] = __hip_atomic_load(cnt + tid * CNT_STRIDE, __ATOMIC_RELAXED, __HIP_MEMORY_SCOPE_AGENT);
    __syncthreads();
    if (tid == 0) { int p = 0, pa = 0, pb = 0; for (int e = 0; e < 32; ++e) { const int nb = (tab[e] + 255) >> 8, na = nb < 2 ? nb : 2;
            tab[32 + e] = p; tab[65 + e] = pa; tab[98 + e] = pb; p += nb; pa += na; pb += nb - na; } tab[64] = p; tab[97] = pa; tab[130] = pb; }
    __syncthreads();
}

__device__ __forceinline__ float sum8_dpp(float x) {
    x += __builtin_bit_cast(float, __builtin_amdgcn_update_dpp(0, __builtin_bit_cast(int, x), 0xB1, 0xF, 0xF, true));
    x += __builtin_bit_cast(float, __builtin_amdgcn_update_dpp(0, __builtin_bit_cast(int, x), 0x4E, 0xF, 0xF, true));
    x += __builtin_bit_cast(float, __builtin_amdgcn_update_dpp(0, __builtin_bit_cast(int, x), 0x141, 0xF, 0xF, true));
    return x;
}
__device__ __forceinline__ float h2f(unsigned short u) { return (float)__builtin_bit_cast(_Float16, u); }
__device__ __forceinline__ float sum32_x(float x) {
    x += __builtin_bit_cast(float, __builtin_amdgcn_update_dpp(0, __builtin_bit_cast(int, x), 0xB1, 0xF, 0xF, true));
    x += __builtin_bit_cast(float, __builtin_amdgcn_update_dpp(0, __builtin_bit_cast(int, x), 0x4E, 0xF, 0xF, true));
    x += __builtin_bit_cast(float, __builtin_amdgcn_update_dpp(0, __builtin_bit_cast(int, x), 0x141, 0xF, 0xF, true));
    x += __builtin_bit_cast(float, __builtin_amdgcn_update_dpp(0, __builtin_bit_cast(int, x), 0x140, 0xF, 0xF, true));
    x += __builtin_bit_cast(float, __builtin_amdgcn_ds_bpermute((pg8::lane_id() ^ 16) << 2, __builtin_bit_cast(int, x)));
    return x;
}
__device__ __forceinline__ float wsum64(float x) {
    x = sum32_x(x); auto rr = __builtin_amdgcn_permlane32_swap(__float_as_uint(x), __float_as_uint(x), false, false); return __uint_as_float(rr[0]) + __uint_as_float(rr[1]);
}
__device__ __forceinline__ void rwkv_prep_tile(Frame& F, int tile, const f16_t* PROJ16, const f16_t* LSLAB, const float* mu, const float* w0, const f16_t* W2T, const float* a0, const f16_t* A2T, const f16_t* G2T,
                                               const float* k_k, const float* k_a, float* lwout, f16_t* kmod, f16_t* Aout, f16_t* Bout, f16_t* gout) {
    typedef _Float16 f16x8 __attribute__((ext_vector_type(8))); typedef float f32x16 __attribute__((ext_vector_type(16)));
    constexpr int SXS = 592;
    LAS unsigned char* sx = F.lds + RING_OFF;
    const int lane = FLANE, tid = F.wave * 64 + lane, t0 = tile * 32, r32 = lane & 31, hi = lane >> 5;
    __syncthreads();
    for (int e = tid; e < 32 * 36; e += 512) {
        typedef unsigned short us8v __attribute__((ext_vector_type(8)));
        const int tok = e / 36, i8 = (e % 36) * 8, pos = (t0 + tok) & (S - 1);
        float cv[8], pv[8];
#pragma unroll
        for (int i = 0; i < 8; ++i) { cv[i] = 0.f; pv[i] = 0.f; }
#pragma unroll
        for (int sl = 0; sl < 4; ++sl) { const f16_t* cur = LSLAB + ((size_t)sl * T + t0 + tok) * 512 + i8;
            const us8v c8 = *(const GAS us8v*)cur; us8v p8 = c8; if (pos > 0) p8 = *(const GAS us8v*)(cur - 512);
#pragma unroll
            for (int i = 0; i < 8; ++i) { cv[i] += h2f(c8[i]); pv[i] += h2f(p8[i]); } }
        float f[8];
#pragma unroll
        for (int i = 0; i < 8; ++i) { const float xs = cv[i] + ((pos > 0 ? pv[i] : 0.f) - cv[i]) * mu[3072 + i8 + i];
            f[i] = i8 < 64 ? 1.f - 2.f / (1.f + __expf(2.f * xs)) : (i8 < 128 ? xs : 1.f / (1.f + __expf(-xs))); }
        *(LAS v4u*)(sx + tok * SXS + i8 * 2) = (v4u){pk2h(f[0], f[1]), pk2h(f[2], f[3]), pk2h(f[4], f[5]), pk2h(f[6], f[7])};
    }
    __syncthreads();
    const LAS unsigned char* ap = sx + r32 * SXS + hi * 16;
#pragma unroll 1
    for (int hd = 0; hd < 2; ++hd) {
        const int ch0 = 128 * F.wave + 64 * hd;
        f32x16 aw[2], aa[2], ag[2];
#pragma unroll
        for (int tt = 0; tt < 2; ++tt)
#pragma unroll
            for (int r = 0; r < 16; ++r) { aw[tt][r] = 0.f; aa[tt][r] = 0.f; ag[tt][r] = 0.f; }
#pragma unroll
        for (int tt = 0; tt < 2; ++tt) {
            const int n = ch0 + 32 * tt + r32;
            const f16_t* bw = W2T + (size_t)n * 64 + hi * 8; const f16_t* ba = A2T + (size_t)n * 64 + hi * 8; const f16_t* bg = G2T + (size_t)n * 160 + hi * 8;
#pragma unroll
            for (int ks = 0; ks < 4; ++ks) {
                aw[tt] = __builtin_amdgcn_mfma_f32_32x32x16_f16(*(const LAS f16x8*)(ap + ks * 32), *(const GAS f16x8*)(bw + ks * 16), aw[tt], 0, 0, 0);
                aa[tt] = __builtin_amdgcn_mfma_f32_32x32x16_f16(*(const LAS f16x8*)(ap + 128 + ks * 32), *(const GAS f16x8*)(ba + ks * 16), aa[tt], 0, 0, 0); }
#pragma unroll
            for (int ks = 0; ks < 10; ++ks)
                ag[tt] = __builtin_amdgcn_mfma_f32_32x32x16_f16(*(const LAS f16x8*)(ap + 256 + ks * 32), *(const GAS f16x8*)(bg + ks * 16), ag[tt], 0, 0, 0);
        }
        float k0[2][16];
        float pkk[2], pka[2], pmu[2], pw0[2], pa0[2];
#pragma unroll
        for (int tt = 0; tt < 2; ++tt) { const int n = ch0 + 32 * tt + r32; pkk[tt] = k_k[n]; pka[tt] = k_a[n]; pmu[tt] = mu[1024 + n]; pw0[tt] = w0[n]; pa0[tt] = a0[n]; }
#pragma unroll
        for (int rh = 0; rh < 2; ++rh) {
        float inv[8];
#pragma unroll
        for (int r = 8 * rh; r < 8 * rh + 8; ++r) { const int tok = t0 + (r & 3) + 8 * (r >> 2) + 4 * hi, pos = tok & (S - 1); float ss = 0.f;
#pragma unroll
            for (int tt = 0; tt < 2; ++tt) { const f16_t* cur = PROJ16 + (size_t)tok * PN + 4096 + ch0 + 32 * tt + r32;
                const float cv = h2f(cur[0]), pv = pos > 0 ? h2f(cur[-PN]) : 0.f; k0[tt][r] = cv + (pv - cv) * pmu[tt]; const float kq = k0[tt][r] * pkk[tt]; ss = fmaf(kq, kq, ss); }
            ss = sum32_x(ss); inv[r - 8 * rh] = __builtin_amdgcn_rsqf(fmaxf(ss, 1e-24f)); }
#pragma unroll
        for (int r = 8 * rh; r < 8 * rh + 8; ++r) { const int tok = t0 + (r & 3) + 8 * (r >> 2) + 4 * hi;
#pragma unroll
            for (int tt = 0; tt < 2; ++tt) { const size_t o = (size_t)tok * RWK + ch0 + 32 * tt + r32;
                const float z = -(pw0[tt] + aw[tt][r]); const float sp = z > 20.f ? z : __logf(1.f + __expf(z));
                lwout[o] = -__expf(-sp - 0.5f);
                const float asig = 1.f / (1.f + __expf(-(pa0[tt] + aa[tt][r]))); const float kk = k0[tt][r] * pkk[tt] * inv[r - 8 * rh];
                kmod[o] = __builtin_bit_cast(unsigned short, (_Float16)(k0[tt][r] * (1.f + (asig - 1.f) * pka[tt])));
                Aout[o] = __builtin_bit_cast(unsigned short, (_Float16)(-kk)); Bout[o] = __builtin_bit_cast(unsigned short, (_Float16)(kk * asig));
                gout[o] = __builtin_bit_cast(unsigned short, (_Float16)ag[tt][r]); } }
        }
    }
}
__device__ __forceinline__ float sum16_dpp(float x) {
    x += __builtin_bit_cast(float, __builtin_amdgcn_update_dpp(0, __builtin_bit_cast(int, x), 0xB1, 0xF, 0xF, true));
    x += __builtin_bit_cast(float, __builtin_amdgcn_update_dpp(0, __builtin_bit_cast(int, x), 0x4E, 0xF, 0xF, true));
    x += __builtin_bit_cast(float, __builtin_amdgcn_update_dpp(0, __builtin_bit_cast(int, x), 0x141, 0xF, 0xF, true));
    x += __builtin_bit_cast(float, __builtin_amdgcn_update_dpp(0, __builtin_bit_cast(int, x), 0x140, 0xF, 0xF, true));
    return x;
}
__device__ __forceinline__ f32x4 h4f(const f16_t* p) { typedef _Float16 h4_t __attribute__((ext_vector_type(4))); const h4_t v = *(const GAS h4_t*)p; return (f32x4){(float)v[0], (float)v[1], (float)v[2], (float)v[3]}; }
#ifndef REP_P0
#define REP_P0 1
#endif
#ifndef REP_PROJ
#define REP_PROJ 1
#endif
#ifndef REP_PLE
#define REP_PLE 1
#endif
#ifndef REP_CONV
#define REP_CONV 1
#endif
#ifndef REP_P2
#define REP_P2 1
#endif
#ifndef CONV_RATE
#define CONV_RATE 384
#endif
#ifndef REP_P3
#define REP_P3 1
#endif
#ifndef PROBE_K
#define PROBE_K -1
#endif
#ifndef PROBE_J
#define PROBE_J -1
#endif
#ifndef PROBE_SCALE
#define PROBE_SCALE 1e-3f
#endif
#ifndef REP_P5
#define REP_P5 1
#endif
#ifndef REP_P8
#define REP_P8 1
#endif
#ifndef REP_P6
#define REP_P6 1
#endif
#ifndef REP_P7
#define REP_P7 1
#endif
struct Args { const float* in[37]; float* out; unsigned char* ws; int ph_lo, ph_hi, li, pad; };
__global__ void __launch_bounds__(NWAVES * 64, 2) mega_fwd(Args args) {
    extern __shared__ __attribute__((aligned(16))) unsigned char lds[];
    Frame F;
    F.lds = (LAS unsigned char*)lds; F.MISC = (volatile LAS unsigned*)(F.lds + MISC_OFF);
    F.wave = __builtin_amdgcn_readfirstlane(threadIdx.x >> 6);
    F.G = gridDim.x; { const int bx = blockIdx.x; F.vcu = (F.G % 8 == 0) ? (bx % 8) * (F.G / 8) + bx / 8 : bx; }
    unsigned char* ws = args.ws;
    F.ctl = (gu32*)(ws);
    for (int u = FTID; u < (LDS_BYTES - LDSCTL_OFF) / 4; u += NWAVES * 64) ((LAS unsigned*)(F.lds + LDSCTL_OFF))[u] = 0u;
    __syncthreads();
    XcdBarrier bar = xcd_barrier_post((unsigned*)(F.ctl + CW_BAR) + args.li * XCD_BAR_WORDS, F.MISC + 8);
    unsigned long long t0_ = 0, tk_ = 0; if (PROBE_K != -1) t0_ = __builtin_amdgcn_s_memrealtime();
    const int lo = args.ph_lo, hi = args.ph_hi;
#define IN(k) (lo <= (k) && (k) < hi)
#define BOTH(k) (IN(k) && IN((k) + 1))
    f16_t* WinT = (f16_t*)(ws + WS_WINT); f16_t* H16 = (f16_t*)(ws + WS_H16); f16_t* PROJ16 = (f16_t*)(ws + WS_PROJ16); float* DECAY = (float*)(ws + WS_DECAY); f16_t* KMOD = (f16_t*)(ws + WS_KMOD); f16_t* A16 = (f16_t*)(ws + WS_A16); f16_t* B16 = (f16_t*)(ws + WS_B16); f16_t* G16 = (f16_t*)(ws + WS_G16);
    f16_t* WoutT = (f16_t*)(ws + WS_WOUTT); f16_t* GateT = (f16_t*)(ws + WS_GATET); f16_t* PleT = (f16_t*)(ws + WS_PLET); f16_t* P16 = (f16_t*)(ws + WS_P16);
    f16_t* PW16 = (f16_t*)(ws + WS_PW16); f16_t* Y16 = (f16_t*)(ws + WS_Y16); float* ROWRS = (float*)(ws + WS_ROWRS);
    float* RT = (float*)(ws + WS_RT); f16_t* GUT = (f16_t*)(ws + WS_GUT); f16_t* DNT = (f16_t*)(ws + WS_DNT); f16_t* HID = (f16_t*)(ws + WS_HID); f16_t* FFN16 = (f16_t*)(ws + WS_FFN16); f16_t* H1_16 = (f16_t*)(ws + WS_H1_16);
    int* cnt = (int*)(ws + WS_CNT); int* ltok = (int*)(ws + WS_LTOK); int* lpair = (int*)(ws + WS_LPAIR); float* pairw = (float*)(ws + WS_PAIRW);
    const int gw = F.vcu * NWAVES + F.wave, NGW = F.G * NWAVES;
    if (IN(0)) for (int rep_ = 0; rep_ < REP_P0; ++rep_) {
        LAS float* scr = (LAS float*)(F.lds + RING_OFF + F.wave * 16384);
        constexpr int I_IN = (D / 64) * (NPROJ / 32);
        for (int it = gw; it < I_IN; it += NGW) p0_transpose_item(args.in[5], D, NPROJ, WinT, 0, scr, it, FLANE);
        constexpr int I_SQ = (D / 64) * (D / 32), I_PLE = (256 / 64) * (D / 32);
        for (int it = gw; it < 2 * I_SQ + I_PLE; it += NGW) {
            if (it < I_SQ) p0_transpose_item(args.in[22], D, D, WoutT, 0, scr, it, FLANE);
            else if (it < 2 * I_SQ) p0_transpose_item(args.in[36], D, D, GateT, 0, scr, it - I_SQ, FLANE);
            else p0_transpose_item(args.in[34], 256, D, PleT, 0, scr, it - 2 * I_SQ, FLANE);
        }
        { const GAS f32x4* pi = (const GAS f32x4*)args.in[1]; GAS unsigned long long* po = (GAS unsigned long long*)P16;
          for (int i = blockIdx.x * 512 + FTID; i < T * 256 / 4; i += F.G * 512) { const f32x4 v = pi[i]; po[i] = (unsigned long long)pk2h(v.x, v.y) | ((unsigned long long)pk2h(v.z, v.w) << 32); } }
        { GAS v4u* z = (GAS v4u*)(WinT + (size_t)NPROJ * D); const int nz = (PN - NPROJ) * D * 2 / 16;
          for (int i = blockIdx.x * 512 + FTID; i < nz; i += F.G * 512) z[i] = (v4u){0u, 0u, 0u, 0u}; }
        {
            f16_t* W2T = (f16_t*)(ws + WS_W2T); f16_t* A2T = (f16_t*)(ws + WS_A2T); f16_t* G2T = (f16_t*)(ws + WS_G2T);
            for (int i = blockIdx.x * 512 + FTID; i < 1024 * 288; i += F.G * 512) { const int n = i / 288, k = i % 288;
                if (k < 64) W2T[n * 64 + k] = __builtin_bit_cast(unsigned short, (_Float16)args.in[13][k * 1024 + n]);
                else if (k < 128) A2T[n * 64 + (k - 64)] = __builtin_bit_cast(unsigned short, (_Float16)args.in[15][(k - 64) * 1024 + n]);
                else G2T[n * 160 + (k - 128)] = __builtin_bit_cast(unsigned short, (_Float16)args.in[16][(k - 128) * 1024 + n]); } }
        if (blockIdx.x == 0) {
            const int tid = FTID; float* lamp = (float*)(ws + WS_LAM); float* biasT = (float*)(ws + WS_BIAS);
            if (tid < 64) { const float a = wave_sum_b(args.in[6][tid] * args.in[7][tid]), b2 = wave_sum_b(args.in[8][tid] * args.in[9][tid]); if (tid == 0) *lamp = expf(a) - expf(b2) + LAMBDA_INIT; }
            for (int i = tid; i < 8 * 129; i += 512) { const int hh = i / 129, n = i % 129; int bucket;
                if (n < 16) bucket = n; else { const int large = 16 + (int)(logf((float)n / 16.f) / 2.0794415416798357f * 16.f); bucket = large < 31 ? large : 31; }
                biasT[i] = args.in[4][bucket * 8 + hh]; }
        }
        for (int m = gw; m < T; m += NGW) ln_row_f16(FLANE, args.in[0] + (size_t)m * D, args.in[2], args.in[3], H16 + (size_t)m * D, (float2*)(ws + WS_ROWST) + m);
        if (BOTH(0) && rep_ == REP_P0 - 1) xcd_barrier(bar); else __syncthreads();
    }
    if (PROBE_K == 0) tk_ = __builtin_amdgcn_s_memrealtime();
    if (PROBE_J == 0) t0_ = __builtin_amdgcn_s_memrealtime();
    if (IN(1)) {
        pg8::Gemm g{H16, WinT, T, 6144, D, D}; pg8::StaticOrder S; S.init(T, 6144, F.G, (int)blockIdx.x);
        pg8::EpiF16 E{PROJ16, PN, 4, att::C2};
        for (int rep_ = 0; rep_ < REP_PROJ; ++rep_) pg8::gemm_phase<pg8::EpiF16, pg8::StaticOrder, true>(F.lds + RING_OFF, g, S, E, F.wave);
        { pg8::Gemm gl{H16, WinT + (size_t)6144 * D, T, 512, 512, D}; pg8::SplitKOrder Sl{T / 256, 2, 4, F.G, (int)blockIdx.x};
          pg8::EpiSlab El{(f16_t*)(ws + WS_LSLAB), 512, (size_t)T * 512};
          pg8::gemm_phase<pg8::EpiSlab, pg8::SplitKOrder, true>(F.lds + RING_OFF, gl, Sl, El, F.wave); }
        for (int rep_ = 0; rep_ < REP_PLE; ++rep_) { pg8::Gemm g2{P16, PleT, T, D, 256, 256}; pg8::StaticOrder S2; S2.init(T, D, F.G, (int)blockIdx.x);
          pg8::EpiF16 E2{PW16, D, 0, 1.f};
          pg8::gemm_phase<pg8::EpiF16, pg8::StaticOrder, true>(F.lds + RING_OFF, g2, S2, E2, F.wave); }
        if (BOTH(1)) xcd_barrier(bar);
    }
    if (PROBE_K == 1) tk_ = __builtin_amdgcn_s_memrealtime();
    if (PROBE_J == 1) t0_ = __builtin_amdgcn_s_memrealtime();
    if (IN(2)) {
        for (int rep_ = 0; rep_ < REP_P2; ++rep_)
        if (F.vcu < T / 32) { const int tile = F.vcu;
            rwkv_prep_tile(F, tile, PROJ16, (const f16_t*)(ws + WS_LSLAB), args.in[11], args.in[12], (const f16_t*)(ws + WS_W2T), args.in[14], (const f16_t*)(ws + WS_A2T), (const f16_t*)(ws + WS_G2T), args.in[17], args.in[18], DECAY, KMOD, A16, B16, G16);
            asm volatile("s_waitcnt vmcnt(0)" ::: "memory"); __syncthreads();
            { rk::ChunkIn nin; const int tl_ = (F.wave & 3) * 64 + FLANE, tg_ = tile * 32 + (tl_ >> 3), ps_ = tg_ & (S - 1), cb_ = (F.wave >> 2) * 64 + (tl_ & 7) * 8;
              rk::chunk_load(nin, tg_, ps_, cb_, ws);
              for (int hA = 0; hA < 16; hA += 2) {
                  rk::chunk_pair(F.lds + RING_OFF, F.wave, tile, hA, nin, hA + 2 < 16, args.in[11], args.in[19], ws); } }
            __syncthreads();
        }
        if (BOTH(2)) xcd_barrier(bar);
    }
    if (PROBE_K == 2) tk_ = __builtin_amdgcn_s_memrealtime();
    if (PROBE_J == 2) t0_ = __builtin_amdgcn_s_memrealtime();
    if (IN(3)) {
        if (F.vcu < 64) rk::scan_unit(F.lds + RING_OFF, F.wave, F.vcu, ws + WS_CHK, (const float*)(ws + WS_BONUS), PROJ16, args.in[11], G16, args.in[20], args.in[21], Y16);
        {
            const float lam = *(const float*)(ws + WS_LAM);
            volatile LAS unsigned* qslot = F.MISC + 12;
            const float* wg = args.in[29]; const float* wu = args.in[30]; const float* wd = args.in[31];
            auto conv_batch = [&]() -> bool {
                __syncthreads();
                if (FTID == 0) qslot[1] = __hip_atomic_fetch_add(F.ctl + CW_CONVQ, 1u, __ATOMIC_RELAXED, __HIP_MEMORY_SCOPE_AGENT);
                __syncthreads();
                const int q = (int)__builtin_amdgcn_readfirstlane(qslot[1]);
                if (q >= NE * 1536 / 128) return false;
                LAS unsigned char* scr = F.lds + RING_OFF + F.wave * 16384;
                tpd_stream(q * 128 + F.wave, q * 128 + 128, 8, [=](int it) { const int e = it / 1536, r = it % 1536;
                    if (r < 1024) { const int rr = r & 511, nb = rr % 16; return TpDesc{(r < 512 ? wg : wu) + (size_t)e * D * 512, GUT + (size_t)e * 1024 * D, D, 512, 128 * (nb >> 2) + (r < 512 ? 0 : 128), rr}; }
                    return TpDesc{wd + (size_t)e * 512 * D, DNT + (size_t)e * D * 512, 512, D, 0, r - 1024}; }, scr, FLANE);
                return true;
            };
            int credit = 0;
            for (;;) {
                __syncthreads();
                if (FTID == 0) *qslot = __hip_atomic_fetch_add(F.ctl + CW_ATTQ, 1u, __ATOMIC_RELAXED, __HIP_MEMORY_SCOPE_AGENT);
                __syncthreads();
                const int u = (int)__builtin_amdgcn_readfirstlane(*qslot);
                if (u >= 512) break;
                const int qb = 15 - (u >> 5), bh = u & 31;
                att::attn_unit<8>(F.lds + RING_OFF, F.wave, bh >> 3, bh & 7, qb, PROJ16, Y16, (const float*)(ws + WS_BIAS) + (bh & 7) * 129, lam, args.in[10]);
                credit += 2 * (qb + 1) * CONV_RATE;
                while (credit >= 8704) { credit -= 8704; if (!conv_batch()) { credit = 0; break; } }
            }
            while (conv_batch()) {}
        }
        if (BOTH(3)) xcd_barrier(bar);
    }
    if (PROBE_K == 3) tk_ = __builtin_amdgcn_s_memrealtime();
    if (PROBE_J == 3) t0_ = __builtin_amdgcn_s_memrealtime();
    if (IN(4)) {
        for (int i = blockIdx.x * 512 + FTID; i < 36 * D; i += F.G * 512) { const int e = i / D, d = i % D; RT[i] = e < 4 ? args.in[25][d * 4 + e] : args.in[27][d * 32 + (e - 4)]; }
        pg8::Gemm g{Y16, WoutT, T, D, D, D}; pg8::StaticOrder S; S.init(T, D, F.G, (int)blockIdx.x);
        pg8::EpiResLN E{args.in[0], args.out, D, ALPHA, (const float2*)(ws + WS_ROWST), args.in[2], args.in[3]};
        pg8::gemm_phase<pg8::EpiResLN, pg8::StaticOrder, true>(F.lds + RING_OFF, g, S, E, F.wave);
        if (BOTH(4)) xcd_barrier(bar);
    }
    if (PROBE_K == 4) tk_ = __builtin_amdgcn_s_memrealtime();
    if (PROBE_J == 4) t0_ = __builtin_amdgcn_s_memrealtime();
    if (IN(5)) for (int rep_ = 0; rep_ < REP_P5; ++rep_) {
        const bool dry = rep_ < REP_P5 - 1;
        f16_t* o16b = dry ? (f16_t*)(ws + WS_CHK + 64 * MiB) : H1_16;
        const int lane = FLANE, tid = F.wave * 64 + lane;
        LAS float* lg = (LAS float*)(F.lds + RING_OFF + 49152) + F.wave * 256;
        LAS int* lcnt = (LAS int*)(F.lds + RING_OFF + 106496);
        if (F.wave == 0 && lane < 32) lcnt[lane] = 0;
        if (F.vcu < T / 32) {
            const int r0 = F.vcu * 32 + F.wave * 4;
            f32x4 v0[8], v1[8], v2[8], v3[8];
            { const GAS f32x4* xr = (const GAS f32x4*)(args.out + (size_t)r0 * D) + lane;
#pragma unroll
              for (int j = 0; j < 8; ++j) { v0[j] = xr[64 * j]; v1[j] = xr[64 * j + D / 4]; v2[j] = xr[64 * j + 2 * (D / 4)]; v3[j] = xr[64 * j + 3 * (D / 4)]; } }
            rt_stage(RT, F.lds + RING_OFF, F.wave, lane);
            ln_norm(lane, v0, args.in[23], args.in[24]); ln_norm(lane, v1, args.in[23], args.in[24]); asm volatile("" ::: "memory"); ln_norm(lane, v2, args.in[23], args.in[24]); ln_norm(lane, v3, args.in[23], args.in[24]);
#pragma unroll 1
            for (int ec = 0; ec < 6; ++ec) {
                asm volatile("s_waitcnt vmcnt(0)" ::: "memory"); __syncthreads();
                if (ec + 1 < 6) rt_stage(RT + (size_t)(ec + 1) * 6 * D, F.lds + RING_OFF + ((ec + 1) & 1) * 57344, F.wave, lane);
                const LAS float* rtb = (const LAS float*)(F.lds + RING_OFF + (ec & 1) * 57344);
                float a0[6], a1[6], a2[6], a3[6];
                typedef float f32x2 __attribute__((ext_vector_type(2)));
#pragma unroll
                for (int eh = 0; eh < 2; ++eh) {
                    f32x2 c0[3], c1[3], c2[3], c3[3];
#pragma unroll
                    for (int e = 0; e < 3; ++e) { c0[e] = 0.f; c1[e] = 0.f; c2[e] = 0.f; c3[e] = 0.f; }
#pragma unroll
                    for (int j = 0; j < 8; ++j)
#pragma unroll
                        for (int e = 0; e < 3; ++e) { const f32x4 w = *(const LAS f32x4*)(rtb + (3 * eh + e) * D + 256 * j + 4 * lane); const f32x2 wl = w.xy, wh = w.zw;
                            c0[e] += v0[j].xy * wl; c0[e] += v0[j].zw * wh; c1[e] += v1[j].xy * wl; c1[e] += v1[j].zw * wh;
                            c2[e] += v2[j].xy * wl; c2[e] += v2[j].zw * wh; c3[e] += v3[j].xy * wl; c3[e] += v3[j].zw * wh; }
#pragma unroll
                    for (int e = 0; e < 3; ++e) { a0[3 * eh + e] = c0[e].x + c0[e].y; a1[3 * eh + e] = c1[e].x + c1[e].y; a2[3 * eh + e] = c2[e].x + c2[e].y; a3[3 * eh + e] = c3[e].x + c3[e].y; }
                }
#pragma unroll
                for (int e = 0; e < 6; ++e) { a0[e] = wsum64(a0[e]); a1[e] = wsum64(a1[e]); a2[e] = wsum64(a2[e]); a3[e] = wsum64(a3[e]); }
                if (lane == 0) {
#pragma unroll
                    for (int e = 0; e < 6; ++e) { lg[ec * 6 + e] = a0[e]; lg[64 + ec * 6 + e] = a1[e]; lg[128 + ec * 6 + e] = a2[e]; lg[192 + ec * 6 + e] = a3[e]; } }
            }
            LDS_WAIT();
            int ea = 0, ebb = 0, pl0 = 0, pl1 = 0; float wa = 0.f, wb = 0.f;
            if (lane < 4 && !dry) { float aa[36];
#pragma unroll
                for (int e = 0; e < 36; ++e) aa[e] = lg[lane * 64 + e];
                route_pick(aa, args.in[26], args.in[28], ea, ebb, wa, wb);
                pl0 = __hip_atomic_fetch_add(lcnt + ea, 1, __ATOMIC_RELAXED, __HIP_MEMORY_SCOPE_WORKGROUP); pl1 = __hip_atomic_fetch_add(lcnt + ebb, 1, __ATOMIC_RELAXED, __HIP_MEMORY_SCOPE_WORKGROUP); }
            __syncthreads();
            if (F.wave == 0 && lane < 32 && !dry) { const int c = lcnt[lane]; int base = 0; if (c) base = atomicAdd(&cnt[lane * CNT_STRIDE], c); lcnt[32 + lane] = base; }
            __syncthreads();
            if (lane < 4 && !dry) { const int tok = r0 + lane; const int p0 = lcnt[32 + ea] + pl0, p1 = lcnt[32 + ebb] + pl1;
                ltok[ea * 8192 + p0] = tok; lpair[ea * 8192 + p0] = tok * 2; ltok[ebb * 8192 + p1] = tok; lpair[ebb * 8192 + p1] = tok * 2 + 1;
                pairw[tok * 2] = wa; pairw[tok * 2 + 1] = wb; }
            ln_store16(lane, v0, o16b + (size_t)r0 * D); ln_store16(lane, v1, o16b + (size_t)(r0 + 1) * D);
            ln_store16(lane, v2, o16b + (size_t)(r0 + 2) * D); ln_store16(lane, v3, o16b + (size_t)(r0 + 3) * D);
        }
        if (BOTH(5) && !dry) xcd_barrier(bar); else __syncthreads();
    }
    if (PROBE_K == 5) tk_ = __builtin_amdgcn_s_memrealtime();
    if (PROBE_J == 5) t0_ = __builtin_amdgcn_s_memrealtime();
    if (IN(6)) {
        build_moe_table(F, cnt);
        pg8::Gemm g{H1_16, GUT, 0, 0, D, D}; pg8::MoeOrder<true> S{(const LAS int*)(F.lds + TAB_OFF), ltok, F.vcu, F.G, 4, (size_t)1024 * D * 2, 0};
        pg8::EpiGU E{HID};
        for (int rep_ = 0; rep_ < REP_P6; ++rep_) pg8::gemm_phase<pg8::EpiGU, pg8::MoeOrder<true>, true>(F.lds + RING_OFF, g, S, E, F.wave);
        if (BOTH(6)) xcd_barrier(bar);
    }
    if (PROBE_K == 6) tk_ = __builtin_amdgcn_s_memrealtime();
    if (PROBE_J == 6) t0_ = __builtin_amdgcn_s_memrealtime();
    if (IN(7)) {
        build_moe_table(F, cnt);
        const pg8::Gemm gU{H1_16, GUT, 0, 0, D, D}; const pg8::Gemm gD{HID, DNT, 0, 0, 512, 512};
        const pg8::EpiGU EU{HID}; const pg8::EpiDown ED{FFN16, lpair};
        if (F.vcu < 64) { pg8::MoeOrder<true> S{(const LAS int*)(F.lds + TAB_OFF), ltok, F.vcu, 64, 4, (size_t)1024 * D * 2, 1};
            pg8::gemm_phase<pg8::EpiGU, pg8::MoeOrder<true>, true>(F.lds + RING_OFF, gU, S, EU, F.wave); }
        else { pg8::MoeOrder<false> S{(const LAS int*)(F.lds + TAB_OFF), nullptr, F.vcu - 64, F.G - 64, 8, (size_t)D * 512 * 2, 0};
            pg8::gemm_phase<pg8::EpiDown, pg8::MoeOrder<false>, true>(F.lds + RING_OFF, gD, S, ED, F.wave); }
        xcd_barrier(bar);
        { pg8::MoeOrder<false> S{(const LAS int*)(F.lds + TAB_OFF), nullptr, F.vcu, F.G, 8, (size_t)D * 512 * 2, 1};
          pg8::gemm_phase<pg8::EpiDown, pg8::MoeOrder<false>, true>(F.lds + RING_OFF, gD, S, ED, F.wave); }
        if (BOTH(7)) xcd_barrier(bar);
    }
    if (PROBE_K == 7) tk_ = __builtin_amdgcn_s_memrealtime();
    if (PROBE_J == 7) t0_ = __builtin_amdgcn_s_memrealtime();
    if (IN(8)) for (int rep_ = 0; rep_ < REP_P8; ++rep_) {
        const bool dry = rep_ < REP_P8 - 1;
        f16_t* o16b = dry ? (f16_t*)(ws + WS_GUT + 64 * MiB) : Y16; float* rrs = dry ? (float*)(ws + WS_GUT + 100 * MiB) : ROWRS;
        typedef _Float16 h4_t __attribute__((ext_vector_type(4)));
        const int lane = FLANE;
        for (int m = gw; m < T; m += NGW) {
            f32x4 v[8]; const GAS h4_t* xr = (const GAS h4_t*)(H1_16 + (size_t)m * D) + lane;
            const GAS h4_t* f0 = (const GAS h4_t*)(FFN16 + (size_t)(2 * m) * D) + lane; const GAS h4_t* f1 = (const GAS h4_t*)(FFN16 + (size_t)(2 * m + 1) * D) + lane;
            const GAS h4_t* pr = (const GAS h4_t*)(PW16 + (size_t)m * D) + lane;
            const float w0 = pairw[2 * m], w1 = pairw[2 * m + 1]; float q = 0.f;
#pragma unroll
            for (int j = 0; j < 8; ++j) { const h4_t x = xr[64 * j]; const h4_t a = f0[64 * j], c = f1[64 * j], pv = pr[64 * j];
                v[j].x = ALPHA * (float)x[0] + w0 * (float)a[0] + w1 * (float)c[0]; v[j].y = ALPHA * (float)x[1] + w0 * (float)a[1] + w1 * (float)c[1];
                v[j].z = ALPHA * (float)x[2] + w0 * (float)a[2] + w1 * (float)c[2]; v[j].w = ALPHA * (float)x[3] + w0 * (float)a[3] + w1 * (float)c[3];
                q += ((float)pv[0] * (float)pv[0] + (float)pv[1] * (float)pv[1]) + ((float)pv[2] * (float)pv[2] + (float)pv[3] * (float)pv[3]); }
            ln_norm(lane, v, args.in[32], args.in[33]); ln_store16(lane, v, o16b + (size_t)m * D);
            q = wave_sum_b(q);
            if (lane == 0) rrs[m] = __builtin_amdgcn_rsqf(q * (1.f / D) + LN_EPS);
        }
        if (BOTH(8) && !dry) xcd_barrier(bar); else __syncthreads();
    }
    if (PROBE_K == 8) tk_ = __builtin_amdgcn_s_memrealtime();
    if (PROBE_J == 8) t0_ = __builtin_amdgcn_s_memrealtime();
    if (IN(9)) {
        pg8::Gemm g{Y16, GateT, T, D, D, D}; pg8::StaticOrder S; S.init(T, D, F.G, (int)blockIdx.x);
        pg8::EpiFinal E{args.out, D, Y16, PW16, ROWRS, args.in[35]};
        pg8::gemm_phase<pg8::EpiFinal, pg8::StaticOrder, true>(F.lds + RING_OFF, g, S, E, F.wave);
    }
    if (PROBE_K != -1) {
        if (PROBE_K == 9) tk_ = __builtin_amdgcn_s_memrealtime();
        xcd_barrier(bar);
        if (blockIdx.x == 0 && FTID == 0) args.out[0] += (PROBE_K == -2) ? 100000.f : (float)(tk_ - t0_) * PROBE_SCALE;
    }
#undef IN
#undef BOTH
}

extern "C" void kernel_launch(void* const* d_in, const int* in_sizes, int n_in, void* d_out, int out_size, void* d_ws, size_t ws_size, hipStream_t stream) {
    static int grid = 0;
    if (grid == 0) {
        if (ws_size < WS_END2 || n_in != 37 || out_size != T * D) { fprintf(stderr, "kernel_launch: bad ws/n_in/out: %zu %d %d\n", ws_size, n_in, out_size); grid = -1; return; }
        int dev = 0, cus = 0;
        if (hipGetDevice(&dev) != hipSuccess || hipDeviceGetAttribute(&cus, hipDeviceAttributeMultiprocessorCount, dev) != hipSuccess) { grid = -1; return; }
        if (hipFuncSetAttribute((const void*)mega_fwd, hipFuncAttributeMaxDynamicSharedMemorySize, LDS_BYTES) != hipSuccess) { fprintf(stderr, "kernel_launch: hipFuncSetAttribute failed\n"); grid = -1; return; }
        if (cus != 256) { fprintf(stderr, "kernel_launch: built for a 256-CU device, found %d\n", cus); grid = -1; return; }
        grid = cus;
    }
    if (grid < 0) return;
    (void)hipMemsetAsync(d_ws, 0, CTL_ZERO_BYTES, stream);
    Args a{}; for (int i = 0; i < 37; ++i) a.in[i] = (const float*)d_in[i]; a.out = (float*)d_out; a.ws = (unsigned char*)d_ws; a.ph_lo = 0; a.ph_hi = 10; a.li = 0;
    hipLaunchKernelGGL(mega_fwd, dim3(grid), dim3(NWAVES * 64), LDS_BYTES, stream, a);
}
```

```cpp
#include <hip/hip_runtime.h>
#include <cstdio>
#include <cstdint>
#include <cmath>

constexpr int NB = 4, S = 2048, D = 2048, T = NB * S;
constexpr int NPROJ = 6432;
constexpr int RWK = 1024;
constexpr int COL_Q = 0, COL_K = 1024, COL_V = 2048, COL_RW = 3072;
constexpr int NH = 8, NRH = 16;
constexpr int NE = 32;
constexpr float LN_EPS = 1e-5f;
constexpr float ALPHA = 1.189207115002721f;
constexpr float LAMBDA_INIT = 0.2f;

constexpr size_t MiB = 1u << 20;
constexpr size_t WS_CNT = 4096;
constexpr int CNT_STRIDE = 32;
constexpr size_t WS_LTOK = 1 * MiB;
constexpr size_t WS_LPAIR = 2 * MiB;
constexpr size_t WS_PAIRW = 3 * MiB;
constexpr size_t WS_RT = 3 * MiB + 128 * 1024;
constexpr size_t WS_LAM = 3 * MiB + 512 * 1024;
constexpr size_t WS_BIAS = 3 * MiB + 512 * 1024 + 1024;
constexpr size_t WS_ROWRS = 3 * MiB + 768 * 1024;
constexpr size_t WS_ROWST = 3 * MiB + 832 * 1024;
constexpr size_t WS_WINT = 4 * MiB;
constexpr size_t WS_WOUTT = 30 * MiB;
constexpr size_t WS_GATET = 38 * MiB;
constexpr size_t WS_PLET = 46 * MiB;
constexpr size_t WS_P16 = 47 * MiB;
constexpr size_t WS_W2T = 51 * MiB;
constexpr size_t WS_A2T = 51 * MiB + 128 * 1024;
constexpr size_t WS_G2T = 51 * MiB + 256 * 1024;
constexpr size_t WS_CHK = 52 * MiB;
constexpr size_t WS_BONUS = 148 * MiB;
constexpr size_t WS_LSLAB = 150 * MiB;
constexpr size_t WS_GUT = 348 * MiB;
constexpr size_t WS_DNT = 150 * MiB;
constexpr size_t WS_PROJ16 = 244 * MiB;
constexpr size_t WS_FFN16 = 52 * MiB;
constexpr size_t WS_HID = 116 * MiB;
constexpr size_t WS_DECAY = 348 * MiB;
constexpr size_t WS_KMOD = 380 * MiB;
constexpr size_t WS_A16 = 396 * MiB;
constexpr size_t WS_B16 = 412 * MiB;
constexpr size_t WS_G16 = 214 * MiB;
constexpr size_t WS_H16 = 444 * MiB;
constexpr size_t WS_H1_16 = 244 * MiB;
constexpr size_t WS_Y16 = 476 * MiB;
constexpr size_t WS_PW16 = 508 * MiB;
constexpr size_t WS_END2 = 540 * MiB;

namespace pg8 {
#define PG8_LAS __attribute__((address_space(3)))
typedef unsigned short f16_t;
typedef _Float16 f16x8 __attribute__((ext_vector_type(8)));
typedef float f32x4 __attribute__((ext_vector_type(4)));
typedef unsigned u32x4 __attribute__((ext_vector_type(4)));
constexpr int BM = 256, BK = 64, HALF = 128, HTB = HALF * BK * 2  , STAGE_BYTES = 8 * HTB, NXCD = 8, WGM = 8;

__host__ __device__ __forceinline__ int lds_byte(int r, int c) { const int st = (r >> 4) * 2 + (c >> 5), rr = r & 15, cc = c & 31, ob = rr * 64 + cc * 2; return st * 1024 + (ob ^ (((ob >> 9) & 1) << 5)); }
__host__ __device__ __forceinline__ void stage_rc(int b, int& R, int& C) { const int st = b / 1024, sb = b % 1024, swz = sb ^ (((sb >> 9) & 1) << 5); R = (st >> 1) * 16 + swz / 64; C = (st & 1) * 32 + (swz % 64) / 2; }
__host__ __device__ __forceinline__ int perm32(int rho) { const int n = rho >> 4, i = rho & 15; return 8 * (i >> 2) + 4 * n + (i & 3); }

__device__ __forceinline__ int lane_id() { int l; asm volatile("v_mbcnt_lo_u32_b32 %0, -1, 0\n\tv_mbcnt_hi_u32_b32 %0, -1, %0" : "=v"(l)); return l; }
struct Unit { int pm, pn, e, rb, cnt; };
struct Gemm { const f16_t* A; const f16_t* Bt; int M, N, K, ld; };

struct StaticOrder {
    int nM, nN, nwg, G, c, lim, off;
    __host__ __device__ void init(int M, int N, int G_, int c_) { nM = M / BM; nN = N / BM; nwg = nM * nN; G = G_; c = c_; lim = nwg; off = 0; }
    __host__ __device__ bool next(int i, Unit& u) const {
        const long L = (long)i * G + c; if (L >= lim) return false;
        int wgid = (int)L + off; { const int q = nwg / NXCD, r = nwg % NXCD, xcd = wgid % NXCD, off = wgid / NXCD; wgid = (xcd < r ? xcd * (q + 1) : r * (q + 1) + (xcd - r) * q) + off; }
        const int nig = WGM * nN, gid = wgid / nig, fm = gid * WGM, gsz = (nM - fm) < WGM ? (nM - fm) : WGM;
        u.pm = fm + ((wgid % nig) % gsz); u.pn = (wgid % nig) / gsz; return true;
    }
    __device__ __forceinline__ void a_ready(const Unit&) const {}
    __device__ __forceinline__ void done(const Unit&) const {}
    __device__ __forceinline__ const char* a_base(const Gemm& g, const Unit& u) const { return (const char*)g.A + (size_t)u.pm * ((size_t)BM * g.ld * 2); }
    __device__ __forceinline__ const char* b_base(const Gemm& g, const Unit& u) const { return (const char*)g.Bt + (size_t)u.pn * ((size_t)BM * g.ld * 2); }
    __device__ __forceinline__ void a_voff(const Gemm& g, const Unit&, int tid, unsigned (&va)[2][2]) const {
#pragma unroll
        for (int i = 0; i < 2; ++i) { int R, C; stage_rc(tid * 16 + i * 8192, R, C); va[0][i] = (unsigned)(R * g.ld + C) * 2u; va[1][i] = va[0][i] + (unsigned)(HALF * g.ld * 2); }
    }
};
struct SplitKOrder {
    int nM, nN, nks, G, c;
    __device__ __forceinline__ bool next(int i, Unit& u) const { const int L = i * G + c; if (L >= nM * nN * nks) return false; u.e = L / (nM * nN); const int rem = L % (nM * nN); u.pn = rem / nM; u.pm = rem % nM; u.rb = 0; u.cnt = 0; return true; }
    __device__ __forceinline__ void a_ready(const Unit&) const {}
    __device__ __forceinline__ void done(const Unit&) const {}
    __device__ __forceinline__ const char* a_base(const Gemm& g, const Unit& u) const { return (const char*)g.A + (size_t)u.pm * ((size_t)BM * g.ld * 2) + (size_t)u.e * g.K * 2; }
    __device__ __forceinline__ const char* b_base(const Gemm& g, const Unit& u) const { return (const char*)g.Bt + (size_t)u.pn * ((size_t)BM * g.ld * 2) + (size_t)u.e * g.K * 2; }
    __device__ __forceinline__ void a_voff(const Gemm& g, const Unit&, int tid, unsigned (&va)[2][2]) const {
#pragma unroll
        for (int i = 0; i < 2; ++i) { int R, C; stage_rc(tid * 16 + i * 8192, R, C); va[0][i] = (unsigned)(R * g.ld + C) * 2u; va[1][i] = va[0][i] + (unsigned)(HALF * g.ld * 2); }
    }
};
template <bool GATHER> struct MoeOrder {
    const PG8_LAS int* tab; const int* list; int vcu, G, ntn; size_t estride; int cls;
    __device__ __forceinline__ bool next(int i, Unit& u) const {
        const int L = vcu + i * G; const int base = cls ? 98 : 65; const int tot = tab[base + 32] * ntn; if (L >= tot) return false;
        int e = 0; while (tab[base + 1 + e] * ntn <= L) ++e;
        const int nbk = tab[base + 1 + e] - tab[base + e], q = L - tab[base + e] * ntn; const int rb = q % nbk + (cls ? 2 : 0);
        u.e = __builtin_amdgcn_readfirstlane(e); u.pn = __builtin_amdgcn_readfirstlane(q / nbk); u.rb = __builtin_amdgcn_readfirstlane(rb);
        u.pm = __builtin_amdgcn_readfirstlane(tab[32 + e] + rb); u.cnt = __builtin_amdgcn_readfirstlane(tab[e]); return true;
    }
    __device__ __forceinline__ void a_ready(const Unit&) const {}
    __device__ __forceinline__ void done(const Unit&) const {}
    __device__ __forceinline__ const char* a_base(const Gemm& g, const Unit& u) const { return GATHER ? (const char*)g.A : (const char*)g.A + (size_t)u.pm * ((size_t)BM * g.ld * 2); }
    __device__ __forceinline__ const char* b_base(const Gemm& g, const Unit& u) const { return (const char*)g.Bt + (size_t)u.e * estride + (size_t)u.pn * ((size_t)BM * g.ld * 2); }
    __device__ __forceinline__ void a_voff(const Gemm& g, const Unit& u, int tid, unsigned (&va)[2][2]) const {
#pragma unroll
        for (int i = 0; i < 2; ++i) { int R, C; stage_rc(tid * 16 + i * 8192, R, C);
            if (GATHER) {
#pragma unroll
                for (int h = 0; h < 2; ++h) { int idx = u.rb * BM + h * HALF + R; idx = idx < u.cnt ? idx : u.cnt - 1; const int tok = list[u.e * 8192 + idx]; va[h][i] = (unsigned)(tok * g.ld + C) * 2u; }
            } else { va[0][i] = (unsigned)(R * g.ld + C) * 2u; va[1][i] = va[0][i] + (unsigned)(HALF * g.ld * 2); } }
    }
};


typedef _Float16 h2_t __attribute__((ext_vector_type(2)));
__device__ __forceinline__ unsigned cvt_pk_f16(float lo, float hi) { h2_t v = {(_Float16)lo, (_Float16)hi}; return __builtin_bit_cast(unsigned, v); }
struct EpiF16 {
    static constexpr bool PERM = true, AFTER_DRAIN = false;
    f16_t* O; int ldc; int ntile0; float scale0;
    __device__ __forceinline__ void operator()(const f32x4 (&acc)[2][2][4][2], const Unit& u, int wr, int wc, int fr, int fq) const {
        const int row0 = u.pm * BM + wr * 64 + fr; const int col0 = u.pn * BM + wc * 32 + 8 * fq;
        const float sc = (u.pn < ntile0) ? scale0 : 1.f;
#pragma unroll
        for (int ai = 0; ai < 2; ++ai)
#pragma unroll
            for (int m = 0; m < 4; ++m) { f16_t* rowp = O + (size_t)(row0 + ai * HALF + m * 16) * ldc + col0;
#pragma unroll
                for (int bj = 0; bj < 2; ++bj) { f32x4 v0 = acc[ai][bj][m][0] * sc, v1 = acc[ai][bj][m][1] * sc;
                    u32x4 w; w.x = cvt_pk_f16(v0[0], v0[1]); w.y = cvt_pk_f16(v0[2], v0[3]); w.z = cvt_pk_f16(v1[0], v1[1]); w.w = cvt_pk_f16(v1[2], v1[3]);
                    *(u32x4*)(rowp + bj * HALF) = w; } }
    }
};


struct EpiSlab {
    static constexpr bool PERM = true, AFTER_DRAIN = false;
    f16_t* O; int ldc; size_t slab;
    __device__ __forceinline__ void operator()(const f32x4 (&acc)[2][2][4][2], const Unit& u, int wr, int wc, int fr, int fq) const {
        const int row0 = u.pm * BM + wr * 64 + fr; const int col0 = u.pn * BM + wc * 32 + 8 * fq; f16_t* Ob = O + (size_t)u.e * slab;
#pragma unroll
        for (int ai = 0; ai < 2; ++ai)
#pragma unroll
            for (int m = 0; m < 4; ++m) { f16_t* rowp = Ob + (size_t)(row0 + ai * HALF + m * 16) * ldc + col0;
#pragma unroll
                for (int bj = 0; bj < 2; ++bj) { const f32x4 v0 = acc[ai][bj][m][0], v1 = acc[ai][bj][m][1];
                    u32x4 w; w.x = cvt_pk_f16(v0[0], v0[1]); w.y = cvt_pk_f16(v0[2], v0[3]); w.z = cvt_pk_f16(v1[0], v1[1]); w.w = cvt_pk_f16(v1[2], v1[3]);
                    *(u32x4*)(rowp + bj * HALF) = w; } }
    }
};
struct EpiResF32 {
    static constexpr bool PERM = false, AFTER_DRAIN = false;
    float* io; int ldc; float alpha;
    __device__ __forceinline__ void operator()(const f32x4 (&acc)[2][2][4][2], const Unit& u, int wr, int wc, int fr, int fq) const {
        const int row0 = u.pm * BM + wr * 64 + fr; const int col0 = u.pn * BM + wc * 32 + 4 * fq;
#pragma unroll
        for (int ai = 0; ai < 2; ++ai)
#pragma unroll
            for (int m = 0; m < 4; ++m) { float* rowp = io + (size_t)(row0 + ai * HALF + m * 16) * ldc + col0;
#pragma unroll
                for (int bj = 0; bj < 2; ++bj)
#pragma unroll
                    for (int n = 0; n < 2; ++n) { f32x4* p = (f32x4*)(rowp + bj * HALF + n * 16); const f32x4 r = *p; *p = r * alpha + acc[ai][bj][m][n]; } }
    }
};
struct EpiResLN {
    static constexpr bool PERM = false, AFTER_DRAIN = false;
    const float* x; float* out; int ldc; float alpha; const float2* st; const float* g; const float* b;
    __device__ __forceinline__ void operator()(const f32x4 (&acc)[2][2][4][2], const Unit& u, int wr, int wc, int fr, int fq) const {
        const int row0 = u.pm * BM + wr * 64 + fr; const int col0 = u.pn * BM + wc * 32 + 4 * fq;
        f32x4 gg[2][2], bb[2][2];
#pragma unroll
        for (int bj = 0; bj < 2; ++bj)
#pragma unroll
            for (int n = 0; n < 2; ++n) { gg[bj][n] = *(const f32x4*)(g + col0 + bj * HALF + n * 16); bb[bj][n] = *(const f32x4*)(b + col0 + bj * HALF + n * 16); }
#pragma unroll
        for (int ai = 0; ai < 2; ++ai)
#pragma unroll
          for (int mh = 0; mh < 2; ++mh) {
            f32x4 r[2][2][2]; float2 ms[2];
#pragma unroll
            for (int mm = 0; mm < 2; ++mm) { const int row = row0 + ai * HALF + (2 * mh + mm) * 16; ms[mm] = st[row]; const float* xp = x + (size_t)row * ldc + col0;
#pragma unroll
                for (int bj = 0; bj < 2; ++bj)
#pragma unroll
                    for (int n = 0; n < 2; ++n) r[mm][bj][n] = *(const f32x4*)(xp + bj * HALF + n * 16); }
#pragma unroll
            for (int mm = 0; mm < 2; ++mm) { const int m = 2 * mh + mm; const int row = row0 + ai * HALF + m * 16; float* op = out + (size_t)row * ldc + col0;
#pragma unroll
                for (int bj = 0; bj < 2; ++bj)
#pragma unroll
                    for (int n = 0; n < 2; ++n) { const f32x4 h = (r[mm][bj][n] - ms[mm].x) * ms[mm].y * gg[bj][n] + bb[bj][n]; *(f32x4*)(op + bj * HALF + n * 16) = h * alpha + acc[ai][bj][m][n]; } }
            asm volatile("" ::: "memory");
          }
    }
};
struct EpiFinal {
    static constexpr bool PERM = false, AFTER_DRAIN = false;
    float* out; int ldc; const f16_t* h2; const f16_t* pw; const float* rowrs; const float* g;
    __device__ __forceinline__ void operator()(const f32x4 (&acc)[2][2][4][2], const Unit& u, int wr, int wc, int fr, int fq) const {
        typedef _Float16 h4_t __attribute__((ext_vector_type(4)));
        const int row0 = u.pm * BM + wr * 64 + fr; const int col0 = u.pn * BM + wc * 32 + 4 * fq;
        f32x4 gv[2][2];
#pragma unroll
        for (int bj = 0; bj < 2; ++bj)
#pragma unroll
            for (int n = 0; n < 2; ++n) gv[bj][n] = *(const f32x4*)(g + col0 + bj * HALF + n * 16);
#pragma unroll
        for (int ai = 0; ai < 2; ++ai)
#pragma unroll
          for (int mh = 0; mh < 2; ++mh) {
            h4_t hv[2][2][2], pv[2][2][2]; float rs[2];
#pragma unroll
            for (int mm = 0; mm < 2; ++mm) { const int row = row0 + ai * HALF + (2 * mh + mm) * 16; const size_t off = (size_t)row * ldc + col0; rs[mm] = rowrs[row];
#pragma unroll
                for (int bj = 0; bj < 2; ++bj)
#pragma unroll
                    for (int n = 0; n < 2; ++n) { hv[mm][bj][n] = *(const h4_t*)(h2 + off + bj * HALF + n * 16); pv[mm][bj][n] = *(const h4_t*)(pw + off + bj * HALF + n * 16); } }
#pragma unroll
            for (int mm = 0; mm < 2; ++mm) { const int m = 2 * mh + mm; const int row = row0 + ai * HALF + m * 16; const size_t off = (size_t)row * ldc + col0;
#pragma unroll
                for (int bj = 0; bj < 2; ++bj)
#pragma unroll
                    for (int n = 0; n < 2; ++n) { const f32x4 a = acc[ai][bj][m][n]; f32x4 o;
#pragma unroll
                        for (int c = 0; c < 4; ++c) o[c] = (float)hv[mm][bj][n][c] + (1.f / (1.f + __expf(-a[c]))) * ((float)pv[mm][bj][n][c] * rs[mm]) * gv[bj][n][c];
                        *(f32x4*)(out + off + bj * HALF + n * 16) = o; } }
            asm volatile("" ::: "memory");
          }
    }
};

struct EpiGU {
    static constexpr bool PERM = true, AFTER_DRAIN = false;
    f16_t* O;
    __device__ __forceinline__ void operator()(const f32x4 (&acc)[2][2][4][2], const Unit& u, int wr, int wc, int fr, int fq) const {
        const int row0 = u.pm * BM + wr * 64 + fr; const int col0 = u.pn * HALF + wc * 32 + 8 * fq;
#pragma unroll
        for (int ai = 0; ai < 2; ++ai)
#pragma unroll
            for (int m = 0; m < 4; ++m) { f16_t* rowp = O + (size_t)(row0 + ai * HALF + m * 16) * 512 + col0; float o[8];
#pragma unroll
                for (int n = 0; n < 2; ++n)
#pragma unroll
                    for (int c = 0; c < 4; ++c) { const float gt = acc[ai][0][m][n][c], up = acc[ai][1][m][n][c]; o[n * 4 + c] = gt / (1.f + __expf(-gt)) * up; }
                u32x4 w; w.x = cvt_pk_f16(o[0], o[1]); w.y = cvt_pk_f16(o[2], o[3]); w.z = cvt_pk_f16(o[4], o[5]); w.w = cvt_pk_f16(o[6], o[7]);
                *(u32x4*)rowp = w; }
    }
};
struct EpiDown {
    static constexpr bool PERM = true, AFTER_DRAIN = false;
    f16_t* O; const int* lpair;
    __device__ __forceinline__ void operator()(const f32x4 (&acc)[2][2][4][2], const Unit& u, int wr, int wc, int fr, int fq) const {
        const int r0 = u.rb * BM + wr * 64 + fr; const int col0 = u.pn * BM + wc * 32 + 8 * fq;
#pragma unroll
        for (int ai = 0; ai < 2; ++ai)
#pragma unroll
            for (int m = 0; m < 4; ++m) { const int r = r0 + ai * HALF + m * 16;
                if (r < u.cnt) { const int pair = lpair[u.e * 8192 + r]; f16_t* rowp = O + (size_t)pair * 2048 + col0;
#pragma unroll
                    for (int bj = 0; bj < 2; ++bj) { const f32x4 v0 = acc[ai][bj][m][0], v1 = acc[ai][bj][m][1];
                        u32x4 w; w.x = cvt_pk_f16(v0[0], v0[1]); w.y = cvt_pk_f16(v0[2], v0[3]); w.z = cvt_pk_f16(v1[0], v1[1]); w.w = cvt_pk_f16(v1[2], v1[3]);
                        *(u32x4*)(rowp + bj * HALF) = w; } } }
    }
};
template <class Epi, class Sched, bool ALIGN_EPI = false, bool SP2 = true>
__device__ __forceinline__ void gemm_phase(PG8_LAS unsigned char* lds, const Gemm g, const Sched& S, const Epi& E, const int wid) {
    static_assert(SP2, "only the SP2 K-loop is kept in this file");
    const int lane = lane_id(), tid = wid * 64 + lane, wr = wid >> 2, wc = wid & 3, fr = lane & 15, fq = lane >> 4;
    const int K = g.ld, nt = g.K / BK;
    unsigned voffB[2];
#pragma unroll
    for (int i = 0; i < 2; ++i) { int R, C; stage_rc(tid * 16 + i * 8192, R, C); const int Rb = Epi::PERM ? ((R & ~31) + perm32(R & 31)) : R;
        voffB[i] = (unsigned)(Rb * K + C) * 2u; }
    const size_t kstep = (size_t)(BK * 2);
    const size_t hstep = (size_t)HALF * K * 2;
    const unsigned ldsw = (unsigned)wid * 1024u;
    const int aoff = lds_byte(wr * 64 + fr, fq * 8), boff = lds_byte(wc * 32 + fr, fq * 8);
#define PG8_SA(b, h) (((b) * 2 + (h)) * HTB)
#define PG8_SB(b, h) ((4 + (b) * 2 + (h)) * HTB)
#define PG8_STAGE(bufoff, gbase, voff) do { _Pragma("unroll") for (int _i = 0; _i < 2; ++_i) \
        __builtin_amdgcn_global_load_lds((const unsigned*)((const char*)(gbase) + (voff)[_i]), (PG8_LAS unsigned*)(lds + (bufoff) + ldsw + _i * 8192), 16, 0, 0); } while (0)
#define PG8_LDA(dst, b, h) do { _Pragma("unroll") for (int m = 0; m < 4; ++m) _Pragma("unroll") for (int k = 0; k < 2; ++k) dst[m][k] = *(const PG8_LAS f16x8*)(lds + PG8_SA(b, h) + aoff + m * 2048 + k * 1024); } while (0)
#define PG8_LDB(dst, b, h) do { _Pragma("unroll") for (int n = 0; n < 2; ++n) _Pragma("unroll") for (int k = 0; k < 2; ++k) dst[n][k] = *(const PG8_LAS f16x8*)(lds + PG8_SB(b, h) + boff + n * 2048 + k * 1024); } while (0)
#define PG8_MMA(ai, bj, At, Bt) do { __builtin_amdgcn_s_setprio(1); _Pragma("unroll") for (int m = 0; m < 4; ++m) _Pragma("unroll") for (int n = 0; n < 2; ++n) _Pragma("unroll") for (int k = 0; k < 2; ++k) \
        acc[ai][bj][m][n] = __builtin_amdgcn_mfma_f32_16x16x32_f16(Bt[n][k], At[m][k], acc[ai][bj][m][n], 0, 0, 0); __builtin_amdgcn_s_setprio(0); } while (0)
#define PG8_WAIT_V(n) asm volatile("s_waitcnt vmcnt(" #n ")" ::: "memory")
#define PG8_WAIT_L(n) asm volatile("s_waitcnt lgkmcnt(" #n ")" ::: "memory")
#define PG8_BAR __builtin_amdgcn_s_barrier()
#define PG8_SCHED __builtin_amdgcn_sched_barrier(0)
    Unit cur, nxt; int ui = 0;
    if (!S.next(0, cur)) return;
    f32x4 acc[2][2][4][2];
#pragma unroll
    for (int a = 0; a < 2; ++a)
#pragma unroll
        for (int b = 0; b < 2; ++b)
#pragma unroll
            for (int m = 0; m < 4; ++m)
#pragma unroll
                for (int n = 0; n < 2; ++n) acc[a][b][m][n] = (f32x4){0.f, 0.f, 0.f, 0.f};
    f16x8 At[4][2], B0[2][2], B1[2][2];
    const char* cA = S.a_base(g, cur); const char* cB = S.b_base(g, cur);
    unsigned vaC[2][2];
    S.a_voff(g, cur, tid, vaC);
    S.a_ready(cur);
    PG8_STAGE(PG8_SB(0, 0), cB, voffB); PG8_STAGE(PG8_SB(0, 1), cB + hstep, voffB); PG8_STAGE(PG8_SA(0, 0), cA, vaC[0]); PG8_STAGE(PG8_SA(0, 1), cA, vaC[1]);
    if (wr == 1) PG8_BAR;
    PG8_WAIT_V(2); PG8_BAR;
    PG8_STAGE(PG8_SB(1, 0), cB + kstep, voffB); PG8_STAGE(PG8_SA(1, 0), cA + kstep, vaC[0]); PG8_STAGE(PG8_SB(1, 1), cB + hstep + kstep, voffB);
    PG8_WAIT_V(6); PG8_BAR;
    for (;;) {
        const bool has_next = S.next(ui + 1, nxt);
        const char* nA = has_next ? S.a_base(g, nxt) : cA; const char* nB = has_next ? S.b_base(g, nxt) : cB;
        for (int t = 0; t < nt; t += 2) {
            const bool last = (t == nt - 2);

            const char* a1 = cA + (size_t)(t + 1) * kstep;
            const char* a2 = last ? nA : cA + (size_t)(t + 2) * kstep; const char* b2 = last ? nB : cB + (size_t)(t + 2) * kstep;
            const char* a3 = a2 + kstep; const char* b3 = b2 + kstep;
            if (last && has_next) S.a_ready(nxt);
            PG8_LDB(B0, 0, 0); PG8_LDB(B1, 0, 1); PG8_SCHED; PG8_LDA(At, 0, 0); PG8_STAGE(PG8_SA(1, 1), a1, vaC[1]);
            if (last && has_next) S.a_voff(g, nxt, wid * 64 + lane_id(), vaC);
            PG8_WAIT_V(8); PG8_WAIT_L(0); PG8_BAR; PG8_MMA(0, 0, At, B0); PG8_MMA(0, 1, At, B1); PG8_BAR; PG8_SCHED;
            PG8_LDA(At, 0, 1); PG8_STAGE(PG8_SB(0, 0), b2, voffB); PG8_STAGE(PG8_SB(0, 1), b2 + hstep, voffB); PG8_STAGE(PG8_SA(0, 0), a2, vaC[0]);
            PG8_WAIT_V(8); PG8_WAIT_L(0); PG8_BAR; PG8_MMA(1, 0, At, B0); PG8_MMA(1, 1, At, B1); PG8_BAR; PG8_SCHED;
            PG8_LDB(B0, 1, 0); PG8_LDB(B1, 1, 1); PG8_SCHED; PG8_LDA(At, 1, 0); PG8_STAGE(PG8_SA(0, 1), a2, vaC[1]);
            PG8_WAIT_V(8); PG8_WAIT_L(0); PG8_BAR; PG8_MMA(0, 0, At, B0); PG8_MMA(0, 1, At, B1); PG8_BAR; PG8_SCHED;
            PG8_LDA(At, 1, 1); PG8_STAGE(PG8_SB(1, 0), b3, voffB); PG8_STAGE(PG8_SB(1, 1), b3 + hstep, voffB); PG8_STAGE(PG8_SA(1, 0), a3, vaC[0]);
            PG8_WAIT_V(8); PG8_WAIT_L(0); PG8_BAR; PG8_MMA(1, 0, At, B0); PG8_MMA(1, 1, At, B1); PG8_BAR; PG8_SCHED;
        }
        if constexpr (ALIGN_EPI) { if (wr == 0) PG8_BAR; }
        { const int l2 = lane_id(); E(acc, cur, wr, wc, l2 & 15, l2 >> 4); } S.done(cur);
        if (!has_next) break;
#pragma unroll
        for (int a = 0; a < 2; ++a)
#pragma unroll
            for (int b = 0; b < 2; ++b)
#pragma unroll
                for (int m = 0; m < 4; ++m)
#pragma unroll
                    for (int n = 0; n < 2; ++n) acc[a][b][m][n] = (f32x4){0.f, 0.f, 0.f, 0.f};
        cur = nxt; cA = nA; cB = nB; ++ui;
        if constexpr (ALIGN_EPI) { if (wr == 1) PG8_BAR; }
    }
    PG8_WAIT_V(0);
    if constexpr (!ALIGN_EPI) { if (wr == 0) PG8_BAR; }
    PG8_BAR;
#undef PG8_SA
#undef PG8_SB
#undef PG8_STAGE
#undef PG8_LDA
#undef PG8_LDB
#undef PG8_MMA
#undef PG8_WAIT_V
#undef PG8_WAIT_L
#undef PG8_BAR
#undef PG8_SCHED
}
}

constexpr int PN = 6656;
namespace att {
#define ALAS __attribute__((address_space(3)))
typedef _Float16 f16x8 __attribute__((ext_vector_type(8)));
typedef float f32x16 __attribute__((ext_vector_type(16)));
typedef short v4i16_t __attribute__((ext_vector_type(4)));
typedef unsigned u32x4 __attribute__((ext_vector_type(4)));
constexpr int SLOT = 16384, L_K = 0, L_V = 3 * SLOT, L_SCR = 6 * SLOT, L_TAB = L_SCR + 2048, L_END = L_TAB + 1024;
constexpr int L_XB = 0, L_STG = 65536;
constexpr float LOG2E = 1.4426950408889634f;
constexpr float C2 = 0.125f * LOG2E;
__device__ __forceinline__ int crow(int r, int hi) { return (r & 3) + 8 * (r >> 2) + 4 * hi; }
__device__ __forceinline__ void glds16(const void* g, ALAS unsigned char* l) { __builtin_amdgcn_global_load_lds((const unsigned*)g, (ALAS unsigned*)l, 16, 0, 0); }
__device__ __forceinline__ float xhalf(float v, int hi) { auto rr = __builtin_amdgcn_permlane32_swap(__float_as_uint(v), __float_as_uint(v), false, false); return hi ? __uint_as_float(rr[0]) : __uint_as_float(rr[1]); }
__device__ __forceinline__ unsigned pkh(float lo, float hi) { typedef _Float16 h2 __attribute__((ext_vector_type(2))); h2 v = {(_Float16)lo, (_Float16)hi}; return __builtin_bit_cast(unsigned, v); }
__device__ __forceinline__ v4i16_t vtr(const ALAS unsigned char* p) { return __builtin_amdgcn_ds_read_tr16_b64_v4i16((ALAS v4i16_t*)p); }

typedef int vfrag_t __attribute__((ext_vector_type(2)));
#define VFRAG vfrag_t
template <int OFF> __device__ __forceinline__ void vtr_asm(vfrag_t& r, unsigned a) { asm volatile("ds_read_b64_tr_b16 %0, %1 offset:%2" : "=v"(r) : "v"(a), "n"(OFF) : "memory"); }
#define VLOADS(vb, s_) do { vtr_asm<(0 * 4 + (s_)) * 1024>(vb[0], vsa); vtr_asm<(0 * 4 + (s_)) * 1024 + 512>(vb[1], vsa); vtr_asm<(1 * 4 + (s_)) * 1024>(vb[2], vsa); vtr_asm<(1 * 4 + (s_)) * 1024 + 512>(vb[3], vsa); \
        vtr_asm<(2 * 4 + (s_)) * 1024>(vb[4], vsa); vtr_asm<(2 * 4 + (s_)) * 1024 + 512>(vb[5], vsa); vtr_asm<(3 * 4 + (s_)) * 1024>(vb[6], vsa); vtr_asm<(3 * 4 + (s_)) * 1024 + 512>(vb[7], vsa); } while (0)
#define VWAIT(n, vb) asm volatile("s_waitcnt lgkmcnt(" #n ")" : "+v"(vb[0]), "+v"(vb[1]), "+v"(vb[2]), "+v"(vb[3]), "+v"(vb[4]), "+v"(vb[5]), "+v"(vb[6]), "+v"(vb[7]) :: "memory")
#define SBAR_() __builtin_amdgcn_sched_barrier(0)
#define PVSTEP(s_, d_, vb, FILL_) do { typedef int i32x4_ __attribute__((ext_vector_type(4))); const i32x4_ bv_ = {vb[2 * (d_)][0], vb[2 * (d_)][1], vb[2 * (d_) + 1][0], vb[2 * (d_) + 1][1]}; \
        o[d_] = __builtin_amdgcn_mfma_f32_32x32x16_f16(__builtin_bit_cast(f16x8, pw[s_]), __builtin_bit_cast(f16x8, bv_), o[d_], 0, 0, 0); FILL_; SBAR_(); } while (0)
#define PFILL(c_, i_) do { const float e0_ = __builtin_amdgcn_exp2f(((c_) < 2 ? p0 : p1)[8 * ((c_) & 1) + 2 * (i_)]), e1_ = __builtin_amdgcn_exp2f(((c_) < 2 ? p0 : p1)[8 * ((c_) & 1) + 2 * (i_) + 1]); \
        sacc += e0_ + e1_; pw[c_][i_] = pkh(e0_, e1_); asm volatile("" : "+v"(pw[c_])); } while (0)
#define PNOFILL do { } while (0)
template <int THR>
__device__ __forceinline__ void attn_unit(ALAS unsigned char* lds, const int wave, const int b, const int h, const int qb, const unsigned short* PROJ, unsigned short* Y,
                                          const float* biasG, const float lam, const float* subln_g) {
    const int lane = pg8::lane_id(), r32 = lane & 31, hi = lane >> 5;
    const int c = wave >> 2, w4 = wave & 3;
    const int q0 = qb * 128, qw0 = q0 + 32 * w4, q = qw0 + r32;
    const size_t rowbase = (size_t)b * S;
    { ALAS float* tabL = (ALAS float*)(lds + L_TAB); const int tid = wave * 64 + lane; if (tid < 129) tabL[tid] = biasG[tid] * LOG2E; }
    f16x8 qf[4];
    { const unsigned short* Qp = PROJ + (rowbase + q) * PN + h * 128 + c * 64 + hi * 8;
#pragma unroll
      for (int d0 = 0; d0 < 4; ++d0) qf[d0] = *(const f16x8*)(Qp + d0 * 16); }
    const int krow0 = 8 * wave + (lane >> 4), krow1 = krow0 + 4;
    const unsigned short* ksrc0 = PROJ + (rowbase + krow0) * PN + 1024 + h * 128 + (((lane & 15) ^ (krow0 & 15)) * 8);
    const unsigned short* ksrc1 = PROJ + (rowbase + krow1) * PN + 1024 + h * 128 + (((lane & 15) ^ (krow1 & 15)) * 8);
    const unsigned short* vsrc0 = PROJ + (rowbase + 16 * ((2 * wave) & 3) + (lane >> 2)) * PN + 2048 + h * 128 + 32 * ((2 * wave) >> 2) + (lane & 3) * 8;
    ALAS unsigned char* kdst = lds + L_K + (2 * wave) * 1024; ALAS unsigned char* vdst = lds + L_V + (2 * wave) * 1024;
#define ATT_ISSUE(t, slot) do { const size_t go_ = (size_t)(t) * 64 * PN; \
        glds16(ksrc0 + go_, kdst + (slot) * SLOT); glds16(ksrc1 + go_, kdst + (slot) * SLOT + 1024); \
        glds16(vsrc0 + go_, vdst + (slot) * SLOT); glds16(vsrc0 + go_ + (size_t)16 * PN, vdst + (slot) * SLOT + 1024); } while (0)
    const int NT = (q0 + 128) / 64;
    ATT_ISSUE(0, 0); ATT_ISSUE(1, 1);
    ALAS float* wsf = (ALAS float*)(lds + L_SCR) + wave * 64;
    const ALAS float* tabL = (const ALAS float*)(lds + L_TAB);
    const float bfar = biasG[128] * LOG2E;
    float mhat = 0.f, l = 0.f;
    f32x16 o[4];
#pragma unroll
    for (int d = 0; d < 4; ++d)
#pragma unroll
        for (int r = 0; r < 16; ++r) o[d][r] = 0.f;
    f32x16 negm;
#pragma unroll
    for (int r = 0; r < 16; ++r) negm[r] = bfar;
    int slot = 0;
    for (int t = 0; t < NT; ++t) {
        if (t + 1 < NT) asm volatile("s_waitcnt vmcnt(4)" ::: "memory"); else asm volatile("s_waitcnt vmcnt(0)" ::: "memory");
        __builtin_amdgcn_s_barrier();
        asm volatile("" ::: "memory");
        if (t + 2 < NT) { const int s2 = slot == 0 ? 2 : slot - 1; ATT_ISSUE(t + 2, s2); }
        const int k0 = t * 64;
        if (k0 <= qw0 + 31) {
            const ALAS unsigned char* Ks = lds + L_K + slot * SLOT + r32 * 256;
            const int kx = r32 & 15, kc0 = 8 * c + hi;
            const int ko[4] = {((kc0 + 0) ^ kx) << 4, ((kc0 + 2) ^ kx) << 4, ((kc0 + 4) ^ kx) << 4, ((kc0 + 6) ^ kx) << 4};
            const unsigned vsa = (unsigned)(__UINTPTR_TYPE__)(lds + L_V + slot * SLOT + (4 * hi + ((lane & 15) >> 2)) * 64 + ((lane >> 4) & 1) * 32 + (lane & 3) * 8);
            f16x8 ka[8];
#pragma unroll
            for (int d0 = 0; d0 < 4; ++d0) { ka[2 * d0] = *(const ALAS f16x8*)(Ks + ko[d0]); ka[2 * d0 + 1] = *(const ALAS f16x8*)(Ks + ko[d0] + 8192); }
            f32x16 p0, p1;
            const bool nearb = (k0 + 63 + 128 > qw0);
            if (nearb) {
                f32x16 c0, c1;
#pragma unroll
                for (int r = 0; r < 16; ++r) { int rel = q - (k0 + crow(r, hi)); int i0 = rel < 0 ? 0 : (rel > 128 ? 128 : rel); int rel1 = rel - 32; int i1 = rel1 < 0 ? 0 : (rel1 > 128 ? 128 : rel1);
                    c0[r] = tabL[i0] - mhat; c1[r] = tabL[i1] - mhat; }
#pragma unroll
                for (int d0 = 0; d0 < 4; ++d0) {
                    p0 = __builtin_amdgcn_mfma_f32_32x32x16_f16(ka[2 * d0], qf[d0], d0 == 0 ? c0 : p0, 0, 0, 0); p1 = __builtin_amdgcn_mfma_f32_32x32x16_f16(ka[2 * d0 + 1], qf[d0], d0 == 0 ? c1 : p1, 0, 0, 0); }
                if (k0 + 63 > qw0) {
#pragma unroll
                    for (int r = 0; r < 16; ++r) { const int kv = k0 + crow(r, hi); if (kv > q) p0[r] = -INFINITY; if (kv + 32 > q) p1[r] = -INFINITY; }
                }
            } else {
#pragma unroll
                for (int d0 = 0; d0 < 4; ++d0) {
                    p0 = __builtin_amdgcn_mfma_f32_32x32x16_f16(ka[2 * d0], qf[d0], d0 == 0 ? negm : p0, 0, 0, 0); p1 = __builtin_amdgcn_mfma_f32_32x32x16_f16(ka[2 * d0 + 1], qf[d0], d0 == 0 ? negm : p1, 0, 0, 0); }
            }
            VFRAG vb0[8], vb1[8];
            VLOADS(vb0, 0);
            float rm = fmaxf(p0[0], p1[0]);
#pragma unroll
            for (int r = 1; r < 16; ++r) rm = fmaxf(rm, fmaxf(p0[r], p1[r]));
            rm = fmaxf(rm, xhalf(rm, hi));
            const bool first = (t == 0);
            if (first || __any(rm > (float)THR)) {
                const float dl = first ? rm : fmaxf(rm, 0.f);
                mhat += dl;
#pragma unroll
                for (int r = 0; r < 16; ++r) { p0[r] -= dl; p1[r] -= dl; }
#pragma unroll
                for (int r = 0; r < 16; ++r) negm[r] = bfar - mhat;
                if (!first) {
                    const float f = __builtin_amdgcn_exp2f(-dl); l *= f;
                    if (hi == 0) wsf[r32] = f;
                    asm volatile("s_waitcnt lgkmcnt(0)" ::: "memory");
#pragma unroll
                    for (int r = 0; r < 16; ++r) { const float fr_ = wsf[crow(r, hi)];
#pragma unroll
                        for (int d = 0; d < 4; ++d) o[d][r] *= fr_; }
                }
            }
            float sacc = 0.f;
            u32x4 pw[4];
            PFILL(0, 0); PFILL(0, 1); PFILL(0, 2); PFILL(0, 3);
            SBAR_();
            VLOADS(vb1, 1); VWAIT(8, vb0);
            PVSTEP(0, 0, vb0, PFILL(1, 0)); PVSTEP(0, 1, vb0, PFILL(1, 1)); PVSTEP(0, 2, vb0, PFILL(1, 2)); PVSTEP(0, 3, vb0, PFILL(1, 3));
            VLOADS(vb0, 2); VWAIT(8, vb1);
            PVSTEP(1, 0, vb1, PFILL(2, 0)); PVSTEP(1, 1, vb1, PFILL(2, 1)); PVSTEP(1, 2, vb1, PFILL(2, 2)); PVSTEP(1, 3, vb1, PFILL(2, 3));
            VLOADS(vb1, 3); VWAIT(8, vb0);
            PVSTEP(2, 0, vb0, PFILL(3, 0)); PVSTEP(2, 1, vb0, PFILL(3, 1)); PVSTEP(2, 2, vb0, PFILL(3, 2)); PVSTEP(2, 3, vb0, PFILL(3, 3));
            VWAIT(0, vb1);
            PVSTEP(3, 0, vb1, PNOFILL); PVSTEP(3, 1, vb1, PNOFILL); PVSTEP(3, 2, vb1, PNOFILL); PVSTEP(3, 3, vb1, PNOFILL);
            l += sacc;
        }
        slot = slot == 2 ? 0 : slot + 1;
    }
#undef ATT_ISSUE
    l += xhalf(l, hi);
    if (hi == 0) wsf[r32] = 1.0f / l;
    asm volatile("s_waitcnt lgkmcnt(0)" ::: "memory");
#pragma unroll
    for (int r = 0; r < 16; ++r) { const float f = wsf[crow(r, hi)];
#pragma unroll
        for (int d = 0; d < 4; ++d) o[d][r] *= f; }
    asm volatile("s_waitcnt lgkmcnt(0)" ::: "memory"); __builtin_amdgcn_s_barrier(); asm volatile("" ::: "memory");
    ALAS float* xb = (ALAS float*)(lds + L_XB) + w4 * 4096 + lane;
    if (c == 1) {
#pragma unroll
        for (int d = 0; d < 4; ++d)
#pragma unroll
            for (int r = 0; r < 16; ++r) xb[(d * 16 + r) * 64] = o[d][r];
    }
    asm volatile("s_waitcnt lgkmcnt(0)" ::: "memory"); __builtin_amdgcn_s_barrier(); asm volatile("" ::: "memory");
    if (c == 0) {
        float sc[16];
#pragma unroll
        for (int r = 0; r < 16; ++r) { float ss = 0.f;
#pragma unroll
            for (int d = 0; d < 4; ++d) { o[d][r] -= lam * xb[(d * 16 + r) * 64]; ss += o[d][r] * o[d][r]; }
            ss += __shfl_xor(ss, 1); ss += __shfl_xor(ss, 2); ss += __shfl_xor(ss, 4); ss += __shfl_xor(ss, 8); ss += __shfl_xor(ss, 16);
            sc[r] = __builtin_amdgcn_rsqf(ss * (1.f / 128.f) + LN_EPS) * (1.f - LAMBDA_INIT); }
        ALAS _Float16* stg = (ALAS _Float16*)(lds + L_STG + w4 * 8192);
#pragma unroll
        for (int d = 0; d < 4; ++d) { const float gg = subln_g[32 * d + r32];
#pragma unroll
            for (int r = 0; r < 16; ++r) stg[crow(r, hi) * 128 + 32 * d + r32] = (_Float16)(o[d][r] * sc[r] * gg); }
        asm volatile("s_waitcnt lgkmcnt(0)" ::: "memory");
        unsigned short* Yw = Y + (rowbase + qw0) * D + h * 128;
#pragma unroll
        for (int i = 0; i < 8; ++i) { const int row = i * 4 + (lane >> 4), ch = lane & 15; const u32x4 v = *(const ALAS u32x4*)((const ALAS unsigned char*)stg + row * 256 + ch * 16);
            *(u32x4*)(Yw + (size_t)row * D + ch * 8) = v; }
    }
    asm volatile("s_waitcnt lgkmcnt(0)" ::: "memory"); __builtin_amdgcn_s_barrier(); asm volatile("" ::: "memory");
}
#undef ALAS
}

namespace rk {
#define RLAS __attribute__((address_space(3)))
#define RGAS __attribute__((address_space(1)))
typedef __bf16 bf16x8 __attribute__((ext_vector_type(8)));
typedef _Float16 f16x8 __attribute__((ext_vector_type(8)));
typedef float f32x16 __attribute__((ext_vector_type(16)));
typedef float f32x4 __attribute__((ext_vector_type(4)));
typedef unsigned u32x4 __attribute__((ext_vector_type(4)));
typedef unsigned short us8 __attribute__((ext_vector_type(8)));
constexpr int C = 32;
constexpr int TS = 144, CS = 80;
constexpr int O_AT = 0, O_RT = 4608, O_BT = 9216, O_KT = 13824;
constexpr int O_AAB = 0, O_AAK = 4608, O_ARB = 7168, O_ARK = 9728;
constexpr int O_PIMG = 0, O_QIMG = 8192;
constexpr int O_VT = 18432, O_KH = 23552, O_BH = 28672;
constexpr int O_X0 = 33792;
constexpr int O_RH = 50688;
constexpr int O_GAM = 55296;
constexpr int HALF_BYTES = 57344;
constexpr int CHK_BYTES = 24576, CK_P = 0, CK_Q = 8192, CK_G = 12288, CK_Y = 20480;
__device__ __forceinline__ int crow(int r, int hi) { return (r & 3) + 8 * (r >> 2) + 4 * hi; }
__device__ __forceinline__ unsigned pkb(float lo, float hi) { typedef float f2 __attribute__((ext_vector_type(2))); typedef __bf16 b2 __attribute__((ext_vector_type(2))); f2 v = {lo, hi}; b2 w = __builtin_convertvector(v, b2); return __builtin_bit_cast(unsigned, w); }
__device__ __forceinline__ unsigned pkh(float lo, float hi) { typedef _Float16 h2 __attribute__((ext_vector_type(2))); h2 v = {(_Float16)lo, (_Float16)hi}; return __builtin_bit_cast(unsigned, v); }
__device__ __forceinline__ float h2f(unsigned short u) { return (float)__builtin_bit_cast(_Float16, u); }
__device__ __forceinline__ unsigned short f2h(float f) { return __builtin_bit_cast(unsigned short, (_Float16)f); }
__device__ __forceinline__ float sum8(float x) {
    x += __builtin_bit_cast(float, __builtin_amdgcn_update_dpp(0, __builtin_bit_cast(int, x), 0xB1, 0xF, 0xF, true));
    x += __builtin_bit_cast(float, __builtin_amdgcn_update_dpp(0, __builtin_bit_cast(int, x), 0x4E, 0xF, 0xF, true));
    x += __builtin_bit_cast(float, __builtin_amdgcn_update_dpp(0, __builtin_bit_cast(int, x), 0x141, 0xF, 0xF, true));
    return x;
}
__device__ __forceinline__ int frag_pos(int m, int c) { return (((c >> 4) * 64 + m + 32 * ((c >> 2) & 1)) * 8) + ((c >> 3) & 1) * 4 + (c & 3); }

struct ChunkIn { f32x4 l0, l1; us8 a8, b8, k8, rc, rp, vc, vp; };
__device__ __forceinline__ void chunk_load(ChunkIn& in, int tglob, int pos, int chb, const unsigned char* ws) {
    const unsigned short* PROJ16 = (const unsigned short*)(ws + WS_PROJ16); const float* LW = (const float*)(ws + WS_DECAY); const unsigned short* KMOD = (const unsigned short*)(ws + WS_KMOD);
    const unsigned short* A16 = (const unsigned short*)(ws + WS_A16); const unsigned short* B16 = (const unsigned short*)(ws + WS_B16);
    in.l0 = *(const RGAS f32x4*)(LW + (size_t)tglob * RWK + chb); in.l1 = *(const RGAS f32x4*)(LW + (size_t)tglob * RWK + chb + 4);
    in.a8 = *(const RGAS us8*)(A16 + (size_t)tglob * RWK + chb); in.b8 = *(const RGAS us8*)(B16 + (size_t)tglob * RWK + chb); in.k8 = *(const RGAS us8*)(KMOD + (size_t)tglob * RWK + chb);
    const unsigned short* cur = PROJ16 + (size_t)tglob * PN + 3072 + chb;
    in.rc = *(const RGAS us8*)cur; in.vc = *(const RGAS us8*)(cur + 2048); in.rp = in.rc; in.vp = in.vc; if (pos > 0) { in.rp = *(const RGAS us8*)(cur - PN); in.vp = *(const RGAS us8*)(cur - PN + 2048); }
}
__device__ __forceinline__ void chunk_pair(RLAS unsigned char* lds, const int wave, const int tile, const int hA, ChunkIn& in, const bool has_next, const float* mu, const float* r_k, unsigned char* ws) {
    unsigned char* CHK = ws + WS_CHK; float* BONUS = (float*)(ws + WS_BONUS);
    const int lane = pg8::lane_id(), hf = wave >> 2, q = wave & 3, r32 = lane & 31, hi = lane >> 5;
    const int h = hA + hf;
    RLAS unsigned char* L = lds + hf * HALF_BYTES;
    const int t = q * 64 + lane;
    const int tok = t >> 3, c8 = (t & 7) * 8;
    const int tglob = tile * C + tok, pos = tglob & (S - 1), bidx = tglob >> 11;
    const int chb = h * 64 + c8;
    float lw[8], av[8], bv[8], kv[8], rv[8], vv[8];
    { lw[0] = in.l0.x; lw[1] = in.l0.y; lw[2] = in.l0.z; lw[3] = in.l0.w; lw[4] = in.l1.x; lw[5] = in.l1.y; lw[6] = in.l1.z; lw[7] = in.l1.w;
      const f32x4 m0 = *(const RGAS f32x4*)(mu + chb), m1 = *(const RGAS f32x4*)(mu + chb + 4), n0 = *(const RGAS f32x4*)(mu + 2048 + chb), n1 = *(const RGAS f32x4*)(mu + 2048 + chb + 4);
      const float mr[8] = {m0.x, m0.y, m0.z, m0.w, m1.x, m1.y, m1.z, m1.w}, mv[8] = {n0.x, n0.y, n0.z, n0.w, n1.x, n1.y, n1.z, n1.w};
#pragma unroll
      for (int i = 0; i < 8; ++i) { av[i] = h2f(in.a8[i]); bv[i] = h2f(in.b8[i]); kv[i] = h2f(in.k8[i]);
          const float rcf = h2f(in.rc[i]), rpf = pos > 0 ? h2f(in.rp[i]) : 0.f, vcf = h2f(in.vc[i]), vpf = pos > 0 ? h2f(in.vp[i]) : 0.f;
          rv[i] = rcf + (rpf - rcf) * mr[i]; vv[i] = vcf + (vpf - vcf) * mv[i]; } }
    { const f32x4 k0 = *(const RGAS f32x4*)(r_k + chb), k1 = *(const RGAS f32x4*)(r_k + chb + 4); const float rk8[8] = {k0.x, k0.y, k0.z, k0.w, k1.x, k1.y, k1.z, k1.w};
      float bs = 0.f;
#pragma unroll
      for (int i = 0; i < 8; ++i) bs += rv[i] * kv[i] * rk8[i];
      bs = sum8(bs); if ((t & 7) == 0) BONUS[(size_t)tglob * 16 + h] = bs; }
    RLAS float* lwL = (RLAS float*)(L + O_X0 + 64 * 132);
    __syncthreads();
#pragma unroll
    for (int i = 0; i < 8; ++i) lwL[tok * 65 + c8 + i] = lw[i];
    __syncthreads();
    { RLAS float* part = (RLAS float*)(L + O_GAM) + 64;
      const int ch = t & 63, seg = t >> 6; float sg = 0.f;
#pragma unroll
      for (int k = 0; k < 8; ++k) sg += lwL[(8 * seg + k) * 65 + ch];
      part[seg * 64 + ch] = sg;
      __syncthreads();
      float g = 0.f;
#pragma unroll
      for (int s2 = 0; s2 < 3; ++s2) if (s2 < seg) g += part[s2 * 64 + ch];
#pragma unroll
      for (int k = 0; k < 8; ++k) { g += lwL[(8 * seg + k) * 65 + ch]; lwL[(8 * seg + k) * 65 + ch] = g; } }
    __syncthreads();
    {
        float G[8], GL[8];
#pragma unroll
        for (int i = 0; i < 8; ++i) { G[i] = lwL[tok * 65 + c8 + i]; GL[i] = lwL[31 * 65 + c8 + i]; }
        float at[8], rt[8], bt[8], kt[8], bh[8], kh[8];
#pragma unroll
        for (int i = 0; i < 8; ++i) { const float eg = __expf(G[i]), eng = __expf(-G[i]), egm = __expf(G[i] - lw[i]), egl = __expf(GL[i] - G[i]);
            at[i] = av[i] * egm; rt[i] = rv[i] * eg; bt[i] = bv[i] * eng; kt[i] = kv[i] * eng; bh[i] = bv[i] * egl; kh[i] = kv[i] * egl; }
        *(RLAS u32x4*)(L + O_AT + tok * TS + c8 * 2) = (u32x4){pkb(at[0], at[1]), pkb(at[2], at[3]), pkb(at[4], at[5]), pkb(at[6], at[7])};
        *(RLAS u32x4*)(L + O_RT + tok * TS + c8 * 2) = (u32x4){pkb(rt[0], rt[1]), pkb(rt[2], rt[3]), pkb(rt[4], rt[5]), pkb(rt[6], rt[7])};
        *(RLAS u32x4*)(L + O_BT + tok * TS + c8 * 2) = (u32x4){pkb(bt[0], bt[1]), pkb(bt[2], bt[3]), pkb(bt[4], bt[5]), pkb(bt[6], bt[7])};
        *(RLAS u32x4*)(L + O_KT + tok * TS + c8 * 2) = (u32x4){pkb(kt[0], kt[1]), pkb(kt[2], kt[3]), pkb(kt[4], kt[5]), pkb(kt[6], kt[7])};
        *(RLAS u32x4*)(L + O_RH + tok * TS + c8 * 2) = (u32x4){pkh(rt[0], rt[1]), pkh(rt[2], rt[3]), pkh(rt[4], rt[5]), pkh(rt[6], rt[7])};
#pragma unroll
        for (int i = 0; i < 8; ++i) { const int ch = c8 + i;
            *(RLAS unsigned short*)(L + O_VT + ch * CS + tok * 2) = f2h(vv[i]); *(RLAS unsigned short*)(L + O_KH + ch * CS + tok * 2) = f2h(kh[i]); *(RLAS unsigned short*)(L + O_BH + ch * CS + tok * 2) = f2h(bh[i]);
            ((RLAS float*)(L + O_X0))[ch * 33 + tok] = at[i];
            if (tok == C - 1) ((RLAS float*)(L + O_GAM))[ch] = __expf(GL[i]); }
    }
    __syncthreads();
    {
        const RLAS unsigned char* Lp = L + (q < 2 ? O_AT : O_RT) + r32 * TS + hi * 16; const RLAS unsigned char* Rp = L + ((q & 1) ? O_KT : O_BT) + r32 * TS + hi * 16;
        f32x16 acc;
#pragma unroll
        for (int r = 0; r < 16; ++r) acc[r] = 0.f;
#pragma unroll
        for (int ks = 0; ks < 4; ++ks) acc = __builtin_amdgcn_mfma_f32_32x32x16_bf16(*(const RLAS bf16x8*)(Lp + ks * 32), *(const RLAS bf16x8*)(Rp + ks * 32), acc, 0, 0, 0);
#pragma unroll
        for (int r = 0; r < 16; ++r) { const int tau = crow(r, hi); const bool keep = (q < 2) ? (r32 < tau) : (r32 <= tau); acc[r] = keep ? acc[r] : 0.f; }
        __syncthreads();
        if (q == 0) {
#pragma unroll
            for (int r = 0; r < 16; ++r) ((RLAS float*)(L + O_AAB))[r32 * 36 + crow(r, hi)] = acc[r];
        } else {
            RLAS unsigned char* o = L + (q == 1 ? O_AAK : (q == 2 ? O_ARB : O_ARK));
#pragma unroll
            for (int r = 0; r < 16; ++r) *(RLAS unsigned short*)(o + crow(r, hi) * CS + r32 * 2) = f2h(acc[r]);
        }
    }
    __syncthreads();
    const int J = q & 1, part = q >> 1;
    if (part == 1) {
        f32x16 accX;
#pragma unroll
        for (int r = 0; r < 16; ++r) accX[r] = 0.f;
        const RLAS unsigned char* Vp = L + O_VT + (32 * J + r32) * CS + hi * 16; const RLAS unsigned char* Ap = L + O_AAK + r32 * CS + hi * 16;
#pragma unroll
        for (int ks = 0; ks < 2; ++ks) accX = __builtin_amdgcn_mfma_f32_32x32x16_f16(*(const RLAS f16x8*)(Ap + ks * 32), *(const RLAS f16x8*)(Vp + ks * 32), accX, 0, 0, 0);
#pragma unroll
        for (int r = 0; r < 16; ++r) ((RLAS float*)(L + O_X0))[(64 + 32 * J + r32) * 33 + crow(r, hi)] = accX[r];
    }
    __syncthreads();
    float z[C];
    if (q < 2) {
        const RLAS float* xc = (const RLAS float*)(L + O_X0) + (64 * q + lane) * 33;
#pragma unroll
        for (int k = 0; k < C; ++k) z[k] = xc[k];
    }
    __syncthreads();
    if (q < 2) {
        const RLAS float* AabT = (const RLAS float*)(L + O_AAB);
#pragma unroll
        for (int sx = 0; sx < C - 1; ++sx) {
            const float zs = z[sx];
#pragma unroll
            for (int t4 = (sx + 1) / 4; t4 < C / 4; ++t4) { const f32x4 aa = *(const RLAS f32x4*)(AabT + sx * 36 + 4 * t4);
                if (4 * t4 + 0 > sx) z[4 * t4 + 0] = fmaf(aa.x, zs, z[4 * t4 + 0]); if (4 * t4 + 1 > sx) z[4 * t4 + 1] = fmaf(aa.y, zs, z[4 * t4 + 1]);
                if (4 * t4 + 2 > sx) z[4 * t4 + 2] = fmaf(aa.z, zs, z[4 * t4 + 2]); if (4 * t4 + 3 > sx) z[4 * t4 + 3] = fmaf(aa.w, zs, z[4 * t4 + 3]); }
        }
        RLAS unsigned char* zr = L + O_X0 + (64 * q + lane) * CS;
#pragma unroll
        for (int k8 = 0; k8 < 4; ++k8) *(RLAS u32x4*)(zr + k8 * 16) = (u32x4){pkh(z[8 * k8], z[8 * k8 + 1]), pkh(z[8 * k8 + 2], z[8 * k8 + 3]), pkh(z[8 * k8 + 4], z[8 * k8 + 5]), pkh(z[8 * k8 + 6], z[8 * k8 + 7])};
    }
    __syncthreads();
    f32x16 accQ, accP, accA, accB;
#pragma unroll
    for (int r = 0; r < 16; ++r) { accA[r] = 0.f; accB[r] = 0.f; }
    {
        const RLAS unsigned char* Vp = L + O_VT + (32 * J + r32) * CS + hi * 16;
        const RLAS unsigned char* Kp = L + O_KH + (32 * part + r32) * CS + hi * 16;
        const RLAS unsigned char* Ap = L + O_ARK + r32 * CS + hi * 16;
#pragma unroll
        for (int ks = 0; ks < 2; ++ks) { const f16x8 vf = *(const RLAS f16x8*)(Vp + ks * 32);
            if (part == 0) accA = __builtin_amdgcn_mfma_f32_32x32x16_f16(*(const RLAS f16x8*)(Ap + ks * 32), vf, accA, 0, 0, 0);
            accB = __builtin_amdgcn_mfma_f32_32x32x16_f16(*(const RLAS f16x8*)(Kp + ks * 32), vf, accB, 0, 0, 0); }
    }
    {
        const RLAS float* gam = (const RLAS float*)(L + O_GAM);
#pragma unroll
        for (int r = 0; r < 16; ++r) { const int m = crow(r, hi);
            accQ[r] = h2f(*(const RLAS unsigned short*)(L + O_RH + m * TS + (32 * J + r32) * 2));
            accP[r] = (J == part && m == r32) ? gam[32 * J + r32] : 0.f; }
        const RLAS unsigned char* Zw = L + O_X0 + (32 * J + r32) * CS + hi * 16; const RLAS unsigned char* Zu = Zw + 64 * CS;
        const RLAS unsigned char* Bp = L + O_BH + (32 * part + r32) * CS + hi * 16; const RLAS unsigned char* Rb = L + O_ARB + r32 * CS + hi * 16;
#pragma unroll
        for (int ks = 0; ks < 2; ++ks) { const f16x8 zw = *(const RLAS f16x8*)(Zw + ks * 32), zu = *(const RLAS f16x8*)(Zu + ks * 32), bf = *(const RLAS f16x8*)(Bp + ks * 32);
            accP = __builtin_amdgcn_mfma_f32_32x32x16_f16(bf, zw, accP, 0, 0, 0);
            accB = __builtin_amdgcn_mfma_f32_32x32x16_f16(bf, zu, accB, 0, 0, 0);
            if (part == 0) { const f16x8 rb = *(const RLAS f16x8*)(Rb + ks * 32);
                accQ = __builtin_amdgcn_mfma_f32_32x32x16_f16(rb, zw, accQ, 0, 0, 0);
                accA = __builtin_amdgcn_mfma_f32_32x32x16_f16(rb, zu, accA, 0, 0, 0); } }
    }
    __syncthreads();
    { int tg2 = tglob, cb2 = has_next ? chb + 128 : chb; asm volatile("" : "+v"(tg2), "+v"(cb2)); chunk_load(in, tg2, pos, cb2, ws); }
    unsigned char* rec = CHK + ((size_t)((bidx * 16 + h) * (S / C)) + (size_t)(pos >> 5)) * CHK_BYTES;
    { u32x4 w0, w1; w0 = (u32x4){pkh(accB[0], accB[1]), pkh(accB[2], accB[3]), pkh(accB[4], accB[5]), pkh(accB[6], accB[7])}; w1 = (u32x4){pkh(accB[8], accB[9]), pkh(accB[10], accB[11]), pkh(accB[12], accB[13]), pkh(accB[14], accB[15])};
      RGAS u32x4* g = (RGAS u32x4*)(rec + CK_G + ((part * 2 + J) * 64 + lane) * 32); g[0] = w0; g[1] = w1;
      if (part == 0) { w0 = (u32x4){pkh(accA[0], accA[1]), pkh(accA[2], accA[3]), pkh(accA[4], accA[5]), pkh(accA[6], accA[7])}; w1 = (u32x4){pkh(accA[8], accA[9]), pkh(accA[10], accA[11]), pkh(accA[12], accA[13]), pkh(accA[14], accA[15])};
          RGAS u32x4* y = (RGAS u32x4*)(rec + CK_Y + (J * 64 + lane) * 32); y[0] = w0; y[1] = w1; } }
    {
        RLAS unsigned short* pimg = (RLAS unsigned short*)(L + O_PIMG) + ((part * 2 + J) * 2) * 512;
        RLAS unsigned short* qimg = (RLAS unsigned short*)(L + O_QIMG) + (J * 2) * 512;
#pragma unroll
        for (int r = 0; r < 16; ++r) { const int fp = frag_pos(crow(r, hi), r32); pimg[fp] = f2h(accP[r]); if (part == 0) qimg[fp] = f2h(accQ[r]); }
    }
    __syncthreads();
    { const RLAS u32x4* src = (const RLAS u32x4*)(L + O_PIMG); RGAS u32x4* dst = (RGAS u32x4*)(rec + CK_P);
#pragma unroll
      for (int i = 0; i < 3; ++i) dst[i * 256 + t] = src[i * 256 + t]; }
}

__device__ __forceinline__ void scan_unit(RLAS unsigned char* lds, const int wave, const int bh, const unsigned char* CHK, const float* BONUS, const unsigned short* PROJ16, const float* mu,
                                          const unsigned short* G16, const float* lnx_g, const float* lnx_b, unsigned short* Y16) {
    const int lane = pg8::lane_id(), r32 = lane & 31, hi = lane >> 5;
    const int b = bh >> 4, h = bh & 15;
    RLAS float* ytile = (RLAS float*)lds;
    constexpr int RING0 = 18432, NSL = 4;
    const unsigned char* rec0 = CHK + (size_t)bh * (S / C) * CHK_BYTES;
    constexpr int NCH = S / C;
    __syncthreads();
    if (wave >= 6) {
        const int p0 = (wave - 6) * 12;
#define RK_DMA(c) do { const unsigned char* src_ = rec0 + (size_t)(c) * CHK_BYTES + p0 * 1024 + lane * 16; RLAS unsigned char* dst_ = lds + RING0 + ((c) & (NSL - 1)) * CHK_BYTES + p0 * 1024; \
            _Pragma("unroll") for (int j_ = 0; j_ < 12; ++j_) __builtin_amdgcn_global_load_lds((const unsigned*)(src_ + j_ * 1024), (RLAS unsigned*)(dst_ + j_ * 1024), 16, 0, 0); } while (0)
        RK_DMA(0); RK_DMA(1); RK_DMA(2);
        for (int c = 0; c <= NCH; ++c) {
            if (c + 2 < NCH) asm volatile("s_waitcnt vmcnt(24)" ::: "memory"); else if (c + 1 < NCH) asm volatile("s_waitcnt vmcnt(12)" ::: "memory"); else asm volatile("s_waitcnt vmcnt(0)" ::: "memory");
            __builtin_amdgcn_s_barrier(); asm volatile("" ::: "memory");
            if (c + 3 < NCH) RK_DMA(c + 3);
        }
#undef RK_DMA
    } else if (wave < 2) {
        const int J = wave;
        f32x16 H0, H1;
#pragma unroll
        for (int r = 0; r < 16; ++r) { H0[r] = 0.f; H1[r] = 0.f; }
        for (int c = 0; c <= NCH; ++c) {
            asm volatile("s_waitcnt lgkmcnt(0)" ::: "memory"); __builtin_amdgcn_s_barrier(); asm volatile("" ::: "memory");
            if (c == NCH) break;
            const RLAS unsigned char* rec = lds + RING0 + (c & (NSL - 1)) * CHK_BYTES;
            u32x4 hb[4];
            hb[0] = (u32x4){pkh(H0[0], H0[1]), pkh(H0[2], H0[3]), pkh(H0[4], H0[5]), pkh(H0[6], H0[7])}; hb[1] = (u32x4){pkh(H0[8], H0[9]), pkh(H0[10], H0[11]), pkh(H0[12], H0[13]), pkh(H0[14], H0[15])};
            hb[2] = (u32x4){pkh(H1[0], H1[1]), pkh(H1[2], H1[3]), pkh(H1[4], H1[5]), pkh(H1[6], H1[7])}; hb[3] = (u32x4){pkh(H1[8], H1[9]), pkh(H1[10], H1[11]), pkh(H1[12], H1[13]), pkh(H1[14], H1[15])};
            f32x16 y, n0, n1;
#define RK_UNPK(dst, w0, w1) do { const f16x8 a_ = __builtin_bit_cast(f16x8, w0), b_ = __builtin_bit_cast(f16x8, w1); \
            _Pragma("unroll") for (int i_ = 0; i_ < 8; ++i_) { dst[i_] = (float)a_[i_]; dst[8 + i_] = (float)b_[i_]; } } while (0)
            { const u32x4 y0 = *(const RLAS u32x4*)(rec + CK_Y + (J * 64 + lane) * 32), y1 = *(const RLAS u32x4*)(rec + CK_Y + (J * 64 + lane) * 32 + 16); RK_UNPK(y, y0, y1);
              const u32x4 g0 = *(const RLAS u32x4*)(rec + CK_G + (J * 64 + lane) * 32), g1 = *(const RLAS u32x4*)(rec + CK_G + (J * 64 + lane) * 32 + 16); RK_UNPK(n0, g0, g1);
              const u32x4 g2 = *(const RLAS u32x4*)(rec + CK_G + ((2 + J) * 64 + lane) * 32), g3 = *(const RLAS u32x4*)(rec + CK_G + ((2 + J) * 64 + lane) * 32 + 16); RK_UNPK(n1, g2, g3); }
#pragma unroll
            for (int ks = 0; ks < 4; ++ks) {
                const f16x8 hf = __builtin_bit_cast(f16x8, hb[ks]);
                y = __builtin_amdgcn_mfma_f32_32x32x16_f16(*(const RLAS f16x8*)(rec + CK_Q + (ks * 64 + lane) * 16), hf, y, 0, 0, 0);
                n0 = __builtin_amdgcn_mfma_f32_32x32x16_f16(*(const RLAS f16x8*)(rec + CK_P + (ks * 64 + lane) * 16), hf, n0, 0, 0, 0);
                n1 = __builtin_amdgcn_mfma_f32_32x32x16_f16(*(const RLAS f16x8*)(rec + CK_P + ((4 + ks) * 64 + lane) * 16), hf, n1, 0, 0, 0);
            }
#undef RK_UNPK
            H0 = n0; H1 = n1;
            RLAS float* yt = ytile + (c & 1) * (32 * 68);
#pragma unroll
            for (int r = 0; r < 16; ++r) yt[crow(r, hi) * 68 + 32 * J + r32] = y[r];
        }
    } else {
        const int p = wave - 2, v8 = (lane & 7) * 8, trow = 8 * p + (lane >> 3);
        float lg[8], lb[8], mv[8];
#pragma unroll
        for (int i = 0; i < 8; ++i) { lg[i] = lnx_g[h * 64 + v8 + i]; lb[i] = lnx_b[h * 64 + v8 + i]; mv[i] = mu[2048 + h * 64 + v8 + i]; }
        struct PSlot { float bon; us8 vc, vp, g8; };
        PSlot ps[4];
#define RK_PLOAD(SL, cc_) do { const int pos_ = (cc_) * C + trow; const size_t tok_ = (size_t)b * S + pos_; ps[SL].bon = BONUS[tok_ * 16 + h]; \
            const unsigned short* cur_ = PROJ16 + tok_ * PN + 5120 + h * 64 + v8; ps[SL].vc = *(const RGAS us8*)cur_; ps[SL].vp = ps[SL].vc; if (pos_ > 0) ps[SL].vp = *(const RGAS us8*)(cur_ - PN); \
            ps[SL].g8 = *(const RGAS us8*)(G16 + tok_ * RWK + h * 64 + v8); } while (0)
#define RK_PSTEP(SL, cc_) do { \
            asm volatile("s_waitcnt lgkmcnt(0)" ::: "memory"); __builtin_amdgcn_s_barrier(); asm volatile("" ::: "memory"); \
            if ((cc_) >= 0) { const int cc = (cc_); \
                const float bon = ps[SL].bon; const us8 vc = ps[SL].vc, vp = ps[SL].vp, g8 = ps[SL].g8; \
                if (cc + 4 < NCH) RK_PLOAD(SL, cc + 4); \
                const RLAS float* yt = ytile + (cc & 1) * (32 * 68) + trow * 68 + v8; \
                const f32x4 ya = *(const RLAS f32x4*)yt, yb = *(const RLAS f32x4*)(yt + 4); \
                float yv[8] = {ya.x, ya.y, ya.z, ya.w, yb.x, yb.y, yb.z, yb.w}; \
                float sm = 0.f; \
                _Pragma("unroll") for (int i = 0; i < 8; ++i) sm += yv[i]; \
                const float mean = sum8(sm) * (1.f / 64.f); float sq = 0.f; \
                _Pragma("unroll") for (int i = 0; i < 8; ++i) { yv[i] -= mean; sq += yv[i] * yv[i]; } \
                const float rstd = __builtin_amdgcn_rsqf(sum8(sq) * (1.f / 64.f) + 64e-5f); \
                const int pos = cc * C + trow; const size_t tok = (size_t)b * S + pos; \
                float o[8]; \
                _Pragma("unroll") for (int i = 0; i < 8; ++i) { const float vcf = h2f(vc[i]), vpf = pos > 0 ? h2f(vp[i]) : 0.f; const float vx = vcf + (vpf - vcf) * mv[i]; \
                    o[i] = (yv[i] * rstd * lg[i] + lb[i] + bon * vx) * h2f(g8[i]); } \
                *(RGAS u32x4*)(Y16 + tok * D + 1024 + h * 64 + v8) = (u32x4){pkh(o[0], o[1]), pkh(o[2], o[3]), pkh(o[4], o[5]), pkh(o[6], o[7])}; } } while (0)
        RK_PLOAD(0, 0); RK_PLOAD(1, 1); RK_PLOAD(2, 2); RK_PLOAD(3, 3);
        for (int cb = 0; cb < NCH; cb += 4) {
            RK_PSTEP(3, cb - 1); RK_PSTEP(0, cb); RK_PSTEP(1, cb + 1); RK_PSTEP(2, cb + 2);
        }
        RK_PSTEP(3, NCH - 1);
#undef RK_PSTEP
#undef RK_PLOAD
    }
    __syncthreads();
}
#undef RLAS
#undef RGAS
}

constexpr int NWAVES = 8;
constexpr int RING_OFF = 0, RING_BYTES = 131072;
constexpr int LDSCTL_OFF = RING_BYTES, MISC_OFF = LDSCTL_OFF + 320;
constexpr int LDS_BYTES = 147456;
#define GAS __attribute__((address_space(1)))
#define LAS __attribute__((address_space(3)))
typedef unsigned v4u __attribute__((ext_vector_type(4)));
typedef float f32x4 __attribute__((ext_vector_type(4)));
typedef GAS unsigned gu32;
#define RLX_AGENT __ATOMIC_RELAXED, __HIP_MEMORY_SCOPE_AGENT
#define LDS_WAIT() asm volatile("s_waitcnt lgkmcnt(0)" ::: "memory")
#define VM_WAIT() asm volatile("s_waitcnt vmcnt(0)" ::: "memory")
constexpr int CW_PQ = 66;
constexpr int CW_CONVQ = 65;
constexpr int CW_ATTQ = 64;
constexpr int CW_BAR = 4096;
constexpr size_t CTL_ZERO_BYTES = 64 * 1024;

#define XB_TMO      128
#define XB_XCNT(j)  (256  + 64 * (j))
#define XB_XSUB(j)  (1280 + 64 * (j))
#define XB_XGEN(j)  (2304 + 64 * (j))
#define XB_TOP      3328
#define XB_TOPGEN   3392
#define XCD_BAR_WORDS 3456
#define XB_SPIN_CAP (1u << 18)

__device__ __forceinline__ unsigned xb_ld(unsigned* p)              { return __hip_atomic_load(p, __ATOMIC_RELAXED, __HIP_MEMORY_SCOPE_AGENT); }
__device__ __forceinline__ unsigned xb_add(unsigned* p, unsigned v) { return __hip_atomic_fetch_add(p, v, __ATOMIC_RELAXED, __HIP_MEMORY_SCOPE_AGENT); }
__device__ __forceinline__ unsigned xb_xcc_id() { return (unsigned)__builtin_amdgcn_s_getreg((3 << 11) | 20) & 0xFu; }
#define XB_SPIN(cond, bar) do { unsigned _sp = 0; while (cond) { __builtin_amdgcn_s_sleep(1); \
    if ((++_sp & 255u) == 0u) { if (xb_ld(&(bar)[XB_TMO])) break; if (_sp > XB_SPIN_CAP) { atomicAdd(&(bar)[XB_TMO], 1u); break; } } } } while (0)

struct XcdBarrier {
    unsigned* bar; unsigned x; bool w0;
    volatile LAS unsigned* st;
};

__device__ __forceinline__ XcdBarrier xcd_barrier_post(unsigned* bar, volatile LAS unsigned* st) {
    XcdBarrier b; b.bar = bar; b.x = xb_xcc_id(); b.st = st; b.w0 = (__builtin_amdgcn_readfirstlane(threadIdx.x >> 6) == 0);
    if (__builtin_amdgcn_readfirstlane(threadIdx.x >> 6) == 0 && pg8::lane_id() == 0) (void)xb_add(&bar[XB_XCNT(b.x)], 1u);
    return b;
}
__device__ __forceinline__ void xcd_barrier_complete(unsigned* bar, unsigned x, unsigned& nloc, unsigned& nx) {
    const unsigned G = gridDim.x * gridDim.y * gridDim.z;
    unsigned sum, cnt, mine, sp = 0u;
    for (;;) {
        sum = 0u; cnt = 0u; mine = 0u;
#pragma unroll
        for (unsigned j = 0; j < 16; ++j) { const unsigned c = xb_ld(&bar[XB_XCNT(j)]); sum += c; cnt += (c > 0u) ? 1u : 0u; mine = (j == x) ? c : mine; }
        if (sum == G) break;
        __builtin_amdgcn_s_sleep(1);
        if ((++sp & 255u) == 0u) { if (xb_ld(&bar[XB_TMO])) break; if (sp > XB_SPIN_CAP) { atomicAdd(&bar[XB_TMO], 1u); break; } }
    }
    nloc = mine > 0u ? mine : 1u; nx = cnt > 0u ? cnt : 1u;
}

__device__ __forceinline__ void xcd_barrier(const XcdBarrier& b) {
    asm volatile("s_waitcnt vmcnt(0)" ::: "memory");
    __syncthreads();
    if (b.w0 && pg8::lane_id() == 0) {
        unsigned* bar = b.bar;
        __builtin_amdgcn_s_waitcnt(0);
        unsigned nloc = b.st[0], nx = b.st[1];
        if (nloc == 0u) { xcd_barrier_complete(bar, b.x, nloc, nx); b.st[0] = nloc; b.st[1] = nx; }
        const unsigned old = xb_add(&bar[XB_XSUB(b.x)], 1u);
        const unsigned gen = old / nloc;
        if (old + 1u == (gen + 1u) * nloc) {
            __builtin_amdgcn_fence(__ATOMIC_RELEASE, "agent");
            asm volatile("s_waitcnt vmcnt(0)" ::: "memory");
            const unsigned og = xb_add(&bar[XB_TOP], 1u);
            const unsigned tg = og / nx;
            if (og + 1u == (tg + 1u) * nx) xb_add(&bar[XB_TOPGEN], 1u);
            else XB_SPIN(xb_ld(&bar[XB_TOPGEN]) == tg, bar);
            __builtin_amdgcn_fence(__ATOMIC_ACQUIRE, "agent");
            xb_add(&bar[XB_XGEN(b.x)], 1u);
            asm volatile("s_waitcnt vmcnt(0)" ::: "memory");
        } else {
            XB_SPIN(xb_ld(&bar[XB_XGEN(b.x)]) == gen, bar);
            __builtin_amdgcn_fence(__ATOMIC_ACQUIRE, "agent");
            asm volatile("s_waitcnt vmcnt(0)" ::: "memory");
        }
    }
    __syncthreads();
}


typedef unsigned short f16_t;
typedef _Float16 h2v __attribute__((ext_vector_type(2)));
__device__ __forceinline__ unsigned pk2h(float lo, float hi) { h2v v = {(_Float16)lo, (_Float16)hi}; return __builtin_bit_cast(unsigned, v); }

struct Frame {
    LAS unsigned char* lds; volatile LAS unsigned* MISC; gu32* ctl;
    int wave, vcu, G;
};
#define FTID (F.wave * 64 + pg8::lane_id())
#define FLANE (pg8::lane_id())
__device__ __forceinline__ void p0_transpose_item(const float* W, int K, int N, f16_t* WT, int row_off, LAS float* scr, int item, int lane) {
    const int nblk = N / 32, kb = item / nblk, nb = item % nblk, k0 = 64 * kb, n0 = 32 * nb;
#pragma unroll 8
    for (int i = 0; i < 32; ++i) { const int kk = 2 * i + (lane >> 5); scr[kk * 33 + (lane & 31)] = W[(size_t)(k0 + kk) * N + n0 + (lane & 31)]; }
    LDS_WAIT(); asm volatile("" ::: "memory");
    const int c = lane & 7;
#pragma unroll
    for (int j = 0; j < 4; ++j) { const int n = (lane >> 3) + 8 * j; const LAS float* s = scr + (8 * c) * 33 + n;
        v4u o; o.x = pk2h(s[0 * 33], s[1 * 33]); o.y = pk2h(s[2 * 33], s[3 * 33]); o.z = pk2h(s[4 * 33], s[5 * 33]); o.w = pk2h(s[6 * 33], s[7 * 33]);
        *(GAS v4u*)(WT + (size_t)(row_off + n0 + n) * K + k0 + 8 * c) = o; }
    LDS_WAIT(); asm volatile("" ::: "memory");
}
#ifndef TP_LD
#define TP_LD(p) (*(p))
#endif
struct TpDesc { const float* W; f16_t* WT; int K, N, row_off, item; };
__device__ __forceinline__ void tp_load(float (&r)[32], const TpDesc& d, int lane) {
    const int nblk = d.N / 32, kb = d.item / nblk, nb = d.item % nblk, k0 = 64 * kb, n0 = 32 * nb;
#pragma unroll
    for (int i = 0; i < 32; ++i) r[i] = TP_LD(d.W + (size_t)(k0 + 2 * i + (lane >> 5)) * d.N + n0 + (lane & 31));
}
__device__ __forceinline__ void tp_emit(const TpDesc& d, LAS float* scr, int lane) {
    const int nblk = d.N / 32, kb = d.item / nblk, nb = d.item % nblk, k0 = 64 * kb, n0 = 32 * nb, c = lane & 7;
#pragma unroll
    for (int j = 0; j < 4; ++j) { const int n = (lane >> 3) + 8 * j; const LAS float* sp = scr + (8 * c) * 33 + n;
        v4u o; o.x = pk2h(sp[0 * 33], sp[1 * 33]); o.y = pk2h(sp[2 * 33], sp[3 * 33]); o.z = pk2h(sp[4 * 33], sp[5 * 33]); o.w = pk2h(sp[6 * 33], sp[7 * 33]);
        *(GAS v4u*)(d.WT + (size_t)(d.row_off + n0 + n) * d.K + k0 + 8 * c) = o; }
}
template <class MK> __device__ __forceinline__ void tp_stream(int first, int n, int stride, MK mk, LAS float* scr, int lane) {
    if (first >= n) return;
    float r[32]; int it = first; TpDesc d = mk(it); tp_load(r, d, lane);
    for (;;) {
#pragma unroll
        for (int i = 0; i < 32; ++i) scr[(2 * i + (lane >> 5)) * 33 + (lane & 31)] = r[i];
        LDS_WAIT(); asm volatile("" ::: "memory");
        const int nit = it + stride; const bool more = nit < n; TpDesc dn = d;
        if (more) { dn = mk(nit); tp_load(r, dn, lane); }
        tp_emit(d, scr, lane);
        LDS_WAIT(); asm volatile("" ::: "memory");
        if (!more) break;
        it = nit; d = dn;
    }
}
#ifndef TPD_AUX
#define TPD_AUX 2
#endif
__device__ __forceinline__ void tpd_load(const TpDesc& d, LAS unsigned char* buf, int lane) {
    const int nblk = d.N / 32, kb = d.item / nblk, nb = d.item % nblk, k0 = 64 * kb, n0 = 32 * nb;
    const float* src = d.W + (size_t)(k0 + (lane >> 3)) * d.N + n0;
#pragma unroll
    for (int j = 0; j < 8; ++j) __builtin_amdgcn_global_load_lds((const unsigned*)(src + (size_t)(8 * j) * d.N + 4 * ((lane & 7) ^ j)), (LAS unsigned*)(buf + j * 1024), 16, 0, TPD_AUX);
}
__device__ __forceinline__ void tpd_emit(const TpDesc& d, const LAS unsigned char* buf, int lane) {
    const int nblk = d.N / 32, kb = d.item / nblk, nb = d.item % nblk, k0 = 64 * kb, n0 = 32 * nb, c = lane & 7;
#pragma unroll
    for (int j = 0; j < 4; ++j) { const int n = (lane >> 3) + 8 * j; const LAS float* sp = (const LAS float*)(buf + (8 * c) * 128 + (((n >> 2) ^ c) * 16) + (n & 3) * 4);
        v4u o; o.x = pk2h(sp[0 * 32], sp[1 * 32]); o.y = pk2h(sp[2 * 32], sp[3 * 32]); o.z = pk2h(sp[4 * 32], sp[5 * 32]); o.w = pk2h(sp[6 * 32], sp[7 * 32]);
        __builtin_nontemporal_store(o, (GAS v4u*)(d.WT + (size_t)(d.row_off + n0 + n) * d.K + k0 + 8 * c)); }
}
template <class MK> __device__ __forceinline__ void tpd_stream(int first, int n, int stride, MK mk, LAS unsigned char* buf, int lane) {
    for (int it = first; it < n; it += 2 * stride) {
        const bool two = it + stride < n;
        const TpDesc d0 = mk(it); const TpDesc d1 = mk(two ? it + stride : it);
        tpd_load(d0, buf, lane); if (two) tpd_load(d1, buf + 8192, lane);
        asm volatile("s_waitcnt vmcnt(0)" ::: "memory");
        tpd_emit(d0, buf, lane); if (two) tpd_emit(d1, buf + 8192, lane);
        LDS_WAIT(); asm volatile("" ::: "memory");
    }
}
__device__ __forceinline__ float wave_sum_b(float v) {
#pragma unroll
    for (int o = 1; o < 64; o <<= 1) v += __shfl_xor(v, o);
    return v;
}
__device__ __forceinline__ void ln_row_dual(int lane, const float* xrow, const float* g, const float* b, float* o32, f16_t* o16) {
    const GAS f32x4* xr = (const GAS f32x4*)xrow + lane;
    f32x4 v[8]; float s = 0.f;
#pragma unroll
    for (int j = 0; j < 8; ++j) { v[j] = xr[64 * j]; s += (v[j].x + v[j].y) + (v[j].z + v[j].w); }
    const float mean = wave_sum_b(s) * (1.f / D); float s2 = 0.f;
#pragma unroll
    for (int j = 0; j < 8; ++j) { v[j] = v[j] - mean; s2 += (v[j].x * v[j].x + v[j].y * v[j].y) + (v[j].z * v[j].z + v[j].w * v[j].w); }
    const float rstd = __builtin_amdgcn_rsqf(wave_sum_b(s2) * (1.f / D) + LN_EPS);
    const GAS f32x4* g4 = (const GAS f32x4*)g + lane; const GAS f32x4* b4 = (const GAS f32x4*)b + lane;
    GAS f32x4* o4 = (GAS f32x4*)o32 + lane; GAS unsigned long long* o8 = (GAS unsigned long long*)o16 + lane;
#pragma unroll
    for (int j = 0; j < 8; ++j) { const f32x4 o = v[j] * rstd * g4[64 * j] + b4[64 * j]; o4[64 * j] = o;
        o8[64 * j] = (unsigned long long)pk2h(o.x, o.y) | ((unsigned long long)pk2h(o.z, o.w) << 32); }
}


__device__ __forceinline__ void ln_row_f16(int lane, const float* xrow, const float* g, const float* b, f16_t* o16, float2* st) {
    const GAS f32x4* xr = (const GAS f32x4*)xrow + lane;
    f32x4 v[8]; float s = 0.f;
#pragma unroll
    for (int j = 0; j < 8; ++j) { v[j] = xr[64 * j]; s += (v[j].x + v[j].y) + (v[j].z + v[j].w); }
    const float mean = wave_sum_b(s) * (1.f / D); float s2 = 0.f;
#pragma unroll
    for (int j = 0; j < 8; ++j) { v[j] = v[j] - mean; s2 += (v[j].x * v[j].x + v[j].y * v[j].y) + (v[j].z * v[j].z + v[j].w * v[j].w); }
    const float rstd = __builtin_amdgcn_rsqf(wave_sum_b(s2) * (1.f / D) + LN_EPS);
    const GAS f32x4* g4 = (const GAS f32x4*)g + lane; const GAS f32x4* b4 = (const GAS f32x4*)b + lane;
    GAS unsigned long long* o8 = (GAS unsigned long long*)o16 + lane;
#pragma unroll
    for (int j = 0; j < 8; ++j) { const f32x4 o = v[j] * rstd * g4[64 * j] + b4[64 * j];
        o8[64 * j] = (unsigned long long)pk2h(o.x, o.y) | ((unsigned long long)pk2h(o.z, o.w) << 32); }
    if (lane == 0) *st = make_float2(mean, rstd);
}

__device__ __forceinline__ void p0_transpose_item_gu(const float* W, int K, int N, f16_t* WT, int gu_s, LAS float* scr, int item, int lane) {
    const int nblk = N / 32, nb = item % nblk; const int row_off = gu_s < 0 ? 0 : 128 * (nb >> 2) + 128 * gu_s;
    p0_transpose_item(W, K, N, WT, row_off, scr, item, lane);
}
__device__ __forceinline__ void ln_norm(int lane, f32x4 (&v)[8], const float* g, const float* b) {
    float s = 0.f;
#pragma unroll
    for (int j = 0; j < 8; ++j) s += (v[j].x + v[j].y) + (v[j].z + v[j].w);
    const float mean = wave_sum_b(s) * (1.f / D); float s2 = 0.f;
#pragma unroll
    for (int j = 0; j < 8; ++j) { v[j] = v[j] - mean; s2 += (v[j].x * v[j].x + v[j].y * v[j].y) + (v[j].z * v[j].z + v[j].w * v[j].w); }
    const float rstd = __builtin_amdgcn_rsqf(wave_sum_b(s2) * (1.f / D) + LN_EPS);
    const GAS f32x4* g4 = (const GAS f32x4*)g + lane; const GAS f32x4* b4 = (const GAS f32x4*)b + lane;
#pragma unroll
    for (int j = 0; j < 8; ++j) v[j] = v[j] * rstd * g4[64 * j] + b4[64 * j];
}
__device__ __forceinline__ void ln_store(int lane, const f32x4 (&v)[8], float* o32, f16_t* o16) {
    GAS f32x4* o4 = (GAS f32x4*)o32 + lane; GAS unsigned long long* o8 = (GAS unsigned long long*)o16 + lane;
#pragma unroll
    for (int j = 0; j < 8; ++j) { o4[64 * j] = v[j]; o8[64 * j] = (unsigned long long)pk2h(v[j].x, v[j].y) | ((unsigned long long)pk2h(v[j].z, v[j].w) << 32); }
}
__device__ __forceinline__ void ln_store16(int lane, const f32x4 (&v)[8], f16_t* o16) {
    GAS unsigned long long* o8 = (GAS unsigned long long*)o16 + lane;
#pragma unroll
    for (int j = 0; j < 8; ++j) o8[64 * j] = (unsigned long long)pk2h(v[j].x, v[j].y) | ((unsigned long long)pk2h(v[j].z, v[j].w) << 32);
}
__device__ __forceinline__ void ln_regs(int lane, f32x4 (&v)[8], const float* g, const float* b, float* o32, f16_t* o16) { ln_norm(lane, v, g, b); ln_store(lane, v, o32, o16); }
__device__ __forceinline__ void rt_stage(const float* src, LAS unsigned char* dst, int wave, int lane) {
#pragma unroll
    for (int i = 0; i < 6; ++i) __builtin_amdgcn_global_load_lds((const unsigned*)(src + 4 * (wave * 64 + lane + 512 * i)), (LAS unsigned*)(dst + (wave * 64 + 512 * i) * 16), 16, 0, 0);
}
__device__ __forceinline__ void route_pick(const float (&acc)[36], const float* gb, const float* eb, int& ea, int& ebb, float& wa, float& wb) {
    float gl[4]; float gm = -3.0e38f; int gi = 0;
#pragma unroll
    for (int i = 0; i < 4; ++i) { gl[i] = acc[i] + gb[i]; if (gl[i] > gm) { gm = gl[i]; gi = i; } }
    float gs = 0.f;
#pragma unroll
    for (int i = 0; i < 4; ++i) gs += __expf(gl[i] - gm);
    const float gtop = 1.f / gs;
    float el[8]; float em = -3.0e38f; int e0 = 0;
#pragma unroll
    for (int i = 0; i < 8; ++i) { float v = 0.f;
#pragma unroll
        for (int g = 0; g < 4; ++g) if (g == gi) v = acc[4 + g * 8 + i] + eb[g * 8 + i];
        el[i] = v; if (v > em) { em = v; e0 = i; } }
    float em2 = -3.0e38f; int e1 = 0;
#pragma unroll
    for (int i = 0; i < 8; ++i) if (i != e0 && el[i] > em2) { em2 = el[i]; e1 = i; }
    const float x1 = __expf(em2 - em);
    const float w0 = 1.f / (1.f + x1), w1 = x1 / (1.f + x1);
    ea = gi * 8 + e0; ebb = gi * 8 + e1; wa = w0 * gtop; wb = w1 * gtop;
}
constexpr int TAB_OFF = LDSCTL_OFF + 1024;
__device__ __forceinline__ void build_moe_table(Frame& F, const int* cnt) {
    LAS int* tab = (LAS int*)(F.lds + TAB_OFF);
    const int tid = FTID;
    if (tid < 32) tab[tid] = __hip_atomic_load(cnt + tid * CNT_STRIDE, __ATOMIC_RELAXED, __HIP_MEMORY_SCOPE_AGENT);
    __syncthreads();
    if (tid <= 32) {
        int p = 0, pa = 0, pb = 0;
#pragma unroll 8
        for (int e = 0; e < 32; ++e) { const int nb = (tab[e] + 255) >> 8, na = nb < 2 ? nb : 2; if (e < tid) { p += nb; pa += na; pb += nb - na; } }
        tab[32 + tid] = p; tab[65 + tid] = pa; tab[98 + tid] = pb; }
    __syncthreads();
}

__device__ __forceinline__ float sum8_dpp(float x) {
    x += __builtin_bit_cast(float, __builtin_amdgcn_update_dpp(0, __builtin_bit_cast(int, x), 0xB1, 0xF, 0xF, true));
    x += __builtin_bit_cast(float, __builtin_amdgcn_update_dpp(0, __builtin_bit_cast(int, x), 0x4E, 0xF, 0xF, true));
    x += __builtin_bit_cast(float, __builtin_amdgcn_update_dpp(0, __builtin_bit_cast(int, x), 0x141, 0xF, 0xF, true));
    return x;
}
__device__ __forceinline__ float h2f(unsigned short u) { return (float)__builtin_bit_cast(_Float16, u); }
__device__ __forceinline__ float sum32_x(float x) {
    x += __builtin_bit_cast(float, __builtin_amdgcn_update_dpp(0, __builtin_bit_cast(int, x), 0xB1, 0xF, 0xF, true));
    x += __builtin_bit_cast(float, __builtin_amdgcn_update_dpp(0, __builtin_bit_cast(int, x), 0x4E, 0xF, 0xF, true));
    x += __builtin_bit_cast(float, __builtin_amdgcn_update_dpp(0, __builtin_bit_cast(int, x), 0x141, 0xF, 0xF, true));
    x += __builtin_bit_cast(float, __builtin_amdgcn_update_dpp(0, __builtin_bit_cast(int, x), 0x140, 0xF, 0xF, true));
    x += __builtin_bit_cast(float, __builtin_amdgcn_ds_bpermute((pg8::lane_id() ^ 16) << 2, __builtin_bit_cast(int, x)));
    return x;
}
__device__ __forceinline__ float wsum64(float x) {
    x = sum32_x(x); auto rr = __builtin_amdgcn_permlane32_swap(__float_as_uint(x), __float_as_uint(x), false, false); return __uint_as_float(rr[0]) + __uint_as_float(rr[1]);
}
__device__ __forceinline__ void rwkv_prep_tile(Frame& F, int tile, const f16_t* PROJ16, const f16_t* LSLAB, const float* mu, const float* w0, const f16_t* W2T, const float* a0, const f16_t* A2T, const f16_t* G2T,
                                               const float* k_k, const float* k_a, float* lwout, f16_t* kmod, f16_t* Aout, f16_t* Bout, f16_t* gout) {
    typedef _Float16 f16x8 __attribute__((ext_vector_type(8))); typedef float f32x16 __attribute__((ext_vector_type(16)));
    constexpr int SXS = 592;
    LAS unsigned char* sx = F.lds + RING_OFF;
    const int lane = FLANE, tid = F.wave * 64 + lane, t0 = tile * 32, r32 = lane & 31, hi = lane >> 5;
    __syncthreads();
    LAS unsigned char* kst = F.lds + RING_OFF + 20480 + F.wave * 9216;
#pragma unroll
    for (int i = 0; i < 9; ++i) { int j = 4 * i + (lane >> 4); j = j > 32 ? 32 : j;
        __builtin_amdgcn_global_load_lds((const unsigned*)(PROJ16 + ((size_t)t0 + j) * PN - PN + 4096 + 128 * F.wave + 8 * (lane & 15)), (LAS unsigned*)(kst + i * 1024), 16, 0, 0); }
    for (int e = tid; e < 32 * 36; e += 512) {
        typedef unsigned short us8v __attribute__((ext_vector_type(8)));
        const int tok = e / 36, i8 = (e % 36) * 8, pos = (t0 + tok) & (S - 1); const bool hp = pos > 0;
        us8v c8[4], p8[4];
#pragma unroll
        for (int sl = 0; sl < 4; ++sl) { const f16_t* cur = LSLAB + ((size_t)sl * T + t0 + tok) * 512 + i8; c8[sl] = *(const GAS us8v*)cur; p8[sl] = *(const GAS us8v*)(hp ? cur - 512 : cur); }
        const f32x4 m0 = *(const GAS f32x4*)(mu + 3072 + i8), m1 = *(const GAS f32x4*)(mu + 3072 + i8 + 4);
        const float mm[8] = {m0.x, m0.y, m0.z, m0.w, m1.x, m1.y, m1.z, m1.w};
        const float kx = i8 < 64 ? 2.f : -1.f;
        float f[8];
#pragma unroll
        for (int i = 0; i < 8; ++i) { const float cv = (h2f(c8[0][i]) + h2f(c8[1][i])) + (h2f(c8[2][i]) + h2f(c8[3][i])); const float pv = (h2f(p8[0][i]) + h2f(p8[1][i])) + (h2f(p8[2][i]) + h2f(p8[3][i]));
            const float xs = cv + ((hp ? pv : 0.f) - cv) * mm[i]; const float rc = 1.f / (1.f + __expf(kx * xs));
            f[i] = i8 < 64 ? 1.f - 2.f * rc : (i8 < 128 ? xs : rc); }
        *(LAS v4u*)(sx + tok * SXS + i8 * 2) = (v4u){pk2h(f[0], f[1]), pk2h(f[2], f[3]), pk2h(f[4], f[5]), pk2h(f[6], f[7])};
    }
    __syncthreads();
    const LAS unsigned char* ap = sx + r32 * SXS + hi * 16;
#pragma unroll 1
    for (int hd = 0; hd < 2; ++hd) {
        const int ch0 = 128 * F.wave + 64 * hd;
        f32x16 aw[2], aa[2], ag[2];
#pragma unroll
        for (int tt = 0; tt < 2; ++tt)
#pragma unroll
            for (int r = 0; r < 16; ++r) { aw[tt][r] = 0.f; aa[tt][r] = 0.f; ag[tt][r] = 0.f; }
        {
            const f16_t* bw0 = W2T + (size_t)(ch0 + r32) * 64 + hi * 8; const f16_t* ba0 = A2T + (size_t)(ch0 + r32) * 64 + hi * 8; const f16_t* bg0 = G2T + (size_t)(ch0 + r32) * 160 + hi * 8;
            f16x8 fw[2][4], fa[2][4], fg0[10], fg1[10];
#pragma unroll
            for (int tt = 0; tt < 2; ++tt)
#pragma unroll
                for (int ks = 0; ks < 4; ++ks) { fw[tt][ks] = *(const GAS f16x8*)(bw0 + tt * 32 * 64 + ks * 16); fa[tt][ks] = *(const GAS f16x8*)(ba0 + tt * 32 * 64 + ks * 16); }
#pragma unroll
            for (int ks = 0; ks < 10; ++ks) fg0[ks] = *(const GAS f16x8*)(bg0 + ks * 16);
#pragma unroll
            for (int tt = 0; tt < 2; ++tt)
#pragma unroll
                for (int ks = 0; ks < 4; ++ks) {
                    aw[tt] = __builtin_amdgcn_mfma_f32_32x32x16_f16(*(const LAS f16x8*)(ap + ks * 32), fw[tt][ks], aw[tt], 0, 0, 0);
                    aa[tt] = __builtin_amdgcn_mfma_f32_32x32x16_f16(*(const LAS f16x8*)(ap + 128 + ks * 32), fa[tt][ks], aa[tt], 0, 0, 0); }
#pragma unroll
            for (int ks = 0; ks < 10; ++ks) fg1[ks] = *(const GAS f16x8*)(bg0 + 32 * 160 + ks * 16);
#pragma unroll
            for (int ks = 0; ks < 10; ++ks) ag[0] = __builtin_amdgcn_mfma_f32_32x32x16_f16(*(const LAS f16x8*)(ap + 256 + ks * 32), fg0[ks], ag[0], 0, 0, 0);
#pragma unroll
            for (int ks = 0; ks < 10; ++ks) ag[1] = __builtin_amdgcn_mfma_f32_32x32x16_f16(*(const LAS f16x8*)(ap + 256 + ks * 32), fg1[ks], ag[1], 0, 0, 0);
        }
        int t0e = t0; asm volatile("" : "+s"(t0e));
        float k0[2][16];
        float pkk[2], pka[2], pmu[2], pw0[2], pa0[2];
#pragma unroll
        for (int tt = 0; tt < 2; ++tt) { const int n = ch0 + 32 * tt + r32; pkk[tt] = k_k[n]; pka[tt] = k_a[n]; pmu[tt] = mu[1024 + n]; pw0[tt] = w0[n]; pa0[tt] = a0[n]; }
        asm volatile("s_waitcnt vmcnt(0)" ::: "memory");
#pragma unroll
        for (int r = 0; r < 16; ++r) { const int tl = (r & 3) + 8 * (r >> 2) + 4 * hi, pos = (t0e + tl) & (S - 1);
#pragma unroll
            for (int tt = 0; tt < 2; ++tt) { const LAS unsigned short* kl = (const LAS unsigned short*)kst + (tl + 1) * 128 + 64 * hd + 32 * tt + r32;
                const float cv = h2f(kl[0]), pvr = h2f(kl[-128]), pv = pos > 0 ? pvr : 0.f; k0[tt][r] = cv + (pv - cv) * pmu[tt]; } }
        float inv[16];
#pragma unroll
        for (int r = 0; r < 16; ++r) { const float q0 = k0[0][r] * pkk[0], q1 = k0[1][r] * pkk[1]; const float ss = sum32_x(fmaf(q0, q0, q1 * q1)); inv[r] = __builtin_amdgcn_rsqf(fmaxf(ss, 1e-24f)); }
#pragma unroll
        for (int r = 0; r < 16; ++r) { const int tok = t0e + (r & 3) + 8 * (r >> 2) + 4 * hi;
#pragma unroll
            for (int tt = 0; tt < 2; ++tt) { const size_t o = (size_t)tok * RWK + ch0 + 32 * tt + r32;
                const float z = -(pw0[tt] + aw[tt][r]); const float sp = z > 20.f ? z : __logf(1.f + __expf(z));
                lwout[o] = -__expf(-sp - 0.5f);
                const float asig = 1.f / (1.f + __expf(-(pa0[tt] + aa[tt][r]))); const float kk = k0[tt][r] * pkk[tt] * inv[r];
                kmod[o] = __builtin_bit_cast(unsigned short, (_Float16)(k0[tt][r] * (1.f + (asig - 1.f) * pka[tt])));
                Aout[o] = __builtin_bit_cast(unsigned short, (_Float16)(-kk)); Bout[o] = __builtin_bit_cast(unsigned short, (_Float16)(kk * asig));
                gout[o] = __builtin_bit_cast(unsigned short, (_Float16)ag[tt][r]); } }
    }
}
__device__ __forceinline__ float sum16_dpp(float x) {
    x += __builtin_bit_cast(float, __builtin_amdgcn_update_dpp(0, __builtin_bit_cast(int, x), 0xB1, 0xF, 0xF, true));
    x += __builtin_bit_cast(float, __builtin_amdgcn_update_dpp(0, __builtin_bit_cast(int, x), 0x4E, 0xF, 0xF, true));
    x += __builtin_bit_cast(float, __builtin_amdgcn_update_dpp(0, __builtin_bit_cast(int, x), 0x141, 0xF, 0xF, true));
    x += __builtin_bit_cast(float, __builtin_amdgcn_update_dpp(0, __builtin_bit_cast(int, x), 0x140, 0xF, 0xF, true));
    return x;
}
__device__ __forceinline__ f32x4 h4f(const f16_t* p) { typedef _Float16 h4_t __attribute__((ext_vector_type(4))); const h4_t v = *(const GAS h4_t*)p; return (f32x4){(float)v[0], (float)v[1], (float)v[2], (float)v[3]}; }
#ifndef REP_P0
#define REP_P0 1
#endif
#ifndef REP_PROJ
#define REP_PROJ 1
#endif
#ifndef REP_PLE
#define REP_PLE 1
#endif
#ifndef REP_CONV
#define REP_CONV 1
#endif
#ifndef REP_P2
#define REP_P2 1
#endif
#ifndef REP_P3
#define REP_P3 1
#endif
#ifndef PROBE_K
#define PROBE_K -1
#endif
#ifndef PROBE_J
#define PROBE_J -1
#endif
#ifndef PROBE_SCALE
#define PROBE_SCALE 1e-3f
#endif
#ifndef REP_P5
#define REP_P5 1
#endif
#ifndef REP_P8
#define REP_P8 1
#endif
#ifndef REP_P6
#define REP_P6 1
#endif
#ifndef REP_P7
#define REP_P7 1
#endif
struct Args { const float* in[37]; float* out; unsigned char* ws; int ph_lo, ph_hi, li, pad; };
__global__ void __launch_bounds__(NWAVES * 64, 2) mega_fwd(Args args) {
    extern __shared__ __attribute__((aligned(16))) unsigned char lds[];
    Frame F;
    F.lds = (LAS unsigned char*)lds; F.MISC = (volatile LAS unsigned*)(F.lds + MISC_OFF);
    F.wave = __builtin_amdgcn_readfirstlane(threadIdx.x >> 6);
    F.G = gridDim.x; { const int bx = blockIdx.x; F.vcu = (F.G % 8 == 0) ? (bx % 8) * (F.G / 8) + bx / 8 : bx; }
    unsigned char* ws = args.ws;
    F.ctl = (gu32*)(ws);
    for (int u = FTID; u < (LDS_BYTES - LDSCTL_OFF) / 4; u += NWAVES * 64) ((LAS unsigned*)(F.lds + LDSCTL_OFF))[u] = 0u;
    __syncthreads();
    XcdBarrier bar = xcd_barrier_post((unsigned*)(F.ctl + CW_BAR) + args.li * XCD_BAR_WORDS, F.MISC + 8);
    unsigned long long t0_ = 0, tk_ = 0; if (PROBE_K != -1) t0_ = __builtin_amdgcn_s_memrealtime();
    const int lo = args.ph_lo, hi = args.ph_hi;
#define IN(k) (lo <= (k) && (k) < hi)
#define BOTH(k) (IN(k) && IN((k) + 1))
    f16_t* WinT = (f16_t*)(ws + WS_WINT); f16_t* H16 = (f16_t*)(ws + WS_H16); f16_t* PROJ16 = (f16_t*)(ws + WS_PROJ16); float* DECAY = (float*)(ws + WS_DECAY); f16_t* KMOD = (f16_t*)(ws + WS_KMOD); f16_t* A16 = (f16_t*)(ws + WS_A16); f16_t* B16 = (f16_t*)(ws + WS_B16); f16_t* G16 = (f16_t*)(ws + WS_G16);
    f16_t* WoutT = (f16_t*)(ws + WS_WOUTT); f16_t* GateT = (f16_t*)(ws + WS_GATET); f16_t* PleT = (f16_t*)(ws + WS_PLET); f16_t* P16 = (f16_t*)(ws + WS_P16);
    f16_t* PW16 = (f16_t*)(ws + WS_PW16); f16_t* Y16 = (f16_t*)(ws + WS_Y16); float* ROWRS = (float*)(ws + WS_ROWRS);
    float* RT = (float*)(ws + WS_RT); f16_t* GUT = (f16_t*)(ws + WS_GUT); f16_t* DNT = (f16_t*)(ws + WS_DNT); f16_t* HID = (f16_t*)(ws + WS_HID); f16_t* FFN16 = (f16_t*)(ws + WS_FFN16); f16_t* H1_16 = (f16_t*)(ws + WS_H1_16);
    int* cnt = (int*)(ws + WS_CNT); int* ltok = (int*)(ws + WS_LTOK); int* lpair = (int*)(ws + WS_LPAIR); float* pairw = (float*)(ws + WS_PAIRW);
    const int gw = F.vcu * NWAVES + F.wave, NGW = F.G * NWAVES;
    if (IN(0)) for (int rep_ = 0; rep_ < REP_P0; ++rep_) {
        LAS float* scr = (LAS float*)(F.lds + RING_OFF + F.wave * 16384);
        constexpr int I_IN = (D / 64) * (NPROJ / 32);
        for (int it = gw; it < I_IN; it += NGW) p0_transpose_item(args.in[5], D, NPROJ, WinT, 0, scr, it, FLANE);
        { GAS v4u* z = (GAS v4u*)(WinT + (size_t)NPROJ * D); const int nz = (PN - NPROJ) * D * 2 / 16;
          for (int i = blockIdx.x * 512 + FTID; i < nz; i += F.G * 512) z[i] = (v4u){0u, 0u, 0u, 0u}; }
        {
            f16_t* W2T = (f16_t*)(ws + WS_W2T); f16_t* A2T = (f16_t*)(ws + WS_A2T); f16_t* G2T = (f16_t*)(ws + WS_G2T);
            for (int i = blockIdx.x * 512 + FTID; i < 1024 * 288; i += F.G * 512) { const int n = i / 288, k = i % 288;
                if (k < 64) W2T[n * 64 + k] = __builtin_bit_cast(unsigned short, (_Float16)args.in[13][k * 1024 + n]);
                else if (k < 128) A2T[n * 64 + (k - 64)] = __builtin_bit_cast(unsigned short, (_Float16)args.in[15][(k - 64) * 1024 + n]);
                else G2T[n * 160 + (k - 128)] = __builtin_bit_cast(unsigned short, (_Float16)args.in[16][(k - 128) * 1024 + n]); } }
        if (blockIdx.x == 0) {
            const int tid = FTID; float* lamp = (float*)(ws + WS_LAM); float* biasT = (float*)(ws + WS_BIAS);
            if (tid < 64) { const float a = wave_sum_b(args.in[6][tid] * args.in[7][tid]), b2 = wave_sum_b(args.in[8][tid] * args.in[9][tid]); if (tid == 0) *lamp = expf(a) - expf(b2) + LAMBDA_INIT; }
            for (int i = tid; i < 8 * 129; i += 512) { const int hh = i / 129, n = i % 129; int bucket;
                if (n < 16) bucket = n; else { const int large = 16 + (int)(logf((float)n / 16.f) / 2.0794415416798357f * 16.f); bucket = large < 31 ? large : 31; }
                biasT[i] = args.in[4][bucket * 8 + hh]; }
        }
        for (int m = gw; m < T; m += NGW) ln_row_f16(FLANE, args.in[0] + (size_t)m * D, args.in[2], args.in[3], H16 + (size_t)m * D, (float2*)(ws + WS_ROWST) + m);
        if (BOTH(0) && rep_ == REP_P0 - 1) xcd_barrier(bar); else __syncthreads();
    }
    if (PROBE_K == 0) tk_ = __builtin_amdgcn_s_memrealtime();
    if (PROBE_J == 0) t0_ = __builtin_amdgcn_s_memrealtime();
    if (IN(1)) {
        pg8::Gemm g{H16, WinT, T, 6144, D, D}; pg8::StaticOrder S; S.init(T, 6144, F.G, (int)blockIdx.x);
        pg8::EpiF16 E{PROJ16, PN, 4, att::C2};
        for (int rep_ = 0; rep_ < REP_PROJ; ++rep_) pg8::gemm_phase<pg8::EpiF16, pg8::StaticOrder, true>(F.lds + RING_OFF, g, S, E, F.wave);
        { pg8::Gemm gl{H16, WinT + (size_t)6144 * D, T, 512, 512, D}; pg8::SplitKOrder Sl{T / 256, 2, 4, F.G, (int)blockIdx.x};
          pg8::EpiSlab El{(f16_t*)(ws + WS_LSLAB), 512, (size_t)T * 512};
          pg8::gemm_phase<pg8::EpiSlab, pg8::SplitKOrder, true>(F.lds + RING_OFF, gl, Sl, El, F.wave); }
        if (BOTH(1)) xcd_barrier(bar);
    }
    if (PROBE_K == 1) tk_ = __builtin_amdgcn_s_memrealtime();
    if (PROBE_J == 1) t0_ = __builtin_amdgcn_s_memrealtime();
    if (IN(2)) {
        for (int rep_ = 0; rep_ < REP_P2; ++rep_)
        if (F.vcu < T / 32) { const int tile = F.vcu;
            rwkv_prep_tile(F, tile, PROJ16, (const f16_t*)(ws + WS_LSLAB), args.in[11], args.in[12], (const f16_t*)(ws + WS_W2T), args.in[14], (const f16_t*)(ws + WS_A2T), (const f16_t*)(ws + WS_G2T), args.in[17], args.in[18], DECAY, KMOD, A16, B16, G16);
            asm volatile("s_waitcnt vmcnt(0)" ::: "memory"); __syncthreads();
            { rk::ChunkIn nin; const int tl_ = (F.wave & 3) * 64 + FLANE, tg_ = tile * 32 + (tl_ >> 3), ps_ = tg_ & (S - 1), cb_ = (F.wave >> 2) * 64 + (tl_ & 7) * 8;
              rk::chunk_load(nin, tg_, ps_, cb_, ws);
              for (int hA = 0; hA < 16; hA += 2) {
                  rk::chunk_pair(F.lds + RING_OFF, F.wave, tile, hA, nin, hA + 2 < 16, args.in[11], args.in[19], ws); } }
            __syncthreads();
        }
        if (BOTH(2)) xcd_barrier(bar);
    }
    if (PROBE_K == 2) tk_ = __builtin_amdgcn_s_memrealtime();
    if (PROBE_J == 2) t0_ = __builtin_amdgcn_s_memrealtime();
    if (IN(3)) {
        if ((F.vcu & 3) == 0) rk::scan_unit(F.lds + RING_OFF, F.wave, F.vcu >> 2, ws + WS_CHK, (const float*)(ws + WS_BONUS), PROJ16, args.in[11], G16, args.in[20], args.in[21], Y16);
        {
            const float lam = *(const float*)(ws + WS_LAM);
            volatile LAS unsigned* qslot = F.MISC + 12;
            const float* wg = args.in[29]; const float* wu = args.in[30]; const float* wd = args.in[31];
            auto conv_batch = [&]() -> bool {
                __syncthreads();
                if (FTID == 0) qslot[1] = __hip_atomic_fetch_add(F.ctl + CW_CONVQ, 1u, __ATOMIC_RELAXED, __HIP_MEMORY_SCOPE_AGENT);
                __syncthreads();
                const int q = (int)__builtin_amdgcn_readfirstlane(qslot[1]);
                if (q >= NE * 1536 / 64) return false;
                LAS unsigned char* scr = F.lds + RING_OFF + F.wave * 16384;
                tpd_stream(q * 64 + F.wave, q * 64 + 64, 8, [=](int it) { const int e = it / 1536, r = it % 1536;
                    if (r < 1024) { const int rr = r & 511, nb = rr % 16; return TpDesc{(r < 512 ? wg : wu) + (size_t)e * D * 512, GUT + (size_t)e * 1024 * D, D, 512, 128 * (nb >> 2) + (r < 512 ? 0 : 128), rr}; }
                    return TpDesc{wd + (size_t)e * 512 * D, DNT + (size_t)e * D * 512, 512, D, 0, r - 1024}; }, scr, FLANE);
                return true;
            };
            if ((F.vcu & 3) == 1 || (F.vcu & 7) == 2) while (conv_batch()) {}
            for (;;) {
                __syncthreads();
                if (FTID == 0) *qslot = __hip_atomic_fetch_add(F.ctl + CW_ATTQ, 1u, __ATOMIC_RELAXED, __HIP_MEMORY_SCOPE_AGENT);
                __syncthreads();
                const int u = (int)__builtin_amdgcn_readfirstlane(*qslot);
                if (u >= 512) break;
                const int qb = 15 - (u >> 5), bh = u & 31;
                att::attn_unit<8>(F.lds + RING_OFF, F.wave, bh >> 3, bh & 7, qb, PROJ16, Y16, (const float*)(ws + WS_BIAS) + (bh & 7) * 129, lam, args.in[10]);
            }
            while (conv_batch()) {}
            for (;;) {
                __syncthreads();
                if (FTID == 0) qslot[1] = __hip_atomic_fetch_add(F.ctl + CW_PQ, 1u, __ATOMIC_RELAXED, __HIP_MEMORY_SCOPE_AGENT);
                __syncthreads();
                const int q = (int)__builtin_amdgcn_readfirstlane(qslot[1]);
                if (q >= 96 + 256) break;
                if (q >= 96) { p0_transpose_item(args.in[22], D, D, WoutT, 0, (LAS float*)(F.lds + RING_OFF + F.wave * 16384), (q - 96) * 8 + F.wave, FLANE); continue; }
                if (q < 64) { const GAS f32x4* pi = (const GAS f32x4*)args.in[1] + (size_t)q * 8192; GAS unsigned long long* po = (GAS unsigned long long*)P16 + (size_t)q * 8192;
                    f32x4 v[16];
#pragma unroll
                    for (int i = 0; i < 16; ++i) v[i] = pi[FTID + 512 * i];
#pragma unroll
                    for (int i = 0; i < 16; ++i) po[FTID + 512 * i] = (unsigned long long)pk2h(v[i].x, v[i].y) | ((unsigned long long)pk2h(v[i].z, v[i].w) << 32); }
                else p0_transpose_item(args.in[34], 256, D, PleT, 0, (LAS float*)(F.lds + RING_OFF + F.wave * 16384), (q - 64) * 8 + F.wave, FLANE);
            }
        }
        if (BOTH(3)) xcd_barrier(bar);
    }
    if (PROBE_K == 3) tk_ = __builtin_amdgcn_s_memrealtime();
    if (PROBE_J == 3) t0_ = __builtin_amdgcn_s_memrealtime();
    if (IN(4)) {
        for (int i = blockIdx.x * 512 + FTID; i < 36 * D; i += F.G * 512) { const int e = i / D, d = i % D; RT[i] = e < 4 ? args.in[25][d * 4 + e] : args.in[27][d * 32 + (e - 4)]; }
        pg8::Gemm g{Y16, WoutT, T, D, D, D}; pg8::StaticOrder S; S.init(T, D, F.G, (int)blockIdx.x);
        pg8::EpiResLN E{args.in[0], args.out, D, ALPHA, (const float2*)(ws + WS_ROWST), args.in[2], args.in[3]};
        pg8::gemm_phase<pg8::EpiResLN, pg8::StaticOrder, true>(F.lds + RING_OFF, g, S, E, F.wave);
        if (BOTH(4)) xcd_barrier(bar);
    }
    if (PROBE_K == 4) tk_ = __builtin_amdgcn_s_memrealtime();
    if (PROBE_J == 4) t0_ = __builtin_amdgcn_s_memrealtime();
    if (IN(5)) for (int rep_ = 0; rep_ < REP_P5; ++rep_) {
        const bool dry = rep_ < REP_P5 - 1;
        f16_t* o16b = dry ? (f16_t*)(ws + WS_CHK + 64 * MiB) : H1_16;
        const int lane = FLANE, tid = F.wave * 64 + lane;
        LAS float* lg = (LAS float*)(F.lds + RING_OFF + 49152) + F.wave * 256;
        LAS int* lcnt = (LAS int*)(F.lds + RING_OFF + 106496);
        if (F.wave == 0 && lane < 32) lcnt[lane] = 0;
        if (F.vcu < T / 32) {
            const int r0 = F.vcu * 32 + F.wave * 4;
            f32x4 v0[8], v1[8], v2[8], v3[8];
            { const GAS f32x4* xr = (const GAS f32x4*)(args.out + (size_t)r0 * D) + lane;
#pragma unroll
              for (int j = 0; j < 8; ++j) { v0[j] = xr[64 * j]; v1[j] = xr[64 * j + D / 4]; v2[j] = xr[64 * j + 2 * (D / 4)]; v3[j] = xr[64 * j + 3 * (D / 4)]; } }
            rt_stage(RT, F.lds + RING_OFF, F.wave, lane);
            ln_norm(lane, v0, args.in[23], args.in[24]); ln_norm(lane, v1, args.in[23], args.in[24]); asm volatile("" ::: "memory"); ln_norm(lane, v2, args.in[23], args.in[24]); ln_norm(lane, v3, args.in[23], args.in[24]);
#pragma unroll 1
            for (int ec = 0; ec < 6; ++ec) {
                asm volatile("s_waitcnt vmcnt(0)" ::: "memory"); __syncthreads();
                if (ec + 1 < 6) rt_stage(RT + (size_t)(ec + 1) * 6 * D, F.lds + RING_OFF + ((ec + 1) & 1) * 57344, F.wave, lane);
                const LAS float* rtb = (const LAS float*)(F.lds + RING_OFF + (ec & 1) * 57344);
                float a0[6], a1[6], a2[6], a3[6];
                typedef float f32x2 __attribute__((ext_vector_type(2)));
#pragma unroll
                for (int eh = 0; eh < 2; ++eh) {
                    f32x2 c0[3], c1[3], c2[3], c3[3];
#pragma unroll
                    for (int e = 0; e < 3; ++e) { c0[e] = 0.f; c1[e] = 0.f; c2[e] = 0.f; c3[e] = 0.f; }
#pragma unroll
                    for (int j = 0; j < 8; ++j)
#pragma unroll
                        for (int e = 0; e < 3; ++e) { const f32x4 w = *(const LAS f32x4*)(rtb + (3 * eh + e) * D + 256 * j + 4 * lane); const f32x2 wl = w.xy, wh = w.zw;
                            c0[e] += v0[j].xy * wl; c0[e] += v0[j].zw * wh; c1[e] += v1[j].xy * wl; c1[e] += v1[j].zw * wh;
                            c2[e] += v2[j].xy * wl; c2[e] += v2[j].zw * wh; c3[e] += v3[j].xy * wl; c3[e] += v3[j].zw * wh; }
#pragma unroll
                    for (int e = 0; e < 3; ++e) { a0[3 * eh + e] = c0[e].x + c0[e].y; a1[3 * eh + e] = c1[e].x + c1[e].y; a2[3 * eh + e] = c2[e].x + c2[e].y; a3[3 * eh + e] = c3[e].x + c3[e].y; }
                }
#pragma unroll
                for (int e = 0; e < 6; ++e) { a0[e] = wsum64(a0[e]); a1[e] = wsum64(a1[e]); a2[e] = wsum64(a2[e]); a3[e] = wsum64(a3[e]); }
                if (lane == 0) {
#pragma unroll
                    for (int e = 0; e < 6; ++e) { lg[ec * 6 + e] = a0[e]; lg[64 + ec * 6 + e] = a1[e]; lg[128 + ec * 6 + e] = a2[e]; lg[192 + ec * 6 + e] = a3[e]; } }
            }
            LDS_WAIT();
            int ea = 0, ebb = 0, pl0 = 0, pl1 = 0; float wa = 0.f, wb = 0.f;
            if (lane < 4 && !dry) { float aa[36];
#pragma unroll
                for (int e = 0; e < 36; ++e) aa[e] = lg[lane * 64 + e];
                route_pick(aa, args.in[26], args.in[28], ea, ebb, wa, wb);
                pl0 = __hip_atomic_fetch_add(lcnt + ea, 1, __ATOMIC_RELAXED, __HIP_MEMORY_SCOPE_WORKGROUP); pl1 = __hip_atomic_fetch_add(lcnt + ebb, 1, __ATOMIC_RELAXED, __HIP_MEMORY_SCOPE_WORKGROUP); }
            __syncthreads();
            if (F.wave == 0 && lane < 32 && !dry) { const int c = lcnt[lane]; int base = 0; if (c) base = atomicAdd(&cnt[lane * CNT_STRIDE], c); lcnt[32 + lane] = base; }
            __syncthreads();
            if (lane < 4 && !dry) { const int tok = r0 + lane; const int p0 = lcnt[32 + ea] + pl0, p1 = lcnt[32 + ebb] + pl1;
                ltok[ea * 8192 + p0] = tok; lpair[ea * 8192 + p0] = tok * 2; ltok[ebb * 8192 + p1] = tok; lpair[ebb * 8192 + p1] = tok * 2 + 1;
                pairw[tok * 2] = wa; pairw[tok * 2 + 1] = wb; }
            ln_store16(lane, v0, o16b + (size_t)r0 * D); ln_store16(lane, v1, o16b + (size_t)(r0 + 1) * D);
            ln_store16(lane, v2, o16b + (size_t)(r0 + 2) * D); ln_store16(lane, v3, o16b + (size_t)(r0 + 3) * D);
        }
        if (BOTH(5) && !dry) xcd_barrier(bar); else __syncthreads();
    }
    if (PROBE_K == 5) tk_ = __builtin_amdgcn_s_memrealtime();
    if (PROBE_J == 5) t0_ = __builtin_amdgcn_s_memrealtime();
    if (IN(6)) {
        build_moe_table(F, cnt);
        pg8::Gemm g{H1_16, GUT, 0, 0, D, D}; pg8::MoeOrder<true> S{(const LAS int*)(F.lds + TAB_OFF), ltok, F.vcu, F.G, 4, (size_t)1024 * D * 2, 0};
        pg8::EpiGU E{HID};
        for (int rep_ = 0; rep_ < REP_P6; ++rep_) pg8::gemm_phase<pg8::EpiGU, pg8::MoeOrder<true>, true>(F.lds + RING_OFF, g, S, E, F.wave);
        if (BOTH(6)) xcd_barrier(bar);
    }
    if (PROBE_K == 6) tk_ = __builtin_amdgcn_s_memrealtime();
    if (PROBE_J == 6) t0_ = __builtin_amdgcn_s_memrealtime();
    if (IN(7)) {
        if (!IN(6)) build_moe_table(F, cnt);
        const pg8::Gemm gU{H1_16, GUT, 0, 0, D, D}; const pg8::Gemm gD{HID, DNT, 0, 0, 512, 512};
        const pg8::EpiGU EU{HID}; const pg8::EpiDown ED{FFN16, lpair};
        if (F.vcu < 64) { pg8::MoeOrder<true> S{(const LAS int*)(F.lds + TAB_OFF), ltok, F.vcu, 64, 4, (size_t)1024 * D * 2, 1};
            pg8::gemm_phase<pg8::EpiGU, pg8::MoeOrder<true>, true>(F.lds + RING_OFF, gU, S, EU, F.wave); }
        else { pg8::MoeOrder<false> S{(const LAS int*)(F.lds + TAB_OFF), nullptr, F.vcu - 64, F.G - 64, 8, (size_t)D * 512 * 2, 0};
            pg8::gemm_phase<pg8::EpiDown, pg8::MoeOrder<false>, true>(F.lds + RING_OFF, gD, S, ED, F.wave);
            __syncthreads();
            const int dv = F.vcu - 64;
            if (dv < 128) { LAS float* scr = (LAS float*)(F.lds + RING_OFF + F.wave * 16384); constexpr int I_SQ = (D / 64) * (D / 32);
              for (int it = dv * NWAVES + F.wave; it < I_SQ; it += 128 * NWAVES) p0_transpose_item(args.in[36], D, D, GateT, 0, scr, it, FLANE); }
            else { pg8::Gemm g2{P16, PleT, T, D, 256, 256}; pg8::StaticOrder S2; S2.init(T, D, 64, dv - 128); S2.lim = 128;
              pg8::EpiF16 E2{PW16, D, 0, 1.f};
              pg8::gemm_phase<pg8::EpiF16, pg8::StaticOrder, true>(F.lds + RING_OFF, g2, S2, E2, F.wave); } }
        xcd_barrier(bar);
        { pg8::MoeOrder<false> S{(const LAS int*)(F.lds + TAB_OFF), nullptr, F.vcu, F.G, 8, (size_t)D * 512 * 2, 1};
          pg8::gemm_phase<pg8::EpiDown, pg8::MoeOrder<false>, true>(F.lds + RING_OFF, gD, S, ED, F.wave); }
        if (F.vcu >= F.G / 2) { pg8::Gemm g2{P16, PleT, T, D, 256, 256}; pg8::StaticOrder S2; S2.init(T, D, F.G / 2, F.vcu - F.G / 2); S2.lim = 128; S2.off = 128;
          pg8::EpiF16 E2{PW16, D, 0, 1.f};
          pg8::gemm_phase<pg8::EpiF16, pg8::StaticOrder, true>(F.lds + RING_OFF, g2, S2, E2, F.wave); }
        if (BOTH(7)) xcd_barrier(bar);
    }
    if (PROBE_K == 7) tk_ = __builtin_amdgcn_s_memrealtime();
    if (PROBE_J == 7) t0_ = __builtin_amdgcn_s_memrealtime();
    if (IN(8)) for (int rep_ = 0; rep_ < REP_P8; ++rep_) {
        const bool dry = rep_ < REP_P8 - 1;
        f16_t* o16b = dry ? (f16_t*)(ws + WS_GUT + 64 * MiB) : Y16; float* rrs = dry ? (float*)(ws + WS_GUT + 100 * MiB) : ROWRS;
        typedef _Float16 h4_t __attribute__((ext_vector_type(4)));
        const int lane = FLANE;
        for (int m = gw; m < T; m += NGW) {
            f32x4 v[8]; const GAS h4_t* xr = (const GAS h4_t*)(H1_16 + (size_t)m * D) + lane;
            const GAS h4_t* f0 = (const GAS h4_t*)(FFN16 + (size_t)(2 * m) * D) + lane; const GAS h4_t* f1 = (const GAS h4_t*)(FFN16 + (size_t)(2 * m + 1) * D) + lane;
            const GAS h4_t* pr = (const GAS h4_t*)(PW16 + (size_t)m * D) + lane;
            const float w0 = pairw[2 * m], w1 = pairw[2 * m + 1]; float q = 0.f;
#pragma unroll
            for (int j = 0; j < 8; ++j) { const h4_t x = xr[64 * j]; const h4_t a = f0[64 * j], c = f1[64 * j], pv = pr[64 * j];
                v[j].x = ALPHA * (float)x[0] + w0 * (float)a[0] + w1 * (float)c[0]; v[j].y = ALPHA * (float)x[1] + w0 * (float)a[1] + w1 * (float)c[1];
                v[j].z = ALPHA * (float)x[2] + w0 * (float)a[2] + w1 * (float)c[2]; v[j].w = ALPHA * (float)x[3] + w0 * (float)a[3] + w1 * (float)c[3];
                q += ((float)pv[0] * (float)pv[0] + (float)pv[1] * (float)pv[1]) + ((float)pv[2] * (float)pv[2] + (float)pv[3] * (float)pv[3]); }
            ln_norm(lane, v, args.in[32], args.in[33]); ln_store16(lane, v, o16b + (size_t)m * D);
            q = wave_sum_b(q);
            if (lane == 0) rrs[m] = __builtin_amdgcn_rsqf(q * (1.f / D) + LN_EPS);
        }
        if (BOTH(8) && !dry) xcd_barrier(bar); else __syncthreads();
    }
    if (PROBE_K == 8) tk_ = __builtin_amdgcn_s_memrealtime();
    if (PROBE_J == 8) t0_ = __builtin_amdgcn_s_memrealtime();
    if (IN(9)) {
        pg8::Gemm g{Y16, GateT, T, D, D, D}; pg8::StaticOrder S; S.init(T, D, F.G, (int)blockIdx.x);
        pg8::EpiFinal E{args.out, D, Y16, PW16, ROWRS, args.in[35]};
        pg8::gemm_phase<pg8::EpiFinal, pg8::StaticOrder, true>(F.lds + RING_OFF, g, S, E, F.wave);
    }
    if (PROBE_K != -1) {
        if (PROBE_K == 9) tk_ = __builtin_amdgcn_s_memrealtime();
        xcd_barrier(bar);
        if (blockIdx.x == 0 && FTID == 0) args.out[0] += (PROBE_K == -2) ? 100000.f : (float)(tk_ - t0_) * PROBE_SCALE;
    }
#undef IN
#undef BOTH
}

extern "C" void kernel_launch(void* const* d_in, const int* in_sizes, int n_in, void* d_out, int out_size, void* d_ws, size_t ws_size, hipStream_t stream) {
    static int grid = 0;
    if (grid == 0) {
        if (ws_size < WS_END2 || n_in != 37 || out_size != T * D) { fprintf(stderr, "kernel_launch: bad ws/n_in/out: %zu %d %d\n", ws_size, n_in, out_size); grid = -1; return; }
        int dev = 0, cus = 0;
        if (hipGetDevice(&dev) != hipSuccess || hipDeviceGetAttribute(&cus, hipDeviceAttributeMultiprocessorCount, dev) != hipSuccess) { grid = -1; return; }
        if (hipFuncSetAttribute((const void*)mega_fwd, hipFuncAttributeMaxDynamicSharedMemorySize, LDS_BYTES) != hipSuccess) { fprintf(stderr, "kernel_launch: hipFuncSetAttribute failed\n"); grid = -1; return; }
        if (cus != 256) { fprintf(stderr, "kernel_launch: built for a 256-CU device, found %d\n", cus); grid = -1; return; }
        grid = cus;
    }
    if (grid < 0) return;
    (void)hipMemsetAsync(d_ws, 0, CTL_ZERO_BYTES, stream);
    Args a{}; for (int i = 0; i < 37; ++i) a.in[i] = (const float*)d_in[i]; a.out = (float*)d_out; a.ws = (unsigned char*)d_ws; a.ph_lo = 0; a.ph_hi = 10; a.li = 0;
    hipLaunchKernelGGL(mega_fwd, dim3(grid), dim3(NWAVES * 64), LDS_BYTES, stream, a);
}
```
